# Optimizing an MI355X kernel written in HIP

```python
import math
import jax
import jax.numpy as jnp
from jax import lax
import numpy as np

D_MODEL = 1024
BATCH = 2
SEQ = 8192
DEPTH = 2

CHUNK = 64
Q_BLOCK = 128
HEAD_DIM = 64
N_HEADS_SB = 8
N_HEADS_DIFF = 4
N_HEADS_CHUNK = D_MODEL // HEAD_DIM
D_SB = N_HEADS_SB * HEAD_DIM
D_DIFF = N_HEADS_DIFF * 2 * HEAD_DIM
D_MIX = D_SB + D_DIFF
D_IN_EVEN = 3 * D_SB + 3 * D_DIFF
ROPE_THETA = 500000.0
ROT_DIM = HEAD_DIM // 4
LEFT_CHUNKS = 8
BAND = (LEFT_CHUNKS + 1) * CHUNK
REL_CLIP = 128
N_REL = 2 * REL_CLIP + 1
D_FF_DENSE = 2816
N_EXPERTS = 8
TOP_K = 2
D_FF_EXPERT = 3584
RMS_EPS = 1e-6
N_EVEN = (DEPTH + 1) // 2
N_ODD = DEPTH // 2

kernel_name = 'hybrid_stickbreak_diff_chunkband_moe_trunk'

F32 = jnp.float32


def rms_norm(x, g):
    xf = x.astype(F32)
    y = xf * lax.rsqrt(jnp.mean(xf * xf, axis=-1, keepdims=True) + RMS_EPS)
    return (y * g.astype(F32)).astype(x.dtype)


def rope_tables(positions):
    inv_freq = ROPE_THETA ** (-jnp.arange(0, ROT_DIM, 2, dtype=F32) / ROT_DIM)
    ang = positions.astype(F32)[..., None] * inv_freq
    return jnp.cos(ang)[:, None], jnp.sin(ang)[:, None]


def partial_rope(x, cos, sin):
    half = ROT_DIM // 2
    x1 = x[..., :half].astype(F32)
    x2 = x[..., half:ROT_DIM].astype(F32)
    rot = jnp.concatenate([x1 * cos - x2 * sin, x2 * cos + x1 * sin], axis=-1)
    return jnp.concatenate([rot.astype(x.dtype), x[..., ROT_DIM:]], axis=-1)


def split_heads(t, n):
    b, s, _ = t.shape
    return t.reshape(b, s, n, -1).transpose(0, 2, 1, 3)


def merge_heads(o):
    b, h, s, d = o.shape
    return o.transpose(0, 2, 1, 3).reshape(b, s, h * d)


def to_query_blocks(q):
    b, h, s, d = q.shape
    return jnp.moveaxis(q.reshape(b, h, s // Q_BLOCK, Q_BLOCK, d), 2, 0)


def from_query_blocks(o):
    nb, b, h, qb, d = o.shape
    return jnp.moveaxis(o, 0, 2).reshape(b, h, nb * qb, d)


def stick_breaking_attention(q, k, v):
    s_len = q.shape[2]
    nb = s_len // Q_BLOCK
    scale = HEAD_DIM ** -0.5
    k_idx = jnp.arange(s_len)

    def block(args):
        q_blk, start = args
        z = jnp.einsum('bhqd,bhkd->bhqk', q_blk, k, preferred_element_type=F32) * scale
        t_idx = start + jnp.arange(Q_BLOCK)
        past = k_idx[None, :] < t_idx[:, None]
        log_stay = jnp.where(past, jax.nn.log_sigmoid(-z), 0.0)
        between = lax.cumsum(log_stay, axis=3, reverse=True) - log_stay
        w = jnp.where(past, jnp.exp(jax.nn.log_sigmoid(z) + between), 0.0)
        return jnp.einsum('bhqk,bhkd->bhqd', w.astype(v.dtype), v)

    out = lax.map(block, (to_query_blocks(q), jnp.arange(nb, dtype=jnp.int32) * Q_BLOCK))
    return from_query_blocks(out)


def differential_attention(q, k, v, lam):
    b, h, _, s_len, d = q.shape
    nb = s_len // Q_BLOCK
    scale = HEAD_DIM ** -0.5
    k_chunk = jnp.arange(s_len) // CHUNK
    q_blocks = jnp.moveaxis(q.reshape(b, h, 2, nb, Q_BLOCK, d), 3, 0)

    def block(args):
        q_blk, start = args
        sc = jnp.einsum('bhmqd,bhmkd->bhmqk', q_blk, k, preferred_element_type=F32) * scale
        t_chunk = (start + jnp.arange(Q_BLOCK)) // CHUNK
        visible = k_chunk[None, :] <= t_chunk[:, None]
        p = jax.nn.softmax(jnp.where(visible, sc, -jnp.inf), axis=-1)
        w = p[:, :, 0] - lam * p[:, :, 1]
        return jnp.einsum('bhqk,bhkv->bhqv', w.astype(v.dtype), v)

    out = lax.map(block, (q_blocks, jnp.arange(nb, dtype=jnp.int32) * Q_BLOCK))
    return from_query_blocks(out)


def chunk_band_attention(q, k, v, rel_table):
    b, h, s_len, d = q.shape
    nc = s_len // CHUNK
    pad = LEFT_CHUNKS * CHUNK
    scale = HEAD_DIM ** -0.5
    k_pad = jnp.pad(k, ((0, 0), (0, 0), (pad, 0), (0, 0)))
    v_pad = jnp.pad(v, ((0, 0), (0, 0), (pad, 0), (0, 0)))
    i = jnp.arange(CHUNK)
    j = jnp.arange(BAND)
    rel = jnp.clip(pad + i[:, None] - j[None, :], -REL_CLIP, REL_CLIP) + REL_CLIP
    bias = rel_table[:, rel].astype(F32)
    q_chunks = jnp.moveaxis(q.reshape(b, h, nc, CHUNK, d), 2, 0)

    def chunk(args):
        q_c, c = args
        start = c * CHUNK
        k_band = lax.dynamic_slice_in_dim(k_pad, start, BAND, axis=2)
        v_band = lax.dynamic_slice_in_dim(v_pad, start, BAND, axis=2)
        sc = jnp.einsum('bhqd,bhkd->bhqk', q_c, k_band, preferred_element_type=F32) * scale + bias
        valid = (start - pad + j) >= 0
        p = jax.nn.softmax(jnp.where(valid[None, None, None, :], sc, -jnp.inf), axis=-1)
        return jnp.einsum('bhqk,bhkd->bhqd', p.astype(v.dtype), v_band)

    out = lax.map(chunk, (q_chunks, jnp.arange(nc, dtype=jnp.int32)))
    return jnp.moveaxis(out, 0, 2).reshape(b, h, s_len, d)


def even_mixer(h, cos, sin, w_in, q_norm, k_norm, lam_q1, lam_k1, lam_q2, lam_k2, subln, w_out, layer):
    b, s, _ = h.shape
    proj = h @ w_in
    cuts = [D_SB, 2 * D_SB, 3 * D_SB, 3 * D_SB + D_DIFF, 3 * D_SB + 2 * D_DIFF]
    q_sb, k_sb, v_sb, q_df, k_df, v_df = jnp.split(proj, cuts, axis=-1)
    o_sb = stick_breaking_attention(split_heads(q_sb, N_HEADS_SB), split_heads(k_sb, N_HEADS_SB),
                                    split_heads(v_sb, N_HEADS_SB))
    qd = partial_rope(rms_norm(split_heads(q_df, 2 * N_HEADS_DIFF), q_norm), cos, sin)
    kd = partial_rope(rms_norm(split_heads(k_df, 2 * N_HEADS_DIFF), k_norm), cos, sin)
    qd = qd.reshape(b, N_HEADS_DIFF, 2, s, HEAD_DIM)
    kd = kd.reshape(b, N_HEADS_DIFF, 2, s, HEAD_DIM)
    vd = split_heads(v_df, N_HEADS_DIFF)
    lam_init = 0.8 - 0.6 * math.exp(-0.3 * layer)
    lam = (jnp.exp(jnp.sum(lam_q1.astype(F32) * lam_k1.astype(F32)))
           - jnp.exp(jnp.sum(lam_q2.astype(F32) * lam_k2.astype(F32))) + lam_init)
    o_df = rms_norm(differential_attention(qd, kd, vd, lam), subln) * (1.0 - lam_init)
    merged = jnp.concatenate([merge_heads(o_sb), merge_heads(o_df)], axis=-1)
    return merged @ w_out


def odd_mixer(h, w_qkv, q_norm, k_norm, rel_table, w_out):
    q, k, v = jnp.split(h @ w_qkv, 3, axis=-1)
    q = rms_norm(split_heads(q, N_HEADS_CHUNK), q_norm)
    k = rms_norm(split_heads(k, N_HEADS_CHUNK), k_norm)
    o = chunk_band_attention(q, k, split_heads(v, N_HEADS_CHUNK), rel_table)
    return merge_heads(o) @ w_out


def swiglu(h, w_gate, w_up, w_down):
    return (jax.nn.silu(h @ w_gate) * (h @ w_up)) @ w_down


def moe_swiglu(h, w_router, we_gate, we_up, we_down):
    b, s, d = h.shape
    t = h.reshape(b * s, d)
    logits = (t @ w_router).astype(F32)
    top_val, top_idx = lax.top_k(logits, TOP_K)
    gates = jax.nn.softmax(top_val, axis=-1)
    combine = jnp.einsum('tk,tke->te', gates, jax.nn.one_hot(top_idx, N_EXPERTS, dtype=F32))
    y = jnp.zeros_like(t)
    for e in range(N_EXPERTS):
        y = y + combine[:, e:e + 1].astype(t.dtype) * swiglu(t, we_gate[e], we_up[e], we_down[e])
    return y.reshape(b, s, d)


def setup_inputs(seed: int = 0) -> dict:
    key = jax.random.key(seed)
    ks = jax.random.split(key, 32)

    def nrm(k, shape, scale):
        return jax.random.normal(k, shape, F32) * scale

    def gain(k, shape):
        return 1.0 + 0.02 * jax.random.normal(k, shape, F32)

    x = nrm(ks[0], (BATCH, SEQ, D_MODEL), 1.0)
    offsets = jax.random.randint(ks[1], (BATCH, 1), 0, 16, dtype=jnp.int32) * CHUNK
    positions = offsets + jnp.arange(SEQ, dtype=jnp.int32)[None, :]
    return {
        'x': x,
        'positions': positions,
        'ev_attn_norm': gain(ks[2], (N_EVEN, D_MODEL)),
        'ev_w_in': nrm(ks[3], (N_EVEN, D_MODEL, D_IN_EVEN), D_MODEL ** -0.5),
        'ev_q_norm': gain(ks[4], (N_EVEN, HEAD_DIM)),
        'ev_k_norm': gain(ks[5], (N_EVEN, HEAD_DIM)),
        'ev_lambda_q1': nrm(ks[6], (N_EVEN, HEAD_DIM), 0.1),
        'ev_lambda_k1': nrm(ks[7], (N_EVEN, HEAD_DIM), 0.1),
        'ev_lambda_q2': nrm(ks[8], (N_EVEN, HEAD_DIM), 0.1),
        'ev_lambda_k2': nrm(ks[9], (N_EVEN, HEAD_DIM), 0.1),
        'ev_subln': gain(ks[10], (N_EVEN, 2 * HEAD_DIM)),
        'ev_w_out': nrm(ks[11], (N_EVEN, D_MIX, D_MODEL), D_MIX ** -0.5),
        'ev_ffn_norm': gain(ks[12], (N_EVEN, D_MODEL)),
        'ev_w_gate': nrm(ks[13], (N_EVEN, D_MODEL, D_FF_DENSE), D_MODEL ** -0.5),
        'ev_w_up': nrm(ks[14], (N_EVEN, D_MODEL, D_FF_DENSE), D_MODEL ** -0.5),
        'ev_w_down': nrm(ks[15], (N_EVEN, D_FF_DENSE, D_MODEL), D_FF_DENSE ** -0.5),
        'od_attn_norm': gain(ks[16], (N_ODD, D_MODEL)),
        'od_w_qkv': nrm(ks[17], (N_ODD, D_MODEL, 3 * N_HEADS_CHUNK * HEAD_DIM), D_MODEL ** -0.5),
        'od_q_norm': gain(ks[18], (N_ODD, HEAD_DIM)),
        'od_k_norm': gain(ks[19], (N_ODD, HEAD_DIM)),
        'od_rel_bias': nrm(ks[20], (N_ODD, N_HEADS_CHUNK, N_REL), 0.5),
        'od_w_out': nrm(ks[21], (N_ODD, N_HEADS_CHUNK * HEAD_DIM, D_MODEL), (N_HEADS_CHUNK * HEAD_DIM) ** -0.5),
        'od_ffn_norm': gain(ks[22], (N_ODD, D_MODEL)),
        'od_router': nrm(ks[23], (N_ODD, D_MODEL, N_EXPERTS), D_MODEL ** -0.5),
        'od_we_gate': nrm(ks[24], (N_ODD, N_EXPERTS, D_MODEL, D_FF_EXPERT), D_MODEL ** -0.5),
        'od_we_up': nrm(ks[25], (N_ODD, N_EXPERTS, D_MODEL, D_FF_EXPERT), D_MODEL ** -0.5),
        'od_we_down': nrm(ks[26], (N_ODD, N_EXPERTS, D_FF_EXPERT, D_MODEL), D_FF_EXPERT ** -0.5),
    }


def reference(x, positions, ev_attn_norm, ev_w_in, ev_q_norm, ev_k_norm, ev_lambda_q1, ev_lambda_k1,
              ev_lambda_q2, ev_lambda_k2, ev_subln, ev_w_out, ev_ffn_norm, ev_w_gate, ev_w_up, ev_w_down,
              od_attn_norm, od_w_qkv, od_q_norm, od_k_norm, od_rel_bias, od_w_out, od_ffn_norm, od_router,
              od_we_gate, od_we_up, od_we_down):
    cos, sin = rope_tables(positions)
    for layer in range(DEPTH):
        i = layer // 2
        if layer % 2 == 0:
            x = x + even_mixer(rms_norm(x, ev_attn_norm[i]), cos, sin, ev_w_in[i], ev_q_norm[i], ev_k_norm[i],
                               ev_lambda_q1[i], ev_lambda_k1[i], ev_lambda_q2[i], ev_lambda_k2[i],
                               ev_subln[i], ev_w_out[i], layer)
            x = x + swiglu(rms_norm(x, ev_ffn_norm[i]), ev_w_gate[i], ev_w_up[i], ev_w_down[i])
        else:
            x = x + odd_mixer(rms_norm(x, od_attn_norm[i]), od_w_qkv[i], od_q_norm[i], od_k_norm[i],
                              od_rel_bias[i], od_w_out[i])
            x = x + moe_swiglu(rms_norm(x, od_ffn_norm[i]), od_router[i], od_we_gate[i], od_we_up[i],
                               od_we_down[i])
    return x
```

```cpp
#include <hip/hip_runtime.h>
#include <cstdio>
#include <cstdint>
#include <cmath>
namespace pg8 {
#define PG8_LAS __attribute__((address_space(3)))
typedef unsigned short bf16_t;
typedef short bf16x8 __attribute__((ext_vector_type(8)));
typedef float f32x4 __attribute__((ext_vector_type(4)));
typedef unsigned u32x4 __attribute__((ext_vector_type(4)));
constexpr int BM = 256, BK = 64, HALF = 128, HTB = HALF * BK * 2  , STAGE_BYTES = 8 * HTB, NXCD = 8, WGM = 8;

__host__ __device__ __forceinline__ int lds_byte(int r, int c) { const int st = (r >> 4) * 2 + (c >> 5), rr = r & 15, cc = c & 31, ob = rr * 64 + cc * 2; return st * 1024 + (ob ^ (((ob >> 9) & 1) << 5)); }
__host__ __device__ __forceinline__ void stage_rc(int b, int& R, int& C) { const int st = b / 1024, sb = b % 1024, swz = sb ^ (((sb >> 9) & 1) << 5); R = (st >> 1) * 16 + swz / 64; C = (st & 1) * 32 + (swz % 64) / 2; }
__host__ __device__ __forceinline__ int perm32(int rho) { const int n = rho >> 4, i = rho & 15; return 8 * (i >> 2) + 4 * n + (i & 3); }

struct Unit { int pm, pn; };
struct Gemm { const bf16_t* A; const bf16_t* Bt; int M, N, K; };

struct StaticOrder {
    int nM, nN, nwg, G, c;
    __host__ __device__ void init(int M, int N, int G_, int c_) { nM = M / BM; nN = N / BM; nwg = nM * nN; G = G_; c = c_; }
    __host__ __device__ bool next(int i, Unit& u) const {
        const long L = (long)i * G + c; if (L >= nwg) return false;
        int wgid = (int)L; { const int q = nwg / NXCD, r = nwg % NXCD, xcd = wgid % NXCD, off = wgid / NXCD; wgid = (xcd < r ? xcd * (q + 1) : r * (q + 1) + (xcd - r) * q) + off; }
        const int nig = WGM * nN, gid = wgid / nig, fm = gid * WGM, gsz = (nM - fm) < WGM ? (nM - fm) : WGM;
        u.pm = fm + ((wgid % nig) % gsz); u.pn = (wgid % nig) / gsz; return true;
    }
    __device__ __forceinline__ void a_ready(const Unit&) const {}
    __device__ __forceinline__ void done(const Unit&) const {}
};

struct MoeOrder {
    int nM, nN, nwg, G, c, tile0; const int* tile_expert;
    __device__ void init(int ntiles, int npn, int G_, int c_, int tile0_, const int* te) { nM = ntiles; nN = npn; nwg = nM * nN; G = G_; c = c_; tile0 = tile0_; tile_expert = te; }
    __device__ bool next(int i, Unit& u) const {
        const long L = (long)i * G + c; if (L >= nwg) return false;
        int wgid = (int)L; { const int q = nwg / NXCD, r = nwg % NXCD, xcd = wgid % NXCD, off = wgid / NXCD; wgid = (xcd < r ? xcd * (q + 1) : r * (q + 1) + (xcd - r) * q) + off; }
        const int nig = WGM * nN, gid = wgid / nig, fm = gid * WGM, gsz = (nM - fm) < WGM ? (nM - fm) : WGM;
        u.pm = fm + ((wgid % nig) % gsz); const int pnl = (wgid % nig) / gsz;
        const int e = __builtin_amdgcn_readfirstlane(tile_expert[tile0 + u.pm]);
        u.pn = e * nN + pnl; return true;
    }
    __device__ __forceinline__ void a_ready(const Unit&) const {}
    __device__ __forceinline__ void done(const Unit&) const {}
};

__device__ __forceinline__ unsigned cvt_pk_bf16(float lo, float hi) { unsigned r; asm volatile("v_cvt_pk_bf16_f32 %0, %1, %2" : "=v"(r) : "v"(lo), "v"(hi)); return r; }
__device__ __forceinline__ u32x4 pack8(const f32x4& a, const f32x4& b) { u32x4 w; w.x = cvt_pk_bf16(a[0], a[1]); w.y = cvt_pk_bf16(a[2], a[3]); w.z = cvt_pk_bf16(b[0], b[1]); w.w = cvt_pk_bf16(b[2], b[3]); return w; }
constexpr float RMS_EPS = 1e-6f;
constexpr float LOG2E = 1.4426950408889634f;
constexpr float C2 = 0.125f * LOG2E;
__device__ __forceinline__ float row_ss(const float* ss, int nparts, int row) {
    if (nparts == 1) return ss[row];
    const f32x4* p = (const f32x4*)(ss + (size_t)row * 16); f32x4 a = p[0], b = p[1], c = p[2], d = p[3]; a = (a + b) + (c + d); return (a[0] + a[1]) + (a[2] + a[3]);
}

struct EpiProj {
    static constexpr bool PERM = true, AFTER_DRAIN = false;
    bf16_t* O; int ldc; const float* ss; int nparts; const float* gq; const float* gk; const float* rope; int layer;
    __device__ __forceinline__ void operator()(const f32x4 (&acc)[2][2][4][2], const Unit& u, int wr, int wc, int fr, int fq) const {
        const int pn = u.pn; int kind = 0; float scale = 1.f; bool rope_on = false;
        if (layer == 0) { const int t = pn >> 1; if (t == 0) scale = C2; else if (t == 3) { kind = 1; scale = C2; rope_on = true; } else if (t == 4) { kind = 2; rope_on = true; } }
        else { const int t = pn >> 2; if (t == 0) { kind = 1; scale = C2; } else if (t == 1) kind = 2; }
        const float* gv = (kind == 1) ? gq : gk;
        f32x4 g[2][2];
#pragma unroll
        for (int bj = 0; bj < 2; ++bj)
#pragma unroll
            for (int n = 0; n < 2; ++n) g[bj][n] = kind ? *(const f32x4*)(gv + 32 * bj + 8 * fq + 4 * n) : (f32x4){1.f, 1.f, 1.f, 1.f};
        const int row0 = u.pm * BM + wr * 64 + fr, col0 = pn * BM + wc * 64 + 8 * fq;
#pragma unroll
        for (int ai = 0; ai < 2; ++ai)
#pragma unroll
            for (int m = 0; m < 4; ++m) {
                const int row = row0 + ai * HALF + m * 16;
                const float r = rsqrtf(row_ss(ss, nparts, row) * (1.f / 1024.f) + RMS_EPS);
                f32x4 v[2][2]; float s = 0.f;
#pragma unroll
                for (int bj = 0; bj < 2; ++bj)
#pragma unroll
                    for (int n = 0; n < 2; ++n) { v[bj][n] = acc[ai][bj][m][n] * r; const f32x4 x = v[bj][n]; s += (x[0] * x[0] + x[1] * x[1]) + (x[2] * x[2] + x[3] * x[3]); }
                if (kind) {
                    s += __shfl_xor(s, 16); s += __shfl_xor(s, 32);
                    const float rs = rsqrtf(s * (1.f / 64.f) + RMS_EPS);
#pragma unroll
                    for (int bj = 0; bj < 2; ++bj)
#pragma unroll
                        for (int n = 0; n < 2; ++n) v[bj][n] = v[bj][n] * rs * g[bj][n];
                    if (rope_on) {
                        f32x4 p[2];
#pragma unroll
                        for (int n = 0; n < 2; ++n)
#pragma unroll
                            for (int j = 0; j < 4; ++j) p[n][j] = __shfl_xor(v[0][n][j], 16);
                        const f32x4 c0 = *(const f32x4*)(rope + (size_t)row * 16), c1 = *(const f32x4*)(rope + (size_t)row * 16 + 4);
                        const f32x4 s0 = *(const f32x4*)(rope + (size_t)row * 16 + 8), s1 = *(const f32x4*)(rope + (size_t)row * 16 + 12);
                        if (fq == 0) { v[0][0] = v[0][0] * c0 - p[0] * s0; v[0][1] = v[0][1] * c1 - p[1] * s1; }
                        else if (fq == 1) { v[0][0] = v[0][0] * c0 + p[0] * s0; v[0][1] = v[0][1] * c1 + p[1] * s1; }
                    }
                }
                bf16_t* rowp = O + (size_t)row * ldc + col0;
#pragma unroll
                for (int bj = 0; bj < 2; ++bj) *(u32x4*)(rowp + 32 * bj) = pack8(v[bj][0] * scale, v[bj][1] * scale);
            }
    }
};

struct EpiResid {
    static constexpr bool PERM = true, AFTER_DRAIN = false;
    const float* base; float* out; bf16_t* xb; float* ss;
    __device__ __forceinline__ void operator()(const f32x4 (&acc)[2][2][4][2], const Unit& u, int wr, int wc, int fr, int fq) const {
        const int row0 = u.pm * BM + wr * 64 + fr, col0 = u.pn * BM + wc * 32 + 8 * fq;
#pragma unroll
        for (int ai = 0; ai < 2; ++ai)
#pragma unroll
            for (int m = 0; m < 4; ++m) {
                const int row = row0 + ai * HALF + m * 16; float s = 0.f;
#pragma unroll
                for (int bj = 0; bj < 2; ++bj) {
                    const size_t off = (size_t)row * 1024 + col0 + bj * HALF;
                    const f32x4 v0 = acc[ai][bj][m][0] + *(const f32x4*)(base + off), v1 = acc[ai][bj][m][1] + *(const f32x4*)(base + off + 4);
                    *(f32x4*)(out + off) = v0; *(f32x4*)(out + off + 4) = v1;
                    *(u32x4*)(xb + off) = pack8(v0, v1);
                    s += (v0[0] * v0[0] + v0[1] * v0[1]) + (v0[2] * v0[2] + v0[3] * v0[3]) + (v1[0] * v1[0] + v1[1] * v1[1]) + (v1[2] * v1[2] + v1[3] * v1[3]);
                }
                if (ss) { s += __shfl_xor(s, 16); s += __shfl_xor(s, 32); if (fq == 0) ss[(size_t)row * 16 + u.pn * 4 + wc] = s; }
            }
    }
};

struct EpiSwiglu {
    static constexpr bool PERM = true, AFTER_DRAIN = false;
    bf16_t* O; int ldc; const float* ss; int nparts; const int* rowtok; int tile0; int npn;
    __device__ __forceinline__ void operator()(const f32x4 (&acc)[2][2][4][2], const Unit& u, int wr, int wc, int fr, int fq) const {
        const int pnl = u.pn % npn; const int row0 = u.pm * BM + wr * 64 + fr, col0 = pnl * HALF + wc * 32 + 8 * fq;
#pragma unroll
        for (int ai = 0; ai < 2; ++ai)
#pragma unroll
            for (int m = 0; m < 4; ++m) {
                const int row = row0 + ai * HALF + m * 16;
                int tok = row; if (rowtok) tok = rowtok[tile0 * BM + row];
                const float r = (tok >= 0) ? rsqrtf(row_ss(ss, nparts, tok >= 0 ? tok : 0) * (1.f / 1024.f) + RMS_EPS) : 0.f;
                f32x4 a[2];
#pragma unroll
                for (int n = 0; n < 2; ++n)
#pragma unroll
                    for (int j = 0; j < 4; ++j) { const float gt = acc[ai][0][m][n][j] * r, up = acc[ai][1][m][n][j] * r;
                        a[n][j] = gt * __builtin_amdgcn_rcpf(1.f + __builtin_amdgcn_exp2f(-gt * LOG2E)) * up; }
                *(u32x4*)(O + (size_t)row * ldc + col0) = pack8(a[0], a[1]);
            }
    }
};

struct EpiMoeDown {
    static constexpr bool PERM = true, AFTER_DRAIN = false;
    float* out; const int* rowtok; const float* rowgate; int tile0;
    __device__ __forceinline__ void operator()(const f32x4 (&acc)[2][2][4][2], const Unit& u, int wr, int wc, int fr, int fq) const {
        const int pnl = u.pn & 3; const int row0 = (tile0 + u.pm) * BM + wr * 64 + fr, col0 = pnl * BM + wc * 32 + 8 * fq;
#pragma unroll
        for (int ai = 0; ai < 2; ++ai)
#pragma unroll
            for (int m = 0; m < 4; ++m) {
                const int srow = row0 + ai * HALF + m * 16; const int tok = rowtok[srow];
                if (tok >= 0) { const float gt = rowgate[srow];
#pragma unroll
                    for (int bj = 0; bj < 2; ++bj)
#pragma unroll
                        for (int n = 0; n < 2; ++n) { f32x4* p = (f32x4*)(out + (size_t)tok * 1024 + col0 + bj * HALF + 4 * n); *p = *p + acc[ai][bj][m][n] * gt; } }
            }
    }
};

template <class Epi, class Sched, bool ALIGN_EPI = false, bool SP2 = false>
__device__ __forceinline__ void gemm_phase(PG8_LAS unsigned char* lds, const Gemm g, const Sched& S, const Epi& E) {
    const int tid = threadIdx.x, wid = __builtin_amdgcn_readfirstlane(tid >> 6), lane = tid & 63, wr = wid >> 2, wc = wid & 3, fr = lane & 15, fq = lane >> 4;
    const int K = g.K, nt = K / BK;
    unsigned voffA[2], voffB[2];
#pragma unroll
    for (int i = 0; i < 2; ++i) { int R, C; stage_rc(tid * 16 + i * 8192, R, C); const int Rb = Epi::PERM ? ((R & ~31) + perm32(R & 31)) : R;
        voffA[i] = (unsigned)(R * K + C) * 2u; voffB[i] = (unsigned)(Rb * K + C) * 2u; }
    const size_t kstep = (size_t)(BK * 2);
    const size_t hstep = (size_t)HALF * K * 2;
    const size_t tstep = 2 * hstep;
    const unsigned ldsw = (unsigned)wid * 1024u;
    const int aoff = lds_byte(wr * 64 + fr, fq * 8), boff = lds_byte(wc * 32 + fr, fq * 8);
#define PG8_SA(b, h) (((b) * 2 + (h)) * HTB)
#define PG8_SB(b, h) ((4 + (b) * 2 + (h)) * HTB)
#define PG8_STAGE(bufoff, gbase, voff) do { _Pragma("unroll") for (int _i = 0; _i < 2; ++_i) \
        __builtin_amdgcn_global_load_lds((const unsigned*)((const char*)(gbase) + (voff)[_i]), (PG8_LAS unsigned*)(lds + (bufoff) + ldsw + _i * 8192), 16, 0, 0); } while (0)
#define PG8_LDA(dst, b, h) do { _Pragma("unroll") for (int m = 0; m < 4; ++m) _Pragma("unroll") for (int k = 0; k < 2; ++k) dst[m][k] = *(const PG8_LAS bf16x8*)(lds + PG8_SA(b, h) + aoff + m * 2048 + k * 1024); } while (0)
#define PG8_LDB(dst, b, h) do { _Pragma("unroll") for (int n = 0; n < 2; ++n) _Pragma("unroll") for (int k = 0; k < 2; ++k) dst[n][k] = *(const PG8_LAS bf16x8*)(lds + PG8_SB(b, h) + boff + n * 2048 + k * 1024); } while (0)
#define PG8_MMA(ai, bj, At, Bt) do { __builtin_amdgcn_s_setprio(1); _Pragma("unroll") for (int m = 0; m < 4; ++m) _Pragma("unroll") for (int n = 0; n < 2; ++n) _Pragma("unroll") for (int k = 0; k < 2; ++k) \
        acc[ai][bj][m][n] = __builtin_amdgcn_mfma_f32_16x16x32_bf16(Bt[n][k], At[m][k], acc[ai][bj][m][n], 0, 0, 0); __builtin_amdgcn_s_setprio(0); } while (0)
#define PG8_WAIT_V(n) asm volatile("s_waitcnt vmcnt(" #n ")" ::: "memory")
#define PG8_WAIT_L(n) asm volatile("s_waitcnt lgkmcnt(" #n ")" ::: "memory")
#define PG8_BAR __builtin_amdgcn_s_barrier()
#define PG8_SCHED __builtin_amdgcn_sched_barrier(0)
    Unit cur, nxt; int ui = 0;
    if (!S.next(0, cur)) return;
    f32x4 acc[2][2][4][2];
#pragma unroll
    for (int a = 0; a < 2; ++a)
#pragma unroll
        for (int b = 0; b < 2; ++b)
#pragma unroll
            for (int m = 0; m < 4; ++m)
#pragma unroll
                for (int n = 0; n < 2; ++n) acc[a][b][m][n] = (f32x4){0.f, 0.f, 0.f, 0.f};
    bf16x8 At[4][2], B0[2][2], B1[2][2];
    const char* cA = (const char*)g.A + (size_t)cur.pm * tstep; const char* cB = (const char*)g.Bt + (size_t)cur.pn * tstep;
    S.a_ready(cur);
    if constexpr (SP2) {
        PG8_STAGE(PG8_SB(0, 0), cB, voffB); PG8_STAGE(PG8_SB(0, 1), cB + hstep, voffB); PG8_STAGE(PG8_SA(0, 0), cA, voffA); PG8_STAGE(PG8_SA(0, 1), cA + hstep, voffA);
        if (wr == 1) PG8_BAR;
        PG8_WAIT_V(2); PG8_BAR;
        PG8_STAGE(PG8_SB(1, 0), cB + kstep, voffB); PG8_STAGE(PG8_SA(1, 0), cA + kstep, voffA); PG8_STAGE(PG8_SB(1, 1), cB + hstep + kstep, voffB);
        PG8_WAIT_V(6); PG8_BAR;
    } else {
        PG8_STAGE(PG8_SB(0, 0), cB, voffB); PG8_STAGE(PG8_SA(0, 0), cA, voffA); PG8_STAGE(PG8_SB(0, 1), cB + hstep, voffB); PG8_STAGE(PG8_SA(0, 1), cA + hstep, voffA);
        if (wr == 1) PG8_BAR;
        PG8_WAIT_V(4); PG8_BAR;
        PG8_STAGE(PG8_SB(1, 0), cB + kstep, voffB); PG8_STAGE(PG8_SA(1, 0), cA + kstep, voffA); PG8_STAGE(PG8_SB(1, 1), cB + hstep + kstep, voffB);
        PG8_WAIT_V(6); PG8_BAR;
    }
    for (;;) {
        const bool has_next = S.next(ui + 1, nxt);
        const char* nA = has_next ? (const char*)g.A + (size_t)nxt.pm * tstep : cA; const char* nB = has_next ? (const char*)g.Bt + (size_t)nxt.pn * tstep : cB;
        for (int t = 0; t < nt; t += 2) {
            const bool last = (t == nt - 2);
            const char* a1 = cA + (size_t)(t + 1) * kstep;
            const char* a2 = last ? nA : cA + (size_t)(t + 2) * kstep; const char* b2 = last ? nB : cB + (size_t)(t + 2) * kstep;
            const char* a3 = a2 + kstep; const char* b3 = b2 + kstep;
            if (last && has_next) S.a_ready(nxt);
            if constexpr (SP2) {
            PG8_LDB(B0, 0, 0); PG8_LDB(B1, 0, 1); PG8_SCHED; PG8_LDA(At, 0, 0); PG8_STAGE(PG8_SA(1, 1), a1 + hstep, voffA);
            PG8_WAIT_V(8); PG8_WAIT_L(0); PG8_BAR; PG8_MMA(0, 0, At, B0); PG8_MMA(0, 1, At, B1); PG8_BAR; PG8_SCHED;
            PG8_LDA(At, 0, 1); PG8_STAGE(PG8_SB(0, 0), b2, voffB); PG8_STAGE(PG8_SB(0, 1), b2 + hstep, voffB); PG8_STAGE(PG8_SA(0, 0), a2, voffA);
            PG8_WAIT_V(8); PG8_WAIT_L(0); PG8_BAR; PG8_MMA(1, 0, At, B0); PG8_MMA(1, 1, At, B1); PG8_BAR; PG8_SCHED;
            PG8_LDB(B0, 1, 0); PG8_LDB(B1, 1, 1); PG8_SCHED; PG8_LDA(At, 1, 0); PG8_STAGE(PG8_SA(0, 1), a2 + hstep, voffA);
            PG8_WAIT_V(8); PG8_WAIT_L(0); PG8_BAR; PG8_MMA(0, 0, At, B0); PG8_MMA(0, 1, At, B1); PG8_BAR; PG8_SCHED;
            PG8_LDA(At, 1, 1); PG8_STAGE(PG8_SB(1, 0), b3, voffB); PG8_STAGE(PG8_SB(1, 1), b3 + hstep, voffB); PG8_STAGE(PG8_SA(1, 0), a3, voffA);
            PG8_WAIT_V(8); PG8_WAIT_L(0); PG8_BAR; PG8_MMA(1, 0, At, B0); PG8_MMA(1, 1, At, B1); PG8_BAR; PG8_SCHED;
            } else {
            PG8_LDB(B0, 0, 0); PG8_SCHED; PG8_LDA(At, 0, 0); PG8_STAGE(PG8_SA(1, 1), a1 + hstep, voffA);
            PG8_WAIT_L(8); PG8_BAR; PG8_WAIT_L(0); PG8_MMA(0, 0, At, B0); PG8_BAR; PG8_SCHED;
            PG8_LDB(B1, 0, 1); PG8_STAGE(PG8_SB(0, 0), b2, voffB);
            PG8_BAR; PG8_WAIT_L(0); PG8_MMA(0, 1, At, B1); PG8_BAR;
            PG8_LDA(At, 0, 1); PG8_STAGE(PG8_SA(0, 0), a2, voffA);
            PG8_BAR; PG8_WAIT_L(0); PG8_MMA(1, 0, At, B0); PG8_BAR; PG8_SCHED;
            PG8_STAGE(PG8_SB(0, 1), b2 + hstep, voffB);
            PG8_WAIT_V(6); PG8_BAR; PG8_MMA(1, 1, At, B1); PG8_BAR;
            PG8_LDB(B0, 1, 0); PG8_SCHED; PG8_LDA(At, 1, 0); PG8_STAGE(PG8_SA(0, 1), a2 + hstep, voffA);
            PG8_WAIT_L(8); PG8_BAR; PG8_WAIT_L(0); PG8_MMA(0, 0, At, B0); PG8_BAR; PG8_SCHED;
            PG8_LDB(B1, 1, 1); PG8_STAGE(PG8_SB(1, 0), b3, voffB);
            PG8_BAR; PG8_WAIT_L(0); PG8_MMA(0, 1, At, B1); PG8_BAR;
            PG8_LDA(At, 1, 1); PG8_STAGE(PG8_SA(1, 0), a3, voffA);
            PG8_BAR; PG8_WAIT_L(0); PG8_MMA(1, 0, At, B0); PG8_BAR; PG8_SCHED;
            PG8_STAGE(PG8_SB(1, 1), b3 + hstep, voffB);
            PG8_WAIT_V(6); PG8_BAR; PG8_MMA(1, 1, At, B1); PG8_BAR;
            }
        }
        if constexpr (ALIGN_EPI) { if (wr == 0) PG8_BAR; }
        if constexpr (!Epi::AFTER_DRAIN) { E(acc, cur, wr, wc, fr, fq); S.done(cur); }
        if (!has_next) break;
#pragma unroll
        for (int a = 0; a < 2; ++a)
#pragma unroll
            for (int b = 0; b < 2; ++b)
#pragma unroll
                for (int m = 0; m < 4; ++m)
#pragma unroll
                    for (int n = 0; n < 2; ++n) acc[a][b][m][n] = (f32x4){0.f, 0.f, 0.f, 0.f};
        cur = nxt; cA = nA; cB = nB; ++ui;
        if constexpr (ALIGN_EPI) { if (wr == 1) PG8_BAR; }
    }
    PG8_WAIT_V(0);
    if constexpr (!ALIGN_EPI) { if (wr == 0) PG8_BAR; }
    PG8_BAR;
    if constexpr (Epi::AFTER_DRAIN) { E.fused(acc, cur, wr, wc, fr, fq, lds, wid, lane); S.done(cur); }
#undef PG8_SA
#undef PG8_SB
#undef PG8_STAGE
#undef PG8_LDA
#undef PG8_LDB
#undef PG8_MMA
#undef PG8_WAIT_V
#undef PG8_WAIT_L
#undef PG8_BAR
#undef PG8_SCHED
}
}

namespace att {
using pg8::bf16_t; using pg8::bf16x8; using pg8::u32x4;
typedef float f32x16 __attribute__((ext_vector_type(16)));
typedef short s16x4 __attribute__((ext_vector_type(4)));
typedef float f32x2_t __attribute__((ext_vector_type(2))); typedef __bf16 bf16x2_t __attribute__((ext_vector_type(2)));
#define ALAS __attribute__((address_space(3)))
typedef ALAS const char* lds_cptr;
constexpr int SEQ = 8192, PITCH = 3072;
constexpr int KVSLOT = 24576;
constexpr int L_WS = 2 * KVSLOT, L_OST = L_WS + 2048, L_TAB = L_OST + 8 * 4096, L_FLAG = L_TAB + 1056, L_END = L_FLAG + 64;
constexpr float SB_THR = 152.f;
__device__ __forceinline__ int crow(int r, int hi) { return (r & 3) + 8 * (r >> 2) + 4 * hi; }
__device__ __forceinline__ void glds16(const void* gsrc, unsigned lds_dst) { unsigned keep;
    asm volatile("s_mov_b32 %0, m0\n\ts_mov_b32 m0, %2\n\ts_nop 0\n\tglobal_load_lds_dwordx4 %1, off\n\ts_mov_b32 m0, %0" : "=&s"(keep) : "v"(gsrc), "s"(lds_dst) : "memory"); }
__device__ __forceinline__ unsigned cvtpk(float lo, float hi) { f32x2_t v = {lo, hi}; bf16x2_t b = __builtin_convertvector(v, bf16x2_t); return __builtin_bit_cast(unsigned, b); }
__device__ __forceinline__ unsigned short f2bf(float f) { unsigned u = __builtin_bit_cast(unsigned, f); return (unsigned short)((u + 0x7fffu + ((u >> 16) & 1u)) >> 16); }
#define MFMA32(a, b, c) __builtin_amdgcn_mfma_f32_32x32x16_bf16((a), (b), (c), 0, 0, 0)

__device__ __forceinline__ void qkt(f32x16& p0, f32x16& p1, lds_cptr kb, const bf16x8* qr, const f32x16& cin) {
#pragma unroll
    for (int d0 = 0; d0 < 4; ++d0) {
        const bf16x8 b0 = *(const ALAS bf16x8*)(kb + d0 * 2048);
        const bf16x8 b1 = *(const ALAS bf16x8*)(kb + d0 * 2048 + 512);
        if (d0 == 0) { p0 = MFMA32(b0, qr[0], cin); p1 = MFMA32(b1, qr[0], cin); }
        else { p0 = MFMA32(b0, qr[d0], p0); p1 = MFMA32(b1, qr[d0], p1); }
    }
}
template <int ND> __device__ __forceinline__ void pv(f32x16* o, int vb, bf16x8 pa0, bf16x8 pa1, bf16x8 pa2, bf16x8 pa3) {
#pragma unroll
    for (int d0 = 0; d0 < ND; ++d0) { s16x4 lo[4], hi[4];
#pragma unroll
        for (int ks = 0; ks < 4; ++ks) {
            asm volatile("ds_read_b64_tr_b16 %0,%1 offset:%c2" : "=&v"(lo[ks]) : "v"(vb), "i"(d0 * 4096 + ks * 1024) : "memory");
            asm volatile("ds_read_b64_tr_b16 %0,%1 offset:%c2" : "=&v"(hi[ks]) : "v"(vb), "i"(d0 * 4096 + ks * 1024 + 512) : "memory"); }
        asm volatile("s_waitcnt lgkmcnt(0)" ::: "memory"); __builtin_amdgcn_sched_barrier(0);
#define ATT_PK(k) (bf16x8){lo[k][0], lo[k][1], lo[k][2], lo[k][3], hi[k][0], hi[k][1], hi[k][2], hi[k][3]}
        o[d0] = MFMA32(pa0, ATT_PK(0), o[d0]);
        o[d0] = MFMA32(pa1, ATT_PK(1), o[d0]);
        o[d0] = MFMA32(pa2, ATT_PK(2), o[d0]);
        o[d0] = MFMA32(pa3, ATT_PK(3), o[d0]);
#undef ATT_PK
    }
}

template <int MODE, int VD>
__device__ __forceinline__ void attn_unit(ALAS char* shm, const bf16_t* Qb, const bf16_t* Kb, const bf16_t* Vb, bf16_t* Ob, int opitch, int q0, float mref2, const float* tab) {
    constexpr int ND = VD / 32;
    const int tid = threadIdx.x, lane = tid & 63, r32 = lane & 31, hi = lane >> 5; const int wid = __builtin_amdgcn_readfirstlane(tid >> 6);
    const unsigned lds0 = (unsigned)(uintptr_t)shm;
    ALAS float* wsf = (ALAS float*)(shm + L_WS) + wid * 64;
    ALAS float* tabL = (ALAS float*)(shm + L_TAB);
    ALAS unsigned* flg = (ALAS unsigned*)(shm + L_FLAG);
    if (MODE == 1) { for (int i = tid; i < 257; i += 512) tabL[i] = tab[i] * pg8::LOG2E; }
    const bf16_t* Qw = Qb + (size_t)(q0 + wid * 32) * PITCH;
    bf16x8 qr[4];
#pragma unroll
    for (int d0 = 0; d0 < 4; ++d0) qr[d0] = *(const bf16x8*)(Qw + (size_t)r32 * PITCH + d0 * 16 + hi * 8);
    int t_first, n_t, t_step;
    if (MODE == 0) { t_first = 0; n_t = q0 / 64 + 4; t_step = 1; }
    else if (MODE == 1) { const int c0 = q0 / 64; t_first = c0 - 8 > 0 ? c0 - 8 : 0; n_t = c0 + 4 - t_first; t_step = 1; }
    else { t_first = q0 / 64 + 3; n_t = q0 / 64 + 4; t_step = -1; }
    const bf16_t* ksrc = Kb + (size_t)lane * PITCH + wid * 8;
    const bf16_t* vsrc = Vb + (size_t)(16 * (wid & 3) + (lane >> 2)) * PITCH + (wid >> 2) * 32 + (lane & 3) * 8;
#define ATT_DMA(t, slot) do { const size_t to_ = (size_t)(t) * 64 * PITCH; const unsigned sb_ = lds0 + (unsigned)(slot) * KVSLOT; \
        glds16(ksrc + to_, (unsigned)__builtin_amdgcn_readfirstlane(sb_ + wid * 1024)); \
        glds16(vsrc + to_, (unsigned)__builtin_amdgcn_readfirstlane(sb_ + 8192 + wid * 1024)); \
        if (VD == 128) glds16(vsrc + to_ + 64, (unsigned)__builtin_amdgcn_readfirstlane(sb_ + 8192 + (wid + 8) * 1024)); } while (0)
    f32x16 o[ND];
#pragma unroll
    for (int d = 0; d < ND; ++d) o[d] = f32x16{};
    f32x16 cin;
#pragma unroll
    for (int r = 0; r < 16; ++r) cin[r] = (MODE == 2) ? 0.f : -mref2;
    float l_reg = 0.f, A = 0.f; bool wdone = false;
    const int wrow0 = q0 + wid * 32, qrow = wrow0 + r32;
    const int vb0 = (int)lds0 + 8192 + ((lane >> 4) & 1) * 32 + (lane & 3) * 8 + (4 * hi + ((lane & 15) >> 2)) * 64;
    ATT_DMA(t_first, 0);
    for (int i = 0; i < n_t; ++i) {
        const int t = t_first + i * t_step, slot = i & 1;
        asm volatile("s_waitcnt vmcnt(0) lgkmcnt(0)\n\ts_barrier" ::: "memory");
        if (MODE == 2 && i > 0) { const int par = ((i - 1) & 1) * 8; unsigned all = 1u;
#pragma unroll
            for (int w = 0; w < 8; ++w) all &= flg[par + w];
            if (__builtin_amdgcn_readfirstlane(all)) break; }
        if (i + 1 < n_t) ATT_DMA(t + t_step, slot ^ 1);
        bool active;
        if (MODE == 0) active = (64 * t <= wrow0);
        else if (MODE == 1) { const int cw = wrow0 / 64; active = (t >= cw - 8) && (t <= cw); }
        else active = !wdone && (64 * t < wrow0 + 31);
        if (active) {
            const lds_cptr kb = (lds_cptr)shm + slot * KVSLOT + hi * 1024 + r32 * 16;
            f32x16 p0, p1; qkt(p0, p1, kb, qr, cin);
            if (MODE == 0) {
#pragma unroll
                for (int r = 0; r < 16; ++r) { p0[r] = __builtin_amdgcn_exp2f(p0[r]); p1[r] = __builtin_amdgcn_exp2f(p1[r]); }
            } else if (MODE == 1) {
                const int cw = wrow0 / 64;
                if (t <= cw - 3) { const float cb = tabL[256];
#pragma unroll
                    for (int r = 0; r < 16; ++r) { p0[r] = __builtin_amdgcn_exp2f(p0[r] + cb); p1[r] = __builtin_amdgcn_exp2f(p1[r] + cb); }
                } else { const int dq = qrow - 64 * t - 4 * hi;
#pragma unroll
                    for (int r = 0; r < 16; ++r) { int d0 = dq - ((r & 3) + 8 * (r >> 2)), d1 = d0 - 32;
                        d0 = d0 < -128 ? -128 : (d0 > 128 ? 128 : d0); d1 = d1 < -128 ? -128 : (d1 > 128 ? 128 : d1);
                        p0[r] = __builtin_amdgcn_exp2f(p0[r] + tabL[d0 + 128]); p1[r] = __builtin_amdgcn_exp2f(p1[r] + tabL[d1 + 128]); }
                }
            } else {
                const bool needmask = (64 * t + 63 >= wrow0);
                const int kq = qrow - 64 * t - 4 * hi;
                float g[8];
#pragma unroll
                for (int k = 0; k < 8; ++k) g[k] = 0.f;
                f32x16 s0, s1;
#pragma unroll
                for (int r = 0; r < 16; ++r) { const int kv = (r & 3) + 8 * (r >> 2);
                    { const float y = p0[r], a = __builtin_fabsf(y); float sp = __builtin_fmaxf(y, 0.f) + __builtin_amdgcn_logf(1.f + __builtin_amdgcn_exp2f(-a)); if (needmask && !(kv < kq)) sp = 0.f; s0[r] = sp; g[r >> 2] += sp; }
                    { const float y = p1[r], a = __builtin_fabsf(y); float sp = __builtin_fmaxf(y, 0.f) + __builtin_amdgcn_logf(1.f + __builtin_amdgcn_exp2f(-a)); if (needmask && !(kv + 32 < kq)) sp = 0.f; s1[r] = sp; g[4 + (r >> 2)] += sp; } }
                float pg[8];
#pragma unroll
                for (int k = 0; k < 8; ++k) pg[k] = __shfl_xor(g[k], 32);
                float base[8]; float own = 0.f, par = 0.f;
#pragma unroll
                for (int k = 7; k >= 0; --k) { const float par_incl = par + pg[k]; base[k] = A + own + (hi == 0 ? par_incl : par); own += g[k]; par = par_incl; }
                A += own + par;
#pragma unroll
                for (int k = 0; k < 4; ++k) {
                    { float c = base[k]; c += s0[4 * k + 3]; const float w3 = __builtin_amdgcn_exp2f(p0[4 * k + 3] - c); c += s0[4 * k + 2]; const float w2 = __builtin_amdgcn_exp2f(p0[4 * k + 2] - c);
                      c += s0[4 * k + 1]; const float w1 = __builtin_amdgcn_exp2f(p0[4 * k + 1] - c); c += s0[4 * k]; const float w0 = __builtin_amdgcn_exp2f(p0[4 * k] - c);
                      p0[4 * k] = w0; p0[4 * k + 1] = w1; p0[4 * k + 2] = w2; p0[4 * k + 3] = w3; }
                    { float c = base[4 + k]; c += s1[4 * k + 3]; const float w3 = __builtin_amdgcn_exp2f(p1[4 * k + 3] - c); c += s1[4 * k + 2]; const float w2 = __builtin_amdgcn_exp2f(p1[4 * k + 2] - c);
                      c += s1[4 * k + 1]; const float w1 = __builtin_amdgcn_exp2f(p1[4 * k + 1] - c); c += s1[4 * k]; const float w0 = __builtin_amdgcn_exp2f(p1[4 * k] - c);
                      p1[4 * k] = w0; p1[4 * k + 1] = w1; p1[4 * k + 2] = w2; p1[4 * k + 3] = w3; }
                }
                if (needmask) {
#pragma unroll
                    for (int r = 0; r < 16; ++r) { const int kv = (r & 3) + 8 * (r >> 2); if (!(kv < kq)) p0[r] = 0.f; if (!(kv + 32 < kq)) p1[r] = 0.f; }
                }
                wdone = __all(A >= SB_THR);
            }
            if (MODE != 2) { float s = 0.f;
#pragma unroll
                for (int r = 0; r < 16; ++r) s += p0[r] + p1[r];
                l_reg += s; }
            u32x4 pw0, pw1, pw2, pw3;
            pw0 = (u32x4){cvtpk(p0[0], p0[1]), cvtpk(p0[2], p0[3]), cvtpk(p0[4], p0[5]), cvtpk(p0[6], p0[7])};
            pw1 = (u32x4){cvtpk(p0[8], p0[9]), cvtpk(p0[10], p0[11]), cvtpk(p0[12], p0[13]), cvtpk(p0[14], p0[15])};
            pw2 = (u32x4){cvtpk(p1[0], p1[1]), cvtpk(p1[2], p1[3]), cvtpk(p1[4], p1[5]), cvtpk(p1[6], p1[7])};
            pw3 = (u32x4){cvtpk(p1[8], p1[9]), cvtpk(p1[10], p1[11]), cvtpk(p1[12], p1[13]), cvtpk(p1[14], p1[15])};
            pv<ND>(o, vb0 + slot * KVSLOT, __builtin_bit_cast(bf16x8, pw0), __builtin_bit_cast(bf16x8, pw1), __builtin_bit_cast(bf16x8, pw2), __builtin_bit_cast(bf16x8, pw3));
        }
        if (MODE == 2) { if (lane == 0) flg[(i & 1) * 8 + wid] = wdone ? 1u : 0u; }
    }
#undef ATT_DMA
    float rl[16];
    if (MODE != 2) {
        l_reg += __shfl_xor(l_reg, 32);
        if (hi == 0) wsf[32 + r32] = l_reg;
        asm volatile("s_waitcnt lgkmcnt(0)" ::: "memory");
#pragma unroll
        for (int r = 0; r < 16; ++r) rl[r] = __builtin_amdgcn_rcpf(wsf[32 + crow(r, hi)]);
    } else {
#pragma unroll
        for (int r = 0; r < 16; ++r) rl[r] = 1.f;
    }
    bf16_t* Ow = Ob + (size_t)(q0 + wid * 32) * opitch;
    ALAS bf16_t* stg = (ALAS bf16_t*)(shm + L_OST) + wid * 2048;
#pragma unroll
    for (int half = 0; half < ND / 2; ++half) {
#pragma unroll
        for (int r = 0; r < 16; ++r) { const int orow = crow(r, hi);
#pragma unroll
            for (int d0 = 0; d0 < 2; ++d0) stg[orow * 64 + d0 * 32 + r32] = f2bf(o[half * 2 + d0][r] * rl[r]); }
        asm volatile("s_waitcnt lgkmcnt(0)" ::: "memory");
#pragma unroll
        for (int i = 0; i < 4; ++i) { const int row = i * 8 + (lane >> 3), ch = lane & 7; const u32x4 v = *(const ALAS u32x4*)(stg + row * 64 + ch * 8); *(u32x4*)(Ow + (size_t)row * opitch + half * 64 + ch * 8) = v; }
        asm volatile("s_waitcnt lgkmcnt(0)" ::: "memory");
    }
    asm volatile("s_waitcnt vmcnt(0) lgkmcnt(0)\n\ts_barrier" ::: "memory");
}
}

constexpr int NWAVES = 8, NTHR = NWAVES * 64;
constexpr int BATCH = 2, SEQ = 8192, T = BATCH * SEQ, D = 1024;
constexpr int NPROJ = 3072, FFD = 2816, FFE = 3584, NEXP = 8;
constexpr size_t MiB = 1u << 20;
constexpr size_t CTL_ZERO_BYTES = 1 * MiB;
constexpr int CW_TMO = 0, CW_BAR = 4096;
constexpr int CW_HIST = 16384;
constexpr int CW_MOE = 24576;
constexpr size_t WS_SS0 = 1 * MiB, WS_SS3 = WS_SS0 + 65536, WS_ROPE = WS_SS3 + 65536  , WS_TOKSEL = WS_ROPE + MiB  ,
                 WS_TOKGATE = WS_TOKSEL + 65536  , WS_ROWTOK = WS_TOKGATE + 131072  , WS_ROWGATE = WS_ROWTOK + 147456  ;
static_assert(WS_ROWGATE + 147456 <= 4 * MiB, "small arrays");
constexpr size_t WS_XB = 4 * MiB;
constexpr size_t WS_AO = 36 * MiB;
constexpr size_t WS_ACT0 = 68 * MiB;
constexpr size_t WS_XF = 164 * MiB;
constexpr size_t WS_WIN = 228 * MiB, WS_WO0 = 234 * MiB, WS_WGU0 = 236 * MiB, WS_WD0 = 247 * MiB, WS_WQKV = 253 * MiB, WS_WO1 = 259 * MiB;
constexpr size_t WS_WEGU = 264 * MiB;
constexpr size_t WS_WED = 376 * MiB;
constexpr size_t WS_SS1 = 432 * MiB, WS_SS2 = 433 * MiB;
constexpr size_t WS_END = 434 * MiB;
constexpr size_t WS_SORTA = 36 * MiB;
constexpr size_t WS_ACTE = 108 * MiB;
static_assert(WS_SORTA + (size_t)36864 * 2048 <= WS_ACTE && WS_ACTE + (size_t)18432 * 7168 <= WS_WO0 && WS_WD0 + (size_t)1024 * 2816 * 2 <= WS_WQKV && WS_WO1 + 2 * MiB <= WS_WEGU, "ws map");
constexpr int RING_BYTES = 131072, MISC_OFF = RING_BYTES + 320, LDS_BYTES = 147456;
static_assert(att::L_END <= RING_BYTES, "attention LDS");

#define GAS __attribute__((address_space(1)))
#define LAS __attribute__((address_space(3)))
typedef unsigned short bf16;
typedef unsigned v4u __attribute__((ext_vector_type(4)));
typedef float f32x4 __attribute__((ext_vector_type(4)));
typedef GAS unsigned gu32;
#define RLX_AGENT __ATOMIC_RELAXED, __HIP_MEMORY_SCOPE_AGENT
#define LDS_WAIT() asm volatile("s_waitcnt lgkmcnt(0)" ::: "memory")
#define VM_WAIT() asm volatile("s_waitcnt vmcnt(0)" ::: "memory")
__device__ __forceinline__ unsigned f2bf(float f) { unsigned u = __builtin_bit_cast(unsigned, f); return (u + 0x7fffu + ((u >> 16) & 1u)) >> 16; }
__device__ __forceinline__ unsigned pk2(float lo, float hi) { return f2bf(lo) | (f2bf(hi) << 16); }
__device__ __forceinline__ float bf2f(unsigned short h) { return __builtin_bit_cast(float, (unsigned)h << 16); }
#define XB_TMO      128
#define XB_XCNT(j)  (256  + 64 * (j))
#define XB_XSUB(j)  (1280 + 64 * (j))
#define XB_XGEN(j)  (2304 + 64 * (j))
#define XB_TOP      3328
#define XB_TOPGEN   3392
#define XCD_BAR_WORDS 3456
#define XB_SPIN_CAP (1u << 18)

__device__ __forceinline__ unsigned xb_ld(unsigned* p)              { return __hip_atomic_load(p, __ATOMIC_RELAXED, __HIP_MEMORY_SCOPE_AGENT); }
__device__ __forceinline__ unsigned xb_add(unsigned* p, unsigned v) { return __hip_atomic_fetch_add(p, v, __ATOMIC_RELAXED, __HIP_MEMORY_SCOPE_AGENT); }
__device__ __forceinline__ unsigned xb_xcc_id() { return (unsigned)__builtin_amdgcn_s_getreg((3 << 11) | 20) & 0xFu; }
#define XB_SPIN(cond, bar) do { unsigned _sp = 0; while (cond) { __builtin_amdgcn_s_sleep(1); \
    if ((++_sp & 255u) == 0u) { if (xb_ld(&(bar)[XB_TMO])) break; if (_sp > XB_SPIN_CAP) { atomicAdd(&(bar)[XB_TMO], 1u); break; } } } } while (0)

struct XcdBarrier {
    unsigned* bar; unsigned x;
    volatile LAS unsigned* st;
};

__device__ __forceinline__ XcdBarrier xcd_barrier_post(unsigned* bar, volatile LAS unsigned* st) {
    XcdBarrier b; b.bar = bar; b.x = xb_xcc_id(); b.st = st;
    if (threadIdx.x == 0) (void)xb_add(&bar[XB_XCNT(b.x)], 1u);
    return b;
}
__device__ __forceinline__ void xcd_barrier_complete(unsigned* bar, unsigned x, unsigned& nloc, unsigned& nx) {
    const unsigned G = gridDim.x * gridDim.y * gridDim.z;
    unsigned sum, cnt, mine, sp = 0u;
    for (;;) {
        sum = 0u; cnt = 0u; mine = 0u;
#pragma unroll
        for (unsigned j = 0; j < 16; ++j) { const unsigned c = xb_ld(&bar[XB_XCNT(j)]); sum += c; cnt += (c > 0u) ? 1u : 0u; mine = (j == x) ? c : mine; }
        if (sum == G) break;
        __builtin_amdgcn_s_sleep(1);
        if ((++sp & 255u) == 0u) { if (xb_ld(&bar[XB_TMO])) break; if (sp > XB_SPIN_CAP) { atomicAdd(&bar[XB_TMO], 1u); break; } }
    }
    nloc = mine > 0u ? mine : 1u; nx = cnt > 0u ? cnt : 1u;
}

__device__ __forceinline__ void xcd_barrier(const XcdBarrier& b) {
    asm volatile("s_waitcnt vmcnt(0)" ::: "memory");
    __syncthreads();
    if (threadIdx.x == 0) {
        unsigned* bar = b.bar;
        __builtin_amdgcn_s_waitcnt(0);
        unsigned nloc = b.st[0], nx = b.st[1];
        if (nloc == 0u) { xcd_barrier_complete(bar, b.x, nloc, nx); b.st[0] = nloc; b.st[1] = nx; }
        const unsigned old = xb_add(&bar[XB_XSUB(b.x)], 1u);
        const unsigned gen = old / nloc;
        if (old + 1u == (gen + 1u) * nloc) {
            __builtin_amdgcn_fence(__ATOMIC_RELEASE, "agent");
            asm volatile("s_waitcnt vmcnt(0)" ::: "memory");
            const unsigned og = xb_add(&bar[XB_TOP], 1u);
            const unsigned tg = og / nx;
            if (og + 1u == (tg + 1u) * nx) xb_add(&bar[XB_TOPGEN], 1u);
            else XB_SPIN(xb_ld(&bar[XB_TOPGEN]) == tg, bar);
            __builtin_amdgcn_fence(__ATOMIC_ACQUIRE, "agent");
            xb_add(&bar[XB_XGEN(b.x)], 1u);
            asm volatile("s_waitcnt vmcnt(0)" ::: "memory");
        } else {
            XB_SPIN(xb_ld(&bar[XB_XGEN(b.x)]) == gen, bar);
            __builtin_amdgcn_fence(__ATOMIC_ACQUIRE, "agent");
            asm volatile("s_waitcnt vmcnt(0)" ::: "memory");
        }
    }
    __syncthreads();
}

__device__ __forceinline__ float wave_sum(float v) {
#pragma unroll
    for (int o = 1; o < 64; o <<= 1) v += __shfl_xor(v, o);
    return v;
}
__device__ __forceinline__ float wave_max(float v) {
#pragma unroll
    for (int o = 1; o < 64; o <<= 1) v = fmaxf(v, __shfl_xor(v, o));
    return v;
}
__device__ __forceinline__ int dest_block(int blk, int map) {
    if (map == 1) { const int s = blk & 7; return (blk & ~7) + 4 * (s & 1) + (s >> 1); }
    if (map == 2) return (blk >> 2) * 8 + (blk & 3);
    if (map == 3) return (blk >> 2) * 8 + 4 + (blk & 3);
    return blk;
}
__device__ __forceinline__ void tr_tile(const float* W, int K, int N, bf16* WT, int map, const float* gain, LAS unsigned* scr, int item, int lane) {
    const int nblk = N / 64, kb = item / nblk, nb = item % nblk, k0 = 64 * kb, n0 = 64 * nb;
    const int c = lane & 15, ip = lane >> 4;
#pragma unroll
    for (int it = 0; it < 8; ++it) { const int kp = it * 4 + ip, k = k0 + 2 * kp;
        f32x4 a = *(const GAS f32x4*)(W + (size_t)k * N + n0 + 4 * c), b = *(const GAS f32x4*)(W + (size_t)(k + 1) * N + n0 + 4 * c);
        if (gain) { a = a * gain[k]; b = b * gain[k + 1]; }
#pragma unroll
        for (int j = 0; j < 4; ++j) scr[(4 * c + j) * 33 + kp] = pk2(a[j], b[j]); }
    LDS_WAIT(); asm volatile("" ::: "memory");
#pragma unroll
    for (int it = 0; it < 8; ++it) { const int n = it * 8 + (lane >> 3), q = lane & 7;
        v4u o; o.x = scr[n * 33 + 4 * q]; o.y = scr[n * 33 + 4 * q + 1]; o.z = scr[n * 33 + 4 * q + 2]; o.w = scr[n * 33 + 4 * q + 3];
        const int drow = dest_block((n0 + n) >> 5, map) * 32 + (n & 31);
        *(GAS v4u*)(WT + (size_t)drow * K + k0 + 8 * q) = o; }
    LDS_WAIT(); asm volatile("" ::: "memory");
}

struct KArgs { const void* in[27]; float* out; unsigned char* ws; int ph_lo, ph_hi; };

__global__ void __launch_bounds__(NTHR, 2) fwd_kernel(KArgs args) {
    extern __shared__ __attribute__((aligned(16))) unsigned char lds_raw[];
    LAS unsigned char* lds = (LAS unsigned char*)lds_raw;
    volatile LAS unsigned* MISC = (volatile LAS unsigned*)(lds + MISC_OFF);
    const int tid = threadIdx.x, lane = tid & 63, wave = __builtin_amdgcn_readfirstlane(tid >> 6);
    const int G = gridDim.x; const int bx = blockIdx.x; const int vcu = (G % 8 == 0) ? (bx % 8) * (G / 8) + bx / 8 : bx;
    unsigned char* ws = args.ws;
    unsigned* ctl = (unsigned*)ws;
    for (int u = tid; u < (LDS_BYTES - RING_BYTES) / 4; u += NTHR) ((LAS unsigned*)(lds + RING_BYTES))[u] = 0u;
    __syncthreads();
    XcdBarrier bar = xcd_barrier_post(ctl + CW_BAR, MISC + 8);
    const int lo = args.ph_lo, hi_ph = args.ph_hi;
#define IN(k) (lo <= (k) && (k) < hi_ph)
#define SEAM(k) do { if (IN(k) && IN((k) + 1)) xcd_barrier(bar); } while (0)
    const float* x_in = (const float*)args.in[0]; const int* positions = (const int*)args.in[1];
    const float* ev_attn_norm = (const float*)args.in[2]; const float* ev_w_in = (const float*)args.in[3];
    const float* ev_q_norm = (const float*)args.in[4]; const float* ev_k_norm = (const float*)args.in[5];
    const float* ev_lq1 = (const float*)args.in[6]; const float* ev_lk1 = (const float*)args.in[7]; const float* ev_lq2 = (const float*)args.in[8]; const float* ev_lk2 = (const float*)args.in[9];
    const float* ev_subln = (const float*)args.in[10]; const float* ev_w_out = (const float*)args.in[11]; const float* ev_ffn_norm = (const float*)args.in[12];
    const float* ev_w_gate = (const float*)args.in[13]; const float* ev_w_up = (const float*)args.in[14]; const float* ev_w_down = (const float*)args.in[15];
    const float* od_attn_norm = (const float*)args.in[16]; const float* od_w_qkv = (const float*)args.in[17];
    const float* od_q_norm = (const float*)args.in[18]; const float* od_k_norm = (const float*)args.in[19]; const float* od_rel_bias = (const float*)args.in[20];
    const float* od_w_out = (const float*)args.in[21]; const float* od_ffn_norm = (const float*)args.in[22]; const float* od_router = (const float*)args.in[23];
    const float* od_we_gate = (const float*)args.in[24]; const float* od_we_up = (const float*)args.in[25]; const float* od_we_down = (const float*)args.in[26];
    float* out = args.out;
    float* ss0 = (float*)(ws + WS_SS0); float* ss1 = (float*)(ws + WS_SS1); float* ss2 = (float*)(ws + WS_SS2); float* ss3 = (float*)(ws + WS_SS3);
    float* rope = (float*)(ws + WS_ROPE); unsigned* toksel = (unsigned*)(ws + WS_TOKSEL); float* tokgate = (float*)(ws + WS_TOKGATE);
    int* rowtok = (int*)(ws + WS_ROWTOK); float* rowgate = (float*)(ws + WS_ROWGATE);
    bf16* XB = (bf16*)(ws + WS_XB); bf16* AO = (bf16*)(ws + WS_AO); bf16* ACT0 = (bf16*)(ws + WS_ACT0); float* XF = (float*)(ws + WS_XF); bf16* OD = (bf16*)(ws + WS_XF);
    bf16* Win_t = (bf16*)(ws + WS_WIN); bf16* Wo0_t = (bf16*)(ws + WS_WO0); bf16* Wgu0_t = (bf16*)(ws + WS_WGU0); bf16* Wd0_t = (bf16*)(ws + WS_WD0);
    bf16* Wqkv_t = (bf16*)(ws + WS_WQKV); bf16* Wo1_t = (bf16*)(ws + WS_WO1); bf16* WEgu_t = (bf16*)(ws + WS_WEGU); bf16* WEd_t = (bf16*)(ws + WS_WED);
    bf16* SORTA = (bf16*)(ws + WS_SORTA); bf16* ACTE = (bf16*)(ws + WS_ACTE);
    const int gw = vcu * NWAVES + wave, NGW = G * NWAVES;

    if (IN(0)) {
        LAS unsigned* scr = (LAS unsigned*)(lds + wave * 8704);
        constexpr int I_IN = 16 * 48, I_O = 16 * 16, I_G = 16 * 44, I_D = 44 * 16, I_EG = 16 * 56, I_ED = 56 * 16;
        constexpr int NSMALL = I_IN + I_O + 2 * I_G + I_D + I_IN + I_O, NITEMS = NSMALL + 24 * I_EG;
        for (int it = gw; it < NITEMS; it += NGW) {
            int r = it;
            if (r < I_IN) { tr_tile(ev_w_in, D, NPROJ, Win_t, 1, ev_attn_norm, scr, r, lane); continue; } r -= I_IN;
            if (r < I_O) { tr_tile(ev_w_out, D, D, Wo0_t, 0, nullptr, scr, r, lane); continue; } r -= I_O;
            if (r < I_G) { tr_tile(ev_w_gate, D, FFD, Wgu0_t, 2, ev_ffn_norm, scr, r, lane); continue; } r -= I_G;
            if (r < I_G) { tr_tile(ev_w_up, D, FFD, Wgu0_t, 3, ev_ffn_norm, scr, r, lane); continue; } r -= I_G;
            if (r < I_D) { tr_tile(ev_w_down, FFD, D, Wd0_t, 0, nullptr, scr, r, lane); continue; } r -= I_D;
            if (r < I_IN) { tr_tile(od_w_qkv, D, NPROJ, Wqkv_t, 1, od_attn_norm, scr, r, lane); continue; } r -= I_IN;
            if (r < I_O) { tr_tile(od_w_out, D, D, Wo1_t, 0, nullptr, scr, r, lane); continue; } r -= I_O;
            const int which = r / (8 * I_EG), rr = r % (8 * I_EG), e = rr / I_EG, item = rr % I_EG;
            if (which == 0) tr_tile(od_we_gate + (size_t)e * D * FFE, D, FFE, WEgu_t + (size_t)e * 2 * FFE * D, 2, od_ffn_norm, scr, item, lane);
            else if (which == 1) tr_tile(od_we_up + (size_t)e * D * FFE, D, FFE, WEgu_t + (size_t)e * 2 * FFE * D, 3, od_ffn_norm, scr, item, lane);
            else tr_tile(od_we_down + (size_t)e * FFE * D, FFE, D, WEd_t + (size_t)e * D * FFE, 0, nullptr, scr, item, lane);
        }
        for (int m = gw; m < T; m += NGW) {
            const GAS f32x4* xr = (const GAS f32x4*)(x_in + (size_t)m * D) + lane; f32x4 v[4]; float s = 0.f;
#pragma unroll
            for (int j = 0; j < 4; ++j) { v[j] = xr[64 * j]; s += (v[j].x * v[j].x + v[j].y * v[j].y) + (v[j].z * v[j].z + v[j].w * v[j].w); }
            s = wave_sum(s); if (lane == 0) ss0[m] = s;
            GAS unsigned long long* o8 = (GAS unsigned long long*)(XB + (size_t)m * D) + lane;
#pragma unroll
            for (int j = 0; j < 4; ++j) o8[64 * j] = (unsigned long long)pk2(v[j].x, v[j].y) | ((unsigned long long)pk2(v[j].z, v[j].w) << 32);
        }
        for (int i = vcu * NTHR + tid; i < T * 8; i += G * NTHR) {
            const int tok = i >> 3, f = i & 7;
            const double inv = exp2(-(double)f * (18.931568569324174 / 8.0));
            double ang = (double)positions[tok] * inv; ang -= 6.283185307179586 * rint(ang * 0.15915494309189535);
            float sn, cs; sincosf((float)ang, &sn, &cs);
            rope[(size_t)tok * 16 + f] = cs; rope[(size_t)tok * 16 + 8 + f] = sn;
        }
    }
    SEAM(0);

    if (IN(1)) {
        pg8::Gemm g{XB, Win_t, T, NPROJ, D}; pg8::StaticOrder S; S.init(T, NPROJ, G, bx);
        pg8::EpiProj E{ACT0, NPROJ, ss0, 1, ev_q_norm, ev_k_norm, rope, 0};
        pg8::gemm_phase<pg8::EpiProj, pg8::StaticOrder, true, true>(lds, g, S, E);
    }
    SEAM(1);

    if (IN(2)) {
        const float gqm = wave_max(fabsf(ev_q_norm[lane])), gkm = wave_max(fabsf(ev_k_norm[lane]));
        const float mref = 8.f * gqm * gkm * pg8::LOG2E;
        for (int L = vcu; L < 512; L += G) {
            const int bhm = (L & 255) >> 4, qb = (L < 256) ? (L & 15) : 31 - (L & 15);
            const int b = bhm >> 3, hm = bhm & 7, h = hm >> 1;
            const bf16* base = ACT0 + (size_t)b * SEQ * NPROJ;
            att::attn_unit<0, 128>((LAS char*)lds, base + 1536 + hm * 64, base + 2048 + hm * 64, base + 2560 + h * 128, OD + (size_t)b * SEQ * D + hm * 128, D, qb * 256, mref, nullptr);
        }
        for (int L = vcu; L < 512; L += G) {
            const int bh = (L & 255) >> 4, qb = 2 * (L & 15) + (L >> 8);
            const int b = bh >> 3, h = bh & 7;
            const bf16* base = ACT0 + (size_t)b * SEQ * NPROJ;
            att::attn_unit<2, 64>((LAS char*)lds, base + h * 64, base + 512 + h * 64, base + 1024 + h * 64, AO + (size_t)b * SEQ * D + h * 64, D, qb * 256, 0.f, nullptr);
        }
    }
    SEAM(2);

    if (IN(3)) {
        const float a1 = wave_sum(ev_lq1[lane] * ev_lk1[lane]), a2 = wave_sum(ev_lq2[lane] * ev_lk2[lane]);
        const float lam_init = 0.2f, lam = expf(a1) - expf(a2) + lam_init;
        const int h = lane >> 4, v0 = (lane & 15) * 8;
        float sg[8];
#pragma unroll
        for (int j = 0; j < 8; ++j) sg[j] = ev_subln[v0 + j] * (1.f - lam_init);
        for (int m = gw; m < T; m += NGW) {
            const v4u a = *(const GAS v4u*)(OD + (size_t)m * D + (2 * h) * 128 + v0), b = *(const GAS v4u*)(OD + (size_t)m * D + (2 * h + 1) * 128 + v0);
            float d[8]; float s = 0.f;
#pragma unroll
            for (int j = 0; j < 4; ++j) { const unsigned ua = a[j], ub = b[j];
                d[2 * j] = bf2f((unsigned short)(ua & 0xffffu)) - lam * bf2f((unsigned short)(ub & 0xffffu));
                d[2 * j + 1] = bf2f((unsigned short)(ua >> 16)) - lam * bf2f((unsigned short)(ub >> 16));
                s += d[2 * j] * d[2 * j] + d[2 * j + 1] * d[2 * j + 1]; }
            s += __shfl_xor(s, 1); s += __shfl_xor(s, 2); s += __shfl_xor(s, 4); s += __shfl_xor(s, 8);
            const float rs = rsqrtf(s * (1.f / 128.f) + pg8::RMS_EPS);
            v4u o; o.x = pk2(d[0] * rs * sg[0], d[1] * rs * sg[1]); o.y = pk2(d[2] * rs * sg[2], d[3] * rs * sg[3]); o.z = pk2(d[4] * rs * sg[4], d[5] * rs * sg[5]); o.w = pk2(d[6] * rs * sg[6], d[7] * rs * sg[7]);
            *(GAS v4u*)(AO + (size_t)m * D + 512 + h * 128 + v0) = o;
        }
    }
    SEAM(3);

    if (IN(4)) {
        pg8::Gemm g{AO, Wo0_t, T, D, D}; pg8::StaticOrder S; S.init(T, D, G, bx);
        pg8::EpiResid E{x_in, XF, XB, ss1};
        pg8::gemm_phase<pg8::EpiResid, pg8::StaticOrder, false, true>(lds, g, S, E);
    }
    SEAM(4);

    if (IN(5)) {
        pg8::Gemm g{XB, Wgu0_t, T, 2 * FFD, D}; pg8::StaticOrder S; S.init(T, 2 * FFD, G, bx);
        pg8::EpiSwiglu E{ACT0, FFD, ss1, 16, nullptr, 0, 2 * FFD / 256};
        pg8::gemm_phase<pg8::EpiSwiglu, pg8::StaticOrder, true, true>(lds, g, S, E);
    }
    SEAM(5);

    if (IN(6)) {
        pg8::Gemm g{ACT0, Wd0_t, T, D, FFD}; pg8::StaticOrder S; S.init(T, D, G, bx);
        pg8::EpiResid E{XF, XF, XB, ss2};
        pg8::gemm_phase<pg8::EpiResid, pg8::StaticOrder, false, true>(lds, g, S, E);
    }
    SEAM(6);

    if (IN(7)) {
        pg8::Gemm g{XB, Wqkv_t, T, NPROJ, D}; pg8::StaticOrder S; S.init(T, NPROJ, G, bx);
        pg8::EpiProj E{ACT0, NPROJ, ss2, 16, od_q_norm, od_k_norm, nullptr, 1};
        pg8::gemm_phase<pg8::EpiProj, pg8::StaticOrder, true, true>(lds, g, S, E);
    }
    SEAM(7);

    if (IN(8)) {
        const float gqm = wave_max(fabsf(od_q_norm[lane])), gkm = wave_max(fabsf(od_k_norm[lane]));
        for (int L = vcu; L < 1024; L += G) {
            const int bh = (L & 255) >> 3, qb = 4 * (L & 7) + (L >> 8);
            const int b = bh >> 4, h = bh & 15;
            const float* tab = od_rel_bias + h * 257;
            float tm = fabsf(tab[lane]); tm = fmaxf(tm, fabsf(tab[64 + lane])); tm = fmaxf(tm, fabsf(tab[128 + lane])); tm = fmaxf(tm, fabsf(tab[192 + lane])); tm = fmaxf(tm, fabsf(tab[256]));
            tm = wave_max(tm);
            const float mref = (8.f * gqm * gkm + tm) * pg8::LOG2E;
            const bf16* base = ACT0 + (size_t)b * SEQ * NPROJ;
            att::attn_unit<1, 64>((LAS char*)lds, base + h * 64, base + 1024 + h * 64, base + 2048 + h * 64, AO + (size_t)b * SEQ * D + h * 64, D, qb * 256, mref, tab);
        }
    }
    SEAM(8);

    if (IN(9)) {
        pg8::Gemm g{AO, Wo1_t, T, D, D}; pg8::StaticOrder S; S.init(T, D, G, bx);
        pg8::EpiResid E{XF, out, XB, nullptr};
        pg8::gemm_phase<pg8::EpiResid, pg8::StaticOrder, false, true>(lds, g, S, E);
    }
    SEAM(9);

    if (IN(10)) {
        LAS unsigned* sel = (LAS unsigned*)lds;
        for (int blk = vcu; blk < T / 64; blk += G) {
            for (int tl = wave; tl < 64; tl += NWAVES) {
                const int tok = blk * 64 + tl;
                const GAS f32x4* xr = (const GAS f32x4*)(out + (size_t)tok * D) + lane; float s = 0.f; float lg[8];
#pragma unroll
                for (int e = 0; e < 8; ++e) lg[e] = 0.f;
#pragma unroll
                for (int j = 0; j < 4; ++j) { const f32x4 v = xr[64 * j]; s += (v.x * v.x + v.y * v.y) + (v.z * v.z + v.w * v.w);
                    const int k0 = 4 * lane + 256 * j; const f32x4 gn = *(const GAS f32x4*)(od_ffn_norm + k0);
#pragma unroll
                    for (int i = 0; i < 4; ++i) { const float xv = v[i] * gn[i]; const f32x4 w0 = *(const GAS f32x4*)(od_router + (size_t)(k0 + i) * 8), w1 = *(const GAS f32x4*)(od_router + (size_t)(k0 + i) * 8 + 4);
                        lg[0] += xv * w0.x; lg[1] += xv * w0.y; lg[2] += xv * w0.z; lg[3] += xv * w0.w; lg[4] += xv * w1.x; lg[5] += xv * w1.y; lg[6] += xv * w1.z; lg[7] += xv * w1.w; } }
                s = wave_sum(s);
#pragma unroll
                for (int e = 0; e < 8; ++e) lg[e] = wave_sum(lg[e]);
                if (lane == 0) {
                    const float r = rsqrtf(s * (1.f / 1024.f) + pg8::RMS_EPS); ss3[tok] = s;
                    int e0 = 0; float v0 = lg[0];
#pragma unroll
                    for (int e = 1; e < 8; ++e) if (lg[e] > v0) { v0 = lg[e]; e0 = e; }
                    int e1 = -1; float v1 = 0.f;
#pragma unroll
                    for (int e = 0; e < 8; ++e) if (e != e0 && (e1 < 0 || lg[e] > v1)) { v1 = lg[e]; e1 = e; }
                    const float ex = expf((v1 - v0) * r), g0 = 1.f / (1.f + ex), g1 = ex / (1.f + ex);
                    sel[tl] = (unsigned)e0 | ((unsigned)e1 << 8); tokgate[2 * tok] = g0; tokgate[2 * tok + 1] = g1;
                }
            }
            __syncthreads();
            if (wave == 0) { const unsigned sv = sel[lane]; const int e0 = sv & 0xff, e1 = sv >> 8; unsigned rank0 = 0, rank1 = 0;
                const unsigned long long lt = (1ull << lane) - 1ull;
#pragma unroll
                for (int e = 0; e < 8; ++e) { const unsigned long long m0 = __ballot(e0 == e), m1 = __ballot(e1 == e);
                    if (e0 == e) rank0 = __popcll(m0 & lt); if (e1 == e) rank1 = __popcll(m1 & lt);
                    if (lane == 0) { ctl[CW_HIST + blk * 16 + e] = __popcll(m0); ctl[CW_HIST + blk * 16 + 8 + e] = __popcll(m1); } }
                toksel[blk * 64 + lane] = sv | (rank0 << 16) | (rank1 << 24); }
            __syncthreads();
        }
    }
    SEAM(10);

    if (IN(11)) {
        LAS unsigned* hs = (LAS unsigned*)lds;
        for (int i = tid; i < 4096; i += NTHR) hs[i] = ctl[CW_HIST + i];
        __syncthreads();
        if (tid < 16) { unsigned s = 0; for (int b2 = 0; b2 < 256; ++b2) s += hs[b2 * 16 + tid]; hs[4096 + tid] = s; }
        __syncthreads();
        if (tid == 0) { unsigned acc = 0; for (int g2 = 0; g2 < 16; ++g2) { hs[4128 + g2] = acc; acc += (hs[4096 + g2] + 255u) & ~255u; } hs[4128 + 16] = acc; }
        __syncthreads();
        if (bx == 0) {
            if (tid == 0) { ctl[CW_MOE] = hs[4128 + 8] >> 8; ctl[CW_MOE + 1] = hs[4128 + 16] >> 8; }
            if (tid < 16) { const unsigned t0 = hs[4128 + tid] >> 8, t1 = hs[4128 + tid + 1] >> 8; for (unsigned t = t0; t < t1; ++t) ctl[CW_MOE + 16 + t] = tid & 7; }
        }
        for (int blk = vcu; blk < T / 64; blk += G) {
            if (tid < 16) { unsigned s = 0; for (int b2 = 0; b2 < blk; ++b2) s += hs[b2 * 16 + tid]; hs[4160 + tid] = s; }
            __syncthreads();
            for (int tl = wave; tl < 64; tl += NWAVES) {
                const int tok = blk * 64 + tl; const unsigned sv = toksel[tok];
                const v4u r0 = *(const GAS v4u*)(XB + (size_t)tok * D + lane * 8), r1 = *(const GAS v4u*)(XB + (size_t)tok * D + 512 + lane * 8);
#pragma unroll
                for (int sl = 0; sl < 2; ++sl) { const int e = (sv >> (8 * sl)) & 0xff, rank = (sv >> (16 + 8 * sl)) & 0xff, g2 = sl * 8 + e;
                    const unsigned srow = hs[4128 + g2] + hs[4160 + g2] + rank;
                    *(GAS v4u*)(SORTA + (size_t)srow * D + lane * 8) = r0; *(GAS v4u*)(SORTA + (size_t)srow * D + 512 + lane * 8) = r1;
                    if (lane == 0) { rowtok[srow] = tok; rowgate[srow] = tokgate[2 * tok + sl]; } }
            }
            __syncthreads();
        }
        for (int g2 = vcu; g2 < 16; g2 += G) {
            const unsigned r0 = hs[4128 + g2] + hs[4096 + g2], r1 = hs[4128 + g2 + 1];
            for (unsigned r = r0 + wave; r < r1; r += NWAVES) { if (lane == 0) { rowtok[r] = -1; rowgate[r] = 0.f; }
                *(GAS v4u*)(SORTA + (size_t)r * D + lane * 8) = (v4u){0u, 0u, 0u, 0u}; *(GAS v4u*)(SORTA + (size_t)r * D + 512 + lane * 8) = (v4u){0u, 0u, 0u, 0u}; }
        }
    }
    SEAM(11);

#define MOE_CHUNK(PH, CH) \
    if (IN(PH)) { const int nA = (int)__builtin_amdgcn_readfirstlane(ctl[CW_MOE]), nT = (int)__builtin_amdgcn_readfirstlane(ctl[CW_MOE + 1]); \
        const int tile0 = (CH) ? nA : 0, ntile = (CH) ? nT - nA : nA; \
        pg8::Gemm g{SORTA + (size_t)tile0 * 256 * D, WEgu_t, 0, 0, D}; pg8::MoeOrder S; S.init(ntile, 2 * FFE / 256, G, bx, tile0, (const int*)(ctl + CW_MOE + 16)); \
        pg8::EpiSwiglu E{ACTE, FFE, ss3, 1, rowtok, tile0, 2 * FFE / 256}; \
        pg8::gemm_phase<pg8::EpiSwiglu, pg8::MoeOrder, true, true>(lds, g, S, E); } \
    SEAM(PH); \
    if (IN((PH) + 1)) { const int nA = (int)__builtin_amdgcn_readfirstlane(ctl[CW_MOE]), nT = (int)__builtin_amdgcn_readfirstlane(ctl[CW_MOE + 1]); \
        const int tile0 = (CH) ? nA : 0, ntile = (CH) ? nT - nA : nA; \
        pg8::Gemm g{ACTE, WEd_t, 0, 0, FFE}; pg8::MoeOrder S; S.init(ntile, D / 256, G, bx, tile0, (const int*)(ctl + CW_MOE + 16)); \
        pg8::EpiMoeDown E{out, rowtok, rowgate, tile0}; \
        pg8::gemm_phase<pg8::EpiMoeDown, pg8::MoeOrder, true, true>(lds, g, S, E); }
    MOE_CHUNK(12, 0)
    SEAM(13);
    MOE_CHUNK(14, 1)
#undef MOE_CHUNK
#undef IN
#undef SEAM
}

constexpr int N_PHASES = 16;
extern "C" void kernel_launch(void* const* d_in, const int* in_sizes, int n_in, void* d_out, int out_size, void* d_ws, size_t ws_size, hipStream_t stream) {
    static int grid = 0;
    if (grid == 0) {
        if (n_in != 27 || out_size != T * D || ws_size < WS_END) { fprintf(stderr, "kernel_launch: unexpected problem (n_in %d, out %d, ws %zu)\n", n_in, out_size, ws_size); grid = -1; return; }
        int dev = 0, cus = 0, per_cu = 0;
        if (hipGetDevice(&dev) != hipSuccess || hipDeviceGetAttribute(&cus, hipDeviceAttributeMultiprocessorCount, dev) != hipSuccess) { grid = -1; return; }
        if (hipFuncSetAttribute((const void*)fwd_kernel, hipFuncAttributeMaxDynamicSharedMemorySize, LDS_BYTES) != hipSuccess) { fprintf(stderr, "kernel_launch: hipFuncSetAttribute failed\n"); grid = -1; return; }
        if (hipOccupancyMaxActiveBlocksPerMultiprocessor(&per_cu, (const void*)fwd_kernel, NTHR, LDS_BYTES) != hipSuccess || per_cu < 1) { fprintf(stderr, "kernel_launch: occupancy query says %d\n", per_cu); }
        (void)hipGetLastError();
        grid = cus;
    }
    if (grid < 0) return;
    (void)hipMemsetAsync(d_ws, 0, CTL_ZERO_BYTES, stream);
    KArgs a{};
    for (int i = 0; i < 27; ++i) a.in[i] = d_in[i];
    a.out = (float*)d_out; a.ws = (unsigned char*)d_ws; a.ph_lo = 0; a.ph_hi = N_PHASES;
    hipLaunchKernelGGL(fwd_kernel, dim3(grid), dim3(NTHR), LDS_BYTES, stream, a);
}
```

```cpp
#include <hip/hip_runtime.h>
#include <cstdio>
#include <cstdint>
#include <cmath>
#define PROBE_MASK 0x0
namespace pg8 {
#define PG8_LAS __attribute__((address_space(3)))
typedef unsigned short bf16_t;
typedef short bf16x8 __attribute__((ext_vector_type(8)));
typedef float f32x4 __attribute__((ext_vector_type(4)));
typedef unsigned u32x4 __attribute__((ext_vector_type(4)));
constexpr int BM = 256, BK = 64, HALF = 128, HTB = HALF * BK * 2  , STAGE_BYTES = 8 * HTB, NXCD = 8, WGM = 8;

__host__ __device__ __forceinline__ int lds_byte(int r, int c) { const int st = (r >> 4) * 2 + (c >> 5), rr = r & 15, cc = c & 31, ob = rr * 64 + cc * 2; return st * 1024 + (ob ^ (((ob >> 9) & 1) << 5)); }
__host__ __device__ __forceinline__ void stage_rc(int b, int& R, int& C) { const int st = b / 1024, sb = b % 1024, swz = sb ^ (((sb >> 9) & 1) << 5); R = (st >> 1) * 16 + swz / 64; C = (st & 1) * 32 + (swz % 64) / 2; }
__host__ __device__ __forceinline__ int perm32(int rho) { const int n = rho >> 4, i = rho & 15; return 8 * (i >> 2) + 4 * n + (i & 3); }

struct Unit { int pm, pn; };
struct Gemm { const bf16_t* A; const bf16_t* Bt; int M, N, K; };

struct StaticOrder {
    int nM, nN, nwg, G, c;
    __host__ __device__ void init(int M, int N, int G_, int c_) { nM = M / BM; nN = N / BM; nwg = nM * nN; G = G_; c = c_; }
    __host__ __device__ bool next(int i, Unit& u) const {
        const long L = (long)i * G + c; if (L >= nwg) return false;
        int wgid = (int)L; { const int q = nwg / NXCD, r = nwg % NXCD, xcd = wgid % NXCD, off = wgid / NXCD; wgid = (xcd < r ? xcd * (q + 1) : r * (q + 1) + (xcd - r) * q) + off; }
        const int nig = WGM * nN, gid = wgid / nig, fm = gid * WGM, gsz = (nM - fm) < WGM ? (nM - fm) : WGM;
        u.pm = fm + ((wgid % nig) % gsz); u.pn = (wgid % nig) / gsz; return true;
    }
    __device__ __forceinline__ void a_ready(const Unit&) const {}
    __device__ __forceinline__ void done(const Unit&) const {}
};

struct MoeOrder {
    int nM, nN, nwg, G, c, tile0; const int* tile_expert;
    __device__ void init(int ntiles, int npn, int G_, int c_, int tile0_, const int* te) { nM = ntiles; nN = npn; nwg = nM * nN; G = G_; c = c_; tile0 = tile0_; tile_expert = te; }
    __device__ bool next(int i, Unit& u) const {
        const long L = (long)i * G + c; if (L >= nwg) return false;
        int wgid = (int)L; { const int q = nwg / NXCD, r = nwg % NXCD, xcd = wgid % NXCD, off = wgid / NXCD; wgid = (xcd < r ? xcd * (q + 1) : r * (q + 1) + (xcd - r) * q) + off; }
        const int nig = WGM * nN, gid = wgid / nig, fm = gid * WGM, gsz = (nM - fm) < WGM ? (nM - fm) : WGM;
        u.pm = fm + ((wgid % nig) % gsz); const int pnl = (wgid % nig) / gsz;
        const int e = __builtin_amdgcn_readfirstlane(tile_expert[tile0 + u.pm]);
        u.pn = e * nN + pnl; return true;
    }
    __device__ __forceinline__ void a_ready(const Unit&) const {}
    __device__ __forceinline__ void done(const Unit&) const {}
};

__device__ __forceinline__ unsigned cvt_pk_bf16(float lo, float hi) { unsigned r; asm volatile("v_cvt_pk_bf16_f32 %0, %1, %2" : "=v"(r) : "v"(lo), "v"(hi)); return r; }
__device__ __forceinline__ u32x4 pack8(const f32x4& a, const f32x4& b) { u32x4 w; w.x = cvt_pk_bf16(a[0], a[1]); w.y = cvt_pk_bf16(a[2], a[3]); w.z = cvt_pk_bf16(b[0], b[1]); w.w = cvt_pk_bf16(b[2], b[3]); return w; }
constexpr float RMS_EPS = 1e-6f;
constexpr float LOG2E = 1.4426950408889634f;
constexpr float C2 = 0.125f * LOG2E;
__device__ __forceinline__ float row_ss(const float* ss, int nparts, int row) {
    if (nparts == 1) return ss[row];
    const f32x4* p = (const f32x4*)(ss + (size_t)row * 16); f32x4 a = p[0], b = p[1], c = p[2], d = p[3]; a = (a + b) + (c + d); return (a[0] + a[1]) + (a[2] + a[3]);
}

struct EpiProj {
    static constexpr bool PERM = true, AFTER_DRAIN = false;
    bf16_t* O; int ldc; const float* ss; int nparts; const float* gq; const float* gk; const float* rope; int layer;
    __device__ __forceinline__ void operator()(const f32x4 (&acc)[2][2][4][2], const Unit& u, int wr, int wc, int fr, int fq) const {
        const int pn = u.pn; int kind = 0; float scale = 1.f; bool rope_on = false;
        if (layer == 0) { const int t = pn >> 1; if (t == 0) scale = C2; else if (t == 3) { kind = 1; scale = C2; rope_on = true; } else if (t == 4) { kind = 2; rope_on = true; } }
        else { const int t = pn >> 2; if (t == 0) { kind = 1; scale = C2; } else if (t == 1) kind = 2; }
        const float* gv = (kind == 1) ? gq : gk;
        f32x4 g[2][2];
#pragma unroll
        for (int bj = 0; bj < 2; ++bj)
#pragma unroll
            for (int n = 0; n < 2; ++n) g[bj][n] = kind ? *(const f32x4*)(gv + 32 * bj + 8 * fq + 4 * n) : (f32x4){1.f, 1.f, 1.f, 1.f};
        const int row0 = u.pm * BM + wr * 64 + fr, col0 = pn * BM + wc * 64 + 8 * fq;
#pragma unroll
        for (int ai = 0; ai < 2; ++ai)
#pragma unroll
            for (int m = 0; m < 4; ++m) {
                const int row = row0 + ai * HALF + m * 16;
                const float r = rsqrtf(row_ss(ss, nparts, row) * (1.f / 1024.f) + RMS_EPS);
                f32x4 v[2][2]; float s = 0.f;
#pragma unroll
                for (int bj = 0; bj < 2; ++bj)
#pragma unroll
                    for (int n = 0; n < 2; ++n) { v[bj][n] = acc[ai][bj][m][n] * r; const f32x4 x = v[bj][n]; s += (x[0] * x[0] + x[1] * x[1]) + (x[2] * x[2] + x[3] * x[3]); }
                if (kind) {
                    s += __shfl_xor(s, 16); s += __shfl_xor(s, 32);
                    const float rs = rsqrtf(s * (1.f / 64.f) + RMS_EPS);
#pragma unroll
                    for (int bj = 0; bj < 2; ++bj)
#pragma unroll
                        for (int n = 0; n < 2; ++n) v[bj][n] = v[bj][n] * rs * g[bj][n];
                    if (rope_on) {
                        f32x4 p[2];
#pragma unroll
                        for (int n = 0; n < 2; ++n)
#pragma unroll
                            for (int j = 0; j < 4; ++j) p[n][j] = __shfl_xor(v[0][n][j], 16);
                        const f32x4 c0 = *(const f32x4*)(rope + (size_t)row * 16), c1 = *(const f32x4*)(rope + (size_t)row * 16 + 4);
                        const f32x4 s0 = *(const f32x4*)(rope + (size_t)row * 16 + 8), s1 = *(const f32x4*)(rope + (size_t)row * 16 + 12);
                        if (fq == 0) { v[0][0] = v[0][0] * c0 - p[0] * s0; v[0][1] = v[0][1] * c1 - p[1] * s1; }
                        else if (fq == 1) { v[0][0] = v[0][0] * c0 + p[0] * s0; v[0][1] = v[0][1] * c1 + p[1] * s1; }
                    }
                }
                bf16_t* rowp = O + (size_t)row * ldc + col0;
#pragma unroll
                for (int bj = 0; bj < 2; ++bj) *(u32x4*)(rowp + 32 * bj) = pack8(v[bj][0] * scale, v[bj][1] * scale);
            }
    }
};

struct EpiResid {
    static constexpr bool PERM = true, AFTER_DRAIN = false;
    const float* base; float* out; bf16_t* xb; float* ss;
    __device__ __forceinline__ void operator()(const f32x4 (&acc)[2][2][4][2], const Unit& u, int wr, int wc, int fr, int fq) const {
        const int row0 = u.pm * BM + wr * 64 + fr, col0 = u.pn * BM + wc * 32 + 8 * fq;
#pragma unroll
        for (int ai = 0; ai < 2; ++ai)
#pragma unroll
            for (int m = 0; m < 4; ++m) {
                const int row = row0 + ai * HALF + m * 16; float s = 0.f;
#pragma unroll
                for (int bj = 0; bj < 2; ++bj) {
                    const size_t off = (size_t)row * 1024 + col0 + bj * HALF;
                    const f32x4 v0 = acc[ai][bj][m][0] + *(const f32x4*)(base + off), v1 = acc[ai][bj][m][1] + *(const f32x4*)(base + off + 4);
                    *(f32x4*)(out + off) = v0; *(f32x4*)(out + off + 4) = v1;
                    if (xb) *(u32x4*)(xb + off) = pack8(v0, v1);
                    s += (v0[0] * v0[0] + v0[1] * v0[1]) + (v0[2] * v0[2] + v0[3] * v0[3]) + (v1[0] * v1[0] + v1[1] * v1[1]) + (v1[2] * v1[2] + v1[3] * v1[3]);
                }
                if (ss) { s += __shfl_xor(s, 16); s += __shfl_xor(s, 32); if (fq == 0) ss[(size_t)row * 16 + u.pn * 4 + wc] = s; }
            }
    }
};

__device__ __forceinline__ unsigned pk4_fp8(float a, float b, float c, float d) { int w = __builtin_amdgcn_cvt_pk_fp8_f32(a, b, 0, false); w = __builtin_amdgcn_cvt_pk_fp8_f32(c, d, w, true); return (unsigned)w; }
template <bool OUT8> struct EpiSwiglu {
    static constexpr bool PERM = true, AFTER_DRAIN = false;
    void* O; int ldc; const float* ss; int nparts; const int* rowtok; int tile0; int npn; float pre;
    __device__ __forceinline__ void operator()(const f32x4 (&acc)[2][2][4][2], const Unit& u, int wr, int wc, int fr, int fq) const {
        const int pnl = u.pn % npn; const int row0 = u.pm * BM + wr * 64 + fr, col0 = pnl * HALF + wc * 32 + 8 * fq;
#pragma unroll
        for (int ai = 0; ai < 2; ++ai)
#pragma unroll
            for (int m = 0; m < 4; ++m) {
                const int row = row0 + ai * HALF + m * 16;
                int tok = row; if (rowtok) tok = rowtok[tile0 * BM + row];
                const float r = (tok >= 0) ? rsqrtf(row_ss(ss, nparts, tok >= 0 ? tok : 0) * (1.f / 1024.f) + RMS_EPS) * pre : 0.f;
                f32x4 a[2];
#pragma unroll
                for (int n = 0; n < 2; ++n)
#pragma unroll
                    for (int j = 0; j < 4; ++j) { const float gt = acc[ai][0][m][n][j] * r, up = acc[ai][1][m][n][j] * r;
                        a[n][j] = gt * __builtin_amdgcn_rcpf(1.f + __builtin_amdgcn_exp2f(-gt * LOG2E)) * up; }
                if constexpr (OUT8) { typedef unsigned u32x2 __attribute__((ext_vector_type(2))); u32x2 w; w.x = pk4_fp8(a[0][0], a[0][1], a[0][2], a[0][3]); w.y = pk4_fp8(a[1][0], a[1][1], a[1][2], a[1][3]); *(u32x2*)((unsigned char*)O + (size_t)row * ldc + col0) = w; }
                else *(u32x4*)((bf16_t*)O + (size_t)row * ldc + col0) = pack8(a[0], a[1]);
            }
    }
};

struct EpiMoeDown {
    static constexpr bool PERM = true, AFTER_DRAIN = false;
    float* out; const int* rowtok; const float* rowgate; int tile0; float pre;
    __device__ __forceinline__ void operator()(const f32x4 (&acc)[2][2][4][2], const Unit& u, int wr, int wc, int fr, int fq) const {
        const int pnl = u.pn & 3; const int row0 = (tile0 + u.pm) * BM + wr * 64 + fr, col0 = pnl * BM + wc * 32 + 8 * fq;
#pragma unroll
        for (int ai = 0; ai < 2; ++ai)
#pragma unroll
            for (int m = 0; m < 4; ++m) {
                const int srow = row0 + ai * HALF + m * 16; const int tok = rowtok[srow];
                if (tok >= 0) { const float gt = rowgate[srow] * pre;
#pragma unroll
                    for (int bj = 0; bj < 2; ++bj)
#pragma unroll
                        for (int n = 0; n < 2; ++n) { f32x4* p = (f32x4*)(out + (size_t)tok * 1024 + col0 + bj * HALF + 4 * n); *p = *p + acc[ai][bj][m][n] * gt; } }
            }
    }
};

typedef int i32x4 __attribute__((ext_vector_type(4)));
typedef int i32x8 __attribute__((ext_vector_type(8)));
template <class Epi, class Sched, bool ALIGN_EPI = false, bool SP2 = false, bool F8 = false>
__device__ __forceinline__ void gemm_phase(PG8_LAS unsigned char* lds, const Gemm g, const Sched& S, const Epi& E) {
    const int tid = threadIdx.x, wid = __builtin_amdgcn_readfirstlane(tid >> 6), lane = tid & 63, wr = wid >> 2, wc = wid & 3, fr = lane & 15, fq = lane >> 4;
    const int K = g.K, nt = K / BK;
    unsigned voffA[2], voffB[2];
#pragma unroll
    for (int i = 0; i < 2; ++i) { int R, C; stage_rc(tid * 16 + i * 8192, R, C); const int Rb = Epi::PERM ? ((R & ~31) + perm32(R & 31)) : R;
        voffA[i] = (unsigned)(R * K + C) * 2u; voffB[i] = (unsigned)(Rb * K + C) * 2u; }
    const size_t kstep = (size_t)(BK * 2);
    const size_t hstep = (size_t)HALF * K * 2;
    const size_t tstep = 2 * hstep;
    const unsigned ldsw = (unsigned)wid * 1024u;
    const int aoff = lds_byte(wr * 64 + fr, fq * 8), boff = lds_byte(wc * 32 + fr, fq * 8);
#define PG8_SA(b, h) (((b) * 2 + (h)) * HTB)
#define PG8_SB(b, h) ((4 + (b) * 2 + (h)) * HTB)
#define PG8_STAGE(bufoff, gbase, voff) do { _Pragma("unroll") for (int _i = 0; _i < 2; ++_i) \
        __builtin_amdgcn_global_load_lds((const unsigned*)((const char*)(gbase) + (voff)[_i]), (PG8_LAS unsigned*)(lds + (bufoff) + ldsw + _i * 8192), 16, 0, 0); } while (0)
#define PG8_LDA(dst, b, h) do { if constexpr (F8) { _Pragma("unroll") for (int m = 0; m < 4; ++m) dst##8[m] = PG8_CAT(*(const PG8_LAS bf16x8*)(lds + PG8_SA(b, h) + aoff + m * 2048), *(const PG8_LAS bf16x8*)(lds + PG8_SA(b, h) + aoff + m * 2048 + 1024)); } \
        else { _Pragma("unroll") for (int m = 0; m < 4; ++m) _Pragma("unroll") for (int k = 0; k < 2; ++k) dst[m][k] = *(const PG8_LAS bf16x8*)(lds + PG8_SA(b, h) + aoff + m * 2048 + k * 1024); } } while (0)
#define PG8_LDB(dst, b, h) do { if constexpr (F8) { _Pragma("unroll") for (int n = 0; n < 2; ++n) dst##8[n] = PG8_CAT(*(const PG8_LAS bf16x8*)(lds + PG8_SB(b, h) + boff + n * 2048), *(const PG8_LAS bf16x8*)(lds + PG8_SB(b, h) + boff + n * 2048 + 1024)); } \
        else { _Pragma("unroll") for (int n = 0; n < 2; ++n) _Pragma("unroll") for (int k = 0; k < 2; ++k) dst[n][k] = *(const PG8_LAS bf16x8*)(lds + PG8_SB(b, h) + boff + n * 2048 + k * 1024); } } while (0)
#define PG8_CAT(x, y) __builtin_shufflevector(__builtin_bit_cast(i32x4, (x)), __builtin_bit_cast(i32x4, (y)), 0, 1, 2, 3, 4, 5, 6, 7)
#define PG8_MMA(ai, bj, At, Bt) do { __builtin_amdgcn_s_setprio(1); _Pragma("unroll") for (int m = 0; m < 4; ++m) _Pragma("unroll") for (int n = 0; n < 2; ++n) { \
        if constexpr (F8) { asm volatile("v_mfma_f32_16x16x128_f8f6f4 %0, %1, %2, %0" : "+v"(acc[ai][bj][m][n]) : "v"(Bt##8[n]), "v"(At##8[m])); } \
        else { _Pragma("unroll") for (int k = 0; k < 2; ++k) acc[ai][bj][m][n] = __builtin_amdgcn_mfma_f32_16x16x32_bf16(Bt[n][k], At[m][k], acc[ai][bj][m][n], 0, 0, 0); } } __builtin_amdgcn_s_setprio(0); } while (0)
#define PG8_WAIT_V(n) asm volatile("s_waitcnt vmcnt(" #n ")" ::: "memory")
#define PG8_WAIT_L(n) asm volatile("s_waitcnt lgkmcnt(" #n ")" ::: "memory")
#define PG8_BAR __builtin_amdgcn_s_barrier()
#define PG8_SCHED __builtin_amdgcn_sched_barrier(0)
    Unit cur, nxt; int ui = 0;
    if (!S.next(0, cur)) return;
    f32x4 acc[2][2][4][2];
#pragma unroll
    for (int a = 0; a < 2; ++a)
#pragma unroll
        for (int b = 0; b < 2; ++b)
#pragma unroll
            for (int m = 0; m < 4; ++m)
#pragma unroll
                for (int n = 0; n < 2; ++n) acc[a][b][m][n] = (f32x4){0.f, 0.f, 0.f, 0.f};
    bf16x8 At[4][2], B0[2][2], B1[2][2];
    i32x8 At8[4], B08[2], B18[2];
    const char* cA = (const char*)g.A + (size_t)cur.pm * tstep; const char* cB = (const char*)g.Bt + (size_t)cur.pn * tstep;
    S.a_ready(cur);
    if constexpr (SP2) {
        PG8_STAGE(PG8_SB(0, 0), cB, voffB); PG8_STAGE(PG8_SB(0, 1), cB + hstep, voffB); PG8_STAGE(PG8_SA(0, 0), cA, voffA); PG8_STAGE(PG8_SA(0, 1), cA + hstep, voffA);
        if (wr == 1) PG8_BAR;
        PG8_WAIT_V(2); PG8_BAR;
        PG8_STAGE(PG8_SB(1, 0), cB + kstep, voffB); PG8_STAGE(PG8_SA(1, 0), cA + kstep, voffA); PG8_STAGE(PG8_SB(1, 1), cB + hstep + kstep, voffB);
        PG8_WAIT_V(6); PG8_BAR;
    } else {
        PG8_STAGE(PG8_SB(0, 0), cB, voffB); PG8_STAGE(PG8_SA(0, 0), cA, voffA); PG8_STAGE(PG8_SB(0, 1), cB + hstep, voffB); PG8_STAGE(PG8_SA(0, 1), cA + hstep, voffA);
        if (wr == 1) PG8_BAR;
        PG8_WAIT_V(4); PG8_BAR;
        PG8_STAGE(PG8_SB(1, 0), cB + kstep, voffB); PG8_STAGE(PG8_SA(1, 0), cA + kstep, voffA); PG8_STAGE(PG8_SB(1, 1), cB + hstep + kstep, voffB);
        PG8_WAIT_V(6); PG8_BAR;
    }
    for (;;) {
        const bool has_next = S.next(ui + 1, nxt);
        const char* nA = has_next ? (const char*)g.A + (size_t)nxt.pm * tstep : cA; const char* nB = has_next ? (const char*)g.Bt + (size_t)nxt.pn * tstep : cB;
#pragma nounroll
        for (int t = 0; t < nt; t += 2) {
            const bool last = (t == nt - 2);
            const char* a1 = cA + (size_t)(t + 1) * kstep;
            const char* a2 = last ? nA : cA + (size_t)(t + 2) * kstep; const char* b2 = last ? nB : cB + (size_t)(t + 2) * kstep;
            const char* a3 = a2 + kstep; const char* b3 = b2 + kstep;
            if (last && has_next) S.a_ready(nxt);
            if constexpr (SP2) {
            PG8_LDB(B0, 0, 0); PG8_LDB(B1, 0, 1); PG8_SCHED; PG8_LDA(At, 0, 0); PG8_STAGE(PG8_SA(1, 1), a1 + hstep, voffA);
            PG8_WAIT_V(8); PG8_WAIT_L(0); PG8_BAR; PG8_MMA(0, 0, At, B0); PG8_MMA(0, 1, At, B1); PG8_BAR; PG8_SCHED;
            PG8_LDA(At, 0, 1); PG8_STAGE(PG8_SB(0, 0), b2, voffB); PG8_STAGE(PG8_SB(0, 1), b2 + hstep, voffB); PG8_STAGE(PG8_SA(0, 0), a2, voffA);
            PG8_WAIT_V(8); PG8_WAIT_L(0); PG8_BAR; PG8_MMA(1, 0, At, B0); PG8_MMA(1, 1, At, B1); PG8_BAR; PG8_SCHED;
            PG8_LDB(B0, 1, 0); PG8_LDB(B1, 1, 1); PG8_SCHED; PG8_LDA(At, 1, 0); PG8_STAGE(PG8_SA(0, 1), a2 + hstep, voffA);
            PG8_WAIT_V(8); PG8_WAIT_L(0); PG8_BAR; PG8_MMA(0, 0, At, B0); PG8_MMA(0, 1, At, B1); PG8_BAR; PG8_SCHED;
            PG8_LDA(At, 1, 1); PG8_STAGE(PG8_SB(1, 0), b3, voffB); PG8_STAGE(PG8_SB(1, 1), b3 + hstep, voffB); PG8_STAGE(PG8_SA(1, 0), a3, voffA);
            PG8_WAIT_V(8); PG8_WAIT_L(0); PG8_BAR; PG8_MMA(1, 0, At, B0); PG8_MMA(1, 1, At, B1); PG8_BAR; PG8_SCHED;
            } else {
            PG8_LDB(B0, 0, 0); PG8_SCHED; PG8_LDA(At, 0, 0); PG8_STAGE(PG8_SA(1, 1), a1 + hstep, voffA);
            PG8_WAIT_L(8); PG8_BAR; PG8_WAIT_L(0); PG8_MMA(0, 0, At, B0); PG8_BAR; PG8_SCHED;
            PG8_LDB(B1, 0, 1); PG8_STAGE(PG8_SB(0, 0), b2, voffB);
            PG8_BAR; PG8_WAIT_L(0); PG8_MMA(0, 1, At, B1); PG8_BAR;
            PG8_LDA(At, 0, 1); PG8_STAGE(PG8_SA(0, 0), a2, voffA);
            PG8_BAR; PG8_WAIT_L(0); PG8_MMA(1, 0, At, B0); PG8_BAR; PG8_SCHED;
            PG8_STAGE(PG8_SB(0, 1), b2 + hstep, voffB);
            PG8_WAIT_V(6); PG8_BAR; PG8_MMA(1, 1, At, B1); PG8_BAR;
            PG8_LDB(B0, 1, 0); PG8_SCHED; PG8_LDA(At, 1, 0); PG8_STAGE(PG8_SA(0, 1), a2 + hstep, voffA);
            PG8_WAIT_L(8); PG8_BAR; PG8_WAIT_L(0); PG8_MMA(0, 0, At, B0); PG8_BAR; PG8_SCHED;
            PG8_LDB(B1, 1, 1); PG8_STAGE(PG8_SB(1, 0), b3, voffB);
            PG8_BAR; PG8_WAIT_L(0); PG8_MMA(0, 1, At, B1); PG8_BAR;
            PG8_LDA(At, 1, 1); PG8_STAGE(PG8_SA(1, 0), a3, voffA);
            PG8_BAR; PG8_WAIT_L(0); PG8_MMA(1, 0, At, B0); PG8_BAR; PG8_SCHED;
            PG8_STAGE(PG8_SB(1, 1), b3 + hstep, voffB);
            PG8_WAIT_V(6); PG8_BAR; PG8_MMA(1, 1, At, B1); PG8_BAR;
            }
        }
        if constexpr (F8) asm volatile("s_nop 15\n\ts_nop 15\n\ts_nop 15" ::: "memory");
        if constexpr (ALIGN_EPI) { if (wr == 0) PG8_BAR; }
        if constexpr (!Epi::AFTER_DRAIN) { E(acc, cur, wr, wc, fr, fq); S.done(cur); }
        if (!has_next) break;
#pragma unroll
        for (int a = 0; a < 2; ++a)
#pragma unroll
            for (int b = 0; b < 2; ++b)
#pragma unroll
                for (int m = 0; m < 4; ++m)
#pragma unroll
                    for (int n = 0; n < 2; ++n) acc[a][b][m][n] = (f32x4){0.f, 0.f, 0.f, 0.f};
        cur = nxt; cA = nA; cB = nB; ++ui;
        if constexpr (ALIGN_EPI) { if (wr == 1) PG8_BAR; }
    }
    PG8_WAIT_V(0);
    if constexpr (!ALIGN_EPI) { if (wr == 0) PG8_BAR; }
    PG8_BAR;
    if constexpr (Epi::AFTER_DRAIN) { E.fused(acc, cur, wr, wc, fr, fq, lds, wid, lane); S.done(cur); }
#undef PG8_SA
#undef PG8_SB
#undef PG8_STAGE
#undef PG8_LDA
#undef PG8_LDB
#undef PG8_MMA
#undef PG8_CAT
#undef PG8_WAIT_V
#undef PG8_WAIT_L
#undef PG8_BAR
#undef PG8_SCHED
}
}

namespace att {
using pg8::bf16_t; using pg8::bf16x8; using pg8::u32x4;
typedef float f32x16 __attribute__((ext_vector_type(16)));
typedef short s16x4 __attribute__((ext_vector_type(4)));
typedef float f32x2_t __attribute__((ext_vector_type(2))); typedef __bf16 bf16x2_t __attribute__((ext_vector_type(2)));
#define ALAS __attribute__((address_space(3)))
typedef ALAS const char* lds_cptr;
constexpr int SEQ = 8192, PITCH = 3072;
constexpr int KVSLOT = 24576;
constexpr int L_WS = 2 * KVSLOT, L_OST = L_WS + 2048, L_TAB = L_OST + 8 * 4096, L_FLAG = L_TAB + 1056, L_END = L_FLAG + 64;
constexpr float SB_THR = 152.f;
__device__ __forceinline__ int crow(int r, int hi) { return (r & 3) + 8 * (r >> 2) + 4 * hi; }
__device__ __forceinline__ void glds16(const void* gsrc, unsigned lds_dst) { unsigned keep;
    asm volatile("s_mov_b32 %0, m0\n\ts_mov_b32 m0, %2\n\ts_nop 0\n\tglobal_load_lds_dwordx4 %1, off\n\ts_mov_b32 m0, %0" : "=&s"(keep) : "v"(gsrc), "s"(lds_dst) : "memory"); }
__device__ __forceinline__ unsigned cvtpk(float lo, float hi) { f32x2_t v = {lo, hi}; bf16x2_t b = __builtin_convertvector(v, bf16x2_t); return __builtin_bit_cast(unsigned, b); }
__device__ __forceinline__ unsigned short f2bf(float f) { unsigned u = __builtin_bit_cast(unsigned, f); return (unsigned short)((u + 0x7fffu + ((u >> 16) & 1u)) >> 16); }
#define MFMA32(a, b, c) __builtin_amdgcn_mfma_f32_32x32x16_bf16((a), (b), (c), 0, 0, 0)

__device__ __forceinline__ void qkt(f32x16& p0, f32x16& p1, lds_cptr kb, const bf16x8* qr, const f32x16& cin) {
#pragma unroll
    for (int d0 = 0; d0 < 4; ++d0) {
        const bf16x8 b0 = *(const ALAS bf16x8*)(kb + d0 * 2048);
        const bf16x8 b1 = *(const ALAS bf16x8*)(kb + d0 * 2048 + 512);
        if (d0 == 0) { p0 = MFMA32(b0, qr[0], cin); p1 = MFMA32(b1, qr[0], cin); }
        else { p0 = MFMA32(b0, qr[d0], p0); p1 = MFMA32(b1, qr[d0], p1); }
    }
}
template <int ND> __device__ __forceinline__ void pv(f32x16* o, int vb, bf16x8 pa0, bf16x8 pa1, bf16x8 pa2, bf16x8 pa3) {
#pragma unroll
    for (int d0 = 0; d0 < ND; ++d0) { s16x4 lo[4], hi[4];
#pragma unroll
        for (int ks = 0; ks < 4; ++ks) {
            asm volatile("ds_read_b64_tr_b16 %0,%1 offset:%c2" : "=&v"(lo[ks]) : "v"(vb), "i"(d0 * 4096 + ks * 1024) : "memory");
            asm volatile("ds_read_b64_tr_b16 %0,%1 offset:%c2" : "=&v"(hi[ks]) : "v"(vb), "i"(d0 * 4096 + ks * 1024 + 512) : "memory"); }
        asm volatile("s_waitcnt lgkmcnt(0)" ::: "memory"); __builtin_amdgcn_sched_barrier(0);
#define ATT_PK(k) (bf16x8){lo[k][0], lo[k][1], lo[k][2], lo[k][3], hi[k][0], hi[k][1], hi[k][2], hi[k][3]}
        o[d0] = MFMA32(pa0, ATT_PK(0), o[d0]);
        o[d0] = MFMA32(pa1, ATT_PK(1), o[d0]);
        o[d0] = MFMA32(pa2, ATT_PK(2), o[d0]);
        o[d0] = MFMA32(pa3, ATT_PK(3), o[d0]);
#undef ATT_PK
    }
}

template <int MODE, int VD>
__device__ __forceinline__ void attn_unit(ALAS char* shm, const bf16_t* Qb, const bf16_t* Kb, const bf16_t* Vb, bf16_t* Ob, int opitch, int q0, float mref2, const float* tab) {
    constexpr int ND = VD / 32;
    const int tid = threadIdx.x, lane = tid & 63, r32 = lane & 31, hi = lane >> 5; const int wid = __builtin_amdgcn_readfirstlane(tid >> 6);
    const unsigned lds0 = (unsigned)(uintptr_t)shm;
    ALAS float* wsf = (ALAS float*)(shm + L_WS) + wid * 64;
    ALAS float* tabL = (ALAS float*)(shm + L_TAB);
    ALAS unsigned* flg = (ALAS unsigned*)(shm + L_FLAG);
    if (MODE == 1) { for (int i = tid; i < 257; i += 512) tabL[i] = tab[i] * pg8::LOG2E; }
    const bf16_t* Qw = Qb + (size_t)(q0 + wid * 32) * PITCH;
    bf16x8 qr[4];
#pragma unroll
    for (int d0 = 0; d0 < 4; ++d0) qr[d0] = *(const bf16x8*)(Qw + (size_t)r32 * PITCH + d0 * 16 + hi * 8);
    int t_first, n_t, t_step;
    if (MODE == 0) { t_first = 0; n_t = q0 / 64 + 4; t_step = 1; }
    else if (MODE == 1) { const int c0 = q0 / 64; t_first = c0 - 8 > 0 ? c0 - 8 : 0; n_t = c0 + 4 - t_first; t_step = 1; }
    else { t_first = q0 / 64 + 3; n_t = q0 / 64 + 4; t_step = -1; }
    const bf16_t* ksrc = Kb + (size_t)lane * PITCH + wid * 8;
    const bf16_t* vsrc = Vb + (size_t)(16 * (wid & 3) + (lane >> 2)) * PITCH + (wid >> 2) * 32 + (lane & 3) * 8;
#define ATT_DMA(t, slot) do { const size_t to_ = (size_t)(t) * 64 * PITCH; const unsigned sb_ = lds0 + (unsigned)(slot) * KVSLOT; \
        glds16(ksrc + to_, (unsigned)__builtin_amdgcn_readfirstlane(sb_ + wid * 1024)); \
        glds16(vsrc + to_, (unsigned)__builtin_amdgcn_readfirstlane(sb_ + 8192 + wid * 1024)); \
        if (VD == 128) glds16(vsrc + to_ + 64, (unsigned)__builtin_amdgcn_readfirstlane(sb_ + 8192 + (wid + 8) * 1024)); } while (0)
    f32x16 o[ND];
#pragma unroll
    for (int d = 0; d < ND; ++d) o[d] = f32x16{};
    f32x16 cin;
#pragma unroll
    for (int r = 0; r < 16; ++r) cin[r] = (MODE == 2) ? 0.f : -mref2;
    float l_reg = 0.f, A = 0.f; bool wdone = false;
    const int wrow0 = q0 + wid * 32, qrow = wrow0 + r32;
    const int vb0 = (int)lds0 + 8192 + ((lane >> 4) & 1) * 32 + (lane & 3) * 8 + (4 * hi + ((lane & 15) >> 2)) * 64;
    ATT_DMA(t_first, 0);
    for (int i = 0; i < n_t; ++i) {
        const int t = t_first + i * t_step, slot = i & 1;
        asm volatile("s_waitcnt vmcnt(0) lgkmcnt(0)\n\ts_barrier" ::: "memory");
        if (MODE == 2 && i > 0) { const int par = ((i - 1) & 1) * 8; unsigned all = 1u;
#pragma unroll
            for (int w = 0; w < 8; ++w) all &= flg[par + w];
            if (__builtin_amdgcn_readfirstlane(all)) break; }
        if (i + 1 < n_t) ATT_DMA(t + t_step, slot ^ 1);
        bool active;
        if (MODE == 0) active = (64 * t <= wrow0);
        else if (MODE == 1) { const int cw = wrow0 / 64; active = (t >= cw - 8) && (t <= cw); }
        else active = !wdone && (64 * t < wrow0 + 31);
        if (active) {
            const lds_cptr kb = (lds_cptr)shm + slot * KVSLOT + hi * 1024 + r32 * 16;
            f32x16 p0, p1; qkt(p0, p1, kb, qr, cin);
            if (MODE == 0) {
#pragma unroll
                for (int r = 0; r < 16; ++r) { p0[r] = __builtin_amdgcn_exp2f(p0[r]); p1[r] = __builtin_amdgcn_exp2f(p1[r]); }
            } else if (MODE == 1) {
                const int cw = wrow0 / 64;
                if (t <= cw - 3) { const float cb = tabL[256];
#pragma unroll
                    for (int r = 0; r < 16; ++r) { p0[r] = __builtin_amdgcn_exp2f(p0[r] + cb); p1[r] = __builtin_amdgcn_exp2f(p1[r] + cb); }
                } else { const int dq = qrow - 64 * t - 4 * hi;
#pragma unroll
                    for (int r = 0; r < 16; ++r) { int d0 = dq - ((r & 3) + 8 * (r >> 2)), d1 = d0 - 32;
                        d0 = d0 < -128 ? -128 : (d0 > 128 ? 128 : d0); d1 = d1 < -128 ? -128 : (d1 > 128 ? 128 : d1);
                        p0[r] = __builtin_amdgcn_exp2f(p0[r] + tabL[d0 + 128]); p1[r] = __builtin_amdgcn_exp2f(p1[r] + tabL[d1 + 128]); }
                }
            } else {
                const bool needmask = (64 * t + 63 >= wrow0);
                const int kq = qrow - 64 * t - 4 * hi;
                float g[8];
#pragma unroll
                for (int k = 0; k < 8; ++k) g[k] = 0.f;
                f32x16 s0, s1;
#pragma unroll
                for (int r = 0; r < 16; ++r) { const int kv = (r & 3) + 8 * (r >> 2);
                    { const float y = p0[r], a = __builtin_fabsf(y); float sp = __builtin_fmaxf(y, 0.f) + __builtin_amdgcn_logf(1.f + __builtin_amdgcn_exp2f(-a)); if (needmask && !(kv < kq)) sp = 0.f; s0[r] = sp; g[r >> 2] += sp; }
                    { const float y = p1[r], a = __builtin_fabsf(y); float sp = __builtin_fmaxf(y, 0.f) + __builtin_amdgcn_logf(1.f + __builtin_amdgcn_exp2f(-a)); if (needmask && !(kv + 32 < kq)) sp = 0.f; s1[r] = sp; g[4 + (r >> 2)] += sp; } }
                float pg[8];
#pragma unroll
                for (int k = 0; k < 8; ++k) pg[k] = __shfl_xor(g[k], 32);
                float base[8]; float own = 0.f, par = 0.f;
#pragma unroll
                for (int k = 7; k >= 0; --k) { const float par_incl = par + pg[k]; base[k] = A + own + (hi == 0 ? par_incl : par); own += g[k]; par = par_incl; }
                A += own + par;
#pragma unroll
                for (int k = 0; k < 4; ++k) {
                    { float c = base[k]; c += s0[4 * k + 3]; const float w3 = __builtin_amdgcn_exp2f(p0[4 * k + 3] - c); c += s0[4 * k + 2]; const float w2 = __builtin_amdgcn_exp2f(p0[4 * k + 2] - c);
                      c += s0[4 * k + 1]; const float w1 = __builtin_amdgcn_exp2f(p0[4 * k + 1] - c); c += s0[4 * k]; const float w0 = __builtin_amdgcn_exp2f(p0[4 * k] - c);
                      p0[4 * k] = w0; p0[4 * k + 1] = w1; p0[4 * k + 2] = w2; p0[4 * k + 3] = w3; }
                    { float c = base[4 + k]; c += s1[4 * k + 3]; const float w3 = __builtin_amdgcn_exp2f(p1[4 * k + 3] - c); c += s1[4 * k + 2]; const float w2 = __builtin_amdgcn_exp2f(p1[4 * k + 2] - c);
                      c += s1[4 * k + 1]; const float w1 = __builtin_amdgcn_exp2f(p1[4 * k + 1] - c); c += s1[4 * k]; const float w0 = __builtin_amdgcn_exp2f(p1[4 * k] - c);
                      p1[4 * k] = w0; p1[4 * k + 1] = w1; p1[4 * k + 2] = w2; p1[4 * k + 3] = w3; }
                }
                if (needmask) {
#pragma unroll
                    for (int r = 0; r < 16; ++r) { const int kv = (r & 3) + 8 * (r >> 2); if (!(kv < kq)) p0[r] = 0.f; if (!(kv + 32 < kq)) p1[r] = 0.f; }
                }
                wdone = __all(A >= SB_THR);
            }
            if (MODE != 2) { float s = 0.f;
#pragma unroll
                for (int r = 0; r < 16; ++r) s += p0[r] + p1[r];
                l_reg += s; }
            u32x4 pw0, pw1, pw2, pw3;
            pw0 = (u32x4){cvtpk(p0[0], p0[1]), cvtpk(p0[2], p0[3]), cvtpk(p0[4], p0[5]), cvtpk(p0[6], p0[7])};
            pw1 = (u32x4){cvtpk(p0[8], p0[9]), cvtpk(p0[10], p0[11]), cvtpk(p0[12], p0[13]), cvtpk(p0[14], p0[15])};
            pw2 = (u32x4){cvtpk(p1[0], p1[1]), cvtpk(p1[2], p1[3]), cvtpk(p1[4], p1[5]), cvtpk(p1[6], p1[7])};
            pw3 = (u32x4){cvtpk(p1[8], p1[9]), cvtpk(p1[10], p1[11]), cvtpk(p1[12], p1[13]), cvtpk(p1[14], p1[15])};
            pv<ND>(o, vb0 + slot * KVSLOT, __builtin_bit_cast(bf16x8, pw0), __builtin_bit_cast(bf16x8, pw1), __builtin_bit_cast(bf16x8, pw2), __builtin_bit_cast(bf16x8, pw3));
        }
        if (MODE == 2) { if (lane == 0) flg[(i & 1) * 8 + wid] = wdone ? 1u : 0u; }
    }
#undef ATT_DMA
    float rl[16];
    if (MODE != 2) {
        l_reg += __shfl_xor(l_reg, 32);
        if (hi == 0) wsf[32 + r32] = l_reg;
        asm volatile("s_waitcnt lgkmcnt(0)" ::: "memory");
#pragma unroll
        for (int r = 0; r < 16; ++r) rl[r] = __builtin_amdgcn_rcpf(wsf[32 + crow(r, hi)]);
    } else {
#pragma unroll
        for (int r = 0; r < 16; ++r) rl[r] = 1.f;
    }
    bf16_t* Ow = Ob + (size_t)(q0 + wid * 32) * opitch;
    ALAS bf16_t* stg = (ALAS bf16_t*)(shm + L_OST) + wid * 2048;
#pragma unroll
    for (int half = 0; half < ND / 2; ++half) {
#pragma unroll
        for (int r = 0; r < 16; ++r) { const int orow = crow(r, hi);
#pragma unroll
            for (int d0 = 0; d0 < 2; ++d0) stg[orow * 64 + d0 * 32 + r32] = f2bf(o[half * 2 + d0][r] * rl[r]); }
        asm volatile("s_waitcnt lgkmcnt(0)" ::: "memory");
#pragma unroll
        for (int i = 0; i < 4; ++i) { const int row = i * 8 + (lane >> 3), ch = lane & 7; const u32x4 v = *(const ALAS u32x4*)(stg + row * 64 + ch * 8); *(u32x4*)(Ow + (size_t)row * opitch + half * 64 + ch * 8) = v; }
        asm volatile("s_waitcnt lgkmcnt(0)" ::: "memory");
    }
    asm volatile("s_waitcnt vmcnt(0) lgkmcnt(0)\n\ts_barrier" ::: "memory");
}
}

constexpr int NWAVES = 8, NTHR = NWAVES * 64;
constexpr int BATCH = 2, SEQ = 8192, T = BATCH * SEQ, D = 1024;
constexpr int NPROJ = 3072, FFD = 2816, FFE = 3584, NEXP = 8;
constexpr size_t MiB = 1u << 20;
constexpr size_t CTL_ZERO_BYTES = 1 * MiB;
constexpr int CW_TMO = 0, CW_BAR = 4096;
constexpr int CW_HIST = 16384;
constexpr int CW_MOE = 24576;
constexpr size_t WS_SS0 = 1 * MiB, WS_SS3 = WS_SS0 + 65536, WS_ROPE = WS_SS3 + 65536  , WS_TOKSEL = WS_ROPE + MiB  ,
                 WS_TOKGATE = WS_TOKSEL + 65536  , WS_ROWTOK = WS_TOKGATE + 131072  , WS_ROWGATE = WS_ROWTOK + 147456  ;
static_assert(WS_ROWGATE + 147456 <= 4 * MiB, "small arrays");
constexpr size_t WS_XB = 4 * MiB;
constexpr size_t WS_AO = 36 * MiB;
constexpr size_t WS_ACT0 = 68 * MiB;
constexpr size_t WS_XF = 164 * MiB;
constexpr size_t WS_WIN = 228 * MiB, WS_WO0 = 234 * MiB, WS_WGU0 = 236 * MiB, WS_WD0 = 247 * MiB, WS_WQKV = 253 * MiB, WS_WO1 = 259 * MiB;
constexpr size_t WS_WEGU = 264 * MiB;
constexpr size_t WS_WED = 376 * MiB;
constexpr size_t WS_SS1 = 432 * MiB, WS_SS2 = 433 * MiB;
constexpr size_t WS_END = 434 * MiB;
constexpr size_t WS_SORTA = 36 * MiB;
constexpr size_t WS_ACTE = 108 * MiB;
static_assert(WS_SORTA + (size_t)36864 * 2048 <= WS_ACTE && WS_ACTE + (size_t)18432 * 7168 <= WS_WO0 && WS_WD0 + (size_t)1024 * 2816 * 2 <= WS_WQKV && WS_WO1 + 2 * MiB <= WS_WEGU, "ws map");
constexpr int RING_BYTES = 131072, MISC_OFF = RING_BYTES + 320, LDS_BYTES = 147456;
static_assert(att::L_END <= RING_BYTES, "attention LDS");

#define GAS __attribute__((address_space(1)))
#define LAS __attribute__((address_space(3)))
typedef unsigned short bf16;
typedef unsigned v4u __attribute__((ext_vector_type(4)));
typedef float f32x4 __attribute__((ext_vector_type(4)));
typedef GAS unsigned gu32;
#define RLX_AGENT __ATOMIC_RELAXED, __HIP_MEMORY_SCOPE_AGENT
#define LDS_WAIT() asm volatile("s_waitcnt lgkmcnt(0)" ::: "memory")
#define VM_WAIT() asm volatile("s_waitcnt vmcnt(0)" ::: "memory")
__device__ __forceinline__ unsigned f2bf(float f) { unsigned u = __builtin_bit_cast(unsigned, f); return (u + 0x7fffu + ((u >> 16) & 1u)) >> 16; }
__device__ __forceinline__ unsigned pk2(float lo, float hi) { return f2bf(lo) | (f2bf(hi) << 16); }
__device__ __forceinline__ float bf2f(unsigned short h) { return __builtin_bit_cast(float, (unsigned)h << 16); }
#define XB_TMO      128
#define XB_XCNT(j)  (256  + 64 * (j))
#define XB_XSUB(j)  (1280 + 64 * (j))
#define XB_XGEN(j)  (2304 + 64 * (j))
#define XB_TOP      3328
#define XB_TOPGEN   3392
#define XCD_BAR_WORDS 3456
#define XB_SPIN_CAP (1u << 18)

__device__ __forceinline__ unsigned xb_ld(unsigned* p)              { return __hip_atomic_load(p, __ATOMIC_RELAXED, __HIP_MEMORY_SCOPE_AGENT); }
__device__ __forceinline__ unsigned xb_add(unsigned* p, unsigned v) { return __hip_atomic_fetch_add(p, v, __ATOMIC_RELAXED, __HIP_MEMORY_SCOPE_AGENT); }
__device__ __forceinline__ unsigned xb_xcc_id() { return (unsigned)__builtin_amdgcn_s_getreg((3 << 11) | 20) & 0xFu; }
#define XB_SPIN(cond, bar) do { unsigned _sp = 0; while (cond) { __builtin_amdgcn_s_sleep(1); \
    if ((++_sp & 255u) == 0u) { if (xb_ld(&(bar)[XB_TMO])) break; if (_sp > XB_SPIN_CAP) { atomicAdd(&(bar)[XB_TMO], 1u); break; } } } } while (0)

struct XcdBarrier {
    unsigned* bar; unsigned x;
    volatile LAS unsigned* st;
};

__device__ __forceinline__ XcdBarrier xcd_barrier_post(unsigned* bar, volatile LAS unsigned* st) {
    XcdBarrier b; b.bar = bar; b.x = xb_xcc_id(); b.st = st;
    if (threadIdx.x == 0) (void)xb_add(&bar[XB_XCNT(b.x)], 1u);
    return b;
}
__device__ __forceinline__ void xcd_barrier_complete(unsigned* bar, unsigned x, unsigned& nloc, unsigned& nx) {
    const unsigned G = gridDim.x * gridDim.y * gridDim.z;
    unsigned sum, cnt, mine, sp = 0u;
    for (;;) {
        sum = 0u; cnt = 0u; mine = 0u;
#pragma unroll
        for (unsigned j = 0; j < 16; ++j) { const unsigned c = xb_ld(&bar[XB_XCNT(j)]); sum += c; cnt += (c > 0u) ? 1u : 0u; mine = (j == x) ? c : mine; }
        if (sum == G) break;
        __builtin_amdgcn_s_sleep(1);
        if ((++sp & 255u) == 0u) { if (xb_ld(&bar[XB_TMO])) break; if (sp > XB_SPIN_CAP) { atomicAdd(&bar[XB_TMO], 1u); break; } }
    }
    nloc = mine > 0u ? mine : 1u; nx = cnt > 0u ? cnt : 1u;
}

__device__ __forceinline__ void xcd_barrier(const XcdBarrier& b) {
    asm volatile("s_waitcnt vmcnt(0)" ::: "memory");
    __syncthreads();
    if (threadIdx.x == 0) {
        unsigned* bar = b.bar;
        __builtin_amdgcn_s_waitcnt(0);
        unsigned nloc = b.st[0], nx = b.st[1];
        if (nloc == 0u) { xcd_barrier_complete(bar, b.x, nloc, nx); b.st[0] = nloc; b.st[1] = nx; }
        const unsigned old = xb_add(&bar[XB_XSUB(b.x)], 1u);
        const unsigned gen = old / nloc;
        if (old + 1u == (gen + 1u) * nloc) {
            __builtin_amdgcn_fence(__ATOMIC_RELEASE, "agent");
            asm volatile("s_waitcnt vmcnt(0)" ::: "memory");
            const unsigned og = xb_add(&bar[XB_TOP], 1u);
            const unsigned tg = og / nx;
            if (og + 1u == (tg + 1u) * nx) xb_add(&bar[XB_TOPGEN], 1u);
            else XB_SPIN(xb_ld(&bar[XB_TOPGEN]) == tg, bar);
            __builtin_amdgcn_fence(__ATOMIC_ACQUIRE, "agent");
            xb_add(&bar[XB_XGEN(b.x)], 1u);
            asm volatile("s_waitcnt vmcnt(0)" ::: "memory");
        } else {
            XB_SPIN(xb_ld(&bar[XB_XGEN(b.x)]) == gen, bar);
            __builtin_amdgcn_fence(__ATOMIC_ACQUIRE, "agent");
            asm volatile("s_waitcnt vmcnt(0)" ::: "memory");
        }
    }
    __syncthreads();
}

__device__ __forceinline__ float wave_sum(float v) {
#pragma unroll
    for (int o = 1; o < 64; o <<= 1) v += __shfl_xor(v, o);
    return v;
}
__device__ __forceinline__ float wave_max(float v) {
#pragma unroll
    for (int o = 1; o < 64; o <<= 1) v = fmaxf(v, __shfl_xor(v, o));
    return v;
}
__device__ __forceinline__ int dest_block(int blk, int map) {
    if (map == 1) { const int s = blk & 7; return (blk & ~7) + 4 * (s & 1) + (s >> 1); }
    if (map == 2) return (blk >> 2) * 8 + (blk & 3);
    if (map == 3) return (blk >> 2) * 8 + 4 + (blk & 3);
    return blk;
}
__device__ __forceinline__ void tr_tile(const float* W, int K, int N, bf16* WT, int map, const float* gain, LAS unsigned* scr, int item, int lane) {
    const int nblk = N / 64, kb = item / nblk, nb = item % nblk, k0 = 64 * kb, n0 = 64 * nb;
    const int c = lane & 15, ip = lane >> 4;
#pragma unroll
    for (int it = 0; it < 8; ++it) { const int kp = it * 4 + ip, k = k0 + 2 * kp;
        f32x4 a = *(const GAS f32x4*)(W + (size_t)k * N + n0 + 4 * c), b = *(const GAS f32x4*)(W + (size_t)(k + 1) * N + n0 + 4 * c);
        if (gain) { a = a * gain[k]; b = b * gain[k + 1]; }
#pragma unroll
        for (int j = 0; j < 4; ++j) scr[(4 * c + j) * 33 + kp] = pk2(a[j], b[j]); }
    LDS_WAIT(); asm volatile("" ::: "memory");
#pragma unroll
    for (int it = 0; it < 8; ++it) { const int n = it * 8 + (lane >> 3), q = lane & 7;
        v4u o; o.x = scr[n * 33 + 4 * q]; o.y = scr[n * 33 + 4 * q + 1]; o.z = scr[n * 33 + 4 * q + 2]; o.w = scr[n * 33 + 4 * q + 3];
        const int drow = dest_block((n0 + n) >> 5, map) * 32 + (n & 31);
        *(GAS v4u*)(WT + (size_t)drow * K + k0 + 8 * q) = o; }
    LDS_WAIT(); asm volatile("" ::: "memory");
}

__device__ __forceinline__ void tr_tile8(const float* W, int K, int N, unsigned char* WT, int map, const float* gain, float wscale, LAS unsigned* scr, int item, int lane) {
    const int nblk = N / 64, kb = item / nblk, nb = item % nblk, k0 = 64 * kb, n0 = 64 * nb;
    const int c = lane & 15, ip = lane >> 4;
#pragma unroll
    for (int it = 0; it < 4; ++it) { const int k4 = it * 4 + ip, k = k0 + 4 * k4; f32x4 a[4];
#pragma unroll
        for (int i = 0; i < 4; ++i) a[i] = *(const GAS f32x4*)(W + (size_t)(k + i) * N + n0 + 4 * c) * ((gain ? gain[k + i] : 1.f) * wscale);
#pragma unroll
        for (int j = 0; j < 4; ++j) scr[(4 * c + j) * 17 + k4] = pg8::pk4_fp8(a[0][j], a[1][j], a[2][j], a[3][j]); }
    LDS_WAIT(); asm volatile("" ::: "memory");
#pragma unroll
    for (int it = 0; it < 4; ++it) { const int n = it * 16 + (lane >> 2), q = lane & 3;
        v4u o; o.x = scr[n * 17 + 4 * q]; o.y = scr[n * 17 + 4 * q + 1]; o.z = scr[n * 17 + 4 * q + 2]; o.w = scr[n * 17 + 4 * q + 3];
        const int drow = dest_block((n0 + n) >> 5, map) * 32 + (n & 31);
        *(GAS v4u*)(WT + (size_t)drow * K + k0 + 16 * q) = o; }
    LDS_WAIT(); asm volatile("" ::: "memory");
}
constexpr float W8_SCALE = 64.f;

#ifndef PROBE_MASK
#define PROBE_MASK 0
#endif
struct KArgs { const void* in[27]; float* out; unsigned char* ws; int ph_lo, ph_hi; };

__global__ void __launch_bounds__(NTHR, 2) fwd_kernel(KArgs args) {
    extern __shared__ __attribute__((aligned(16))) unsigned char lds_raw[];
    LAS unsigned char* lds = (LAS unsigned char*)lds_raw;
    volatile LAS unsigned* MISC = (volatile LAS unsigned*)(lds + MISC_OFF);
    const int tid = threadIdx.x, lane = tid & 63, wave = __builtin_amdgcn_readfirstlane(tid >> 6);
    const int G = gridDim.x; const int bx = blockIdx.x; const int vcu = (G % 8 == 0) ? (bx % 8) * (G / 8) + bx / 8 : bx;
    unsigned char* ws = args.ws;
    unsigned* ctl = (unsigned*)ws;
    for (int u = tid; u < (LDS_BYTES - RING_BYTES) / 4; u += NTHR) ((LAS unsigned*)(lds + RING_BYTES))[u] = 0u;
    __syncthreads();
    XcdBarrier bar = xcd_barrier_post(ctl + CW_BAR, MISC + 8);
    const int lo = args.ph_lo, hi_ph = args.ph_hi;
#define IN(k) (lo <= (k) && (k) < hi_ph)
#define REP(k)
#define SEAM(k) do { if (IN(k) && IN((k) + 1)) xcd_barrier(bar); } while (0)
    const float* x_in = (const float*)args.in[0]; const int* positions = (const int*)args.in[1];
    const float* ev_attn_norm = (const float*)args.in[2]; const float* ev_w_in = (const float*)args.in[3];
    const float* ev_q_norm = (const float*)args.in[4]; const float* ev_k_norm = (const float*)args.in[5];
    const float* ev_lq1 = (const float*)args.in[6]; const float* ev_lk1 = (const float*)args.in[7]; const float* ev_lq2 = (const float*)args.in[8]; const float* ev_lk2 = (const float*)args.in[9];
    const float* ev_subln = (const float*)args.in[10]; const float* ev_w_out = (const float*)args.in[11]; const float* ev_ffn_norm = (const float*)args.in[12];
    const float* ev_w_gate = (const float*)args.in[13]; const float* ev_w_up = (const float*)args.in[14]; const float* ev_w_down = (const float*)args.in[15];
    const float* od_attn_norm = (const float*)args.in[16]; const float* od_w_qkv = (const float*)args.in[17];
    const float* od_q_norm = (const float*)args.in[18]; const float* od_k_norm = (const float*)args.in[19]; const float* od_rel_bias = (const float*)args.in[20];
    const float* od_w_out = (const float*)args.in[21]; const float* od_ffn_norm = (const float*)args.in[22]; const float* od_router = (const float*)args.in[23];
    const float* od_we_gate = (const float*)args.in[24]; const float* od_we_up = (const float*)args.in[25]; const float* od_we_down = (const float*)args.in[26];
    float* out = args.out;
    float* ss0 = (float*)(ws + WS_SS0); float* ss1 = (float*)(ws + WS_SS1); float* ss2 = (float*)(ws + WS_SS2); float* ss3 = (float*)(ws + WS_SS3);
    float* rope = (float*)(ws + WS_ROPE); unsigned* toksel = (unsigned*)(ws + WS_TOKSEL); float* tokgate = (float*)(ws + WS_TOKGATE);
    int* rowtok = (int*)(ws + WS_ROWTOK); float* rowgate = (float*)(ws + WS_ROWGATE);
    bf16* XB = (bf16*)(ws + WS_XB); bf16* AO = (bf16*)(ws + WS_AO); bf16* ACT0 = (bf16*)(ws + WS_ACT0); float* XF = (float*)(ws + WS_XF); bf16* OD = (bf16*)(ws + WS_XF);
    bf16* Win_t = (bf16*)(ws + WS_WIN); bf16* Wo0_t = (bf16*)(ws + WS_WO0); bf16* Wgu0_t = (bf16*)(ws + WS_WGU0); bf16* Wd0_t = (bf16*)(ws + WS_WD0);
    bf16* Wqkv_t = (bf16*)(ws + WS_WQKV); bf16* Wo1_t = (bf16*)(ws + WS_WO1); unsigned char* WEgu8 = ws + WS_WEGU; unsigned char* WEd8 = ws + WS_WED;
    unsigned char* SORTA8 = ws + WS_SORTA; unsigned char* ACTE8 = ws + WS_ACTE;
    const int gw = vcu * NWAVES + wave, NGW = G * NWAVES;

    REP(0) if (IN(0)) {
        LAS unsigned* scr = (LAS unsigned*)(lds + wave * 8704);
        constexpr int I_IN = 16 * 48, I_O = 16 * 16, I_G = 16 * 44, I_D = 44 * 16, I_EG = 16 * 56, I_ED = 56 * 16;
        constexpr int NSMALL = I_IN + I_O + 2 * I_G + I_D + I_IN + I_O, NITEMS = NSMALL + 24 * I_EG;
        for (int it = gw; it < NITEMS; it += NGW) {
            int r = it;
            if (r < I_IN) { tr_tile(ev_w_in, D, NPROJ, Win_t, 1, ev_attn_norm, scr, r, lane); continue; } r -= I_IN;
            if (r < I_O) { tr_tile(ev_w_out, D, D, Wo0_t, 0, nullptr, scr, r, lane); continue; } r -= I_O;
            if (r < I_G) { tr_tile(ev_w_gate, D, FFD, Wgu0_t, 2, ev_ffn_norm, scr, r, lane); continue; } r -= I_G;
            if (r < I_G) { tr_tile(ev_w_up, D, FFD, Wgu0_t, 3, ev_ffn_norm, scr, r, lane); continue; } r -= I_G;
            if (r < I_D) { tr_tile(ev_w_down, FFD, D, Wd0_t, 0, nullptr, scr, r, lane); continue; } r -= I_D;
            if (r < I_IN) { tr_tile(od_w_qkv, D, NPROJ, Wqkv_t, 1, od_attn_norm, scr, r, lane); continue; } r -= I_IN;
            if (r < I_O) { tr_tile(od_w_out, D, D, Wo1_t, 0, nullptr, scr, r, lane); continue; } r -= I_O;
            const int which = r / (8 * I_EG), rr = r % (8 * I_EG), e = rr / I_EG, item = rr % I_EG;
            if (which == 0) tr_tile8(od_we_gate + (size_t)e * D * FFE, D, FFE, WEgu8 + (size_t)e * 2 * FFE * D, 2, od_ffn_norm, W8_SCALE, scr, item, lane);
            else if (which == 1) tr_tile8(od_we_up + (size_t)e * D * FFE, D, FFE, WEgu8 + (size_t)e * 2 * FFE * D, 3, od_ffn_norm, W8_SCALE, scr, item, lane);
            else tr_tile8(od_we_down + (size_t)e * FFE * D, FFE, D, WEd8 + (size_t)e * D * FFE, 0, nullptr, W8_SCALE, scr, item, lane);
        }
        for (int m = gw; m < T; m += NGW) {
            const GAS f32x4* xr = (const GAS f32x4*)(x_in + (size_t)m * D) + lane; f32x4 v[4]; float s = 0.f;
#pragma unroll
            for (int j = 0; j < 4; ++j) { v[j] = xr[64 * j]; s += (v[j].x * v[j].x + v[j].y * v[j].y) + (v[j].z * v[j].z + v[j].w * v[j].w); }
            s = wave_sum(s); if (lane == 0) ss0[m] = s;
            GAS unsigned long long* o8 = (GAS unsigned long long*)(XB + (size_t)m * D) + lane;
#pragma unroll
            for (int j = 0; j < 4; ++j) o8[64 * j] = (unsigned long long)pk2(v[j].x, v[j].y) | ((unsigned long long)pk2(v[j].z, v[j].w) << 32);
        }
        for (int i = vcu * NTHR + tid; i < T * 8; i += G * NTHR) {
            const int tok = i >> 3, f = i & 7;
            const double inv = exp2(-(double)f * (18.931568569324174 / 8.0));
            double ang = (double)positions[tok] * inv; ang -= 6.283185307179586 * rint(ang * 0.15915494309189535);
            float sn, cs; sincosf((float)ang, &sn, &cs);
            rope[(size_t)tok * 16 + f] = cs; rope[(size_t)tok * 16 + 8 + f] = sn;
        }
    }
    SEAM(0);

    REP(1) if (IN(1)) {
        pg8::Gemm g{XB, Win_t, T, NPROJ, D}; pg8::StaticOrder S; S.init(T, NPROJ, G, bx);
        pg8::EpiProj E{ACT0, NPROJ, ss0, 1, ev_q_norm, ev_k_norm, rope, 0};
        pg8::gemm_phase<pg8::EpiProj, pg8::StaticOrder, true, true>(lds, g, S, E);
    }
    SEAM(1);

    REP(2) if (IN(2)) {
        const float gqm = wave_max(fabsf(ev_q_norm[lane])), gkm = wave_max(fabsf(ev_k_norm[lane]));
        const float mref = 8.f * gqm * gkm * pg8::LOG2E;
        for (int L = vcu; L < 512; L += G) {
            const int bhm = (L & 255) >> 4, qb = (L < 256) ? (L & 15) : 31 - (L & 15);
            const int b = bhm >> 3, hm = bhm & 7, h = hm >> 1;
            const bf16* base = ACT0 + (size_t)b * SEQ * NPROJ;
            att::attn_unit<0, 128>((LAS char*)lds, base + 1536 + hm * 64, base + 2048 + hm * 64, base + 2560 + h * 128, OD + (size_t)b * SEQ * D + hm * 128, D, qb * 256, mref, nullptr);
        }
        for (int L = vcu; L < 512; L += G) {
            const int bh = (L & 255) >> 4, qb = 2 * (L & 15) + (L >> 8);
            const int b = bh >> 3, h = bh & 7;
            const bf16* base = ACT0 + (size_t)b * SEQ * NPROJ;
            att::attn_unit<2, 64>((LAS char*)lds, base + h * 64, base + 512 + h * 64, base + 1024 + h * 64, AO + (size_t)b * SEQ * D + h * 64, D, qb * 256, 0.f, nullptr);
        }
    }
    SEAM(2);

    REP(3) if (IN(3)) {
        const float a1 = wave_sum(ev_lq1[lane] * ev_lk1[lane]), a2 = wave_sum(ev_lq2[lane] * ev_lk2[lane]);
        const float lam_init = 0.2f, lam = expf(a1) - expf(a2) + lam_init;
        const int h = lane >> 4, v0 = (lane & 15) * 8;
        float sg[8];
#pragma unroll
        for (int j = 0; j < 8; ++j) sg[j] = ev_subln[v0 + j] * (1.f - lam_init);
        for (int m = gw; m < T; m += NGW) {
            const v4u a = *(const GAS v4u*)(OD + (size_t)m * D + (2 * h) * 128 + v0), b = *(const GAS v4u*)(OD + (size_t)m * D + (2 * h + 1) * 128 + v0);
            float d[8]; float s = 0.f;
#pragma unroll
            for (int j = 0; j < 4; ++j) { const unsigned ua = a[j], ub = b[j];
                d[2 * j] = bf2f((unsigned short)(ua & 0xffffu)) - lam * bf2f((unsigned short)(ub & 0xffffu));
                d[2 * j + 1] = bf2f((unsigned short)(ua >> 16)) - lam * bf2f((unsigned short)(ub >> 16));
                s += d[2 * j] * d[2 * j] + d[2 * j + 1] * d[2 * j + 1]; }
            s += __shfl_xor(s, 1); s += __shfl_xor(s, 2); s += __shfl_xor(s, 4); s += __shfl_xor(s, 8);
            const float rs = rsqrtf(s * (1.f / 128.f) + pg8::RMS_EPS);
            v4u o; o.x = pk2(d[0] * rs * sg[0], d[1] * rs * sg[1]); o.y = pk2(d[2] * rs * sg[2], d[3] * rs * sg[3]); o.z = pk2(d[4] * rs * sg[4], d[5] * rs * sg[5]); o.w = pk2(d[6] * rs * sg[6], d[7] * rs * sg[7]);
            *(GAS v4u*)(AO + (size_t)m * D + 512 + h * 128 + v0) = o;
        }
    }
    SEAM(3);

    REP(4) if (IN(4)) {
        pg8::Gemm g{AO, Wo0_t, T, D, D}; pg8::StaticOrder S; S.init(T, D, G, bx);
        pg8::EpiResid E{x_in, XF, XB, ss1};
        pg8::gemm_phase<pg8::EpiResid, pg8::StaticOrder, false, true>(lds, g, S, E);
    }
    SEAM(4);

    REP(5) if (IN(5)) {
        pg8::Gemm g{XB, Wgu0_t, T, 2 * FFD, D}; pg8::StaticOrder S; S.init(T, 2 * FFD, G, bx);
        pg8::EpiSwiglu<false> E{ACT0, FFD, ss1, 16, nullptr, 0, 2 * FFD / 256, 1.f};
        pg8::gemm_phase<pg8::EpiSwiglu<false>, pg8::StaticOrder, true, true>(lds, g, S, E);
    }
    SEAM(5);

    if (IN(6)) {
        pg8::Gemm g{ACT0, Wd0_t, T, D, FFD}; pg8::StaticOrder S; S.init(T, D, G, bx);
        pg8::EpiResid E{XF, XF, XB, ss2};
        pg8::gemm_phase<pg8::EpiResid, pg8::StaticOrder, false, true>(lds, g, S, E);
    }
    SEAM(6);

    REP(7) if (IN(7)) {
        pg8::Gemm g{XB, Wqkv_t, T, NPROJ, D}; pg8::StaticOrder S; S.init(T, NPROJ, G, bx);
        pg8::EpiProj E{ACT0, NPROJ, ss2, 16, od_q_norm, od_k_norm, nullptr, 1};
        pg8::gemm_phase<pg8::EpiProj, pg8::StaticOrder, true, true>(lds, g, S, E);
    }
    SEAM(7);

    REP(8) if (IN(8)) {
        const float gqm = wave_max(fabsf(od_q_norm[lane])), gkm = wave_max(fabsf(od_k_norm[lane]));
        for (int L = vcu; L < 1024; L += G) {
            const int bh = (L & 255) >> 3, qb = 4 * (L & 7) + (L >> 8);
            const int b = bh >> 4, h = bh & 15;
            const float* tab = od_rel_bias + h * 257;
            float tm = fabsf(tab[lane]); tm = fmaxf(tm, fabsf(tab[64 + lane])); tm = fmaxf(tm, fabsf(tab[128 + lane])); tm = fmaxf(tm, fabsf(tab[192 + lane])); tm = fmaxf(tm, fabsf(tab[256]));
            tm = wave_max(tm);
            const float mref = (8.f * gqm * gkm + tm) * pg8::LOG2E;
            const bf16* base = ACT0 + (size_t)b * SEQ * NPROJ;
            att::attn_unit<1, 64>((LAS char*)lds, base + h * 64, base + 1024 + h * 64, base + 2048 + h * 64, AO + (size_t)b * SEQ * D + h * 64, D, qb * 256, mref, tab);
        }
    }
    SEAM(8);

    REP(9) if (IN(9)) {
        pg8::Gemm g{AO, Wo1_t, T, D, D}; pg8::StaticOrder S; S.init(T, D, G, bx);
        pg8::EpiResid E{XF, out, nullptr, nullptr};
        pg8::gemm_phase<pg8::EpiResid, pg8::StaticOrder, false, true>(lds, g, S, E);
    }
    SEAM(9);

    REP(10) if (IN(10)) {
        LAS unsigned* sel = (LAS unsigned*)lds;
        for (int blk = vcu; blk < T / 64; blk += G) {
            for (int tl = wave; tl < 64; tl += NWAVES) {
                const int tok = blk * 64 + tl;
                const GAS f32x4* xr = (const GAS f32x4*)(out + (size_t)tok * D) + lane; float s = 0.f; float lg[8];
#pragma unroll
                for (int e = 0; e < 8; ++e) lg[e] = 0.f;
#pragma unroll
                for (int j = 0; j < 4; ++j) { const f32x4 v = xr[64 * j]; s += (v.x * v.x + v.y * v.y) + (v.z * v.z + v.w * v.w);
                    const int k0 = 4 * lane + 256 * j; const f32x4 gn = *(const GAS f32x4*)(od_ffn_norm + k0);
#pragma unroll
                    for (int i = 0; i < 4; ++i) { const float xv = v[i] * gn[i]; const f32x4 w0 = *(const GAS f32x4*)(od_router + (size_t)(k0 + i) * 8), w1 = *(const GAS f32x4*)(od_router + (size_t)(k0 + i) * 8 + 4);
                        lg[0] += xv * w0.x; lg[1] += xv * w0.y; lg[2] += xv * w0.z; lg[3] += xv * w0.w; lg[4] += xv * w1.x; lg[5] += xv * w1.y; lg[6] += xv * w1.z; lg[7] += xv * w1.w; } }
                s = wave_sum(s);
#pragma unroll
                for (int e = 0; e < 8; ++e) lg[e] = wave_sum(lg[e]);
                if (lane == 0) {
                    const float r = rsqrtf(s * (1.f / 1024.f) + pg8::RMS_EPS); ss3[tok] = s;
                    int e0 = 0; float v0 = lg[0];
#pragma unroll
                    for (int e = 1; e < 8; ++e) if (lg[e] > v0) { v0 = lg[e]; e0 = e; }
                    int e1 = -1; float v1 = 0.f;
#pragma unroll
                    for (int e = 0; e < 8; ++e) if (e != e0 && (e1 < 0 || lg[e] > v1)) { v1 = lg[e]; e1 = e; }
                    const float ex = expf((v1 - v0) * r), g0 = 1.f / (1.f + ex), g1 = ex / (1.f + ex);
                    sel[tl] = (unsigned)e0 | ((unsigned)e1 << 8); tokgate[2 * tok] = g0; tokgate[2 * tok + 1] = g1;
                }
            }
            __syncthreads();
            if (wave == 0) { const unsigned sv = sel[lane]; const int e0 = sv & 0xff, e1 = sv >> 8; unsigned rank0 = 0, rank1 = 0;
                const unsigned long long lt = (1ull << lane) - 1ull;
#pragma unroll
                for (int e = 0; e < 8; ++e) { const unsigned long long m0 = __ballot(e0 == e), m1 = __ballot(e1 == e);
                    if (e0 == e) rank0 = __popcll(m0 & lt); if (e1 == e) rank1 = __popcll(m1 & lt);
                    if (lane == 0) { ctl[CW_HIST + blk * 16 + e] = __popcll(m0); ctl[CW_HIST + blk * 16 + 8 + e] = __popcll(m1); } }
                toksel[blk * 64 + lane] = sv | (rank0 << 16) | (rank1 << 24); }
            __syncthreads();
        }
    }
    SEAM(10);

    REP(11) if (IN(11)) {
        LAS unsigned* hs = (LAS unsigned*)lds;
        for (int i = tid; i < 4096; i += NTHR) hs[i] = ctl[CW_HIST + i];
        __syncthreads();
        if (tid < 16) { unsigned s = 0; for (int b2 = 0; b2 < 256; ++b2) s += hs[b2 * 16 + tid]; hs[4096 + tid] = s; }
        __syncthreads();
        if (tid == 0) { unsigned acc = 0; for (int g2 = 0; g2 < 16; ++g2) { hs[4128 + g2] = acc; acc += (hs[4096 + g2] + 255u) & ~255u; } hs[4128 + 16] = acc; }
        __syncthreads();
        if (bx == 0) {
            if (tid == 0) { ctl[CW_MOE] = hs[4128 + 8] >> 8; ctl[CW_MOE + 1] = hs[4128 + 16] >> 8; }
            if (tid < 16) { const unsigned t0 = hs[4128 + tid] >> 8, t1 = hs[4128 + tid + 1] >> 8; for (unsigned t = t0; t < t1; ++t) ctl[CW_MOE + 16 + t] = tid & 7; }
        }
        for (int blk = vcu; blk < T / 64; blk += G) {
            if (tid < 16) { unsigned s = 0; for (int b2 = 0; b2 < blk; ++b2) s += hs[b2 * 16 + tid]; hs[4160 + tid] = s; }
            __syncthreads();
            for (int tl = wave; tl < 64; tl += NWAVES) {
                const int tok = blk * 64 + tl; const unsigned sv = toksel[tok];
                const GAS f32x4* xr = (const GAS f32x4*)(out + (size_t)tok * D + 16 * lane); const f32x4 v0 = xr[0], v1 = xr[1], v2 = xr[2], v3 = xr[3];
                v4u pk; pk.x = pg8::pk4_fp8(v0[0], v0[1], v0[2], v0[3]); pk.y = pg8::pk4_fp8(v1[0], v1[1], v1[2], v1[3]); pk.z = pg8::pk4_fp8(v2[0], v2[1], v2[2], v2[3]); pk.w = pg8::pk4_fp8(v3[0], v3[1], v3[2], v3[3]);
#pragma unroll
                for (int sl = 0; sl < 2; ++sl) { const int e = (sv >> (8 * sl)) & 0xff, rank = (sv >> (16 + 8 * sl)) & 0xff, g2 = sl * 8 + e;
                    const unsigned srow = hs[4128 + g2] + hs[4160 + g2] + rank;
                    *(GAS v4u*)(SORTA8 + (size_t)srow * D + lane * 16) = pk;
                    if (lane == 0) { rowtok[srow] = tok; rowgate[srow] = tokgate[2 * tok + sl]; } }
            }
            __syncthreads();
        }
        for (int g2 = vcu; g2 < 16; g2 += G) {
            const unsigned r0 = hs[4128 + g2] + hs[4096 + g2], r1 = hs[4128 + g2 + 1];
            for (unsigned r = r0 + wave; r < r1; r += NWAVES) { if (lane == 0) { rowtok[r] = -1; rowgate[r] = 0.f; }
                *(GAS v4u*)(SORTA8 + (size_t)r * D + lane * 16) = (v4u){0u, 0u, 0u, 0u}; }
        }
    }
    SEAM(11);

#define MOE_CHUNK(PH, CH) \
    REP(PH) if (IN(PH)) { const int nA = (int)__builtin_amdgcn_readfirstlane(ctl[CW_MOE]), nT = (int)__builtin_amdgcn_readfirstlane(ctl[CW_MOE + 1]); \
        const int tile0 = (CH) ? nA : 0, ntile = (CH) ? nT - nA : nA; \
        pg8::Gemm g{(const bf16*)(SORTA8 + (size_t)tile0 * 256 * D), (const bf16*)WEgu8, 0, 0, D / 2}; pg8::MoeOrder S; S.init(ntile, 2 * FFE / 256, G, bx, tile0, (const int*)(ctl + CW_MOE + 16)); \
        pg8::EpiSwiglu<true> E{ACTE8, FFE, ss3, 1, rowtok, tile0, 2 * FFE / 256, 1.f / W8_SCALE}; \
        pg8::gemm_phase<pg8::EpiSwiglu<true>, pg8::MoeOrder, true, true, true>(lds, g, S, E); } \
    SEAM(PH); \
    if (IN((PH) + 1)) { const int nA = (int)__builtin_amdgcn_readfirstlane(ctl[CW_MOE]), nT = (int)__builtin_amdgcn_readfirstlane(ctl[CW_MOE + 1]); \
        const int tile0 = (CH) ? nA : 0, ntile = (CH) ? nT - nA : nA; \
        pg8::Gemm g{(const bf16*)ACTE8, (const bf16*)WEd8, 0, 0, FFE / 2}; pg8::MoeOrder S; S.init(ntile, D / 256, G, bx, tile0, (const int*)(ctl + CW_MOE + 16)); \
        pg8::EpiMoeDown E{out, rowtok, rowgate, tile0, 1.f / W8_SCALE}; \
        pg8::gemm_phase<pg8::EpiMoeDown, pg8::MoeOrder, true, true, true>(lds, g, S, E); }
    MOE_CHUNK(12, 0)
    SEAM(13);
    MOE_CHUNK(14, 1)
#undef MOE_CHUNK
#undef IN
#undef SEAM
}

constexpr int N_PHASES = 16;
extern "C" void kernel_launch(void* const* d_in, const int* in_sizes, int n_in, void* d_out, int out_size, void* d_ws, size_t ws_size, hipStream_t stream) {
    static int grid = 0;
    if (grid == 0) {
        if (n_in != 27 || out_size != T * D || ws_size < WS_END) { fprintf(stderr, "kernel_launch: unexpected problem (n_in %d, out %d, ws %zu)\n", n_in, out_size, ws_size); grid = -1; return; }
        int dev = 0, cus = 0, per_cu = 0;
        if (hipGetDevice(&dev) != hipSuccess || hipDeviceGetAttribute(&cus, hipDeviceAttributeMultiprocessorCount, dev) != hipSuccess) { grid = -1; return; }
        if (hipFuncSetAttribute((const void*)fwd_kernel, hipFuncAttributeMaxDynamicSharedMemorySize, LDS_BYTES) != hipSuccess) { fprintf(stderr, "kernel_launch: hipFuncSetAttribute failed\n"); grid = -1; return; }
        if (hipOccupancyMaxActiveBlocksPerMultiprocessor(&per_cu, (const void*)fwd_kernel, NTHR, LDS_BYTES) != hipSuccess || per_cu < 1) { fprintf(stderr, "kernel_launch: occupancy query says %d\n", per_cu); }
        (void)hipGetLastError();
        grid = cus;
    }
    if (grid < 0) return;
    (void)hipMemsetAsync(d_ws, 0, CTL_ZERO_BYTES, stream);
    KArgs a{};
    for (int i = 0; i < 27; ++i) a.in[i] = d_in[i];
    a.out = (float*)d_out; a.ws = (unsigned char*)d_ws; a.ph_lo = 0; a.ph_hi = N_PHASES;
    hipLaunchKernelGGL(fwd_kernel, dim3(grid), dim3(NTHR), LDS_BYTES, stream, a);
}
```

```cpp
#include <hip/hip_runtime.h>
#include <cstdio>
#include <cstdint>
#include <cmath>
#define PROBE_MASK 0x0
namespace pg8 {
#define PG8_LAS __attribute__((address_space(3)))
typedef unsigned short bf16_t;
typedef short bf16x8 __attribute__((ext_vector_type(8)));
typedef float f32x4 __attribute__((ext_vector_type(4)));
typedef unsigned u32x4 __attribute__((ext_vector_type(4)));
constexpr int BM = 256, BK = 64, HALF = 128, HTB = HALF * BK * 2  , STAGE_BYTES = 8 * HTB, NXCD = 8, WGM = 8;

__host__ __device__ __forceinline__ int lds_byte(int r, int c) { const int st = (r >> 4) * 2 + (c >> 5), rr = r & 15, cc = c & 31, ob = rr * 64 + cc * 2; return st * 1024 + (ob ^ (((ob >> 9) & 1) << 5)); }
__host__ __device__ __forceinline__ void stage_rc(int b, int& R, int& C) { const int st = b / 1024, sb = b % 1024, swz = sb ^ (((sb >> 9) & 1) << 5); R = (st >> 1) * 16 + swz / 64; C = (st & 1) * 32 + (swz % 64) / 2; }
__host__ __device__ __forceinline__ int perm32(int rho) { const int n = rho >> 4, i = rho & 15; return 8 * (i >> 2) + 4 * n + (i & 3); }

struct Unit { int pm, pn; };
struct Gemm { const bf16_t* A; const bf16_t* Bt; int M, N, K; };

struct StaticOrder {
    int nM, nN, nwg, G, c;
    __host__ __device__ void init(int M, int N, int G_, int c_) { nM = M / BM; nN = N / BM; nwg = nM * nN; G = G_; c = c_; }
    __host__ __device__ bool next(int i, Unit& u) const {
        const long L = (long)i * G + c; if (L >= nwg) return false;
        int wgid = (int)L; { const int q = nwg / NXCD, r = nwg % NXCD, xcd = wgid % NXCD, off = wgid / NXCD; wgid = (xcd < r ? xcd * (q + 1) : r * (q + 1) + (xcd - r) * q) + off; }
        const int nig = WGM * nN, gid = wgid / nig, fm = gid * WGM, gsz = (nM - fm) < WGM ? (nM - fm) : WGM;
        u.pm = fm + ((wgid % nig) % gsz); u.pn = (wgid % nig) / gsz; return true;
    }
    __device__ __forceinline__ void a_ready(const Unit&) const {}
    __device__ __forceinline__ void done(const Unit&) const {}
};

struct MoeOrder {
    int nM, nN, nwg, G, c, tile0; const int* tile_expert;
    __device__ void init(int ntiles, int npn, int G_, int c_, int tile0_, const int* te) { nM = ntiles; nN = npn; nwg = nM * nN; G = G_; c = c_; tile0 = tile0_; tile_expert = te; }
    __device__ bool next(int i, Unit& u) const {
        const long L = (long)i * G + c; if (L >= nwg) return false;
        int wgid = (int)L; { const int q = nwg / NXCD, r = nwg % NXCD, xcd = wgid % NXCD, off = wgid / NXCD; wgid = (xcd < r ? xcd * (q + 1) : r * (q + 1) + (xcd - r) * q) + off; }
        const int nig = WGM * nN, gid = wgid / nig, fm = gid * WGM, gsz = (nM - fm) < WGM ? (nM - fm) : WGM;
        u.pm = fm + ((wgid % nig) % gsz); const int pnl = (wgid % nig) / gsz;
        const int e = __builtin_amdgcn_readfirstlane(tile_expert[tile0 + u.pm]);
        u.pn = e * nN + pnl; return true;
    }
    __device__ __forceinline__ void a_ready(const Unit&) const {}
    __device__ __forceinline__ void done(const Unit&) const {}
};

__device__ __forceinline__ unsigned cvt_pk_bf16(float lo, float hi) { unsigned r; asm volatile("v_cvt_pk_bf16_f32 %0, %1, %2" : "=v"(r) : "v"(lo), "v"(hi)); return r; }
__device__ __forceinline__ u32x4 pack8(const f32x4& a, const f32x4& b) { u32x4 w; w.x = cvt_pk_bf16(a[0], a[1]); w.y = cvt_pk_bf16(a[2], a[3]); w.z = cvt_pk_bf16(b[0], b[1]); w.w = cvt_pk_bf16(b[2], b[3]); return w; }
__device__ __forceinline__ unsigned pk4_fp8(float a, float b, float c, float d) { int w = __builtin_amdgcn_cvt_pk_fp8_f32(a, b, 0, false); w = __builtin_amdgcn_cvt_pk_fp8_f32(c, d, w, true); return (unsigned)w; }
constexpr float RMS_EPS = 1e-6f;
constexpr float LOG2E = 1.4426950408889634f;
constexpr float C2 = 0.125f * LOG2E;
__device__ __forceinline__ float row_ss(const float* ss, int nparts, int row) {
    if (nparts == 1) return ss[row];
    const f32x4* p = (const f32x4*)(ss + (size_t)row * 16); f32x4 a = p[0], b = p[1], c = p[2], d = p[3]; a = (a + b) + (c + d); return (a[0] + a[1]) + (a[2] + a[3]);
}

struct EpiProj {
    static constexpr bool PERM = true, AFTER_DRAIN = false;
    bf16_t* O; int ldc; const float* ss; int nparts; const float* gq; const float* gk; const float* rope; int layer; float pre;
    __device__ __forceinline__ void operator()(const f32x4 (&acc)[2][2][4][2], const Unit& u, int wr, int wc, int fr, int fq) const {
        const int pn = u.pn; int kind = 0; float scale = 1.f; bool rope_on = false;
        if (layer == 0) { const int t = pn >> 1; if (t == 0) scale = C2; else if (t == 3) { kind = 1; scale = C2; rope_on = true; } else if (t == 4) { kind = 2; rope_on = true; } }
        else { const int t = pn >> 2; if (t == 0) { kind = 1; scale = C2; } else if (t == 1) kind = 2; }
        const float* gv = (kind == 1) ? gq : gk;
        f32x4 g[2][2];
#pragma unroll
        for (int bj = 0; bj < 2; ++bj)
#pragma unroll
            for (int n = 0; n < 2; ++n) g[bj][n] = kind ? *(const f32x4*)(gv + 32 * bj + 8 * fq + 4 * n) : (f32x4){1.f, 1.f, 1.f, 1.f};
        const int row0 = u.pm * BM + wr * 64 + fr, col0 = pn * BM + wc * 64 + 8 * fq;
#pragma unroll
        for (int ai = 0; ai < 2; ++ai)
#pragma unroll
            for (int m = 0; m < 4; ++m) {
                const int row = row0 + ai * HALF + m * 16;
                const float r = rsqrtf(row_ss(ss, nparts, row) * (1.f / 1024.f) + RMS_EPS) * pre;
                f32x4 v[2][2]; float s = 0.f;
#pragma unroll
                for (int bj = 0; bj < 2; ++bj)
#pragma unroll
                    for (int n = 0; n < 2; ++n) { v[bj][n] = acc[ai][bj][m][n] * r; const f32x4 x = v[bj][n]; s += (x[0] * x[0] + x[1] * x[1]) + (x[2] * x[2] + x[3] * x[3]); }
                if (kind) {
                    s += __shfl_xor(s, 16); s += __shfl_xor(s, 32);
                    const float rs = rsqrtf(s * (1.f / 64.f) + RMS_EPS);
#pragma unroll
                    for (int bj = 0; bj < 2; ++bj)
#pragma unroll
                        for (int n = 0; n < 2; ++n) v[bj][n] = v[bj][n] * rs * g[bj][n];
                    if (rope_on) {
                        f32x4 p[2];
#pragma unroll
                        for (int n = 0; n < 2; ++n)
#pragma unroll
                            for (int j = 0; j < 4; ++j) p[n][j] = __shfl_xor(v[0][n][j], 16);
                        const f32x4 c0 = *(const f32x4*)(rope + (size_t)row * 16), c1 = *(const f32x4*)(rope + (size_t)row * 16 + 4);
                        const f32x4 s0 = *(const f32x4*)(rope + (size_t)row * 16 + 8), s1 = *(const f32x4*)(rope + (size_t)row * 16 + 12);
                        if (fq == 0) { v[0][0] = v[0][0] * c0 - p[0] * s0; v[0][1] = v[0][1] * c1 - p[1] * s1; }
                        else if (fq == 1) { v[0][0] = v[0][0] * c0 + p[0] * s0; v[0][1] = v[0][1] * c1 + p[1] * s1; }
                    }
                }
                bf16_t* rowp = O + (size_t)row * ldc + col0;
#pragma unroll
                for (int bj = 0; bj < 2; ++bj) *(u32x4*)(rowp + 32 * bj) = pack8(v[bj][0] * scale, v[bj][1] * scale);
            }
    }
};

struct EpiResid {
    static constexpr bool PERM = true, AFTER_DRAIN = false;
    const float* base; float* out; bf16_t* xb; float* ss; float pre; unsigned char* x8;
    __device__ __forceinline__ void operator()(const f32x4 (&acc)[2][2][4][2], const Unit& u, int wr, int wc, int fr, int fq) const {
        const int row0 = u.pm * BM + wr * 64 + fr, col0 = u.pn * BM + wc * 32 + 8 * fq;
#pragma unroll
        for (int ai = 0; ai < 2; ++ai)
#pragma unroll
            for (int m = 0; m < 4; ++m) {
                const int row = row0 + ai * HALF + m * 16; float s = 0.f;
#pragma unroll
                for (int bj = 0; bj < 2; ++bj) {
                    const size_t off = (size_t)row * 1024 + col0 + bj * HALF;
                    const f32x4 v0 = acc[ai][bj][m][0] * pre + *(const f32x4*)(base + off), v1 = acc[ai][bj][m][1] * pre + *(const f32x4*)(base + off + 4);
                    *(f32x4*)(out + off) = v0; *(f32x4*)(out + off + 4) = v1;
                    if (xb) *(u32x4*)(xb + off) = pack8(v0, v1);
                    if (x8) { typedef unsigned u32x2 __attribute__((ext_vector_type(2))); u32x2 w8; w8.x = pk4_fp8(v0[0], v0[1], v0[2], v0[3]); w8.y = pk4_fp8(v1[0], v1[1], v1[2], v1[3]); *(u32x2*)(x8 + off) = w8; }
                    s += (v0[0] * v0[0] + v0[1] * v0[1]) + (v0[2] * v0[2] + v0[3] * v0[3]) + (v1[0] * v1[0] + v1[1] * v1[1]) + (v1[2] * v1[2] + v1[3] * v1[3]);
                }
                if (ss) { s += __shfl_xor(s, 16); s += __shfl_xor(s, 32); if (fq == 0) ss[(size_t)row * 16 + u.pn * 4 + wc] = s; }
            }
    }
};

template <bool OUT8> struct EpiSwiglu {
    static constexpr bool PERM = true, AFTER_DRAIN = false;
    void* O; int ldc; const float* ss; int nparts; const int* rowtok; int tile0; int npn; float pre;
    __device__ __forceinline__ void operator()(const f32x4 (&acc)[2][2][4][2], const Unit& u, int wr, int wc, int fr, int fq) const {
        const int pnl = u.pn % npn; const int row0 = u.pm * BM + wr * 64 + fr, col0 = pnl * HALF + wc * 32 + 8 * fq;
#pragma unroll
        for (int ai = 0; ai < 2; ++ai)
#pragma unroll
            for (int m = 0; m < 4; ++m) {
                const int row = row0 + ai * HALF + m * 16;
                int tok = row; if (rowtok) tok = rowtok[tile0 * BM + row];
                const float r = (tok >= 0) ? rsqrtf(row_ss(ss, nparts, tok >= 0 ? tok : 0) * (1.f / 1024.f) + RMS_EPS) * pre : 0.f;
                f32x4 a[2];
#pragma unroll
                for (int n = 0; n < 2; ++n)
#pragma unroll
                    for (int j = 0; j < 4; ++j) { const float gt = acc[ai][0][m][n][j] * r, up = acc[ai][1][m][n][j] * r;
                        a[n][j] = gt * __builtin_amdgcn_rcpf(1.f + __builtin_amdgcn_exp2f(-gt * LOG2E)) * up; }
                if constexpr (OUT8) { typedef unsigned u32x2 __attribute__((ext_vector_type(2))); u32x2 w; w.x = pk4_fp8(a[0][0], a[0][1], a[0][2], a[0][3]); w.y = pk4_fp8(a[1][0], a[1][1], a[1][2], a[1][3]); *(u32x2*)((unsigned char*)O + (size_t)row * ldc + col0) = w; }
                else *(u32x4*)((bf16_t*)O + (size_t)row * ldc + col0) = pack8(a[0], a[1]);
            }
    }
};

struct EpiMoeDown {
    static constexpr bool PERM = true, AFTER_DRAIN = false;
    float* out; const int* rowtok; const float* rowgate; int tile0; float pre; int nostore;
    __device__ __forceinline__ void operator()(const f32x4 (&acc)[2][2][4][2], const Unit& u, int wr, int wc, int fr, int fq) const {
        const int pnl = u.pn & 3; const int row0 = (tile0 + u.pm) * BM + wr * 64 + fr, col0 = pnl * BM + wc * 32 + 8 * fq;
#pragma unroll
        for (int ai = 0; ai < 2; ++ai)
#pragma unroll
            for (int m = 0; m < 4; ++m) {
                const int srow = row0 + ai * HALF + m * 16; const int tok = nostore ? -1 : rowtok[srow];
                if (tok >= 0) { const float gt = rowgate[srow] * pre;
#pragma unroll
                    for (int bj = 0; bj < 2; ++bj)
#pragma unroll
                        for (int n = 0; n < 2; ++n) { f32x4* p = (f32x4*)(out + (size_t)tok * 1024 + col0 + bj * HALF + 4 * n); *p = *p + acc[ai][bj][m][n] * gt; } }
            }
    }
};

typedef int i32x4 __attribute__((ext_vector_type(4)));
typedef int i32x8 __attribute__((ext_vector_type(8)));
template <class Epi, class Sched, bool ALIGN_EPI = false, bool SP2 = false, bool F8 = false>
__device__ __forceinline__ void gemm_phase(PG8_LAS unsigned char* lds, const Gemm g, const Sched& S, const Epi& E) {
    const int tid = threadIdx.x, wid = __builtin_amdgcn_readfirstlane(tid >> 6), lane = tid & 63, wr = wid >> 2, wc = wid & 3, fr = lane & 15, fq = lane >> 4;
    const int K = g.K, nt = K / BK;
    unsigned voffA[2], voffB[2];
#pragma unroll
    for (int i = 0; i < 2; ++i) { int R, C; stage_rc(tid * 16 + i * 8192, R, C); const int Rb = Epi::PERM ? ((R & ~31) + perm32(R & 31)) : R;
        voffA[i] = (unsigned)(R * K + C) * 2u; voffB[i] = (unsigned)(Rb * K + C) * 2u; }
    const size_t kstep = (size_t)(BK * 2);
    const size_t hstep = (size_t)HALF * K * 2;
    const size_t tstep = 2 * hstep;
    const unsigned ldsw = (unsigned)wid * 1024u;
    const int aoff = lds_byte(wr * 64 + fr, fq * 8), boff = lds_byte(wc * 32 + fr, fq * 8);
#define PG8_SA(b, h) (((b) * 2 + (h)) * HTB)
#define PG8_SB(b, h) ((4 + (b) * 2 + (h)) * HTB)
#define PG8_STAGE(bufoff, gbase, voff) do { _Pragma("unroll") for (int _i = 0; _i < 2; ++_i) \
        __builtin_amdgcn_global_load_lds((const unsigned*)((const char*)(gbase) + (voff)[_i]), (PG8_LAS unsigned*)(lds + (bufoff) + ldsw + _i * 8192), 16, 0, 0); } while (0)
#define PG8_LDA(dst, b, h) do { if constexpr (F8) { _Pragma("unroll") for (int m = 0; m < 4; ++m) dst##8[m] = PG8_CAT(*(const PG8_LAS bf16x8*)(lds + PG8_SA(b, h) + aoff + m * 2048), *(const PG8_LAS bf16x8*)(lds + PG8_SA(b, h) + aoff + m * 2048 + 1024)); } \
        else { _Pragma("unroll") for (int m = 0; m < 4; ++m) _Pragma("unroll") for (int k = 0; k < 2; ++k) dst[m][k] = *(const PG8_LAS bf16x8*)(lds + PG8_SA(b, h) + aoff + m * 2048 + k * 1024); } } while (0)
#define PG8_LDB(dst, b, h) do { if constexpr (F8) { _Pragma("unroll") for (int n = 0; n < 2; ++n) dst##8[n] = PG8_CAT(*(const PG8_LAS bf16x8*)(lds + PG8_SB(b, h) + boff + n * 2048), *(const PG8_LAS bf16x8*)(lds + PG8_SB(b, h) + boff + n * 2048 + 1024)); } \
        else { _Pragma("unroll") for (int n = 0; n < 2; ++n) _Pragma("unroll") for (int k = 0; k < 2; ++k) dst[n][k] = *(const PG8_LAS bf16x8*)(lds + PG8_SB(b, h) + boff + n * 2048 + k * 1024); } } while (0)
#define PG8_CAT(x, y) __builtin_shufflevector(__builtin_bit_cast(i32x4, (x)), __builtin_bit_cast(i32x4, (y)), 0, 1, 2, 3, 4, 5, 6, 7)
#define PG8_MMA(ai, bj, At, Bt) do { __builtin_amdgcn_s_setprio(1); _Pragma("unroll") for (int m = 0; m < 4; ++m) _Pragma("unroll") for (int n = 0; n < 2; ++n) { \
        if constexpr (F8) { asm volatile("v_mfma_f32_16x16x128_f8f6f4 %0, %1, %2, %0" : "+v"(acc[ai][bj][m][n]) : "v"(Bt##8[n]), "v"(At##8[m])); } \
        else { _Pragma("unroll") for (int k = 0; k < 2; ++k) acc[ai][bj][m][n] = __builtin_amdgcn_mfma_f32_16x16x32_bf16(Bt[n][k], At[m][k], acc[ai][bj][m][n], 0, 0, 0); } } __builtin_amdgcn_s_setprio(0); } while (0)
#define PG8_WAIT_V(n) asm volatile("s_waitcnt vmcnt(" #n ")" ::: "memory")
#define PG8_WAIT_L(n) asm volatile("s_waitcnt lgkmcnt(" #n ")" ::: "memory")
#define PG8_BAR __builtin_amdgcn_s_barrier()
#define PG8_SCHED __builtin_amdgcn_sched_barrier(0)
    Unit cur, nxt; int ui = 0;
    if (!S.next(0, cur)) return;
    f32x4 acc[2][2][4][2];
#pragma unroll
    for (int a = 0; a < 2; ++a)
#pragma unroll
        for (int b = 0; b < 2; ++b)
#pragma unroll
            for (int m = 0; m < 4; ++m)
#pragma unroll
                for (int n = 0; n < 2; ++n) acc[a][b][m][n] = (f32x4){0.f, 0.f, 0.f, 0.f};
    bf16x8 At[4][2], B0[2][2], B1[2][2];
    i32x8 At8[4], B08[2], B18[2];
    const char* cA = (const char*)g.A + (size_t)cur.pm * tstep; const char* cB = (const char*)g.Bt + (size_t)cur.pn * tstep;
    S.a_ready(cur);
    if constexpr (SP2) {
        PG8_STAGE(PG8_SB(0, 0), cB, voffB); PG8_STAGE(PG8_SB(0, 1), cB + hstep, voffB); PG8_STAGE(PG8_SA(0, 0), cA, voffA); PG8_STAGE(PG8_SA(0, 1), cA + hstep, voffA);
        if (wr == 1) PG8_BAR;
        PG8_WAIT_V(2); PG8_BAR;
        PG8_STAGE(PG8_SB(1, 0), cB + kstep, voffB); PG8_STAGE(PG8_SA(1, 0), cA + kstep, voffA); PG8_STAGE(PG8_SB(1, 1), cB + hstep + kstep, voffB);
        PG8_WAIT_V(6); PG8_BAR;
    } else {
        PG8_STAGE(PG8_SB(0, 0), cB, voffB); PG8_STAGE(PG8_SA(0, 0), cA, voffA); PG8_STAGE(PG8_SB(0, 1), cB + hstep, voffB); PG8_STAGE(PG8_SA(0, 1), cA + hstep, voffA);
        if (wr == 1) PG8_BAR;
        PG8_WAIT_V(4); PG8_BAR;
        PG8_STAGE(PG8_SB(1, 0), cB + kstep, voffB); PG8_STAGE(PG8_SA(1, 0), cA + kstep, voffA); PG8_STAGE(PG8_SB(1, 1), cB + hstep + kstep, voffB);
        PG8_WAIT_V(6); PG8_BAR;
    }
    for (;;) {
        const bool has_next = S.next(ui + 1, nxt);
        const char* nA = has_next ? (const char*)g.A + (size_t)nxt.pm * tstep : cA; const char* nB = has_next ? (const char*)g.Bt + (size_t)nxt.pn * tstep : cB;
#pragma nounroll
        for (int t = 0; t < nt; t += 2) {
            const bool last = (t == nt - 2);
            const char* a1 = cA + (size_t)(t + 1) * kstep;
            const char* a2 = last ? nA : cA + (size_t)(t + 2) * kstep; const char* b2 = last ? nB : cB + (size_t)(t + 2) * kstep;
            const char* a3 = a2 + kstep; const char* b3 = b2 + kstep;
            if (last && has_next) S.a_ready(nxt);
            if constexpr (SP2) {
            PG8_LDB(B0, 0, 0); PG8_LDB(B1, 0, 1); PG8_SCHED; PG8_LDA(At, 0, 0); PG8_STAGE(PG8_SA(1, 1), a1 + hstep, voffA);
            PG8_WAIT_V(8); PG8_WAIT_L(0); PG8_BAR; PG8_MMA(0, 0, At, B0); PG8_MMA(0, 1, At, B1); PG8_BAR; PG8_SCHED;
            PG8_LDA(At, 0, 1); PG8_STAGE(PG8_SB(0, 0), b2, voffB); PG8_STAGE(PG8_SB(0, 1), b2 + hstep, voffB); PG8_STAGE(PG8_SA(0, 0), a2, voffA);
            PG8_WAIT_V(8); PG8_WAIT_L(0); PG8_BAR; PG8_MMA(1, 0, At, B0); PG8_MMA(1, 1, At, B1); PG8_BAR; PG8_SCHED;
            PG8_LDB(B0, 1, 0); PG8_LDB(B1, 1, 1); PG8_SCHED; PG8_LDA(At, 1, 0); PG8_STAGE(PG8_SA(0, 1), a2 + hstep, voffA);
            PG8_WAIT_V(8); PG8_WAIT_L(0); PG8_BAR; PG8_MMA(0, 0, At, B0); PG8_MMA(0, 1, At, B1); PG8_BAR; PG8_SCHED;
            PG8_LDA(At, 1, 1); PG8_STAGE(PG8_SB(1, 0), b3, voffB); PG8_STAGE(PG8_SB(1, 1), b3 + hstep, voffB); PG8_STAGE(PG8_SA(1, 0), a3, voffA);
            PG8_WAIT_V(8); PG8_WAIT_L(0); PG8_BAR; PG8_MMA(1, 0, At, B0); PG8_MMA(1, 1, At, B1); PG8_BAR; PG8_SCHED;
            } else {
            PG8_LDB(B0, 0, 0); PG8_SCHED; PG8_LDA(At, 0, 0); PG8_STAGE(PG8_SA(1, 1), a1 + hstep, voffA);
            PG8_WAIT_L(8); PG8_BAR; PG8_WAIT_L(0); PG8_MMA(0, 0, At, B0); PG8_BAR; PG8_SCHED;
            PG8_LDB(B1, 0, 1); PG8_STAGE(PG8_SB(0, 0), b2, voffB);
            PG8_BAR; PG8_WAIT_L(0); PG8_MMA(0, 1, At, B1); PG8_BAR;
            PG8_LDA(At, 0, 1); PG8_STAGE(PG8_SA(0, 0), a2, voffA);
            PG8_BAR; PG8_WAIT_L(0); PG8_MMA(1, 0, At, B0); PG8_BAR; PG8_SCHED;
            PG8_STAGE(PG8_SB(0, 1), b2 + hstep, voffB);
            PG8_WAIT_V(6); PG8_BAR; PG8_MMA(1, 1, At, B1); PG8_BAR;
            PG8_LDB(B0, 1, 0); PG8_SCHED; PG8_LDA(At, 1, 0); PG8_STAGE(PG8_SA(0, 1), a2 + hstep, voffA);
            PG8_WAIT_L(8); PG8_BAR; PG8_WAIT_L(0); PG8_MMA(0, 0, At, B0); PG8_BAR; PG8_SCHED;
            PG8_LDB(B1, 1, 1); PG8_STAGE(PG8_SB(1, 0), b3, voffB);
            PG8_BAR; PG8_WAIT_L(0); PG8_MMA(0, 1, At, B1); PG8_BAR;
            PG8_LDA(At, 1, 1); PG8_STAGE(PG8_SA(1, 0), a3, voffA);
            PG8_BAR; PG8_WAIT_L(0); PG8_MMA(1, 0, At, B0); PG8_BAR; PG8_SCHED;
            PG8_STAGE(PG8_SB(1, 1), b3 + hstep, voffB);
            PG8_WAIT_V(6); PG8_BAR; PG8_MMA(1, 1, At, B1); PG8_BAR;
            }
        }
        if constexpr (F8) asm volatile("s_nop 15\n\ts_nop 15\n\ts_nop 15" ::: "memory");
        if constexpr (ALIGN_EPI) { if (wr == 0) PG8_BAR; }
        if constexpr (!Epi::AFTER_DRAIN) { E(acc, cur, wr, wc, fr, fq); S.done(cur); }
        if (!has_next) break;
#pragma unroll
        for (int a = 0; a < 2; ++a)
#pragma unroll
            for (int b = 0; b < 2; ++b)
#pragma unroll
                for (int m = 0; m < 4; ++m)
#pragma unroll
                    for (int n = 0; n < 2; ++n) acc[a][b][m][n] = (f32x4){0.f, 0.f, 0.f, 0.f};
        cur = nxt; cA = nA; cB = nB; ++ui;
        if constexpr (ALIGN_EPI) { if (wr == 1) PG8_BAR; }
    }
    PG8_WAIT_V(0);
    if constexpr (!ALIGN_EPI) { if (wr == 0) PG8_BAR; }
    PG8_BAR;
    if constexpr (Epi::AFTER_DRAIN) { E.fused(acc, cur, wr, wc, fr, fq, lds, wid, lane); S.done(cur); }
#undef PG8_SA
#undef PG8_SB
#undef PG8_STAGE
#undef PG8_LDA
#undef PG8_LDB
#undef PG8_MMA
#undef PG8_CAT
#undef PG8_WAIT_V
#undef PG8_WAIT_L
#undef PG8_BAR
#undef PG8_SCHED
}
}

namespace att {
using pg8::bf16_t; using pg8::bf16x8; using pg8::u32x4;
typedef float f32x16 __attribute__((ext_vector_type(16)));
typedef short s16x4 __attribute__((ext_vector_type(4)));
typedef float f32x2_t __attribute__((ext_vector_type(2))); typedef __bf16 bf16x2_t __attribute__((ext_vector_type(2)));
#define ALAS __attribute__((address_space(3)))
typedef ALAS const char* lds_cptr;
constexpr int SEQ = 8192, PITCH = 3072;
constexpr int KVSLOT = 24576;
constexpr int L_WS = 4 * KVSLOT, L_TAB = L_WS + 2048, L_FLAG = L_TAB + 1056, L_END = L_FLAG + 64, L_OST = 0;
constexpr float SB_THR = 152.f;
__device__ __forceinline__ int crow(int r, int hi) { return (r & 3) + 8 * (r >> 2) + 4 * hi; }
__device__ __forceinline__ void glds16(const void* gsrc, unsigned lds_dst) { unsigned keep;
    asm volatile("s_mov_b32 %0, m0\n\ts_mov_b32 m0, %2\n\ts_nop 0\n\tglobal_load_lds_dwordx4 %1, off\n\ts_mov_b32 m0, %0" : "=&s"(keep) : "v"(gsrc), "s"(lds_dst) : "memory"); }
__device__ __forceinline__ unsigned cvtpk(float lo, float hi) { f32x2_t v = {lo, hi}; bf16x2_t b = __builtin_convertvector(v, bf16x2_t); return __builtin_bit_cast(unsigned, b); }
__device__ __forceinline__ unsigned short f2bf(float f) { unsigned u = __builtin_bit_cast(unsigned, f); return (unsigned short)((u + 0x7fffu + ((u >> 16) & 1u)) >> 16); }
#define MFMA32(a, b, c) __builtin_amdgcn_mfma_f32_32x32x16_bf16((a), (b), (c), 0, 0, 0)

__device__ __forceinline__ void qkt(f32x16& p0, f32x16& p1, lds_cptr kb, const bf16x8* qr, const f32x16& cin) {
#pragma unroll
    for (int d0 = 0; d0 < 4; ++d0) {
        const bf16x8 b0 = *(const ALAS bf16x8*)(kb + d0 * 2048);
        const bf16x8 b1 = *(const ALAS bf16x8*)(kb + d0 * 2048 + 512);
        if (d0 == 0) { p0 = MFMA32(b0, qr[0], cin); p1 = MFMA32(b1, qr[0], cin); }
        else { p0 = MFMA32(b0, qr[d0], p0); p1 = MFMA32(b1, qr[d0], p1); }
    }
}
template <int ND> __device__ __forceinline__ void pv(f32x16* o, int vb, bf16x8 pa0, bf16x8 pa1, bf16x8 pa2, bf16x8 pa3) {
#pragma unroll
    for (int d0 = 0; d0 < ND; ++d0) { s16x4 lo[4], hi[4];
#pragma unroll
        for (int ks = 0; ks < 4; ++ks) {
            asm volatile("ds_read_b64_tr_b16 %0,%1 offset:%c2" : "=&v"(lo[ks]) : "v"(vb), "i"(d0 * 4096 + ks * 1024) : "memory");
            asm volatile("ds_read_b64_tr_b16 %0,%1 offset:%c2" : "=&v"(hi[ks]) : "v"(vb), "i"(d0 * 4096 + ks * 1024 + 512) : "memory"); }
        asm volatile("s_waitcnt lgkmcnt(0)" ::: "memory"); __builtin_amdgcn_sched_barrier(0);
#define ATT_PK(k) (bf16x8){lo[k][0], lo[k][1], lo[k][2], lo[k][3], hi[k][0], hi[k][1], hi[k][2], hi[k][3]}
        o[d0] = MFMA32(pa0, ATT_PK(0), o[d0]);
        o[d0] = MFMA32(pa1, ATT_PK(1), o[d0]);
        o[d0] = MFMA32(pa2, ATT_PK(2), o[d0]);
        o[d0] = MFMA32(pa3, ATT_PK(3), o[d0]);
#undef ATT_PK
    }
}

template <int MODE, int VD>
__device__ __forceinline__ void attn_unit(ALAS char* shm, const bf16_t* Qb, const bf16_t* Kb, const bf16_t* Vb, bf16_t* Ob, int opitch, int q0, float mref2, const float* tab) {
    constexpr int ND = VD / 32;
    const int tid = threadIdx.x, lane = tid & 63, r32 = lane & 31, hi = lane >> 5; const int wid = __builtin_amdgcn_readfirstlane(tid >> 6);
    const unsigned lds0 = (unsigned)(uintptr_t)shm;
    ALAS float* wsf = (ALAS float*)(shm + L_WS) + wid * 64;
    ALAS float* tabL = (ALAS float*)(shm + L_TAB);
    ALAS unsigned* flg = (ALAS unsigned*)(shm + L_FLAG);
    if (MODE == 1) { for (int i = tid; i < 257; i += 512) tabL[i] = tab[i] * pg8::LOG2E; }
    const bf16_t* Qw = Qb + (size_t)(q0 + wid * 32) * PITCH;
    bf16x8 qr[4];
#pragma unroll
    for (int d0 = 0; d0 < 4; ++d0) qr[d0] = *(const bf16x8*)(Qw + (size_t)r32 * PITCH + d0 * 16 + hi * 8);
    int t_first, n_t, t_step;
    if (MODE == 0) { t_first = 0; n_t = q0 / 64 + 4; t_step = 1; }
    else if (MODE == 1) { const int c0 = q0 / 64; t_first = c0 - 8 > 0 ? c0 - 8 : 0; n_t = c0 + 4 - t_first; t_step = 1; }
    else { t_first = q0 / 64 + 3; n_t = q0 / 64 + 4; t_step = -1; }
    const bf16_t* ksrc = Kb + (size_t)lane * PITCH + wid * 8;
    const bf16_t* vsrc = Vb + (size_t)(16 * (wid & 3) + (lane >> 2)) * PITCH + (wid >> 2) * 32 + (lane & 3) * 8;
#define ATT_DMA(t, slot) do { const size_t to_ = (size_t)(t) * 64 * PITCH; const unsigned sb_ = lds0 + (unsigned)(slot) * KVSLOT; \
        glds16(ksrc + to_, (unsigned)__builtin_amdgcn_readfirstlane(sb_ + wid * 1024)); \
        glds16(vsrc + to_, (unsigned)__builtin_amdgcn_readfirstlane(sb_ + 8192 + wid * 1024)); \
        if (VD == 128) glds16(vsrc + to_ + 64, (unsigned)__builtin_amdgcn_readfirstlane(sb_ + 8192 + (wid + 8) * 1024)); } while (0)
    f32x16 o[ND];
#pragma unroll
    for (int d = 0; d < ND; ++d) o[d] = f32x16{};
    f32x16 cin;
#pragma unroll
    for (int r = 0; r < 16; ++r) cin[r] = (MODE == 2) ? 0.f : -mref2;
    float l_reg = 0.f, A = 0.f; bool wdone = false;
    const int wrow0 = q0 + wid * 32, qrow = wrow0 + r32;
    const int vb0 = (int)lds0 + 8192 + ((lane >> 4) & 1) * 32 + (lane & 3) * 8 + (4 * hi + ((lane & 15) >> 2)) * 64;
    asm volatile("s_waitcnt vmcnt(0)" ::: "memory"); asm volatile("" : "+v"(qr[0]), "+v"(qr[1]), "+v"(qr[2]), "+v"(qr[3]));
    ATT_DMA(t_first, 0);
    for (int i = 0; i < n_t; ++i) {
        const int t = t_first + i * t_step, slot = i & 1;
        asm volatile("s_waitcnt vmcnt(0) lgkmcnt(0)\n\ts_barrier" ::: "memory");
        if (MODE == 2 && i > 0) { const int par = ((i - 1) & 1) * 8; unsigned all = 1u;
#pragma unroll
            for (int w = 0; w < 8; ++w) all &= flg[par + w];
            if (__builtin_amdgcn_readfirstlane(all)) break; }
        if (i + 1 < n_t) ATT_DMA(t + t_step, slot ^ 1);
        bool active;
        if (MODE == 0) active = (64 * t <= wrow0);
        else if (MODE == 1) { const int cw = wrow0 / 64; active = (t >= cw - 8) && (t <= cw); }
        else active = !wdone && (64 * t < wrow0 + 31);
        if (active) {
            const lds_cptr kb = (lds_cptr)shm + slot * KVSLOT + hi * 1024 + r32 * 16;
            f32x16 p0, p1; qkt(p0, p1, kb, qr, cin);
            if (MODE == 0) {
#pragma unroll
                for (int r = 0; r < 16; ++r) { p0[r] = __builtin_amdgcn_exp2f(p0[r]); p1[r] = __builtin_amdgcn_exp2f(p1[r]); }
            } else if (MODE == 1) {
                const int cw = wrow0 / 64;
                if (t <= cw - 3) { const float cb = tabL[256];
#pragma unroll
                    for (int r = 0; r < 16; ++r) { p0[r] = __builtin_amdgcn_exp2f(p0[r] + cb); p1[r] = __builtin_amdgcn_exp2f(p1[r] + cb); }
                } else { const int dq = qrow - 64 * t - 4 * hi;
#pragma unroll
                    for (int r = 0; r < 16; ++r) { int d0 = dq - ((r & 3) + 8 * (r >> 2)), d1 = d0 - 32;
                        d0 = d0 < -128 ? -128 : (d0 > 128 ? 128 : d0); d1 = d1 < -128 ? -128 : (d1 > 128 ? 128 : d1);
                        p0[r] = __builtin_amdgcn_exp2f(p0[r] + tabL[d0 + 128]); p1[r] = __builtin_amdgcn_exp2f(p1[r] + tabL[d1 + 128]); }
                }
            } else {
                const bool needmask = (64 * t + 63 >= wrow0);
                const int kq = qrow - 64 * t - 4 * hi;
                float g[8];
#pragma unroll
                for (int k = 0; k < 8; ++k) g[k] = 0.f;
                f32x16 s0, s1;
#pragma unroll
                for (int r = 0; r < 16; ++r) { const int kv = (r & 3) + 8 * (r >> 2);
                    { const float y = p0[r], a = __builtin_fabsf(y); float sp = __builtin_fmaxf(y, 0.f) + __builtin_amdgcn_logf(1.f + __builtin_amdgcn_exp2f(-a)); if (needmask && !(kv < kq)) sp = 0.f; s0[r] = sp; g[r >> 2] += sp; }
                    { const float y = p1[r], a = __builtin_fabsf(y); float sp = __builtin_fmaxf(y, 0.f) + __builtin_amdgcn_logf(1.f + __builtin_amdgcn_exp2f(-a)); if (needmask && !(kv + 32 < kq)) sp = 0.f; s1[r] = sp; g[4 + (r >> 2)] += sp; } }
                float pg[8];
#pragma unroll
                for (int k = 0; k < 8; ++k) pg[k] = __shfl_xor(g[k], 32);
                float base[8]; float own = 0.f, par = 0.f;
#pragma unroll
                for (int k = 7; k >= 0; --k) { const float par_incl = par + pg[k]; base[k] = A + own + (hi == 0 ? par_incl : par); own += g[k]; par = par_incl; }
                A += own + par;
#pragma unroll
                for (int k = 0; k < 4; ++k) {
                    { float c = base[k]; c += s0[4 * k + 3]; const float w3 = __builtin_amdgcn_exp2f(p0[4 * k + 3] - c); c += s0[4 * k + 2]; const float w2 = __builtin_amdgcn_exp2f(p0[4 * k + 2] - c);
                      c += s0[4 * k + 1]; const float w1 = __builtin_amdgcn_exp2f(p0[4 * k + 1] - c); c += s0[4 * k]; const float w0 = __builtin_amdgcn_exp2f(p0[4 * k] - c);
                      p0[4 * k] = w0; p0[4 * k + 1] = w1; p0[4 * k + 2] = w2; p0[4 * k + 3] = w3; }
                    { float c = base[4 + k]; c += s1[4 * k + 3]; const float w3 = __builtin_amdgcn_exp2f(p1[4 * k + 3] - c); c += s1[4 * k + 2]; const float w2 = __builtin_amdgcn_exp2f(p1[4 * k + 2] - c);
                      c += s1[4 * k + 1]; const float w1 = __builtin_amdgcn_exp2f(p1[4 * k + 1] - c); c += s1[4 * k]; const float w0 = __builtin_amdgcn_exp2f(p1[4 * k] - c);
                      p1[4 * k] = w0; p1[4 * k + 1] = w1; p1[4 * k + 2] = w2; p1[4 * k + 3] = w3; }
                }
                if (needmask) {
#pragma unroll
                    for (int r = 0; r < 16; ++r) { const int kv = (r & 3) + 8 * (r >> 2); if (!(kv < kq)) p0[r] = 0.f; if (!(kv + 32 < kq)) p1[r] = 0.f; }
                }
                wdone = __all(A >= SB_THR);
            }
            if (MODE != 2) { float s = 0.f;
#pragma unroll
                for (int r = 0; r < 16; ++r) s += p0[r] + p1[r];
                l_reg += s; }
            u32x4 pw0, pw1, pw2, pw3;
            pw0 = (u32x4){cvtpk(p0[0], p0[1]), cvtpk(p0[2], p0[3]), cvtpk(p0[4], p0[5]), cvtpk(p0[6], p0[7])};
            pw1 = (u32x4){cvtpk(p0[8], p0[9]), cvtpk(p0[10], p0[11]), cvtpk(p0[12], p0[13]), cvtpk(p0[14], p0[15])};
            pw2 = (u32x4){cvtpk(p1[0], p1[1]), cvtpk(p1[2], p1[3]), cvtpk(p1[4], p1[5]), cvtpk(p1[6], p1[7])};
            pw3 = (u32x4){cvtpk(p1[8], p1[9]), cvtpk(p1[10], p1[11]), cvtpk(p1[12], p1[13]), cvtpk(p1[14], p1[15])};
            pv<ND>(o, vb0 + slot * KVSLOT, __builtin_bit_cast(bf16x8, pw0), __builtin_bit_cast(bf16x8, pw1), __builtin_bit_cast(bf16x8, pw2), __builtin_bit_cast(bf16x8, pw3));
        }
        if (MODE == 2) { if (lane == 0) flg[(i & 1) * 8 + wid] = wdone ? 1u : 0u; }
    }
#undef ATT_DMA
    asm volatile("s_waitcnt vmcnt(0) lgkmcnt(0)\n\ts_barrier" ::: "memory");
    float rl[16];
    if (MODE != 2) {
        l_reg += __shfl_xor(l_reg, 32);
        if (hi == 0) wsf[32 + r32] = l_reg;
        asm volatile("s_waitcnt lgkmcnt(0)" ::: "memory");
#pragma unroll
        for (int r = 0; r < 16; ++r) rl[r] = __builtin_amdgcn_rcpf(wsf[32 + crow(r, hi)]);
    } else {
#pragma unroll
        for (int r = 0; r < 16; ++r) rl[r] = 1.f;
    }
    bf16_t* Ow = Ob + (size_t)(q0 + wid * 32) * opitch;
    ALAS bf16_t* stg = (ALAS bf16_t*)(shm + L_OST) + wid * 2048;
#pragma unroll
    for (int half = 0; half < ND / 2; ++half) {
#pragma unroll
        for (int r = 0; r < 16; ++r) { const int orow = crow(r, hi);
#pragma unroll
            for (int d0 = 0; d0 < 2; ++d0) stg[orow * 64 + d0 * 32 + r32] = f2bf(o[half * 2 + d0][r] * rl[r]); }
        asm volatile("s_waitcnt lgkmcnt(0)" ::: "memory");
#pragma unroll
        for (int i = 0; i < 4; ++i) { const int row = i * 8 + (lane >> 3), ch = lane & 7; const u32x4 v = *(const ALAS u32x4*)(stg + row * 64 + ch * 8); *(u32x4*)(Ow + (size_t)row * opitch + half * 64 + ch * 8) = v; }
        asm volatile("s_waitcnt lgkmcnt(0)" ::: "memory");
    }
    asm volatile("s_waitcnt vmcnt(0) lgkmcnt(0)\n\ts_barrier" ::: "memory");
}


__device__ __forceinline__ void qkt8(f32x16& p0, f32x16& p1, lds_cptr kb, const bf16x8* qr, const f32x16& cin) {
    bf16x8 kf[8];
#pragma unroll
    for (int d0 = 0; d0 < 4; ++d0) { kf[2 * d0] = *(const ALAS bf16x8*)(kb + d0 * 2048); kf[2 * d0 + 1] = *(const ALAS bf16x8*)(kb + d0 * 2048 + 512); }
    __builtin_amdgcn_sched_barrier(0);
    p0 = MFMA32(kf[0], qr[0], cin); p1 = MFMA32(kf[1], qr[0], cin);
#pragma unroll
    for (int d0 = 1; d0 < 4; ++d0) { p0 = MFMA32(kf[2 * d0], qr[d0], p0); p1 = MFMA32(kf[2 * d0 + 1], qr[d0], p1); }
}
template <int ND, int KS0> __device__ __forceinline__ void v_reads(s16x4 (&lo)[ND][2], s16x4 (&hi)[ND][2], int vb) {
#pragma unroll
    for (int ks = 0; ks < 2; ++ks)
#pragma unroll
        for (int d0 = 0; d0 < ND; ++d0) {
            asm volatile("ds_read_b64_tr_b16 %0,%1 offset:%c2" : "=&v"(lo[d0][ks]) : "v"(vb), "i"(d0 * 4096 + (KS0 + ks) * 1024) : "memory");
            asm volatile("ds_read_b64_tr_b16 %0,%1 offset:%c2" : "=&v"(hi[d0][ks]) : "v"(vb), "i"(d0 * 4096 + (KS0 + ks) * 1024 + 512) : "memory"); }
}
template <int ND> __device__ __forceinline__ void pv_half(f32x16* o, const s16x4 (&lo)[ND][2], const s16x4 (&hi)[ND][2], bf16x8 pa, bf16x8 pb) {
#define ATT_PK2(d, k) (bf16x8){lo[d][k][0], lo[d][k][1], lo[d][k][2], lo[d][k][3], hi[d][k][0], hi[d][k][1], hi[d][k][2], hi[d][k][3]}
#pragma unroll
    for (int d0 = 0; d0 < ND; ++d0) o[d0] = MFMA32(pa, ATT_PK2(d0, 0), o[d0]);
#pragma unroll
    for (int d0 = 0; d0 < ND; ++d0) o[d0] = MFMA32(pb, ATT_PK2(d0, 1), o[d0]);
#undef ATT_PK2
}
template <int MODE> __device__ __forceinline__ void p_half(f32x16& p, float& l_reg, u32x4& wa, u32x4& wb, bool const_bias, int dq, const ALAS float* tabL) {
    if (MODE == 0) {
#pragma unroll
        for (int r = 0; r < 16; ++r) p[r] = __builtin_amdgcn_exp2f(p[r]);
    } else if (const_bias) { const float cb = tabL[256];
#pragma unroll
        for (int r = 0; r < 16; ++r) p[r] = __builtin_amdgcn_exp2f(p[r] + cb);
    } else {
#pragma unroll
        for (int r = 0; r < 16; ++r) { int d = dq - ((r & 3) + 8 * (r >> 2)); d = d < -128 ? -128 : (d > 128 ? 128 : d); p[r] = __builtin_amdgcn_exp2f(p[r] + tabL[d + 128]); }
    }
    float s = 0.f;
#pragma unroll
    for (int r = 0; r < 16; ++r) s += p[r];
    l_reg += s;
    wa = (u32x4){cvtpk(p[0], p[1]), cvtpk(p[2], p[3]), cvtpk(p[4], p[5]), cvtpk(p[6], p[7])};
    wb = (u32x4){cvtpk(p[8], p[9]), cvtpk(p[10], p[11]), cvtpk(p[12], p[13]), cvtpk(p[14], p[15])};
}
__device__ __forceinline__ void vm_wait_n(int n) {
    if (n <= 0) asm volatile("s_waitcnt vmcnt(0)" ::: "memory"); else if (n == 1) asm volatile("s_waitcnt vmcnt(1)" ::: "memory"); else if (n == 2) asm volatile("s_waitcnt vmcnt(2)" ::: "memory");
    else if (n == 3) asm volatile("s_waitcnt vmcnt(3)" ::: "memory"); else if (n == 4) asm volatile("s_waitcnt vmcnt(4)" ::: "memory"); else if (n == 5) asm volatile("s_waitcnt vmcnt(5)" ::: "memory");
    else if (n == 6) asm volatile("s_waitcnt vmcnt(6)" ::: "memory"); else if (n == 7) asm volatile("s_waitcnt vmcnt(7)" ::: "memory"); else asm volatile("s_waitcnt vmcnt(8)" ::: "memory");
}
template <int MODE, int VD, bool OUT8 = false>
__device__ __forceinline__ void attn_unit_pp(ALAS char* shm, const bf16_t* Qb, const bf16_t* Kb, const bf16_t* Vb, void* Ob, int opitch, int q0, float mref2, const float* tab, float oscale = 1.f) {
    static_assert(MODE == 0 || MODE == 1, "ping-pong loop: softmax modes only");
    constexpr int ND = VD / 32, NV = VD / 64, PD = 3, NS = PD + 1, PER = 1 + NV;
    const int tid = threadIdx.x, lane = tid & 63, r32 = lane & 31, hi = lane >> 5; const int wid = __builtin_amdgcn_readfirstlane(tid >> 6); const int grp = wid >> 2;
    const unsigned lds0 = (unsigned)(uintptr_t)shm;
    ALAS float* wsf = (ALAS float*)(shm + L_WS) + wid * 64;
    ALAS float* tabL = (ALAS float*)(shm + L_TAB);
    if (MODE == 1) { for (int i = tid; i < 257; i += 512) tabL[i] = tab[i] * pg8::LOG2E; }
    const bf16_t* Qw = Qb + (size_t)(q0 + wid * 32) * PITCH;
    bf16x8 qr[4];
#pragma unroll
    for (int d0 = 0; d0 < 4; ++d0) qr[d0] = *(const bf16x8*)(Qw + (size_t)r32 * PITCH + d0 * 16 + hi * 8);
    int t_first, n_t;
    if (MODE == 0) { t_first = 0; n_t = q0 / 64 + 4; }
    else { const int c0 = q0 / 64; t_first = c0 - 8 > 0 ? c0 - 8 : 0; n_t = c0 + 4 - t_first; }
    const bf16_t* ksrc = Kb + (size_t)lane * PITCH + wid * 8 + (size_t)t_first * 64 * PITCH;
    const bf16_t* vsrc = Vb + (size_t)(16 * (wid & 3) + (lane >> 2)) * PITCH + (wid >> 2) * 32 + (lane & 3) * 8 + (size_t)t_first * 64 * PITCH;
    int issued = 0;
#define PP_DMA_K(i) do { if ((i) < n_t) { glds16(ksrc + (size_t)(i) * 64 * PITCH, (unsigned)__builtin_amdgcn_readfirstlane(lds0 + (unsigned)((i) % NS) * KVSLOT + wid * 1024)); issued += 1; } } while (0)
#define PP_DMA_V(i) do { if ((i) < n_t) { const unsigned sb_ = lds0 + (unsigned)((i) % NS) * KVSLOT + 8192; glds16(vsrc + (size_t)(i) * 64 * PITCH, (unsigned)__builtin_amdgcn_readfirstlane(sb_ + wid * 1024)); \
        if (VD == 128) glds16(vsrc + (size_t)(i) * 64 * PITCH + 64, (unsigned)__builtin_amdgcn_readfirstlane(sb_ + (wid + 8) * 1024)); issued += NV; } } while (0)
#define PP_NEED_K(j) vm_wait_n(issued - ((j) * PER + 1))
#define PP_NEED_V(j) vm_wait_n(issued - ((j) + 1) * PER)
#define PP_BAR() asm volatile("s_waitcnt lgkmcnt(0)\n\ts_barrier" ::: "memory")
    f32x16 o[ND];
#pragma unroll
    for (int d = 0; d < ND; ++d) o[d] = f32x16{};
    f32x16 cin;
#pragma unroll
    for (int r = 0; r < 16; ++r) cin[r] = -mref2;
    float l_reg = 0.f;
    const int wrow0 = q0 + wid * 32, qrow = wrow0 + r32, cw = wrow0 / 64;
    const int vb0 = (int)lds0 + 8192 + ((lane >> 4) & 1) * 32 + (lane & 3) * 8 + (4 * hi + ((lane & 15) >> 2)) * 64;
    asm volatile("s_waitcnt vmcnt(0)" ::: "memory"); asm volatile("" : "+v"(qr[0]), "+v"(qr[1]), "+v"(qr[2]), "+v"(qr[3]));
#pragma unroll
    for (int j = 0; j < PD; ++j) { PP_DMA_K(j); PP_DMA_V(j); }
    if (grp) PP_DMA_K(PD);
    PP_NEED_V(0);
    PP_BAR();
    if (grp) PP_BAR();
    u32x4 pw0, pw1, pw2, pw3; f32x16 p1;
    for (int i = 0; i < n_t; ++i) {
        const int t = t_first + i, slot = i % NS;
        bool active;
        if (MODE == 0) active = (t <= cw); else active = (t >= cw - 8) && (t <= cw);
        if (grp == 0) PP_DMA_K(i + PD); else PP_DMA_V(i + PD);
        if (active) {
            const lds_cptr kb = (lds_cptr)shm + slot * KVSLOT + hi * 1024 + r32 * 16;
            f32x16 p0; qkt8(p0, p1, kb, qr, cin);
            p_half<MODE>(p0, l_reg, pw0, pw1, t <= cw - 3, qrow - 64 * t - 4 * hi, tabL);
        }
        if (grp == 0) PP_NEED_V(i); else PP_NEED_K(i + 1);
        PP_BAR();
        if (grp == 0) PP_DMA_V(i + PD); else PP_DMA_K(i + 1 + PD);
        if (active) {
            const int vb = vb0 + slot * KVSLOT;
            s16x4 lo0[ND][2], hi0[ND][2], lo1[ND][2], hi1[ND][2];
            v_reads<ND, 0>(lo0, hi0, vb);
            asm volatile("s_waitcnt lgkmcnt(0)" ::: "memory");
            v_reads<ND, 2>(lo1, hi1, vb);
            __builtin_amdgcn_sched_barrier(0);
            pv_half<ND>(o, lo0, hi0, __builtin_bit_cast(bf16x8, pw0), __builtin_bit_cast(bf16x8, pw1));
            __builtin_amdgcn_sched_barrier(0);
            p_half<MODE>(p1, l_reg, pw2, pw3, t <= cw - 3, qrow - 64 * t - 4 * hi - 32, tabL);
            asm volatile("s_waitcnt lgkmcnt(0)" ::: "memory");
            __builtin_amdgcn_sched_barrier(0);
            pv_half<ND>(o, lo1, hi1, __builtin_bit_cast(bf16x8, pw2), __builtin_bit_cast(bf16x8, pw3));
        }
        if (grp == 0) PP_NEED_K(i + 1); else PP_NEED_V(i + 1);
        PP_BAR();
    }
    if (grp == 0) PP_BAR();
#undef PP_DMA_K
#undef PP_DMA_V
#undef PP_NEED_K
#undef PP_NEED_V
    float rl[16];
    l_reg += __shfl_xor(l_reg, 32);
    if (hi == 0) wsf[32 + r32] = l_reg;
    asm volatile("s_waitcnt lgkmcnt(0)" ::: "memory");
#pragma unroll
    for (int r = 0; r < 16; ++r) rl[r] = __builtin_amdgcn_rcpf(wsf[32 + crow(r, hi)]) * oscale;
    if constexpr (OUT8) {
        static_assert(!OUT8 || VD == 64, "fp8 output: 64-wide heads");
        unsigned char* Ow = (unsigned char*)Ob + (size_t)(q0 + wid * 32) * opitch;
        ALAS unsigned char* stg = (ALAS unsigned char*)(shm + L_OST) + wid * 2048;
#pragma unroll
        for (int r = 0; r < 16; ++r) { const int orow = crow(r, hi);
#pragma unroll
            for (int d0 = 0; d0 < 2; ++d0) { const float v = o[d0][r] * rl[r]; stg[orow * 64 + d0 * 32 + r32] = (unsigned char)(__builtin_amdgcn_cvt_pk_fp8_f32(v, v, 0, false) & 0xff); } }
        asm volatile("s_waitcnt lgkmcnt(0)" ::: "memory");
#pragma unroll
        for (int i = 0; i < 2; ++i) { const int row = i * 16 + (lane >> 2), ch = lane & 3; const u32x4 v = *(const ALAS u32x4*)(stg + row * 64 + ch * 16); *(u32x4*)(Ow + (size_t)row * opitch + ch * 16) = v; }
        asm volatile("s_waitcnt lgkmcnt(0)" ::: "memory");
    } else {
    bf16_t* Ow = (bf16_t*)Ob + (size_t)(q0 + wid * 32) * opitch;
    ALAS bf16_t* stg = (ALAS bf16_t*)(shm + L_OST) + wid * 2048;
#pragma unroll
    for (int half = 0; half < ND / 2; ++half) {
#pragma unroll
        for (int r = 0; r < 16; ++r) { const int orow = crow(r, hi);
#pragma unroll
            for (int d0 = 0; d0 < 2; ++d0) stg[orow * 64 + d0 * 32 + r32] = f2bf(o[half * 2 + d0][r] * rl[r]); }
        asm volatile("s_waitcnt lgkmcnt(0)" ::: "memory");
#pragma unroll
        for (int i = 0; i < 4; ++i) { const int row = i * 8 + (lane >> 3), ch = lane & 7; const u32x4 v = *(const ALAS u32x4*)(stg + row * 64 + ch * 8); *(u32x4*)(Ow + (size_t)row * opitch + half * 64 + ch * 8) = v; }
        asm volatile("s_waitcnt lgkmcnt(0)" ::: "memory");
    }
    }
    PP_BAR();
#undef PP_BAR
}
}

constexpr int NWAVES = 8, NTHR = NWAVES * 64;
constexpr int BATCH = 2, SEQ = 8192, T = BATCH * SEQ, D = 1024;
constexpr int NPROJ = 3072, FFD = 2816, FFE = 3584, NEXP = 8;
constexpr size_t MiB = 1u << 20;
constexpr size_t CTL_ZERO_BYTES = 1 * MiB;
constexpr int CW_TMO = 0, CW_BAR = 4096;
constexpr int CW_HIST = 16384;
constexpr int CW_MOE = 24576;
constexpr size_t WS_SS0 = 1 * MiB, WS_SS3 = WS_SS0 + 65536, WS_ROPE = WS_SS3 + 65536  , WS_TOKSEL = WS_ROPE + MiB  ,
                 WS_TOKGATE = WS_TOKSEL + 65536  , WS_ROWTOK = WS_TOKGATE + 131072  , WS_ROWGATE = WS_ROWTOK + 147456  ;
static_assert(WS_ROWGATE + 147456 <= 4 * MiB, "small arrays");
constexpr size_t WS_XB = 4 * MiB;
constexpr size_t WS_AO = 36 * MiB;
constexpr size_t WS_ACT0 = 68 * MiB;
constexpr size_t WS_XF = 164 * MiB;
constexpr size_t WS_WIN = 228 * MiB, WS_WO0 = 234 * MiB, WS_WGU0 = 236 * MiB, WS_WD0 = 247 * MiB, WS_WQKV = 253 * MiB, WS_WO1 = 259 * MiB;
constexpr size_t WS_WEGU = 264 * MiB;
constexpr size_t WS_WED = 376 * MiB;
constexpr size_t WS_SS1 = 432 * MiB, WS_SS2 = 433 * MiB;
constexpr size_t WS_END = 434 * MiB;
constexpr size_t WS_SORTA = 36 * MiB;
constexpr size_t WS_ACTE = 108 * MiB;
static_assert(WS_SORTA + (size_t)36864 * 2048 <= WS_ACTE && WS_ACTE + (size_t)18432 * 7168 <= WS_WO0 && WS_WD0 + (size_t)1024 * 2816 * 2 <= WS_WQKV && WS_WO1 + 2 * MiB <= WS_WEGU, "ws map");
constexpr int RING_BYTES = 131072, MISC_OFF = RING_BYTES + 320, LDS_BYTES = 147456;
static_assert(att::L_END <= RING_BYTES, "attention LDS");

#define GAS __attribute__((address_space(1)))
#define LAS __attribute__((address_space(3)))
typedef unsigned short bf16;
typedef unsigned v4u __attribute__((ext_vector_type(4)));
typedef float f32x4 __attribute__((ext_vector_type(4)));
typedef GAS unsigned gu32;
#define RLX_AGENT __ATOMIC_RELAXED, __HIP_MEMORY_SCOPE_AGENT
#define LDS_WAIT() asm volatile("s_waitcnt lgkmcnt(0)" ::: "memory")
#define VM_WAIT() asm volatile("s_waitcnt vmcnt(0)" ::: "memory")
__device__ __forceinline__ unsigned f2bf(float f) { unsigned u = __builtin_bit_cast(unsigned, f); return (u + 0x7fffu + ((u >> 16) & 1u)) >> 16; }
__device__ __forceinline__ unsigned pk2(float lo, float hi) { return f2bf(lo) | (f2bf(hi) << 16); }
__device__ __forceinline__ float bf2f(unsigned short h) { return __builtin_bit_cast(float, (unsigned)h << 16); }
#define XB_TMO      128
#define XB_XCNT(j)  (256  + 64 * (j))
#define XB_XSUB(j)  (1280 + 64 * (j))
#define XB_XGEN(j)  (2304 + 64 * (j))
#define XB_TOP      3328
#define XB_TOPGEN   3392
#define XCD_BAR_WORDS 3456
#define XB_SPIN_CAP (1u << 18)

__device__ __forceinline__ unsigned xb_ld(unsigned* p)              { return __hip_atomic_load(p, __ATOMIC_RELAXED, __HIP_MEMORY_SCOPE_AGENT); }
__device__ __forceinline__ unsigned xb_add(unsigned* p, unsigned v) { return __hip_atomic_fetch_add(p, v, __ATOMIC_RELAXED, __HIP_MEMORY_SCOPE_AGENT); }
__device__ __forceinline__ unsigned xb_xcc_id() { return (unsigned)__builtin_amdgcn_s_getreg((3 << 11) | 20) & 0xFu; }
#define XB_SPIN(cond, bar) do { unsigned _sp = 0; while (cond) { __builtin_amdgcn_s_sleep(1); \
    if ((++_sp & 255u) == 0u) { if (xb_ld(&(bar)[XB_TMO])) break; if (_sp > XB_SPIN_CAP) { atomicAdd(&(bar)[XB_TMO], 1u); break; } } } } while (0)

struct XcdBarrier {
    unsigned* bar; unsigned x;
    volatile LAS unsigned* st;
};

__device__ __forceinline__ XcdBarrier xcd_barrier_post(unsigned* bar, volatile LAS unsigned* st) {
    XcdBarrier b; b.bar = bar; b.x = xb_xcc_id(); b.st = st;
    if (threadIdx.x == 0) (void)xb_add(&bar[XB_XCNT(b.x)], 1u);
    return b;
}
__device__ __forceinline__ void xcd_barrier_complete(unsigned* bar, unsigned x, unsigned& nloc, unsigned& nx) {
    const unsigned G = gridDim.x * gridDim.y * gridDim.z;
    unsigned sum, cnt, mine, sp = 0u;
    for (;;) {
        sum = 0u; cnt = 0u; mine = 0u;
#pragma unroll
        for (unsigned j = 0; j < 16; ++j) { const unsigned c = xb_ld(&bar[XB_XCNT(j)]); sum += c; cnt += (c > 0u) ? 1u : 0u; mine = (j == x) ? c : mine; }
        if (sum == G) break;
        __builtin_amdgcn_s_sleep(1);
        if ((++sp & 255u) == 0u) { if (xb_ld(&bar[XB_TMO])) break; if (sp > XB_SPIN_CAP) { atomicAdd(&bar[XB_TMO], 1u); break; } }
    }
    nloc = mine > 0u ? mine : 1u; nx = cnt > 0u ? cnt : 1u;
}

__device__ __forceinline__ void xcd_barrier(const XcdBarrier& b) {
    asm volatile("s_waitcnt vmcnt(0)" ::: "memory");
    __syncthreads();
    if (threadIdx.x == 0) {
        unsigned* bar = b.bar;
        __builtin_amdgcn_s_waitcnt(0);
        unsigned nloc = b.st[0], nx = b.st[1];
        if (nloc == 0u) { xcd_barrier_complete(bar, b.x, nloc, nx); b.st[0] = nloc; b.st[1] = nx; }
        const unsigned old = xb_add(&bar[XB_XSUB(b.x)], 1u);
        const unsigned gen = old / nloc;
        if (old + 1u == (gen + 1u) * nloc) {
            __builtin_amdgcn_fence(__ATOMIC_RELEASE, "agent");
            asm volatile("s_waitcnt vmcnt(0)" ::: "memory");
            const unsigned og = xb_add(&bar[XB_TOP], 1u);
            const unsigned tg = og / nx;
            if (og + 1u == (tg + 1u) * nx) xb_add(&bar[XB_TOPGEN], 1u);
            else XB_SPIN(xb_ld(&bar[XB_TOPGEN]) == tg, bar);
            __builtin_amdgcn_fence(__ATOMIC_ACQUIRE, "agent");
            xb_add(&bar[XB_XGEN(b.x)], 1u);
            asm volatile("s_waitcnt vmcnt(0)" ::: "memory");
        } else {
            XB_SPIN(xb_ld(&bar[XB_XGEN(b.x)]) == gen, bar);
            __builtin_amdgcn_fence(__ATOMIC_ACQUIRE, "agent");
            asm volatile("s_waitcnt vmcnt(0)" ::: "memory");
        }
    }
    __syncthreads();
}

__device__ __forceinline__ float wave_sum(float v) {
#pragma unroll
    for (int o = 1; o < 64; o <<= 1) v += __shfl_xor(v, o);
    return v;
}
__device__ __forceinline__ float wave_max(float v) {
#pragma unroll
    for (int o = 1; o < 64; o <<= 1) v = fmaxf(v, __shfl_xor(v, o));
    return v;
}
__device__ __forceinline__ int dest_block(int blk, int map) {
    if (map == 1) { const int s = blk & 7; return (blk & ~7) + 4 * (s & 1) + (s >> 1); }
    if (map == 2) return (blk >> 2) * 8 + (blk & 3);
    if (map == 3) return (blk >> 2) * 8 + 4 + (blk & 3);
    return blk;
}
__device__ __forceinline__ void tr_tile(const float* W, int K, int N, bf16* WT, int map, const float* gain, LAS unsigned* scr, int item, int lane) {
    const int nblk = N / 64, kb = item / nblk, nb = item % nblk, k0 = 64 * kb, n0 = 64 * nb;
    const int c = lane & 15, ip = lane >> 4;
#pragma unroll
    for (int it = 0; it < 8; ++it) { const int kp = it * 4 + ip, k = k0 + 2 * kp;
        f32x4 a = *(const GAS f32x4*)(W + (size_t)k * N + n0 + 4 * c), b = *(const GAS f32x4*)(W + (size_t)(k + 1) * N + n0 + 4 * c);
        if (gain) { a = a * gain[k]; b = b * gain[k + 1]; }
#pragma unroll
        for (int j = 0; j < 4; ++j) scr[(4 * c + j) * 33 + kp] = pk2(a[j], b[j]); }
    LDS_WAIT(); asm volatile("" ::: "memory");
#pragma unroll
    for (int it = 0; it < 8; ++it) { const int n = it * 8 + (lane >> 3), q = lane & 7;
        v4u o; o.x = scr[n * 33 + 4 * q]; o.y = scr[n * 33 + 4 * q + 1]; o.z = scr[n * 33 + 4 * q + 2]; o.w = scr[n * 33 + 4 * q + 3];
        const int drow = dest_block((n0 + n) >> 5, map) * 32 + (n & 31);
        *(GAS v4u*)(WT + (size_t)drow * K + k0 + 8 * q) = o; }
    LDS_WAIT(); asm volatile("" ::: "memory");
}

__device__ __forceinline__ void tr_tile8(const float* W, int K, int N, unsigned char* WT, int map, const float* gain, float wscale, LAS unsigned* scr, int item, int lane) {
    const int nblk = N / 64, kb = item / nblk, nb = item % nblk, k0 = 64 * kb, n0 = 64 * nb;
    const int c = lane & 15, ip = lane >> 4;
#pragma unroll
    for (int it = 0; it < 4; ++it) { const int k4 = it * 4 + ip, k = k0 + 4 * k4; f32x4 a[4];
#pragma unroll
        for (int i = 0; i < 4; ++i) a[i] = *(const GAS f32x4*)(W + (size_t)(k + i) * N + n0 + 4 * c) * ((gain ? gain[k + i] : 1.f) * wscale);
#pragma unroll
        for (int j = 0; j < 4; ++j) scr[(4 * c + j) * 17 + k4] = pg8::pk4_fp8(a[0][j], a[1][j], a[2][j], a[3][j]); }
    LDS_WAIT(); asm volatile("" ::: "memory");
#pragma unroll
    for (int it = 0; it < 4; ++it) { const int n = it * 16 + (lane >> 2), q = lane & 3;
        v4u o; o.x = scr[n * 17 + 4 * q]; o.y = scr[n * 17 + 4 * q + 1]; o.z = scr[n * 17 + 4 * q + 2]; o.w = scr[n * 17 + 4 * q + 3];
        const int drow = dest_block((n0 + n) >> 5, map) * 32 + (n & 31);
        *(GAS v4u*)(WT + (size_t)drow * K + k0 + 16 * q) = o; }
    LDS_WAIT(); asm volatile("" ::: "memory");
}
constexpr float AO8_SCALE = 16.f;
constexpr float W8_SCALE = 64.f;

#ifndef PROBE_MASK
#define PROBE_MASK 0
#endif
struct KArgs { const void* in[27]; float* out; unsigned char* ws; int ph_lo, ph_hi, flags, pad; };

__global__ void __launch_bounds__(NTHR, 2) fwd_kernel(KArgs args) {
    extern __shared__ __attribute__((aligned(16))) unsigned char lds_raw[];
    LAS unsigned char* lds = (LAS unsigned char*)lds_raw;
    volatile LAS unsigned* MISC = (volatile LAS unsigned*)(lds + MISC_OFF);
    const int tid = threadIdx.x, lane = tid & 63, wave = __builtin_amdgcn_readfirstlane(tid >> 6);
    const int G = gridDim.x; const int bx = blockIdx.x; const int vcu = (G % 8 == 0) ? (bx % 8) * (G / 8) + bx / 8 : bx;
    unsigned char* ws = args.ws;
    unsigned* ctl = (unsigned*)ws;
    for (int u = tid; u < (LDS_BYTES - RING_BYTES) / 4; u += NTHR) ((LAS unsigned*)(lds + RING_BYTES))[u] = 0u;
    __syncthreads();
    XcdBarrier bar = xcd_barrier_post(ctl + CW_BAR, MISC + 8);
    const int lo = args.ph_lo, hi_ph = args.ph_hi;
#define IN(k) (lo <= (k) && (k) < hi_ph)
#define REP(k)
#define SEAM(k) do { if (IN(k) && IN((k) + 1)) xcd_barrier(bar); } while (0)
    const float* x_in = (const float*)args.in[0]; const int* positions = (const int*)args.in[1];
    const float* ev_attn_norm = (const float*)args.in[2]; const float* ev_w_in = (const float*)args.in[3];
    const float* ev_q_norm = (const float*)args.in[4]; const float* ev_k_norm = (const float*)args.in[5];
    const float* ev_lq1 = (const float*)args.in[6]; const float* ev_lk1 = (const float*)args.in[7]; const float* ev_lq2 = (const float*)args.in[8]; const float* ev_lk2 = (const float*)args.in[9];
    const float* ev_subln = (const float*)args.in[10]; const float* ev_w_out = (const float*)args.in[11]; const float* ev_ffn_norm = (const float*)args.in[12];
    const float* ev_w_gate = (const float*)args.in[13]; const float* ev_w_up = (const float*)args.in[14]; const float* ev_w_down = (const float*)args.in[15];
    const float* od_attn_norm = (const float*)args.in[16]; const float* od_w_qkv = (const float*)args.in[17];
    const float* od_q_norm = (const float*)args.in[18]; const float* od_k_norm = (const float*)args.in[19]; const float* od_rel_bias = (const float*)args.in[20];
    const float* od_w_out = (const float*)args.in[21]; const float* od_ffn_norm = (const float*)args.in[22]; const float* od_router = (const float*)args.in[23];
    const float* od_we_gate = (const float*)args.in[24]; const float* od_we_up = (const float*)args.in[25]; const float* od_we_down = (const float*)args.in[26];
    float* out = args.out;
    float* ss0 = (float*)(ws + WS_SS0); float* ss1 = (float*)(ws + WS_SS1); float* ss2 = (float*)(ws + WS_SS2); float* ss3 = (float*)(ws + WS_SS3);
    float* rope = (float*)(ws + WS_ROPE); unsigned* toksel = (unsigned*)(ws + WS_TOKSEL); float* tokgate = (float*)(ws + WS_TOKGATE);
    int* rowtok = (int*)(ws + WS_ROWTOK); float* rowgate = (float*)(ws + WS_ROWGATE);
    bf16* XB = (bf16*)(ws + WS_XB); bf16* AO = (bf16*)(ws + WS_AO); bf16* ACT0 = (bf16*)(ws + WS_ACT0); float* XF = (float*)(ws + WS_XF); bf16* OD = (bf16*)(ws + WS_XF);
    bf16* Win_t = (bf16*)(ws + WS_WIN); bf16* Wo0_t = (bf16*)(ws + WS_WO0); bf16* Wgu0_t = (bf16*)(ws + WS_WGU0); bf16* Wd0_t = (bf16*)(ws + WS_WD0);
    unsigned char* Wqkv8 = ws + WS_WQKV; unsigned char* Wo18 = ws + WS_WO1; unsigned char* XB8 = ws + WS_XB; unsigned char* AO8 = ws + WS_AO; unsigned char* WEgu8 = ws + WS_WEGU; unsigned char* WEd8 = ws + WS_WED;
    unsigned char* SORTA8 = ws + WS_SORTA; unsigned char* ACTE8 = ws + WS_ACTE;
    const int gw = vcu * NWAVES + wave, NGW = G * NWAVES;

    REP(0) if (IN(0)) {
        LAS unsigned* scr = (LAS unsigned*)(lds + wave * 8704);
        constexpr int I_IN = 16 * 48, I_O = 16 * 16, I_G = 16 * 44, I_D = 44 * 16, I_EG = 16 * 56, I_ED = 56 * 16;
        constexpr int NSMALL = I_IN + I_O + 2 * I_G + I_D + I_IN + I_O, NITEMS = NSMALL + 24 * I_EG;
        for (int it = gw; it < NITEMS; it += NGW) {
            int r = it;
            if (r < I_IN) { tr_tile(ev_w_in, D, NPROJ, Win_t, 1, ev_attn_norm, scr, r, lane); continue; } r -= I_IN;
            if (r < I_O) { tr_tile(ev_w_out, D, D, Wo0_t, 0, nullptr, scr, r, lane); continue; } r -= I_O;
            if (r < I_G) { tr_tile(ev_w_gate, D, FFD, Wgu0_t, 2, ev_ffn_norm, scr, r, lane); continue; } r -= I_G;
            if (r < I_G) { tr_tile(ev_w_up, D, FFD, Wgu0_t, 3, ev_ffn_norm, scr, r, lane); continue; } r -= I_G;
            if (r < I_D) { tr_tile(ev_w_down, FFD, D, Wd0_t, 0, nullptr, scr, r, lane); continue; } r -= I_D;
            if (r < I_IN) { tr_tile8(od_w_qkv, D, NPROJ, Wqkv8, 1, od_attn_norm, W8_SCALE, scr, r, lane); continue; } r -= I_IN;
            if (r < I_O) { tr_tile8(od_w_out, D, D, Wo18, 0, nullptr, W8_SCALE, scr, r, lane); continue; } r -= I_O;
            const int which = r / (8 * I_EG), rr = r % (8 * I_EG), e = rr / I_EG, item = rr % I_EG;
            if (which == 0) tr_tile8(od_we_gate + (size_t)e * D * FFE, D, FFE, WEgu8 + (size_t)e * 2 * FFE * D, 2, od_ffn_norm, W8_SCALE, scr, item, lane);
            else if (which == 1) tr_tile8(od_we_up + (size_t)e * D * FFE, D, FFE, WEgu8 + (size_t)e * 2 * FFE * D, 3, od_ffn_norm, W8_SCALE, scr, item, lane);
            else tr_tile8(od_we_down + (size_t)e * FFE * D, FFE, D, WEd8 + (size_t)e * D * FFE, 0, nullptr, W8_SCALE, scr, item, lane);
        }
        for (int m = gw; m < T; m += NGW) {
            const GAS f32x4* xr = (const GAS f32x4*)(x_in + (size_t)m * D) + lane; f32x4 v[4]; float s = 0.f;
#pragma unroll
            for (int j = 0; j < 4; ++j) { v[j] = xr[64 * j]; s += (v[j].x * v[j].x + v[j].y * v[j].y) + (v[j].z * v[j].z + v[j].w * v[j].w); }
            s = wave_sum(s); if (lane == 0) ss0[m] = s;
            GAS unsigned long long* o8 = (GAS unsigned long long*)(XB + (size_t)m * D) + lane;
#pragma unroll
            for (int j = 0; j < 4; ++j) o8[64 * j] = (unsigned long long)pk2(v[j].x, v[j].y) | ((unsigned long long)pk2(v[j].z, v[j].w) << 32);
        }
        for (int i = vcu * NTHR + tid; i < T * 8; i += G * NTHR) {
            const int tok = i >> 3, f = i & 7;
            const double inv = exp2(-(double)f * (18.931568569324174 / 8.0));
            double ang = (double)positions[tok] * inv; ang -= 6.283185307179586 * rint(ang * 0.15915494309189535);
            float sn, cs; sincosf((float)ang, &sn, &cs);
            rope[(size_t)tok * 16 + f] = cs; rope[(size_t)tok * 16 + 8 + f] = sn;
        }
    }
    SEAM(0);

    REP(1) if (IN(1)) {
        pg8::Gemm g{XB, Win_t, T, NPROJ, D}; pg8::StaticOrder S; S.init(T, NPROJ, G, bx);
        pg8::EpiProj E{ACT0, NPROJ, ss0, 1, ev_q_norm, ev_k_norm, rope, 0, 1.f};
        pg8::gemm_phase<pg8::EpiProj, pg8::StaticOrder, true, true>(lds, g, S, E);
    }
    SEAM(1);

    REP(2) if (IN(2)) {
        const float gqm = wave_max(fabsf(ev_q_norm[lane])), gkm = wave_max(fabsf(ev_k_norm[lane]));
        const float mref = 8.f * gqm * gkm * pg8::LOG2E;
        if (!(args.flags & 1)) for (int L = vcu; L < 512; L += G) {
            const int bhm = (L & 255) >> 4, qb = (L < 256) ? (L & 15) : 31 - (L & 15);
            const int b = bhm >> 3, hm = bhm & 7, h = hm >> 1;
            const bf16* base = ACT0 + (size_t)b * SEQ * NPROJ;
            att::attn_unit_pp<0, 128>((LAS char*)lds, base + 1536 + hm * 64, base + 2048 + hm * 64, base + 2560 + h * 128, OD + (size_t)b * SEQ * D + hm * 128, D, qb * 256, mref, nullptr);
        }
        if (!(args.flags & 2)) for (int L = vcu; L < 512; L += G) {
            const int bh = (L & 255) >> 4, qb = 2 * (L & 15) + (L >> 8);
            const int b = bh >> 3, h = bh & 7;
            const bf16* base = ACT0 + (size_t)b * SEQ * NPROJ;
            att::attn_unit<2, 64>((LAS char*)lds, base + h * 64, base + 512 + h * 64, base + 1024 + h * 64, AO + (size_t)b * SEQ * D + h * 64, D, qb * 256, 0.f, nullptr);
        }
    }
    SEAM(2);

    REP(3) if (IN(3)) {
        const float a1 = wave_sum(ev_lq1[lane] * ev_lk1[lane]), a2 = wave_sum(ev_lq2[lane] * ev_lk2[lane]);
        const float lam_init = 0.2f, lam = expf(a1) - expf(a2) + lam_init;
        const int h = lane >> 4, v0 = (lane & 15) * 8;
        float sg[8];
#pragma unroll
        for (int j = 0; j < 8; ++j) sg[j] = ev_subln[v0 + j] * (1.f - lam_init);
        for (int m = gw; m < T; m += NGW) {
            const v4u a = *(const GAS v4u*)(OD + (size_t)m * D + (2 * h) * 128 + v0), b = *(const GAS v4u*)(OD + (size_t)m * D + (2 * h + 1) * 128 + v0);
            float d[8]; float s = 0.f;
#pragma unroll
            for (int j = 0; j < 4; ++j) { const unsigned ua = a[j], ub = b[j];
                d[2 * j] = bf2f((unsigned short)(ua & 0xffffu)) - lam * bf2f((unsigned short)(ub & 0xffffu));
                d[2 * j + 1] = bf2f((unsigned short)(ua >> 16)) - lam * bf2f((unsigned short)(ub >> 16));
                s += d[2 * j] * d[2 * j] + d[2 * j + 1] * d[2 * j + 1]; }
            s += __shfl_xor(s, 1); s += __shfl_xor(s, 2); s += __shfl_xor(s, 4); s += __shfl_xor(s, 8);
            const float rs = rsqrtf(s * (1.f / 128.f) + pg8::RMS_EPS);
            v4u o; o.x = pk2(d[0] * rs * sg[0], d[1] * rs * sg[1]); o.y = pk2(d[2] * rs * sg[2], d[3] * rs * sg[3]); o.z = pk2(d[4] * rs * sg[4], d[5] * rs * sg[5]); o.w = pk2(d[6] * rs * sg[6], d[7] * rs * sg[7]);
            *(GAS v4u*)(AO + (size_t)m * D + 512 + h * 128 + v0) = o;
        }
    }
    SEAM(3);

    REP(4) if (IN(4)) {
        pg8::Gemm g{AO, Wo0_t, T, D, D}; pg8::StaticOrder S; S.init(T, D, G, bx);
        pg8::EpiResid E{x_in, XF, XB, ss1, 1.f, nullptr};
        pg8::gemm_phase<pg8::EpiResid, pg8::StaticOrder, false, true>(lds, g, S, E);
    }
    SEAM(4);

    REP(5) if (IN(5)) {
        pg8::Gemm g{XB, Wgu0_t, T, 2 * FFD, D}; pg8::StaticOrder S; S.init(T, 2 * FFD, G, bx);
        pg8::EpiSwiglu<false> E{ACT0, FFD, ss1, 16, nullptr, 0, 2 * FFD / 256, 1.f};
        pg8::gemm_phase<pg8::EpiSwiglu<false>, pg8::StaticOrder, true, true>(lds, g, S, E);
    }
    SEAM(5);

    if (IN(6)) {
        pg8::Gemm g{ACT0, Wd0_t, T, D, FFD}; pg8::StaticOrder S; S.init(T, D, G, bx);
        pg8::EpiResid E{XF, XF, nullptr, ss2, 1.f, XB8};
        pg8::gemm_phase<pg8::EpiResid, pg8::StaticOrder, false, true>(lds, g, S, E);
    }
    SEAM(6);

    REP(7) if (IN(7)) {
        pg8::Gemm g{(const bf16*)XB8, (const bf16*)Wqkv8, T, NPROJ, D / 2}; pg8::StaticOrder S; S.init(T, NPROJ, G, bx);
        pg8::EpiProj E{ACT0, NPROJ, ss2, 16, od_q_norm, od_k_norm, nullptr, 1, 1.f / W8_SCALE};
        pg8::gemm_phase<pg8::EpiProj, pg8::StaticOrder, true, true, true>(lds, g, S, E);
    }
    SEAM(7);

    REP(8) if (IN(8)) {
        const float gqm = wave_max(fabsf(od_q_norm[lane])), gkm = wave_max(fabsf(od_k_norm[lane]));
        for (int L = vcu; L < 1024; L += G) {
            const int bh = (L & 255) >> 3, qb = 4 * (L & 7) + (L >> 8);
            const int b = bh >> 4, h = bh & 15;
            const float* tab = od_rel_bias + h * 257;
            float tm = fabsf(tab[lane]); tm = fmaxf(tm, fabsf(tab[64 + lane])); tm = fmaxf(tm, fabsf(tab[128 + lane])); tm = fmaxf(tm, fabsf(tab[192 + lane])); tm = fmaxf(tm, fabsf(tab[256]));
            tm = wave_max(tm);
            const float mref = (8.f * gqm * gkm + tm) * pg8::LOG2E;
            const bf16* base = ACT0 + (size_t)b * SEQ * NPROJ;
            att::attn_unit_pp<1, 64, true>((LAS char*)lds, base + h * 64, base + 1024 + h * 64, base + 2048 + h * 64, AO8 + (size_t)b * SEQ * D + h * 64, D, qb * 256, mref, tab, AO8_SCALE);
        }
    }
    SEAM(8);

    REP(9) if (IN(9)) {
        pg8::Gemm g{(const bf16*)AO8, (const bf16*)Wo18, T, D, D / 2}; pg8::StaticOrder S; S.init(T, D, G, bx);
        pg8::EpiResid E{XF, out, nullptr, nullptr, 1.f / (W8_SCALE * AO8_SCALE), nullptr};
        pg8::gemm_phase<pg8::EpiResid, pg8::StaticOrder, false, true, true>(lds, g, S, E);
    }
    SEAM(9);

    REP(10) if (IN(10)) {
        LAS float* wrT = (LAS float*)lds;
        LAS unsigned* sel = (LAS unsigned*)(lds + 32768);
        for (int i = tid; i < 1024; i += NTHR) { const float gn = od_ffn_norm[i]; const f32x4 w0 = *(const GAS f32x4*)(od_router + (size_t)i * 8), w1 = *(const GAS f32x4*)(od_router + (size_t)i * 8 + 4);
            wrT[i] = w0.x * gn; wrT[1024 + i] = w0.y * gn; wrT[2048 + i] = w0.z * gn; wrT[3072 + i] = w0.w * gn; wrT[4096 + i] = w1.x * gn; wrT[5120 + i] = w1.y * gn; wrT[6144 + i] = w1.z * gn; wrT[7168 + i] = w1.w * gn; }
        __syncthreads();
        for (int blk = vcu; blk < T / 64; blk += G) {
#pragma unroll 1
            for (int q4 = 0; q4 < 2; ++q4) {
                const int tok0 = blk * 64 + wave * 8 + q4 * 4;
                f32x4 xv[4][4]; float s[4]; float lg[4][8];
#pragma unroll
                for (int t4 = 0; t4 < 4; ++t4) { const GAS f32x4* xr = (const GAS f32x4*)(out + (size_t)(tok0 + t4) * D) + lane;
#pragma unroll
                    for (int j = 0; j < 4; ++j) xv[t4][j] = xr[64 * j]; }
#pragma unroll
                for (int t4 = 0; t4 < 4; ++t4) { s[t4] = 0.f;
#pragma unroll
                    for (int e2 = 0; e2 < 8; ++e2) lg[t4][e2] = 0.f;
#pragma unroll
                    for (int j = 0; j < 4; ++j) { const f32x4 v = xv[t4][j]; s[t4] += (v.x * v.x + v.y * v.y) + (v.z * v.z + v.w * v.w); } }
#pragma unroll
                for (int j = 0; j < 4; ++j)
#pragma unroll
                    for (int e2 = 0; e2 < 8; ++e2) { const f32x4 w = *(const LAS f32x4*)(wrT + e2 * 1024 + 256 * j + 4 * lane);
#pragma unroll
                        for (int t4 = 0; t4 < 4; ++t4) { const f32x4 v = xv[t4][j]; lg[t4][e2] += (v.x * w.x + v.y * w.y) + (v.z * w.z + v.w * w.w); } }
#pragma unroll
                for (int t4 = 0; t4 < 4; ++t4) { s[t4] = wave_sum(s[t4]);
#pragma unroll
                    for (int e2 = 0; e2 < 8; ++e2) lg[t4][e2] = wave_sum(lg[t4][e2]); }
                if (lane == 0) {
#pragma unroll
                    for (int t4 = 0; t4 < 4; ++t4) { const int tok = tok0 + t4;
                        const float r = rsqrtf(s[t4] * (1.f / 1024.f) + pg8::RMS_EPS); ss3[tok] = s[t4];
                        int e0 = 0; float v0 = lg[t4][0];
#pragma unroll
                        for (int e2 = 1; e2 < 8; ++e2) if (lg[t4][e2] > v0) { v0 = lg[t4][e2]; e0 = e2; }
                        int e1 = -1; float v1 = 0.f;
#pragma unroll
                        for (int e2 = 0; e2 < 8; ++e2) if (e2 != e0 && (e1 < 0 || lg[t4][e2] > v1)) { v1 = lg[t4][e2]; e1 = e2; }
                        const float ex = expf((v1 - v0) * r), g0 = 1.f / (1.f + ex), g1 = ex / (1.f + ex);
                        sel[wave * 8 + q4 * 4 + t4] = (unsigned)e0 | ((unsigned)e1 << 8); tokgate[2 * tok] = g0; tokgate[2 * tok + 1] = g1; }
                }
            }
            __syncthreads();
            if (wave == 0) { const unsigned sv = sel[lane]; const int e0 = sv & 0xff, e1 = sv >> 8; unsigned rank0 = 0, rank1 = 0;
                const unsigned long long lt = (1ull << lane) - 1ull;
#pragma unroll
                for (int e = 0; e < 8; ++e) { const unsigned long long m0 = __ballot(e0 == e), m1 = __ballot(e1 == e);
                    if (e0 == e) rank0 = __popcll(m0 & lt); if (e1 == e) rank1 = __popcll(m1 & lt);
                    if (lane == 0) { ctl[CW_HIST + blk * 16 + e] = __popcll(m0); ctl[CW_HIST + blk * 16 + 8 + e] = __popcll(m1); } }
                toksel[blk * 64 + lane] = sv | (rank0 << 16) | (rank1 << 24); }
            __syncthreads();
        }
    }
    SEAM(10);

    REP(11) if (IN(11)) {
        LAS unsigned* hs = (LAS unsigned*)lds;
        for (int i = tid; i < 4096; i += NTHR) hs[i] = ctl[CW_HIST + i];
        __syncthreads();
        if (tid < 16) hs[4096 + tid] = 0u;
        __syncthreads();
        { unsigned s = 0; const int g2 = tid & 15;
#pragma unroll
          for (int b2 = tid >> 4; b2 < 256; b2 += 32) s += hs[b2 * 16 + g2];
          atomicAdd((unsigned*)&hs[4096 + g2], s); }
        __syncthreads();
        if (tid == 0) { unsigned acc = 0; for (int g2 = 0; g2 < 16; ++g2) { hs[4128 + g2] = acc; acc += (hs[4096 + g2] + 255u) & ~255u; } hs[4128 + 16] = acc; }
        __syncthreads();
        if (bx == 0) {
            if (tid == 0) { ctl[CW_MOE] = hs[4128 + 8] >> 8; ctl[CW_MOE + 1] = hs[4128 + 16] >> 8; }
            if (tid < 16) { const unsigned t0 = hs[4128 + tid] >> 8, t1 = hs[4128 + tid + 1] >> 8; for (unsigned t = t0; t < t1; ++t) ctl[CW_MOE + 16 + t] = tid & 7; }
        }
        for (int blk = vcu; blk < T / 64; blk += G) {
            if (tid < 16) hs[4160 + tid] = 0u;
            __syncthreads();
            { unsigned s = 0; const int g2 = tid & 15;
#pragma unroll
              for (int b2 = tid >> 4; b2 < 256; b2 += 32) s += (b2 < blk) ? hs[b2 * 16 + g2] : 0u;
              atomicAdd((unsigned*)&hs[4160 + g2], s); }
            __syncthreads();
            for (int tl = wave; tl < 64; tl += NWAVES) {
                const int tok = blk * 64 + tl; const unsigned sv = toksel[tok];
                const GAS f32x4* xr = (const GAS f32x4*)(out + (size_t)tok * D + 16 * lane); const f32x4 v0 = xr[0], v1 = xr[1], v2 = xr[2], v3 = xr[3];
                v4u pk; pk.x = pg8::pk4_fp8(v0[0], v0[1], v0[2], v0[3]); pk.y = pg8::pk4_fp8(v1[0], v1[1], v1[2], v1[3]); pk.z = pg8::pk4_fp8(v2[0], v2[1], v2[2], v2[3]); pk.w = pg8::pk4_fp8(v3[0], v3[1], v3[2], v3[3]);
#pragma unroll
                for (int sl = 0; sl < 2; ++sl) { const int e = (sv >> (8 * sl)) & 0xff, rank = (sv >> (16 + 8 * sl)) & 0xff, g2 = sl * 8 + e;
                    const unsigned srow = hs[4128 + g2] + hs[4160 + g2] + rank;
                    *(GAS v4u*)(SORTA8 + (size_t)srow * D + lane * 16) = pk;
                    if (lane == 0) { rowtok[srow] = tok; rowgate[srow] = tokgate[2 * tok + sl]; } }
            }
            __syncthreads();
        }
        for (int g2 = vcu; g2 < 16; g2 += G) {
            const unsigned r0 = hs[4128 + g2] + hs[4096 + g2], r1 = hs[4128 + g2 + 1];
            for (unsigned r = r0 + wave; r < r1; r += NWAVES) { if (lane == 0) { rowtok[r] = -1; rowgate[r] = 0.f; }
                *(GAS v4u*)(SORTA8 + (size_t)r * D + lane * 16) = (v4u){0u, 0u, 0u, 0u}; }
        }
    }
    SEAM(11);

#define MOE_CHUNK(PH, CH) \
    REP(PH) if (IN(PH)) { const int nA = (int)__builtin_amdgcn_readfirstlane(ctl[CW_MOE]), nT = (int)__builtin_amdgcn_readfirstlane(ctl[CW_MOE + 1]); \
        const int tile0 = (CH) ? nA : 0, ntile = (CH) ? nT - nA : nA; \
        pg8::Gemm g{(const bf16*)(SORTA8 + (size_t)tile0 * 256 * D), (const bf16*)WEgu8, 0, 0, D / 2}; pg8::MoeOrder S; S.init(ntile, 2 * FFE / 256, G, bx, tile0, (const int*)(ctl + CW_MOE + 16)); \
        pg8::EpiSwiglu<true> E{ACTE8, FFE, ss3, 1, rowtok, tile0, 2 * FFE / 256, 1.f / W8_SCALE}; \
        pg8::gemm_phase<pg8::EpiSwiglu<true>, pg8::MoeOrder, true, true, true>(lds, g, S, E); } \
    SEAM(PH); \
    if (IN((PH) + 1)) { const int nA = (int)__builtin_amdgcn_readfirstlane(ctl[CW_MOE]), nT = (int)__builtin_amdgcn_readfirstlane(ctl[CW_MOE + 1]); \
        const int tile0 = (CH) ? nA : 0, ntile = (CH) ? nT - nA : nA; \
        pg8::Gemm g{(const bf16*)ACTE8, (const bf16*)WEd8, 0, 0, FFE / 2}; pg8::MoeOrder S; S.init(ntile, D / 256, G, bx, tile0, (const int*)(ctl + CW_MOE + 16)); \
        pg8::EpiMoeDown E{out, rowtok, rowgate, tile0, 1.f / W8_SCALE, (args.flags >> 2) & 1}; \
        pg8::gemm_phase<pg8::EpiMoeDown, pg8::MoeOrder, true, true, true>(lds, g, S, E); }
    MOE_CHUNK(12, 0)
    SEAM(13);
    MOE_CHUNK(14, 1)
#undef MOE_CHUNK
#undef IN
#undef SEAM
}

constexpr int N_PHASES = 16;
extern "C" void kernel_launch(void* const* d_in, const int* in_sizes, int n_in, void* d_out, int out_size, void* d_ws, size_t ws_size, hipStream_t stream) {
    static int grid = 0;
    if (grid == 0) {
        if (n_in != 27 || out_size != T * D || ws_size < WS_END) { fprintf(stderr, "kernel_launch: unexpected problem (n_in %d, out %d, ws %zu)\n", n_in, out_size, ws_size); grid = -1; return; }
        int dev = 0, cus = 0, per_cu = 0;
        if (hipGetDevice(&dev) != hipSuccess || hipDeviceGetAttribute(&cus, hipDeviceAttributeMultiprocessorCount, dev) != hipSuccess) { grid = -1; return; }
        if (hipFuncSetAttribute((const void*)fwd_kernel, hipFuncAttributeMaxDynamicSharedMemorySize, LDS_BYTES) != hipSuccess) { fprintf(stderr, "kernel_launch: hipFuncSetAttribute failed\n"); grid = -1; return; }
        if (hipOccupancyMaxActiveBlocksPerMultiprocessor(&per_cu, (const void*)fwd_kernel, NTHR, LDS_BYTES) != hipSuccess || per_cu < 1) { fprintf(stderr, "kernel_launch: occupancy query says %d\n", per_cu); }
        (void)hipGetLastError();
        grid = cus;
    }
    if (grid < 0) return;
    (void)hipMemsetAsync(d_ws, 0, CTL_ZERO_BYTES, stream);
    KArgs a{};
    for (int i = 0; i < 27; ++i) a.in[i] = d_in[i];
    a.out = (float*)d_out; a.ws = (unsigned char*)d_ws; a.ph_lo = 0; a.ph_hi = N_PHASES;
    hipLaunchKernelGGL(fwd_kernel, dim3(grid), dim3(NTHR), LDS_BYTES, stream, a);
#if defined(PROBE_LO)
    (void)hipMemsetAsync((char*)d_ws + CW_BAR * 4, 0, XCD_BAR_WORDS * 4, stream);
    a.ph_lo = PROBE_LO; a.ph_hi = PROBE_HI;
#if defined(PROBE_FLAGS)
    a.flags = PROBE_FLAGS;
#endif
    hipLaunchKernelGGL(fwd_kernel, dim3(grid), dim3(NTHR), LDS_BYTES, stream, a);
#endif
}
```

```cpp
#include <hip/hip_runtime.h>
#include <cstdio>
#include <cstdint>
#include <cmath>
#define PROBE_MASK 0x0
namespace pg8 {
#define PG8_LAS __attribute__((address_space(3)))
typedef unsigned short bf16_t;
typedef short bf16x8 __attribute__((ext_vector_type(8)));
typedef float f32x4 __attribute__((ext_vector_type(4)));
typedef unsigned u32x4 __attribute__((ext_vector_type(4)));
constexpr int BM = 256, BK = 64, HALF = 128, HTB = HALF * BK * 2  , STAGE_BYTES = 8 * HTB, NXCD = 8, WGM = 8;

__host__ __device__ __forceinline__ int lds_byte(int r, int c) { const int st = (r >> 4) * 2 + (c >> 5), rr = r & 15, cc = c & 31, ob = rr * 64 + cc * 2; return st * 1024 + (ob ^ (((ob >> 9) & 1) << 5)); }
__host__ __device__ __forceinline__ void stage_rc(int b, int& R, int& C) { const int st = b / 1024, sb = b % 1024, swz = sb ^ (((sb >> 9) & 1) << 5); R = (st >> 1) * 16 + swz / 64; C = (st & 1) * 32 + (swz % 64) / 2; }
__host__ __device__ __forceinline__ int perm32(int rho) { const int n = rho >> 4, i = rho & 15; return 8 * (i >> 2) + 4 * n + (i & 3); }

struct Unit { int pm, pn; };
struct Gemm { const bf16_t* A; const bf16_t* Bt; int M, N, K; };

struct StaticOrder {
    int nM, nN, nwg, G, c;
    __host__ __device__ void init(int M, int N, int G_, int c_) { nM = M / BM; nN = N / BM; nwg = nM * nN; G = G_; c = c_; }
    __host__ __device__ bool next(int i, Unit& u) const {
        const long L = (long)i * G + c; if (L >= nwg) return false;
        int wgid = (int)L; { const int q = nwg / NXCD, r = nwg % NXCD, xcd = wgid % NXCD, off = wgid / NXCD; wgid = (xcd < r ? xcd * (q + 1) : r * (q + 1) + (xcd - r) * q) + off; }
        const int nig = WGM * nN, gid = wgid / nig, fm = gid * WGM, gsz = (nM - fm) < WGM ? (nM - fm) : WGM;
        u.pm = fm + ((wgid % nig) % gsz); u.pn = (wgid % nig) / gsz; return true;
    }
    __device__ __forceinline__ void a_ready(const Unit&) const {}
    __device__ __forceinline__ void done(const Unit&) const {}
};

struct MoeOrder {
    int nM, nN, nwg, G, c, tile0; const int* tile_expert;
    int H, R;
    __device__ void init(int ntiles, int npn, int G_, int c_, int tile0_, const int* te, int H_ = 0, int R_ = 0) { nM = ntiles; nN = npn; nwg = nM * nN; G = G_; c = c_; tile0 = tile0_; tile_expert = te; H = H_; R = R_; }
    __device__ bool next(int i, Unit& u) const {
        long L;
        if (H == 0) L = (long)i * G + c;
        else if (c >= H) { if (i >= R) return false; L = (long)i * (G - H) + (c - H); }
        else L = (long)R * (G - H) + (long)i * H + c;
        if (L >= nwg) return false;
        int wgid = (int)L; { const int q = nwg / NXCD, r = nwg % NXCD, xcd = wgid % NXCD, off = wgid / NXCD; wgid = (xcd < r ? xcd * (q + 1) : r * (q + 1) + (xcd - r) * q) + off; }
        const int nig = WGM * nN, gid = wgid / nig, fm = gid * WGM, gsz = (nM - fm) < WGM ? (nM - fm) : WGM;
        u.pm = fm + ((wgid % nig) % gsz); const int pnl = (wgid % nig) / gsz;
        const int e = __builtin_amdgcn_readfirstlane(tile_expert[tile0 + u.pm]);
        u.pn = e * nN + pnl; return true;
    }
    __device__ __forceinline__ void a_ready(const Unit&) const {}
    __device__ __forceinline__ void done(const Unit&) const {}
};

__device__ __forceinline__ unsigned cvt_pk_bf16(float lo, float hi) { unsigned r; asm volatile("v_cvt_pk_bf16_f32 %0, %1, %2" : "=v"(r) : "v"(lo), "v"(hi)); return r; }
__device__ __forceinline__ u32x4 pack8(const f32x4& a, const f32x4& b) { u32x4 w; w.x = cvt_pk_bf16(a[0], a[1]); w.y = cvt_pk_bf16(a[2], a[3]); w.z = cvt_pk_bf16(b[0], b[1]); w.w = cvt_pk_bf16(b[2], b[3]); return w; }
__device__ __forceinline__ unsigned pk4_fp8(float a, float b, float c, float d) { int w = __builtin_amdgcn_cvt_pk_fp8_f32(a, b, 0, false); w = __builtin_amdgcn_cvt_pk_fp8_f32(c, d, w, true); return (unsigned)w; }
constexpr float RMS_EPS = 1e-6f;
constexpr float LOG2E = 1.4426950408889634f;
constexpr float C2 = 0.125f * LOG2E;
__device__ __forceinline__ float row_ss(const float* ss, int nparts, int row) {
    if (nparts == 1) return ss[row];
    const f32x4* p = (const f32x4*)(ss + (size_t)row * 16); f32x4 a = p[0], b = p[1], c = p[2], d = p[3]; a = (a + b) + (c + d); return (a[0] + a[1]) + (a[2] + a[3]);
}

struct EpiProj {
    static constexpr bool PERM = true, AFTER_DRAIN = false;
    bf16_t* O; int ldc; const float* ss; int nparts; const float* gq; const float* gk; const float* rope; int layer; float pre;
    __device__ __forceinline__ void operator()(const f32x4 (&acc)[2][2][4][2], const Unit& u, int wr, int wc, int fr, int fq) const {
        const int pn = u.pn; int kind = 0; float scale = 1.f; bool rope_on = false;
        if (layer == 0) { const int t = pn >> 1; if (t == 0) scale = C2; else if (t == 3) { kind = 1; scale = C2; rope_on = true; } else if (t == 4) { kind = 2; rope_on = true; } }
        else { const int t = pn >> 2; if (t == 0) { kind = 1; scale = C2; } else if (t == 1) kind = 2; }
        const float* gv = (kind == 1) ? gq : gk;
        f32x4 g[2][2];
#pragma unroll
        for (int bj = 0; bj < 2; ++bj)
#pragma unroll
            for (int n = 0; n < 2; ++n) g[bj][n] = kind ? *(const f32x4*)(gv + 32 * bj + 8 * fq + 4 * n) : (f32x4){1.f, 1.f, 1.f, 1.f};
        const int row0 = u.pm * BM + wr * 64 + fr, col0 = pn * BM + wc * 64 + 8 * fq;
#pragma unroll
        for (int ai = 0; ai < 2; ++ai)
#pragma unroll
            for (int m = 0; m < 4; ++m) {
                const int row = row0 + ai * HALF + m * 16;
                const float r = rsqrtf(row_ss(ss, nparts, row) * (1.f / 1024.f) + RMS_EPS) * pre;
                f32x4 v[2][2]; float s = 0.f;
#pragma unroll
                for (int bj = 0; bj < 2; ++bj)
#pragma unroll
                    for (int n = 0; n < 2; ++n) { v[bj][n] = acc[ai][bj][m][n] * r; const f32x4 x = v[bj][n]; s += (x[0] * x[0] + x[1] * x[1]) + (x[2] * x[2] + x[3] * x[3]); }
                if (kind) {
                    s += __shfl_xor(s, 16); s += __shfl_xor(s, 32);
                    const float rs = rsqrtf(s * (1.f / 64.f) + RMS_EPS);
#pragma unroll
                    for (int bj = 0; bj < 2; ++bj)
#pragma unroll
                        for (int n = 0; n < 2; ++n) v[bj][n] = v[bj][n] * rs * g[bj][n];
                    if (rope_on) {
                        f32x4 p[2];
#pragma unroll
                        for (int n = 0; n < 2; ++n)
#pragma unroll
                            for (int j = 0; j < 4; ++j) p[n][j] = __shfl_xor(v[0][n][j], 16);
                        const f32x4 c0 = *(const f32x4*)(rope + (size_t)row * 16), c1 = *(const f32x4*)(rope + (size_t)row * 16 + 4);
                        const f32x4 s0 = *(const f32x4*)(rope + (size_t)row * 16 + 8), s1 = *(const f32x4*)(rope + (size_t)row * 16 + 12);
                        if (fq == 0) { v[0][0] = v[0][0] * c0 - p[0] * s0; v[0][1] = v[0][1] * c1 - p[1] * s1; }
                        else if (fq == 1) { v[0][0] = v[0][0] * c0 + p[0] * s0; v[0][1] = v[0][1] * c1 + p[1] * s1; }
                    }
                }
                bf16_t* rowp = O + (size_t)row * ldc + col0;
#pragma unroll
                for (int bj = 0; bj < 2; ++bj) *(u32x4*)(rowp + 32 * bj) = pack8(v[bj][0] * scale, v[bj][1] * scale);
            }
    }
};

struct EpiResid {
    static constexpr bool PERM = true, AFTER_DRAIN = false;
    const float* base; float* out; bf16_t* xb; float* ss; float pre; unsigned char* x8;
    __device__ __forceinline__ void operator()(const f32x4 (&acc)[2][2][4][2], const Unit& u, int wr, int wc, int fr, int fq) const {
        const int row0 = u.pm * BM + wr * 64 + fr, col0 = u.pn * BM + wc * 32 + 8 * fq;
#pragma unroll
        for (int ai = 0; ai < 2; ++ai)
#pragma unroll
            for (int m = 0; m < 4; ++m) {
                const int row = row0 + ai * HALF + m * 16; float s = 0.f;
#pragma unroll
                for (int bj = 0; bj < 2; ++bj) {
                    const size_t off = (size_t)row * 1024 + col0 + bj * HALF;
                    const f32x4 v0 = acc[ai][bj][m][0] * pre + *(const f32x4*)(base + off), v1 = acc[ai][bj][m][1] * pre + *(const f32x4*)(base + off + 4);
                    *(f32x4*)(out + off) = v0; *(f32x4*)(out + off + 4) = v1;
                    if (xb) *(u32x4*)(xb + off) = pack8(v0, v1);
                    if (x8) { typedef unsigned u32x2 __attribute__((ext_vector_type(2))); u32x2 w8; w8.x = pk4_fp8(v0[0], v0[1], v0[2], v0[3]); w8.y = pk4_fp8(v1[0], v1[1], v1[2], v1[3]); *(u32x2*)(x8 + off) = w8; }
                    s += (v0[0] * v0[0] + v0[1] * v0[1]) + (v0[2] * v0[2] + v0[3] * v0[3]) + (v1[0] * v1[0] + v1[1] * v1[1]) + (v1[2] * v1[2] + v1[3] * v1[3]);
                }
                if (ss) { s += __shfl_xor(s, 16); s += __shfl_xor(s, 32); if (fq == 0) ss[(size_t)row * 16 + u.pn * 4 + wc] = s; }
            }
    }
};

template <bool OUT8> struct EpiSwiglu {
    static constexpr bool PERM = true, AFTER_DRAIN = false;
    void* O; int ldc; const float* ss; int nparts; const int* rowtok; int tile0; int npn; float pre;
    __device__ __forceinline__ void operator()(const f32x4 (&acc)[2][2][4][2], const Unit& u, int wr, int wc, int fr, int fq) const {
        const int pnl = u.pn % npn; const int row0 = u.pm * BM + wr * 64 + fr, col0 = pnl * HALF + wc * 32 + 8 * fq;
#pragma unroll
        for (int ai = 0; ai < 2; ++ai)
#pragma unroll
            for (int m = 0; m < 4; ++m) {
                const int row = row0 + ai * HALF + m * 16;
                int tok = row; if (rowtok) tok = rowtok[tile0 * BM + row];
                const float r = (tok >= 0) ? rsqrtf(row_ss(ss, nparts, tok >= 0 ? tok : 0) * (1.f / 1024.f) + RMS_EPS) * pre : 0.f;
                f32x4 a[2];
#pragma unroll
                for (int n = 0; n < 2; ++n)
#pragma unroll
                    for (int j = 0; j < 4; ++j) { const float gt = acc[ai][0][m][n][j] * r, up = acc[ai][1][m][n][j] * r;
                        a[n][j] = gt * __builtin_amdgcn_rcpf(1.f + __builtin_amdgcn_exp2f(-gt * LOG2E)) * up; }
                if constexpr (OUT8) { typedef unsigned u32x2 __attribute__((ext_vector_type(2))); u32x2 w; w.x = pk4_fp8(a[0][0], a[0][1], a[0][2], a[0][3]); w.y = pk4_fp8(a[1][0], a[1][1], a[1][2], a[1][3]); *(u32x2*)((unsigned char*)O + (size_t)row * ldc + col0) = w; }
                else *(u32x4*)((bf16_t*)O + (size_t)row * ldc + col0) = pack8(a[0], a[1]);
            }
    }
};

struct EpiMoeDown {
    static constexpr bool PERM = true, AFTER_DRAIN = false;
    float* out; const int* rowtok; const float* rowgate; int tile0; float pre; int nostore;
    __device__ __forceinline__ void operator()(const f32x4 (&acc)[2][2][4][2], const Unit& u, int wr, int wc, int fr, int fq) const {
        const int pnl = u.pn & 3; const int row0 = (tile0 + u.pm) * BM + wr * 64 + fr, col0 = pnl * BM + wc * 32 + 8 * fq;
#pragma unroll
        for (int ai = 0; ai < 2; ++ai)
#pragma unroll
            for (int m = 0; m < 4; ++m) {
                const int srow = row0 + ai * HALF + m * 16; const int tok = nostore ? -1 : rowtok[srow];
                if (tok >= 0) { const float gt = rowgate[srow] * pre;
#pragma unroll
                    for (int bj = 0; bj < 2; ++bj)
#pragma unroll
                        for (int n = 0; n < 2; ++n) { f32x4* p = (f32x4*)(out + (size_t)tok * 1024 + col0 + bj * HALF + 4 * n); *p = *p + acc[ai][bj][m][n] * gt; } }
            }
    }
};

typedef int i32x4 __attribute__((ext_vector_type(4)));
typedef int i32x8 __attribute__((ext_vector_type(8)));
template <class Epi, class Sched, bool ALIGN_EPI = false, bool SP2 = false, bool F8 = false>
__device__ __forceinline__ void gemm_phase(PG8_LAS unsigned char* lds, const Gemm g, const Sched& S, const Epi& E) {
    const int tid = threadIdx.x, wid = __builtin_amdgcn_readfirstlane(tid >> 6), lane = tid & 63, wr = wid >> 2, wc = wid & 3, fr = lane & 15, fq = lane >> 4;
    const int K = g.K, nt = K / BK;
    unsigned voffA[2], voffB[2];
#pragma unroll
    for (int i = 0; i < 2; ++i) { int R, C; stage_rc(tid * 16 + i * 8192, R, C); const int Rb = Epi::PERM ? ((R & ~31) + perm32(R & 31)) : R;
        voffA[i] = (unsigned)(R * K + C) * 2u; voffB[i] = (unsigned)(Rb * K + C) * 2u; }
    const size_t kstep = (size_t)(BK * 2);
    const size_t hstep = (size_t)HALF * K * 2;
    const size_t tstep = 2 * hstep;
    const unsigned ldsw = (unsigned)wid * 1024u;
    const int aoff = lds_byte(wr * 64 + fr, fq * 8), boff = lds_byte(wc * 32 + fr, fq * 8);
#define PG8_SA(b, h) (((b) * 2 + (h)) * HTB)
#define PG8_SB(b, h) ((4 + (b) * 2 + (h)) * HTB)
#define PG8_STAGE(bufoff, gbase, voff) do { _Pragma("unroll") for (int _i = 0; _i < 2; ++_i) \
        __builtin_amdgcn_global_load_lds((const unsigned*)((const char*)(gbase) + (voff)[_i]), (PG8_LAS unsigned*)(lds + (bufoff) + ldsw + _i * 8192), 16, 0, 0); } while (0)
#define PG8_LDA(dst, b, h) do { if constexpr (F8) { _Pragma("unroll") for (int m = 0; m < 4; ++m) dst##8[m] = PG8_CAT(*(const PG8_LAS bf16x8*)(lds + PG8_SA(b, h) + aoff + m * 2048), *(const PG8_LAS bf16x8*)(lds + PG8_SA(b, h) + aoff + m * 2048 + 1024)); } \
        else { _Pragma("unroll") for (int m = 0; m < 4; ++m) _Pragma("unroll") for (int k = 0; k < 2; ++k) dst[m][k] = *(const PG8_LAS bf16x8*)(lds + PG8_SA(b, h) + aoff + m * 2048 + k * 1024); } } while (0)
#define PG8_LDB(dst, b, h) do { if constexpr (F8) { _Pragma("unroll") for (int n = 0; n < 2; ++n) dst##8[n] = PG8_CAT(*(const PG8_LAS bf16x8*)(lds + PG8_SB(b, h) + boff + n * 2048), *(const PG8_LAS bf16x8*)(lds + PG8_SB(b, h) + boff + n * 2048 + 1024)); } \
        else { _Pragma("unroll") for (int n = 0; n < 2; ++n) _Pragma("unroll") for (int k = 0; k < 2; ++k) dst[n][k] = *(const PG8_LAS bf16x8*)(lds + PG8_SB(b, h) + boff + n * 2048 + k * 1024); } } while (0)
#define PG8_CAT(x, y) __builtin_shufflevector(__builtin_bit_cast(i32x4, (x)), __builtin_bit_cast(i32x4, (y)), 0, 1, 2, 3, 4, 5, 6, 7)
#define PG8_MMA(ai, bj, At, Bt) do { __builtin_amdgcn_s_setprio(1); _Pragma("unroll") for (int m = 0; m < 4; ++m) _Pragma("unroll") for (int n = 0; n < 2; ++n) { \
        if constexpr (F8) { asm volatile("v_mfma_f32_16x16x128_f8f6f4 %0, %1, %2, %0" : "+v"(acc[ai][bj][m][n]) : "v"(Bt##8[n]), "v"(At##8[m])); } \
        else { _Pragma("unroll") for (int k = 0; k < 2; ++k) acc[ai][bj][m][n] = __builtin_amdgcn_mfma_f32_16x16x32_bf16(Bt[n][k], At[m][k], acc[ai][bj][m][n], 0, 0, 0); } } __builtin_amdgcn_s_setprio(0); } while (0)
#define PG8_WAIT_V(n) asm volatile("s_waitcnt vmcnt(" #n ")" ::: "memory")
#define PG8_WAIT_L(n) asm volatile("s_waitcnt lgkmcnt(" #n ")" ::: "memory")
#define PG8_BAR __builtin_amdgcn_s_barrier()
#define PG8_SCHED __builtin_amdgcn_sched_barrier(0)
    Unit cur, nxt; int ui = 0;
    if (!S.next(0, cur)) return;
    f32x4 acc[2][2][4][2];
#pragma unroll
    for (int a = 0; a < 2; ++a)
#pragma unroll
        for (int b = 0; b < 2; ++b)
#pragma unroll
            for (int m = 0; m < 4; ++m)
#pragma unroll
                for (int n = 0; n < 2; ++n) acc[a][b][m][n] = (f32x4){0.f, 0.f, 0.f, 0.f};
    bf16x8 At[4][2], B0[2][2], B1[2][2];
    i32x8 At8[4], B08[2], B18[2];
    const char* cA = (const char*)g.A + (size_t)cur.pm * tstep; const char* cB = (const char*)g.Bt + (size_t)cur.pn * tstep;
    S.a_ready(cur);
    if constexpr (SP2) {
        PG8_STAGE(PG8_SB(0, 0), cB, voffB); PG8_STAGE(PG8_SB(0, 1), cB + hstep, voffB); PG8_STAGE(PG8_SA(0, 0), cA, voffA); PG8_STAGE(PG8_SA(0, 1), cA + hstep, voffA);
        if (wr == 1) PG8_BAR;
        PG8_WAIT_V(2); PG8_BAR;
        PG8_STAGE(PG8_SB(1, 0), cB + kstep, voffB); PG8_STAGE(PG8_SA(1, 0), cA + kstep, voffA); PG8_STAGE(PG8_SB(1, 1), cB + hstep + kstep, voffB);
        PG8_WAIT_V(6); PG8_BAR;
    } else {
        PG8_STAGE(PG8_SB(0, 0), cB, voffB); PG8_STAGE(PG8_SA(0, 0), cA, voffA); PG8_STAGE(PG8_SB(0, 1), cB + hstep, voffB); PG8_STAGE(PG8_SA(0, 1), cA + hstep, voffA);
        if (wr == 1) PG8_BAR;
        PG8_WAIT_V(4); PG8_BAR;
        PG8_STAGE(PG8_SB(1, 0), cB + kstep, voffB); PG8_STAGE(PG8_SA(1, 0), cA + kstep, voffA); PG8_STAGE(PG8_SB(1, 1), cB + hstep + kstep, voffB);
        PG8_WAIT_V(6); PG8_BAR;
    }
    for (;;) {
        const bool has_next = S.next(ui + 1, nxt);
        const char* nA = has_next ? (const char*)g.A + (size_t)nxt.pm * tstep : cA; const char* nB = has_next ? (const char*)g.Bt + (size_t)nxt.pn * tstep : cB;
#pragma nounroll
        for (int t = 0; t < nt; t += 2) {
            const bool last = (t == nt - 2);
            const char* a1 = cA + (size_t)(t + 1) * kstep;
            const char* a2 = last ? nA : cA + (size_t)(t + 2) * kstep; const char* b2 = last ? nB : cB + (size_t)(t + 2) * kstep;
            const char* a3 = a2 + kstep; const char* b3 = b2 + kstep;
            if (last && has_next) S.a_ready(nxt);
            if constexpr (SP2) {
            PG8_LDB(B0, 0, 0); PG8_LDB(B1, 0, 1); PG8_SCHED; PG8_LDA(At, 0, 0); PG8_STAGE(PG8_SA(1, 1), a1 + hstep, voffA);
            PG8_WAIT_V(8); PG8_WAIT_L(0); PG8_BAR; PG8_MMA(0, 0, At, B0); PG8_MMA(0, 1, At, B1); PG8_BAR; PG8_SCHED;
            PG8_LDA(At, 0, 1); PG8_STAGE(PG8_SB(0, 0), b2, voffB); PG8_STAGE(PG8_SB(0, 1), b2 + hstep, voffB); PG8_STAGE(PG8_SA(0, 0), a2, voffA);
            PG8_WAIT_V(8); PG8_WAIT_L(0); PG8_BAR; PG8_MMA(1, 0, At, B0); PG8_MMA(1, 1, At, B1); PG8_BAR; PG8_SCHED;
            PG8_LDB(B0, 1, 0); PG8_LDB(B1, 1, 1); PG8_SCHED; PG8_LDA(At, 1, 0); PG8_STAGE(PG8_SA(0, 1), a2 + hstep, voffA);
            PG8_WAIT_V(8); PG8_WAIT_L(0); PG8_BAR; PG8_MMA(0, 0, At, B0); PG8_MMA(0, 1, At, B1); PG8_BAR; PG8_SCHED;
            PG8_LDA(At, 1, 1); PG8_STAGE(PG8_SB(1, 0), b3, voffB); PG8_STAGE(PG8_SB(1, 1), b3 + hstep, voffB); PG8_STAGE(PG8_SA(1, 0), a3, voffA);
            PG8_WAIT_V(8); PG8_WAIT_L(0); PG8_BAR; PG8_MMA(1, 0, At, B0); PG8_MMA(1, 1, At, B1); PG8_BAR; PG8_SCHED;
            } else {
            PG8_LDB(B0, 0, 0); PG8_SCHED; PG8_LDA(At, 0, 0); PG8_STAGE(PG8_SA(1, 1), a1 + hstep, voffA);
            PG8_WAIT_L(8); PG8_BAR; PG8_WAIT_L(0); PG8_MMA(0, 0, At, B0); PG8_BAR; PG8_SCHED;
            PG8_LDB(B1, 0, 1); PG8_STAGE(PG8_SB(0, 0), b2, voffB);
            PG8_BAR; PG8_WAIT_L(0); PG8_MMA(0, 1, At, B1); PG8_BAR;
            PG8_LDA(At, 0, 1); PG8_STAGE(PG8_SA(0, 0), a2, voffA);
            PG8_BAR; PG8_WAIT_L(0); PG8_MMA(1, 0, At, B0); PG8_BAR; PG8_SCHED;
            PG8_STAGE(PG8_SB(0, 1), b2 + hstep, voffB);
            PG8_WAIT_V(6); PG8_BAR; PG8_MMA(1, 1, At, B1); PG8_BAR;
            PG8_LDB(B0, 1, 0); PG8_SCHED; PG8_LDA(At, 1, 0); PG8_STAGE(PG8_SA(0, 1), a2 + hstep, voffA);
            PG8_WAIT_L(8); PG8_BAR; PG8_WAIT_L(0); PG8_MMA(0, 0, At, B0); PG8_BAR; PG8_SCHED;
            PG8_LDB(B1, 1, 1); PG8_STAGE(PG8_SB(1, 0), b3, voffB);
            PG8_BAR; PG8_WAIT_L(0); PG8_MMA(0, 1, At, B1); PG8_BAR;
            PG8_LDA(At, 1, 1); PG8_STAGE(PG8_SA(1, 0), a3, voffA);
            PG8_BAR; PG8_WAIT_L(0); PG8_MMA(1, 0, At, B0); PG8_BAR; PG8_SCHED;
            PG8_STAGE(PG8_SB(1, 1), b3 + hstep, voffB);
            PG8_WAIT_V(6); PG8_BAR; PG8_MMA(1, 1, At, B1); PG8_BAR;
            }
        }
        if constexpr (F8) asm volatile("s_nop 15\n\ts_nop 15\n\ts_nop 15" ::: "memory");
        if constexpr (ALIGN_EPI) { if (wr == 0) PG8_BAR; }
        if constexpr (!Epi::AFTER_DRAIN) { E(acc, cur, wr, wc, fr, fq); S.done(cur); }
        if (!has_next) break;
#pragma unroll
        for (int a = 0; a < 2; ++a)
#pragma unroll
            for (int b = 0; b < 2; ++b)
#pragma unroll
                for (int m = 0; m < 4; ++m)
#pragma unroll
                    for (int n = 0; n < 2; ++n) acc[a][b][m][n] = (f32x4){0.f, 0.f, 0.f, 0.f};
        cur = nxt; cA = nA; cB = nB; ++ui;
        if constexpr (ALIGN_EPI) { if (wr == 1) PG8_BAR; }
    }
    PG8_WAIT_V(0);
    if constexpr (!ALIGN_EPI) { if (wr == 0) PG8_BAR; }
    PG8_BAR;
    if constexpr (Epi::AFTER_DRAIN) { E.fused(acc, cur, wr, wc, fr, fq, lds, wid, lane); S.done(cur); }
#undef PG8_SA
#undef PG8_SB
#undef PG8_STAGE
#undef PG8_LDA
#undef PG8_LDB
#undef PG8_MMA
#undef PG8_CAT
#undef PG8_WAIT_V
#undef PG8_WAIT_L
#undef PG8_BAR
#undef PG8_SCHED
}
}

namespace att {
using pg8::bf16_t; using pg8::bf16x8; using pg8::u32x4;
typedef float f32x16 __attribute__((ext_vector_type(16)));
typedef short s16x4 __attribute__((ext_vector_type(4)));
typedef float f32x2_t __attribute__((ext_vector_type(2))); typedef __bf16 bf16x2_t __attribute__((ext_vector_type(2)));
#define ALAS __attribute__((address_space(3)))
typedef ALAS const char* lds_cptr;
constexpr int SEQ = 8192, PITCH = 3072;
constexpr int KVSLOT = 24576;
constexpr int L_WS = 4 * KVSLOT, L_TAB = L_WS + 2048, L_FLAG = L_TAB + 1056, L_END = L_FLAG + 64, L_OST = 0;
constexpr float SB_THR = 152.f;
__device__ __forceinline__ int crow(int r, int hi) { return (r & 3) + 8 * (r >> 2) + 4 * hi; }
__device__ __forceinline__ void glds16(const void* gsrc, unsigned lds_dst) { unsigned keep;
    asm volatile("s_mov_b32 %0, m0\n\ts_mov_b32 m0, %2\n\ts_nop 0\n\tglobal_load_lds_dwordx4 %1, off\n\ts_mov_b32 m0, %0" : "=&s"(keep) : "v"(gsrc), "s"(lds_dst) : "memory"); }
__device__ __forceinline__ unsigned cvtpk(float lo, float hi) { f32x2_t v = {lo, hi}; bf16x2_t b = __builtin_convertvector(v, bf16x2_t); return __builtin_bit_cast(unsigned, b); }
__device__ __forceinline__ unsigned short f2bf(float f) { unsigned u = __builtin_bit_cast(unsigned, f); return (unsigned short)((u + 0x7fffu + ((u >> 16) & 1u)) >> 16); }
#define MFMA32(a, b, c) __builtin_amdgcn_mfma_f32_32x32x16_bf16((a), (b), (c), 0, 0, 0)

__device__ __forceinline__ void qkt(f32x16& p0, f32x16& p1, lds_cptr kb, const bf16x8* qr, const f32x16& cin) {
#pragma unroll
    for (int d0 = 0; d0 < 4; ++d0) {
        const bf16x8 b0 = *(const ALAS bf16x8*)(kb + d0 * 2048);
        const bf16x8 b1 = *(const ALAS bf16x8*)(kb + d0 * 2048 + 512);
        if (d0 == 0) { p0 = MFMA32(b0, qr[0], cin); p1 = MFMA32(b1, qr[0], cin); }
        else { p0 = MFMA32(b0, qr[d0], p0); p1 = MFMA32(b1, qr[d0], p1); }
    }
}
template <int ND> __device__ __forceinline__ void pv(f32x16* o, int vb, bf16x8 pa0, bf16x8 pa1, bf16x8 pa2, bf16x8 pa3) {
#pragma unroll
    for (int d0 = 0; d0 < ND; ++d0) { s16x4 lo[4], hi[4];
#pragma unroll
        for (int ks = 0; ks < 4; ++ks) {
            asm volatile("ds_read_b64_tr_b16 %0,%1 offset:%c2" : "=&v"(lo[ks]) : "v"(vb), "i"(d0 * 4096 + ks * 1024) : "memory");
            asm volatile("ds_read_b64_tr_b16 %0,%1 offset:%c2" : "=&v"(hi[ks]) : "v"(vb), "i"(d0 * 4096 + ks * 1024 + 512) : "memory"); }
        asm volatile("s_waitcnt lgkmcnt(0)" ::: "memory"); __builtin_amdgcn_sched_barrier(0);
#define ATT_PK(k) (bf16x8){lo[k][0], lo[k][1], lo[k][2], lo[k][3], hi[k][0], hi[k][1], hi[k][2], hi[k][3]}
        o[d0] = MFMA32(pa0, ATT_PK(0), o[d0]);
        o[d0] = MFMA32(pa1, ATT_PK(1), o[d0]);
        o[d0] = MFMA32(pa2, ATT_PK(2), o[d0]);
        o[d0] = MFMA32(pa3, ATT_PK(3), o[d0]);
#undef ATT_PK
    }
}

template <int MODE, int VD>
__device__ __forceinline__ void attn_unit(ALAS char* shm, const bf16_t* Qb, const bf16_t* Kb, const bf16_t* Vb, bf16_t* Ob, int opitch, int q0, float mref2, const float* tab) {
    constexpr int ND = VD / 32;
    const int tid = threadIdx.x, lane = tid & 63, r32 = lane & 31, hi = lane >> 5; const int wid = __builtin_amdgcn_readfirstlane(tid >> 6);
    const unsigned lds0 = (unsigned)(uintptr_t)shm;
    ALAS float* wsf = (ALAS float*)(shm + L_WS) + wid * 64;
    ALAS float* tabL = (ALAS float*)(shm + L_TAB);
    ALAS unsigned* flg = (ALAS unsigned*)(shm + L_FLAG);
    if (MODE == 1) { for (int i = tid; i < 257; i += 512) tabL[i] = tab[i] * pg8::LOG2E; }
    const bf16_t* Qw = Qb + (size_t)(q0 + wid * 32) * PITCH;
    bf16x8 qr[4];
#pragma unroll
    for (int d0 = 0; d0 < 4; ++d0) qr[d0] = *(const bf16x8*)(Qw + (size_t)r32 * PITCH + d0 * 16 + hi * 8);
    int t_first, n_t, t_step;
    if (MODE == 0) { t_first = 0; n_t = q0 / 64 + 4; t_step = 1; }
    else if (MODE == 1) { const int c0 = q0 / 64; t_first = c0 - 8 > 0 ? c0 - 8 : 0; n_t = c0 + 4 - t_first; t_step = 1; }
    else { t_first = q0 / 64 + 3; n_t = q0 / 64 + 4; t_step = -1; }
    const bf16_t* ksrc = Kb + (size_t)lane * PITCH + wid * 8;
    const bf16_t* vsrc = Vb + (size_t)(16 * (wid & 3) + (lane >> 2)) * PITCH + (wid >> 2) * 32 + (lane & 3) * 8;
#define ATT_DMA(t, slot) do { const size_t to_ = (size_t)(t) * 64 * PITCH; const unsigned sb_ = lds0 + (unsigned)(slot) * KVSLOT; \
        glds16(ksrc + to_, (unsigned)__builtin_amdgcn_readfirstlane(sb_ + wid * 1024)); \
        glds16(vsrc + to_, (unsigned)__builtin_amdgcn_readfirstlane(sb_ + 8192 + wid * 1024)); \
        if (VD == 128) glds16(vsrc + to_ + 64, (unsigned)__builtin_amdgcn_readfirstlane(sb_ + 8192 + (wid + 8) * 1024)); } while (0)
    f32x16 o[ND];
#pragma unroll
    for (int d = 0; d < ND; ++d) o[d] = f32x16{};
    f32x16 cin;
#pragma unroll
    for (int r = 0; r < 16; ++r) cin[r] = (MODE == 2) ? 0.f : -mref2;
    float l_reg = 0.f, A = 0.f; bool wdone = false;
    const int wrow0 = q0 + wid * 32, qrow = wrow0 + r32;
    const int vb0 = (int)lds0 + 8192 + ((lane >> 4) & 1) * 32 + (lane & 3) * 8 + (4 * hi + ((lane & 15) >> 2)) * 64;
    asm volatile("s_waitcnt vmcnt(0)" ::: "memory"); asm volatile("" : "+v"(qr[0]), "+v"(qr[1]), "+v"(qr[2]), "+v"(qr[3]));
    ATT_DMA(t_first, 0);
    for (int i = 0; i < n_t; ++i) {
        const int t = t_first + i * t_step, slot = i & 1;
        asm volatile("s_waitcnt vmcnt(0) lgkmcnt(0)\n\ts_barrier" ::: "memory");
        if (MODE == 2 && i > 0) { const int par = ((i - 1) & 1) * 8; unsigned all = 1u;
#pragma unroll
            for (int w = 0; w < 8; ++w) all &= flg[par + w];
            if (__builtin_amdgcn_readfirstlane(all)) break; }
        if (i + 1 < n_t) ATT_DMA(t + t_step, slot ^ 1);
        bool active;
        if (MODE == 0) active = (64 * t <= wrow0);
        else if (MODE == 1) { const int cw = wrow0 / 64; active = (t >= cw - 8) && (t <= cw); }
        else active = !wdone && (64 * t < wrow0 + 31);
        if (active) {
            const lds_cptr kb = (lds_cptr)shm + slot * KVSLOT + hi * 1024 + r32 * 16;
            f32x16 p0, p1; qkt(p0, p1, kb, qr, cin);
            if (MODE == 0) {
#pragma unroll
                for (int r = 0; r < 16; ++r) { p0[r] = __builtin_amdgcn_exp2f(p0[r]); p1[r] = __builtin_amdgcn_exp2f(p1[r]); }
            } else if (MODE == 1) {
                const int cw = wrow0 / 64;
                if (t <= cw - 3) { const float cb = tabL[256];
#pragma unroll
                    for (int r = 0; r < 16; ++r) { p0[r] = __builtin_amdgcn_exp2f(p0[r] + cb); p1[r] = __builtin_amdgcn_exp2f(p1[r] + cb); }
                } else { const int dq = qrow - 64 * t - 4 * hi;
#pragma unroll
                    for (int r = 0; r < 16; ++r) { int d0 = dq - ((r & 3) + 8 * (r >> 2)), d1 = d0 - 32;
                        d0 = d0 < -128 ? -128 : (d0 > 128 ? 128 : d0); d1 = d1 < -128 ? -128 : (d1 > 128 ? 128 : d1);
                        p0[r] = __builtin_amdgcn_exp2f(p0[r] + tabL[d0 + 128]); p1[r] = __builtin_amdgcn_exp2f(p1[r] + tabL[d1 + 128]); }
                }
            } else {
                const bool needmask = (64 * t + 63 >= wrow0);
                const int kq = qrow - 64 * t - 4 * hi;
                float g[8];
#pragma unroll
                for (int k = 0; k < 8; ++k) g[k] = 0.f;
                f32x16 s0, s1;
#pragma unroll
                for (int r = 0; r < 16; ++r) { const int kv = (r & 3) + 8 * (r >> 2);
                    { const float y = p0[r], a = __builtin_fabsf(y); float sp = __builtin_fmaxf(y, 0.f) + __builtin_amdgcn_logf(1.f + __builtin_amdgcn_exp2f(-a)); if (needmask && !(kv < kq)) sp = 0.f; s0[r] = sp; g[r >> 2] += sp; }
                    { const float y = p1[r], a = __builtin_fabsf(y); float sp = __builtin_fmaxf(y, 0.f) + __builtin_amdgcn_logf(1.f + __builtin_amdgcn_exp2f(-a)); if (needmask && !(kv + 32 < kq)) sp = 0.f; s1[r] = sp; g[4 + (r >> 2)] += sp; } }
                float pg[8];
#pragma unroll
                for (int k = 0; k < 8; ++k) pg[k] = __shfl_xor(g[k], 32);
                float base[8]; float own = 0.f, par = 0.f;
#pragma unroll
                for (int k = 7; k >= 0; --k) { const float par_incl = par + pg[k]; base[k] = A + own + (hi == 0 ? par_incl : par); own += g[k]; par = par_incl; }
                A += own + par;
#pragma unroll
                for (int k = 0; k < 4; ++k) {
                    { float c = base[k]; c += s0[4 * k + 3]; const float w3 = __builtin_amdgcn_exp2f(p0[4 * k + 3] - c); c += s0[4 * k + 2]; const float w2 = __builtin_amdgcn_exp2f(p0[4 * k + 2] - c);
                      c += s0[4 * k + 1]; const float w1 = __builtin_amdgcn_exp2f(p0[4 * k + 1] - c); c += s0[4 * k]; const float w0 = __builtin_amdgcn_exp2f(p0[4 * k] - c);
                      p0[4 * k] = w0; p0[4 * k + 1] = w1; p0[4 * k + 2] = w2; p0[4 * k + 3] = w3; }
                    { float c = base[4 + k]; c += s1[4 * k + 3]; const float w3 = __builtin_amdgcn_exp2f(p1[4 * k + 3] - c); c += s1[4 * k + 2]; const float w2 = __builtin_amdgcn_exp2f(p1[4 * k + 2] - c);
                      c += s1[4 * k + 1]; const float w1 = __builtin_amdgcn_exp2f(p1[4 * k + 1] - c); c += s1[4 * k]; const float w0 = __builtin_amdgcn_exp2f(p1[4 * k] - c);
                      p1[4 * k] = w0; p1[4 * k + 1] = w1; p1[4 * k + 2] = w2; p1[4 * k + 3] = w3; }
                }
                if (needmask) {
#pragma unroll
                    for (int r = 0; r < 16; ++r) { const int kv = (r & 3) + 8 * (r >> 2); if (!(kv < kq)) p0[r] = 0.f; if (!(kv + 32 < kq)) p1[r] = 0.f; }
                }
                wdone = __all(A >= SB_THR);
            }
            if (MODE != 2) { float s = 0.f;
#pragma unroll
                for (int r = 0; r < 16; ++r) s += p0[r] + p1[r];
                l_reg += s; }
            u32x4 pw0, pw1, pw2, pw3;
            pw0 = (u32x4){cvtpk(p0[0], p0[1]), cvtpk(p0[2], p0[3]), cvtpk(p0[4], p0[5]), cvtpk(p0[6], p0[7])};
            pw1 = (u32x4){cvtpk(p0[8], p0[9]), cvtpk(p0[10], p0[11]), cvtpk(p0[12], p0[13]), cvtpk(p0[14], p0[15])};
            pw2 = (u32x4){cvtpk(p1[0], p1[1]), cvtpk(p1[2], p1[3]), cvtpk(p1[4], p1[5]), cvtpk(p1[6], p1[7])};
            pw3 = (u32x4){cvtpk(p1[8], p1[9]), cvtpk(p1[10], p1[11]), cvtpk(p1[12], p1[13]), cvtpk(p1[14], p1[15])};
            pv<ND>(o, vb0 + slot * KVSLOT, __builtin_bit_cast(bf16x8, pw0), __builtin_bit_cast(bf16x8, pw1), __builtin_bit_cast(bf16x8, pw2), __builtin_bit_cast(bf16x8, pw3));
        }
        if (MODE == 2) { if (lane == 0) flg[(i & 1) * 8 + wid] = wdone ? 1u : 0u; }
    }
#undef ATT_DMA
    asm volatile("s_waitcnt vmcnt(0) lgkmcnt(0)\n\ts_barrier" ::: "memory");
    float rl[16];
    if (MODE != 2) {
        l_reg += __shfl_xor(l_reg, 32);
        if (hi == 0) wsf[32 + r32] = l_reg;
        asm volatile("s_waitcnt lgkmcnt(0)" ::: "memory");
#pragma unroll
        for (int r = 0; r < 16; ++r) rl[r] = __builtin_amdgcn_rcpf(wsf[32 + crow(r, hi)]);
    } else {
#pragma unroll
        for (int r = 0; r < 16; ++r) rl[r] = 1.f;
    }
    bf16_t* Ow = Ob + (size_t)(q0 + wid * 32) * opitch;
    ALAS bf16_t* stg = (ALAS bf16_t*)(shm + L_OST) + wid * 2048;
#pragma unroll
    for (int half = 0; half < ND / 2; ++half) {
#pragma unroll
        for (int r = 0; r < 16; ++r) { const int orow = crow(r, hi);
#pragma unroll
            for (int d0 = 0; d0 < 2; ++d0) stg[orow * 64 + d0 * 32 + r32] = f2bf(o[half * 2 + d0][r] * rl[r]); }
        asm volatile("s_waitcnt lgkmcnt(0)" ::: "memory");
#pragma unroll
        for (int i = 0; i < 4; ++i) { const int row = i * 8 + (lane >> 3), ch = lane & 7; const u32x4 v = *(const ALAS u32x4*)(stg + row * 64 + ch * 8); *(u32x4*)(Ow + (size_t)row * opitch + half * 64 + ch * 8) = v; }
        asm volatile("s_waitcnt lgkmcnt(0)" ::: "memory");
    }
    asm volatile("s_waitcnt vmcnt(0) lgkmcnt(0)\n\ts_barrier" ::: "memory");
}


__device__ __forceinline__ void qkt8(f32x16& p0, f32x16& p1, lds_cptr kb, const bf16x8* qr, const f32x16& cin) {
    bf16x8 kf[8];
#pragma unroll
    for (int d0 = 0; d0 < 4; ++d0) { kf[2 * d0] = *(const ALAS bf16x8*)(kb + d0 * 2048); kf[2 * d0 + 1] = *(const ALAS bf16x8*)(kb + d0 * 2048 + 512); }
    __builtin_amdgcn_sched_barrier(0);
    p0 = MFMA32(kf[0], qr[0], cin); p1 = MFMA32(kf[1], qr[0], cin);
#pragma unroll
    for (int d0 = 1; d0 < 4; ++d0) { p0 = MFMA32(kf[2 * d0], qr[d0], p0); p1 = MFMA32(kf[2 * d0 + 1], qr[d0], p1); }
}
template <int ND, int KS0> __device__ __forceinline__ void v_reads(s16x4 (&lo)[ND][2], s16x4 (&hi)[ND][2], int vb) {
#pragma unroll
    for (int ks = 0; ks < 2; ++ks)
#pragma unroll
        for (int d0 = 0; d0 < ND; ++d0) {
            asm volatile("ds_read_b64_tr_b16 %0,%1 offset:%c2" : "=&v"(lo[d0][ks]) : "v"(vb), "i"(d0 * 4096 + (KS0 + ks) * 1024) : "memory");
            asm volatile("ds_read_b64_tr_b16 %0,%1 offset:%c2" : "=&v"(hi[d0][ks]) : "v"(vb), "i"(d0 * 4096 + (KS0 + ks) * 1024 + 512) : "memory"); }
}
template <int ND> __device__ __forceinline__ void pv_half(f32x16* o, const s16x4 (&lo)[ND][2], const s16x4 (&hi)[ND][2], bf16x8 pa, bf16x8 pb) {
#define ATT_PK2(d, k) (bf16x8){lo[d][k][0], lo[d][k][1], lo[d][k][2], lo[d][k][3], hi[d][k][0], hi[d][k][1], hi[d][k][2], hi[d][k][3]}
#pragma unroll
    for (int d0 = 0; d0 < ND; ++d0) o[d0] = MFMA32(pa, ATT_PK2(d0, 0), o[d0]);
#pragma unroll
    for (int d0 = 0; d0 < ND; ++d0) o[d0] = MFMA32(pb, ATT_PK2(d0, 1), o[d0]);
#undef ATT_PK2
}
template <int MODE> __device__ __forceinline__ void p_half(f32x16& p, float& l_reg, u32x4& wa, u32x4& wb, bool const_bias, int dq, const ALAS float* tabL) {
    if (MODE == 0) {
#pragma unroll
        for (int r = 0; r < 16; ++r) p[r] = __builtin_amdgcn_exp2f(p[r]);
    } else if (const_bias) { const float cb = tabL[256];
#pragma unroll
        for (int r = 0; r < 16; ++r) p[r] = __builtin_amdgcn_exp2f(p[r] + cb);
    } else {
#pragma unroll
        for (int r = 0; r < 16; ++r) { int d = dq - ((r & 3) + 8 * (r >> 2)); d = d < -128 ? -128 : (d > 128 ? 128 : d); p[r] = __builtin_amdgcn_exp2f(p[r] + tabL[d + 128]); }
    }
    float s = 0.f;
#pragma unroll
    for (int r = 0; r < 16; ++r) s += p[r];
    l_reg += s;
    wa = (u32x4){cvtpk(p[0], p[1]), cvtpk(p[2], p[3]), cvtpk(p[4], p[5]), cvtpk(p[6], p[7])};
    wb = (u32x4){cvtpk(p[8], p[9]), cvtpk(p[10], p[11]), cvtpk(p[12], p[13]), cvtpk(p[14], p[15])};
}
__device__ __forceinline__ void vm_wait_n(int n) {
    if (n <= 0) asm volatile("s_waitcnt vmcnt(0)" ::: "memory"); else if (n == 1) asm volatile("s_waitcnt vmcnt(1)" ::: "memory"); else if (n == 2) asm volatile("s_waitcnt vmcnt(2)" ::: "memory");
    else if (n == 3) asm volatile("s_waitcnt vmcnt(3)" ::: "memory"); else if (n == 4) asm volatile("s_waitcnt vmcnt(4)" ::: "memory"); else if (n == 5) asm volatile("s_waitcnt vmcnt(5)" ::: "memory");
    else if (n == 6) asm volatile("s_waitcnt vmcnt(6)" ::: "memory"); else if (n == 7) asm volatile("s_waitcnt vmcnt(7)" ::: "memory"); else asm volatile("s_waitcnt vmcnt(8)" ::: "memory");
}
template <int MODE, int VD, bool OUT8 = false>
__device__ __forceinline__ void attn_unit_pp(ALAS char* shm, const bf16_t* Qb, const bf16_t* Kb, const bf16_t* Vb, void* Ob, int opitch, int q0, float mref2, const float* tab, float oscale = 1.f) {
    static_assert(MODE == 0 || MODE == 1, "ping-pong loop: softmax modes only");
    constexpr int ND = VD / 32, NV = VD / 64, PD = 3, NS = PD + 1, PER = 1 + NV;
    const int tid = threadIdx.x, lane = tid & 63, r32 = lane & 31, hi = lane >> 5; const int wid = __builtin_amdgcn_readfirstlane(tid >> 6); const int grp = wid >> 2;
    const unsigned lds0 = (unsigned)(uintptr_t)shm;
    ALAS float* wsf = (ALAS float*)(shm + L_WS) + wid * 64;
    ALAS float* tabL = (ALAS float*)(shm + L_TAB);
    if (MODE == 1) { for (int i = tid; i < 257; i += 512) tabL[i] = tab[i] * pg8::LOG2E; }
    const bf16_t* Qw = Qb + (size_t)(q0 + wid * 32) * PITCH;
    bf16x8 qr[4];
#pragma unroll
    for (int d0 = 0; d0 < 4; ++d0) qr[d0] = *(const bf16x8*)(Qw + (size_t)r32 * PITCH + d0 * 16 + hi * 8);
    int t_first, n_t;
    if (MODE == 0) { t_first = 0; n_t = q0 / 64 + 4; }
    else { const int c0 = q0 / 64; t_first = c0 - 8 > 0 ? c0 - 8 : 0; n_t = c0 + 4 - t_first; }
    const bf16_t* ksrc = Kb + (size_t)lane * PITCH + wid * 8 + (size_t)t_first * 64 * PITCH;
    const bf16_t* vsrc = Vb + (size_t)(16 * (wid & 3) + (lane >> 2)) * PITCH + (wid >> 2) * 32 + (lane & 3) * 8 + (size_t)t_first * 64 * PITCH;
    int issued = 0;
#define PP_DMA_K(i) do { if ((i) < n_t) { glds16(ksrc + (size_t)(i) * 64 * PITCH, (unsigned)__builtin_amdgcn_readfirstlane(lds0 + (unsigned)((i) % NS) * KVSLOT + wid * 1024)); issued += 1; } } while (0)
#define PP_DMA_V(i) do { if ((i) < n_t) { const unsigned sb_ = lds0 + (unsigned)((i) % NS) * KVSLOT + 8192; glds16(vsrc + (size_t)(i) * 64 * PITCH, (unsigned)__builtin_amdgcn_readfirstlane(sb_ + wid * 1024)); \
        if (VD == 128) glds16(vsrc + (size_t)(i) * 64 * PITCH + 64, (unsigned)__builtin_amdgcn_readfirstlane(sb_ + (wid + 8) * 1024)); issued += NV; } } while (0)
#define PP_NEED_K(j) vm_wait_n(issued - ((j) * PER + 1))
#define PP_NEED_V(j) vm_wait_n(issued - ((j) + 1) * PER)
#define PP_BAR() asm volatile("s_waitcnt lgkmcnt(0)\n\ts_barrier" ::: "memory")
    f32x16 o[ND];
#pragma unroll
    for (int d = 0; d < ND; ++d) o[d] = f32x16{};
    f32x16 cin;
#pragma unroll
    for (int r = 0; r < 16; ++r) cin[r] = -mref2;
    float l_reg = 0.f;
    const int wrow0 = q0 + wid * 32, qrow = wrow0 + r32, cw = wrow0 / 64;
    const int vb0 = (int)lds0 + 8192 + ((lane >> 4) & 1) * 32 + (lane & 3) * 8 + (4 * hi + ((lane & 15) >> 2)) * 64;
    asm volatile("s_waitcnt vmcnt(0)" ::: "memory"); asm volatile("" : "+v"(qr[0]), "+v"(qr[1]), "+v"(qr[2]), "+v"(qr[3]));
#pragma unroll
    for (int j = 0; j < PD; ++j) { PP_DMA_K(j); PP_DMA_V(j); }
    if (grp) PP_DMA_K(PD);
    PP_NEED_V(0);
    PP_BAR();
    if (grp) PP_BAR();
    u32x4 pw0, pw1, pw2, pw3; f32x16 p1;
    for (int i = 0; i < n_t; ++i) {
        const int t = t_first + i, slot = i % NS;
        bool active;
        if (MODE == 0) active = (t <= cw); else active = (t >= cw - 8) && (t <= cw);
        if (grp == 0) PP_DMA_K(i + PD); else PP_DMA_V(i + PD);
        if (active) {
            const lds_cptr kb = (lds_cptr)shm + slot * KVSLOT + hi * 1024 + r32 * 16;
            f32x16 p0; qkt8(p0, p1, kb, qr, cin);
            p_half<MODE>(p0, l_reg, pw0, pw1, t <= cw - 3, qrow - 64 * t - 4 * hi, tabL);
        }
        if (grp == 0) PP_NEED_V(i); else PP_NEED_K(i + 1);
        PP_BAR();
        if (grp == 0) PP_DMA_V(i + PD); else PP_DMA_K(i + 1 + PD);
        if (active) {
            const int vb = vb0 + slot * KVSLOT;
            s16x4 lo0[ND][2], hi0[ND][2], lo1[ND][2], hi1[ND][2];
            v_reads<ND, 0>(lo0, hi0, vb);
            asm volatile("s_waitcnt lgkmcnt(0)" ::: "memory");
            v_reads<ND, 2>(lo1, hi1, vb);
            __builtin_amdgcn_sched_barrier(0);
            pv_half<ND>(o, lo0, hi0, __builtin_bit_cast(bf16x8, pw0), __builtin_bit_cast(bf16x8, pw1));
            __builtin_amdgcn_sched_barrier(0);
            p_half<MODE>(p1, l_reg, pw2, pw3, t <= cw - 3, qrow - 64 * t - 4 * hi - 32, tabL);
            asm volatile("s_waitcnt lgkmcnt(0)" ::: "memory");
            __builtin_amdgcn_sched_barrier(0);
            pv_half<ND>(o, lo1, hi1, __builtin_bit_cast(bf16x8, pw2), __builtin_bit_cast(bf16x8, pw3));
        }
        if (grp == 0) PP_NEED_K(i + 1); else PP_NEED_V(i + 1);
        PP_BAR();
    }
    if (grp == 0) PP_BAR();
#undef PP_DMA_K
#undef PP_DMA_V
#undef PP_NEED_K
#undef PP_NEED_V
    float rl[16];
    l_reg += __shfl_xor(l_reg, 32);
    if (hi == 0) wsf[32 + r32] = l_reg;
    asm volatile("s_waitcnt lgkmcnt(0)" ::: "memory");
#pragma unroll
    for (int r = 0; r < 16; ++r) rl[r] = __builtin_amdgcn_rcpf(wsf[32 + crow(r, hi)]) * oscale;
    if constexpr (OUT8) {
        static_assert(!OUT8 || VD == 64, "fp8 output: 64-wide heads");
        unsigned char* Ow = (unsigned char*)Ob + (size_t)(q0 + wid * 32) * opitch;
        ALAS unsigned char* stg = (ALAS unsigned char*)(shm + L_OST) + wid * 2048;
#pragma unroll
        for (int r = 0; r < 16; ++r) { const int orow = crow(r, hi);
#pragma unroll
            for (int d0 = 0; d0 < 2; ++d0) { const float v = o[d0][r] * rl[r]; stg[orow * 64 + d0 * 32 + r32] = (unsigned char)(__builtin_amdgcn_cvt_pk_fp8_f32(v, v, 0, false) & 0xff); } }
        asm volatile("s_waitcnt lgkmcnt(0)" ::: "memory");
#pragma unroll
        for (int i = 0; i < 2; ++i) { const int row = i * 16 + (lane >> 2), ch = lane & 3; const u32x4 v = *(const ALAS u32x4*)(stg + row * 64 + ch * 16); *(u32x4*)(Ow + (size_t)row * opitch + ch * 16) = v; }
        asm volatile("s_waitcnt lgkmcnt(0)" ::: "memory");
    } else {
    bf16_t* Ow = (bf16_t*)Ob + (size_t)(q0 + wid * 32) * opitch;
    ALAS bf16_t* stg = (ALAS bf16_t*)(shm + L_OST) + wid * 2048;
#pragma unroll
    for (int half = 0; half < ND / 2; ++half) {
#pragma unroll
        for (int r = 0; r < 16; ++r) { const int orow = crow(r, hi);
#pragma unroll
            for (int d0 = 0; d0 < 2; ++d0) stg[orow * 64 + d0 * 32 + r32] = f2bf(o[half * 2 + d0][r] * rl[r]); }
        asm volatile("s_waitcnt lgkmcnt(0)" ::: "memory");
#pragma unroll
        for (int i = 0; i < 4; ++i) { const int row = i * 8 + (lane >> 3), ch = lane & 7; const u32x4 v = *(const ALAS u32x4*)(stg + row * 64 + ch * 8); *(u32x4*)(Ow + (size_t)row * opitch + half * 64 + ch * 8) = v; }
        asm volatile("s_waitcnt lgkmcnt(0)" ::: "memory");
    }
    }
    PP_BAR();
#undef PP_BAR
}
}

constexpr int NWAVES = 8, NTHR = NWAVES * 64;
constexpr int BATCH = 2, SEQ = 8192, T = BATCH * SEQ, D = 1024;
constexpr int NPROJ = 3072, FFD = 2816, FFE = 3584, NEXP = 8;
constexpr size_t MiB = 1u << 20;
constexpr size_t CTL_ZERO_BYTES = 1 * MiB;
constexpr int CW_TMO = 0, CW_BAR = 4096;
constexpr int CW_HIST = 16384;
constexpr int CW_QATT = 32768, CW_QCONV = 32768 + 64;
constexpr int CW_MOE = 24576;
constexpr size_t WS_SS0 = 1 * MiB, WS_SS3 = WS_SS0 + 65536, WS_ROPE = WS_SS3 + 65536  , WS_TOKSEL = WS_ROPE + MiB  ,
                 WS_TOKGATE = WS_TOKSEL + 65536  , WS_ROWTOK = WS_TOKGATE + 131072  , WS_ROWGATE = WS_ROWTOK + 147456  ;
static_assert(WS_ROWGATE + 147456 <= 4 * MiB, "small arrays");
constexpr size_t WS_XB = 4 * MiB;
constexpr size_t WS_AO = 36 * MiB;
constexpr size_t WS_ACT0 = 68 * MiB;
constexpr size_t WS_XF = 164 * MiB;
constexpr size_t WS_WIN = 228 * MiB, WS_WO0 = 234 * MiB, WS_WGU0 = 236 * MiB, WS_WD0 = 247 * MiB, WS_WQKV = 253 * MiB, WS_WO1 = 259 * MiB;
constexpr size_t WS_WEGU = 264 * MiB;
constexpr size_t WS_WED = 376 * MiB;
constexpr size_t WS_SS1 = 432 * MiB, WS_SS2 = 433 * MiB;
constexpr size_t WS_END = 434 * MiB;
constexpr size_t WS_SORTA = 36 * MiB;
constexpr size_t WS_ACTE = 108 * MiB;
static_assert(WS_SORTA + (size_t)36864 * 2048 <= WS_ACTE && WS_ACTE + (size_t)18432 * 7168 <= WS_WO0 && WS_WD0 + (size_t)1024 * 2816 * 2 <= WS_WQKV && WS_WO1 + 2 * MiB <= WS_WEGU, "ws map");
constexpr int RING_BYTES = 131072, MISC_OFF = RING_BYTES + 320, LDS_BYTES = 147456;
static_assert(att::L_END <= RING_BYTES, "attention LDS");

#define GAS __attribute__((address_space(1)))
#define LAS __attribute__((address_space(3)))
typedef unsigned short bf16;
typedef unsigned v4u __attribute__((ext_vector_type(4)));
typedef float f32x4 __attribute__((ext_vector_type(4)));
typedef GAS unsigned gu32;
#define RLX_AGENT __ATOMIC_RELAXED, __HIP_MEMORY_SCOPE_AGENT
#define LDS_WAIT() asm volatile("s_waitcnt lgkmcnt(0)" ::: "memory")
#define VM_WAIT() asm volatile("s_waitcnt vmcnt(0)" ::: "memory")
__device__ __forceinline__ unsigned f2bf(float f) { unsigned u = __builtin_bit_cast(unsigned, f); return (u + 0x7fffu + ((u >> 16) & 1u)) >> 16; }
__device__ __forceinline__ unsigned pk2(float lo, float hi) { return f2bf(lo) | (f2bf(hi) << 16); }
__device__ __forceinline__ float bf2f(unsigned short h) { return __builtin_bit_cast(float, (unsigned)h << 16); }
#define XB_TMO      128
#define XB_XCNT(j)  (256  + 64 * (j))
#define XB_XSUB(j)  (1280 + 64 * (j))
#define XB_XGEN(j)  (2304 + 64 * (j))
#define XB_TOP      3328
#define XB_TOPGEN   3392
#define XCD_BAR_WORDS 3456
#define XB_SPIN_CAP (1u << 18)

__device__ __forceinline__ unsigned xb_ld(unsigned* p)              { return __hip_atomic_load(p, __ATOMIC_RELAXED, __HIP_MEMORY_SCOPE_AGENT); }
__device__ __forceinline__ unsigned xb_add(unsigned* p, unsigned v) { return __hip_atomic_fetch_add(p, v, __ATOMIC_RELAXED, __HIP_MEMORY_SCOPE_AGENT); }
__device__ __forceinline__ unsigned xb_xcc_id() { return (unsigned)__builtin_amdgcn_s_getreg((3 << 11) | 20) & 0xFu; }
#define XB_SPIN(cond, bar) do { unsigned _sp = 0; while (cond) { __builtin_amdgcn_s_sleep(1); \
    if ((++_sp & 255u) == 0u) { if (xb_ld(&(bar)[XB_TMO])) break; if (_sp > XB_SPIN_CAP) { atomicAdd(&(bar)[XB_TMO], 1u); break; } } } } while (0)

struct XcdBarrier {
    unsigned* bar; unsigned x;
    volatile LAS unsigned* st;
};

__device__ __forceinline__ XcdBarrier xcd_barrier_post(unsigned* bar, volatile LAS unsigned* st) {
    XcdBarrier b; b.bar = bar; b.x = xb_xcc_id(); b.st = st;
    if (threadIdx.x == 0) (void)xb_add(&bar[XB_XCNT(b.x)], 1u);
    return b;
}
__device__ __forceinline__ void xcd_barrier_complete(unsigned* bar, unsigned x, unsigned& nloc, unsigned& nx) {
    const unsigned G = gridDim.x * gridDim.y * gridDim.z;
    unsigned sum, cnt, mine, sp = 0u;
    for (;;) {
        sum = 0u; cnt = 0u; mine = 0u;
#pragma unroll
        for (unsigned j = 0; j < 16; ++j) { const unsigned c = xb_ld(&bar[XB_XCNT(j)]); sum += c; cnt += (c > 0u) ? 1u : 0u; mine = (j == x) ? c : mine; }
        if (sum == G) break;
        __builtin_amdgcn_s_sleep(1);
        if ((++sp & 255u) == 0u) { if (xb_ld(&bar[XB_TMO])) break; if (sp > XB_SPIN_CAP) { atomicAdd(&bar[XB_TMO], 1u); break; } }
    }
    nloc = mine > 0u ? mine : 1u; nx = cnt > 0u ? cnt : 1u;
}

__device__ __forceinline__ void xcd_barrier(const XcdBarrier& b) {
    asm volatile("s_waitcnt vmcnt(0)" ::: "memory");
    __syncthreads();
    if (threadIdx.x == 0) {
        unsigned* bar = b.bar;
        __builtin_amdgcn_s_waitcnt(0);
        unsigned nloc = b.st[0], nx = b.st[1];
        if (nloc == 0u) { xcd_barrier_complete(bar, b.x, nloc, nx); b.st[0] = nloc; b.st[1] = nx; }
        const unsigned old = xb_add(&bar[XB_XSUB(b.x)], 1u);
        const unsigned gen = old / nloc;
        if (old + 1u == (gen + 1u) * nloc) {
            __builtin_amdgcn_fence(__ATOMIC_RELEASE, "agent");
            asm volatile("s_waitcnt vmcnt(0)" ::: "memory");
            const unsigned og = xb_add(&bar[XB_TOP], 1u);
            const unsigned tg = og / nx;
            if (og + 1u == (tg + 1u) * nx) xb_add(&bar[XB_TOPGEN], 1u);
            else XB_SPIN(xb_ld(&bar[XB_TOPGEN]) == tg, bar);
            __builtin_amdgcn_fence(__ATOMIC_ACQUIRE, "agent");
            xb_add(&bar[XB_XGEN(b.x)], 1u);
            asm volatile("s_waitcnt vmcnt(0)" ::: "memory");
        } else {
            XB_SPIN(xb_ld(&bar[XB_XGEN(b.x)]) == gen, bar);
            __builtin_amdgcn_fence(__ATOMIC_ACQUIRE, "agent");
            asm volatile("s_waitcnt vmcnt(0)" ::: "memory");
        }
    }
    __syncthreads();
}

__device__ __forceinline__ float wave_sum(float v) {
#pragma unroll
    for (int o = 1; o < 64; o <<= 1) v += __shfl_xor(v, o);
    return v;
}
__device__ __forceinline__ float wave_max(float v) {
#pragma unroll
    for (int o = 1; o < 64; o <<= 1) v = fmaxf(v, __shfl_xor(v, o));
    return v;
}
__device__ __forceinline__ int dest_block(int blk, int map) {
    if (map == 1) { const int s = blk & 7; return (blk & ~7) + 4 * (s & 1) + (s >> 1); }
    if (map == 2) return (blk >> 2) * 8 + (blk & 3);
    if (map == 3) return (blk >> 2) * 8 + 4 + (blk & 3);
    return blk;
}
__device__ __forceinline__ void tr_tile(const float* W, int K, int N, bf16* WT, int map, const float* gain, LAS unsigned* scr, int item, int lane) {
    const int nblk = N / 64, kb = item / nblk, nb = item % nblk, k0 = 64 * kb, n0 = 64 * nb;
    const int c = lane & 15, ip = lane >> 4;
#pragma unroll
    for (int it = 0; it < 8; ++it) { const int kp = it * 4 + ip, k = k0 + 2 * kp;
        f32x4 a = *(const GAS f32x4*)(W + (size_t)k * N + n0 + 4 * c), b = *(const GAS f32x4*)(W + (size_t)(k + 1) * N + n0 + 4 * c);
        if (gain) { a = a * gain[k]; b = b * gain[k + 1]; }
#pragma unroll
        for (int j = 0; j < 4; ++j) scr[(4 * c + j) * 33 + kp] = pk2(a[j], b[j]); }
    LDS_WAIT(); asm volatile("" ::: "memory");
#pragma unroll
    for (int it = 0; it < 8; ++it) { const int n = it * 8 + (lane >> 3), q = lane & 7;
        v4u o; o.x = scr[n * 33 + 4 * q]; o.y = scr[n * 33 + 4 * q + 1]; o.z = scr[n * 33 + 4 * q + 2]; o.w = scr[n * 33 + 4 * q + 3];
        const int drow = dest_block((n0 + n) >> 5, map) * 32 + (n & 31);
        *(GAS v4u*)(WT + (size_t)drow * K + k0 + 8 * q) = o; }
    LDS_WAIT(); asm volatile("" ::: "memory");
}

__device__ __forceinline__ void tr_tile8(const float* W, int K, int N, unsigned char* WT, int map, const float* gain, float wscale, LAS unsigned* scr, int item, int lane) {
    const int nblk = N / 64, kb = item / nblk, nb = item % nblk, k0 = 64 * kb, n0 = 64 * nb;
    const int c = lane & 15, ip = lane >> 4;
#pragma unroll
    for (int it = 0; it < 4; ++it) { const int k4 = it * 4 + ip, k = k0 + 4 * k4; f32x4 a[4];
#pragma unroll
        for (int i = 0; i < 4; ++i) a[i] = *(const GAS f32x4*)(W + (size_t)(k + i) * N + n0 + 4 * c) * ((gain ? gain[k + i] : 1.f) * wscale);
#pragma unroll
        for (int j = 0; j < 4; ++j) scr[(4 * c + j) * 17 + k4] = pg8::pk4_fp8(a[0][j], a[1][j], a[2][j], a[3][j]); }
    LDS_WAIT(); asm volatile("" ::: "memory");
#pragma unroll
    for (int it = 0; it < 4; ++it) { const int n = it * 16 + (lane >> 2), q = lane & 3;
        v4u o; o.x = scr[n * 17 + 4 * q]; o.y = scr[n * 17 + 4 * q + 1]; o.z = scr[n * 17 + 4 * q + 2]; o.w = scr[n * 17 + 4 * q + 3];
        const int drow = dest_block((n0 + n) >> 5, map) * 32 + (n & 31);
        *(GAS v4u*)(WT + (size_t)drow * K + k0 + 16 * q) = o; }
    LDS_WAIT(); asm volatile("" ::: "memory");
}

struct TrItem { const float* W; unsigned char* WT; const float* gain; int K, N, map, fp8, k0, n0; float scale; };
__device__ __forceinline__ void tr_load(const TrItem& d, f32x4 (&a)[16], float (&g)[16], int lane) {
    const int c = lane & 15, ip = lane >> 4;
#pragma unroll
    for (int it = 0; it < 4; ++it)
#pragma unroll
        for (int i = 0; i < 4; ++i) { const int k = d.k0 + 4 * (it * 4 + ip) + i;
            a[it * 4 + i] = *(const GAS f32x4*)(d.W + (size_t)k * d.N + d.n0 + 4 * c); g[it * 4 + i] = d.gain ? d.gain[k] : 1.f; }
}
__device__ __forceinline__ void tr_emit(const TrItem& d, const f32x4 (&a)[16], const float (&g)[16], LAS unsigned* scr, int lane) {
    const int c = lane & 15, ip = lane >> 4;
    if (d.fp8) {
#pragma unroll
        for (int it = 0; it < 4; ++it) { const int k4 = it * 4 + ip;
#pragma unroll
            for (int j = 0; j < 4; ++j) scr[(4 * c + j) * 17 + k4] = pg8::pk4_fp8(a[it * 4][j] * (g[it * 4] * d.scale), a[it * 4 + 1][j] * (g[it * 4 + 1] * d.scale), a[it * 4 + 2][j] * (g[it * 4 + 2] * d.scale), a[it * 4 + 3][j] * (g[it * 4 + 3] * d.scale)); }
        LDS_WAIT(); asm volatile("" ::: "memory");
#pragma unroll
        for (int it = 0; it < 4; ++it) { const int n = it * 16 + (lane >> 2), q = lane & 3;
            v4u o; o.x = scr[n * 17 + 4 * q]; o.y = scr[n * 17 + 4 * q + 1]; o.z = scr[n * 17 + 4 * q + 2]; o.w = scr[n * 17 + 4 * q + 3];
            const int drow = dest_block((d.n0 + n) >> 5, d.map) * 32 + (n & 31);
            *(GAS v4u*)(d.WT + (size_t)drow * d.K + d.k0 + 16 * q) = o; }
    } else {
#pragma unroll
        for (int it = 0; it < 4; ++it) { const int k4 = it * 4 + ip;
#pragma unroll
            for (int j = 0; j < 4; ++j) { scr[(4 * c + j) * 33 + 2 * k4] = pk2(a[it * 4][j] * g[it * 4], a[it * 4 + 1][j] * g[it * 4 + 1]); scr[(4 * c + j) * 33 + 2 * k4 + 1] = pk2(a[it * 4 + 2][j] * g[it * 4 + 2], a[it * 4 + 3][j] * g[it * 4 + 3]); } }
        LDS_WAIT(); asm volatile("" ::: "memory");
#pragma unroll
        for (int it = 0; it < 8; ++it) { const int n = it * 8 + (lane >> 3), q = lane & 7;
            v4u o; o.x = scr[n * 33 + 4 * q]; o.y = scr[n * 33 + 4 * q + 1]; o.z = scr[n * 33 + 4 * q + 2]; o.w = scr[n * 33 + 4 * q + 3];
            const int drow = dest_block((d.n0 + n) >> 5, d.map) * 32 + (n & 31);
            *(GAS v4u*)(d.WT + ((size_t)drow * d.K + d.k0 + 8 * q) * 2) = o; }
    }
    LDS_WAIT(); asm volatile("" ::: "memory");
}
constexpr float AO8_SCALE = 16.f;
constexpr float W8_SCALE = 64.f;

#ifndef PROBE_MASK
#define PROBE_MASK 0
#endif
struct KArgs { const void* in[27]; float* out; unsigned char* ws; int ph_lo, ph_hi, flags, pad; };

__global__ void __launch_bounds__(NTHR, 2) fwd_kernel(KArgs args) {
    extern __shared__ __attribute__((aligned(16))) unsigned char lds_raw[];
    LAS unsigned char* lds = (LAS unsigned char*)lds_raw;
    volatile LAS unsigned* MISC = (volatile LAS unsigned*)(lds + MISC_OFF);
    const int tid = threadIdx.x, lane = tid & 63, wave = __builtin_amdgcn_readfirstlane(tid >> 6);
    const int G = gridDim.x; const int bx = blockIdx.x; const int vcu = (G % 8 == 0) ? (bx % 8) * (G / 8) + bx / 8 : bx;
    unsigned char* ws = args.ws;
    unsigned* ctl = (unsigned*)ws;
    for (int u = tid; u < (LDS_BYTES - RING_BYTES) / 4; u += NTHR) ((LAS unsigned*)(lds + RING_BYTES))[u] = 0u;
    __syncthreads();
    XcdBarrier bar = xcd_barrier_post(ctl + CW_BAR, MISC + 8);
    const int lo = args.ph_lo, hi_ph = args.ph_hi;
#define IN(k) (lo <= (k) && (k) < hi_ph)
#define REP(k)
#define SEAM(k) do { if (IN(k) && IN((k) + 1)) xcd_barrier(bar); } while (0)
    const float* x_in = (const float*)args.in[0]; const int* positions = (const int*)args.in[1];
    const float* ev_attn_norm = (const float*)args.in[2]; const float* ev_w_in = (const float*)args.in[3];
    const float* ev_q_norm = (const float*)args.in[4]; const float* ev_k_norm = (const float*)args.in[5];
    const float* ev_lq1 = (const float*)args.in[6]; const float* ev_lk1 = (const float*)args.in[7]; const float* ev_lq2 = (const float*)args.in[8]; const float* ev_lk2 = (const float*)args.in[9];
    const float* ev_subln = (const float*)args.in[10]; const float* ev_w_out = (const float*)args.in[11]; const float* ev_ffn_norm = (const float*)args.in[12];
    const float* ev_w_gate = (const float*)args.in[13]; const float* ev_w_up = (const float*)args.in[14]; const float* ev_w_down = (const float*)args.in[15];
    const float* od_attn_norm = (const float*)args.in[16]; const float* od_w_qkv = (const float*)args.in[17];
    const float* od_q_norm = (const float*)args.in[18]; const float* od_k_norm = (const float*)args.in[19]; const float* od_rel_bias = (const float*)args.in[20];
    const float* od_w_out = (const float*)args.in[21]; const float* od_ffn_norm = (const float*)args.in[22]; const float* od_router = (const float*)args.in[23];
    const float* od_we_gate = (const float*)args.in[24]; const float* od_we_up = (const float*)args.in[25]; const float* od_we_down = (const float*)args.in[26];
    float* out = args.out;
    float* ss0 = (float*)(ws + WS_SS0); float* ss1 = (float*)(ws + WS_SS1); float* ss2 = (float*)(ws + WS_SS2); float* ss3 = (float*)(ws + WS_SS3);
    float* rope = (float*)(ws + WS_ROPE); unsigned* toksel = (unsigned*)(ws + WS_TOKSEL); float* tokgate = (float*)(ws + WS_TOKGATE);
    int* rowtok = (int*)(ws + WS_ROWTOK); float* rowgate = (float*)(ws + WS_ROWGATE);
    bf16* XB = (bf16*)(ws + WS_XB); bf16* AO = (bf16*)(ws + WS_AO); bf16* ACT0 = (bf16*)(ws + WS_ACT0); float* XF = (float*)(ws + WS_XF); bf16* OD = (bf16*)(ws + WS_XF);
    bf16* Win_t = (bf16*)(ws + WS_WIN); bf16* Wo0_t = (bf16*)(ws + WS_WO0); bf16* Wgu0_t = (bf16*)(ws + WS_WGU0); bf16* Wd0_t = (bf16*)(ws + WS_WD0);
    unsigned char* Wqkv8 = ws + WS_WQKV; unsigned char* Wo18 = ws + WS_WO1; unsigned char* XB8 = ws + WS_XB; unsigned char* AO8 = ws + WS_AO; unsigned char* WEgu8 = ws + WS_WEGU; unsigned char* WEd8 = ws + WS_WED;
    unsigned char* SORTA8 = ws + WS_SORTA; unsigned char* ACTE8 = ws + WS_ACTE;
    const int gw = vcu * NWAVES + wave, NGW = G * NWAVES;

    constexpr int I_IN = 16 * 48, I_O = 16 * 16, I_G = 16 * 44, I_D = 44 * 16, I_EG = 16 * 56, I_ED = 56 * 16;
    constexpr int NSMALL = I_IN + I_O + 2 * I_G + I_D + I_IN + I_O, NITEMS = NSMALL + 24 * I_EG;
        auto decode = [&](int it) -> TrItem {
        TrItem d; int r = it; d.scale = 1.f; d.fp8 = 0; d.gain = nullptr; d.map = 0;
        auto fin = [&](int nbl) { d.k0 = 64 * (r / nbl); d.n0 = 64 * (r % nbl); };
        if (r < I_IN) { d.W = ev_w_in; d.K = D; d.N = NPROJ; d.WT = (unsigned char*)Win_t; d.map = 1; d.gain = ev_attn_norm; fin(NPROJ / 64); return d; } r -= I_IN;
        if (r < I_O) { d.W = ev_w_out; d.K = D; d.N = D; d.WT = (unsigned char*)Wo0_t; fin(D / 64); return d; } r -= I_O;
        if (r < I_G) { d.W = ev_w_gate; d.K = D; d.N = FFD; d.WT = (unsigned char*)Wgu0_t; d.map = 2; d.gain = ev_ffn_norm; fin(FFD / 64); return d; } r -= I_G;
        if (r < I_G) { d.W = ev_w_up; d.K = D; d.N = FFD; d.WT = (unsigned char*)Wgu0_t; d.map = 3; d.gain = ev_ffn_norm; fin(FFD / 64); return d; } r -= I_G;
        if (r < I_D) { d.W = ev_w_down; d.K = FFD; d.N = D; d.WT = (unsigned char*)Wd0_t; fin(D / 64); return d; } r -= I_D;
        d.fp8 = 1; d.scale = W8_SCALE;
        if (r < I_IN) { d.W = od_w_qkv; d.K = D; d.N = NPROJ; d.WT = Wqkv8; d.map = 1; d.gain = od_attn_norm; fin(NPROJ / 64); return d; } r -= I_IN;
        if (r < I_O) { d.W = od_w_out; d.K = D; d.N = D; d.WT = Wo18; fin(D / 64); return d; } r -= I_O;
        const int which = r / (8 * I_EG), rr = r % (8 * I_EG), e2 = rr / I_EG; r = rr % I_EG;
        if (which == 0) { d.W = od_we_gate + (size_t)e2 * D * FFE; d.K = D; d.N = FFE; d.WT = WEgu8 + (size_t)e2 * 2 * FFE * D; d.map = 2; d.gain = od_ffn_norm; fin(FFE / 64); }
        else if (which == 1) { d.W = od_we_up + (size_t)e2 * D * FFE; d.K = D; d.N = FFE; d.WT = WEgu8 + (size_t)e2 * 2 * FFE * D; d.map = 3; d.gain = od_ffn_norm; fin(FFE / 64); }
        else { d.W = od_we_down + (size_t)e2 * FFE * D; d.K = FFE; d.N = D; d.WT = WEd8 + (size_t)e2 * D * FFE; fin(D / 64); }
        return d; };
    auto conv_range = [&](int first, int end, int stride) {
        LAS unsigned* scr = (LAS unsigned*)(lds + wave * 8704);
        f32x4 bufA[16], bufB[16]; float gA[16], gB[16]; TrItem dA, dB; int it = first;
        if (it < end) { dA = decode(it); tr_load(dA, bufA, gA, lane); }
        while (it < end) {
            const int it2 = it + stride, it3 = it2 + stride;
            if (it2 < end) { dB = decode(it2); tr_load(dB, bufB, gB, lane); }
            tr_emit(dA, bufA, gA, scr, lane);
            if (it3 < end) { dA = decode(it3); tr_load(dA, bufA, gA, lane); }
            if (it2 < end) tr_emit(dB, bufB, gB, scr, lane);
            it = it3; } };
    auto pull = [&](int qword) -> int {
        __syncthreads(); if (tid == 0) MISC[16] = __hip_atomic_fetch_add(ctl + qword, 1u, __ATOMIC_RELAXED, __HIP_MEMORY_SCOPE_AGENT); __syncthreads();
        return __builtin_amdgcn_readfirstlane((int)MISC[16]); };

    REP(0) if (IN(0)) {
        conv_range(gw, NSMALL, NGW);
        for (int m = gw; m < T; m += NGW) {
            const GAS f32x4* xr = (const GAS f32x4*)(x_in + (size_t)m * D) + lane; f32x4 v[4]; float s = 0.f;
#pragma unroll
            for (int j = 0; j < 4; ++j) { v[j] = xr[64 * j]; s += (v[j].x * v[j].x + v[j].y * v[j].y) + (v[j].z * v[j].z + v[j].w * v[j].w); }
            s = wave_sum(s); if (lane == 0) ss0[m] = s;
            GAS unsigned long long* o8 = (GAS unsigned long long*)(XB + (size_t)m * D) + lane;
#pragma unroll
            for (int j = 0; j < 4; ++j) o8[64 * j] = (unsigned long long)pk2(v[j].x, v[j].y) | ((unsigned long long)pk2(v[j].z, v[j].w) << 32);
        }
        for (int i = vcu * NTHR + tid; i < T * 8; i += G * NTHR) {
            const int tok = i >> 3, f = i & 7;
            const double inv = exp2(-(double)f * (18.931568569324174 / 8.0));
            double ang = (double)positions[tok] * inv; ang -= 6.283185307179586 * rint(ang * 0.15915494309189535);
            float sn, cs; sincosf((float)ang, &sn, &cs);
            rope[(size_t)tok * 16 + f] = cs; rope[(size_t)tok * 16 + 8 + f] = sn;
        }
    }
    SEAM(0);

    REP(1) if (IN(1)) {
        pg8::Gemm g{XB, Win_t, T, NPROJ, D}; pg8::StaticOrder S; S.init(T, NPROJ, G, bx);
        pg8::EpiProj E{ACT0, NPROJ, ss0, 1, ev_q_norm, ev_k_norm, rope, 0, 1.f};
        pg8::gemm_phase<pg8::EpiProj, pg8::StaticOrder, true, true>(lds, g, S, E);
    }
    SEAM(1);

    REP(2) if (IN(2)) {
        const float gqm = wave_max(fabsf(ev_q_norm[lane])), gkm = wave_max(fabsf(ev_k_norm[lane]));
        const float mref = 8.f * gqm * gkm * pg8::LOG2E;
        constexpr int NJOBS = (NITEMS - NSMALL + 31) / 32;
        const bool conv_first = ((bx >> 3) & 3) == 3;
#define P2_CONV_LOOP() for (;;) { const int j = pull(CW_QCONV); if (j >= NJOBS) break; \
            const int first = NSMALL + j * 32 + wave * 4, last = (first + 4 < NITEMS) ? first + 4 : NITEMS; \
            _Pragma("unroll 1") for (int it = first; it < last; ++it) { LAS unsigned* scr = (LAS unsigned*)(lds + wave * 8704); f32x4 bufA[16]; float gA[16]; const TrItem dA = decode(it); tr_load(dA, bufA, gA, lane); tr_emit(dA, bufA, gA, scr, lane); } }
        if (conv_first) P2_CONV_LOOP()
        for (;;) { const int idx = pull(CW_QATT); if (idx >= 1024) break;
            if (idx < 512) { if (args.flags & 1) continue;
                const int bhm = idx & 15, qb = 31 - (idx >> 4);
                const int b = bhm >> 3, hm = bhm & 7, h = hm >> 1;
                const bf16* base = ACT0 + (size_t)b * SEQ * NPROJ;
                att::attn_unit_pp<0, 128>((LAS char*)lds, base + 1536 + hm * 64, base + 2048 + hm * 64, base + 2560 + h * 128, OD + (size_t)b * SEQ * D + hm * 128, D, qb * 256, mref, nullptr);
            } else { if (args.flags & 2) continue;
                const int bh = idx & 15, qb = 31 - ((idx - 512) >> 4);
                const int b = bh >> 3, h = bh & 7;
                const bf16* base = ACT0 + (size_t)b * SEQ * NPROJ;
                att::attn_unit<2, 64>((LAS char*)lds, base + h * 64, base + 512 + h * 64, base + 1024 + h * 64, AO + (size_t)b * SEQ * D + h * 64, D, qb * 256, 0.f, nullptr);
            }
        }
        P2_CONV_LOOP()
#undef P2_CONV_LOOP
    }
    SEAM(2);

    REP(3) if (IN(3)) {
        const float a1 = wave_sum(ev_lq1[lane] * ev_lk1[lane]), a2 = wave_sum(ev_lq2[lane] * ev_lk2[lane]);
        const float lam_init = 0.2f, lam = expf(a1) - expf(a2) + lam_init;
        const int h = lane >> 4, v0 = (lane & 15) * 8;
        float sg[8];
#pragma unroll
        for (int j = 0; j < 8; ++j) sg[j] = ev_subln[v0 + j] * (1.f - lam_init);
        for (int m = gw; m < T; m += NGW) {
            const v4u a = *(const GAS v4u*)(OD + (size_t)m * D + (2 * h) * 128 + v0), b = *(const GAS v4u*)(OD + (size_t)m * D + (2 * h + 1) * 128 + v0);
            float d[8]; float s = 0.f;
#pragma unroll
            for (int j = 0; j < 4; ++j) { const unsigned ua = a[j], ub = b[j];
                d[2 * j] = bf2f((unsigned short)(ua & 0xffffu)) - lam * bf2f((unsigned short)(ub & 0xffffu));
                d[2 * j + 1] = bf2f((unsigned short)(ua >> 16)) - lam * bf2f((unsigned short)(ub >> 16));
                s += d[2 * j] * d[2 * j] + d[2 * j + 1] * d[2 * j + 1]; }
            s += __shfl_xor(s, 1); s += __shfl_xor(s, 2); s += __shfl_xor(s, 4); s += __shfl_xor(s, 8);
            const float rs = rsqrtf(s * (1.f / 128.f) + pg8::RMS_EPS);
            v4u o; o.x = pk2(d[0] * rs * sg[0], d[1] * rs * sg[1]); o.y = pk2(d[2] * rs * sg[2], d[3] * rs * sg[3]); o.z = pk2(d[4] * rs * sg[4], d[5] * rs * sg[5]); o.w = pk2(d[6] * rs * sg[6], d[7] * rs * sg[7]);
            *(GAS v4u*)(AO + (size_t)m * D + 512 + h * 128 + v0) = o;
        }
    }
    SEAM(3);

    REP(4) if (IN(4)) {
        pg8::Gemm g{AO, Wo0_t, T, D, D}; pg8::StaticOrder S; S.init(T, D, G, bx);
        pg8::EpiResid E{x_in, XF, XB, ss1, 1.f, nullptr};
        pg8::gemm_phase<pg8::EpiResid, pg8::StaticOrder, false, true>(lds, g, S, E);
    }
    SEAM(4);

    REP(5) if (IN(5)) {
        pg8::Gemm g{XB, Wgu0_t, T, 2 * FFD, D}; pg8::StaticOrder S; S.init(T, 2 * FFD, G, bx);
        pg8::EpiSwiglu<false> E{ACT0, FFD, ss1, 16, nullptr, 0, 2 * FFD / 256, 1.f};
        pg8::gemm_phase<pg8::EpiSwiglu<false>, pg8::StaticOrder, true, true>(lds, g, S, E);
    }
    SEAM(5);

    if (IN(6)) {
        pg8::Gemm g{ACT0, Wd0_t, T, D, FFD}; pg8::StaticOrder S; S.init(T, D, G, bx);
        pg8::EpiResid E{XF, XF, nullptr, ss2, 1.f, XB8};
        pg8::gemm_phase<pg8::EpiResid, pg8::StaticOrder, false, true>(lds, g, S, E);
    }
    SEAM(6);

    REP(7) if (IN(7)) {
        pg8::Gemm g{(const bf16*)XB8, (const bf16*)Wqkv8, T, NPROJ, D / 2}; pg8::StaticOrder S; S.init(T, NPROJ, G, bx);
        pg8::EpiProj E{ACT0, NPROJ, ss2, 16, od_q_norm, od_k_norm, nullptr, 1, 1.f / W8_SCALE};
        pg8::gemm_phase<pg8::EpiProj, pg8::StaticOrder, true, true, true>(lds, g, S, E);
    }
    SEAM(7);

    REP(8) if (IN(8)) {
        const float gqm = wave_max(fabsf(od_q_norm[lane])), gkm = wave_max(fabsf(od_k_norm[lane]));
        for (int L = vcu; L < 1024; L += G) {
            const int bh = (L & 255) >> 3, qb = 4 * (L & 7) + (L >> 8);
            const int b = bh >> 4, h = bh & 15;
            const float* tab = od_rel_bias + h * 257;
            float tm = fabsf(tab[lane]); tm = fmaxf(tm, fabsf(tab[64 + lane])); tm = fmaxf(tm, fabsf(tab[128 + lane])); tm = fmaxf(tm, fabsf(tab[192 + lane])); tm = fmaxf(tm, fabsf(tab[256]));
            tm = wave_max(tm);
            const float mref = (8.f * gqm * gkm + tm) * pg8::LOG2E;
            const bf16* base = ACT0 + (size_t)b * SEQ * NPROJ;
            att::attn_unit_pp<1, 64, true>((LAS char*)lds, base + h * 64, base + 1024 + h * 64, base + 2048 + h * 64, AO8 + (size_t)b * SEQ * D + h * 64, D, qb * 256, mref, tab, AO8_SCALE);
        }
    }
    SEAM(8);

    REP(9) if (IN(9)) {
        pg8::Gemm g{(const bf16*)AO8, (const bf16*)Wo18, T, D, D / 2}; pg8::StaticOrder S; S.init(T, D, G, bx);
        pg8::EpiResid E{XF, out, nullptr, nullptr, 1.f / (W8_SCALE * AO8_SCALE), nullptr};
        pg8::gemm_phase<pg8::EpiResid, pg8::StaticOrder, false, true, true>(lds, g, S, E);
    }
    SEAM(9);

    REP(10) if (IN(10)) {
        LAS float* wrT = (LAS float*)lds;
        LAS unsigned* sel = (LAS unsigned*)(lds + 32768);
        for (int i = tid; i < 1024; i += NTHR) { const float gn = od_ffn_norm[i]; const f32x4 w0 = *(const GAS f32x4*)(od_router + (size_t)i * 8), w1 = *(const GAS f32x4*)(od_router + (size_t)i * 8 + 4);
            wrT[i] = w0.x * gn; wrT[1024 + i] = w0.y * gn; wrT[2048 + i] = w0.z * gn; wrT[3072 + i] = w0.w * gn; wrT[4096 + i] = w1.x * gn; wrT[5120 + i] = w1.y * gn; wrT[6144 + i] = w1.z * gn; wrT[7168 + i] = w1.w * gn; }
        __syncthreads();
        for (int blk = vcu; blk < T / 64; blk += G) {
#pragma unroll 1
            for (int q4 = 0; q4 < 2; ++q4) {
                const int tok0 = blk * 64 + wave * 8 + q4 * 4;
                f32x4 xv[4][4]; float s[4]; float lg[4][8];
#pragma unroll
                for (int t4 = 0; t4 < 4; ++t4) { const GAS f32x4* xr = (const GAS f32x4*)(out + (size_t)(tok0 + t4) * D) + lane;
#pragma unroll
                    for (int j = 0; j < 4; ++j) xv[t4][j] = xr[64 * j]; }
#pragma unroll
                for (int t4 = 0; t4 < 4; ++t4) { s[t4] = 0.f;
#pragma unroll
                    for (int e2 = 0; e2 < 8; ++e2) lg[t4][e2] = 0.f;
#pragma unroll
                    for (int j = 0; j < 4; ++j) { const f32x4 v = xv[t4][j]; s[t4] += (v.x * v.x + v.y * v.y) + (v.z * v.z + v.w * v.w); } }
#pragma unroll
                for (int j = 0; j < 4; ++j)
#pragma unroll
                    for (int e2 = 0; e2 < 8; ++e2) { const f32x4 w = *(const LAS f32x4*)(wrT + e2 * 1024 + 256 * j + 4 * lane);
#pragma unroll
                        for (int t4 = 0; t4 < 4; ++t4) { const f32x4 v = xv[t4][j]; lg[t4][e2] += (v.x * w.x + v.y * w.y) + (v.z * w.z + v.w * w.w); } }
#pragma unroll
                for (int t4 = 0; t4 < 4; ++t4) { s[t4] = wave_sum(s[t4]);
#pragma unroll
                    for (int e2 = 0; e2 < 8; ++e2) lg[t4][e2] = wave_sum(lg[t4][e2]); }
                if (lane == 0) {
#pragma unroll
                    for (int t4 = 0; t4 < 4; ++t4) { const int tok = tok0 + t4;
                        const float r = rsqrtf(s[t4] * (1.f / 1024.f) + pg8::RMS_EPS); ss3[tok] = s[t4];
                        int e0 = 0; float v0 = lg[t4][0];
#pragma unroll
                        for (int e2 = 1; e2 < 8; ++e2) if (lg[t4][e2] > v0) { v0 = lg[t4][e2]; e0 = e2; }
                        int e1 = -1; float v1 = 0.f;
#pragma unroll
                        for (int e2 = 0; e2 < 8; ++e2) if (e2 != e0 && (e1 < 0 || lg[t4][e2] > v1)) { v1 = lg[t4][e2]; e1 = e2; }
                        const float ex = expf((v1 - v0) * r), g0 = 1.f / (1.f + ex), g1 = ex / (1.f + ex);
                        sel[wave * 8 + q4 * 4 + t4] = (unsigned)e0 | ((unsigned)e1 << 8); tokgate[2 * tok] = g0; tokgate[2 * tok + 1] = g1; }
                }
            }
            __syncthreads();
            if (wave == 0) { const unsigned sv = sel[lane]; const int e0 = sv & 0xff, e1 = sv >> 8; unsigned rank0 = 0, rank1 = 0;
                const unsigned long long lt = (1ull << lane) - 1ull;
#pragma unroll
                for (int e = 0; e < 8; ++e) { const unsigned long long m0 = __ballot(e0 == e), m1 = __ballot(e1 == e);
                    if (e0 == e) rank0 = __popcll(m0 & lt); if (e1 == e) rank1 = __popcll(m1 & lt);
                    if (lane == 0) { ctl[CW_HIST + blk * 16 + e] = __popcll(m0); ctl[CW_HIST + blk * 16 + 8 + e] = __popcll(m1); } }
                toksel[blk * 64 + lane] = sv | (rank0 << 16) | (rank1 << 24); }
            __syncthreads();
        }
    }
    SEAM(10);

    REP(11) if (IN(11)) {
        LAS unsigned* hs = (LAS unsigned*)lds;
        for (int i = tid; i < 4096; i += NTHR) hs[i] = ctl[CW_HIST + i];
        __syncthreads();
        if (tid < 16) hs[4096 + tid] = 0u;
        __syncthreads();
        { unsigned s = 0; const int g2 = tid & 15;
#pragma unroll
          for (int b2 = tid >> 4; b2 < 256; b2 += 32) s += hs[b2 * 16 + g2];
          atomicAdd((unsigned*)&hs[4096 + g2], s); }
        __syncthreads();
        if (tid == 0) { unsigned acc = 0; for (int g2 = 0; g2 < 16; ++g2) { hs[4128 + g2] = acc; acc += (hs[4096 + g2] + 255u) & ~255u; } hs[4128 + 16] = acc; }
        __syncthreads();
        if (bx == 0) {
            if (tid == 0) { ctl[CW_MOE] = hs[4128 + 8] >> 8; ctl[CW_MOE + 1] = hs[4128 + 16] >> 8; }
            if (tid < 16) { const unsigned t0 = hs[4128 + tid] >> 8, t1 = hs[4128 + tid + 1] >> 8; for (unsigned t = t0; t < t1; ++t) ctl[CW_MOE + 16 + t] = tid & 7; }
        }
        for (int blk = vcu; blk < T / 64; blk += G) {
            if (tid < 16) hs[4160 + tid] = 0u;
            __syncthreads();
            { unsigned s = 0; const int g2 = tid & 15;
#pragma unroll
              for (int b2 = tid >> 4; b2 < 256; b2 += 32) s += (b2 < blk) ? hs[b2 * 16 + g2] : 0u;
              atomicAdd((unsigned*)&hs[4160 + g2], s); }
            __syncthreads();
            for (int tl = wave; tl < 64; tl += NWAVES) {
                const int tok = blk * 64 + tl; const unsigned sv = toksel[tok];
                const GAS f32x4* xr = (const GAS f32x4*)(out + (size_t)tok * D + 16 * lane); const f32x4 v0 = xr[0], v1 = xr[1], v2 = xr[2], v3 = xr[3];
                v4u pk; pk.x = pg8::pk4_fp8(v0[0], v0[1], v0[2], v0[3]); pk.y = pg8::pk4_fp8(v1[0], v1[1], v1[2], v1[3]); pk.z = pg8::pk4_fp8(v2[0], v2[1], v2[2], v2[3]); pk.w = pg8::pk4_fp8(v3[0], v3[1], v3[2], v3[3]);
#pragma unroll
                for (int sl = 0; sl < 2; ++sl) { const int e = (sv >> (8 * sl)) & 0xff, rank = (sv >> (16 + 8 * sl)) & 0xff, g2 = sl * 8 + e;
                    const unsigned srow = hs[4128 + g2] + hs[4160 + g2] + rank;
                    *(GAS v4u*)(SORTA8 + (size_t)srow * D + lane * 16) = pk;
                    if (lane == 0) { rowtok[srow] = tok; rowgate[srow] = tokgate[2 * tok + sl]; } }
            }
            __syncthreads();
        }
        for (int g2 = vcu; g2 < 16; g2 += G) {
            const unsigned r0 = hs[4128 + g2] + hs[4096 + g2], r1 = hs[4128 + g2 + 1];
            for (unsigned r = r0 + wave; r < r1; r += NWAVES) { if (lane == 0) { rowtok[r] = -1; rowgate[r] = 0.f; }
                *(GAS v4u*)(SORTA8 + (size_t)r * D + lane * 16) = (v4u){0u, 0u, 0u, 0u}; }
        }
    }
    SEAM(11);

    if (IN(12) || IN(13) || IN(14)) {
        const int nA = (int)__builtin_amdgcn_readfirstlane(ctl[CW_MOE]), nT = (int)__builtin_amdgcn_readfirstlane(ctl[CW_MOE + 1]), nB = nT - nA;
        const int* texp = (const int*)(ctl + CW_MOE + 16);
        unsigned char* ACTE8B = ACTE8 + (size_t)63 * MiB;
        if (IN(12)) {
            pg8::Gemm g{(const bf16*)SORTA8, (const bf16*)WEgu8, 0, 0, D / 2}; pg8::MoeOrder S; S.init(nA, 2 * FFE / 256, G, bx, 0, texp);
            pg8::EpiSwiglu<true> E{ACTE8, FFE, ss3, 1, rowtok, 0, 2 * FFE / 256, 1.f / W8_SCALE};
            pg8::gemm_phase<pg8::EpiSwiglu<true>, pg8::MoeOrder, true, true, true>(lds, g, S, E);
        }
        SEAM(12);
        if (IN(13)) {
            { pg8::Gemm g{(const bf16*)ACTE8, (const bf16*)WEd8, 0, 0, FFE / 2}; pg8::MoeOrder S; S.init(nA, D / 256, G, bx, 0, texp);
              pg8::EpiMoeDown E{out, rowtok, rowgate, 0, 1.f / W8_SCALE, (args.flags >> 2) & 1};
              pg8::gemm_phase<pg8::EpiMoeDown, pg8::MoeOrder, true, true, true>(lds, g, S, E); }
            { const int nd = nA * (D / 256), nu = nB * (2 * FFE / 256); int H = nd - G; int R = 0;
              if (H > 0 && H < G / 2) { const int rmax = (nu + (G - H) - 1) / (G - H); int best = 0x7fffffff;
                  for (int r2 = 0; r2 <= rmax; ++r2) { const int rest = nu - r2 * (G - H) > 0 ? nu - r2 * (G - H) : 0; const int light = 28 + 8 * r2, heavy = 56 + 8 * ((rest + H - 1) / H); const int mk = light > heavy ? light : heavy; if (mk < best) { best = mk; R = r2; } } } else H = 0;
              pg8::Gemm g{(const bf16*)(SORTA8 + (size_t)nA * 256 * D), (const bf16*)WEgu8, 0, 0, D / 2}; pg8::MoeOrder S; S.init(nB, 2 * FFE / 256, G, bx, nA, texp, H, R);
              pg8::EpiSwiglu<true> E{ACTE8B, FFE, ss3, 1, rowtok, nA, 2 * FFE / 256, 1.f / W8_SCALE};
              pg8::gemm_phase<pg8::EpiSwiglu<true>, pg8::MoeOrder, true, true, true>(lds, g, S, E); }
        }
        SEAM(13);
        if (IN(14)) {
            pg8::Gemm g{(const bf16*)ACTE8B, (const bf16*)WEd8, 0, 0, FFE / 2}; pg8::MoeOrder S; S.init(nB, D / 256, G, bx, nA, texp);
            pg8::EpiMoeDown E{out, rowtok, rowgate, nA, 1.f / W8_SCALE, (args.flags >> 2) & 1};
            pg8::gemm_phase<pg8::EpiMoeDown, pg8::MoeOrder, true, true, true>(lds, g, S, E);
        }
    }
#undef IN
#undef SEAM
}

constexpr int N_PHASES = 15;
extern "C" void kernel_launch(void* const* d_in, const int* in_sizes, int n_in, void* d_out, int out_size, void* d_ws, size_t ws_size, hipStream_t stream) {
    static int grid = 0;
    if (grid == 0) {
        if (n_in != 27 || out_size != T * D || ws_size < WS_END) { fprintf(stderr, "kernel_launch: unexpected problem (n_in %d, out %d, ws %zu)\n", n_in, out_size, ws_size); grid = -1; return; }
        int dev = 0, cus = 0, per_cu = 0;
        if (hipGetDevice(&dev) != hipSuccess || hipDeviceGetAttribute(&cus, hipDeviceAttributeMultiprocessorCount, dev) != hipSuccess) { grid = -1; return; }
        if (hipFuncSetAttribute((const void*)fwd_kernel, hipFuncAttributeMaxDynamicSharedMemorySize, LDS_BYTES) != hipSuccess) { fprintf(stderr, "kernel_launch: hipFuncSetAttribute failed\n"); grid = -1; return; }
        if (hipOccupancyMaxActiveBlocksPerMultiprocessor(&per_cu, (const void*)fwd_kernel, NTHR, LDS_BYTES) != hipSuccess || per_cu < 1) { fprintf(stderr, "kernel_launch: occupancy query says %d\n", per_cu); }
        (void)hipGetLastError();
        grid = cus;
    }
    if (grid < 0) return;
    (void)hipMemsetAsync(d_ws, 0, CTL_ZERO_BYTES, stream);
    KArgs a{};
    for (int i = 0; i < 27; ++i) a.in[i] = d_in[i];
    a.out = (float*)d_out; a.ws = (unsigned char*)d_ws; a.ph_lo = 0; a.ph_hi = N_PHASES;
    hipLaunchKernelGGL(fwd_kernel, dim3(grid), dim3(NTHR), LDS_BYTES, stream, a);
#if defined(PROBE_LO)
    (void)hipMemsetAsync((char*)d_ws + CW_BAR * 4, 0, XCD_BAR_WORDS * 4, stream);
    a.ph_lo = PROBE_LO; a.ph_hi = PROBE_HI;
#if defined(PROBE_FLAGS)
    a.flags = PROBE_FLAGS;
#endif
    hipLaunchKernelGGL(fwd_kernel, dim3(grid), dim3(NTHR), LDS_BYTES, stream, a);
#endif
}
```

```cpp
#include <hip/hip_runtime.h>
#include <cstdio>
#include <cstdint>
#include <cmath>
#define PROBE_MASK 0x0
namespace pg8 {
#define PG8_LAS __attribute__((address_space(3)))
typedef unsigned short bf16_t;
typedef short bf16x8 __attribute__((ext_vector_type(8)));
typedef float f32x4 __attribute__((ext_vector_type(4)));
typedef unsigned u32x4 __attribute__((ext_vector_type(4)));
constexpr int BM = 256, BK = 64, HALF = 128, HTB = HALF * BK * 2  , STAGE_BYTES = 8 * HTB, NXCD = 8, WGM = 8;

__host__ __device__ __forceinline__ int lds_byte(int r, int c) { const int st = (r >> 4) * 2 + (c >> 5), rr = r & 15, cc = c & 31, ob = rr * 64 + cc * 2; return st * 1024 + (ob ^ (((ob >> 9) & 1) << 5)); }
__host__ __device__ __forceinline__ void stage_rc(int b, int& R, int& C) { const int st = b / 1024, sb = b % 1024, swz = sb ^ (((sb >> 9) & 1) << 5); R = (st >> 1) * 16 + swz / 64; C = (st & 1) * 32 + (swz % 64) / 2; }
__host__ __device__ __forceinline__ int perm32(int rho) { const int n = rho >> 4, i = rho & 15; return 8 * (i >> 2) + 4 * n + (i & 3); }

struct Unit { int pm, pn; };
struct Gemm { const bf16_t* A; const bf16_t* Bt; int M, N, K; };

struct StaticOrder {
    int nM, nN, nwg, G, c;
    __host__ __device__ void init(int M, int N, int G_, int c_) { nM = M / BM; nN = N / BM; nwg = nM * nN; G = G_; c = c_; }
    __host__ __device__ bool next(int i, Unit& u) const {
        const long L = (long)i * G + c; if (L >= nwg) return false;
        int wgid = (int)L; { const int q = nwg / NXCD, r = nwg % NXCD, xcd = wgid % NXCD, off = wgid / NXCD; wgid = (xcd < r ? xcd * (q + 1) : r * (q + 1) + (xcd - r) * q) + off; }
        const int nig = WGM * nN, gid = wgid / nig, fm = gid * WGM, gsz = (nM - fm) < WGM ? (nM - fm) : WGM;
        u.pm = fm + ((wgid % nig) % gsz); u.pn = (wgid % nig) / gsz; return true;
    }
    __device__ __forceinline__ void a_ready(const Unit&) const {}
    __device__ __forceinline__ void done(const Unit&) const {}
};

struct MoeOrder {
    int nM, nN, nwg, G, c, tile0; const int* tile_expert;
    int H, R;
    __device__ void init(int ntiles, int npn, int G_, int c_, int tile0_, const int* te, int H_ = 0, int R_ = 0) { nM = ntiles; nN = npn; nwg = nM * nN; G = G_; c = c_; tile0 = tile0_; tile_expert = te; H = H_; R = R_; }
    __device__ bool next(int i, Unit& u) const {
        long L;
        if (H == 0) L = (long)i * G + c;
        else if (c >= H) { if (i >= R) return false; L = (long)i * (G - H) + (c - H); }
        else L = (long)R * (G - H) + (long)i * H + c;
        if (L >= nwg) return false;
        int wgid = (int)L; { const int q = nwg / NXCD, r = nwg % NXCD, xcd = wgid % NXCD, off = wgid / NXCD; wgid = (xcd < r ? xcd * (q + 1) : r * (q + 1) + (xcd - r) * q) + off; }
        const int nig = WGM * nN, gid = wgid / nig, fm = gid * WGM, gsz = (nM - fm) < WGM ? (nM - fm) : WGM;
        u.pm = fm + ((wgid % nig) % gsz); const int pnl = (wgid % nig) / gsz;
        const int e = __builtin_amdgcn_readfirstlane(tile_expert[tile0 + u.pm]);
        u.pn = e * nN + pnl; return true;
    }
    __device__ __forceinline__ void a_ready(const Unit&) const {}
    __device__ __forceinline__ void done(const Unit&) const {}
};

__device__ __forceinline__ unsigned cvt_pk_bf16(float lo, float hi) { unsigned r; asm volatile("v_cvt_pk_bf16_f32 %0, %1, %2" : "=v"(r) : "v"(lo), "v"(hi)); return r; }
__device__ __forceinline__ u32x4 pack8(const f32x4& a, const f32x4& b) { u32x4 w; w.x = cvt_pk_bf16(a[0], a[1]); w.y = cvt_pk_bf16(a[2], a[3]); w.z = cvt_pk_bf16(b[0], b[1]); w.w = cvt_pk_bf16(b[2], b[3]); return w; }
__device__ __forceinline__ unsigned pk4_fp8(float a, float b, float c, float d) { int w = __builtin_amdgcn_cvt_pk_fp8_f32(a, b, 0, false); w = __builtin_amdgcn_cvt_pk_fp8_f32(c, d, w, true); return (unsigned)w; }
constexpr float RMS_EPS = 1e-6f;
constexpr float LOG2E = 1.4426950408889634f;
constexpr float C2 = 0.125f * LOG2E;
__device__ __forceinline__ float row_ss(const float* ss, int nparts, int row) {
    if (nparts == 1) return ss[row];
    const f32x4* p = (const f32x4*)(ss + (size_t)row * 16); f32x4 a = p[0], b = p[1], c = p[2], d = p[3]; a = (a + b) + (c + d); return (a[0] + a[1]) + (a[2] + a[3]);
}

struct EpiProj {
    static constexpr bool PERM = true, AFTER_DRAIN = false;
    bf16_t* O; int ldc; const float* ss; int nparts; const float* gq; const float* gk; const float* rope; int layer; float pre;
    __device__ __forceinline__ void operator()(const f32x4 (&acc)[2][2][4][2], const Unit& u, int wr, int wc, int fr, int fq) const {
        const int pn = u.pn; int kind = 0; float scale = 1.f; bool rope_on = false;
        if (layer == 0) { const int t = pn >> 1; if (t == 0) scale = C2; else if (t == 3) { kind = 1; scale = C2; rope_on = true; } else if (t == 4) { kind = 2; rope_on = true; } }
        else { const int t = pn >> 2; if (t == 0) { kind = 1; scale = C2; } else if (t == 1) kind = 2; }
        const float* gv = (kind == 1) ? gq : gk;
        f32x4 g[2][2];
#pragma unroll
        for (int bj = 0; bj < 2; ++bj)
#pragma unroll
            for (int n = 0; n < 2; ++n) g[bj][n] = kind ? *(const f32x4*)(gv + 32 * bj + 8 * fq + 4 * n) : (f32x4){1.f, 1.f, 1.f, 1.f};
        const int row0 = u.pm * BM + wr * 64 + fr, col0 = pn * BM + wc * 64 + 8 * fq;
#pragma unroll
        for (int ai = 0; ai < 2; ++ai)
#pragma unroll
            for (int m = 0; m < 4; ++m) {
                const int row = row0 + ai * HALF + m * 16;
                const float r = rsqrtf(row_ss(ss, nparts, row) * (1.f / 1024.f) + RMS_EPS) * pre;
                f32x4 v[2][2]; float s = 0.f;
#pragma unroll
                for (int bj = 0; bj < 2; ++bj)
#pragma unroll
                    for (int n = 0; n < 2; ++n) { v[bj][n] = acc[ai][bj][m][n] * r; const f32x4 x = v[bj][n]; s += (x[0] * x[0] + x[1] * x[1]) + (x[2] * x[2] + x[3] * x[3]); }
                if (kind) {
                    s += __shfl_xor(s, 16); s += __shfl_xor(s, 32);
                    const float rs = rsqrtf(s * (1.f / 64.f) + RMS_EPS);
#pragma unroll
                    for (int bj = 0; bj < 2; ++bj)
#pragma unroll
                        for (int n = 0; n < 2; ++n) v[bj][n] = v[bj][n] * rs * g[bj][n];
                    if (rope_on) {
                        f32x4 p[2];
#pragma unroll
                        for (int n = 0; n < 2; ++n)
#pragma unroll
                            for (int j = 0; j < 4; ++j) p[n][j] = __shfl_xor(v[0][n][j], 16);
                        const f32x4 c0 = *(const f32x4*)(rope + (size_t)row * 16), c1 = *(const f32x4*)(rope + (size_t)row * 16 + 4);
                        const f32x4 s0 = *(const f32x4*)(rope + (size_t)row * 16 + 8), s1 = *(const f32x4*)(rope + (size_t)row * 16 + 12);
                        if (fq == 0) { v[0][0] = v[0][0] * c0 - p[0] * s0; v[0][1] = v[0][1] * c1 - p[1] * s1; }
                        else if (fq == 1) { v[0][0] = v[0][0] * c0 + p[0] * s0; v[0][1] = v[0][1] * c1 + p[1] * s1; }
                    }
                }
                bf16_t* rowp = O + (size_t)row * ldc + col0;
#pragma unroll
                for (int bj = 0; bj < 2; ++bj) *(u32x4*)(rowp + 32 * bj) = pack8(v[bj][0] * scale, v[bj][1] * scale);
            }
    }
};

struct EpiResid {
    static constexpr bool PERM = true, AFTER_DRAIN = false;
    const float* base; float* out; bf16_t* xb; float* ss; float pre; unsigned char* x8;
    __device__ __forceinline__ void operator()(const f32x4 (&acc)[2][2][4][2], const Unit& u, int wr, int wc, int fr, int fq) const {
        const int row0 = u.pm * BM + wr * 64 + fr, col0 = u.pn * BM + wc * 32 + 8 * fq;
#pragma unroll
        for (int ai = 0; ai < 2; ++ai)
#pragma unroll
            for (int m = 0; m < 4; ++m) {
                const int row = row0 + ai * HALF + m * 16; float s = 0.f;
#pragma unroll
                for (int bj = 0; bj < 2; ++bj) {
                    const size_t off = (size_t)row * 1024 + col0 + bj * HALF;
                    const f32x4 v0 = acc[ai][bj][m][0] * pre + *(const f32x4*)(base + off), v1 = acc[ai][bj][m][1] * pre + *(const f32x4*)(base + off + 4);
                    *(f32x4*)(out + off) = v0; *(f32x4*)(out + off + 4) = v1;
                    if (xb) *(u32x4*)(xb + off) = pack8(v0, v1);
                    if (x8) { typedef unsigned u32x2 __attribute__((ext_vector_type(2))); u32x2 w8; w8.x = pk4_fp8(v0[0], v0[1], v0[2], v0[3]); w8.y = pk4_fp8(v1[0], v1[1], v1[2], v1[3]); *(u32x2*)(x8 + off) = w8; }
                    s += (v0[0] * v0[0] + v0[1] * v0[1]) + (v0[2] * v0[2] + v0[3] * v0[3]) + (v1[0] * v1[0] + v1[1] * v1[1]) + (v1[2] * v1[2] + v1[3] * v1[3]);
                }
                if (ss) { s += __shfl_xor(s, 16); s += __shfl_xor(s, 32); if (fq == 0) ss[(size_t)row * 16 + u.pn * 4 + wc] = s; }
            }
    }
};

template <bool OUT8> struct EpiSwiglu {
    static constexpr bool PERM = true, AFTER_DRAIN = false;
    void* O; int ldc; const float* ss; int nparts; const int* rowtok; int tile0; int npn; float pre;
    __device__ __forceinline__ void operator()(const f32x4 (&acc)[2][2][4][2], const Unit& u, int wr, int wc, int fr, int fq) const {
        const int pnl = u.pn % npn; const int row0 = u.pm * BM + wr * 64 + fr, col0 = pnl * HALF + wc * 32 + 8 * fq;
#pragma unroll
        for (int ai = 0; ai < 2; ++ai)
#pragma unroll
            for (int m = 0; m < 4; ++m) {
                const int row = row0 + ai * HALF + m * 16;
                int tok = row; if (rowtok) tok = rowtok[tile0 * BM + row];
                const float r = (tok >= 0) ? rsqrtf(row_ss(ss, nparts, tok >= 0 ? tok : 0) * (1.f / 1024.f) + RMS_EPS) * pre : 0.f;
                f32x4 a[2];
#pragma unroll
                for (int n = 0; n < 2; ++n)
#pragma unroll
                    for (int j = 0; j < 4; ++j) { const float gt = acc[ai][0][m][n][j] * r, up = acc[ai][1][m][n][j] * r;
                        a[n][j] = gt * __builtin_amdgcn_rcpf(1.f + __builtin_amdgcn_exp2f(-gt * LOG2E)) * up; }
                if constexpr (OUT8) { typedef unsigned u32x2 __attribute__((ext_vector_type(2))); u32x2 w; w.x = pk4_fp8(a[0][0], a[0][1], a[0][2], a[0][3]); w.y = pk4_fp8(a[1][0], a[1][1], a[1][2], a[1][3]); *(u32x2*)((unsigned char*)O + (size_t)row * ldc + col0) = w; }
                else *(u32x4*)((bf16_t*)O + (size_t)row * ldc + col0) = pack8(a[0], a[1]);
            }
    }
};

struct EpiMoeDown {
    static constexpr bool PERM = true, AFTER_DRAIN = false;
    float* out; const int* rowtok; const float* rowgate; int tile0; float pre; int nostore;
    __device__ __forceinline__ void operator()(const f32x4 (&acc)[2][2][4][2], const Unit& u, int wr, int wc, int fr, int fq) const {
        const int pnl = u.pn & 3; const int row0 = (tile0 + u.pm) * BM + wr * 64 + fr, col0 = pnl * BM + wc * 32 + 8 * fq;
#pragma unroll
        for (int ai = 0; ai < 2; ++ai)
#pragma unroll
            for (int m = 0; m < 4; ++m) {
                const int srow = row0 + ai * HALF + m * 16; const int tok = nostore ? -1 : rowtok[srow];
                if (tok >= 0) { const float gt = rowgate[srow] * pre;
#pragma unroll
                    for (int bj = 0; bj < 2; ++bj)
#pragma unroll
                        for (int n = 0; n < 2; ++n) { f32x4* p = (f32x4*)(out + (size_t)tok * 1024 + col0 + bj * HALF + 4 * n); *p = *p + acc[ai][bj][m][n] * gt; } }
            }
    }
};

typedef int i32x4 __attribute__((ext_vector_type(4)));
typedef int i32x8 __attribute__((ext_vector_type(8)));
template <class Epi, class Sched, bool ALIGN_EPI = false, bool SP2 = false, bool F8 = false>
__device__ __forceinline__ void gemm_phase(PG8_LAS unsigned char* lds, const Gemm g, const Sched& S, const Epi& E) {
    const int tid = threadIdx.x, wid = __builtin_amdgcn_readfirstlane(tid >> 6), lane = tid & 63, wr = wid >> 2, wc = wid & 3, fr = lane & 15, fq = lane >> 4;
    const int K = g.K, nt = K / BK;
    unsigned voffA[2], voffB[2];
#pragma unroll
    for (int i = 0; i < 2; ++i) { int R, C; stage_rc(tid * 16 + i * 8192, R, C); const int Rb = Epi::PERM ? ((R & ~31) + perm32(R & 31)) : R;
        voffA[i] = (unsigned)(R * K + C) * 2u; voffB[i] = (unsigned)(Rb * K + C) * 2u; }
    const size_t kstep = (size_t)(BK * 2);
    const size_t hstep = (size_t)HALF * K * 2;
    const size_t tstep = 2 * hstep;
    const unsigned ldsw = (unsigned)wid * 1024u;
    const int aoff = lds_byte(wr * 64 + fr, fq * 8), boff = lds_byte(wc * 32 + fr, fq * 8);
#define PG8_SA(b, h) (((b) * 2 + (h)) * HTB)
#define PG8_SB(b, h) ((4 + (b) * 2 + (h)) * HTB)
#define PG8_STAGE(bufoff, gbase, voff) do { _Pragma("unroll") for (int _i = 0; _i < 2; ++_i) \
        __builtin_amdgcn_global_load_lds((const unsigned*)((const char*)(gbase) + (voff)[_i]), (PG8_LAS unsigned*)(lds + (bufoff) + ldsw + _i * 8192), 16, 0, 0); } while (0)
#define PG8_LDA(dst, b, h) do { if constexpr (F8) { _Pragma("unroll") for (int m = 0; m < 4; ++m) dst##8[m] = PG8_CAT(*(const PG8_LAS bf16x8*)(lds + PG8_SA(b, h) + aoff + m * 2048), *(const PG8_LAS bf16x8*)(lds + PG8_SA(b, h) + aoff + m * 2048 + 1024)); } \
        else { _Pragma("unroll") for (int m = 0; m < 4; ++m) _Pragma("unroll") for (int k = 0; k < 2; ++k) dst[m][k] = *(const PG8_LAS bf16x8*)(lds + PG8_SA(b, h) + aoff + m * 2048 + k * 1024); } } while (0)
#define PG8_LDB(dst, b, h) do { if constexpr (F8) { _Pragma("unroll") for (int n = 0; n < 2; ++n) dst##8[n] = PG8_CAT(*(const PG8_LAS bf16x8*)(lds + PG8_SB(b, h) + boff + n * 2048), *(const PG8_LAS bf16x8*)(lds + PG8_SB(b, h) + boff + n * 2048 + 1024)); } \
        else { _Pragma("unroll") for (int n = 0; n < 2; ++n) _Pragma("unroll") for (int k = 0; k < 2; ++k) dst[n][k] = *(const PG8_LAS bf16x8*)(lds + PG8_SB(b, h) + boff + n * 2048 + k * 1024); } } while (0)
#define PG8_CAT(x, y) __builtin_shufflevector(__builtin_bit_cast(i32x4, (x)), __builtin_bit_cast(i32x4, (y)), 0, 1, 2, 3, 4, 5, 6, 7)
#define PG8_MMA(ai, bj, At, Bt) do { __builtin_amdgcn_s_setprio(1); _Pragma("unroll") for (int m = 0; m < 4; ++m) _Pragma("unroll") for (int n = 0; n < 2; ++n) { \
        if constexpr (F8) { asm volatile("v_mfma_f32_16x16x128_f8f6f4 %0, %1, %2, %0" : "+v"(acc[ai][bj][m][n]) : "v"(Bt##8[n]), "v"(At##8[m])); } \
        else { _Pragma("unroll") for (int k = 0; k < 2; ++k) acc[ai][bj][m][n] = __builtin_amdgcn_mfma_f32_16x16x32_bf16(Bt[n][k], At[m][k], acc[ai][bj][m][n], 0, 0, 0); } } __builtin_amdgcn_s_setprio(0); } while (0)
#define PG8_WAIT_V(n) asm volatile("s_waitcnt vmcnt(" #n ")" ::: "memory")
#define PG8_WAIT_L(n) asm volatile("s_waitcnt lgkmcnt(" #n ")" ::: "memory")
#define PG8_BAR __builtin_amdgcn_s_barrier()
#define PG8_SCHED __builtin_amdgcn_sched_barrier(0)
    Unit cur, nxt; int ui = 0;
    if (!S.next(0, cur)) return;
    f32x4 acc[2][2][4][2];
#pragma unroll
    for (int a = 0; a < 2; ++a)
#pragma unroll
        for (int b = 0; b < 2; ++b)
#pragma unroll
            for (int m = 0; m < 4; ++m)
#pragma unroll
                for (int n = 0; n < 2; ++n) acc[a][b][m][n] = (f32x4){0.f, 0.f, 0.f, 0.f};
    bf16x8 At[4][2], B0[2][2], B1[2][2];
    i32x8 At8[4], B08[2], B18[2];
    const char* cA = (const char*)g.A + (size_t)cur.pm * tstep; const char* cB = (const char*)g.Bt + (size_t)cur.pn * tstep;
    S.a_ready(cur);
    if constexpr (SP2) {
        PG8_STAGE(PG8_SB(0, 0), cB, voffB); PG8_STAGE(PG8_SB(0, 1), cB + hstep, voffB); PG8_STAGE(PG8_SA(0, 0), cA, voffA); PG8_STAGE(PG8_SA(0, 1), cA + hstep, voffA);
        if (wr == 1) PG8_BAR;
        PG8_WAIT_V(2); PG8_BAR;
        PG8_STAGE(PG8_SB(1, 0), cB + kstep, voffB); PG8_STAGE(PG8_SA(1, 0), cA + kstep, voffA); PG8_STAGE(PG8_SB(1, 1), cB + hstep + kstep, voffB);
        PG8_WAIT_V(6); PG8_BAR;
    } else {
        PG8_STAGE(PG8_SB(0, 0), cB, voffB); PG8_STAGE(PG8_SA(0, 0), cA, voffA); PG8_STAGE(PG8_SB(0, 1), cB + hstep, voffB); PG8_STAGE(PG8_SA(0, 1), cA + hstep, voffA);
        if (wr == 1) PG8_BAR;
        PG8_WAIT_V(4); PG8_BAR;
        PG8_STAGE(PG8_SB(1, 0), cB + kstep, voffB); PG8_STAGE(PG8_SA(1, 0), cA + kstep, voffA); PG8_STAGE(PG8_SB(1, 1), cB + hstep + kstep, voffB);
        PG8_WAIT_V(6); PG8_BAR;
    }
    for (;;) {
        const bool has_next = S.next(ui + 1, nxt);
        const char* nA = has_next ? (const char*)g.A + (size_t)nxt.pm * tstep : cA; const char* nB = has_next ? (const char*)g.Bt + (size_t)nxt.pn * tstep : cB;
#pragma nounroll
        for (int t = 0; t < nt; t += 2) {
            const bool last = (t == nt - 2);
            const char* a1 = cA + (size_t)(t + 1) * kstep;
            const char* a2 = last ? nA : cA + (size_t)(t + 2) * kstep; const char* b2 = last ? nB : cB + (size_t)(t + 2) * kstep;
            const char* a3 = a2 + kstep; const char* b3 = b2 + kstep;
            if (last && has_next) S.a_ready(nxt);
            if constexpr (SP2) {
            PG8_LDB(B0, 0, 0); PG8_LDB(B1, 0, 1); PG8_SCHED; PG8_LDA(At, 0, 0); PG8_STAGE(PG8_SA(1, 1), a1 + hstep, voffA);
            PG8_WAIT_V(8); PG8_WAIT_L(0); PG8_BAR; PG8_MMA(0, 0, At, B0); PG8_MMA(0, 1, At, B1); PG8_BAR; PG8_SCHED;
            PG8_LDA(At, 0, 1); PG8_STAGE(PG8_SB(0, 0), b2, voffB); PG8_STAGE(PG8_SB(0, 1), b2 + hstep, voffB); PG8_STAGE(PG8_SA(0, 0), a2, voffA);
            PG8_WAIT_V(8); PG8_WAIT_L(0); PG8_BAR; PG8_MMA(1, 0, At, B0); PG8_MMA(1, 1, At, B1); PG8_BAR; PG8_SCHED;
            PG8_LDB(B0, 1, 0); PG8_LDB(B1, 1, 1); PG8_SCHED; PG8_LDA(At, 1, 0); PG8_STAGE(PG8_SA(0, 1), a2 + hstep, voffA);
            PG8_WAIT_V(8); PG8_WAIT_L(0); PG8_BAR; PG8_MMA(0, 0, At, B0); PG8_MMA(0, 1, At, B1); PG8_BAR; PG8_SCHED;
            PG8_LDA(At, 1, 1); PG8_STAGE(PG8_SB(1, 0), b3, voffB); PG8_STAGE(PG8_SB(1, 1), b3 + hstep, voffB); PG8_STAGE(PG8_SA(1, 0), a3, voffA);
            PG8_WAIT_V(8); PG8_WAIT_L(0); PG8_BAR; PG8_MMA(1, 0, At, B0); PG8_MMA(1, 1, At, B1); PG8_BAR; PG8_SCHED;
            } else {
            PG8_LDB(B0, 0, 0); PG8_SCHED; PG8_LDA(At, 0, 0); PG8_STAGE(PG8_SA(1, 1), a1 + hstep, voffA);
            PG8_WAIT_L(8); PG8_BAR; PG8_WAIT_L(0); PG8_MMA(0, 0, At, B0); PG8_BAR; PG8_SCHED;
            PG8_LDB(B1, 0, 1); PG8_STAGE(PG8_SB(0, 0), b2, voffB);
            PG8_BAR; PG8_WAIT_L(0); PG8_MMA(0, 1, At, B1); PG8_BAR;
            PG8_LDA(At, 0, 1); PG8_STAGE(PG8_SA(0, 0), a2, voffA);
            PG8_BAR; PG8_WAIT_L(0); PG8_MMA(1, 0, At, B0); PG8_BAR; PG8_SCHED;
            PG8_STAGE(PG8_SB(0, 1), b2 + hstep, voffB);
            PG8_WAIT_V(6); PG8_BAR; PG8_MMA(1, 1, At, B1); PG8_BAR;
            PG8_LDB(B0, 1, 0); PG8_SCHED; PG8_LDA(At, 1, 0); PG8_STAGE(PG8_SA(0, 1), a2 + hstep, voffA);
            PG8_WAIT_L(8); PG8_BAR; PG8_WAIT_L(0); PG8_MMA(0, 0, At, B0); PG8_BAR; PG8_SCHED;
            PG8_LDB(B1, 1, 1); PG8_STAGE(PG8_SB(1, 0), b3, voffB);
            PG8_BAR; PG8_WAIT_L(0); PG8_MMA(0, 1, At, B1); PG8_BAR;
            PG8_LDA(At, 1, 1); PG8_STAGE(PG8_SA(1, 0), a3, voffA);
            PG8_BAR; PG8_WAIT_L(0); PG8_MMA(1, 0, At, B0); PG8_BAR; PG8_SCHED;
            PG8_STAGE(PG8_SB(1, 1), b3 + hstep, voffB);
            PG8_WAIT_V(6); PG8_BAR; PG8_MMA(1, 1, At, B1); PG8_BAR;
            }
        }
        if constexpr (F8) asm volatile("s_nop 15\n\ts_nop 15\n\ts_nop 15" ::: "memory");
        if constexpr (ALIGN_EPI) { if (wr == 0) PG8_BAR; }
        if constexpr (!Epi::AFTER_DRAIN) { E(acc, cur, wr, wc, fr, fq); S.done(cur); }
        if (!has_next) break;
#pragma unroll
        for (int a = 0; a < 2; ++a)
#pragma unroll
            for (int b = 0; b < 2; ++b)
#pragma unroll
                for (int m = 0; m < 4; ++m)
#pragma unroll
                    for (int n = 0; n < 2; ++n) acc[a][b][m][n] = (f32x4){0.f, 0.f, 0.f, 0.f};
        cur = nxt; cA = nA; cB = nB; ++ui;
        if constexpr (ALIGN_EPI) { if (wr == 1) PG8_BAR; }
    }
    PG8_WAIT_V(0);
    if constexpr (!ALIGN_EPI) { if (wr == 0) PG8_BAR; }
    PG8_BAR;
    if constexpr (Epi::AFTER_DRAIN) { E.fused(acc, cur, wr, wc, fr, fq, lds, wid, lane); S.done(cur); }
#undef PG8_SA
#undef PG8_SB
#undef PG8_STAGE
#undef PG8_LDA
#undef PG8_LDB
#undef PG8_MMA
#undef PG8_CAT
#undef PG8_WAIT_V
#undef PG8_WAIT_L
#undef PG8_BAR
#undef PG8_SCHED
}
}

namespace att {
using pg8::bf16_t; using pg8::bf16x8; using pg8::u32x4;
typedef float f32x16 __attribute__((ext_vector_type(16)));
typedef short s16x4 __attribute__((ext_vector_type(4)));
typedef float f32x2_t __attribute__((ext_vector_type(2))); typedef __bf16 bf16x2_t __attribute__((ext_vector_type(2)));
#define ALAS __attribute__((address_space(3)))
typedef ALAS const char* lds_cptr;
constexpr int SEQ = 8192, PITCH = 3072;
constexpr int KVSLOT = 24576;
constexpr int L_WS = 4 * KVSLOT, L_TAB = L_WS + 2048, L_FLAG = L_TAB + 1056, L_END = L_FLAG + 64, L_OST = 0;
constexpr float SB_THR = 152.f;
__device__ __forceinline__ int crow(int r, int hi) { return (r & 3) + 8 * (r >> 2) + 4 * hi; }
__device__ __forceinline__ void glds16(const void* gsrc, unsigned lds_dst) { unsigned keep;
    asm volatile("s_mov_b32 %0, m0\n\ts_mov_b32 m0, %2\n\ts_nop 0\n\tglobal_load_lds_dwordx4 %1, off\n\ts_mov_b32 m0, %0" : "=&s"(keep) : "v"(gsrc), "s"(lds_dst) : "memory"); }
__device__ __forceinline__ unsigned cvtpk(float lo, float hi) { f32x2_t v = {lo, hi}; bf16x2_t b = __builtin_convertvector(v, bf16x2_t); return __builtin_bit_cast(unsigned, b); }
__device__ __forceinline__ unsigned short f2bf(float f) { unsigned u = __builtin_bit_cast(unsigned, f); return (unsigned short)((u + 0x7fffu + ((u >> 16) & 1u)) >> 16); }
#define MFMA32(a, b, c) __builtin_amdgcn_mfma_f32_32x32x16_bf16((a), (b), (c), 0, 0, 0)

__device__ __forceinline__ void qkt(f32x16& p0, f32x16& p1, lds_cptr kb, const bf16x8* qr, const f32x16& cin) {
#pragma unroll
    for (int d0 = 0; d0 < 4; ++d0) {
        const bf16x8 b0 = *(const ALAS bf16x8*)(kb + d0 * 2048);
        const bf16x8 b1 = *(const ALAS bf16x8*)(kb + d0 * 2048 + 512);
        if (d0 == 0) { p0 = MFMA32(b0, qr[0], cin); p1 = MFMA32(b1, qr[0], cin); }
        else { p0 = MFMA32(b0, qr[d0], p0); p1 = MFMA32(b1, qr[d0], p1); }
    }
}
template <int ND> __device__ __forceinline__ void pv(f32x16* o, int vb, bf16x8 pa0, bf16x8 pa1, bf16x8 pa2, bf16x8 pa3) {
#pragma unroll
    for (int d0 = 0; d0 < ND; ++d0) { s16x4 lo[4], hi[4];
#pragma unroll
        for (int ks = 0; ks < 4; ++ks) {
            asm volatile("ds_read_b64_tr_b16 %0,%1 offset:%c2" : "=&v"(lo[ks]) : "v"(vb), "i"(d0 * 4096 + ks * 1024) : "memory");
            asm volatile("ds_read_b64_tr_b16 %0,%1 offset:%c2" : "=&v"(hi[ks]) : "v"(vb), "i"(d0 * 4096 + ks * 1024 + 512) : "memory"); }
        asm volatile("s_waitcnt lgkmcnt(0)" ::: "memory"); __builtin_amdgcn_sched_barrier(0);
#define ATT_PK(k) (bf16x8){lo[k][0], lo[k][1], lo[k][2], lo[k][3], hi[k][0], hi[k][1], hi[k][2], hi[k][3]}
        o[d0] = MFMA32(pa0, ATT_PK(0), o[d0]);
        o[d0] = MFMA32(pa1, ATT_PK(1), o[d0]);
        o[d0] = MFMA32(pa2, ATT_PK(2), o[d0]);
        o[d0] = MFMA32(pa3, ATT_PK(3), o[d0]);
#undef ATT_PK
    }
}

template <int MODE, int VD>
__device__ __forceinline__ void attn_unit(ALAS char* shm, const bf16_t* Qb, const bf16_t* Kb, const bf16_t* Vb, bf16_t* Ob, int opitch, int q0, float mref2, const float* tab) {
    constexpr int ND = VD / 32;
    const int tid = threadIdx.x, lane = tid & 63, r32 = lane & 31, hi = lane >> 5; const int wid = __builtin_amdgcn_readfirstlane(tid >> 6);
    const unsigned lds0 = (unsigned)(uintptr_t)shm;
    ALAS float* wsf = (ALAS float*)(shm + L_WS) + wid * 64;
    ALAS float* tabL = (ALAS float*)(shm + L_TAB);
    ALAS unsigned* flg = (ALAS unsigned*)(shm + L_FLAG);
    if (MODE == 1) { for (int i = tid; i < 257; i += 512) tabL[i] = tab[i] * pg8::LOG2E; }
    const bf16_t* Qw = Qb + (size_t)(q0 + wid * 32) * PITCH;
    bf16x8 qr[4];
#pragma unroll
    for (int d0 = 0; d0 < 4; ++d0) qr[d0] = *(const bf16x8*)(Qw + (size_t)r32 * PITCH + d0 * 16 + hi * 8);
    int t_first, n_t, t_step;
    if (MODE == 0) { t_first = 0; n_t = q0 / 64 + 4; t_step = 1; }
    else if (MODE == 1) { const int c0 = q0 / 64; t_first = c0 - 8 > 0 ? c0 - 8 : 0; n_t = c0 + 4 - t_first; t_step = 1; }
    else { t_first = q0 / 64 + 3; n_t = q0 / 64 + 4; t_step = -1; }
    const bf16_t* ksrc = Kb + (size_t)lane * PITCH + wid * 8;
    const bf16_t* vsrc = Vb + (size_t)(16 * (wid & 3) + (lane >> 2)) * PITCH + (wid >> 2) * 32 + (lane & 3) * 8;
#define ATT_DMA(t, slot) do { const size_t to_ = (size_t)(t) * 64 * PITCH; const unsigned sb_ = lds0 + (unsigned)(slot) * KVSLOT; \
        glds16(ksrc + to_, (unsigned)__builtin_amdgcn_readfirstlane(sb_ + wid * 1024)); \
        glds16(vsrc + to_, (unsigned)__builtin_amdgcn_readfirstlane(sb_ + 8192 + wid * 1024)); \
        if (VD == 128) glds16(vsrc + to_ + 64, (unsigned)__builtin_amdgcn_readfirstlane(sb_ + 8192 + (wid + 8) * 1024)); } while (0)
    f32x16 o[ND];
#pragma unroll
    for (int d = 0; d < ND; ++d) o[d] = f32x16{};
    f32x16 cin;
#pragma unroll
    for (int r = 0; r < 16; ++r) cin[r] = (MODE == 2) ? 0.f : -mref2;
    float l_reg = 0.f, A = 0.f; bool wdone = false;
    const int wrow0 = q0 + wid * 32, qrow = wrow0 + r32;
    const int vb0 = (int)lds0 + 8192 + ((lane >> 4) & 1) * 32 + (lane & 3) * 8 + (4 * hi + ((lane & 15) >> 2)) * 64;
    asm volatile("s_waitcnt vmcnt(0)" ::: "memory"); asm volatile("" : "+v"(qr[0]), "+v"(qr[1]), "+v"(qr[2]), "+v"(qr[3]));
    ATT_DMA(t_first, 0);
    for (int i = 0; i < n_t; ++i) {
        const int t = t_first + i * t_step, slot = i & 1;
        asm volatile("s_waitcnt vmcnt(0) lgkmcnt(0)\n\ts_barrier" ::: "memory");
        if (MODE == 2 && i > 0) { const int par = ((i - 1) & 1) * 8; unsigned all = 1u;
#pragma unroll
            for (int w = 0; w < 8; ++w) all &= flg[par + w];
            if (__builtin_amdgcn_readfirstlane(all)) break; }
        if (i + 1 < n_t) ATT_DMA(t + t_step, slot ^ 1);
        bool active;
        if (MODE == 0) active = (64 * t <= wrow0);
        else if (MODE == 1) { const int cw = wrow0 / 64; active = (t >= cw - 8) && (t <= cw); }
        else active = !wdone && (64 * t < wrow0 + 31);
        if (active) {
            const lds_cptr kb = (lds_cptr)shm + slot * KVSLOT + hi * 1024 + r32 * 16;
            f32x16 p0, p1; qkt(p0, p1, kb, qr, cin);
            if (MODE == 0) {
#pragma unroll
                for (int r = 0; r < 16; ++r) { p0[r] = __builtin_amdgcn_exp2f(p0[r]); p1[r] = __builtin_amdgcn_exp2f(p1[r]); }
            } else if (MODE == 1) {
                const int cw = wrow0 / 64;
                if (t <= cw - 3) { const float cb = tabL[256];
#pragma unroll
                    for (int r = 0; r < 16; ++r) { p0[r] = __builtin_amdgcn_exp2f(p0[r] + cb); p1[r] = __builtin_amdgcn_exp2f(p1[r] + cb); }
                } else { const int dq = qrow - 64 * t - 4 * hi;
#pragma unroll
                    for (int r = 0; r < 16; ++r) { int d0 = dq - ((r & 3) + 8 * (r >> 2)), d1 = d0 - 32;
                        d0 = d0 < -128 ? -128 : (d0 > 128 ? 128 : d0); d1 = d1 < -128 ? -128 : (d1 > 128 ? 128 : d1);
                        p0[r] = __builtin_amdgcn_exp2f(p0[r] + tabL[d0 + 128]); p1[r] = __builtin_amdgcn_exp2f(p1[r] + tabL[d1 + 128]); }
                }
            } else {
                const bool needmask = (64 * t + 63 >= wrow0);
                const int kq = qrow - 64 * t - 4 * hi;
                float g[8];
#pragma unroll
                for (int k = 0; k < 8; ++k) g[k] = 0.f;
                f32x16 s0, s1;
#pragma unroll
                for (int r = 0; r < 16; ++r) { const int kv = (r & 3) + 8 * (r >> 2);
                    { const float y = p0[r], a = __builtin_fabsf(y); float sp = __builtin_fmaxf(y, 0.f) + __builtin_amdgcn_logf(1.f + __builtin_amdgcn_exp2f(-a)); if (needmask && !(kv < kq)) sp = 0.f; s0[r] = sp; g[r >> 2] += sp; }
                    { const float y = p1[r], a = __builtin_fabsf(y); float sp = __builtin_fmaxf(y, 0.f) + __builtin_amdgcn_logf(1.f + __builtin_amdgcn_exp2f(-a)); if (needmask && !(kv + 32 < kq)) sp = 0.f; s1[r] = sp; g[4 + (r >> 2)] += sp; } }
                float pg[8];
#pragma unroll
                for (int k = 0; k < 8; ++k) pg[k] = __shfl_xor(g[k], 32);
                float base[8]; float own = 0.f, par = 0.f;
#pragma unroll
                for (int k = 7; k >= 0; --k) { const float par_incl = par + pg[k]; base[k] = A + own + (hi == 0 ? par_incl : par); own += g[k]; par = par_incl; }
                A += own + par;
#pragma unroll
                for (int k = 0; k < 4; ++k) {
                    { float c = base[k]; c += s0[4 * k + 3]; const float w3 = __builtin_amdgcn_exp2f(p0[4 * k + 3] - c); c += s0[4 * k + 2]; const float w2 = __builtin_amdgcn_exp2f(p0[4 * k + 2] - c);
                      c += s0[4 * k + 1]; const float w1 = __builtin_amdgcn_exp2f(p0[4 * k + 1] - c); c += s0[4 * k]; const float w0 = __builtin_amdgcn_exp2f(p0[4 * k] - c);
                      p0[4 * k] = w0; p0[4 * k + 1] = w1; p0[4 * k + 2] = w2; p0[4 * k + 3] = w3; }
                    { float c = base[4 + k]; c += s1[4 * k + 3]; const float w3 = __builtin_amdgcn_exp2f(p1[4 * k + 3] - c); c += s1[4 * k + 2]; const float w2 = __builtin_amdgcn_exp2f(p1[4 * k + 2] - c);
                      c += s1[4 * k + 1]; const float w1 = __builtin_amdgcn_exp2f(p1[4 * k + 1] - c); c += s1[4 * k]; const float w0 = __builtin_amdgcn_exp2f(p1[4 * k] - c);
                      p1[4 * k] = w0; p1[4 * k + 1] = w1; p1[4 * k + 2] = w2; p1[4 * k + 3] = w3; }
                }
                if (needmask) {
#pragma unroll
                    for (int r = 0; r < 16; ++r) { const int kv = (r & 3) + 8 * (r >> 2); if (!(kv < kq)) p0[r] = 0.f; if (!(kv + 32 < kq)) p1[r] = 0.f; }
                }
                wdone = __all(A >= SB_THR);
            }
            if (MODE != 2) { float s = 0.f;
#pragma unroll
                for (int r = 0; r < 16; ++r) s += p0[r] + p1[r];
                l_reg += s; }
            u32x4 pw0, pw1, pw2, pw3;
            pw0 = (u32x4){cvtpk(p0[0], p0[1]), cvtpk(p0[2], p0[3]), cvtpk(p0[4], p0[5]), cvtpk(p0[6], p0[7])};
            pw1 = (u32x4){cvtpk(p0[8], p0[9]), cvtpk(p0[10], p0[11]), cvtpk(p0[12], p0[13]), cvtpk(p0[14], p0[15])};
            pw2 = (u32x4){cvtpk(p1[0], p1[1]), cvtpk(p1[2], p1[3]), cvtpk(p1[4], p1[5]), cvtpk(p1[6], p1[7])};
            pw3 = (u32x4){cvtpk(p1[8], p1[9]), cvtpk(p1[10], p1[11]), cvtpk(p1[12], p1[13]), cvtpk(p1[14], p1[15])};
            pv<ND>(o, vb0 + slot * KVSLOT, __builtin_bit_cast(bf16x8, pw0), __builtin_bit_cast(bf16x8, pw1), __builtin_bit_cast(bf16x8, pw2), __builtin_bit_cast(bf16x8, pw3));
        }
        if (MODE == 2) { if (lane == 0) flg[(i & 1) * 8 + wid] = wdone ? 1u : 0u; }
    }
#undef ATT_DMA
    asm volatile("s_waitcnt vmcnt(0) lgkmcnt(0)\n\ts_barrier" ::: "memory");
    float rl[16];
    if (MODE != 2) {
        l_reg += __shfl_xor(l_reg, 32);
        if (hi == 0) wsf[32 + r32] = l_reg;
        asm volatile("s_waitcnt lgkmcnt(0)" ::: "memory");
#pragma unroll
        for (int r = 0; r < 16; ++r) rl[r] = __builtin_amdgcn_rcpf(wsf[32 + crow(r, hi)]);
    } else {
#pragma unroll
        for (int r = 0; r < 16; ++r) rl[r] = 1.f;
    }
    bf16_t* Ow = Ob + (size_t)(q0 + wid * 32) * opitch;
    ALAS bf16_t* stg = (ALAS bf16_t*)(shm + L_OST) + wid * 2048;
#pragma unroll
    for (int half = 0; half < ND / 2; ++half) {
#pragma unroll
        for (int r = 0; r < 16; ++r) { const int orow = crow(r, hi);
#pragma unroll
            for (int d0 = 0; d0 < 2; ++d0) stg[orow * 64 + d0 * 32 + r32] = f2bf(o[half * 2 + d0][r] * rl[r]); }
        asm volatile("s_waitcnt lgkmcnt(0)" ::: "memory");
#pragma unroll
        for (int i = 0; i < 4; ++i) { const int row = i * 8 + (lane >> 3), ch = lane & 7; const u32x4 v = *(const ALAS u32x4*)(stg + row * 64 + ch * 8); *(u32x4*)(Ow + (size_t)row * opitch + half * 64 + ch * 8) = v; }
        asm volatile("s_waitcnt lgkmcnt(0)" ::: "memory");
    }
    asm volatile("s_waitcnt vmcnt(0) lgkmcnt(0)\n\ts_barrier" ::: "memory");
}


__device__ __forceinline__ void qkt8(f32x16& p0, f32x16& p1, lds_cptr kb, const bf16x8* qr, const f32x16& cin) {
    bf16x8 kf[8];
#pragma unroll
    for (int d0 = 0; d0 < 4; ++d0) { kf[2 * d0] = *(const ALAS bf16x8*)(kb + d0 * 2048); kf[2 * d0 + 1] = *(const ALAS bf16x8*)(kb + d0 * 2048 + 512); }
    __builtin_amdgcn_sched_barrier(0);
    p0 = MFMA32(kf[0], qr[0], cin); p1 = MFMA32(kf[1], qr[0], cin);
#pragma unroll
    for (int d0 = 1; d0 < 4; ++d0) { p0 = MFMA32(kf[2 * d0], qr[d0], p0); p1 = MFMA32(kf[2 * d0 + 1], qr[d0], p1); }
}
template <int ND, int KS0> __device__ __forceinline__ void v_reads(s16x4 (&lo)[ND][2], s16x4 (&hi)[ND][2], int vb) {
#pragma unroll
    for (int ks = 0; ks < 2; ++ks)
#pragma unroll
        for (int d0 = 0; d0 < ND; ++d0) {
            asm volatile("ds_read_b64_tr_b16 %0,%1 offset:%c2" : "=&v"(lo[d0][ks]) : "v"(vb), "i"(d0 * 4096 + (KS0 + ks) * 1024) : "memory");
            asm volatile("ds_read_b64_tr_b16 %0,%1 offset:%c2" : "=&v"(hi[d0][ks]) : "v"(vb), "i"(d0 * 4096 + (KS0 + ks) * 1024 + 512) : "memory"); }
}
template <int ND> __device__ __forceinline__ void pv_half(f32x16* o, const s16x4 (&lo)[ND][2], const s16x4 (&hi)[ND][2], bf16x8 pa, bf16x8 pb) {
#define ATT_PK2(d, k) (bf16x8){lo[d][k][0], lo[d][k][1], lo[d][k][2], lo[d][k][3], hi[d][k][0], hi[d][k][1], hi[d][k][2], hi[d][k][3]}
#pragma unroll
    for (int d0 = 0; d0 < ND; ++d0) o[d0] = MFMA32(pa, ATT_PK2(d0, 0), o[d0]);
#pragma unroll
    for (int d0 = 0; d0 < ND; ++d0) o[d0] = MFMA32(pb, ATT_PK2(d0, 1), o[d0]);
#undef ATT_PK2
}
template <int MODE> __device__ __forceinline__ void p_half(f32x16& p, float& l_reg, u32x4& wa, u32x4& wb, bool const_bias, int dq, const ALAS float* tabL) {
    if (MODE == 0) {
#pragma unroll
        for (int r = 0; r < 16; ++r) p[r] = __builtin_amdgcn_exp2f(p[r]);
    } else if (const_bias) { const float cb = tabL[256];
#pragma unroll
        for (int r = 0; r < 16; ++r) p[r] = __builtin_amdgcn_exp2f(p[r] + cb);
    } else {
#pragma unroll
        for (int r = 0; r < 16; ++r) { int d = dq - ((r & 3) + 8 * (r >> 2)); d = d < -128 ? -128 : (d > 128 ? 128 : d); p[r] = __builtin_amdgcn_exp2f(p[r] + tabL[d + 128]); }
    }
    float s = 0.f;
#pragma unroll
    for (int r = 0; r < 16; ++r) s += p[r];
    l_reg += s;
    wa = (u32x4){cvtpk(p[0], p[1]), cvtpk(p[2], p[3]), cvtpk(p[4], p[5]), cvtpk(p[6], p[7])};
    wb = (u32x4){cvtpk(p[8], p[9]), cvtpk(p[10], p[11]), cvtpk(p[12], p[13]), cvtpk(p[14], p[15])};
}
__device__ __forceinline__ void vm_wait_n(int n) {
    if (n <= 0) asm volatile("s_waitcnt vmcnt(0)" ::: "memory"); else if (n == 1) asm volatile("s_waitcnt vmcnt(1)" ::: "memory"); else if (n == 2) asm volatile("s_waitcnt vmcnt(2)" ::: "memory");
    else if (n == 3) asm volatile("s_waitcnt vmcnt(3)" ::: "memory"); else if (n == 4) asm volatile("s_waitcnt vmcnt(4)" ::: "memory"); else if (n == 5) asm volatile("s_waitcnt vmcnt(5)" ::: "memory");
    else if (n == 6) asm volatile("s_waitcnt vmcnt(6)" ::: "memory"); else if (n == 7) asm volatile("s_waitcnt vmcnt(7)" ::: "memory"); else asm volatile("s_waitcnt vmcnt(8)" ::: "memory");
}
template <int MODE, int VD, bool OUT8 = false>
__device__ __forceinline__ void attn_unit_pp(ALAS char* shm, const bf16_t* Qb, const bf16_t* Kb, const bf16_t* Vb, void* Ob, int opitch, int q0, float mref2, const float* tab, float oscale = 1.f) {
    static_assert(MODE == 0 || MODE == 1, "ping-pong loop: softmax modes only");
    constexpr int ND = VD / 32, NV = VD / 64, PD = 3, NS = PD + 1, PER = 1 + NV;
    const int tid = threadIdx.x, lane = tid & 63, r32 = lane & 31, hi = lane >> 5; const int wid = __builtin_amdgcn_readfirstlane(tid >> 6); const int grp = wid >> 2;
    const unsigned lds0 = (unsigned)(uintptr_t)shm;
    ALAS float* wsf = (ALAS float*)(shm + L_WS) + wid * 64;
    ALAS float* tabL = (ALAS float*)(shm + L_TAB);
    if (MODE == 1) { for (int i = tid; i < 257; i += 512) tabL[i] = tab[i] * pg8::LOG2E; }
    const bf16_t* Qw = Qb + (size_t)(q0 + wid * 32) * PITCH;
    bf16x8 qr[4];
#pragma unroll
    for (int d0 = 0; d0 < 4; ++d0) qr[d0] = *(const bf16x8*)(Qw + (size_t)r32 * PITCH + d0 * 16 + hi * 8);
    int t_first, n_t;
    if (MODE == 0) { t_first = 0; n_t = q0 / 64 + 4; }
    else { const int c0 = q0 / 64; t_first = c0 - 8 > 0 ? c0 - 8 : 0; n_t = c0 + 4 - t_first; }
    const bf16_t* ksrc = Kb + (size_t)lane * PITCH + wid * 8 + (size_t)t_first * 64 * PITCH;
    const bf16_t* vsrc = Vb + (size_t)(16 * (wid & 3) + (lane >> 2)) * PITCH + (wid >> 2) * 32 + (lane & 3) * 8 + (size_t)t_first * 64 * PITCH;
    int issued = 0;
#define PP_DMA_K(i) do { if ((i) < n_t) { glds16(ksrc + (size_t)(i) * 64 * PITCH, (unsigned)__builtin_amdgcn_readfirstlane(lds0 + (unsigned)((i) % NS) * KVSLOT + wid * 1024)); issued += 1; } } while (0)
#define PP_DMA_V(i) do { if ((i) < n_t) { const unsigned sb_ = lds0 + (unsigned)((i) % NS) * KVSLOT + 8192; glds16(vsrc + (size_t)(i) * 64 * PITCH, (unsigned)__builtin_amdgcn_readfirstlane(sb_ + wid * 1024)); \
        if (VD == 128) glds16(vsrc + (size_t)(i) * 64 * PITCH + 64, (unsigned)__builtin_amdgcn_readfirstlane(sb_ + (wid + 8) * 1024)); issued += NV; } } while (0)
#define PP_NEED_K(j) vm_wait_n(issued - ((j) * PER + 1))
#define PP_NEED_V(j) vm_wait_n(issued - ((j) + 1) * PER)
#define PP_BAR() asm volatile("s_waitcnt lgkmcnt(0)\n\ts_barrier" ::: "memory")
    f32x16 o[ND];
#pragma unroll
    for (int d = 0; d < ND; ++d) o[d] = f32x16{};
    f32x16 cin;
#pragma unroll
    for (int r = 0; r < 16; ++r) cin[r] = -mref2;
    float l_reg = 0.f;
    const int wrow0 = q0 + wid * 32, qrow = wrow0 + r32, cw = wrow0 / 64;
    const int vb0 = (int)lds0 + 8192 + ((lane >> 4) & 1) * 32 + (lane & 3) * 8 + (4 * hi + ((lane & 15) >> 2)) * 64;
    asm volatile("s_waitcnt vmcnt(0)" ::: "memory"); asm volatile("" : "+v"(qr[0]), "+v"(qr[1]), "+v"(qr[2]), "+v"(qr[3]));
#pragma unroll
    for (int j = 0; j < PD; ++j) { PP_DMA_K(j); PP_DMA_V(j); }
    if (grp) PP_DMA_K(PD);
    PP_NEED_V(0);
    PP_BAR();
    if (grp) PP_BAR();
    u32x4 pw0, pw1, pw2, pw3; f32x16 p1;
    for (int i = 0; i < n_t; ++i) {
        const int t = t_first + i, slot = i % NS;
        bool active;
        if (MODE == 0) active = (t <= cw); else active = (t >= cw - 8) && (t <= cw);
        if (grp == 0) PP_DMA_K(i + PD); else PP_DMA_V(i + PD);
        if (active) {
            const lds_cptr kb = (lds_cptr)shm + slot * KVSLOT + hi * 1024 + r32 * 16;
            f32x16 p0; qkt8(p0, p1, kb, qr, cin);
            p_half<MODE>(p0, l_reg, pw0, pw1, t <= cw - 3, qrow - 64 * t - 4 * hi, tabL);
        }
        if (grp == 0) PP_NEED_V(i); else PP_NEED_K(i + 1);
        PP_BAR();
        if (grp == 0) PP_DMA_V(i + PD); else PP_DMA_K(i + 1 + PD);
        if (active) {
            const int vb = vb0 + slot * KVSLOT;
            s16x4 lo0[ND][2], hi0[ND][2], lo1[ND][2], hi1[ND][2];
            v_reads<ND, 0>(lo0, hi0, vb);
            asm volatile("s_waitcnt lgkmcnt(0)" ::: "memory");
            v_reads<ND, 2>(lo1, hi1, vb);
            __builtin_amdgcn_sched_barrier(0);
            pv_half<ND>(o, lo0, hi0, __builtin_bit_cast(bf16x8, pw0), __builtin_bit_cast(bf16x8, pw1));
            __builtin_amdgcn_sched_barrier(0);
            p_half<MODE>(p1, l_reg, pw2, pw3, t <= cw - 3, qrow - 64 * t - 4 * hi - 32, tabL);
            asm volatile("s_waitcnt lgkmcnt(0)" ::: "memory");
            __builtin_amdgcn_sched_barrier(0);
            pv_half<ND>(o, lo1, hi1, __builtin_bit_cast(bf16x8, pw2), __builtin_bit_cast(bf16x8, pw3));
        }
        if (grp == 0) PP_NEED_K(i + 1); else PP_NEED_V(i + 1);
        PP_BAR();
    }
    if (grp == 0) PP_BAR();
#undef PP_DMA_K
#undef PP_DMA_V
#undef PP_NEED_K
#undef PP_NEED_V
    float rl[16];
    l_reg += __shfl_xor(l_reg, 32);
    if (hi == 0) wsf[32 + r32] = l_reg;
    asm volatile("s_waitcnt lgkmcnt(0)" ::: "memory");
#pragma unroll
    for (int r = 0; r < 16; ++r) rl[r] = __builtin_amdgcn_rcpf(wsf[32 + crow(r, hi)]) * oscale;
    if constexpr (OUT8) {
        static_assert(!OUT8 || VD == 64, "fp8 output: 64-wide heads");
        unsigned char* Ow = (unsigned char*)Ob + (size_t)(q0 + wid * 32) * opitch;
        ALAS unsigned char* stg = (ALAS unsigned char*)(shm + L_OST) + wid * 2048;
#pragma unroll
        for (int r = 0; r < 16; ++r) { const int orow = crow(r, hi);
#pragma unroll
            for (int d0 = 0; d0 < 2; ++d0) { const float v = o[d0][r] * rl[r]; stg[orow * 64 + d0 * 32 + r32] = (unsigned char)(__builtin_amdgcn_cvt_pk_fp8_f32(v, v, 0, false) & 0xff); } }
        asm volatile("s_waitcnt lgkmcnt(0)" ::: "memory");
#pragma unroll
        for (int i = 0; i < 2; ++i) { const int row = i * 16 + (lane >> 2), ch = lane & 3; const u32x4 v = *(const ALAS u32x4*)(stg + row * 64 + ch * 16); *(u32x4*)(Ow + (size_t)row * opitch + ch * 16) = v; }
        asm volatile("s_waitcnt lgkmcnt(0)" ::: "memory");
    } else {
    bf16_t* Ow = (bf16_t*)Ob + (size_t)(q0 + wid * 32) * opitch;
    ALAS bf16_t* stg = (ALAS bf16_t*)(shm + L_OST) + wid * 2048;
#pragma unroll
    for (int half = 0; half < ND / 2; ++half) {
#pragma unroll
        for (int r = 0; r < 16; ++r) { const int orow = crow(r, hi);
#pragma unroll
            for (int d0 = 0; d0 < 2; ++d0) stg[orow * 64 + d0 * 32 + r32] = f2bf(o[half * 2 + d0][r] * rl[r]); }
        asm volatile("s_waitcnt lgkmcnt(0)" ::: "memory");
#pragma unroll
        for (int i = 0; i < 4; ++i) { const int row = i * 8 + (lane >> 3), ch = lane & 7; const u32x4 v = *(const ALAS u32x4*)(stg + row * 64 + ch * 8); *(u32x4*)(Ow + (size_t)row * opitch + half * 64 + ch * 8) = v; }
        asm volatile("s_waitcnt lgkmcnt(0)" ::: "memory");
    }
    }
    PP_BAR();
#undef PP_BAR
}
}

constexpr int NWAVES = 8, NTHR = NWAVES * 64;
constexpr int BATCH = 2, SEQ = 8192, T = BATCH * SEQ, D = 1024;
constexpr int NPROJ = 3072, FFD = 2816, FFE = 3584, NEXP = 8;
constexpr size_t MiB = 1u << 20;
constexpr size_t CTL_ZERO_BYTES = 1 * MiB;
constexpr int CW_TMO = 0, CW_BAR = 4096;
constexpr int CW_HIST = 16384;
constexpr int CW_QATT = 32768, CW_QCONV = 32768 + 64;
constexpr int CW_MOE = 24576;
constexpr size_t WS_SS0 = 1 * MiB, WS_SS3 = WS_SS0 + 65536, WS_ROPE = WS_SS3 + 65536  , WS_TOKSEL = WS_ROPE + MiB  ,
                 WS_TOKGATE = WS_TOKSEL + 65536  , WS_ROWTOK = WS_TOKGATE + 131072  , WS_ROWGATE = WS_ROWTOK + 147456  ;
static_assert(WS_ROWGATE + 147456 <= 4 * MiB, "small arrays");
constexpr size_t WS_XB = 4 * MiB;
constexpr size_t WS_AO = 36 * MiB;
constexpr size_t WS_ACT0 = 68 * MiB;
constexpr size_t WS_XF = 164 * MiB;
constexpr size_t WS_WIN = 228 * MiB, WS_WO0 = 234 * MiB, WS_WGU0 = 236 * MiB, WS_WD0 = 247 * MiB, WS_WQKV = 253 * MiB, WS_WO1 = 259 * MiB;
constexpr size_t WS_WEGU = 264 * MiB;
constexpr size_t WS_WED = 376 * MiB;
constexpr size_t WS_SS1 = 432 * MiB, WS_SS2 = 433 * MiB;
constexpr size_t WS_END = 434 * MiB;
constexpr size_t WS_SORTA = 36 * MiB;
constexpr size_t WS_ACTE = 108 * MiB;
static_assert(WS_SORTA + (size_t)36864 * 2048 <= WS_ACTE && WS_ACTE + (size_t)18432 * 7168 <= WS_WO0 && WS_WD0 + (size_t)1024 * 2816 * 2 <= WS_WQKV && WS_WO1 + 2 * MiB <= WS_WEGU, "ws map");
constexpr int RING_BYTES = 131072, MISC_OFF = RING_BYTES + 320, LDS_BYTES = 147456;
static_assert(att::L_END <= RING_BYTES, "attention LDS");

#define GAS __attribute__((address_space(1)))
#define LAS __attribute__((address_space(3)))
typedef unsigned short bf16;
typedef unsigned v4u __attribute__((ext_vector_type(4)));
typedef float f32x4 __attribute__((ext_vector_type(4)));
typedef GAS unsigned gu32;
#define RLX_AGENT __ATOMIC_RELAXED, __HIP_MEMORY_SCOPE_AGENT
#define LDS_WAIT() asm volatile("s_waitcnt lgkmcnt(0)" ::: "memory")
#define VM_WAIT() asm volatile("s_waitcnt vmcnt(0)" ::: "memory")
__device__ __forceinline__ unsigned f2bf(float f) { unsigned u = __builtin_bit_cast(unsigned, f); return (u + 0x7fffu + ((u >> 16) & 1u)) >> 16; }
__device__ __forceinline__ unsigned pk2(float lo, float hi) { return f2bf(lo) | (f2bf(hi) << 16); }
__device__ __forceinline__ float bf2f(unsigned short h) { return __builtin_bit_cast(float, (unsigned)h << 16); }
#define XB_TMO      128
#define XB_XCNT(j)  (256  + 64 * (j))
#define XB_XSUB(j)  (1280 + 64 * (j))
#define XB_XGEN(j)  (2304 + 64 * (j))
#define XB_TOP      3328
#define XB_TOPGEN   3392
#define XCD_BAR_WORDS 3456
#define XB_SPIN_CAP (1u << 18)

__device__ __forceinline__ unsigned xb_ld(unsigned* p)              { return __hip_atomic_load(p, __ATOMIC_RELAXED, __HIP_MEMORY_SCOPE_AGENT); }
__device__ __forceinline__ unsigned xb_add(unsigned* p, unsigned v) { return __hip_atomic_fetch_add(p, v, __ATOMIC_RELAXED, __HIP_MEMORY_SCOPE_AGENT); }
__device__ __forceinline__ unsigned xb_xcc_id() { return (unsigned)__builtin_amdgcn_s_getreg((3 << 11) | 20) & 0xFu; }
#define XB_SPIN(cond, bar) do { unsigned _sp = 0; while (cond) { __builtin_amdgcn_s_sleep(1); \
    if ((++_sp & 255u) == 0u) { if (xb_ld(&(bar)[XB_TMO])) break; if (_sp > XB_SPIN_CAP) { atomicAdd(&(bar)[XB_TMO], 1u); break; } } } } while (0)

struct XcdBarrier {
    unsigned* bar; unsigned x;
    volatile LAS unsigned* st;
};

__device__ __forceinline__ XcdBarrier xcd_barrier_post(unsigned* bar, volatile LAS unsigned* st) {
    XcdBarrier b; b.bar = bar; b.x = xb_xcc_id(); b.st = st;
    if (threadIdx.x == 0) (void)xb_add(&bar[XB_XCNT(b.x)], 1u);
    return b;
}
__device__ __forceinline__ void xcd_barrier_complete(unsigned* bar, unsigned x, unsigned& nloc, unsigned& nx) {
    const unsigned G = gridDim.x * gridDim.y * gridDim.z;
    unsigned sum, cnt, mine, sp = 0u;
    for (;;) {
        sum = 0u; cnt = 0u; mine = 0u;
#pragma unroll
        for (unsigned j = 0; j < 16; ++j) { const unsigned c = xb_ld(&bar[XB_XCNT(j)]); sum += c; cnt += (c > 0u) ? 1u : 0u; mine = (j == x) ? c : mine; }
        if (sum == G) break;
        __builtin_amdgcn_s_sleep(1);
        if ((++sp & 255u) == 0u) { if (xb_ld(&bar[XB_TMO])) break; if (sp > XB_SPIN_CAP) { atomicAdd(&bar[XB_TMO], 1u); break; } }
    }
    nloc = mine > 0u ? mine : 1u; nx = cnt > 0u ? cnt : 1u;
}

__device__ __forceinline__ void xcd_barrier(const XcdBarrier& b) {
    asm volatile("s_waitcnt vmcnt(0)" ::: "memory");
    __syncthreads();
    if (threadIdx.x == 0) {
        unsigned* bar = b.bar;
        __builtin_amdgcn_s_waitcnt(0);
        unsigned nloc = b.st[0], nx = b.st[1];
        if (nloc == 0u) { xcd_barrier_complete(bar, b.x, nloc, nx); b.st[0] = nloc; b.st[1] = nx; }
        const unsigned old = xb_add(&bar[XB_XSUB(b.x)], 1u);
        const unsigned gen = old / nloc;
        if (old + 1u == (gen + 1u) * nloc) {
            __builtin_amdgcn_fence(__ATOMIC_RELEASE, "agent");
            asm volatile("s_waitcnt vmcnt(0)" ::: "memory");
            const unsigned og = xb_add(&bar[XB_TOP], 1u);
            const unsigned tg = og / nx;
            if (og + 1u == (tg + 1u) * nx) xb_add(&bar[XB_TOPGEN], 1u);
            else XB_SPIN(xb_ld(&bar[XB_TOPGEN]) == tg, bar);
            __builtin_amdgcn_fence(__ATOMIC_ACQUIRE, "agent");
            xb_add(&bar[XB_XGEN(b.x)], 1u);
            asm volatile("s_waitcnt vmcnt(0)" ::: "memory");
        } else {
            XB_SPIN(xb_ld(&bar[XB_XGEN(b.x)]) == gen, bar);
            __builtin_amdgcn_fence(__ATOMIC_ACQUIRE, "agent");
            asm volatile("s_waitcnt vmcnt(0)" ::: "memory");
        }
    }
    __syncthreads();
}

__device__ __forceinline__ float wave_sum(float v) {
#pragma unroll
    for (int o = 1; o < 64; o <<= 1) v += __shfl_xor(v, o);
    return v;
}
__device__ __forceinline__ float wave_max(float v) {
#pragma unroll
    for (int o = 1; o < 64; o <<= 1) v = fmaxf(v, __shfl_xor(v, o));
    return v;
}
__device__ __forceinline__ int dest_block(int blk, int map) {
    if (map == 1) { const int s = blk & 7; return (blk & ~7) + 4 * (s & 1) + (s >> 1); }
    if (map == 2) return (blk >> 2) * 8 + (blk & 3);
    if (map == 3) return (blk >> 2) * 8 + 4 + (blk & 3);
    return blk;
}
__device__ __forceinline__ void tr_tile(const float* W, int K, int N, bf16* WT, int map, const float* gain, LAS unsigned* scr, int item, int lane) {
    const int nblk = N / 64, kb = item / nblk, nb = item % nblk, k0 = 64 * kb, n0 = 64 * nb;
    const int c = lane & 15, ip = lane >> 4;
#pragma unroll
    for (int it = 0; it < 8; ++it) { const int kp = it * 4 + ip, k = k0 + 2 * kp;
        f32x4 a = *(const GAS f32x4*)(W + (size_t)k * N + n0 + 4 * c), b = *(const GAS f32x4*)(W + (size_t)(k + 1) * N + n0 + 4 * c);
        if (gain) { a = a * gain[k]; b = b * gain[k + 1]; }
#pragma unroll
        for (int j = 0; j < 4; ++j) scr[(4 * c + j) * 33 + kp] = pk2(a[j], b[j]); }
    LDS_WAIT(); asm volatile("" ::: "memory");
#pragma unroll
    for (int it = 0; it < 8; ++it) { const int n = it * 8 + (lane >> 3), q = lane & 7;
        v4u o; o.x = scr[n * 33 + 4 * q]; o.y = scr[n * 33 + 4 * q + 1]; o.z = scr[n * 33 + 4 * q + 2]; o.w = scr[n * 33 + 4 * q + 3];
        const int drow = dest_block((n0 + n) >> 5, map) * 32 + (n & 31);
        *(GAS v4u*)(WT + (size_t)drow * K + k0 + 8 * q) = o; }
    LDS_WAIT(); asm volatile("" ::: "memory");
}

__device__ __forceinline__ void tr_tile8(const float* W, int K, int N, unsigned char* WT, int map, const float* gain, float wscale, LAS unsigned* scr, int item, int lane) {
    const int nblk = N / 64, kb = item / nblk, nb = item % nblk, k0 = 64 * kb, n0 = 64 * nb;
    const int c = lane & 15, ip = lane >> 4;
#pragma unroll
    for (int it = 0; it < 4; ++it) { const int k4 = it * 4 + ip, k = k0 + 4 * k4; f32x4 a[4];
#pragma unroll
        for (int i = 0; i < 4; ++i) a[i] = *(const GAS f32x4*)(W + (size_t)(k + i) * N + n0 + 4 * c) * ((gain ? gain[k + i] : 1.f) * wscale);
#pragma unroll
        for (int j = 0; j < 4; ++j) scr[(4 * c + j) * 17 + k4] = pg8::pk4_fp8(a[0][j], a[1][j], a[2][j], a[3][j]); }
    LDS_WAIT(); asm volatile("" ::: "memory");
#pragma unroll
    for (int it = 0; it < 4; ++it) { const int n = it * 16 + (lane >> 2), q = lane & 3;
        v4u o; o.x = scr[n * 17 + 4 * q]; o.y = scr[n * 17 + 4 * q + 1]; o.z = scr[n * 17 + 4 * q + 2]; o.w = scr[n * 17 + 4 * q + 3];
        const int drow = dest_block((n0 + n) >> 5, map) * 32 + (n & 31);
        *(GAS v4u*)(WT + (size_t)drow * K + k0 + 16 * q) = o; }
    LDS_WAIT(); asm volatile("" ::: "memory");
}

struct TrItem { const float* W; unsigned char* WT; const float* gain; int K, N, map, fp8, k0, n0; float scale; };
__device__ __forceinline__ void tr_load(const TrItem& d, f32x4 (&a)[16], float (&g)[16], int lane) {
    const int c = lane & 15, ip = lane >> 4;
#pragma unroll
    for (int it = 0; it < 4; ++it)
#pragma unroll
        for (int i = 0; i < 4; ++i) { const int k = d.k0 + 4 * (it * 4 + ip) + i;
            a[it * 4 + i] = *(const GAS f32x4*)(d.W + (size_t)k * d.N + d.n0 + 4 * c); g[it * 4 + i] = d.gain ? d.gain[k] : 1.f; }
}
__device__ __forceinline__ void tr_emit(const TrItem& d, const f32x4 (&a)[16], const float (&g)[16], LAS unsigned* scr, int lane) {
    const int c = lane & 15, ip = lane >> 4;
    if (d.fp8) {
#pragma unroll
        for (int it = 0; it < 4; ++it) { const int k4 = it * 4 + ip;
#pragma unroll
            for (int j = 0; j < 4; ++j) scr[(4 * c + j) * 17 + k4] = pg8::pk4_fp8(a[it * 4][j] * (g[it * 4] * d.scale), a[it * 4 + 1][j] * (g[it * 4 + 1] * d.scale), a[it * 4 + 2][j] * (g[it * 4 + 2] * d.scale), a[it * 4 + 3][j] * (g[it * 4 + 3] * d.scale)); }
        LDS_WAIT(); asm volatile("" ::: "memory");
#pragma unroll
        for (int it = 0; it < 4; ++it) { const int n = it * 16 + (lane >> 2), q = lane & 3;
            v4u o; o.x = scr[n * 17 + 4 * q]; o.y = scr[n * 17 + 4 * q + 1]; o.z = scr[n * 17 + 4 * q + 2]; o.w = scr[n * 17 + 4 * q + 3];
            const int drow = dest_block((d.n0 + n) >> 5, d.map) * 32 + (n & 31);
            *(GAS v4u*)(d.WT + (size_t)drow * d.K + d.k0 + 16 * q) = o; }
    } else {
#pragma unroll
        for (int it = 0; it < 4; ++it) { const int k4 = it * 4 + ip;
#pragma unroll
            for (int j = 0; j < 4; ++j) { scr[(4 * c + j) * 33 + 2 * k4] = pk2(a[it * 4][j] * g[it * 4], a[it * 4 + 1][j] * g[it * 4 + 1]); scr[(4 * c + j) * 33 + 2 * k4 + 1] = pk2(a[it * 4 + 2][j] * g[it * 4 + 2], a[it * 4 + 3][j] * g[it * 4 + 3]); } }
        LDS_WAIT(); asm volatile("" ::: "memory");
#pragma unroll
        for (int it = 0; it < 8; ++it) { const int n = it * 8 + (lane >> 3), q = lane & 7;
            v4u o; o.x = scr[n * 33 + 4 * q]; o.y = scr[n * 33 + 4 * q + 1]; o.z = scr[n * 33 + 4 * q + 2]; o.w = scr[n * 33 + 4 * q + 3];
            const int drow = dest_block((d.n0 + n) >> 5, d.map) * 32 + (n & 31);
            *(GAS v4u*)(d.WT + ((size_t)drow * d.K + d.k0 + 8 * q) * 2) = o; }
    }
    LDS_WAIT(); asm volatile("" ::: "memory");
}
constexpr float AO8_SCALE = 16.f;
constexpr float W8_SCALE = 64.f;

#ifndef PROBE_MASK
#define PROBE_MASK 0
#endif
struct KArgs { const void* in[27]; float* out; unsigned char* ws; int ph_lo, ph_hi, flags, pad; };

__global__ void __launch_bounds__(NTHR, 2) fwd_kernel(KArgs args) {
    extern __shared__ __attribute__((aligned(16))) unsigned char lds_raw[];
    LAS unsigned char* lds = (LAS unsigned char*)lds_raw;
    volatile LAS unsigned* MISC = (volatile LAS unsigned*)(lds + MISC_OFF);
    const int tid = threadIdx.x, lane = tid & 63, wave = __builtin_amdgcn_readfirstlane(tid >> 6);
    const int G = gridDim.x; const int bx = blockIdx.x; const int vcu = (G % 8 == 0) ? (bx % 8) * (G / 8) + bx / 8 : bx;
    unsigned char* ws = args.ws;
    unsigned* ctl = (unsigned*)ws;
    for (int u = tid; u < (LDS_BYTES - RING_BYTES) / 4; u += NTHR) ((LAS unsigned*)(lds + RING_BYTES))[u] = 0u;
    __syncthreads();
    XcdBarrier bar = xcd_barrier_post(ctl + CW_BAR, MISC + 8);
    const int lo = args.ph_lo, hi_ph = args.ph_hi;
#define IN(k) (lo <= (k) && (k) < hi_ph)
#define REP(k)
#define SEAM(k) do { if (IN(k) && IN((k) + 1)) xcd_barrier(bar); } while (0)
    const float* x_in = (const float*)args.in[0]; const int* positions = (const int*)args.in[1];
    const float* ev_attn_norm = (const float*)args.in[2]; const float* ev_w_in = (const float*)args.in[3];
    const float* ev_q_norm = (const float*)args.in[4]; const float* ev_k_norm = (const float*)args.in[5];
    const float* ev_lq1 = (const float*)args.in[6]; const float* ev_lk1 = (const float*)args.in[7]; const float* ev_lq2 = (const float*)args.in[8]; const float* ev_lk2 = (const float*)args.in[9];
    const float* ev_subln = (const float*)args.in[10]; const float* ev_w_out = (const float*)args.in[11]; const float* ev_ffn_norm = (const float*)args.in[12];
    const float* ev_w_gate = (const float*)args.in[13]; const float* ev_w_up = (const float*)args.in[14]; const float* ev_w_down = (const float*)args.in[15];
    const float* od_attn_norm = (const float*)args.in[16]; const float* od_w_qkv = (const float*)args.in[17];
    const float* od_q_norm = (const float*)args.in[18]; const float* od_k_norm = (const float*)args.in[19]; const float* od_rel_bias = (const float*)args.in[20];
    const float* od_w_out = (const float*)args.in[21]; const float* od_ffn_norm = (const float*)args.in[22]; const float* od_router = (const float*)args.in[23];
    const float* od_we_gate = (const float*)args.in[24]; const float* od_we_up = (const float*)args.in[25]; const float* od_we_down = (const float*)args.in[26];
    float* out = args.out;
    float* ss0 = (float*)(ws + WS_SS0); float* ss1 = (float*)(ws + WS_SS1); float* ss2 = (float*)(ws + WS_SS2); float* ss3 = (float*)(ws + WS_SS3);
    float* rope = (float*)(ws + WS_ROPE); unsigned* toksel = (unsigned*)(ws + WS_TOKSEL); float* tokgate = (float*)(ws + WS_TOKGATE);
    int* rowtok = (int*)(ws + WS_ROWTOK); float* rowgate = (float*)(ws + WS_ROWGATE);
    bf16* XB = (bf16*)(ws + WS_XB); bf16* AO = (bf16*)(ws + WS_AO); bf16* ACT0 = (bf16*)(ws + WS_ACT0); float* XF = (float*)(ws + WS_XF); bf16* OD = (bf16*)(ws + WS_XF);
    bf16* Win_t = (bf16*)(ws + WS_WIN); bf16* Wo0_t = (bf16*)(ws + WS_WO0); bf16* Wgu0_t = (bf16*)(ws + WS_WGU0); bf16* Wd0_t = (bf16*)(ws + WS_WD0);
    unsigned char* Wqkv8 = ws + WS_WQKV; unsigned char* Wo18 = ws + WS_WO1; unsigned char* XB8 = ws + WS_XB; unsigned char* AO8 = ws + WS_AO; unsigned char* WEgu8 = ws + WS_WEGU; unsigned char* WEd8 = ws + WS_WED;
    unsigned char* SORTA8 = ws + WS_SORTA; unsigned char* ACTE8 = ws + WS_ACTE;
    const int gw = vcu * NWAVES + wave, NGW = G * NWAVES;

    constexpr int I_IN = 16 * 48, I_O = 16 * 16, I_G = 16 * 44, I_D = 44 * 16, I_EG = 16 * 56, I_ED = 56 * 16;
    constexpr int NSMALL = I_IN + I_O + 2 * I_G + I_D + I_IN + I_O, NITEMS = NSMALL + 24 * I_EG;
        auto decode = [&](int it) -> TrItem {
        TrItem d; int r = it; d.scale = 1.f; d.fp8 = 0; d.gain = nullptr; d.map = 0;
        auto fin = [&](int nbl) { d.k0 = 64 * (r / nbl); d.n0 = 64 * (r % nbl); };
        if (r < I_IN) { d.W = ev_w_in; d.K = D; d.N = NPROJ; d.WT = (unsigned char*)Win_t; d.map = 1; d.gain = ev_attn_norm; fin(NPROJ / 64); return d; } r -= I_IN;
        if (r < I_O) { d.W = ev_w_out; d.K = D; d.N = D; d.WT = (unsigned char*)Wo0_t; fin(D / 64); return d; } r -= I_O;
        if (r < I_G) { d.W = ev_w_gate; d.K = D; d.N = FFD; d.WT = (unsigned char*)Wgu0_t; d.map = 2; d.gain = ev_ffn_norm; fin(FFD / 64); return d; } r -= I_G;
        if (r < I_G) { d.W = ev_w_up; d.K = D; d.N = FFD; d.WT = (unsigned char*)Wgu0_t; d.map = 3; d.gain = ev_ffn_norm; fin(FFD / 64); return d; } r -= I_G;
        if (r < I_D) { d.W = ev_w_down; d.K = FFD; d.N = D; d.WT = (unsigned char*)Wd0_t; fin(D / 64); return d; } r -= I_D;
        d.fp8 = 1; d.scale = W8_SCALE;
        if (r < I_IN) { d.W = od_w_qkv; d.K = D; d.N = NPROJ; d.WT = Wqkv8; d.map = 1; d.gain = od_attn_norm; fin(NPROJ / 64); return d; } r -= I_IN;
        if (r < I_O) { d.W = od_w_out; d.K = D; d.N = D; d.WT = Wo18; fin(D / 64); return d; } r -= I_O;
        const int which = r / (8 * I_EG), rr = r % (8 * I_EG), e2 = rr / I_EG; r = rr % I_EG;
        if (which == 0) { d.W = od_we_gate + (size_t)e2 * D * FFE; d.K = D; d.N = FFE; d.WT = WEgu8 + (size_t)e2 * 2 * FFE * D; d.map = 2; d.gain = od_ffn_norm; fin(FFE / 64); }
        else if (which == 1) { d.W = od_we_up + (size_t)e2 * D * FFE; d.K = D; d.N = FFE; d.WT = WEgu8 + (size_t)e2 * 2 * FFE * D; d.map = 3; d.gain = od_ffn_norm; fin(FFE / 64); }
        else { d.W = od_we_down + (size_t)e2 * FFE * D; d.K = FFE; d.N = D; d.WT = WEd8 + (size_t)e2 * D * FFE; fin(D / 64); }
        return d; };
    auto conv_range = [&](int first, int end, int stride) {
        LAS unsigned* scr = (LAS unsigned*)(lds + wave * 8704);
        f32x4 bufA[16], bufB[16]; float gA[16], gB[16]; TrItem dA, dB; int it = first;
        if (it < end) { dA = decode(it); tr_load(dA, bufA, gA, lane); }
        while (it < end) {
            const int it2 = it + stride, it3 = it2 + stride;
            if (it2 < end) { dB = decode(it2); tr_load(dB, bufB, gB, lane); }
            tr_emit(dA, bufA, gA, scr, lane);
            if (it3 < end) { dA = decode(it3); tr_load(dA, bufA, gA, lane); }
            if (it2 < end) tr_emit(dB, bufB, gB, scr, lane);
            it = it3; } };
    auto pull = [&](int qword) -> int {
        __syncthreads(); if (tid == 0) MISC[16] = __hip_atomic_fetch_add(ctl + qword, 1u, __ATOMIC_RELAXED, __HIP_MEMORY_SCOPE_AGENT); __syncthreads();
        return __builtin_amdgcn_readfirstlane((int)MISC[16]); };

    REP(0) if (IN(0)) {
        conv_range(gw, I_IN, NGW);
        for (int m = gw; m < T; m += NGW) {
            const GAS f32x4* xr = (const GAS f32x4*)(x_in + (size_t)m * D) + lane; f32x4 v[4]; float s = 0.f;
#pragma unroll
            for (int j = 0; j < 4; ++j) { v[j] = xr[64 * j]; s += (v[j].x * v[j].x + v[j].y * v[j].y) + (v[j].z * v[j].z + v[j].w * v[j].w); }
            s = wave_sum(s); if (lane == 0) ss0[m] = s;
            GAS unsigned long long* o8 = (GAS unsigned long long*)(XB + (size_t)m * D) + lane;
#pragma unroll
            for (int j = 0; j < 4; ++j) o8[64 * j] = (unsigned long long)pk2(v[j].x, v[j].y) | ((unsigned long long)pk2(v[j].z, v[j].w) << 32);
        }
        for (int i = vcu * NTHR + tid; i < T * 8; i += G * NTHR) {
            const int tok = i >> 3, f = i & 7;
            const double inv = exp2(-(double)f * (18.931568569324174 / 8.0));
            double ang = (double)positions[tok] * inv; ang -= 6.283185307179586 * rint(ang * 0.15915494309189535);
            float sn, cs; sincosf((float)ang, &sn, &cs);
            rope[(size_t)tok * 16 + f] = cs; rope[(size_t)tok * 16 + 8 + f] = sn;
        }
    }
    SEAM(0);

    REP(1) if (IN(1)) {
        pg8::Gemm g{XB, Win_t, T, NPROJ, D}; pg8::StaticOrder S; S.init(T, NPROJ, G, bx);
        pg8::EpiProj E{ACT0, NPROJ, ss0, 1, ev_q_norm, ev_k_norm, rope, 0, 1.f};
        pg8::gemm_phase<pg8::EpiProj, pg8::StaticOrder, true, true>(lds, g, S, E);
    }
    SEAM(1);

    REP(2) if (IN(2)) {
        const float gqm = wave_max(fabsf(ev_q_norm[lane])), gkm = wave_max(fabsf(ev_k_norm[lane]));
        const float mref = 8.f * gqm * gkm * pg8::LOG2E;
        constexpr int NJOBS = (NITEMS - I_IN + 63) / 64;
        const bool conv_first = ((bx >> 3) & 3) == 3;
#define P2_CONV_LOOP() for (;;) { const int j = pull(CW_QCONV); if (j >= NJOBS) break; \
            const int first = I_IN + j * 64 + wave * 8; conv_range(first, (first + 8 < NITEMS) ? first + 8 : NITEMS, 1); }
        if (conv_first) P2_CONV_LOOP()
        for (;;) { const int idx = pull(CW_QATT); if (idx >= 1024) break;
            if (idx < 512) { if (args.flags & 1) continue;
                const int bhm = idx & 15, qb = 31 - (idx >> 4);
                const int b = bhm >> 3, hm = bhm & 7, h = hm >> 1;
                const bf16* base = ACT0 + (size_t)b * SEQ * NPROJ;
                att::attn_unit_pp<0, 128>((LAS char*)lds, base + 1536 + hm * 64, base + 2048 + hm * 64, base + 2560 + h * 128, OD + (size_t)b * SEQ * D + hm * 128, D, qb * 256, mref, nullptr);
            } else { if (args.flags & 2) continue;
                const int bh = idx & 15, qb = 31 - ((idx - 512) >> 4);
                const int b = bh >> 3, h = bh & 7;
                const bf16* base = ACT0 + (size_t)b * SEQ * NPROJ;
                att::attn_unit<2, 64>((LAS char*)lds, base + h * 64, base + 512 + h * 64, base + 1024 + h * 64, AO + (size_t)b * SEQ * D + h * 64, D, qb * 256, 0.f, nullptr);
            }
        }
        P2_CONV_LOOP()
#undef P2_CONV_LOOP
    }
    SEAM(2);

    REP(3) if (IN(3)) {
        const float a1 = wave_sum(ev_lq1[lane] * ev_lk1[lane]), a2 = wave_sum(ev_lq2[lane] * ev_lk2[lane]);
        const float lam_init = 0.2f, lam = expf(a1) - expf(a2) + lam_init;
        const int h = lane >> 4, v0 = (lane & 15) * 8;
        float sg[8];
#pragma unroll
        for (int j = 0; j < 8; ++j) sg[j] = ev_subln[v0 + j] * (1.f - lam_init);
        for (int m = gw; m < T; m += NGW) {
            const v4u a = *(const GAS v4u*)(OD + (size_t)m * D + (2 * h) * 128 + v0), b = *(const GAS v4u*)(OD + (size_t)m * D + (2 * h + 1) * 128 + v0);
            float d[8]; float s = 0.f;
#pragma unroll
            for (int j = 0; j < 4; ++j) { const unsigned ua = a[j], ub = b[j];
                d[2 * j] = bf2f((unsigned short)(ua & 0xffffu)) - lam * bf2f((unsigned short)(ub & 0xffffu));
                d[2 * j + 1] = bf2f((unsigned short)(ua >> 16)) - lam * bf2f((unsigned short)(ub >> 16));
                s += d[2 * j] * d[2 * j] + d[2 * j + 1] * d[2 * j + 1]; }
            s += __shfl_xor(s, 1); s += __shfl_xor(s, 2); s += __shfl_xor(s, 4); s += __shfl_xor(s, 8);
            const float rs = rsqrtf(s * (1.f / 128.f) + pg8::RMS_EPS);
            v4u o; o.x = pk2(d[0] * rs * sg[0], d[1] * rs * sg[1]); o.y = pk2(d[2] * rs * sg[2], d[3] * rs * sg[3]); o.z = pk2(d[4] * rs * sg[4], d[5] * rs * sg[5]); o.w = pk2(d[6] * rs * sg[6], d[7] * rs * sg[7]);
            *(GAS v4u*)(AO + (size_t)m * D + 512 + h * 128 + v0) = o;
        }
    }
    SEAM(3);

    REP(4) if (IN(4)) {
        pg8::Gemm g{AO, Wo0_t, T, D, D}; pg8::StaticOrder S; S.init(T, D, G, bx);
        pg8::EpiResid E{x_in, XF, XB, ss1, 1.f, nullptr};
        pg8::gemm_phase<pg8::EpiResid, pg8::StaticOrder, false, true>(lds, g, S, E);
    }
    SEAM(4);

    REP(5) if (IN(5)) {
        pg8::Gemm g{XB, Wgu0_t, T, 2 * FFD, D}; pg8::StaticOrder S; S.init(T, 2 * FFD, G, bx);
        pg8::EpiSwiglu<false> E{ACT0, FFD, ss1, 16, nullptr, 0, 2 * FFD / 256, 1.f};
        pg8::gemm_phase<pg8::EpiSwiglu<false>, pg8::StaticOrder, true, true>(lds, g, S, E);
    }
    SEAM(5);

    if (IN(6)) {
        pg8::Gemm g{ACT0, Wd0_t, T, D, FFD}; pg8::StaticOrder S; S.init(T, D, G, bx);
        pg8::EpiResid E{XF, XF, nullptr, ss2, 1.f, XB8};
        pg8::gemm_phase<pg8::EpiResid, pg8::StaticOrder, false, true>(lds, g, S, E);
    }
    SEAM(6);

    REP(7) if (IN(7)) {
        pg8::Gemm g{(const bf16*)XB8, (const bf16*)Wqkv8, T, NPROJ, D / 2}; pg8::StaticOrder S; S.init(T, NPROJ, G, bx);
        pg8::EpiProj E{ACT0, NPROJ, ss2, 16, od_q_norm, od_k_norm, nullptr, 1, 1.f / W8_SCALE};
        pg8::gemm_phase<pg8::EpiProj, pg8::StaticOrder, true, true, true>(lds, g, S, E);
    }
    SEAM(7);

    REP(8) if (IN(8)) {
        const float gqm = wave_max(fabsf(od_q_norm[lane])), gkm = wave_max(fabsf(od_k_norm[lane]));
        for (int L = vcu; L < 1024; L += G) {
            const int bh = (L & 255) >> 3, qb = 4 * (L & 7) + (L >> 8);
            const int b = bh >> 4, h = bh & 15;
            const float* tab = od_rel_bias + h * 257;
            float tm = fabsf(tab[lane]); tm = fmaxf(tm, fabsf(tab[64 + lane])); tm = fmaxf(tm, fabsf(tab[128 + lane])); tm = fmaxf(tm, fabsf(tab[192 + lane])); tm = fmaxf(tm, fabsf(tab[256]));
            tm = wave_max(tm);
            const float mref = (8.f * gqm * gkm + tm) * pg8::LOG2E;
            const bf16* base = ACT0 + (size_t)b * SEQ * NPROJ;
            att::attn_unit_pp<1, 64, true>((LAS char*)lds, base + h * 64, base + 1024 + h * 64, base + 2048 + h * 64, AO8 + (size_t)b * SEQ * D + h * 64, D, qb * 256, mref, tab, AO8_SCALE);
        }
    }
    SEAM(8);

    REP(9) if (IN(9)) {
        pg8::Gemm g{(const bf16*)AO8, (const bf16*)Wo18, T, D, D / 2}; pg8::StaticOrder S; S.init(T, D, G, bx);
        pg8::EpiResid E{XF, out, nullptr, nullptr, 1.f / (W8_SCALE * AO8_SCALE), nullptr};
        pg8::gemm_phase<pg8::EpiResid, pg8::StaticOrder, false, true, true>(lds, g, S, E);
    }
    SEAM(9);

    REP(10) if (IN(10)) {
        LAS float* wrT = (LAS float*)lds;
        LAS unsigned* sel = (LAS unsigned*)(lds + 32768);
        for (int i = tid; i < 1024; i += NTHR) { const float gn = od_ffn_norm[i]; const f32x4 w0 = *(const GAS f32x4*)(od_router + (size_t)i * 8), w1 = *(const GAS f32x4*)(od_router + (size_t)i * 8 + 4);
            wrT[i] = w0.x * gn; wrT[1024 + i] = w0.y * gn; wrT[2048 + i] = w0.z * gn; wrT[3072 + i] = w0.w * gn; wrT[4096 + i] = w1.x * gn; wrT[5120 + i] = w1.y * gn; wrT[6144 + i] = w1.z * gn; wrT[7168 + i] = w1.w * gn; }
        __syncthreads();
        for (int blk = vcu; blk < T / 64; blk += G) {
#pragma unroll 1
            for (int q4 = 0; q4 < 2; ++q4) {
                const int tok0 = blk * 64 + wave * 8 + q4 * 4;
                f32x4 xv[4][4]; float s[4]; float lg[4][8];
#pragma unroll
                for (int t4 = 0; t4 < 4; ++t4) { const GAS f32x4* xr = (const GAS f32x4*)(out + (size_t)(tok0 + t4) * D) + lane;
#pragma unroll
                    for (int j = 0; j < 4; ++j) xv[t4][j] = xr[64 * j]; }
#pragma unroll
                for (int t4 = 0; t4 < 4; ++t4) { s[t4] = 0.f;
#pragma unroll
                    for (int e2 = 0; e2 < 8; ++e2) lg[t4][e2] = 0.f;
#pragma unroll
                    for (int j = 0; j < 4; ++j) { const f32x4 v = xv[t4][j]; s[t4] += (v.x * v.x + v.y * v.y) + (v.z * v.z + v.w * v.w); } }
#pragma unroll
                for (int j = 0; j < 4; ++j)
#pragma unroll
                    for (int e2 = 0; e2 < 8; ++e2) { const f32x4 w = *(const LAS f32x4*)(wrT + e2 * 1024 + 256 * j + 4 * lane);
#pragma unroll
                        for (int t4 = 0; t4 < 4; ++t4) { const f32x4 v = xv[t4][j]; lg[t4][e2] += (v.x * w.x + v.y * w.y) + (v.z * w.z + v.w * w.w); } }
#pragma unroll
                for (int t4 = 0; t4 < 4; ++t4) { s[t4] = wave_sum(s[t4]);
#pragma unroll
                    for (int e2 = 0; e2 < 8; ++e2) lg[t4][e2] = wave_sum(lg[t4][e2]); }
                if (lane == 0) {
#pragma unroll
                    for (int t4 = 0; t4 < 4; ++t4) { const int tok = tok0 + t4;
                        const float r = rsqrtf(s[t4] * (1.f / 1024.f) + pg8::RMS_EPS); ss3[tok] = s[t4];
                        int e0 = 0; float v0 = lg[t4][0];
#pragma unroll
                        for (int e2 = 1; e2 < 8; ++e2) if (lg[t4][e2] > v0) { v0 = lg[t4][e2]; e0 = e2; }
                        int e1 = -1; float v1 = 0.f;
#pragma unroll
                        for (int e2 = 0; e2 < 8; ++e2) if (e2 != e0 && (e1 < 0 || lg[t4][e2] > v1)) { v1 = lg[t4][e2]; e1 = e2; }
                        const float ex = expf((v1 - v0) * r), g0 = 1.f / (1.f + ex), g1 = ex / (1.f + ex);
                        sel[wave * 8 + q4 * 4 + t4] = (unsigned)e0 | ((unsigned)e1 << 8); tokgate[2 * tok] = g0; tokgate[2 * tok + 1] = g1; }
                }
            }
            __syncthreads();
            if (wave == 0) { const unsigned sv = sel[lane]; const int e0 = sv & 0xff, e1 = sv >> 8; unsigned rank0 = 0, rank1 = 0;
                const unsigned long long lt = (1ull << lane) - 1ull;
#pragma unroll
                for (int e = 0; e < 8; ++e) { const unsigned long long m0 = __ballot(e0 == e), m1 = __ballot(e1 == e);
                    if (e0 == e) rank0 = __popcll(m0 & lt); if (e1 == e) rank1 = __popcll(m1 & lt);
                    if (lane == 0) { ctl[CW_HIST + blk * 16 + e] = __popcll(m0); ctl[CW_HIST + blk * 16 + 8 + e] = __popcll(m1); } }
                toksel[blk * 64 + lane] = sv | (rank0 << 16) | (rank1 << 24); }
            __syncthreads();
        }
    }
    SEAM(10);

    REP(11) if (IN(11)) {
        LAS unsigned* hs = (LAS unsigned*)lds;
        for (int i = tid; i < 4096; i += NTHR) hs[i] = ctl[CW_HIST + i];
        __syncthreads();
        if (tid < 16) hs[4096 + tid] = 0u;
        __syncthreads();
        { unsigned s = 0; const int g2 = tid & 15;
#pragma unroll
          for (int b2 = tid >> 4; b2 < 256; b2 += 32) s += hs[b2 * 16 + g2];
          atomicAdd((unsigned*)&hs[4096 + g2], s); }
        __syncthreads();
        if (tid == 0) { unsigned acc = 0; for (int g2 = 0; g2 < 16; ++g2) { hs[4128 + g2] = acc; acc += (hs[4096 + g2] + 255u) & ~255u; } hs[4128 + 16] = acc; }
        __syncthreads();
        if (bx == 0) {
            if (tid == 0) { ctl[CW_MOE] = hs[4128 + 8] >> 8; ctl[CW_MOE + 1] = hs[4128 + 16] >> 8; }
            if (tid < 16) { const unsigned t0 = hs[4128 + tid] >> 8, t1 = hs[4128 + tid + 1] >> 8; for (unsigned t = t0; t < t1; ++t) ctl[CW_MOE + 16 + t] = tid & 7; }
        }
        for (int blk = vcu; blk < T / 64; blk += G) {
            if (tid < 16) hs[4160 + tid] = 0u;
            __syncthreads();
            { unsigned s = 0; const int g2 = tid & 15;
#pragma unroll
              for (int b2 = tid >> 4; b2 < 256; b2 += 32) s += (b2 < blk) ? hs[b2 * 16 + g2] : 0u;
              atomicAdd((unsigned*)&hs[4160 + g2], s); }
            __syncthreads();
            for (int tl = wave; tl < 64; tl += NWAVES) {
                const int tok = blk * 64 + tl; const unsigned sv = toksel[tok];
                const GAS f32x4* xr = (const GAS f32x4*)(out + (size_t)tok * D + 16 * lane); const f32x4 v0 = xr[0], v1 = xr[1], v2 = xr[2], v3 = xr[3];
                v4u pk; pk.x = pg8::pk4_fp8(v0[0], v0[1], v0[2], v0[3]); pk.y = pg8::pk4_fp8(v1[0], v1[1], v1[2], v1[3]); pk.z = pg8::pk4_fp8(v2[0], v2[1], v2[2], v2[3]); pk.w = pg8::pk4_fp8(v3[0], v3[1], v3[2], v3[3]);
#pragma unroll
                for (int sl = 0; sl < 2; ++sl) { const int e = (sv >> (8 * sl)) & 0xff, rank = (sv >> (16 + 8 * sl)) & 0xff, g2 = sl * 8 + e;
                    const unsigned srow = hs[4128 + g2] + hs[4160 + g2] + rank;
                    *(GAS v4u*)(SORTA8 + (size_t)srow * D + lane * 16) = pk;
                    if (lane == 0) { rowtok[srow] = tok; rowgate[srow] = tokgate[2 * tok + sl]; } }
            }
            __syncthreads();
        }
        for (int g2 = vcu; g2 < 16; g2 += G) {
            const unsigned r0 = hs[4128 + g2] + hs[4096 + g2], r1 = hs[4128 + g2 + 1];
            for (unsigned r = r0 + wave; r < r1; r += NWAVES) { if (lane == 0) { rowtok[r] = -1; rowgate[r] = 0.f; }
                *(GAS v4u*)(SORTA8 + (size_t)r * D + lane * 16) = (v4u){0u, 0u, 0u, 0u}; }
        }
    }
    SEAM(11);

    if (IN(12) || IN(13) || IN(14)) {
        const int nA = (int)__builtin_amdgcn_readfirstlane(ctl[CW_MOE]), nT = (int)__builtin_amdgcn_readfirstlane(ctl[CW_MOE + 1]), nB = nT - nA;
        const int* texp = (const int*)(ctl + CW_MOE + 16);
        unsigned char* ACTE8B = ACTE8 + (size_t)63 * MiB;
        if (IN(12)) {
            pg8::Gemm g{(const bf16*)SORTA8, (const bf16*)WEgu8, 0, 0, D / 2}; pg8::MoeOrder S; S.init(nA, 2 * FFE / 256, G, bx, 0, texp);
            pg8::EpiSwiglu<true> E{ACTE8, FFE, ss3, 1, rowtok, 0, 2 * FFE / 256, 1.f / W8_SCALE};
            pg8::gemm_phase<pg8::EpiSwiglu<true>, pg8::MoeOrder, true, true, true>(lds, g, S, E);
        }
        SEAM(12);
        if (IN(13)) {
            { pg8::Gemm g{(const bf16*)ACTE8, (const bf16*)WEd8, 0, 0, FFE / 2}; pg8::MoeOrder S; S.init(nA, D / 256, G, bx, 0, texp);
              pg8::EpiMoeDown E{out, rowtok, rowgate, 0, 1.f / W8_SCALE, (args.flags >> 2) & 1};
              pg8::gemm_phase<pg8::EpiMoeDown, pg8::MoeOrder, true, true, true>(lds, g, S, E); }
            { const int nd = nA * (D / 256), nu = nB * (2 * FFE / 256); int H = nd - G; int R = 0;
              if (H > 0 && H < G / 2) { const int rmax = (nu + (G - H) - 1) / (G - H); int best = 0x7fffffff;
                  for (int r2 = 0; r2 <= rmax; ++r2) { const int rest = nu - r2 * (G - H) > 0 ? nu - r2 * (G - H) : 0; const int light = 28 + 8 * r2, heavy = 56 + 8 * ((rest + H - 1) / H); const int mk = light > heavy ? light : heavy; if (mk < best) { best = mk; R = r2; } } } else H = 0;
              pg8::Gemm g{(const bf16*)(SORTA8 + (size_t)nA * 256 * D), (const bf16*)WEgu8, 0, 0, D / 2}; pg8::MoeOrder S; S.init(nB, 2 * FFE / 256, G, bx, nA, texp, H, R);
              pg8::EpiSwiglu<true> E{ACTE8B, FFE, ss3, 1, rowtok, nA, 2 * FFE / 256, 1.f / W8_SCALE};
              pg8::gemm_phase<pg8::EpiSwiglu<true>, pg8::MoeOrder, true, true, true>(lds, g, S, E); }
        }
        SEAM(13);
        if (IN(14)) {
            pg8::Gemm g{(const bf16*)ACTE8B, (const bf16*)WEd8, 0, 0, FFE / 2}; pg8::MoeOrder S; S.init(nB, D / 256, G, bx, nA, texp);
            pg8::EpiMoeDown E{out, rowtok, rowgate, nA, 1.f / W8_SCALE, (args.flags >> 2) & 1};
            pg8::gemm_phase<pg8::EpiMoeDown, pg8::MoeOrder, true, true, true>(lds, g, S, E);
        }
    }
#undef IN
#undef SEAM
}

constexpr int N_PHASES = 15;
extern "C" void kernel_launch(void* const* d_in, const int* in_sizes, int n_in, void* d_out, int out_size, void* d_ws, size_t ws_size, hipStream_t stream) {
    static int grid = 0;
    if (grid == 0) {
        if (n_in != 27 || out_size != T * D || ws_size < WS_END) { fprintf(stderr, "kernel_launch: unexpected problem (n_in %d, out %d, ws %zu)\n", n_in, out_size, ws_size); grid = -1; return; }
        int dev = 0, cus = 0, per_cu = 0;
        if (hipGetDevice(&dev) != hipSuccess || hipDeviceGetAttribute(&cus, hipDeviceAttributeMultiprocessorCount, dev) != hipSuccess) { grid = -1; return; }
        if (hipFuncSetAttribute((const void*)fwd_kernel, hipFuncAttributeMaxDynamicSharedMemorySize, LDS_BYTES) != hipSuccess) { fprintf(stderr, "kernel_launch: hipFuncSetAttribute failed\n"); grid = -1; return; }
        if (hipOccupancyMaxActiveBlocksPerMultiprocessor(&per_cu, (const void*)fwd_kernel, NTHR, LDS_BYTES) != hipSuccess || per_cu < 1) { fprintf(stderr, "kernel_launch: occupancy query says %d\n", per_cu); }
        (void)hipGetLastError();
        grid = cus;
    }
    if (grid < 0) return;
    (void)hipMemsetAsync(d_ws, 0, CTL_ZERO_BYTES, stream);
    KArgs a{};
    for (int i = 0; i < 27; ++i) a.in[i] = d_in[i];
    a.out = (float*)d_out; a.ws = (unsigned char*)d_ws; a.ph_lo = 0; a.ph_hi = N_PHASES;
    hipLaunchKernelGGL(fwd_kernel, dim3(grid), dim3(NTHR), LDS_BYTES, stream, a);
#if defined(PROBE_LO)
    (void)hipMemsetAsync((char*)d_ws + CW_BAR * 4, 0, XCD_BAR_WORDS * 4, stream);
    a.ph_lo = PROBE_LO; a.ph_hi = PROBE_HI;
#if defined(PROBE_FLAGS)
    a.flags = PROBE_FLAGS;
#endif
    hipLaunchKernelGGL(fwd_kernel, dim3(grid), dim3(NTHR), LDS_BYTES, stream, a);
#endif
}
```

```cpp
#include <hip/hip_runtime.h>
#include <cstdio>
#include <cstdint>
#include <cmath>
#define PROBE_MASK 0x0
namespace pg8 {
#define PG8_LAS __attribute__((address_space(3)))
typedef unsigned short bf16_t;
typedef short bf16x8 __attribute__((ext_vector_type(8)));
typedef float f32x4 __attribute__((ext_vector_type(4)));
typedef unsigned u32x4 __attribute__((ext_vector_type(4)));
constexpr int BM = 256, BK = 64, HALF = 128, HTB = HALF * BK * 2  , STAGE_BYTES = 8 * HTB, NXCD = 8, WGM = 8;

__host__ __device__ __forceinline__ int lds_byte(int r, int c) { const int st = (r >> 4) * 2 + (c >> 5), rr = r & 15, cc = c & 31, ob = rr * 64 + cc * 2; return st * 1024 + (ob ^ (((ob >> 9) & 1) << 5)); }
__host__ __device__ __forceinline__ void stage_rc(int b, int& R, int& C) { const int st = b / 1024, sb = b % 1024, swz = sb ^ (((sb >> 9) & 1) << 5); R = (st >> 1) * 16 + swz / 64; C = (st & 1) * 32 + (swz % 64) / 2; }
__host__ __device__ __forceinline__ int perm32(int rho) { const int n = rho >> 4, i = rho & 15; return 8 * (i >> 2) + 4 * n + (i & 3); }

struct Unit { int pm, pn; };
struct Gemm { const bf16_t* A; const bf16_t* Bt; int M, N, K; };

struct StaticOrder {
    int nM, nN, nwg, G, c;
    __host__ __device__ void init(int M, int N, int G_, int c_) { nM = M / BM; nN = N / BM; nwg = nM * nN; G = G_; c = c_; }
    __host__ __device__ bool next(int i, Unit& u) const {
        const long L = (long)i * G + c; if (L >= nwg) return false;
        int wgid = (int)L; { const int q = nwg / NXCD, r = nwg % NXCD, xcd = wgid % NXCD, off = wgid / NXCD; wgid = (xcd < r ? xcd * (q + 1) : r * (q + 1) + (xcd - r) * q) + off; }
        const int nig = WGM * nN, gid = wgid / nig, fm = gid * WGM, gsz = (nM - fm) < WGM ? (nM - fm) : WGM;
        u.pm = fm + ((wgid % nig) % gsz); u.pn = (wgid % nig) / gsz; return true;
    }
    __device__ __forceinline__ void a_ready(const Unit&) const {}
    __device__ __forceinline__ void done(const Unit&) const {}
};

struct MoeOrder {
    int nM, nN, nwg, G, c, tile0; const int* tile_expert;
    int H, R;
    __device__ void init(int ntiles, int npn, int G_, int c_, int tile0_, const int* te, int H_ = 0, int R_ = 0) { nM = ntiles; nN = npn; nwg = nM * nN; G = G_; c = c_; tile0 = tile0_; tile_expert = te; H = H_; R = R_; }
    __device__ bool next(int i, Unit& u) const {
        long L;
        if (H == 0) L = (long)i * G + c;
        else if (c >= H) { if (i >= R) return false; L = (long)i * (G - H) + (c - H); }
        else L = (long)R * (G - H) + (long)i * H + c;
        if (L >= nwg) return false;
        int wgid = (int)L; { const int q = nwg / NXCD, r = nwg % NXCD, xcd = wgid % NXCD, off = wgid / NXCD; wgid = (xcd < r ? xcd * (q + 1) : r * (q + 1) + (xcd - r) * q) + off; }
        const int nig = WGM * nN, gid = wgid / nig, fm = gid * WGM, gsz = (nM - fm) < WGM ? (nM - fm) : WGM;
        u.pm = fm + ((wgid % nig) % gsz); const int pnl = (wgid % nig) / gsz;
        const int e = __builtin_amdgcn_readfirstlane(tile_expert[tile0 + u.pm]);
        u.pn = e * nN + pnl; return true;
    }
    __device__ __forceinline__ void a_ready(const Unit&) const {}
    __device__ __forceinline__ void done(const Unit&) const {}
};

__device__ __forceinline__ unsigned cvt_pk_bf16(float lo, float hi) { unsigned r; asm volatile("v_cvt_pk_bf16_f32 %0, %1, %2" : "=v"(r) : "v"(lo), "v"(hi)); return r; }
__device__ __forceinline__ u32x4 pack8(const f32x4& a, const f32x4& b) { u32x4 w; w.x = cvt_pk_bf16(a[0], a[1]); w.y = cvt_pk_bf16(a[2], a[3]); w.z = cvt_pk_bf16(b[0], b[1]); w.w = cvt_pk_bf16(b[2], b[3]); return w; }
__device__ __forceinline__ unsigned pk4_fp8(float a, float b, float c, float d) { int w = __builtin_amdgcn_cvt_pk_fp8_f32(a, b, 0, false); w = __builtin_amdgcn_cvt_pk_fp8_f32(c, d, w, true); return (unsigned)w; }
constexpr float RMS_EPS = 1e-6f;
constexpr float LOG2E = 1.4426950408889634f;
constexpr float C2 = 0.125f * LOG2E;
__device__ __forceinline__ float row_ss(const float* ss, int nparts, int row) {
    if (nparts == 1) return ss[row];
    const f32x4* p = (const f32x4*)(ss + (size_t)row * 16); f32x4 a = p[0], b = p[1], c = p[2], d = p[3]; a = (a + b) + (c + d); return (a[0] + a[1]) + (a[2] + a[3]);
}

struct EpiProj {
    static constexpr bool PERM = true, AFTER_DRAIN = false;
    bf16_t* O; int ldc; const float* ss; int nparts; const float* gq; const float* gk; const float* rope; int layer; float pre;
    __device__ __forceinline__ void operator()(const f32x4 (&acc)[2][2][4][2], const Unit& u, int wr, int wc, int fr, int fq) const {
        const int pn = u.pn; int kind = 0; float scale = 1.f; bool rope_on = false;
        if (layer == 0) { const int t = pn >> 1; if (t == 0) scale = C2; else if (t == 3) { kind = 1; scale = C2; rope_on = true; } else if (t == 4) { kind = 2; rope_on = true; } }
        else { const int t = pn >> 2; if (t == 0) { kind = 1; scale = C2; } else if (t == 1) kind = 2; }
        const float* gv = (kind == 1) ? gq : gk;
        f32x4 g[2][2];
#pragma unroll
        for (int bj = 0; bj < 2; ++bj)
#pragma unroll
            for (int n = 0; n < 2; ++n) g[bj][n] = kind ? *(const f32x4*)(gv + 32 * bj + 8 * fq + 4 * n) : (f32x4){1.f, 1.f, 1.f, 1.f};
        const int row0 = u.pm * BM + wr * 64 + fr, col0 = pn * BM + wc * 64 + 8 * fq;
#pragma unroll
        for (int ai = 0; ai < 2; ++ai)
#pragma unroll
            for (int m = 0; m < 4; ++m) {
                const int row = row0 + ai * HALF + m * 16;
                const float r = rsqrtf(row_ss(ss, nparts, row) * (1.f / 1024.f) + RMS_EPS) * pre;
                f32x4 v[2][2]; float s = 0.f;
#pragma unroll
                for (int bj = 0; bj < 2; ++bj)
#pragma unroll
                    for (int n = 0; n < 2; ++n) { v[bj][n] = acc[ai][bj][m][n] * r; const f32x4 x = v[bj][n]; s += (x[0] * x[0] + x[1] * x[1]) + (x[2] * x[2] + x[3] * x[3]); }
                if (kind) {
                    s += __shfl_xor(s, 16); s += __shfl_xor(s, 32);
                    const float rs = rsqrtf(s * (1.f / 64.f) + RMS_EPS);
#pragma unroll
                    for (int bj = 0; bj < 2; ++bj)
#pragma unroll
                        for (int n = 0; n < 2; ++n) v[bj][n] = v[bj][n] * rs * g[bj][n];
                    if (rope_on) {
                        f32x4 p[2];
#pragma unroll
                        for (int n = 0; n < 2; ++n)
#pragma unroll
                            for (int j = 0; j < 4; ++j) p[n][j] = __shfl_xor(v[0][n][j], 16);
                        const f32x4 c0 = *(const f32x4*)(rope + (size_t)row * 16), c1 = *(const f32x4*)(rope + (size_t)row * 16 + 4);
                        const f32x4 s0 = *(const f32x4*)(rope + (size_t)row * 16 + 8), s1 = *(const f32x4*)(rope + (size_t)row * 16 + 12);
                        if (fq == 0) { v[0][0] = v[0][0] * c0 - p[0] * s0; v[0][1] = v[0][1] * c1 - p[1] * s1; }
                        else if (fq == 1) { v[0][0] = v[0][0] * c0 + p[0] * s0; v[0][1] = v[0][1] * c1 + p[1] * s1; }
                    }
                }
                bf16_t* rowp = O + ((size_t)(pn * 4 + wc) * ldc + row) * 64 + 8 * fq;
#pragma unroll
                for (int bj = 0; bj < 2; ++bj) *(u32x4*)(rowp + 32 * bj) = pack8(v[bj][0] * scale, v[bj][1] * scale);
            }
    }
};

struct EpiResid {
    static constexpr bool PERM = true, AFTER_DRAIN = false;
    const float* base; float* out; bf16_t* xb; float* ss; float pre; unsigned char* x8;
    __device__ __forceinline__ void operator()(const f32x4 (&acc)[2][2][4][2], const Unit& u, int wr, int wc, int fr, int fq) const {
        const int row0 = u.pm * BM + wr * 64 + fr, col0 = u.pn * BM + wc * 32 + 8 * fq;
#pragma unroll
        for (int ai = 0; ai < 2; ++ai)
#pragma unroll
            for (int m = 0; m < 4; ++m) {
                const int row = row0 + ai * HALF + m * 16; float s = 0.f;
#pragma unroll
                for (int bj = 0; bj < 2; ++bj) {
                    const size_t off = (size_t)row * 1024 + col0 + bj * HALF;
                    const f32x4 v0 = acc[ai][bj][m][0] * pre + *(const f32x4*)(base + off), v1 = acc[ai][bj][m][1] * pre + *(const f32x4*)(base + off + 4);
                    *(f32x4*)(out + off) = v0; *(f32x4*)(out + off + 4) = v1;
                    if (xb) *(u32x4*)(xb + off) = pack8(v0, v1);
                    if (x8) { typedef unsigned u32x2 __attribute__((ext_vector_type(2))); u32x2 w8; w8.x = pk4_fp8(v0[0], v0[1], v0[2], v0[3]); w8.y = pk4_fp8(v1[0], v1[1], v1[2], v1[3]); *(u32x2*)(x8 + off) = w8; }
                    s += (v0[0] * v0[0] + v0[1] * v0[1]) + (v0[2] * v0[2] + v0[3] * v0[3]) + (v1[0] * v1[0] + v1[1] * v1[1]) + (v1[2] * v1[2] + v1[3] * v1[3]);
                }
                if (ss) { s += __shfl_xor(s, 16); s += __shfl_xor(s, 32); if (fq == 0) ss[(size_t)row * 16 + u.pn * 4 + wc] = s; }
            }
    }
};

template <bool OUT8> struct EpiSwiglu {
    static constexpr bool PERM = true, AFTER_DRAIN = false;
    void* O; int ldc; const float* ss; int nparts; const int* rowtok; int tile0; int npn; float pre;
    __device__ __forceinline__ void operator()(const f32x4 (&acc)[2][2][4][2], const Unit& u, int wr, int wc, int fr, int fq) const {
        const int pnl = u.pn % npn; const int row0 = u.pm * BM + wr * 64 + fr, col0 = pnl * HALF + wc * 32 + 8 * fq;
#pragma unroll
        for (int ai = 0; ai < 2; ++ai)
#pragma unroll
            for (int m = 0; m < 4; ++m) {
                const int row = row0 + ai * HALF + m * 16;
                int tok = row; if (rowtok) tok = rowtok[tile0 * BM + row];
                const float r = (tok >= 0) ? rsqrtf(row_ss(ss, nparts, tok >= 0 ? tok : 0) * (1.f / 1024.f) + RMS_EPS) * pre : 0.f;
                f32x4 a[2];
#pragma unroll
                for (int n = 0; n < 2; ++n)
#pragma unroll
                    for (int j = 0; j < 4; ++j) { const float gt = acc[ai][0][m][n][j] * r, up = acc[ai][1][m][n][j] * r;
                        a[n][j] = gt * __builtin_amdgcn_rcpf(1.f + __builtin_amdgcn_exp2f(-gt * LOG2E)) * up; }
                if constexpr (OUT8) { typedef unsigned u32x2 __attribute__((ext_vector_type(2))); u32x2 w; w.x = pk4_fp8(a[0][0], a[0][1], a[0][2], a[0][3]); w.y = pk4_fp8(a[1][0], a[1][1], a[1][2], a[1][3]); *(u32x2*)((unsigned char*)O + (size_t)row * ldc + col0) = w; }
                else *(u32x4*)((bf16_t*)O + (size_t)row * ldc + col0) = pack8(a[0], a[1]);
            }
    }
};

struct EpiMoeDown {
    static constexpr bool PERM = true, AFTER_DRAIN = false;
    float* out; const int* rowtok; const float* rowgate; int tile0; float pre; int nostore;
    __device__ __forceinline__ void operator()(const f32x4 (&acc)[2][2][4][2], const Unit& u, int wr, int wc, int fr, int fq) const {
        const int pnl = u.pn & 3; const int row0 = (tile0 + u.pm) * BM + wr * 64 + fr, col0 = pnl * BM + wc * 32 + 8 * fq;
#pragma unroll
        for (int ai = 0; ai < 2; ++ai)
#pragma unroll
            for (int m = 0; m < 4; ++m) {
                const int srow = row0 + ai * HALF + m * 16; const int tok = nostore ? -1 : rowtok[srow];
                if (tok >= 0) { const float gt = rowgate[srow] * pre;
#pragma unroll
                    for (int bj = 0; bj < 2; ++bj)
#pragma unroll
                        for (int n = 0; n < 2; ++n) { f32x4* p = (f32x4*)(out + (size_t)tok * 1024 + col0 + bj * HALF + 4 * n); *p = *p + acc[ai][bj][m][n] * gt; } }
            }
    }
};

typedef int i32x4 __attribute__((ext_vector_type(4)));
typedef int i32x8 __attribute__((ext_vector_type(8)));
template <class Epi, class Sched, bool ALIGN_EPI = false, bool SP2 = false, bool F8 = false>
__device__ __forceinline__ void gemm_phase(PG8_LAS unsigned char* lds, const Gemm g, const Sched& S, const Epi& E) {
    const int tid = threadIdx.x, wid = __builtin_amdgcn_readfirstlane(tid >> 6), lane = tid & 63, wr = wid >> 2, wc = wid & 3, fr = lane & 15, fq = lane >> 4;
    const int K = g.K, nt = K / BK;
    unsigned voffA[2], voffB[2];
#pragma unroll
    for (int i = 0; i < 2; ++i) { int R, C; stage_rc(tid * 16 + i * 8192, R, C); const int Rb = Epi::PERM ? ((R & ~31) + perm32(R & 31)) : R;
        voffA[i] = (unsigned)(R * K + C) * 2u; voffB[i] = (unsigned)(Rb * K + C) * 2u; }
    const size_t kstep = (size_t)(BK * 2);
    const size_t hstep = (size_t)HALF * K * 2;
    const size_t tstep = 2 * hstep;
    const unsigned ldsw = (unsigned)wid * 1024u;
    const int aoff = lds_byte(wr * 64 + fr, fq * 8), boff = lds_byte(wc * 32 + fr, fq * 8);
#define PG8_SA(b, h) (((b) * 2 + (h)) * HTB)
#define PG8_SB(b, h) ((4 + (b) * 2 + (h)) * HTB)
#define PG8_STAGE(bufoff, gbase, voff) do { _Pragma("unroll") for (int _i = 0; _i < 2; ++_i) \
        __builtin_amdgcn_global_load_lds((const unsigned*)((const char*)(gbase) + (voff)[_i]), (PG8_LAS unsigned*)(lds + (bufoff) + ldsw + _i * 8192), 16, 0, 0); } while (0)
#define PG8_LDA(dst, b, h) do { if constexpr (F8) { _Pragma("unroll") for (int m = 0; m < 4; ++m) dst##8[m] = PG8_CAT(*(const PG8_LAS bf16x8*)(lds + PG8_SA(b, h) + aoff + m * 2048), *(const PG8_LAS bf16x8*)(lds + PG8_SA(b, h) + aoff + m * 2048 + 1024)); } \
        else { _Pragma("unroll") for (int m = 0; m < 4; ++m) _Pragma("unroll") for (int k = 0; k < 2; ++k) dst[m][k] = *(const PG8_LAS bf16x8*)(lds + PG8_SA(b, h) + aoff + m * 2048 + k * 1024); } } while (0)
#define PG8_LDB(dst, b, h) do { if constexpr (F8) { _Pragma("unroll") for (int n = 0; n < 2; ++n) dst##8[n] = PG8_CAT(*(const PG8_LAS bf16x8*)(lds + PG8_SB(b, h) + boff + n * 2048), *(const PG8_LAS bf16x8*)(lds + PG8_SB(b, h) + boff + n * 2048 + 1024)); } \
        else { _Pragma("unroll") for (int n = 0; n < 2; ++n) _Pragma("unroll") for (int k = 0; k < 2; ++k) dst[n][k] = *(const PG8_LAS bf16x8*)(lds + PG8_SB(b, h) + boff + n * 2048 + k * 1024); } } while (0)
#define PG8_CAT(x, y) __builtin_shufflevector(__builtin_bit_cast(i32x4, (x)), __builtin_bit_cast(i32x4, (y)), 0, 1, 2, 3, 4, 5, 6, 7)
#define PG8_MMA(ai, bj, At, Bt) do { __builtin_amdgcn_s_setprio(1); _Pragma("unroll") for (int m = 0; m < 4; ++m) _Pragma("unroll") for (int n = 0; n < 2; ++n) { \
        if constexpr (F8) { asm volatile("v_mfma_f32_16x16x128_f8f6f4 %0, %1, %2, %0" : "+v"(acc[ai][bj][m][n]) : "v"(Bt##8[n]), "v"(At##8[m])); } \
        else { _Pragma("unroll") for (int k = 0; k < 2; ++k) acc[ai][bj][m][n] = __builtin_amdgcn_mfma_f32_16x16x32_bf16(Bt[n][k], At[m][k], acc[ai][bj][m][n], 0, 0, 0); } } __builtin_amdgcn_s_setprio(0); } while (0)
#define PG8_WAIT_V(n) asm volatile("s_waitcnt vmcnt(" #n ")" ::: "memory")
#define PG8_WAIT_L(n) asm volatile("s_waitcnt lgkmcnt(" #n ")" ::: "memory")
#define PG8_BAR __builtin_amdgcn_s_barrier()
#define PG8_SCHED __builtin_amdgcn_sched_barrier(0)
    Unit cur, nxt; int ui = 0;
    if (!S.next(0, cur)) return;
    f32x4 acc[2][2][4][2];
#pragma unroll
    for (int a = 0; a < 2; ++a)
#pragma unroll
        for (int b = 0; b < 2; ++b)
#pragma unroll
            for (int m = 0; m < 4; ++m)
#pragma unroll
                for (int n = 0; n < 2; ++n) acc[a][b][m][n] = (f32x4){0.f, 0.f, 0.f, 0.f};
    bf16x8 At[4][2], B0[2][2], B1[2][2];
    i32x8 At8[4], B08[2], B18[2];
    const char* cA = (const char*)g.A + (size_t)cur.pm * tstep; const char* cB = (const char*)g.Bt + (size_t)cur.pn * tstep;
    S.a_ready(cur);
    if constexpr (SP2) {
        PG8_STAGE(PG8_SB(0, 0), cB, voffB); PG8_STAGE(PG8_SB(0, 1), cB + hstep, voffB); PG8_STAGE(PG8_SA(0, 0), cA, voffA); PG8_STAGE(PG8_SA(0, 1), cA + hstep, voffA);
        if (wr == 1) PG8_BAR;
        PG8_WAIT_V(2); PG8_BAR;
        PG8_STAGE(PG8_SB(1, 0), cB + kstep, voffB); PG8_STAGE(PG8_SA(1, 0), cA + kstep, voffA); PG8_STAGE(PG8_SB(1, 1), cB + hstep + kstep, voffB);
        PG8_WAIT_V(6); PG8_BAR;
    } else {
        PG8_STAGE(PG8_SB(0, 0), cB, voffB); PG8_STAGE(PG8_SA(0, 0), cA, voffA); PG8_STAGE(PG8_SB(0, 1), cB + hstep, voffB); PG8_STAGE(PG8_SA(0, 1), cA + hstep, voffA);
        if (wr == 1) PG8_BAR;
        PG8_WAIT_V(4); PG8_BAR;
        PG8_STAGE(PG8_SB(1, 0), cB + kstep, voffB); PG8_STAGE(PG8_SA(1, 0), cA + kstep, voffA); PG8_STAGE(PG8_SB(1, 1), cB + hstep + kstep, voffB);
        PG8_WAIT_V(6); PG8_BAR;
    }
    for (;;) {
        const bool has_next = S.next(ui + 1, nxt);
        const char* nA = has_next ? (const char*)g.A + (size_t)nxt.pm * tstep : cA; const char* nB = has_next ? (const char*)g.Bt + (size_t)nxt.pn * tstep : cB;
#pragma nounroll
        for (int t = 0; t < nt; t += 2) {
            const bool last = (t == nt - 2);
            const char* a1 = cA + (size_t)(t + 1) * kstep;
            const char* a2 = last ? nA : cA + (size_t)(t + 2) * kstep; const char* b2 = last ? nB : cB + (size_t)(t + 2) * kstep;
            const char* a3 = a2 + kstep; const char* b3 = b2 + kstep;
            if (last && has_next) S.a_ready(nxt);
            if constexpr (SP2) {
            PG8_LDB(B0, 0, 0); PG8_LDB(B1, 0, 1); PG8_SCHED; PG8_LDA(At, 0, 0); PG8_STAGE(PG8_SA(1, 1), a1 + hstep, voffA);
            PG8_WAIT_V(8); PG8_WAIT_L(0); PG8_BAR; PG8_MMA(0, 0, At, B0); PG8_MMA(0, 1, At, B1); PG8_BAR; PG8_SCHED;
            PG8_LDA(At, 0, 1); PG8_STAGE(PG8_SB(0, 0), b2, voffB); PG8_STAGE(PG8_SB(0, 1), b2 + hstep, voffB); PG8_STAGE(PG8_SA(0, 0), a2, voffA);
            PG8_WAIT_V(8); PG8_WAIT_L(0); PG8_BAR; PG8_MMA(1, 0, At, B0); PG8_MMA(1, 1, At, B1); PG8_BAR; PG8_SCHED;
            PG8_LDB(B0, 1, 0); PG8_LDB(B1, 1, 1); PG8_SCHED; PG8_LDA(At, 1, 0); PG8_STAGE(PG8_SA(0, 1), a2 + hstep, voffA);
            PG8_WAIT_V(8); PG8_WAIT_L(0); PG8_BAR; PG8_MMA(0, 0, At, B0); PG8_MMA(0, 1, At, B1); PG8_BAR; PG8_SCHED;
            PG8_LDA(At, 1, 1); PG8_STAGE(PG8_SB(1, 0), b3, voffB); PG8_STAGE(PG8_SB(1, 1), b3 + hstep, voffB); PG8_STAGE(PG8_SA(1, 0), a3, voffA);
            PG8_WAIT_V(8); PG8_WAIT_L(0); PG8_BAR; PG8_MMA(1, 0, At, B0); PG8_MMA(1, 1, At, B1); PG8_BAR; PG8_SCHED;
            } else {
            PG8_LDB(B0, 0, 0); PG8_SCHED; PG8_LDA(At, 0, 0); PG8_STAGE(PG8_SA(1, 1), a1 + hstep, voffA);
            PG8_WAIT_L(8); PG8_BAR; PG8_WAIT_L(0); PG8_MMA(0, 0, At, B0); PG8_BAR; PG8_SCHED;
            PG8_LDB(B1, 0, 1); PG8_STAGE(PG8_SB(0, 0), b2, voffB);
            PG8_BAR; PG8_WAIT_L(0); PG8_MMA(0, 1, At, B1); PG8_BAR;
            PG8_LDA(At, 0, 1); PG8_STAGE(PG8_SA(0, 0), a2, voffA);
            PG8_BAR; PG8_WAIT_L(0); PG8_MMA(1, 0, At, B0); PG8_BAR; PG8_SCHED;
            PG8_STAGE(PG8_SB(0, 1), b2 + hstep, voffB);
            PG8_WAIT_V(6); PG8_BAR; PG8_MMA(1, 1, At, B1); PG8_BAR;
            PG8_LDB(B0, 1, 0); PG8_SCHED; PG8_LDA(At, 1, 0); PG8_STAGE(PG8_SA(0, 1), a2 + hstep, voffA);
            PG8_WAIT_L(8); PG8_BAR; PG8_WAIT_L(0); PG8_MMA(0, 0, At, B0); PG8_BAR; PG8_SCHED;
            PG8_LDB(B1, 1, 1); PG8_STAGE(PG8_SB(1, 0), b3, voffB);
            PG8_BAR; PG8_WAIT_L(0); PG8_MMA(0, 1, At, B1); PG8_BAR;
            PG8_LDA(At, 1, 1); PG8_STAGE(PG8_SA(1, 0), a3, voffA);
            PG8_BAR; PG8_WAIT_L(0); PG8_MMA(1, 0, At, B0); PG8_BAR; PG8_SCHED;
            PG8_STAGE(PG8_SB(1, 1), b3 + hstep, voffB);
            PG8_WAIT_V(6); PG8_BAR; PG8_MMA(1, 1, At, B1); PG8_BAR;
            }
        }
        if constexpr (F8) asm volatile("s_nop 15\n\ts_nop 15\n\ts_nop 15" ::: "memory");
        if constexpr (ALIGN_EPI) { if (wr == 0) PG8_BAR; }
        if constexpr (!Epi::AFTER_DRAIN) { E(acc, cur, wr, wc, fr, fq); S.done(cur); }
        if (!has_next) break;
#pragma unroll
        for (int a = 0; a < 2; ++a)
#pragma unroll
            for (int b = 0; b < 2; ++b)
#pragma unroll
                for (int m = 0; m < 4; ++m)
#pragma unroll
                    for (int n = 0; n < 2; ++n) acc[a][b][m][n] = (f32x4){0.f, 0.f, 0.f, 0.f};
        cur = nxt; cA = nA; cB = nB; ++ui;
        if constexpr (ALIGN_EPI) { if (wr == 1) PG8_BAR; }
    }
    PG8_WAIT_V(0);
    if constexpr (!ALIGN_EPI) { if (wr == 0) PG8_BAR; }
    PG8_BAR;
    if constexpr (Epi::AFTER_DRAIN) { E.fused(acc, cur, wr, wc, fr, fq, lds, wid, lane); S.done(cur); }
#undef PG8_SA
#undef PG8_SB
#undef PG8_STAGE
#undef PG8_LDA
#undef PG8_LDB
#undef PG8_MMA
#undef PG8_CAT
#undef PG8_WAIT_V
#undef PG8_WAIT_L
#undef PG8_BAR
#undef PG8_SCHED
}
}

namespace att {
using pg8::bf16_t; using pg8::bf16x8; using pg8::u32x4;
typedef float f32x16 __attribute__((ext_vector_type(16)));
typedef short s16x4 __attribute__((ext_vector_type(4)));
typedef float f32x2_t __attribute__((ext_vector_type(2))); typedef __bf16 bf16x2_t __attribute__((ext_vector_type(2)));
#define ALAS __attribute__((address_space(3)))
typedef ALAS const char* lds_cptr;
constexpr int SEQ = 8192, PITCH = 64, VNEXT = 2 * SEQ * 64;
constexpr int KVSLOT = 24576;
constexpr int L_WS = 114688, L_TAB = L_WS + 2048, L_FLAG = L_TAB + 1056, L_END = L_FLAG + 128, L_OST = 0;
constexpr float SB_THR = 152.f;
__device__ __forceinline__ int crow(int r, int hi) { return (r & 3) + 8 * (r >> 2) + 4 * hi; }
__device__ __forceinline__ void glds16(const void* gsrc, unsigned lds_dst) { unsigned keep;
    asm volatile("s_mov_b32 %0, m0\n\ts_mov_b32 m0, %2\n\ts_nop 0\n\tglobal_load_lds_dwordx4 %1, off\n\ts_mov_b32 m0, %0" : "=&s"(keep) : "v"(gsrc), "s"(lds_dst) : "memory"); }
__device__ __forceinline__ unsigned cvtpk(float lo, float hi) { f32x2_t v = {lo, hi}; bf16x2_t b = __builtin_convertvector(v, bf16x2_t); return __builtin_bit_cast(unsigned, b); }
__device__ __forceinline__ unsigned short f2bf(float f) { unsigned u = __builtin_bit_cast(unsigned, f); return (unsigned short)((u + 0x7fffu + ((u >> 16) & 1u)) >> 16); }
#define MFMA32(a, b, c) __builtin_amdgcn_mfma_f32_32x32x16_bf16((a), (b), (c), 0, 0, 0)

__device__ __forceinline__ void qkt(f32x16& p0, f32x16& p1, lds_cptr kb, const bf16x8* qr, const f32x16& cin) {
#pragma unroll
    for (int d0 = 0; d0 < 4; ++d0) {
        const bf16x8 b0 = *(const ALAS bf16x8*)(kb + d0 * 2048);
        const bf16x8 b1 = *(const ALAS bf16x8*)(kb + d0 * 2048 + 512);
        if (d0 == 0) { p0 = MFMA32(b0, qr[0], cin); p1 = MFMA32(b1, qr[0], cin); }
        else { p0 = MFMA32(b0, qr[d0], p0); p1 = MFMA32(b1, qr[d0], p1); }
    }
}
template <int ND> __device__ __forceinline__ void pv(f32x16* o, int vb, bf16x8 pa0, bf16x8 pa1, bf16x8 pa2, bf16x8 pa3) {
#pragma unroll
    for (int d0 = 0; d0 < ND; ++d0) { s16x4 lo[4], hi[4];
#pragma unroll
        for (int ks = 0; ks < 4; ++ks) {
            asm volatile("ds_read_b64_tr_b16 %0,%1 offset:%c2" : "=&v"(lo[ks]) : "v"(vb), "i"(d0 * 4096 + ks * 1024) : "memory");
            asm volatile("ds_read_b64_tr_b16 %0,%1 offset:%c2" : "=&v"(hi[ks]) : "v"(vb), "i"(d0 * 4096 + ks * 1024 + 512) : "memory"); }
        asm volatile("s_waitcnt lgkmcnt(0)" ::: "memory"); __builtin_amdgcn_sched_barrier(0);
#define ATT_PK(k) (bf16x8){lo[k][0], lo[k][1], lo[k][2], lo[k][3], hi[k][0], hi[k][1], hi[k][2], hi[k][3]}
        o[d0] = MFMA32(pa0, ATT_PK(0), o[d0]);
        o[d0] = MFMA32(pa1, ATT_PK(1), o[d0]);
        o[d0] = MFMA32(pa2, ATT_PK(2), o[d0]);
        o[d0] = MFMA32(pa3, ATT_PK(3), o[d0]);
#undef ATT_PK
    }
}

template <int MODE, int VD, bool OUT8 = false, int TPB = 1>
__device__ __forceinline__ void attn_unit(ALAS char* shm, const bf16_t* Qb, const bf16_t* Kb, const bf16_t* Vb, void* Ob, int opitch, int q0, float mref2, const float* tab, float oscale = 1.f) {
    constexpr int ND = VD / 32, SLOT = 8192 + VD * 128;
    static_assert(2 * TPB * SLOT <= L_WS, "ring vs LDS map");
    const int tid = threadIdx.x, lane = tid & 63, r32 = lane & 31, hi = lane >> 5; const int wid = __builtin_amdgcn_readfirstlane(tid >> 6);
    const unsigned lds0 = (unsigned)(uintptr_t)shm;
    ALAS float* wsf = (ALAS float*)(shm + L_WS) + wid * 64;
    ALAS float* tabL = (ALAS float*)(shm + L_TAB);
    ALAS unsigned* flg = (ALAS unsigned*)(shm + L_FLAG);
    if (MODE == 1) { for (int i = tid; i < 257; i += 512) tabL[i] = tab[i] * pg8::LOG2E; }
    const bf16_t* Qw = Qb + (size_t)(q0 + wid * 32) * PITCH;
    bf16x8 qr[4];
#pragma unroll
    for (int d0 = 0; d0 < 4; ++d0) qr[d0] = *(const bf16x8*)(Qw + (size_t)r32 * PITCH + d0 * 16 + hi * 8);
    int t_first, n_t, t_step;
    if (MODE == 0) { t_first = 0; n_t = q0 / 64 + 4; t_step = 1; }
    else if (MODE == 1) { const int c0 = q0 / 64; t_first = c0 - 8 > 0 ? c0 - 8 : 0; n_t = c0 + 4 - t_first; t_step = 1; }
    else { t_first = q0 / 64 + 3; n_t = q0 / 64 + 4; t_step = -1; }
    const bf16_t* ksrc = Kb + (size_t)lane * PITCH + wid * 8;
    const bf16_t* vsrc = Vb + (size_t)(16 * (wid & 3) + (lane >> 2)) * PITCH + (wid >> 2) * 32 + (lane & 3) * 8;
#define ATT_DMA(t, slot) do { const size_t to_ = (size_t)(t) * 64 * PITCH; const unsigned sb_ = lds0 + (unsigned)(slot) * SLOT; \
        glds16(ksrc + to_, (unsigned)__builtin_amdgcn_readfirstlane(sb_ + wid * 1024)); \
        glds16(vsrc + to_, (unsigned)__builtin_amdgcn_readfirstlane(sb_ + 8192 + wid * 1024)); \
        if (VD == 128) glds16(vsrc + to_ + VNEXT, (unsigned)__builtin_amdgcn_readfirstlane(sb_ + 8192 + (wid + 8) * 1024)); } while (0)
    f32x16 o[ND];
#pragma unroll
    for (int d = 0; d < ND; ++d) o[d] = f32x16{};
    f32x16 cin;
#pragma unroll
    for (int r = 0; r < 16; ++r) cin[r] = (MODE == 2) ? 0.f : -mref2;
    float l_reg = 0.f, A = 0.f; bool wdone = false;
    const int wrow0 = q0 + wid * 32, qrow = wrow0 + r32;
    const int vb0 = (int)lds0 + 8192 + ((lane >> 4) & 1) * 32 + (lane & 3) * 8 + (4 * hi + ((lane & 15) >> 2)) * 64;
    asm volatile("s_waitcnt vmcnt(0)" ::: "memory"); asm volatile("" : "+v"(qr[0]), "+v"(qr[1]), "+v"(qr[2]), "+v"(qr[3]));
#pragma unroll
    for (int u = 0; u < TPB; ++u) ATT_DMA(t_first + u * t_step, u);
    for (int i = 0; i < n_t; ++i) {
        const int t = t_first + i * t_step, slot = i % (2 * TPB);
        if (i % TPB == 0) {
        asm volatile("s_waitcnt vmcnt(0) lgkmcnt(0)\n\ts_barrier" ::: "memory");
        if (MODE == 2 && i > 0) { const int par = ((i - 1) & 3) * 8; unsigned all = 1u;
#pragma unroll
            for (int w = 0; w < 8; ++w) all &= flg[par + w];
            if (__builtin_amdgcn_readfirstlane(all)) break; }
        if (i + TPB < n_t) {
#pragma unroll
            for (int u = 0; u < TPB; ++u) ATT_DMA(t + (TPB + u) * t_step, (i + TPB + u) % (2 * TPB)); }
        }
        bool active;
        if (MODE == 0) active = (64 * t <= wrow0);
        else if (MODE == 1) { const int cw = wrow0 / 64; active = (t >= cw - 8) && (t <= cw); }
        else active = !wdone && (64 * t < wrow0 + 31);
        if (active) {
            const lds_cptr kb = (lds_cptr)shm + slot * SLOT + hi * 1024 + r32 * 16;
            f32x16 p0, p1; qkt(p0, p1, kb, qr, cin);
            if (MODE == 0) {
#pragma unroll
                for (int r = 0; r < 16; ++r) { p0[r] = __builtin_amdgcn_exp2f(p0[r]); p1[r] = __builtin_amdgcn_exp2f(p1[r]); }
            } else if (MODE == 1) {
                const int cw = wrow0 / 64;
                if (t <= cw - 3) { const float cb = tabL[256];
#pragma unroll
                    for (int r = 0; r < 16; ++r) { p0[r] = __builtin_amdgcn_exp2f(p0[r] + cb); p1[r] = __builtin_amdgcn_exp2f(p1[r] + cb); }
                } else { const int dq = qrow - 64 * t - 4 * hi;
#pragma unroll
                    for (int r = 0; r < 16; ++r) { int d0 = dq - ((r & 3) + 8 * (r >> 2)), d1 = d0 - 32;
                        d0 = d0 < -128 ? -128 : (d0 > 128 ? 128 : d0); d1 = d1 < -128 ? -128 : (d1 > 128 ? 128 : d1);
                        p0[r] = __builtin_amdgcn_exp2f(p0[r] + tabL[d0 + 128]); p1[r] = __builtin_amdgcn_exp2f(p1[r] + tabL[d1 + 128]); }
                }
            } else {
                const bool needmask = (64 * t + 63 >= wrow0);
                const int kq = qrow - 64 * t - 4 * hi;
                float g[8];
#pragma unroll
                for (int k = 0; k < 8; ++k) g[k] = 0.f;
                f32x16 s0, s1;
#pragma unroll
                for (int r = 0; r < 16; ++r) { const int kv = (r & 3) + 8 * (r >> 2);
                    { const float y = p0[r], a = __builtin_fabsf(y); float sp = __builtin_fmaxf(y, 0.f) + __builtin_amdgcn_logf(1.f + __builtin_amdgcn_exp2f(-a)); if (needmask && !(kv < kq)) sp = 0.f; s0[r] = sp; g[r >> 2] += sp; }
                    { const float y = p1[r], a = __builtin_fabsf(y); float sp = __builtin_fmaxf(y, 0.f) + __builtin_amdgcn_logf(1.f + __builtin_amdgcn_exp2f(-a)); if (needmask && !(kv + 32 < kq)) sp = 0.f; s1[r] = sp; g[4 + (r >> 2)] += sp; } }
                float pg[8];
#pragma unroll
                for (int k = 0; k < 8; ++k) pg[k] = __shfl_xor(g[k], 32);
                float base[8]; float own = 0.f, par = 0.f;
#pragma unroll
                for (int k = 7; k >= 0; --k) { const float par_incl = par + pg[k]; base[k] = A + own + (hi == 0 ? par_incl : par); own += g[k]; par = par_incl; }
                A += own + par;
#pragma unroll
                for (int k = 0; k < 4; ++k) {
                    { float c = base[k]; c += s0[4 * k + 3]; const float w3 = __builtin_amdgcn_exp2f(p0[4 * k + 3] - c); c += s0[4 * k + 2]; const float w2 = __builtin_amdgcn_exp2f(p0[4 * k + 2] - c);
                      c += s0[4 * k + 1]; const float w1 = __builtin_amdgcn_exp2f(p0[4 * k + 1] - c); c += s0[4 * k]; const float w0 = __builtin_amdgcn_exp2f(p0[4 * k] - c);
                      p0[4 * k] = w0; p0[4 * k + 1] = w1; p0[4 * k + 2] = w2; p0[4 * k + 3] = w3; }
                    { float c = base[4 + k]; c += s1[4 * k + 3]; const float w3 = __builtin_amdgcn_exp2f(p1[4 * k + 3] - c); c += s1[4 * k + 2]; const float w2 = __builtin_amdgcn_exp2f(p1[4 * k + 2] - c);
                      c += s1[4 * k + 1]; const float w1 = __builtin_amdgcn_exp2f(p1[4 * k + 1] - c); c += s1[4 * k]; const float w0 = __builtin_amdgcn_exp2f(p1[4 * k] - c);
                      p1[4 * k] = w0; p1[4 * k + 1] = w1; p1[4 * k + 2] = w2; p1[4 * k + 3] = w3; }
                }
                if (needmask) {
#pragma unroll
                    for (int r = 0; r < 16; ++r) { const int kv = (r & 3) + 8 * (r >> 2); if (!(kv < kq)) p0[r] = 0.f; if (!(kv + 32 < kq)) p1[r] = 0.f; }
                }
                wdone = __all(A >= SB_THR);
            }
            if (MODE != 2) { float s = 0.f;
#pragma unroll
                for (int r = 0; r < 16; ++r) s += p0[r] + p1[r];
                l_reg += s; }
            u32x4 pw0, pw1, pw2, pw3;
            pw0 = (u32x4){cvtpk(p0[0], p0[1]), cvtpk(p0[2], p0[3]), cvtpk(p0[4], p0[5]), cvtpk(p0[6], p0[7])};
            pw1 = (u32x4){cvtpk(p0[8], p0[9]), cvtpk(p0[10], p0[11]), cvtpk(p0[12], p0[13]), cvtpk(p0[14], p0[15])};
            pw2 = (u32x4){cvtpk(p1[0], p1[1]), cvtpk(p1[2], p1[3]), cvtpk(p1[4], p1[5]), cvtpk(p1[6], p1[7])};
            pw3 = (u32x4){cvtpk(p1[8], p1[9]), cvtpk(p1[10], p1[11]), cvtpk(p1[12], p1[13]), cvtpk(p1[14], p1[15])};
            pv<ND>(o, vb0 + slot * SLOT, __builtin_bit_cast(bf16x8, pw0), __builtin_bit_cast(bf16x8, pw1), __builtin_bit_cast(bf16x8, pw2), __builtin_bit_cast(bf16x8, pw3));
        }
        if (MODE == 2) { if (lane == 0) flg[(i & 3) * 8 + wid] = wdone ? 1u : 0u; }
    }
#undef ATT_DMA
    asm volatile("s_waitcnt vmcnt(0) lgkmcnt(0)\n\ts_barrier" ::: "memory");
    float rl[16];
    if (MODE != 2) {
        l_reg += __shfl_xor(l_reg, 32);
        if (hi == 0) wsf[32 + r32] = l_reg;
        asm volatile("s_waitcnt lgkmcnt(0)" ::: "memory");
#pragma unroll
        for (int r = 0; r < 16; ++r) rl[r] = __builtin_amdgcn_rcpf(wsf[32 + crow(r, hi)]) * oscale;
    } else {
#pragma unroll
        for (int r = 0; r < 16; ++r) rl[r] = oscale;
    }
    if constexpr (OUT8) {
        static_assert(!OUT8 || VD == 64, "fp8 output: 64-wide heads");
        unsigned char* Ow = (unsigned char*)Ob + (size_t)(q0 + wid * 32) * opitch;
        ALAS unsigned char* stg = (ALAS unsigned char*)(shm + L_OST) + wid * 2048;
#pragma unroll
        for (int r = 0; r < 16; ++r) { const int orow = crow(r, hi);
#pragma unroll
            for (int d0 = 0; d0 < 2; ++d0) { const float v = o[d0][r] * rl[r]; stg[orow * 64 + d0 * 32 + r32] = (unsigned char)(__builtin_amdgcn_cvt_pk_fp8_f32(v, v, 0, false) & 0xff); } }
        asm volatile("s_waitcnt lgkmcnt(0)" ::: "memory");
#pragma unroll
        for (int i = 0; i < 2; ++i) { const int row = i * 16 + (lane >> 2), ch = lane & 3; const u32x4 v = *(const ALAS u32x4*)(stg + row * 64 + ch * 16); *(u32x4*)(Ow + (size_t)row * opitch + ch * 16) = v; }
        asm volatile("s_waitcnt lgkmcnt(0)" ::: "memory");
    } else {
    bf16_t* Ow = (bf16_t*)Ob + (size_t)(q0 + wid * 32) * opitch;
    ALAS bf16_t* stg = (ALAS bf16_t*)(shm + L_OST) + wid * 2048;
#pragma unroll
    for (int half = 0; half < ND / 2; ++half) {
#pragma unroll
        for (int r = 0; r < 16; ++r) { const int orow = crow(r, hi);
#pragma unroll
            for (int d0 = 0; d0 < 2; ++d0) stg[orow * 64 + d0 * 32 + r32] = f2bf(o[half * 2 + d0][r] * rl[r]); }
        asm volatile("s_waitcnt lgkmcnt(0)" ::: "memory");
#pragma unroll
        for (int i = 0; i < 4; ++i) { const int row = i * 8 + (lane >> 3), ch = lane & 7; const u32x4 v = *(const ALAS u32x4*)(stg + row * 64 + ch * 8); *(u32x4*)(Ow + (size_t)row * opitch + half * 64 + ch * 8) = v; }
        asm volatile("s_waitcnt lgkmcnt(0)" ::: "memory");
    }
    }
    asm volatile("s_waitcnt vmcnt(0) lgkmcnt(0)\n\ts_barrier" ::: "memory");
}


__device__ __forceinline__ void qkt8(f32x16& p0, f32x16& p1, lds_cptr kb, const bf16x8* qr, const f32x16& cin) {
    bf16x8 kf[8];
#pragma unroll
    for (int d0 = 0; d0 < 4; ++d0) { kf[2 * d0] = *(const ALAS bf16x8*)(kb + d0 * 2048); kf[2 * d0 + 1] = *(const ALAS bf16x8*)(kb + d0 * 2048 + 512); }
    __builtin_amdgcn_sched_barrier(0);
    p0 = MFMA32(kf[0], qr[0], cin); p1 = MFMA32(kf[1], qr[0], cin);
#pragma unroll
    for (int d0 = 1; d0 < 4; ++d0) { p0 = MFMA32(kf[2 * d0], qr[d0], p0); p1 = MFMA32(kf[2 * d0 + 1], qr[d0], p1); }
}
template <int ND, int KS0> __device__ __forceinline__ void v_reads(s16x4 (&lo)[ND][2], s16x4 (&hi)[ND][2], int vb) {
#pragma unroll
    for (int ks = 0; ks < 2; ++ks)
#pragma unroll
        for (int d0 = 0; d0 < ND; ++d0) {
            asm volatile("ds_read_b64_tr_b16 %0,%1 offset:%c2" : "=&v"(lo[d0][ks]) : "v"(vb), "i"(d0 * 4096 + (KS0 + ks) * 1024) : "memory");
            asm volatile("ds_read_b64_tr_b16 %0,%1 offset:%c2" : "=&v"(hi[d0][ks]) : "v"(vb), "i"(d0 * 4096 + (KS0 + ks) * 1024 + 512) : "memory"); }
}
template <int ND> __device__ __forceinline__ void pv_half(f32x16* o, const s16x4 (&lo)[ND][2], const s16x4 (&hi)[ND][2], bf16x8 pa, bf16x8 pb) {
#define ATT_PK2(d, k) (bf16x8){lo[d][k][0], lo[d][k][1], lo[d][k][2], lo[d][k][3], hi[d][k][0], hi[d][k][1], hi[d][k][2], hi[d][k][3]}
#pragma unroll
    for (int d0 = 0; d0 < ND; ++d0) o[d0] = MFMA32(pa, ATT_PK2(d0, 0), o[d0]);
#pragma unroll
    for (int d0 = 0; d0 < ND; ++d0) o[d0] = MFMA32(pb, ATT_PK2(d0, 1), o[d0]);
#undef ATT_PK2
}
template <int MODE> __device__ __forceinline__ void p_half(f32x16& p, float& l_reg, u32x4& wa, u32x4& wb, bool const_bias, int dq, const ALAS float* tabL) {
    if (MODE == 0) {
#pragma unroll
        for (int r = 0; r < 16; ++r) p[r] = __builtin_amdgcn_exp2f(p[r]);
    } else if (const_bias) { const float cb = tabL[256];
#pragma unroll
        for (int r = 0; r < 16; ++r) p[r] = __builtin_amdgcn_exp2f(p[r] + cb);
    } else {
#pragma unroll
        for (int r = 0; r < 16; ++r) { int d = dq - ((r & 3) + 8 * (r >> 2)); d = d < -128 ? -128 : (d > 128 ? 128 : d); p[r] = __builtin_amdgcn_exp2f(p[r] + tabL[d + 128]); }
    }
    float s = 0.f;
#pragma unroll
    for (int r = 0; r < 16; ++r) s += p[r];
    l_reg += s;
    wa = (u32x4){cvtpk(p[0], p[1]), cvtpk(p[2], p[3]), cvtpk(p[4], p[5]), cvtpk(p[6], p[7])};
    wb = (u32x4){cvtpk(p[8], p[9]), cvtpk(p[10], p[11]), cvtpk(p[12], p[13]), cvtpk(p[14], p[15])};
}
__device__ __forceinline__ void vm_wait_n(int n) {
    if (n <= 0) asm volatile("s_waitcnt vmcnt(0)" ::: "memory"); else if (n == 1) asm volatile("s_waitcnt vmcnt(1)" ::: "memory"); else if (n == 2) asm volatile("s_waitcnt vmcnt(2)" ::: "memory");
    else if (n == 3) asm volatile("s_waitcnt vmcnt(3)" ::: "memory"); else if (n == 4) asm volatile("s_waitcnt vmcnt(4)" ::: "memory"); else if (n == 5) asm volatile("s_waitcnt vmcnt(5)" ::: "memory");
    else if (n == 6) asm volatile("s_waitcnt vmcnt(6)" ::: "memory"); else if (n == 7) asm volatile("s_waitcnt vmcnt(7)" ::: "memory"); else if (n == 8) asm volatile("s_waitcnt vmcnt(8)" ::: "memory");
    else if (n == 9) asm volatile("s_waitcnt vmcnt(9)" ::: "memory"); else if (n == 10) asm volatile("s_waitcnt vmcnt(10)" ::: "memory"); else asm volatile("s_waitcnt vmcnt(11)" ::: "memory");
}
template <int MODE, int VD, bool OUT8 = false, int PD = 3>
__device__ __forceinline__ void attn_unit_pp(ALAS char* shm, const bf16_t* Qb, const bf16_t* Kb, const bf16_t* Vb, void* Ob, int opitch, int q0, float mref2, const float* tab, float oscale = 1.f, int dbg = 0) {
    static_assert(MODE == 0 || MODE == 1, "ping-pong loop: softmax modes only");
    constexpr int ND = VD / 32, NV = VD / 64, NS = PD + 1, PER = 1 + NV, SLOT = 8192 + VD * 128;
    static_assert(NS * SLOT <= L_WS, "ring vs LDS map");
    const int tid = threadIdx.x, lane = tid & 63, r32 = lane & 31, hi = lane >> 5; const int wid = __builtin_amdgcn_readfirstlane(tid >> 6); const int grp = wid >> 2;
    const unsigned lds0 = (unsigned)(uintptr_t)shm;
    ALAS float* wsf = (ALAS float*)(shm + L_WS) + wid * 64;
    ALAS float* tabL = (ALAS float*)(shm + L_TAB);
    if (MODE == 1) { for (int i = tid; i < 257; i += 512) tabL[i] = tab[i] * pg8::LOG2E; }
    const bf16_t* Qw = Qb + (size_t)(q0 + wid * 32) * PITCH;
    bf16x8 qr[4];
#pragma unroll
    for (int d0 = 0; d0 < 4; ++d0) qr[d0] = *(const bf16x8*)(Qw + (size_t)r32 * PITCH + d0 * 16 + hi * 8);
    int t_first, n_t;
    if (MODE == 0) { t_first = 0; n_t = q0 / 64 + 4; }
    else { const int c0 = q0 / 64; t_first = c0 - 8 > 0 ? c0 - 8 : 0; n_t = c0 + 4 - t_first; }
    const bf16_t* ksrc = Kb + (size_t)lane * PITCH + wid * 8 + (size_t)t_first * 64 * PITCH;
    const bf16_t* vsrc = Vb + (size_t)(16 * (wid & 3) + (lane >> 2)) * PITCH + (wid >> 2) * 32 + (lane & 3) * 8 + (size_t)t_first * 64 * PITCH;
    const bf16_t* ksrc_c = Kb + (size_t)t_first * 64 * PITCH + wid * 512 + lane * 8;
    int issued = 0;
#define PP_DMA_K(i) do { if ((i) < n_t && !(dbg & 64)) { glds16(((dbg & 128) ? ksrc_c : ksrc) + (size_t)(i) * 64 * PITCH, (unsigned)__builtin_amdgcn_readfirstlane(lds0 + (unsigned)((i) % NS) * SLOT + wid * 1024)); issued += 1; } } while (0)
#define PP_DMA_V(i) do { if ((i) < n_t && !(dbg & 64)) { const unsigned sb_ = lds0 + (unsigned)((i) % NS) * SLOT + 8192; glds16(vsrc + (size_t)(i) * 64 * PITCH, (unsigned)__builtin_amdgcn_readfirstlane(sb_ + wid * 1024)); \
        if (VD == 128) glds16(vsrc + (size_t)(i) * 64 * PITCH + VNEXT, (unsigned)__builtin_amdgcn_readfirstlane(sb_ + (wid + 8) * 1024)); issued += NV; } } while (0)
#define PP_NEED_K(j) do { if (!(dbg & 256)) vm_wait_n(issued - ((j) * PER + 1)); } while (0)
#define PP_NEED_V(j) do { if (!(dbg & 256)) vm_wait_n(issued - ((j) + 1) * PER); } while (0)
#define PP_BAR() asm volatile("s_waitcnt lgkmcnt(0)\n\ts_barrier" ::: "memory")
    f32x16 o[ND];
#pragma unroll
    for (int d = 0; d < ND; ++d) o[d] = f32x16{};
    f32x16 cin;
#pragma unroll
    for (int r = 0; r < 16; ++r) cin[r] = -mref2;
    float l_reg = 0.f;
    const int wrow0 = q0 + wid * 32, qrow = wrow0 + r32, cw = wrow0 / 64;
    const int vb0 = (int)lds0 + 8192 + ((lane >> 4) & 1) * 32 + (lane & 3) * 8 + (4 * hi + ((lane & 15) >> 2)) * 64;
    asm volatile("s_waitcnt vmcnt(0)" ::: "memory"); asm volatile("" : "+v"(qr[0]), "+v"(qr[1]), "+v"(qr[2]), "+v"(qr[3]));
#pragma unroll
    for (int j = 0; j < PD; ++j) { PP_DMA_K(j); PP_DMA_V(j); }
    if (grp) PP_DMA_K(PD);
    PP_NEED_V(0);
    PP_BAR();
    if (grp) PP_BAR();
    u32x4 pw0, pw1, pw2, pw3; f32x16 p1;
    for (int i = 0; i < n_t; ++i) {
        const int t = t_first + i, slot = i % NS;
        bool active;
        if (MODE == 0) active = (t <= cw); else active = (t >= cw - 8) && (t <= cw);
        if (grp == 0) PP_DMA_K(i + PD); else PP_DMA_V(i + PD);
        if (active && !(dbg & 32)) {
            const lds_cptr kb = (lds_cptr)shm + slot * SLOT + hi * 1024 + r32 * 16;
            f32x16 p0; qkt8(p0, p1, kb, qr, cin);
            p_half<MODE>(p0, l_reg, pw0, pw1, (t <= cw - 3) || (dbg & 8), qrow - 64 * t - 4 * hi, tabL);
        }
        if (grp == 0) PP_NEED_V(i); else PP_NEED_K(i + 1);
        PP_BAR();
        if (grp == 0) PP_DMA_V(i + PD); else PP_DMA_K(i + 1 + PD);
        if (active && !(dbg & 16)) {
            const int vb = vb0 + slot * SLOT;
            s16x4 lo0[ND][2], hi0[ND][2], lo1[ND][2], hi1[ND][2];
            v_reads<ND, 0>(lo0, hi0, vb);
            asm volatile("s_waitcnt lgkmcnt(0)" ::: "memory");
            v_reads<ND, 2>(lo1, hi1, vb);
            __builtin_amdgcn_sched_barrier(0);
            pv_half<ND>(o, lo0, hi0, __builtin_bit_cast(bf16x8, pw0), __builtin_bit_cast(bf16x8, pw1));
            __builtin_amdgcn_sched_barrier(0);
            p_half<MODE>(p1, l_reg, pw2, pw3, (t <= cw - 3) || (dbg & 8), qrow - 64 * t - 4 * hi - 32, tabL);
            asm volatile("s_waitcnt lgkmcnt(0)" ::: "memory");
            __builtin_amdgcn_sched_barrier(0);
            pv_half<ND>(o, lo1, hi1, __builtin_bit_cast(bf16x8, pw2), __builtin_bit_cast(bf16x8, pw3));
        }
        if (grp == 0) PP_NEED_K(i + 1); else PP_NEED_V(i + 1);
        PP_BAR();
    }
    if (grp == 0) PP_BAR();
#undef PP_DMA_K
#undef PP_DMA_V
#undef PP_NEED_K
#undef PP_NEED_V
    float rl[16];
    l_reg += __shfl_xor(l_reg, 32);
    if (hi == 0) wsf[32 + r32] = l_reg;
    asm volatile("s_waitcnt lgkmcnt(0)" ::: "memory");
#pragma unroll
    for (int r = 0; r < 16; ++r) rl[r] = __builtin_amdgcn_rcpf(wsf[32 + crow(r, hi)]) * oscale;
    if constexpr (OUT8) {
        static_assert(!OUT8 || VD == 64, "fp8 output: 64-wide heads");
        unsigned char* Ow = (unsigned char*)Ob + (size_t)(q0 + wid * 32) * opitch;
        ALAS unsigned char* stg = (ALAS unsigned char*)(shm + L_OST) + wid * 2048;
#pragma unroll
        for (int r = 0; r < 16; ++r) { const int orow = crow(r, hi);
#pragma unroll
            for (int d0 = 0; d0 < 2; ++d0) { const float v = o[d0][r] * rl[r]; stg[orow * 64 + d0 * 32 + r32] = (unsigned char)(__builtin_amdgcn_cvt_pk_fp8_f32(v, v, 0, false) & 0xff); } }
        asm volatile("s_waitcnt lgkmcnt(0)" ::: "memory");
#pragma unroll
        for (int i = 0; i < 2; ++i) { const int row = i * 16 + (lane >> 2), ch = lane & 3; const u32x4 v = *(const ALAS u32x4*)(stg + row * 64 + ch * 16); *(u32x4*)(Ow + (size_t)row * opitch + ch * 16) = v; }
        asm volatile("s_waitcnt lgkmcnt(0)" ::: "memory");
    } else {
    bf16_t* Ow = (bf16_t*)Ob + (size_t)(q0 + wid * 32) * opitch;
    ALAS bf16_t* stg = (ALAS bf16_t*)(shm + L_OST) + wid * 2048;
#pragma unroll
    for (int half = 0; half < ND / 2; ++half) {
#pragma unroll
        for (int r = 0; r < 16; ++r) { const int orow = crow(r, hi);
#pragma unroll
            for (int d0 = 0; d0 < 2; ++d0) stg[orow * 64 + d0 * 32 + r32] = f2bf(o[half * 2 + d0][r] * rl[r]); }
        asm volatile("s_waitcnt lgkmcnt(0)" ::: "memory");
#pragma unroll
        for (int i = 0; i < 4; ++i) { const int row = i * 8 + (lane >> 3), ch = lane & 7; const u32x4 v = *(const ALAS u32x4*)(stg + row * 64 + ch * 8); *(u32x4*)(Ow + (size_t)row * opitch + half * 64 + ch * 8) = v; }
        asm volatile("s_waitcnt lgkmcnt(0)" ::: "memory");
    }
    }
    PP_BAR();
#undef PP_BAR
}
}

constexpr int NWAVES = 8, NTHR = NWAVES * 64;
constexpr int BATCH = 2, SEQ = 8192, T = BATCH * SEQ, D = 1024;
constexpr int NPROJ = 3072, FFD = 2816, FFE = 3584, NEXP = 8;
constexpr size_t MiB = 1u << 20;
constexpr size_t CTL_ZERO_BYTES = 1 * MiB;
constexpr int CW_TMO = 0, CW_BAR = 4096;
constexpr int CW_HIST = 16384;
constexpr int CW_QATT = 32768, CW_QCONV = 32768 + 64 * 8;
constexpr int CW_MOE = 24576;
constexpr size_t WS_SS0 = 1 * MiB, WS_SS3 = WS_SS0 + 65536, WS_ROPE = WS_SS3 + 65536  , WS_TOKSEL = WS_ROPE + MiB  ,
                 WS_TOKGATE = WS_TOKSEL + 65536  , WS_ROWTOK = WS_TOKGATE + 131072  , WS_ROWGATE = WS_ROWTOK + 147456  ;
static_assert(WS_ROWGATE + 147456 <= 4 * MiB, "small arrays");
constexpr size_t WS_XB = 4 * MiB;
constexpr size_t WS_AO = 36 * MiB;
constexpr size_t WS_ACT0 = 68 * MiB;
constexpr size_t WS_XF = 164 * MiB;
constexpr size_t WS_WIN = 228 * MiB, WS_WO0 = 234 * MiB, WS_WGU0 = 236 * MiB, WS_WD0 = 247 * MiB, WS_WQKV = 253 * MiB, WS_WO1 = 259 * MiB;
constexpr size_t WS_WEGU = 264 * MiB;
constexpr size_t WS_WED = 376 * MiB;
constexpr size_t WS_SS1 = 432 * MiB, WS_SS2 = 433 * MiB;
constexpr size_t WS_END = 434 * MiB;
constexpr size_t WS_SORTA = 36 * MiB;
constexpr size_t WS_ACTE = 108 * MiB;
static_assert(WS_SORTA + (size_t)36864 * 2048 <= WS_ACTE && WS_ACTE + (size_t)18432 * 7168 <= WS_WO0 && WS_WD0 + (size_t)1024 * 2816 * 2 <= WS_WQKV && WS_WO1 + 2 * MiB <= WS_WEGU, "ws map");
constexpr int RING_BYTES = 131072, MISC_OFF = RING_BYTES + 320, LDS_BYTES = 147456;
static_assert(att::L_END <= RING_BYTES, "attention LDS");

#define GAS __attribute__((address_space(1)))
#define LAS __attribute__((address_space(3)))
typedef unsigned short bf16;
typedef unsigned v4u __attribute__((ext_vector_type(4)));
typedef float f32x4 __attribute__((ext_vector_type(4)));
typedef GAS unsigned gu32;
#define RLX_AGENT __ATOMIC_RELAXED, __HIP_MEMORY_SCOPE_AGENT
#define LDS_WAIT() asm volatile("s_waitcnt lgkmcnt(0)" ::: "memory")
#define VM_WAIT() asm volatile("s_waitcnt vmcnt(0)" ::: "memory")
__device__ __forceinline__ unsigned f2bf(float f) { unsigned u = __builtin_bit_cast(unsigned, f); return (u + 0x7fffu + ((u >> 16) & 1u)) >> 16; }
__device__ __forceinline__ unsigned pk2(float lo, float hi) { return f2bf(lo) | (f2bf(hi) << 16); }
__device__ __forceinline__ float bf2f(unsigned short h) { return __builtin_bit_cast(float, (unsigned)h << 16); }
#define XB_TMO      128
#define XB_XCNT(j)  (256  + 64 * (j))
#define XB_XSUB(j)  (1280 + 64 * (j))
#define XB_XGEN(j)  (2304 + 64 * (j))
#define XB_TOP      3328
#define XB_TOPGEN   3392
#define XCD_BAR_WORDS 3456
#define XB_SPIN_CAP (1u << 18)

__device__ __forceinline__ unsigned xb_ld(unsigned* p)              { return __hip_atomic_load(p, __ATOMIC_RELAXED, __HIP_MEMORY_SCOPE_AGENT); }
__device__ __forceinline__ unsigned xb_add(unsigned* p, unsigned v) { return __hip_atomic_fetch_add(p, v, __ATOMIC_RELAXED, __HIP_MEMORY_SCOPE_AGENT); }
__device__ __forceinline__ unsigned xb_xcc_id() { return (unsigned)__builtin_amdgcn_s_getreg((3 << 11) | 20) & 0xFu; }
#define XB_SPIN(cond, bar) do { unsigned _sp = 0; while (cond) { __builtin_amdgcn_s_sleep(1); \
    if ((++_sp & 255u) == 0u) { if (xb_ld(&(bar)[XB_TMO])) break; if (_sp > XB_SPIN_CAP) { atomicAdd(&(bar)[XB_TMO], 1u); break; } } } } while (0)

struct XcdBarrier {
    unsigned* bar; unsigned x;
    volatile LAS unsigned* st;
};

__device__ __forceinline__ XcdBarrier xcd_barrier_post(unsigned* bar, volatile LAS unsigned* st) {
    XcdBarrier b; b.bar = bar; b.x = xb_xcc_id(); b.st = st;
    if (threadIdx.x == 0) (void)xb_add(&bar[XB_XCNT(b.x)], 1u);
    return b;
}
__device__ __forceinline__ void xcd_barrier_complete(unsigned* bar, unsigned x, unsigned& nloc, unsigned& nx) {
    const unsigned G = gridDim.x * gridDim.y * gridDim.z;
    unsigned sum, cnt, mine, sp = 0u;
    for (;;) {
        sum = 0u; cnt = 0u; mine = 0u;
#pragma unroll
        for (unsigned j = 0; j < 16; ++j) { const unsigned c = xb_ld(&bar[XB_XCNT(j)]); sum += c; cnt += (c > 0u) ? 1u : 0u; mine = (j == x) ? c : mine; }
        if (sum == G) break;
        __builtin_amdgcn_s_sleep(1);
        if ((++sp & 255u) == 0u) { if (xb_ld(&bar[XB_TMO])) break; if (sp > XB_SPIN_CAP) { atomicAdd(&bar[XB_TMO], 1u); break; } }
    }
    nloc = mine > 0u ? mine : 1u; nx = cnt > 0u ? cnt : 1u;
}

__device__ __forceinline__ void xcd_barrier(const XcdBarrier& b) {
    asm volatile("s_waitcnt vmcnt(0)" ::: "memory");
    __syncthreads();
    if (threadIdx.x == 0) {
        unsigned* bar = b.bar;
        __builtin_amdgcn_s_waitcnt(0);
        unsigned nloc = b.st[0], nx = b.st[1];
        if (nloc == 0u) { xcd_barrier_complete(bar, b.x, nloc, nx); b.st[0] = nloc; b.st[1] = nx; }
        const unsigned old = xb_add(&bar[XB_XSUB(b.x)], 1u);
        const unsigned gen = old / nloc;
        if (old + 1u == (gen + 1u) * nloc) {
            __builtin_amdgcn_fence(__ATOMIC_RELEASE, "agent");
            asm volatile("s_waitcnt vmcnt(0)" ::: "memory");
            const unsigned og = xb_add(&bar[XB_TOP], 1u);
            const unsigned tg = og / nx;
            if (og + 1u == (tg + 1u) * nx) xb_add(&bar[XB_TOPGEN], 1u);
            else XB_SPIN(xb_ld(&bar[XB_TOPGEN]) == tg, bar);
            __builtin_amdgcn_fence(__ATOMIC_ACQUIRE, "agent");
            xb_add(&bar[XB_XGEN(b.x)], 1u);
            asm volatile("s_waitcnt vmcnt(0)" ::: "memory");
        } else {
            XB_SPIN(xb_ld(&bar[XB_XGEN(b.x)]) == gen, bar);
            __builtin_amdgcn_fence(__ATOMIC_ACQUIRE, "agent");
            asm volatile("s_waitcnt vmcnt(0)" ::: "memory");
        }
    }
    __syncthreads();
}

__device__ __forceinline__ float wave_sum(float v) {
#pragma unroll
    for (int o = 1; o < 64; o <<= 1) v += __shfl_xor(v, o);
    return v;
}
__device__ __forceinline__ float wave_max(float v) {
#pragma unroll
    for (int o = 1; o < 64; o <<= 1) v = fmaxf(v, __shfl_xor(v, o));
    return v;
}
__device__ __forceinline__ int dest_block(int blk, int map) {
    if (map == 1) { const int s = blk & 7; return (blk & ~7) + 4 * (s & 1) + (s >> 1); }
    if (map == 2) return (blk >> 2) * 8 + (blk & 3);
    if (map == 3) return (blk >> 2) * 8 + 4 + (blk & 3);
    return blk;
}
__device__ __forceinline__ void tr_tile(const float* W, int K, int N, bf16* WT, int map, const float* gain, LAS unsigned* scr, int item, int lane) {
    const int nblk = N / 64, kb = item / nblk, nb = item % nblk, k0 = 64 * kb, n0 = 64 * nb;
    const int c = lane & 15, ip = lane >> 4;
#pragma unroll
    for (int it = 0; it < 8; ++it) { const int kp = it * 4 + ip, k = k0 + 2 * kp;
        f32x4 a = *(const GAS f32x4*)(W + (size_t)k * N + n0 + 4 * c), b = *(const GAS f32x4*)(W + (size_t)(k + 1) * N + n0 + 4 * c);
        if (gain) { a = a * gain[k]; b = b * gain[k + 1]; }
#pragma unroll
        for (int j = 0; j < 4; ++j) scr[(4 * c + j) * 33 + kp] = pk2(a[j], b[j]); }
    LDS_WAIT(); asm volatile("" ::: "memory");
#pragma unroll
    for (int it = 0; it < 8; ++it) { const int n = it * 8 + (lane >> 3), q = lane & 7;
        v4u o; o.x = scr[n * 33 + 4 * q]; o.y = scr[n * 33 + 4 * q + 1]; o.z = scr[n * 33 + 4 * q + 2]; o.w = scr[n * 33 + 4 * q + 3];
        const int drow = dest_block((n0 + n) >> 5, map) * 32 + (n & 31);
        *(GAS v4u*)(WT + (size_t)drow * K + k0 + 8 * q) = o; }
    LDS_WAIT(); asm volatile("" ::: "memory");
}

__device__ __forceinline__ void tr_tile8(const float* W, int K, int N, unsigned char* WT, int map, const float* gain, float wscale, LAS unsigned* scr, int item, int lane) {
    const int nblk = N / 64, kb = item / nblk, nb = item % nblk, k0 = 64 * kb, n0 = 64 * nb;
    const int c = lane & 15, ip = lane >> 4;
#pragma unroll
    for (int it = 0; it < 4; ++it) { const int k4 = it * 4 + ip, k = k0 + 4 * k4; f32x4 a[4];
#pragma unroll
        for (int i = 0; i < 4; ++i) a[i] = *(const GAS f32x4*)(W + (size_t)(k + i) * N + n0 + 4 * c) * ((gain ? gain[k + i] : 1.f) * wscale);
#pragma unroll
        for (int j = 0; j < 4; ++j) scr[(4 * c + j) * 17 + k4] = pg8::pk4_fp8(a[0][j], a[1][j], a[2][j], a[3][j]); }
    LDS_WAIT(); asm volatile("" ::: "memory");
#pragma unroll
    for (int it = 0; it < 4; ++it) { const int n = it * 16 + (lane >> 2), q = lane & 3;
        v4u o; o.x = scr[n * 17 + 4 * q]; o.y = scr[n * 17 + 4 * q + 1]; o.z = scr[n * 17 + 4 * q + 2]; o.w = scr[n * 17 + 4 * q + 3];
        const int drow = dest_block((n0 + n) >> 5, map) * 32 + (n & 31);
        *(GAS v4u*)(WT + (size_t)drow * K + k0 + 16 * q) = o; }
    LDS_WAIT(); asm volatile("" ::: "memory");
}

struct TrItem { const float* W; unsigned char* WT; const float* gain; int K, N, map, fp8, k0, n0; float scale; };
__device__ __forceinline__ void tr_load(const TrItem& d, f32x4 (&a)[16], float (&g)[16], int lane) {
    const int c = lane & 15, ip = lane >> 4;
#pragma unroll
    for (int it = 0; it < 4; ++it)
#pragma unroll
        for (int i = 0; i < 4; ++i) { const int k = d.k0 + 4 * (it * 4 + ip) + i;
            a[it * 4 + i] = *(const GAS f32x4*)(d.W + (size_t)k * d.N + d.n0 + 4 * c); g[it * 4 + i] = d.gain ? d.gain[k] : 1.f; }
}
__device__ __forceinline__ void tr_emit(const TrItem& d, const f32x4 (&a)[16], const float (&g)[16], LAS unsigned* scr, int lane) {
    const int c = lane & 15, ip = lane >> 4;
    if (d.fp8) {
#pragma unroll
        for (int it = 0; it < 4; ++it) { const int k4 = it * 4 + ip;
#pragma unroll
            for (int j = 0; j < 4; ++j) scr[(4 * c + j) * 17 + k4] = pg8::pk4_fp8(a[it * 4][j] * (g[it * 4] * d.scale), a[it * 4 + 1][j] * (g[it * 4 + 1] * d.scale), a[it * 4 + 2][j] * (g[it * 4 + 2] * d.scale), a[it * 4 + 3][j] * (g[it * 4 + 3] * d.scale)); }
        LDS_WAIT(); asm volatile("" ::: "memory");
#pragma unroll
        for (int it = 0; it < 4; ++it) { const int n = it * 16 + (lane >> 2), q = lane & 3;
            v4u o; o.x = scr[n * 17 + 4 * q]; o.y = scr[n * 17 + 4 * q + 1]; o.z = scr[n * 17 + 4 * q + 2]; o.w = scr[n * 17 + 4 * q + 3];
            const int drow = dest_block((d.n0 + n) >> 5, d.map) * 32 + (n & 31);
            *(GAS v4u*)(d.WT + (size_t)drow * d.K + d.k0 + 16 * q) = o; }
    } else {
#pragma unroll
        for (int it = 0; it < 4; ++it) { const int k4 = it * 4 + ip;
#pragma unroll
            for (int j = 0; j < 4; ++j) { scr[(4 * c + j) * 33 + 2 * k4] = pk2(a[it * 4][j] * g[it * 4], a[it * 4 + 1][j] * g[it * 4 + 1]); scr[(4 * c + j) * 33 + 2 * k4 + 1] = pk2(a[it * 4 + 2][j] * g[it * 4 + 2], a[it * 4 + 3][j] * g[it * 4 + 3]); } }
        LDS_WAIT(); asm volatile("" ::: "memory");
#pragma unroll
        for (int it = 0; it < 8; ++it) { const int n = it * 8 + (lane >> 3), q = lane & 7;
            v4u o; o.x = scr[n * 33 + 4 * q]; o.y = scr[n * 33 + 4 * q + 1]; o.z = scr[n * 33 + 4 * q + 2]; o.w = scr[n * 33 + 4 * q + 3];
            const int drow = dest_block((d.n0 + n) >> 5, d.map) * 32 + (n & 31);
            *(GAS v4u*)(d.WT + ((size_t)drow * d.K + d.k0 + 8 * q) * 2) = o; }
    }
    LDS_WAIT(); asm volatile("" ::: "memory");
}
constexpr float AO8_SCALE = 16.f;
constexpr float W8_SCALE = 64.f;

#ifndef PROBE_MASK
#define PROBE_MASK 0
#endif
struct KArgs { const void* in[27]; float* out; unsigned char* ws; int ph_lo, ph_hi, flags, pad; };

__global__ void __launch_bounds__(NTHR, 2) fwd_kernel(KArgs args) {
    extern __shared__ __attribute__((aligned(16))) unsigned char lds_raw[];
    LAS unsigned char* lds = (LAS unsigned char*)lds_raw;
    volatile LAS unsigned* MISC = (volatile LAS unsigned*)(lds + MISC_OFF);
    const int tid = threadIdx.x, lane = tid & 63, wave = __builtin_amdgcn_readfirstlane(tid >> 6);
    const int G = gridDim.x; const int bx = blockIdx.x; const int vcu = (G % 8 == 0) ? (bx % 8) * (G / 8) + bx / 8 : bx;
    unsigned char* ws = args.ws;
    unsigned* ctl = (unsigned*)ws;
    for (int u = tid; u < (LDS_BYTES - RING_BYTES) / 4; u += NTHR) ((LAS unsigned*)(lds + RING_BYTES))[u] = 0u;
    __syncthreads();
    XcdBarrier bar = xcd_barrier_post(ctl + CW_BAR, MISC + 8);
    const int lo = args.ph_lo, hi_ph = args.ph_hi;
#define IN(k) (lo <= (k) && (k) < hi_ph)
#define REP(k)
#define SEAM(k) do { if (IN(k) && IN((k) + 1)) xcd_barrier(bar); } while (0)
    const float* x_in = (const float*)args.in[0]; const int* positions = (const int*)args.in[1];
    const float* ev_attn_norm = (const float*)args.in[2]; const float* ev_w_in = (const float*)args.in[3];
    const float* ev_q_norm = (const float*)args.in[4]; const float* ev_k_norm = (const float*)args.in[5];
    const float* ev_lq1 = (const float*)args.in[6]; const float* ev_lk1 = (const float*)args.in[7]; const float* ev_lq2 = (const float*)args.in[8]; const float* ev_lk2 = (const float*)args.in[9];
    const float* ev_subln = (const float*)args.in[10]; const float* ev_w_out = (const float*)args.in[11]; const float* ev_ffn_norm = (const float*)args.in[12];
    const float* ev_w_gate = (const float*)args.in[13]; const float* ev_w_up = (const float*)args.in[14]; const float* ev_w_down = (const float*)args.in[15];
    const float* od_attn_norm = (const float*)args.in[16]; const float* od_w_qkv = (const float*)args.in[17];
    const float* od_q_norm = (const float*)args.in[18]; const float* od_k_norm = (const float*)args.in[19]; const float* od_rel_bias = (const float*)args.in[20];
    const float* od_w_out = (const float*)args.in[21]; const float* od_ffn_norm = (const float*)args.in[22]; const float* od_router = (const float*)args.in[23];
    const float* od_we_gate = (const float*)args.in[24]; const float* od_we_up = (const float*)args.in[25]; const float* od_we_down = (const float*)args.in[26];
    float* out = args.out;
    float* ss0 = (float*)(ws + WS_SS0); float* ss1 = (float*)(ws + WS_SS1); float* ss2 = (float*)(ws + WS_SS2); float* ss3 = (float*)(ws + WS_SS3);
    float* rope = (float*)(ws + WS_ROPE); unsigned* toksel = (unsigned*)(ws + WS_TOKSEL); float* tokgate = (float*)(ws + WS_TOKGATE);
    int* rowtok = (int*)(ws + WS_ROWTOK); float* rowgate = (float*)(ws + WS_ROWGATE);
    bf16* XB = (bf16*)(ws + WS_XB); bf16* AO = (bf16*)(ws + WS_AO); bf16* ACT0 = (bf16*)(ws + WS_ACT0); float* XF = (float*)(ws + WS_XF); bf16* OD = (bf16*)(ws + WS_XF);
    bf16* Win_t = (bf16*)(ws + WS_WIN); bf16* Wo0_t = (bf16*)(ws + WS_WO0); bf16* Wgu0_t = (bf16*)(ws + WS_WGU0); bf16* Wd0_t = (bf16*)(ws + WS_WD0);
    unsigned char* Wqkv8 = ws + WS_WQKV; unsigned char* Wo18 = ws + WS_WO1; unsigned char* XB8 = ws + WS_XB; unsigned char* AO8 = ws + WS_AO; unsigned char* WEgu8 = ws + WS_WEGU; unsigned char* WEd8 = ws + WS_WED;
    unsigned char* SORTA8 = ws + WS_SORTA; unsigned char* ACTE8 = ws + WS_ACTE;
    const int gw = vcu * NWAVES + wave, NGW = G * NWAVES;

    constexpr int I_IN = 16 * 48, I_O = 16 * 16, I_G = 16 * 44, I_D = 44 * 16, I_EG = 16 * 56, I_ED = 56 * 16;
    constexpr int NSMALL = I_IN + I_O + 2 * I_G + I_D + I_IN + I_O, NITEMS = NSMALL + 24 * I_EG;
        auto decode = [&](int it) -> TrItem {
        TrItem d; int r = it; d.scale = 1.f; d.fp8 = 0; d.gain = nullptr; d.map = 0;
        auto fin = [&](int nbl) { d.k0 = 64 * (r / nbl); d.n0 = 64 * (r % nbl); };
        if (r < I_IN) { d.W = ev_w_in; d.K = D; d.N = NPROJ; d.WT = (unsigned char*)Win_t; d.map = 1; d.gain = ev_attn_norm; fin(NPROJ / 64); return d; } r -= I_IN;
        if (r < I_O) { d.W = ev_w_out; d.K = D; d.N = D; d.WT = (unsigned char*)Wo0_t; fin(D / 64); return d; } r -= I_O;
        if (r < I_G) { d.W = ev_w_gate; d.K = D; d.N = FFD; d.WT = (unsigned char*)Wgu0_t; d.map = 2; d.gain = ev_ffn_norm; fin(FFD / 64); return d; } r -= I_G;
        if (r < I_G) { d.W = ev_w_up; d.K = D; d.N = FFD; d.WT = (unsigned char*)Wgu0_t; d.map = 3; d.gain = ev_ffn_norm; fin(FFD / 64); return d; } r -= I_G;
        if (r < I_D) { d.W = ev_w_down; d.K = FFD; d.N = D; d.WT = (unsigned char*)Wd0_t; fin(D / 64); return d; } r -= I_D;
        d.fp8 = 1; d.scale = W8_SCALE;
        if (r < I_IN) { d.W = od_w_qkv; d.K = D; d.N = NPROJ; d.WT = Wqkv8; d.map = 1; d.gain = od_attn_norm; fin(NPROJ / 64); return d; } r -= I_IN;
        if (r < I_O) { d.W = od_w_out; d.K = D; d.N = D; d.WT = Wo18; fin(D / 64); return d; } r -= I_O;
        const int which = r / (8 * I_EG), rr = r % (8 * I_EG), e2 = rr / I_EG; r = rr % I_EG;
        if (which == 0) { d.W = od_we_gate + (size_t)e2 * D * FFE; d.K = D; d.N = FFE; d.WT = WEgu8 + (size_t)e2 * 2 * FFE * D; d.map = 2; d.gain = od_ffn_norm; fin(FFE / 64); }
        else if (which == 1) { d.W = od_we_up + (size_t)e2 * D * FFE; d.K = D; d.N = FFE; d.WT = WEgu8 + (size_t)e2 * 2 * FFE * D; d.map = 3; d.gain = od_ffn_norm; fin(FFE / 64); }
        else { d.W = od_we_down + (size_t)e2 * FFE * D; d.K = FFE; d.N = D; d.WT = WEd8 + (size_t)e2 * D * FFE; fin(D / 64); }
        return d; };
    auto conv_range = [&](int first, int end, int stride) {
        LAS unsigned* scr = (LAS unsigned*)(lds + wave * 8704);
        f32x4 bufA[16], bufB[16]; float gA[16], gB[16]; TrItem dA, dB; int it = first;
        if (it < end) { dA = decode(it); tr_load(dA, bufA, gA, lane); }
        while (it < end) {
            const int it2 = it + stride, it3 = it2 + stride;
            if (it2 < end) { dB = decode(it2); tr_load(dB, bufB, gB, lane); }
            tr_emit(dA, bufA, gA, scr, lane);
            if (it3 < end) { dA = decode(it3); tr_load(dA, bufA, gA, lane); }
            if (it2 < end) tr_emit(dB, bufB, gB, scr, lane);
            it = it3; } };
    auto pull = [&](int qword) -> int {
        __syncthreads(); if (tid == 0) MISC[16] = __hip_atomic_fetch_add(ctl + qword, 1u, __ATOMIC_RELAXED, __HIP_MEMORY_SCOPE_AGENT); __syncthreads();
        return __builtin_amdgcn_readfirstlane((int)MISC[16]); };

    REP(0) if (IN(0)) {
        conv_range(gw, I_IN, NGW);
        for (int m = gw; m < T; m += NGW) {
            const GAS f32x4* xr = (const GAS f32x4*)(x_in + (size_t)m * D) + lane; f32x4 v[4]; float s = 0.f;
#pragma unroll
            for (int j = 0; j < 4; ++j) { v[j] = xr[64 * j]; s += (v[j].x * v[j].x + v[j].y * v[j].y) + (v[j].z * v[j].z + v[j].w * v[j].w); }
            s = wave_sum(s); if (lane == 0) ss0[m] = s;
            GAS unsigned long long* o8 = (GAS unsigned long long*)(XB + (size_t)m * D) + lane;
#pragma unroll
            for (int j = 0; j < 4; ++j) o8[64 * j] = (unsigned long long)pk2(v[j].x, v[j].y) | ((unsigned long long)pk2(v[j].z, v[j].w) << 32);
        }
        for (int i = vcu * NTHR + tid; i < T * 8; i += G * NTHR) {
            const int tok = i >> 3, f = i & 7;
            const double inv = exp2(-(double)f * (18.931568569324174 / 8.0));
            double ang = (double)positions[tok] * inv; ang -= 6.283185307179586 * rint(ang * 0.15915494309189535);
            float sn, cs; sincosf((float)ang, &sn, &cs);
            rope[(size_t)tok * 16 + f] = cs; rope[(size_t)tok * 16 + 8 + f] = sn;
        }
    }
    SEAM(0);

    REP(1) if (IN(1)) {
        pg8::Gemm g{XB, Win_t, T, NPROJ, D}; pg8::StaticOrder S; S.init(T, NPROJ, G, bx);
        pg8::EpiProj E{ACT0, T, ss0, 1, ev_q_norm, ev_k_norm, rope, 0, 1.f};
        pg8::gemm_phase<pg8::EpiProj, pg8::StaticOrder, true, true>(lds, g, S, E);
    }
    SEAM(1);

    REP(2) if (IN(2)) {
        const float gqm = wave_max(fabsf(ev_q_norm[lane])), gkm = wave_max(fabsf(ev_k_norm[lane]));
        const float mref = 8.f * gqm * gkm * pg8::LOG2E;
        constexpr int NJOBS = (NITEMS - I_IN + 63) / 64;
        const bool conv_first = ((bx >> 3) & 3) == 3;
#define P2_CONV_LOOP() for (;;) { const int j = pull(CW_QCONV); if (j >= NJOBS) break; \
            const int first = I_IN + j * 64 + wave * 8; conv_range(first, (first + 8 < NITEMS) ? first + 8 : NITEMS, 1); }
        if (conv_first) P2_CONV_LOOP()
#pragma unroll 1
        for (int kq = 0; kq < 8; ++kq) { const int xq = (bx + kq) & 7;
            for (;;) { const int idx = pull(CW_QATT + 64 * xq); if (idx >= 128) break;
                if (idx < 64) { if (args.flags & 1) continue;
                    const int bhm = 2 * xq + (idx & 1), qb = 31 - (idx >> 1);
                    const int b = bhm >> 3, hm = bhm & 7, h = hm >> 1;
                    const bf16* base = ACT0 + (size_t)b * SEQ * 64;
                    att::attn_unit<0, 128, false, 1>((LAS char*)lds, base + (size_t)(24 + hm) * T * 64, base + (size_t)(32 + hm) * T * 64, base + (size_t)(40 + 2 * h) * T * 64, OD + (size_t)b * SEQ * D + hm * 128, D, qb * 256, mref, nullptr);
                } else { if (args.flags & 2) continue;
                    const int bh = 2 * xq + (idx & 1), qb = 31 - ((idx - 64) >> 1);
                    const int b = bh >> 3, h = bh & 7;
                    const bf16* base = ACT0 + (size_t)b * SEQ * 64;
                    att::attn_unit<2, 64>((LAS char*)lds, base + (size_t)h * T * 64, base + (size_t)(8 + h) * T * 64, base + (size_t)(16 + h) * T * 64, AO + (size_t)b * SEQ * D + h * 64, D, qb * 256, 0.f, nullptr);
                }
            }
        }
        P2_CONV_LOOP()
#undef P2_CONV_LOOP
    }
    SEAM(2);

    REP(3) if (IN(3)) {
        const float a1 = wave_sum(ev_lq1[lane] * ev_lk1[lane]), a2 = wave_sum(ev_lq2[lane] * ev_lk2[lane]);
        const float lam_init = 0.2f, lam = expf(a1) - expf(a2) + lam_init;
        const int h = lane >> 4, v0 = (lane & 15) * 8;
        float sg[8];
#pragma unroll
        for (int j = 0; j < 8; ++j) sg[j] = ev_subln[v0 + j] * (1.f - lam_init);
        for (int m = gw; m < T; m += NGW) {
            const v4u a = *(const GAS v4u*)(OD + (size_t)m * D + (2 * h) * 128 + v0), b = *(const GAS v4u*)(OD + (size_t)m * D + (2 * h + 1) * 128 + v0);
            float d[8]; float s = 0.f;
#pragma unroll
            for (int j = 0; j < 4; ++j) { const unsigned ua = a[j], ub = b[j];
                d[2 * j] = bf2f((unsigned short)(ua & 0xffffu)) - lam * bf2f((unsigned short)(ub & 0xffffu));
                d[2 * j + 1] = bf2f((unsigned short)(ua >> 16)) - lam * bf2f((unsigned short)(ub >> 16));
                s += d[2 * j] * d[2 * j] + d[2 * j + 1] * d[2 * j + 1]; }
            s += __shfl_xor(s, 1); s += __shfl_xor(s, 2); s += __shfl_xor(s, 4); s += __shfl_xor(s, 8);
            const float rs = rsqrtf(s * (1.f / 128.f) + pg8::RMS_EPS);
            v4u o; o.x = pk2(d[0] * rs * sg[0], d[1] * rs * sg[1]); o.y = pk2(d[2] * rs * sg[2], d[3] * rs * sg[3]); o.z = pk2(d[4] * rs * sg[4], d[5] * rs * sg[5]); o.w = pk2(d[6] * rs * sg[6], d[7] * rs * sg[7]);
            *(GAS v4u*)(AO + (size_t)m * D + 512 + h * 128 + v0) = o;
        }
    }
    SEAM(3);

    REP(4) if (IN(4)) {
        pg8::Gemm g{AO, Wo0_t, T, D, D}; pg8::StaticOrder S; S.init(T, D, G, bx);
        pg8::EpiResid E{x_in, XF, XB, ss1, 1.f, nullptr};
        pg8::gemm_phase<pg8::EpiResid, pg8::StaticOrder, false, true>(lds, g, S, E);
    }
    SEAM(4);

    REP(5) if (IN(5)) {
        pg8::Gemm g{XB, Wgu0_t, T, 2 * FFD, D}; pg8::StaticOrder S; S.init(T, 2 * FFD, G, bx);
        pg8::EpiSwiglu<false> E{ACT0, FFD, ss1, 16, nullptr, 0, 2 * FFD / 256, 1.f};
        pg8::gemm_phase<pg8::EpiSwiglu<false>, pg8::StaticOrder, true, true>(lds, g, S, E);
    }
    SEAM(5);

    if (IN(6)) {
        pg8::Gemm g{ACT0, Wd0_t, T, D, FFD}; pg8::StaticOrder S; S.init(T, D, G, bx);
        pg8::EpiResid E{XF, XF, nullptr, ss2, 1.f, XB8};
        pg8::gemm_phase<pg8::EpiResid, pg8::StaticOrder, false, true>(lds, g, S, E);
    }
    SEAM(6);

    REP(7) if (IN(7)) {
        pg8::Gemm g{(const bf16*)XB8, (const bf16*)Wqkv8, T, NPROJ, D / 2}; pg8::StaticOrder S; S.init(T, NPROJ, G, bx);
        pg8::EpiProj E{ACT0, T, ss2, 16, od_q_norm, od_k_norm, nullptr, 1, 1.f / W8_SCALE};
        pg8::gemm_phase<pg8::EpiProj, pg8::StaticOrder, true, true, true>(lds, g, S, E);
    }
    SEAM(7);

    REP(8) if (IN(8)) {
        const float gqm = wave_max(fabsf(od_q_norm[lane])), gkm = wave_max(fabsf(od_k_norm[lane]));
        for (int L = vcu; L < 1024; L += G) {
            const int bh = (L & 255) >> 3, qb = 4 * (L & 7) + (L >> 8);
            const int b = bh >> 4, h = bh & 15;
            const float* tab = od_rel_bias + h * 257;
            float tm = fabsf(tab[lane]); tm = fmaxf(tm, fabsf(tab[64 + lane])); tm = fmaxf(tm, fabsf(tab[128 + lane])); tm = fmaxf(tm, fabsf(tab[192 + lane])); tm = fmaxf(tm, fabsf(tab[256]));
            tm = wave_max(tm);
            const float mref = (8.f * gqm * gkm + tm) * pg8::LOG2E;
            const bf16* base = ACT0 + (size_t)b * SEQ * 64;
            att::attn_unit<1, 64, true, 1>((LAS char*)lds, base + (size_t)h * T * 64, base + (size_t)(16 + h) * T * 64, base + (size_t)(32 + h) * T * 64, AO8 + (size_t)b * SEQ * D + h * 64, D, qb * 256, mref, tab, AO8_SCALE);
        }
    }
    SEAM(8);

    REP(9) if (IN(9)) {
        pg8::Gemm g{(const bf16*)AO8, (const bf16*)Wo18, T, D, D / 2}; pg8::StaticOrder S; S.init(T, D, G, bx);
        pg8::EpiResid E{XF, out, nullptr, nullptr, 1.f / (W8_SCALE * AO8_SCALE), nullptr};
        pg8::gemm_phase<pg8::EpiResid, pg8::StaticOrder, false, true, true>(lds, g, S, E);
    }
    SEAM(9);

    REP(10) if (IN(10)) {
        LAS float* wrT = (LAS float*)lds;
        LAS unsigned* sel = (LAS unsigned*)(lds + 32768);
        for (int i = tid; i < 1024; i += NTHR) { const float gn = od_ffn_norm[i]; const f32x4 w0 = *(const GAS f32x4*)(od_router + (size_t)i * 8), w1 = *(const GAS f32x4*)(od_router + (size_t)i * 8 + 4);
            wrT[i] = w0.x * gn; wrT[1024 + i] = w0.y * gn; wrT[2048 + i] = w0.z * gn; wrT[3072 + i] = w0.w * gn; wrT[4096 + i] = w1.x * gn; wrT[5120 + i] = w1.y * gn; wrT[6144 + i] = w1.z * gn; wrT[7168 + i] = w1.w * gn; }
        __syncthreads();
        for (int blk = vcu; blk < T / 64; blk += G) {
#pragma unroll 1
            for (int q4 = 0; q4 < 2; ++q4) {
                const int tok0 = blk * 64 + wave * 8 + q4 * 4;
                f32x4 xv[4][4]; float s[4]; float lg[4][8];
#pragma unroll
                for (int t4 = 0; t4 < 4; ++t4) { const GAS f32x4* xr = (const GAS f32x4*)(out + (size_t)(tok0 + t4) * D) + lane;
#pragma unroll
                    for (int j = 0; j < 4; ++j) xv[t4][j] = xr[64 * j]; }
#pragma unroll
                for (int t4 = 0; t4 < 4; ++t4) { s[t4] = 0.f;
#pragma unroll
                    for (int e2 = 0; e2 < 8; ++e2) lg[t4][e2] = 0.f;
#pragma unroll
                    for (int j = 0; j < 4; ++j) { const f32x4 v = xv[t4][j]; s[t4] += (v.x * v.x + v.y * v.y) + (v.z * v.z + v.w * v.w); } }
#pragma unroll
                for (int j = 0; j < 4; ++j)
#pragma unroll
                    for (int e2 = 0; e2 < 8; ++e2) { const f32x4 w = *(const LAS f32x4*)(wrT + e2 * 1024 + 256 * j + 4 * lane);
#pragma unroll
                        for (int t4 = 0; t4 < 4; ++t4) { const f32x4 v = xv[t4][j]; lg[t4][e2] += (v.x * w.x + v.y * w.y) + (v.z * w.z + v.w * w.w); } }
#pragma unroll
                for (int t4 = 0; t4 < 4; ++t4) { s[t4] = wave_sum(s[t4]);
#pragma unroll
                    for (int e2 = 0; e2 < 8; ++e2) lg[t4][e2] = wave_sum(lg[t4][e2]); }
                if (lane == 0) {
#pragma unroll
                    for (int t4 = 0; t4 < 4; ++t4) { const int tok = tok0 + t4;
                        const float r = rsqrtf(s[t4] * (1.f / 1024.f) + pg8::RMS_EPS); ss3[tok] = s[t4];
                        int e0 = 0; float v0 = lg[t4][0];
#pragma unroll
                        for (int e2 = 1; e2 < 8; ++e2) if (lg[t4][e2] > v0) { v0 = lg[t4][e2]; e0 = e2; }
                        int e1 = -1; float v1 = 0.f;
#pragma unroll
                        for (int e2 = 0; e2 < 8; ++e2) if (e2 != e0 && (e1 < 0 || lg[t4][e2] > v1)) { v1 = lg[t4][e2]; e1 = e2; }
                        const float ex = expf((v1 - v0) * r), g0 = 1.f / (1.f + ex), g1 = ex / (1.f + ex);
                        sel[wave * 8 + q4 * 4 + t4] = (unsigned)e0 | ((unsigned)e1 << 8); tokgate[2 * tok] = g0; tokgate[2 * tok + 1] = g1; }
                }
            }
            __syncthreads();
            if (wave == 0) { const unsigned sv = sel[lane]; const int e0 = sv & 0xff, e1 = sv >> 8; unsigned rank0 = 0, rank1 = 0;
                const unsigned long long lt = (1ull << lane) - 1ull;
#pragma unroll
                for (int e = 0; e < 8; ++e) { const unsigned long long m0 = __ballot(e0 == e), m1 = __ballot(e1 == e);
                    if (e0 == e) rank0 = __popcll(m0 & lt); if (e1 == e) rank1 = __popcll(m1 & lt);
                    if (lane == 0) { ctl[CW_HIST + blk * 16 + e] = __popcll(m0); ctl[CW_HIST + blk * 16 + 8 + e] = __popcll(m1); } }
                toksel[blk * 64 + lane] = sv | (rank0 << 16) | (rank1 << 24); }
            __syncthreads();
        }
    }
    SEAM(10);

    REP(11) if (IN(11)) {
        LAS unsigned* hs = (LAS unsigned*)lds;
        for (int i = tid; i < 4096; i += NTHR) hs[i] = ctl[CW_HIST + i];
        __syncthreads();
        if (tid < 16) hs[4096 + tid] = 0u;
        __syncthreads();
        { unsigned s = 0; const int g2 = tid & 15;
#pragma unroll
          for (int b2 = tid >> 4; b2 < 256; b2 += 32) s += hs[b2 * 16 + g2];
          atomicAdd((unsigned*)&hs[4096 + g2], s); }
        __syncthreads();
        if (tid == 0) { unsigned acc = 0; for (int g2 = 0; g2 < 16; ++g2) { hs[4128 + g2] = acc; acc += (hs[4096 + g2] + 255u) & ~255u; } hs[4128 + 16] = acc; }
        __syncthreads();
        if (bx == 0) {
            if (tid == 0) { ctl[CW_MOE] = hs[4128 + 8] >> 8; ctl[CW_MOE + 1] = hs[4128 + 16] >> 8; }
            if (tid < 16) { const unsigned t0 = hs[4128 + tid] >> 8, t1 = hs[4128 + tid + 1] >> 8; for (unsigned t = t0; t < t1; ++t) ctl[CW_MOE + 16 + t] = tid & 7; }
        }
        for (int blk = vcu; blk < T / 64; blk += G) {
            if (tid < 16) hs[4160 + tid] = 0u;
            __syncthreads();
            { unsigned s = 0; const int g2 = tid & 15;
#pragma unroll
              for (int b2 = tid >> 4; b2 < 256; b2 += 32) s += (b2 < blk) ? hs[b2 * 16 + g2] : 0u;
              atomicAdd((unsigned*)&hs[4160 + g2], s); }
            __syncthreads();
            for (int tl = wave; tl < 64; tl += NWAVES) {
                const int tok = blk * 64 + tl; const unsigned sv = toksel[tok];
                const GAS f32x4* xr = (const GAS f32x4*)(out + (size_t)tok * D + 16 * lane); const f32x4 v0 = xr[0], v1 = xr[1], v2 = xr[2], v3 = xr[3];
                v4u pk; pk.x = pg8::pk4_fp8(v0[0], v0[1], v0[2], v0[3]); pk.y = pg8::pk4_fp8(v1[0], v1[1], v1[2], v1[3]); pk.z = pg8::pk4_fp8(v2[0], v2[1], v2[2], v2[3]); pk.w = pg8::pk4_fp8(v3[0], v3[1], v3[2], v3[3]);
#pragma unroll
                for (int sl = 0; sl < 2; ++sl) { const int e = (sv >> (8 * sl)) & 0xff, rank = (sv >> (16 + 8 * sl)) & 0xff, g2 = sl * 8 + e;
                    const unsigned srow = hs[4128 + g2] + hs[4160 + g2] + rank;
                    *(GAS v4u*)(SORTA8 + (size_t)srow * D + lane * 16) = pk;
                    if (lane == 0) { rowtok[srow] = tok; rowgate[srow] = tokgate[2 * tok + sl]; } }
            }
            __syncthreads();
        }
        for (int g2 = vcu; g2 < 16; g2 += G) {
            const unsigned r0 = hs[4128 + g2] + hs[4096 + g2], r1 = hs[4128 + g2 + 1];
            for (unsigned r = r0 + wave; r < r1; r += NWAVES) { if (lane == 0) { rowtok[r] = -1; rowgate[r] = 0.f; }
                *(GAS v4u*)(SORTA8 + (size_t)r * D + lane * 16) = (v4u){0u, 0u, 0u, 0u}; }
        }
    }
    SEAM(11);

    if (IN(12) || IN(13) || IN(14)) {
        const int nA = (int)__builtin_amdgcn_readfirstlane(ctl[CW_MOE]), nT = (int)__builtin_amdgcn_readfirstlane(ctl[CW_MOE + 1]), nB = nT - nA;
        const int* texp = (const int*)(ctl + CW_MOE + 16);
        unsigned char* ACTE8B = ACTE8 + (size_t)63 * MiB;
        if (IN(12)) {
            pg8::Gemm g{(const bf16*)SORTA8, (const bf16*)WEgu8, 0, 0, D / 2}; pg8::MoeOrder S; S.init(nA, 2 * FFE / 256, G, bx, 0, texp);
            pg8::EpiSwiglu<true> E{ACTE8, FFE, ss3, 1, rowtok, 0, 2 * FFE / 256, 1.f / W8_SCALE};
            pg8::gemm_phase<pg8::EpiSwiglu<true>, pg8::MoeOrder, true, true, true>(lds, g, S, E);
        }
        SEAM(12);
        if (IN(13)) {
            { pg8::Gemm g{(const bf16*)ACTE8, (const bf16*)WEd8, 0, 0, FFE / 2}; pg8::MoeOrder S; S.init(nA, D / 256, G, bx, 0, texp);
              pg8::EpiMoeDown E{out, rowtok, rowgate, 0, 1.f / W8_SCALE, (args.flags >> 2) & 1};
              pg8::gemm_phase<pg8::EpiMoeDown, pg8::MoeOrder, true, true, true>(lds, g, S, E); }
            { const int nd = nA * (D / 256), nu = nB * (2 * FFE / 256); int H = nd - G; int R = 0;
              if (H > 0 && H < G / 2) { const int rmax = (nu + (G - H) - 1) / (G - H); int best = 0x7fffffff;
                  for (int r2 = 0; r2 <= rmax; ++r2) { const int rest = nu - r2 * (G - H) > 0 ? nu - r2 * (G - H) : 0; const int light = 28 + 8 * r2, heavy = 56 + 8 * ((rest + H - 1) / H); const int mk = light > heavy ? light : heavy; if (mk < best) { best = mk; R = r2; } } } else H = 0;
              pg8::Gemm g{(const bf16*)(SORTA8 + (size_t)nA * 256 * D), (const bf16*)WEgu8, 0, 0, D / 2}; pg8::MoeOrder S; S.init(nB, 2 * FFE / 256, G, bx, nA, texp, H, R);
              pg8::EpiSwiglu<true> E{ACTE8B, FFE, ss3, 1, rowtok, nA, 2 * FFE / 256, 1.f / W8_SCALE};
              pg8::gemm_phase<pg8::EpiSwiglu<true>, pg8::MoeOrder, true, true, true>(lds, g, S, E); }
        }
        SEAM(13);
        if (IN(14)) {
            pg8::Gemm g{(const bf16*)ACTE8B, (const bf16*)WEd8, 0, 0, FFE / 2}; pg8::MoeOrder S; S.init(nB, D / 256, G, bx, nA, texp);
            pg8::EpiMoeDown E{out, rowtok, rowgate, nA, 1.f / W8_SCALE, (args.flags >> 2) & 1};
            pg8::gemm_phase<pg8::EpiMoeDown, pg8::MoeOrder, true, true, true>(lds, g, S, E);
        }
    }
#undef IN
#undef SEAM
}

constexpr int N_PHASES = 15;
extern "C" void kernel_launch(void* const* d_in, const int* in_sizes, int n_in, void* d_out, int out_size, void* d_ws, size_t ws_size, hipStream_t stream) {
    static int grid = 0;
    if (grid == 0) {
        if (n_in != 27 || out_size != T * D || ws_size < WS_END) { fprintf(stderr, "kernel_launch: unexpected problem (n_in %d, out %d, ws %zu)\n", n_in, out_size, ws_size); grid = -1; return; }
        int dev = 0, cus = 0, per_cu = 0;
        if (hipGetDevice(&dev) != hipSuccess || hipDeviceGetAttribute(&cus, hipDeviceAttributeMultiprocessorCount, dev) != hipSuccess) { grid = -1; return; }
        if (hipFuncSetAttribute((const void*)fwd_kernel, hipFuncAttributeMaxDynamicSharedMemorySize, LDS_BYTES) != hipSuccess) { fprintf(stderr, "kernel_launch: hipFuncSetAttribute failed\n"); grid = -1; return; }
        if (hipOccupancyMaxActiveBlocksPerMultiprocessor(&per_cu, (const void*)fwd_kernel, NTHR, LDS_BYTES) != hipSuccess || per_cu < 1) { fprintf(stderr, "kernel_launch: occupancy query says %d\n", per_cu); }
        (void)hipGetLastError();
        grid = cus;
    }
    if (grid < 0) return;
    (void)hipMemsetAsync(d_ws, 0, CTL_ZERO_BYTES, stream);
    KArgs a{};
    for (int i = 0; i < 27; ++i) a.in[i] = d_in[i];
    a.out = (float*)d_out; a.ws = (unsigned char*)d_ws; a.ph_lo = 0; a.ph_hi = N_PHASES;
    hipLaunchKernelGGL(fwd_kernel, dim3(grid), dim3(NTHR), LDS_BYTES, stream, a);
#if defined(PROBE_LO)
    (void)hipMemsetAsync((char*)d_ws + CW_BAR * 4, 0, XCD_BAR_WORDS * 4, stream); (void)hipMemsetAsync((char*)d_ws + CW_QATT * 4, 0, 4096, stream);
    a.ph_lo = PROBE_LO; a.ph_hi = PROBE_HI;
#if defined(PROBE_FLAGS)
    a.flags = PROBE_FLAGS;
#endif
    hipLaunchKernelGGL(fwd_kernel, dim3(grid), dim3(NTHR), LDS_BYTES, stream, a);
#endif
}
```

```cpp
#include <hip/hip_runtime.h>
#include <cstdio>
#include <cstdint>
#include <cmath>
#define PROBE_MASK 0x0
namespace pg8 {
#define PG8_LAS __attribute__((address_space(3)))
typedef unsigned short bf16_t;
typedef short bf16x8 __attribute__((ext_vector_type(8)));
typedef float f32x4 __attribute__((ext_vector_type(4)));
typedef unsigned u32x4 __attribute__((ext_vector_type(4)));
constexpr int BM = 256, BK = 64, HALF = 128, HTB = HALF * BK * 2  , STAGE_BYTES = 8 * HTB, NXCD = 8, WGM = 8;

__host__ __device__ __forceinline__ int lds_byte(int r, int c) { const int st = (r >> 4) * 2 + (c >> 5), rr = r & 15, cc = c & 31, ob = rr * 64 + cc * 2; return st * 1024 + (ob ^ (((ob >> 9) & 1) << 5)); }
__host__ __device__ __forceinline__ void stage_rc(int b, int& R, int& C) { const int st = b / 1024, sb = b % 1024, swz = sb ^ (((sb >> 9) & 1) << 5); R = (st >> 1) * 16 + swz / 64; C = (st & 1) * 32 + (swz % 64) / 2; }
__host__ __device__ __forceinline__ int perm32(int rho) { const int n = rho >> 4, i = rho & 15; return 8 * (i >> 2) + 4 * n + (i & 3); }

struct Unit { int pm, pn; };
struct Gemm { const bf16_t* A; const bf16_t* Bt; int M, N, K; };

struct StaticOrder {
    int nM, nN, nwg, G, c, hot;
    __host__ __device__ void init(int M, int N, int G_, int c_, int hot_ = 0) { nM = M / BM; nN = N / BM; nwg = nM * nN; G = G_; c = c_; hot = hot_; }
    __host__ __device__ bool next(int i, Unit& u) const {
        const long L = (long)i * G + c; if (L >= nwg) return false;
        int wgid = (int)L; { const int q = nwg / NXCD, r = nwg % NXCD, xcd = wgid % NXCD, off = wgid / NXCD; wgid = (xcd < r ? xcd * (q + 1) : r * (q + 1) + (xcd - r) * q) + off; }
        const int nig = WGM * nN, gid = wgid / nig, fm = gid * WGM, gsz = (nM - fm) < WGM ? (nM - fm) : WGM;
        u.pm = fm + ((wgid % nig) % gsz); u.pn = (wgid % nig) / gsz; if (hot) { u.pm &= 3; u.pn = 0; } return true;
    }
    __device__ __forceinline__ void a_ready(const Unit&) const {}
    __device__ __forceinline__ void done(const Unit&) const {}
};

struct MoeOrder {
    int nM, nN, nwg, G, c, tile0; const int* tile_expert;
    int H, R, mode;
    __device__ void init(int ntiles, int npn, int G_, int c_, int tile0_, const int* te, int H_ = 0, int R_ = 0, int mode_ = 1) { nM = ntiles; nN = npn; nwg = nM * nN; G = G_; c = c_; tile0 = tile0_; tile_expert = te; H = H_; R = R_; mode = mode_; }
    __device__ static __forceinline__ void plan(int nu, int H, int G, int ucost, int extra, int& mode, int& R) {
        mode = 1; R = 0; if (H <= 0 || H >= G) return;
        const int rmax = (nu + (G - H) - 1) / (G - H); int best = 0x7fffffff;
        for (int r2 = 0; r2 <= rmax; ++r2) { const int rest = nu - r2 * (G - H) > 0 ? nu - r2 * (G - H) : 0;
            { const int light = ucost * r2, heavy = extra + ucost * ((rest + H - 1) / H); const int mk = light > heavy ? light : heavy; if (mk < best) { best = mk; mode = 1; R = r2; } }
            { const int sh = (rest + G - 1) / G; const int light = ucost * (r2 + sh), heavy = extra + ucost * sh; const int mk = light > heavy ? light : heavy; if (mk < best) { best = mk; mode = 2; R = r2; } } }
    }
    __device__ bool next(int i, Unit& u) const {
        long L;
        if (H == 0) L = (long)i * G + c;
        else if (c >= H) { if (i < R) L = (long)i * (G - H) + (c - H); else if (mode == 2) L = (long)R * (G - H) + (long)(i - R) * G + c; else return false; }
        else L = (long)R * (G - H) + (long)i * (mode == 2 ? G : H) + c;
        if (L >= nwg) return false;
        int wgid = (int)L; { const int q = nwg / NXCD, r = nwg % NXCD, xcd = wgid % NXCD, off = wgid / NXCD; wgid = (xcd < r ? xcd * (q + 1) : r * (q + 1) + (xcd - r) * q) + off; }
        const int nig = WGM * nN, gid = wgid / nig, fm = gid * WGM, gsz = (nM - fm) < WGM ? (nM - fm) : WGM;
        u.pm = fm + ((wgid % nig) % gsz); const int pnl = (wgid % nig) / gsz;
        const int e = __builtin_amdgcn_readfirstlane(tile_expert[tile0 + u.pm]);
        u.pn = e * nN + pnl; return true;
    }
    __device__ __forceinline__ void a_ready(const Unit&) const {}
    __device__ __forceinline__ void done(const Unit&) const {}
};

__device__ __forceinline__ unsigned cvt_pk_bf16(float lo, float hi) { unsigned r; asm volatile("v_cvt_pk_bf16_f32 %0, %1, %2" : "=v"(r) : "v"(lo), "v"(hi)); return r; }
__device__ __forceinline__ u32x4 pack8(const f32x4& a, const f32x4& b) { u32x4 w; w.x = cvt_pk_bf16(a[0], a[1]); w.y = cvt_pk_bf16(a[2], a[3]); w.z = cvt_pk_bf16(b[0], b[1]); w.w = cvt_pk_bf16(b[2], b[3]); return w; }
__device__ __forceinline__ unsigned pk4_fp8(float a, float b, float c, float d) { int w = __builtin_amdgcn_cvt_pk_fp8_f32(a, b, 0, false); w = __builtin_amdgcn_cvt_pk_fp8_f32(c, d, w, true); return (unsigned)w; }
constexpr float RMS_EPS = 1e-6f;
constexpr float LOG2E = 1.4426950408889634f;
constexpr float C2 = 0.125f * LOG2E;
__device__ __forceinline__ float row_ss(const float* ss, int nparts, int row) {
    if (nparts == 1) return ss[row];
    const f32x4* p = (const f32x4*)(ss + (size_t)row * 16); f32x4 a = p[0], b = p[1], c = p[2], d = p[3]; a = (a + b) + (c + d); return (a[0] + a[1]) + (a[2] + a[3]);
}

struct EpiProj {
    static constexpr bool PERM = true, AFTER_DRAIN = false;
    bf16_t* O; int ldc; const float* ss; int nparts; const float* gq; const float* gk; const float* rope; int layer; float pre;
    __device__ __forceinline__ void operator()(const f32x4 (&acc)[2][2][4][2], const Unit& u, int wr, int wc, int fr, int fq) const {
        const int pn = u.pn; int kind = 0; float scale = 1.f; bool rope_on = false;
        if (layer == 0) { const int t = pn >> 1; if (t == 0) scale = C2; else if (t == 3) { kind = 1; scale = C2; rope_on = true; } else if (t == 4) { kind = 2; rope_on = true; } }
        else { const int t = pn >> 2; if (t == 0) { kind = 1; scale = C2; } else if (t == 1) kind = 2; }
        const float* gv = (kind == 1) ? gq : gk;
        f32x4 g[2][2];
#pragma unroll
        for (int bj = 0; bj < 2; ++bj)
#pragma unroll
            for (int n = 0; n < 2; ++n) g[bj][n] = kind ? *(const f32x4*)(gv + 32 * bj + 8 * fq + 4 * n) : (f32x4){1.f, 1.f, 1.f, 1.f};
        const int row0 = u.pm * BM + wr * 64 + fr, col0 = pn * BM + wc * 64 + 8 * fq;
#pragma unroll
        for (int ai = 0; ai < 2; ++ai)
#pragma unroll
            for (int m = 0; m < 4; ++m) {
                const int row = row0 + ai * HALF + m * 16;
                const float r = rsqrtf(row_ss(ss, nparts, row) * (1.f / 1024.f) + RMS_EPS) * pre;
                f32x4 v[2][2]; float s = 0.f;
#pragma unroll
                for (int bj = 0; bj < 2; ++bj)
#pragma unroll
                    for (int n = 0; n < 2; ++n) { v[bj][n] = acc[ai][bj][m][n] * r; const f32x4 x = v[bj][n]; s += (x[0] * x[0] + x[1] * x[1]) + (x[2] * x[2] + x[3] * x[3]); }
                if (kind) {
                    s += __shfl_xor(s, 16); s += __shfl_xor(s, 32);
                    const float rs = rsqrtf(s * (1.f / 64.f) + RMS_EPS);
#pragma unroll
                    for (int bj = 0; bj < 2; ++bj)
#pragma unroll
                        for (int n = 0; n < 2; ++n) v[bj][n] = v[bj][n] * rs * g[bj][n];
                    if (rope_on) {
                        f32x4 p[2];
#pragma unroll
                        for (int n = 0; n < 2; ++n)
#pragma unroll
                            for (int j = 0; j < 4; ++j) p[n][j] = __shfl_xor(v[0][n][j], 16);
                        const f32x4 c0 = *(const f32x4*)(rope + (size_t)row * 16), c1 = *(const f32x4*)(rope + (size_t)row * 16 + 4);
                        const f32x4 s0 = *(const f32x4*)(rope + (size_t)row * 16 + 8), s1 = *(const f32x4*)(rope + (size_t)row * 16 + 12);
                        if (fq == 0) { v[0][0] = v[0][0] * c0 - p[0] * s0; v[0][1] = v[0][1] * c1 - p[1] * s1; }
                        else if (fq == 1) { v[0][0] = v[0][0] * c0 + p[0] * s0; v[0][1] = v[0][1] * c1 + p[1] * s1; }
                    }
                }
                bf16_t* rowp = O + ((size_t)(pn * 4 + wc) * ldc + row) * 64 + 8 * fq;
#pragma unroll
                for (int bj = 0; bj < 2; ++bj) *(u32x4*)(rowp + 32 * bj) = pack8(v[bj][0] * scale, v[bj][1] * scale);
            }
    }
};

struct EpiResid {
    static constexpr bool PERM = true, AFTER_DRAIN = false;
    const float* base; float* out; bf16_t* xb; float* ss; float pre; unsigned char* x8;
    __device__ __forceinline__ void operator()(const f32x4 (&acc)[2][2][4][2], const Unit& u, int wr, int wc, int fr, int fq) const {
        const int row0 = u.pm * BM + wr * 64 + fr, col0 = u.pn * BM + wc * 32 + 8 * fq;
#pragma unroll
        for (int ai = 0; ai < 2; ++ai)
#pragma unroll
            for (int m = 0; m < 4; ++m) {
                const int row = row0 + ai * HALF + m * 16; float s = 0.f;
#pragma unroll
                for (int bj = 0; bj < 2; ++bj) {
                    const size_t off = (size_t)row * 1024 + col0 + bj * HALF;
                    const f32x4 v0 = acc[ai][bj][m][0] * pre + *(const f32x4*)(base + off), v1 = acc[ai][bj][m][1] * pre + *(const f32x4*)(base + off + 4);
                    *(f32x4*)(out + off) = v0; *(f32x4*)(out + off + 4) = v1;
                    if (xb) *(u32x4*)(xb + off) = pack8(v0, v1);
                    if (x8) { typedef unsigned u32x2 __attribute__((ext_vector_type(2))); u32x2 w8; w8.x = pk4_fp8(v0[0], v0[1], v0[2], v0[3]); w8.y = pk4_fp8(v1[0], v1[1], v1[2], v1[3]); *(u32x2*)(x8 + off) = w8; }
                    s += (v0[0] * v0[0] + v0[1] * v0[1]) + (v0[2] * v0[2] + v0[3] * v0[3]) + (v1[0] * v1[0] + v1[1] * v1[1]) + (v1[2] * v1[2] + v1[3] * v1[3]);
                }
                if (ss) { s += __shfl_xor(s, 16); s += __shfl_xor(s, 32); if (fq == 0) ss[(size_t)row * 16 + u.pn * 4 + wc] = s; }
            }
    }
};

template <bool OUT8> struct EpiSwiglu {
    static constexpr bool PERM = true, AFTER_DRAIN = false;
    void* O; int ldc; const float* ss; int nparts; const int* rowtok; int tile0; int npn; float pre;
    __device__ __forceinline__ void operator()(const f32x4 (&acc)[2][2][4][2], const Unit& u, int wr, int wc, int fr, int fq) const {
        const int pnl = u.pn % npn; const int row0 = u.pm * BM + wr * 64 + fr, col0 = pnl * HALF + wc * 32 + 8 * fq;
#pragma unroll
        for (int ai = 0; ai < 2; ++ai)
#pragma unroll
            for (int m = 0; m < 4; ++m) {
                const int row = row0 + ai * HALF + m * 16;
                int tok = row; if (rowtok) tok = rowtok[tile0 * BM + row];
                const float r = (tok >= 0) ? rsqrtf(row_ss(ss, nparts, tok >= 0 ? tok : 0) * (1.f / 1024.f) + RMS_EPS) * pre : 0.f;
                f32x4 a[2]; const float rl = -r * LOG2E, r2 = r * r;
#pragma unroll
                for (int n = 0; n < 2; ++n) { const f32x4 gq = acc[ai][0][m][n], t = gq * rl; f32x4 d;
#pragma unroll
                    for (int j = 0; j < 4; ++j) d[j] = __builtin_amdgcn_rcpf(1.f + __builtin_amdgcn_exp2f(t[j]));
                    a[n] = ((gq * acc[ai][1][m][n]) * r2) * d; }
                if constexpr (OUT8) { typedef unsigned u32x2 __attribute__((ext_vector_type(2))); u32x2 w; w.x = pk4_fp8(a[0][0], a[0][1], a[0][2], a[0][3]); w.y = pk4_fp8(a[1][0], a[1][1], a[1][2], a[1][3]); *(u32x2*)((unsigned char*)O + (size_t)row * ldc + col0) = w; }
                else *(u32x4*)((bf16_t*)O + (size_t)row * ldc + col0) = pack8(a[0], a[1]);
            }
    }
};

struct EpiMoeDown {
    static constexpr bool PERM = true, AFTER_DRAIN = false;
    float* out; const int* rowtok; const float* rowgate; int tile0; float pre; int nostore;
    __device__ __forceinline__ void operator()(const f32x4 (&acc)[2][2][4][2], const Unit& u, int wr, int wc, int fr, int fq) const {
        const int pnl = u.pn & 3; const int row0 = (tile0 + u.pm) * BM + wr * 64 + fr, col0 = pnl * BM + wc * 32 + 8 * fq;
#pragma unroll
        for (int ai = 0; ai < 2; ++ai)
#pragma unroll
            for (int m = 0; m < 4; ++m) {
                const int srow = row0 + ai * HALF + m * 16; const int tok = nostore ? -1 : rowtok[srow];
                if (tok >= 0) { const float gt = rowgate[srow] * pre;
#pragma unroll
                    for (int bj = 0; bj < 2; ++bj)
#pragma unroll
                        for (int n = 0; n < 2; ++n) { f32x4* p = (f32x4*)(out + (size_t)tok * 1024 + col0 + bj * HALF + 4 * n); *p = *p + acc[ai][bj][m][n] * gt; } }
            }
    }
};

typedef int i32x4 __attribute__((ext_vector_type(4)));
typedef int i32x8 __attribute__((ext_vector_type(8)));
template <class Epi, class Sched, bool ALIGN_EPI = false, bool SP2 = false, bool F8 = false>
__device__ __forceinline__ void gemm_phase(PG8_LAS unsigned char* lds, const Gemm g, const Sched& S, const Epi& E) {
    const int tid = threadIdx.x, wid = __builtin_amdgcn_readfirstlane(tid >> 6), lane = tid & 63, wr = wid >> 2, wc = wid & 3, fr = lane & 15, fq = lane >> 4;
    const int K = g.K, nt = K / BK;
    unsigned voffA[2], voffB[2];
#pragma unroll
    for (int i = 0; i < 2; ++i) { int R, C; stage_rc(tid * 16 + i * 8192, R, C); const int Rb = Epi::PERM ? ((R & ~31) + perm32(R & 31)) : R;
        voffA[i] = (unsigned)(R * K + C) * 2u; voffB[i] = (unsigned)(Rb * K + C) * 2u; }
    const size_t kstep = (size_t)(BK * 2);
    const size_t hstep = (size_t)HALF * K * 2;
    const size_t tstep = 2 * hstep;
    const unsigned ldsw = (unsigned)wid * 1024u;
    const int aoff = lds_byte(wr * 64 + fr, fq * 8), boff = lds_byte(wc * 32 + fr, fq * 8);
#define PG8_SA(b, h) (((b) * 2 + (h)) * HTB)
#define PG8_SB(b, h) ((4 + (b) * 2 + (h)) * HTB)
#define PG8_STAGE(bufoff, gbase, voff) do { _Pragma("unroll") for (int _i = 0; _i < 2; ++_i) \
        __builtin_amdgcn_global_load_lds((const unsigned*)((const char*)(gbase) + (voff)[_i]), (PG8_LAS unsigned*)(lds + (bufoff) + ldsw + _i * 8192), 16, 0, 0); } while (0)
#define PG8_LDA(dst, b, h) do { if constexpr (F8) { _Pragma("unroll") for (int m = 0; m < 4; ++m) dst##8[m] = PG8_CAT(*(const PG8_LAS bf16x8*)(lds + PG8_SA(b, h) + aoff + m * 2048), *(const PG8_LAS bf16x8*)(lds + PG8_SA(b, h) + aoff + m * 2048 + 1024)); } \
        else { _Pragma("unroll") for (int m = 0; m < 4; ++m) _Pragma("unroll") for (int k = 0; k < 2; ++k) dst[m][k] = *(const PG8_LAS bf16x8*)(lds + PG8_SA(b, h) + aoff + m * 2048 + k * 1024); } } while (0)
#define PG8_LDB(dst, b, h) do { if constexpr (F8) { _Pragma("unroll") for (int n = 0; n < 2; ++n) dst##8[n] = PG8_CAT(*(const PG8_LAS bf16x8*)(lds + PG8_SB(b, h) + boff + n * 2048), *(const PG8_LAS bf16x8*)(lds + PG8_SB(b, h) + boff + n * 2048 + 1024)); } \
        else { _Pragma("unroll") for (int n = 0; n < 2; ++n) _Pragma("unroll") for (int k = 0; k < 2; ++k) dst[n][k] = *(const PG8_LAS bf16x8*)(lds + PG8_SB(b, h) + boff + n * 2048 + k * 1024); } } while (0)
#define PG8_CAT(x, y) __builtin_shufflevector(__builtin_bit_cast(i32x4, (x)), __builtin_bit_cast(i32x4, (y)), 0, 1, 2, 3, 4, 5, 6, 7)
#define PG8_MMA(ai, bj, At, Bt) do { __builtin_amdgcn_s_setprio(1); _Pragma("unroll") for (int m = 0; m < 4; ++m) _Pragma("unroll") for (int n = 0; n < 2; ++n) { \
        if constexpr (F8) { asm volatile("v_mfma_f32_16x16x128_f8f6f4 %0, %1, %2, %0" : "+v"(acc[ai][bj][m][n]) : "v"(Bt##8[n]), "v"(At##8[m])); } \
        else { _Pragma("unroll") for (int k = 0; k < 2; ++k) acc[ai][bj][m][n] = __builtin_amdgcn_mfma_f32_16x16x32_bf16(Bt[n][k], At[m][k], acc[ai][bj][m][n], 0, 0, 0); } } __builtin_amdgcn_s_setprio(0); } while (0)
#define PG8_WAIT_V(n) asm volatile("s_waitcnt vmcnt(" #n ")" ::: "memory")
#define PG8_WAIT_L(n) asm volatile("s_waitcnt lgkmcnt(" #n ")" ::: "memory")
#define PG8_BAR __builtin_amdgcn_s_barrier()
#define PG8_SCHED __builtin_amdgcn_sched_barrier(0)
    Unit cur, nxt; int ui = 0;
    if (!S.next(0, cur)) return;
    f32x4 acc[2][2][4][2];
#pragma unroll
    for (int a = 0; a < 2; ++a)
#pragma unroll
        for (int b = 0; b < 2; ++b)
#pragma unroll
            for (int m = 0; m < 4; ++m)
#pragma unroll
                for (int n = 0; n < 2; ++n) acc[a][b][m][n] = (f32x4){0.f, 0.f, 0.f, 0.f};
    bf16x8 At[4][2], B0[2][2], B1[2][2];
    i32x8 At8[4], B08[2], B18[2];
    const char* cA = (const char*)g.A + (size_t)cur.pm * tstep; const char* cB = (const char*)g.Bt + (size_t)cur.pn * tstep;
    S.a_ready(cur);
    if constexpr (SP2) {
        PG8_STAGE(PG8_SB(0, 0), cB, voffB); PG8_STAGE(PG8_SB(0, 1), cB + hstep, voffB); PG8_STAGE(PG8_SA(0, 0), cA, voffA); PG8_STAGE(PG8_SA(0, 1), cA + hstep, voffA);
        if (wr == 1) PG8_BAR;
        PG8_WAIT_V(2); PG8_BAR;
        PG8_STAGE(PG8_SB(1, 0), cB + kstep, voffB); PG8_STAGE(PG8_SA(1, 0), cA + kstep, voffA); PG8_STAGE(PG8_SB(1, 1), cB + hstep + kstep, voffB);
        PG8_WAIT_V(6); PG8_BAR;
    } else {
        PG8_STAGE(PG8_SB(0, 0), cB, voffB); PG8_STAGE(PG8_SA(0, 0), cA, voffA); PG8_STAGE(PG8_SB(0, 1), cB + hstep, voffB); PG8_STAGE(PG8_SA(0, 1), cA + hstep, voffA);
        if (wr == 1) PG8_BAR;
        PG8_WAIT_V(4); PG8_BAR;
        PG8_STAGE(PG8_SB(1, 0), cB + kstep, voffB); PG8_STAGE(PG8_SA(1, 0), cA + kstep, voffA); PG8_STAGE(PG8_SB(1, 1), cB + hstep + kstep, voffB);
        PG8_WAIT_V(6); PG8_BAR;
    }
    for (;;) {
        const bool has_next = S.next(ui + 1, nxt);
        const char* nA = has_next ? (const char*)g.A + (size_t)nxt.pm * tstep : cA; const char* nB = has_next ? (const char*)g.Bt + (size_t)nxt.pn * tstep : cB;
#pragma nounroll
        for (int t = 0; t < nt; t += 2) {
            const bool last = (t == nt - 2);
            const char* a1 = cA + (size_t)(t + 1) * kstep;
            const char* a2 = last ? nA : cA + (size_t)(t + 2) * kstep; const char* b2 = last ? nB : cB + (size_t)(t + 2) * kstep;
            const char* a3 = a2 + kstep; const char* b3 = b2 + kstep;
            if (last && has_next) S.a_ready(nxt);
            if constexpr (SP2) {
            PG8_LDB(B0, 0, 0); PG8_LDB(B1, 0, 1); PG8_SCHED; PG8_LDA(At, 0, 0); PG8_STAGE(PG8_SA(1, 1), a1 + hstep, voffA);
            PG8_WAIT_V(8); PG8_WAIT_L(0); PG8_BAR; PG8_MMA(0, 0, At, B0); PG8_MMA(0, 1, At, B1); PG8_BAR; PG8_SCHED;
            PG8_LDA(At, 0, 1); PG8_STAGE(PG8_SB(0, 0), b2, voffB); PG8_STAGE(PG8_SB(0, 1), b2 + hstep, voffB); PG8_STAGE(PG8_SA(0, 0), a2, voffA);
            PG8_WAIT_V(8); PG8_WAIT_L(0); PG8_BAR; PG8_MMA(1, 0, At, B0); PG8_MMA(1, 1, At, B1); PG8_BAR; PG8_SCHED;
            PG8_LDB(B0, 1, 0); PG8_LDB(B1, 1, 1); PG8_SCHED; PG8_LDA(At, 1, 0); PG8_STAGE(PG8_SA(0, 1), a2 + hstep, voffA);
            PG8_WAIT_V(8); PG8_WAIT_L(0); PG8_BAR; PG8_MMA(0, 0, At, B0); PG8_MMA(0, 1, At, B1); PG8_BAR; PG8_SCHED;
            PG8_LDA(At, 1, 1); PG8_STAGE(PG8_SB(1, 0), b3, voffB); PG8_STAGE(PG8_SB(1, 1), b3 + hstep, voffB); PG8_STAGE(PG8_SA(1, 0), a3, voffA);
            PG8_WAIT_V(8); PG8_WAIT_L(0); PG8_BAR; PG8_MMA(1, 0, At, B0); PG8_MMA(1, 1, At, B1); PG8_BAR; PG8_SCHED;
            } else {
            PG8_LDB(B0, 0, 0); PG8_SCHED; PG8_LDA(At, 0, 0); PG8_STAGE(PG8_SA(1, 1), a1 + hstep, voffA);
            PG8_WAIT_L(8); PG8_BAR; PG8_WAIT_L(0); PG8_MMA(0, 0, At, B0); PG8_BAR; PG8_SCHED;
            PG8_LDB(B1, 0, 1); PG8_STAGE(PG8_SB(0, 0), b2, voffB);
            PG8_BAR; PG8_WAIT_L(0); PG8_MMA(0, 1, At, B1); PG8_BAR;
            PG8_LDA(At, 0, 1); PG8_STAGE(PG8_SA(0, 0), a2, voffA);
            PG8_BAR; PG8_WAIT_L(0); PG8_MMA(1, 0, At, B0); PG8_BAR; PG8_SCHED;
            PG8_STAGE(PG8_SB(0, 1), b2 + hstep, voffB);
            PG8_WAIT_V(6); PG8_BAR; PG8_MMA(1, 1, At, B1); PG8_BAR;
            PG8_LDB(B0, 1, 0); PG8_SCHED; PG8_LDA(At, 1, 0); PG8_STAGE(PG8_SA(0, 1), a2 + hstep, voffA);
            PG8_WAIT_L(8); PG8_BAR; PG8_WAIT_L(0); PG8_MMA(0, 0, At, B0); PG8_BAR; PG8_SCHED;
            PG8_LDB(B1, 1, 1); PG8_STAGE(PG8_SB(1, 0), b3, voffB);
            PG8_BAR; PG8_WAIT_L(0); PG8_MMA(0, 1, At, B1); PG8_BAR;
            PG8_LDA(At, 1, 1); PG8_STAGE(PG8_SA(1, 0), a3, voffA);
            PG8_BAR; PG8_WAIT_L(0); PG8_MMA(1, 0, At, B0); PG8_BAR; PG8_SCHED;
            PG8_STAGE(PG8_SB(1, 1), b3 + hstep, voffB);
            PG8_WAIT_V(6); PG8_BAR; PG8_MMA(1, 1, At, B1); PG8_BAR;
            }
        }
        if constexpr (F8) asm volatile("s_nop 15\n\ts_nop 15\n\ts_nop 15" ::: "memory");
        if constexpr (ALIGN_EPI) { if (wr == 0) PG8_BAR; }
        if constexpr (!Epi::AFTER_DRAIN) { E(acc, cur, wr, wc, fr, fq); S.done(cur); }
        if (!has_next) break;
#pragma unroll
        for (int a = 0; a < 2; ++a)
#pragma unroll
            for (int b = 0; b < 2; ++b)
#pragma unroll
                for (int m = 0; m < 4; ++m)
#pragma unroll
                    for (int n = 0; n < 2; ++n) acc[a][b][m][n] = (f32x4){0.f, 0.f, 0.f, 0.f};
        cur = nxt; cA = nA; cB = nB; ++ui;
        if constexpr (ALIGN_EPI) { if (wr == 1) PG8_BAR; }
    }
    PG8_WAIT_V(0);
    if constexpr (!ALIGN_EPI) { if (wr == 0) PG8_BAR; }
    PG8_BAR;
    if constexpr (Epi::AFTER_DRAIN) { E.fused(acc, cur, wr, wc, fr, fq, lds, wid, lane); S.done(cur); }
#undef PG8_SA
#undef PG8_SB
#undef PG8_STAGE
#undef PG8_LDA
#undef PG8_LDB
#undef PG8_MMA
#undef PG8_CAT
#undef PG8_WAIT_V
#undef PG8_WAIT_L
#undef PG8_BAR
#undef PG8_SCHED
}
}

namespace att {
using pg8::bf16_t; using pg8::bf16x8; using pg8::u32x4;
typedef float f32x16 __attribute__((ext_vector_type(16)));
typedef short s16x4 __attribute__((ext_vector_type(4)));
typedef float f32x2_t __attribute__((ext_vector_type(2))); typedef __bf16 bf16x2_t __attribute__((ext_vector_type(2)));
#define ALAS __attribute__((address_space(3)))
typedef ALAS const char* lds_cptr;
constexpr int SEQ = 8192, PITCH = 64, VNEXT = 2 * SEQ * 64;
constexpr int KVSLOT = 24576;
constexpr int L_WS = 114688, L_TAB = L_WS + 2048, L_FLAG = L_TAB + 1056, L_END = L_FLAG + 128, L_OST = 0;
constexpr float SB_THR = 152.f;
__device__ __forceinline__ int crow(int r, int hi) { return (r & 3) + 8 * (r >> 2) + 4 * hi; }
__device__ __forceinline__ void glds16(const void* gsrc, unsigned lds_dst) { unsigned keep;
    asm volatile("s_mov_b32 %0, m0\n\ts_mov_b32 m0, %2\n\ts_nop 0\n\tglobal_load_lds_dwordx4 %1, off\n\ts_mov_b32 m0, %0" : "=&s"(keep) : "v"(gsrc), "s"(lds_dst) : "memory"); }
__device__ __forceinline__ unsigned cvtpk(float lo, float hi) { f32x2_t v = {lo, hi}; bf16x2_t b = __builtin_convertvector(v, bf16x2_t); return __builtin_bit_cast(unsigned, b); }
__device__ __forceinline__ unsigned short f2bf(float f) { unsigned u = __builtin_bit_cast(unsigned, f); return (unsigned short)((u + 0x7fffu + ((u >> 16) & 1u)) >> 16); }
#define MFMA32(a, b, c) __builtin_amdgcn_mfma_f32_32x32x16_bf16((a), (b), (c), 0, 0, 0)

__device__ __forceinline__ void qkt(f32x16& p0, f32x16& p1, lds_cptr kb, const bf16x8* qr, const f32x16& cin) {
#pragma unroll
    for (int d0 = 0; d0 < 4; ++d0) {
        const bf16x8 b0 = *(const ALAS bf16x8*)(kb + d0 * 2048);
        const bf16x8 b1 = *(const ALAS bf16x8*)(kb + d0 * 2048 + 512);
        if (d0 == 0) { p0 = MFMA32(b0, qr[0], cin); p1 = MFMA32(b1, qr[0], cin); }
        else { p0 = MFMA32(b0, qr[d0], p0); p1 = MFMA32(b1, qr[d0], p1); }
    }
}

__device__ __forceinline__ void qkt_sw(f32x16& p0, f32x16& p1, lds_cptr ks, const int (&kofs)[4], const bf16x8* qr, const f32x16& cin) {
    bf16x8 kf[8];
#pragma unroll
    for (int d0 = 0; d0 < 4; ++d0) { kf[2 * d0] = *(const ALAS bf16x8*)(ks + kofs[d0]); kf[2 * d0 + 1] = *(const ALAS bf16x8*)(ks + kofs[d0] + 4096); }
    p0 = MFMA32(kf[0], qr[0], cin); p1 = MFMA32(kf[1], qr[0], cin);
#pragma unroll
    for (int d0 = 1; d0 < 4; ++d0) { p0 = MFMA32(kf[2 * d0], qr[d0], p0); p1 = MFMA32(kf[2 * d0 + 1], qr[d0], p1); }
}
template <int ND> __device__ __forceinline__ void pv(f32x16* o, int vb, bf16x8 pa0, bf16x8 pa1, bf16x8 pa2, bf16x8 pa3) {
#pragma unroll
    for (int d0 = 0; d0 < ND; ++d0) { s16x4 lo[4], hi[4];
#pragma unroll
        for (int ks = 0; ks < 4; ++ks) {
            asm volatile("ds_read_b64_tr_b16 %0,%1 offset:%c2" : "=&v"(lo[ks]) : "v"(vb), "i"(d0 * 4096 + ks * 1024) : "memory");
            asm volatile("ds_read_b64_tr_b16 %0,%1 offset:%c2" : "=&v"(hi[ks]) : "v"(vb), "i"(d0 * 4096 + ks * 1024 + 512) : "memory"); }
        asm volatile("s_waitcnt lgkmcnt(0)" ::: "memory"); __builtin_amdgcn_sched_barrier(0);
#define ATT_PK(k) (bf16x8){lo[k][0], lo[k][1], lo[k][2], lo[k][3], hi[k][0], hi[k][1], hi[k][2], hi[k][3]}
        o[d0] = MFMA32(pa0, ATT_PK(0), o[d0]);
        o[d0] = MFMA32(pa1, ATT_PK(1), o[d0]);
        o[d0] = MFMA32(pa2, ATT_PK(2), o[d0]);
        o[d0] = MFMA32(pa3, ATT_PK(3), o[d0]);
#undef ATT_PK
    }
}

template <int MODE, int VD, bool OUT8 = false, int TPB = 1>
__device__ __forceinline__ void attn_unit(ALAS char* shm, const bf16_t* Qb, const bf16_t* Kb, const bf16_t* Vb, void* Ob, int opitch, int q0, float mref2, const float* tab, float oscale = 1.f, int dbg = 0) {
    constexpr int ND = VD / 32, SLOT = 8192 + VD * 128;
    static_assert(2 * TPB * SLOT <= L_WS, "ring vs LDS map");
    const int tid = threadIdx.x, lane = tid & 63, r32 = lane & 31, hi = lane >> 5; const int wid = __builtin_amdgcn_readfirstlane(tid >> 6);
    const unsigned lds0 = (unsigned)(uintptr_t)shm;
    ALAS float* wsf = (ALAS float*)(shm + L_WS) + wid * 64;
    ALAS float* tabL = (ALAS float*)(shm + L_TAB);
    ALAS unsigned* flg = (ALAS unsigned*)(shm + L_FLAG);
    if (MODE == 1) { for (int i = tid; i < 257; i += 512) tabL[i] = tab[i] * pg8::LOG2E; }
    const bf16_t* Qw = Qb + (size_t)(q0 + wid * 32) * PITCH;
    bf16x8 qr[4];
#pragma unroll
    for (int d0 = 0; d0 < 4; ++d0) qr[d0] = *(const bf16x8*)(Qw + (size_t)r32 * PITCH + d0 * 16 + hi * 8);
    int t_first, n_t, t_step;
    if (MODE == 0) { t_first = 0; n_t = q0 / 64 + 4; t_step = 1; }
    else if (MODE == 1) { const int c0 = q0 / 64; t_first = c0 - 8 > 0 ? c0 - 8 : 0; n_t = c0 + 4 - t_first; t_step = 1; }
    else { t_first = q0 / 64 + 3; n_t = q0 / 64 + 4; t_step = -1; }
    const int krow = 8 * wid + (lane >> 3);
    const bf16_t* ksrc = Kb + (size_t)krow * PITCH + (((lane & 7) ^ ((krow >> 1) & 7)) * 8);
    int kofs[4];
#pragma unroll
    for (int d0 = 0; d0 < 4; ++d0) kofs[d0] = (r32 >> 3) * 1024 + ((r32 & 7) * 8 + ((2 * d0 + hi) ^ ((r32 >> 1) & 7))) * 16;
    const bf16_t* vsrc = Vb + (size_t)(16 * (wid & 3) + (lane >> 2)) * PITCH + (wid >> 2) * 32 + (lane & 3) * 8;
#define ATT_DMA(t, slot) do { if (dbg & 64) break; const size_t to_ = (size_t)(t) * 64 * PITCH; const unsigned sb_ = lds0 + (unsigned)(slot) * SLOT; \
        glds16(ksrc + to_, (unsigned)__builtin_amdgcn_readfirstlane(sb_ + wid * 1024)); \
        glds16(vsrc + to_, (unsigned)__builtin_amdgcn_readfirstlane(sb_ + 8192 + wid * 1024)); \
        if (VD == 128) glds16(vsrc + to_ + VNEXT, (unsigned)__builtin_amdgcn_readfirstlane(sb_ + 8192 + (wid + 8) * 1024)); } while (0)
    f32x16 o[ND];
#pragma unroll
    for (int d = 0; d < ND; ++d) o[d] = f32x16{};
    f32x16 cin;
#pragma unroll
    for (int r = 0; r < 16; ++r) cin[r] = (MODE == 2) ? 0.f : -mref2;
    float l_reg = 0.f, A = 0.f; bool wdone = false;
    const int wrow0 = q0 + wid * 32, qrow = wrow0 + r32;
    const int vb0 = (int)lds0 + 8192 + ((lane >> 4) & 1) * 32 + (lane & 3) * 8 + (4 * hi + ((lane & 15) >> 2)) * 64;
    asm volatile("s_waitcnt vmcnt(0)" ::: "memory"); asm volatile("" : "+v"(qr[0]), "+v"(qr[1]), "+v"(qr[2]), "+v"(qr[3]));
#pragma unroll
    for (int u = 0; u < TPB; ++u) ATT_DMA(t_first + u * t_step, u);
    for (int i = 0; i < n_t; ++i) {
        const int t = t_first + i * t_step, slot = i % (2 * TPB);
        if (i % TPB == 0) {
        asm volatile("s_waitcnt vmcnt(0) lgkmcnt(0)\n\ts_barrier" ::: "memory");
        if (MODE == 2 && i > 0) { const int par = ((i - 1) & 3) * 8; unsigned all = 1u;
#pragma unroll
            for (int w = 0; w < 8; ++w) all &= flg[par + w];
            if (__builtin_amdgcn_readfirstlane(all)) break; }
        if (i + TPB < n_t) {
#pragma unroll
            for (int u = 0; u < TPB; ++u) ATT_DMA(t + (TPB + u) * t_step, (i + TPB + u) % (2 * TPB)); }
        }
        bool active;
        if (MODE == 0) active = (64 * t <= wrow0);
        else if (MODE == 1) { const int cw = wrow0 / 64; active = (t >= cw - 8) && (t <= cw); }
        else active = !wdone && (64 * t < wrow0 + 31);
        if (active && !(dbg & 32)) {
            f32x16 p0, p1; qkt_sw(p0, p1, (lds_cptr)shm + slot * SLOT, kofs, qr, cin);
            if (MODE == 0) {
#pragma unroll
                for (int r = 0; r < 16; ++r) { p0[r] = __builtin_amdgcn_exp2f(p0[r]); p1[r] = __builtin_amdgcn_exp2f(p1[r]); }
            } else if (MODE == 1) {
                const int cw = wrow0 / 64;
                if (t <= cw - 3) { const float cb = tabL[256];
#pragma unroll
                    for (int r = 0; r < 16; ++r) { p0[r] = __builtin_amdgcn_exp2f(p0[r] + cb); p1[r] = __builtin_amdgcn_exp2f(p1[r] + cb); }
                } else { const int dq = qrow - 64 * t - 4 * hi;
#pragma unroll
                    for (int r = 0; r < 16; ++r) { int d0 = dq - ((r & 3) + 8 * (r >> 2)), d1 = d0 - 32;
                        d0 = d0 < -128 ? -128 : (d0 > 128 ? 128 : d0); d1 = d1 < -128 ? -128 : (d1 > 128 ? 128 : d1);
                        p0[r] = __builtin_amdgcn_exp2f(p0[r] + tabL[d0 + 128]); p1[r] = __builtin_amdgcn_exp2f(p1[r] + tabL[d1 + 128]); }
                }
            } else {
                const bool needmask = (64 * t + 63 >= wrow0);
                const int kq = qrow - 64 * t - 4 * hi;
                float g[8];
#pragma unroll
                for (int k = 0; k < 8; ++k) g[k] = 0.f;
                f32x16 s0, s1;
#pragma unroll
                for (int r = 0; r < 16; ++r) { const int kv = (r & 3) + 8 * (r >> 2);
                    { const float y = p0[r], a = __builtin_fabsf(y); float sp = __builtin_fmaxf(y, 0.f) + __builtin_amdgcn_logf(1.f + __builtin_amdgcn_exp2f(-a)); if (needmask && !(kv < kq)) sp = 0.f; s0[r] = sp; g[r >> 2] += sp; }
                    { const float y = p1[r], a = __builtin_fabsf(y); float sp = __builtin_fmaxf(y, 0.f) + __builtin_amdgcn_logf(1.f + __builtin_amdgcn_exp2f(-a)); if (needmask && !(kv + 32 < kq)) sp = 0.f; s1[r] = sp; g[4 + (r >> 2)] += sp; } }
                float pg[8];
#pragma unroll
                for (int k = 0; k < 8; ++k) pg[k] = __shfl_xor(g[k], 32);
                float base[8]; float own = 0.f, par = 0.f;
#pragma unroll
                for (int k = 7; k >= 0; --k) { const float par_incl = par + pg[k]; base[k] = A + own + (hi == 0 ? par_incl : par); own += g[k]; par = par_incl; }
                A += own + par;
#pragma unroll
                for (int k = 0; k < 4; ++k) {
                    { float c = base[k]; c += s0[4 * k + 3]; const float w3 = __builtin_amdgcn_exp2f(p0[4 * k + 3] - c); c += s0[4 * k + 2]; const float w2 = __builtin_amdgcn_exp2f(p0[4 * k + 2] - c);
                      c += s0[4 * k + 1]; const float w1 = __builtin_amdgcn_exp2f(p0[4 * k + 1] - c); c += s0[4 * k]; const float w0 = __builtin_amdgcn_exp2f(p0[4 * k] - c);
                      p0[4 * k] = w0; p0[4 * k + 1] = w1; p0[4 * k + 2] = w2; p0[4 * k + 3] = w3; }
                    { float c = base[4 + k]; c += s1[4 * k + 3]; const float w3 = __builtin_amdgcn_exp2f(p1[4 * k + 3] - c); c += s1[4 * k + 2]; const float w2 = __builtin_amdgcn_exp2f(p1[4 * k + 2] - c);
                      c += s1[4 * k + 1]; const float w1 = __builtin_amdgcn_exp2f(p1[4 * k + 1] - c); c += s1[4 * k]; const float w0 = __builtin_amdgcn_exp2f(p1[4 * k] - c);
                      p1[4 * k] = w0; p1[4 * k + 1] = w1; p1[4 * k + 2] = w2; p1[4 * k + 3] = w3; }
                }
                if (needmask) {
#pragma unroll
                    for (int r = 0; r < 16; ++r) { const int kv = (r & 3) + 8 * (r >> 2); if (!(kv < kq)) p0[r] = 0.f; if (!(kv + 32 < kq)) p1[r] = 0.f; }
                }
                wdone = __all(A >= SB_THR);
            }
            if (MODE != 2) { float s = 0.f;
#pragma unroll
                for (int r = 0; r < 16; ++r) s += p0[r] + p1[r];
                l_reg += s; }
            u32x4 pw0, pw1, pw2, pw3;
            pw0 = (u32x4){cvtpk(p0[0], p0[1]), cvtpk(p0[2], p0[3]), cvtpk(p0[4], p0[5]), cvtpk(p0[6], p0[7])};
            pw1 = (u32x4){cvtpk(p0[8], p0[9]), cvtpk(p0[10], p0[11]), cvtpk(p0[12], p0[13]), cvtpk(p0[14], p0[15])};
            pw2 = (u32x4){cvtpk(p1[0], p1[1]), cvtpk(p1[2], p1[3]), cvtpk(p1[4], p1[5]), cvtpk(p1[6], p1[7])};
            pw3 = (u32x4){cvtpk(p1[8], p1[9]), cvtpk(p1[10], p1[11]), cvtpk(p1[12], p1[13]), cvtpk(p1[14], p1[15])};
            pv<ND>(o, vb0 + slot * SLOT, __builtin_bit_cast(bf16x8, pw0), __builtin_bit_cast(bf16x8, pw1), __builtin_bit_cast(bf16x8, pw2), __builtin_bit_cast(bf16x8, pw3));
        }
        if (MODE == 2) { if (lane == 0) flg[(i & 3) * 8 + wid] = wdone ? 1u : 0u; }
    }
#undef ATT_DMA
    asm volatile("s_waitcnt vmcnt(0) lgkmcnt(0)\n\ts_barrier" ::: "memory");
    float rl[16];
    if (MODE != 2) {
        l_reg += __shfl_xor(l_reg, 32);
        if (hi == 0) wsf[32 + r32] = l_reg;
        asm volatile("s_waitcnt lgkmcnt(0)" ::: "memory");
#pragma unroll
        for (int r = 0; r < 16; ++r) rl[r] = __builtin_amdgcn_rcpf(wsf[32 + crow(r, hi)]) * oscale;
    } else {
#pragma unroll
        for (int r = 0; r < 16; ++r) rl[r] = oscale;
    }
    if constexpr (OUT8) {
        static_assert(!OUT8 || VD == 64, "fp8 output: 64-wide heads");
        unsigned char* Ow = (unsigned char*)Ob + (size_t)(q0 + wid * 32) * opitch;
        ALAS unsigned char* stg = (ALAS unsigned char*)(shm + L_OST) + wid * 2048;
#pragma unroll
        for (int r = 0; r < 16; ++r) { const int orow = crow(r, hi);
#pragma unroll
            for (int d0 = 0; d0 < 2; ++d0) { const float v = o[d0][r] * rl[r]; stg[orow * 64 + d0 * 32 + r32] = (unsigned char)(__builtin_amdgcn_cvt_pk_fp8_f32(v, v, 0, false) & 0xff); } }
        asm volatile("s_waitcnt lgkmcnt(0)" ::: "memory");
#pragma unroll
        for (int i = 0; i < 2; ++i) { const int row = i * 16 + (lane >> 2), ch = lane & 3; const u32x4 v = *(const ALAS u32x4*)(stg + row * 64 + ch * 16); *(u32x4*)(Ow + (size_t)row * opitch + ch * 16) = v; }
        asm volatile("s_waitcnt lgkmcnt(0)" ::: "memory");
    } else {
    bf16_t* Ow = (bf16_t*)Ob + (size_t)(q0 + wid * 32) * opitch;
    ALAS bf16_t* stg = (ALAS bf16_t*)(shm + L_OST) + wid * 2048;
#pragma unroll
    for (int half = 0; half < ND / 2; ++half) {
#pragma unroll
        for (int r = 0; r < 16; ++r) { const int orow = crow(r, hi);
#pragma unroll
            for (int d0 = 0; d0 < 2; ++d0) stg[orow * 64 + d0 * 32 + r32] = f2bf(o[half * 2 + d0][r] * rl[r]); }
        asm volatile("s_waitcnt lgkmcnt(0)" ::: "memory");
#pragma unroll
        for (int i = 0; i < 4; ++i) { const int row = i * 8 + (lane >> 3), ch = lane & 7; const u32x4 v = *(const ALAS u32x4*)(stg + row * 64 + ch * 8); *(u32x4*)(Ow + (size_t)row * opitch + half * 64 + ch * 8) = v; }
        asm volatile("s_waitcnt lgkmcnt(0)" ::: "memory");
    }
    }
    asm volatile("s_waitcnt vmcnt(0) lgkmcnt(0)\n\ts_barrier" ::: "memory");
}


__device__ __forceinline__ void qkt8(f32x16& p0, f32x16& p1, lds_cptr kb, const bf16x8* qr, const f32x16& cin) {
    bf16x8 kf[8];
#pragma unroll
    for (int d0 = 0; d0 < 4; ++d0) { kf[2 * d0] = *(const ALAS bf16x8*)(kb + d0 * 2048); kf[2 * d0 + 1] = *(const ALAS bf16x8*)(kb + d0 * 2048 + 512); }
    __builtin_amdgcn_sched_barrier(0);
    p0 = MFMA32(kf[0], qr[0], cin); p1 = MFMA32(kf[1], qr[0], cin);
#pragma unroll
    for (int d0 = 1; d0 < 4; ++d0) { p0 = MFMA32(kf[2 * d0], qr[d0], p0); p1 = MFMA32(kf[2 * d0 + 1], qr[d0], p1); }
}
template <int ND, int KS0> __device__ __forceinline__ void v_reads(s16x4 (&lo)[ND][2], s16x4 (&hi)[ND][2], int vb) {
#pragma unroll
    for (int ks = 0; ks < 2; ++ks)
#pragma unroll
        for (int d0 = 0; d0 < ND; ++d0) {
            asm volatile("ds_read_b64_tr_b16 %0,%1 offset:%c2" : "=&v"(lo[d0][ks]) : "v"(vb), "i"(d0 * 4096 + (KS0 + ks) * 1024) : "memory");
            asm volatile("ds_read_b64_tr_b16 %0,%1 offset:%c2" : "=&v"(hi[d0][ks]) : "v"(vb), "i"(d0 * 4096 + (KS0 + ks) * 1024 + 512) : "memory"); }
}
template <int ND> __device__ __forceinline__ void pv_half(f32x16* o, const s16x4 (&lo)[ND][2], const s16x4 (&hi)[ND][2], bf16x8 pa, bf16x8 pb) {
#define ATT_PK2(d, k) (bf16x8){lo[d][k][0], lo[d][k][1], lo[d][k][2], lo[d][k][3], hi[d][k][0], hi[d][k][1], hi[d][k][2], hi[d][k][3]}
#pragma unroll
    for (int d0 = 0; d0 < ND; ++d0) o[d0] = MFMA32(pa, ATT_PK2(d0, 0), o[d0]);
#pragma unroll
    for (int d0 = 0; d0 < ND; ++d0) o[d0] = MFMA32(pb, ATT_PK2(d0, 1), o[d0]);
#undef ATT_PK2
}
template <int MODE> __device__ __forceinline__ void p_half(f32x16& p, float& l_reg, u32x4& wa, u32x4& wb, bool const_bias, int dq, const ALAS float* tabL) {
    if (MODE == 0) {
#pragma unroll
        for (int r = 0; r < 16; ++r) p[r] = __builtin_amdgcn_exp2f(p[r]);
    } else if (const_bias) { const float cb = tabL[256];
#pragma unroll
        for (int r = 0; r < 16; ++r) p[r] = __builtin_amdgcn_exp2f(p[r] + cb);
    } else {
#pragma unroll
        for (int r = 0; r < 16; ++r) { int d = dq - ((r & 3) + 8 * (r >> 2)); d = d < -128 ? -128 : (d > 128 ? 128 : d); p[r] = __builtin_amdgcn_exp2f(p[r] + tabL[d + 128]); }
    }
    float s = 0.f;
#pragma unroll
    for (int r = 0; r < 16; ++r) s += p[r];
    l_reg += s;
    wa = (u32x4){cvtpk(p[0], p[1]), cvtpk(p[2], p[3]), cvtpk(p[4], p[5]), cvtpk(p[6], p[7])};
    wb = (u32x4){cvtpk(p[8], p[9]), cvtpk(p[10], p[11]), cvtpk(p[12], p[13]), cvtpk(p[14], p[15])};
}
__device__ __forceinline__ void vm_wait_n(int n) {
    if (n <= 0) asm volatile("s_waitcnt vmcnt(0)" ::: "memory"); else if (n == 1) asm volatile("s_waitcnt vmcnt(1)" ::: "memory"); else if (n == 2) asm volatile("s_waitcnt vmcnt(2)" ::: "memory");
    else if (n == 3) asm volatile("s_waitcnt vmcnt(3)" ::: "memory"); else if (n == 4) asm volatile("s_waitcnt vmcnt(4)" ::: "memory"); else if (n == 5) asm volatile("s_waitcnt vmcnt(5)" ::: "memory");
    else if (n == 6) asm volatile("s_waitcnt vmcnt(6)" ::: "memory"); else if (n == 7) asm volatile("s_waitcnt vmcnt(7)" ::: "memory"); else if (n == 8) asm volatile("s_waitcnt vmcnt(8)" ::: "memory");
    else if (n == 9) asm volatile("s_waitcnt vmcnt(9)" ::: "memory"); else if (n == 10) asm volatile("s_waitcnt vmcnt(10)" ::: "memory"); else asm volatile("s_waitcnt vmcnt(11)" ::: "memory");
}
template <int MODE, int VD, bool OUT8 = false, int PD = 3>
__device__ __forceinline__ void attn_unit_pp(ALAS char* shm, const bf16_t* Qb, const bf16_t* Kb, const bf16_t* Vb, void* Ob, int opitch, int q0, float mref2, const float* tab, float oscale = 1.f, int dbg = 0) {
    static_assert(MODE == 0 || MODE == 1, "ping-pong loop: softmax modes only");
    constexpr int ND = VD / 32, NV = VD / 64, NS = PD + 1, PER = 1 + NV, SLOT = 8192 + VD * 128;
    static_assert(NS * SLOT <= L_WS, "ring vs LDS map");
    const int tid = threadIdx.x, lane = tid & 63, r32 = lane & 31, hi = lane >> 5; const int wid = __builtin_amdgcn_readfirstlane(tid >> 6); const int grp = wid >> 2;
    const unsigned lds0 = (unsigned)(uintptr_t)shm;
    ALAS float* wsf = (ALAS float*)(shm + L_WS) + wid * 64;
    ALAS float* tabL = (ALAS float*)(shm + L_TAB);
    if (MODE == 1) { for (int i = tid; i < 257; i += 512) tabL[i] = tab[i] * pg8::LOG2E; }
    const bf16_t* Qw = Qb + (size_t)(q0 + wid * 32) * PITCH;
    bf16x8 qr[4];
#pragma unroll
    for (int d0 = 0; d0 < 4; ++d0) qr[d0] = *(const bf16x8*)(Qw + (size_t)r32 * PITCH + d0 * 16 + hi * 8);
    int t_first, n_t;
    if (MODE == 0) { t_first = 0; n_t = q0 / 64 + 4; }
    else { const int c0 = q0 / 64; t_first = c0 - 8 > 0 ? c0 - 8 : 0; n_t = c0 + 4 - t_first; }
    const bf16_t* ksrc = Kb + (size_t)lane * PITCH + wid * 8 + (size_t)t_first * 64 * PITCH;
    const bf16_t* vsrc = Vb + (size_t)(16 * (wid & 3) + (lane >> 2)) * PITCH + (wid >> 2) * 32 + (lane & 3) * 8 + (size_t)t_first * 64 * PITCH;
    const bf16_t* ksrc_c = Kb + (size_t)t_first * 64 * PITCH + wid * 512 + lane * 8;
    int issued = 0;
#define PP_DMA_K(i) do { if ((i) < n_t && !(dbg & 64)) { glds16(((dbg & 128) ? ksrc_c : ksrc) + (size_t)(i) * 64 * PITCH, (unsigned)__builtin_amdgcn_readfirstlane(lds0 + (unsigned)((i) % NS) * SLOT + wid * 1024)); issued += 1; } } while (0)
#define PP_DMA_V(i) do { if ((i) < n_t && !(dbg & 64)) { const unsigned sb_ = lds0 + (unsigned)((i) % NS) * SLOT + 8192; glds16(vsrc + (size_t)(i) * 64 * PITCH, (unsigned)__builtin_amdgcn_readfirstlane(sb_ + wid * 1024)); \
        if (VD == 128) glds16(vsrc + (size_t)(i) * 64 * PITCH + VNEXT, (unsigned)__builtin_amdgcn_readfirstlane(sb_ + (wid + 8) * 1024)); issued += NV; } } while (0)
#define PP_NEED_K(j) do { if (!(dbg & 256)) vm_wait_n(issued - ((j) * PER + 1)); } while (0)
#define PP_NEED_V(j) do { if (!(dbg & 256)) vm_wait_n(issued - ((j) + 1) * PER); } while (0)
#define PP_BAR() asm volatile("s_waitcnt lgkmcnt(0)\n\ts_barrier" ::: "memory")
    f32x16 o[ND];
#pragma unroll
    for (int d = 0; d < ND; ++d) o[d] = f32x16{};
    f32x16 cin;
#pragma unroll
    for (int r = 0; r < 16; ++r) cin[r] = -mref2;
    float l_reg = 0.f;
    const int wrow0 = q0 + wid * 32, qrow = wrow0 + r32, cw = wrow0 / 64;
    const int vb0 = (int)lds0 + 8192 + ((lane >> 4) & 1) * 32 + (lane & 3) * 8 + (4 * hi + ((lane & 15) >> 2)) * 64;
    asm volatile("s_waitcnt vmcnt(0)" ::: "memory"); asm volatile("" : "+v"(qr[0]), "+v"(qr[1]), "+v"(qr[2]), "+v"(qr[3]));
#pragma unroll
    for (int j = 0; j < PD; ++j) { PP_DMA_K(j); PP_DMA_V(j); }
    if (grp) PP_DMA_K(PD);
    PP_NEED_V(0);
    PP_BAR();
    if (grp) PP_BAR();
    u32x4 pw0, pw1, pw2, pw3; f32x16 p1;
    for (int i = 0; i < n_t; ++i) {
        const int t = t_first + i, slot = i % NS;
        bool active;
        if (MODE == 0) active = (t <= cw); else active = (t >= cw - 8) && (t <= cw);
        if (grp == 0) PP_DMA_K(i + PD); else PP_DMA_V(i + PD);
        if (active && !(dbg & 32)) {
            const lds_cptr kb = (lds_cptr)shm + slot * SLOT + hi * 1024 + r32 * 16;
            f32x16 p0; qkt8(p0, p1, kb, qr, cin);
            p_half<MODE>(p0, l_reg, pw0, pw1, (t <= cw - 3) || (dbg & 8), qrow - 64 * t - 4 * hi, tabL);
        }
        if (grp == 0) PP_NEED_V(i); else PP_NEED_K(i + 1);
        PP_BAR();
        if (grp == 0) PP_DMA_V(i + PD); else PP_DMA_K(i + 1 + PD);
        if (active && !(dbg & 16)) {
            const int vb = vb0 + slot * SLOT;
            s16x4 lo0[ND][2], hi0[ND][2], lo1[ND][2], hi1[ND][2];
            v_reads<ND, 0>(lo0, hi0, vb);
            asm volatile("s_waitcnt lgkmcnt(0)" ::: "memory");
            v_reads<ND, 2>(lo1, hi1, vb);
            __builtin_amdgcn_sched_barrier(0);
            pv_half<ND>(o, lo0, hi0, __builtin_bit_cast(bf16x8, pw0), __builtin_bit_cast(bf16x8, pw1));
            __builtin_amdgcn_sched_barrier(0);
            p_half<MODE>(p1, l_reg, pw2, pw3, (t <= cw - 3) || (dbg & 8), qrow - 64 * t - 4 * hi - 32, tabL);
            asm volatile("s_waitcnt lgkmcnt(0)" ::: "memory");
            __builtin_amdgcn_sched_barrier(0);
            pv_half<ND>(o, lo1, hi1, __builtin_bit_cast(bf16x8, pw2), __builtin_bit_cast(bf16x8, pw3));
        }
        if (grp == 0) PP_NEED_K(i + 1); else PP_NEED_V(i + 1);
        PP_BAR();
    }
    if (grp == 0) PP_BAR();
#undef PP_DMA_K
#undef PP_DMA_V
#undef PP_NEED_K
#undef PP_NEED_V
    float rl[16];
    l_reg += __shfl_xor(l_reg, 32);
    if (hi == 0) wsf[32 + r32] = l_reg;
    asm volatile("s_waitcnt lgkmcnt(0)" ::: "memory");
#pragma unroll
    for (int r = 0; r < 16; ++r) rl[r] = __builtin_amdgcn_rcpf(wsf[32 + crow(r, hi)]) * oscale;
    if constexpr (OUT8) {
        static_assert(!OUT8 || VD == 64, "fp8 output: 64-wide heads");
        unsigned char* Ow = (unsigned char*)Ob + (size_t)(q0 + wid * 32) * opitch;
        ALAS unsigned char* stg = (ALAS unsigned char*)(shm + L_OST) + wid * 2048;
#pragma unroll
        for (int r = 0; r < 16; ++r) { const int orow = crow(r, hi);
#pragma unroll
            for (int d0 = 0; d0 < 2; ++d0) { const float v = o[d0][r] * rl[r]; stg[orow * 64 + d0 * 32 + r32] = (unsigned char)(__builtin_amdgcn_cvt_pk_fp8_f32(v, v, 0, false) & 0xff); } }
        asm volatile("s_waitcnt lgkmcnt(0)" ::: "memory");
#pragma unroll
        for (int i = 0; i < 2; ++i) { const int row = i * 16 + (lane >> 2), ch = lane & 3; const u32x4 v = *(const ALAS u32x4*)(stg + row * 64 + ch * 16); *(u32x4*)(Ow + (size_t)row * opitch + ch * 16) = v; }
        asm volatile("s_waitcnt lgkmcnt(0)" ::: "memory");
    } else {
    bf16_t* Ow = (bf16_t*)Ob + (size_t)(q0 + wid * 32) * opitch;
    ALAS bf16_t* stg = (ALAS bf16_t*)(shm + L_OST) + wid * 2048;
#pragma unroll
    for (int half = 0; half < ND / 2; ++half) {
#pragma unroll
        for (int r = 0; r < 16; ++r) { const int orow = crow(r, hi);
#pragma unroll
            for (int d0 = 0; d0 < 2; ++d0) stg[orow * 64 + d0 * 32 + r32] = f2bf(o[half * 2 + d0][r] * rl[r]); }
        asm volatile("s_waitcnt lgkmcnt(0)" ::: "memory");
#pragma unroll
        for (int i = 0; i < 4; ++i) { const int row = i * 8 + (lane >> 3), ch = lane & 7; const u32x4 v = *(const ALAS u32x4*)(stg + row * 64 + ch * 8); *(u32x4*)(Ow + (size_t)row * opitch + half * 64 + ch * 8) = v; }
        asm volatile("s_waitcnt lgkmcnt(0)" ::: "memory");
    }
    }
    PP_BAR();
#undef PP_BAR
}
}

constexpr int NWAVES = 8, NTHR = NWAVES * 64;
constexpr int BATCH = 2, SEQ = 8192, T = BATCH * SEQ, D = 1024;
constexpr int NPROJ = 3072, FFD = 2816, FFE = 3584, NEXP = 8;
constexpr size_t MiB = 1u << 20;
constexpr size_t CTL_ZERO_BYTES = 1 * MiB;
constexpr int CW_TMO = 0, CW_BAR = 4096;
constexpr int CW_HIST = 16384;
constexpr int CW_QATT = 32768, CW_QCONV = 32768 + 64 * 8;
constexpr int CW_MOE = 24576;
constexpr size_t WS_SS0 = 1 * MiB, WS_SS3 = WS_SS0 + 65536, WS_ROPE = WS_SS3 + 65536  , WS_TOKSEL = WS_ROPE + MiB  ,
                 WS_TOKGATE = WS_TOKSEL + 65536  , WS_ROWTOK = WS_TOKGATE + 131072  , WS_ROWGATE = WS_ROWTOK + 147456  ;
static_assert(WS_ROWGATE + 147456 <= 4 * MiB, "small arrays");
constexpr size_t WS_XB = 4 * MiB;
constexpr size_t WS_AO = 36 * MiB;
constexpr size_t WS_ACT0 = 68 * MiB;
constexpr size_t WS_XF = 164 * MiB;
constexpr size_t WS_WIN = 228 * MiB, WS_WO0 = 234 * MiB, WS_WGU0 = 236 * MiB, WS_WD0 = 247 * MiB, WS_WQKV = 253 * MiB, WS_WO1 = 259 * MiB;
constexpr size_t WS_WEGU = 264 * MiB;
constexpr size_t WS_WED = 376 * MiB;
constexpr size_t WS_SS1 = 432 * MiB, WS_SS2 = 433 * MiB;
constexpr size_t WS_END = 434 * MiB;
constexpr size_t WS_SORTA = 36 * MiB;
constexpr size_t WS_ACTE = 108 * MiB;
static_assert(WS_SORTA + (size_t)36864 * 2048 <= WS_ACTE && WS_ACTE + (size_t)18432 * 7168 <= WS_WO0 && WS_WD0 + (size_t)1024 * 2816 * 2 <= WS_WQKV && WS_WO1 + 2 * MiB <= WS_WEGU, "ws map");
constexpr int RING_BYTES = 131072, MISC_OFF = RING_BYTES + 320, LDS_BYTES = 147456;
static_assert(att::L_END <= RING_BYTES, "attention LDS");

#define GAS __attribute__((address_space(1)))
#define LAS __attribute__((address_space(3)))
typedef unsigned short bf16;
typedef unsigned v4u __attribute__((ext_vector_type(4)));
typedef float f32x4 __attribute__((ext_vector_type(4)));
typedef GAS unsigned gu32;
#define RLX_AGENT __ATOMIC_RELAXED, __HIP_MEMORY_SCOPE_AGENT
#define LDS_WAIT() asm volatile("s_waitcnt lgkmcnt(0)" ::: "memory")
#define VM_WAIT() asm volatile("s_waitcnt vmcnt(0)" ::: "memory")
__device__ __forceinline__ unsigned f2bf(float f) { unsigned u = __builtin_bit_cast(unsigned, f); return (u + 0x7fffu + ((u >> 16) & 1u)) >> 16; }
__device__ __forceinline__ unsigned pk2(float lo, float hi) { return f2bf(lo) | (f2bf(hi) << 16); }
__device__ __forceinline__ float bf2f(unsigned short h) { return __builtin_bit_cast(float, (unsigned)h << 16); }
#define XB_TMO      128
#define XB_XCNT(j)  (256  + 64 * (j))
#define XB_XSUB(j)  (1280 + 64 * (j))
#define XB_XGEN(j)  (2304 + 64 * (j))
#define XB_TOP      3328
#define XB_TOPGEN   3392
#define XCD_BAR_WORDS 3456
#define XB_SPIN_CAP (1u << 18)

__device__ __forceinline__ unsigned xb_ld(unsigned* p)              { return __hip_atomic_load(p, __ATOMIC_RELAXED, __HIP_MEMORY_SCOPE_AGENT); }
__device__ __forceinline__ unsigned xb_add(unsigned* p, unsigned v) { return __hip_atomic_fetch_add(p, v, __ATOMIC_RELAXED, __HIP_MEMORY_SCOPE_AGENT); }
__device__ __forceinline__ unsigned xb_xcc_id() { return (unsigned)__builtin_amdgcn_s_getreg((3 << 11) | 20) & 0xFu; }
#define XB_SPIN(cond, bar) do { unsigned _sp = 0; while (cond) { __builtin_amdgcn_s_sleep(1); \
    if ((++_sp & 255u) == 0u) { if (xb_ld(&(bar)[XB_TMO])) break; if (_sp > XB_SPIN_CAP) { atomicAdd(&(bar)[XB_TMO], 1u); break; } } } } while (0)

struct XcdBarrier {
    unsigned* bar; unsigned x;
    volatile LAS unsigned* st;
};

__device__ __forceinline__ XcdBarrier xcd_barrier_post(unsigned* bar, volatile LAS unsigned* st) {
    XcdBarrier b; b.bar = bar; b.x = xb_xcc_id(); b.st = st;
    if (threadIdx.x == 0) (void)xb_add(&bar[XB_XCNT(b.x)], 1u);
    return b;
}
__device__ __forceinline__ void xcd_barrier_complete(unsigned* bar, unsigned x, unsigned& nloc, unsigned& nx) {
    const unsigned G = gridDim.x * gridDim.y * gridDim.z;
    unsigned sum, cnt, mine, sp = 0u;
    for (;;) {
        sum = 0u; cnt = 0u; mine = 0u;
#pragma unroll
        for (unsigned j = 0; j < 16; ++j) { const unsigned c = xb_ld(&bar[XB_XCNT(j)]); sum += c; cnt += (c > 0u) ? 1u : 0u; mine = (j == x) ? c : mine; }
        if (sum == G) break;
        __builtin_amdgcn_s_sleep(1);
        if ((++sp & 255u) == 0u) { if (xb_ld(&bar[XB_TMO])) break; if (sp > XB_SPIN_CAP) { atomicAdd(&bar[XB_TMO], 1u); break; } }
    }
    nloc = mine > 0u ? mine : 1u; nx = cnt > 0u ? cnt : 1u;
}

__device__ __forceinline__ void xcd_barrier(const XcdBarrier& b) {
    asm volatile("s_waitcnt vmcnt(0)" ::: "memory");
    __syncthreads();
    if (threadIdx.x == 0) {
        unsigned* bar = b.bar;
        __builtin_amdgcn_s_waitcnt(0);
        unsigned nloc = b.st[0], nx = b.st[1];
        if (nloc == 0u) { xcd_barrier_complete(bar, b.x, nloc, nx); b.st[0] = nloc; b.st[1] = nx; }
        const unsigned old = xb_add(&bar[XB_XSUB(b.x)], 1u);
        const unsigned gen = old / nloc;
        if (old + 1u == (gen + 1u) * nloc) {
            __builtin_amdgcn_fence(__ATOMIC_RELEASE, "agent");
            asm volatile("s_waitcnt vmcnt(0)" ::: "memory");
            const unsigned og = xb_add(&bar[XB_TOP], 1u);
            const unsigned tg = og / nx;
            if (og + 1u == (tg + 1u) * nx) xb_add(&bar[XB_TOPGEN], 1u);
            else XB_SPIN(xb_ld(&bar[XB_TOPGEN]) == tg, bar);
            __builtin_amdgcn_fence(__ATOMIC_ACQUIRE, "agent");
            xb_add(&bar[XB_XGEN(b.x)], 1u);
            asm volatile("s_waitcnt vmcnt(0)" ::: "memory");
        } else {
            XB_SPIN(xb_ld(&bar[XB_XGEN(b.x)]) == gen, bar);
            __builtin_amdgcn_fence(__ATOMIC_ACQUIRE, "agent");
            asm volatile("s_waitcnt vmcnt(0)" ::: "memory");
        }
    }
    __syncthreads();
}

__device__ __forceinline__ float wave_sum(float v) {
#pragma unroll
    for (int o = 1; o < 64; o <<= 1) v += __shfl_xor(v, o);
    return v;
}
__device__ __forceinline__ float wave_max(float v) {
#pragma unroll
    for (int o = 1; o < 64; o <<= 1) v = fmaxf(v, __shfl_xor(v, o));
    return v;
}
__device__ __forceinline__ int dest_block(int blk, int map) {
    if (map == 1) { const int s = blk & 7; return (blk & ~7) + 4 * (s & 1) + (s >> 1); }
    if (map == 2) return (blk >> 2) * 8 + (blk & 3);
    if (map == 3) return (blk >> 2) * 8 + 4 + (blk & 3);
    return blk;
}
__device__ __forceinline__ void tr_tile(const float* W, int K, int N, bf16* WT, int map, const float* gain, LAS unsigned* scr, int item, int lane) {
    const int nblk = N / 64, kb = item / nblk, nb = item % nblk, k0 = 64 * kb, n0 = 64 * nb;
    const int c = lane & 15, ip = lane >> 4;
#pragma unroll
    for (int it = 0; it < 8; ++it) { const int kp = it * 4 + ip, k = k0 + 2 * kp;
        f32x4 a = *(const GAS f32x4*)(W + (size_t)k * N + n0 + 4 * c), b = *(const GAS f32x4*)(W + (size_t)(k + 1) * N + n0 + 4 * c);
        if (gain) { a = a * gain[k]; b = b * gain[k + 1]; }
#pragma unroll
        for (int j = 0; j < 4; ++j) scr[(4 * c + j) * 33 + kp] = pk2(a[j], b[j]); }
    LDS_WAIT(); asm volatile("" ::: "memory");
#pragma unroll
    for (int it = 0; it < 8; ++it) { const int n = it * 8 + (lane >> 3), q = lane & 7;
        v4u o; o.x = scr[n * 33 + 4 * q]; o.y = scr[n * 33 + 4 * q + 1]; o.z = scr[n * 33 + 4 * q + 2]; o.w = scr[n * 33 + 4 * q + 3];
        const int drow = dest_block((n0 + n) >> 5, map) * 32 + (n & 31);
        *(GAS v4u*)(WT + (size_t)drow * K + k0 + 8 * q) = o; }
    LDS_WAIT(); asm volatile("" ::: "memory");
}

__device__ __forceinline__ void tr_tile8(const float* W, int K, int N, unsigned char* WT, int map, const float* gain, float wscale, LAS unsigned* scr, int item, int lane) {
    const int nblk = N / 64, kb = item / nblk, nb = item % nblk, k0 = 64 * kb, n0 = 64 * nb;
    const int c = lane & 15, ip = lane >> 4;
#pragma unroll
    for (int it = 0; it < 4; ++it) { const int k4 = it * 4 + ip, k = k0 + 4 * k4; f32x4 a[4];
#pragma unroll
        for (int i = 0; i < 4; ++i) a[i] = *(const GAS f32x4*)(W + (size_t)(k + i) * N + n0 + 4 * c) * ((gain ? gain[k + i] : 1.f) * wscale);
#pragma unroll
        for (int j = 0; j < 4; ++j) scr[(4 * c + j) * 17 + k4] = pg8::pk4_fp8(a[0][j], a[1][j], a[2][j], a[3][j]); }
    LDS_WAIT(); asm volatile("" ::: "memory");
#pragma unroll
    for (int it = 0; it < 4; ++it) { const int n = it * 16 + (lane >> 2), q = lane & 3;
        v4u o; o.x = scr[n * 17 + 4 * q]; o.y = scr[n * 17 + 4 * q + 1]; o.z = scr[n * 17 + 4 * q + 2]; o.w = scr[n * 17 + 4 * q + 3];
        const int drow = dest_block((n0 + n) >> 5, map) * 32 + (n & 31);
        *(GAS v4u*)(WT + (size_t)drow * K + k0 + 16 * q) = o; }
    LDS_WAIT(); asm volatile("" ::: "memory");
}

struct TrItem { const float* W; unsigned char* WT; const float* gain; int K, N, map, fp8, k0, n0; float scale; };
__device__ __forceinline__ void tr_load(const TrItem& d, f32x4 (&a)[16], float (&g)[16], int lane) {
    const int c = lane & 15, ip = lane >> 4;
#pragma unroll
    for (int it = 0; it < 4; ++it)
#pragma unroll
        for (int i = 0; i < 4; ++i) { const int k = d.k0 + 4 * (it * 4 + ip) + i;
            a[it * 4 + i] = __builtin_nontemporal_load((const GAS f32x4*)(d.W + (size_t)k * d.N + d.n0 + 4 * c)); g[it * 4 + i] = d.gain ? d.gain[k] : 1.f; }
}
__device__ __forceinline__ void tr_emit(const TrItem& d, const f32x4 (&a)[16], const float (&g)[16], LAS unsigned* scr, int lane) {
    const int c = lane & 15, ip = lane >> 4;
    if (d.fp8) {
#pragma unroll
        for (int it = 0; it < 4; ++it) { const int k4 = it * 4 + ip;
#pragma unroll
            for (int j = 0; j < 4; ++j) scr[(4 * c + j) * 17 + k4] = pg8::pk4_fp8(a[it * 4][j] * (g[it * 4] * d.scale), a[it * 4 + 1][j] * (g[it * 4 + 1] * d.scale), a[it * 4 + 2][j] * (g[it * 4 + 2] * d.scale), a[it * 4 + 3][j] * (g[it * 4 + 3] * d.scale)); }
        LDS_WAIT(); asm volatile("" ::: "memory");
#pragma unroll
        for (int it = 0; it < 4; ++it) { const int n = it * 16 + (lane >> 2), q = lane & 3;
            v4u o; o.x = scr[n * 17 + 4 * q]; o.y = scr[n * 17 + 4 * q + 1]; o.z = scr[n * 17 + 4 * q + 2]; o.w = scr[n * 17 + 4 * q + 3];
            const int drow = dest_block((d.n0 + n) >> 5, d.map) * 32 + (n & 31);
            __builtin_nontemporal_store(o, (GAS v4u*)(d.WT + (size_t)drow * d.K + d.k0 + 16 * q)); }
    } else {
#pragma unroll
        for (int it = 0; it < 4; ++it) { const int k4 = it * 4 + ip;
#pragma unroll
            for (int j = 0; j < 4; ++j) { scr[(4 * c + j) * 33 + 2 * k4] = pk2(a[it * 4][j] * g[it * 4], a[it * 4 + 1][j] * g[it * 4 + 1]); scr[(4 * c + j) * 33 + 2 * k4 + 1] = pk2(a[it * 4 + 2][j] * g[it * 4 + 2], a[it * 4 + 3][j] * g[it * 4 + 3]); } }
        LDS_WAIT(); asm volatile("" ::: "memory");
#pragma unroll
        for (int it = 0; it < 8; ++it) { const int n = it * 8 + (lane >> 3), q = lane & 7;
            v4u o; o.x = scr[n * 33 + 4 * q]; o.y = scr[n * 33 + 4 * q + 1]; o.z = scr[n * 33 + 4 * q + 2]; o.w = scr[n * 33 + 4 * q + 3];
            const int drow = dest_block((d.n0 + n) >> 5, d.map) * 32 + (n & 31);
            __builtin_nontemporal_store(o, (GAS v4u*)(d.WT + ((size_t)drow * d.K + d.k0 + 8 * q) * 2)); }
    }
    LDS_WAIT(); asm volatile("" ::: "memory");
}
constexpr float AO8_SCALE = 16.f;
constexpr float W8_SCALE = 64.f;

#ifndef PROBE_MASK
#define PROBE_MASK 0
#endif
struct KArgs { const void* in[27]; float* out; unsigned char* ws; int ph_lo, ph_hi, flags, pad; };

struct KArgs;
__device__ __forceinline__ const void* karg_in(const KArgs& a, int k) { asm volatile("" : "+s"(k)); return a.in[k]; }
__global__ void __launch_bounds__(NTHR, 2) fwd_kernel(KArgs args) {
    extern __shared__ __attribute__((aligned(16))) unsigned char lds_raw[];
    LAS unsigned char* lds = (LAS unsigned char*)lds_raw;
    volatile LAS unsigned* MISC = (volatile LAS unsigned*)(lds + MISC_OFF);
    const int tid = threadIdx.x, lane = tid & 63, wave = __builtin_amdgcn_readfirstlane(tid >> 6);
    const int G = gridDim.x; const int bx = blockIdx.x; const int vcu = (G % 8 == 0) ? (bx % 8) * (G / 8) + bx / 8 : bx;
    unsigned char* ws = args.ws;
    unsigned* ctl = (unsigned*)ws;
    for (int u = tid; u < (LDS_BYTES - RING_BYTES) / 4; u += NTHR) ((LAS unsigned*)(lds + RING_BYTES))[u] = 0u;
    __syncthreads();
    XcdBarrier bar = xcd_barrier_post(ctl + CW_BAR, MISC + 8);
    const int lo = args.ph_lo, hi_ph = args.ph_hi;
#define IN(k) (lo <= (k) && (k) < hi_ph)
#define REP(k)
#define SEAM(k) do { if (IN(k) && IN((k) + 1)) xcd_barrier(bar); } while (0)
#define KIN(T, k) ((const T*)karg_in(args, (k)))
#define x_in KIN(float, 0)
#define positions KIN(int, 1)
#define ev_attn_norm KIN(float, 2)
#define ev_w_in KIN(float, 3)
#define ev_q_norm KIN(float, 4)
#define ev_k_norm KIN(float, 5)
#define ev_lq1 KIN(float, 6)
#define ev_lk1 KIN(float, 7)
#define ev_lq2 KIN(float, 8)
#define ev_lk2 KIN(float, 9)
#define ev_subln KIN(float, 10)
#define ev_w_out KIN(float, 11)
#define ev_ffn_norm KIN(float, 12)
#define ev_w_gate KIN(float, 13)
#define ev_w_up KIN(float, 14)
#define ev_w_down KIN(float, 15)
#define od_attn_norm KIN(float, 16)
#define od_w_qkv KIN(float, 17)
#define od_q_norm KIN(float, 18)
#define od_k_norm KIN(float, 19)
#define od_rel_bias KIN(float, 20)
#define od_w_out KIN(float, 21)
#define od_ffn_norm KIN(float, 22)
#define od_router KIN(float, 23)
#define od_we_gate KIN(float, 24)
#define od_we_up KIN(float, 25)
#define od_we_down KIN(float, 26)
    float* out = args.out;
    float* ss0 = (float*)(ws + WS_SS0); float* ss1 = (float*)(ws + WS_SS1); float* ss2 = (float*)(ws + WS_SS2); float* ss3 = (float*)(ws + WS_SS3);
    float* rope = (float*)(ws + WS_ROPE); unsigned* toksel = (unsigned*)(ws + WS_TOKSEL); float* tokgate = (float*)(ws + WS_TOKGATE);
    int* rowtok = (int*)(ws + WS_ROWTOK); float* rowgate = (float*)(ws + WS_ROWGATE);
    bf16* XB = (bf16*)(ws + WS_XB); bf16* AO = (bf16*)(ws + WS_AO); bf16* ACT0 = (bf16*)(ws + WS_ACT0); float* XF = (float*)(ws + WS_XF); bf16* OD = (bf16*)(ws + WS_XF);
    bf16* Win_t = (bf16*)(ws + WS_WIN); bf16* Wo0_t = (bf16*)(ws + WS_WO0); bf16* Wgu0_t = (bf16*)(ws + WS_WGU0); bf16* Wd0_t = (bf16*)(ws + WS_WD0);
    unsigned char* Wqkv8 = ws + WS_WQKV; unsigned char* Wo18 = ws + WS_WO1; unsigned char* XB8 = ws + WS_XB; unsigned char* AO8 = ws + WS_AO; unsigned char* WEgu8 = ws + WS_WEGU; unsigned char* WEd8 = ws + WS_WED;
    unsigned char* SORTA8 = ws + WS_SORTA; unsigned char* ACTE8 = ws + WS_ACTE;
    const int gw = vcu * NWAVES + wave, NGW = G * NWAVES;

    constexpr int I_IN = 16 * 48, I_O = 16 * 16, I_G = 16 * 44, I_D = 44 * 16, I_EG = 16 * 56, I_ED = 56 * 16;
    constexpr int NSMALL = I_IN + I_O + 2 * I_G + I_D + I_IN + I_O, NITEMS = NSMALL + 24 * I_EG;
        auto decode = [&](int it) -> TrItem {
        TrItem d; int r = it; d.scale = 1.f; d.fp8 = 0; d.gain = nullptr; d.map = 0;
        auto fin = [&](int nbl) { d.k0 = 64 * (r / nbl); d.n0 = 64 * (r % nbl); };
        if (r < I_IN) { d.W = ev_w_in; d.K = D; d.N = NPROJ; d.WT = (unsigned char*)Win_t; d.map = 1; d.gain = ev_attn_norm; fin(NPROJ / 64); return d; } r -= I_IN;
        if (r < I_O) { d.W = ev_w_out; d.K = D; d.N = D; d.WT = (unsigned char*)Wo0_t; fin(D / 64); return d; } r -= I_O;
        if (r < I_G) { d.W = ev_w_gate; d.K = D; d.N = FFD; d.WT = (unsigned char*)Wgu0_t; d.map = 2; d.gain = ev_ffn_norm; fin(FFD / 64); return d; } r -= I_G;
        if (r < I_G) { d.W = ev_w_up; d.K = D; d.N = FFD; d.WT = (unsigned char*)Wgu0_t; d.map = 3; d.gain = ev_ffn_norm; fin(FFD / 64); return d; } r -= I_G;
        if (r < I_D) { d.W = ev_w_down; d.K = FFD; d.N = D; d.WT = (unsigned char*)Wd0_t; fin(D / 64); return d; } r -= I_D;
        d.fp8 = 1; d.scale = W8_SCALE;
        if (r < I_IN) { d.W = od_w_qkv; d.K = D; d.N = NPROJ; d.WT = Wqkv8; d.map = 1; d.gain = od_attn_norm; fin(NPROJ / 64); return d; } r -= I_IN;
        if (r < I_O) { d.W = od_w_out; d.K = D; d.N = D; d.WT = Wo18; fin(D / 64); return d; } r -= I_O;
        const int which = r / (8 * I_EG), rr = r % (8 * I_EG), e2 = rr / I_EG; r = rr % I_EG;
        if (which == 0) { d.W = od_we_gate + (size_t)e2 * D * FFE; d.K = D; d.N = FFE; d.WT = WEgu8 + (size_t)e2 * 2 * FFE * D; d.map = 2; d.gain = od_ffn_norm; fin(FFE / 64); }
        else if (which == 1) { d.W = od_we_up + (size_t)e2 * D * FFE; d.K = D; d.N = FFE; d.WT = WEgu8 + (size_t)e2 * 2 * FFE * D; d.map = 3; d.gain = od_ffn_norm; fin(FFE / 64); }
        else { d.W = od_we_down + (size_t)e2 * FFE * D; d.K = FFE; d.N = D; d.WT = WEd8 + (size_t)e2 * D * FFE; fin(D / 64); }
        return d; };
    auto conv_range = [&](int first, int end, int stride) {
        LAS unsigned* scr = (LAS unsigned*)(lds + wave * 8704);
        f32x4 bufA[16], bufB[16]; float gA[16], gB[16]; TrItem dA, dB; int it = first;
        if (it < end) { dA = decode(it); tr_load(dA, bufA, gA, lane); }
        while (it < end) {
            const int it2 = it + stride, it3 = it2 + stride;
            if (it2 < end) { dB = decode(it2); tr_load(dB, bufB, gB, lane); }
            tr_emit(dA, bufA, gA, scr, lane);
            if (it3 < end) { dA = decode(it3); tr_load(dA, bufA, gA, lane); }
            if (it2 < end) tr_emit(dB, bufB, gB, scr, lane);
            it = it3; } };
    auto pull = [&](int qword) -> int {
        __syncthreads(); if (tid == 0) MISC[16] = __hip_atomic_fetch_add(ctl + qword, 1u, __ATOMIC_RELAXED, __HIP_MEMORY_SCOPE_AGENT); __syncthreads();
        return __builtin_amdgcn_readfirstlane((int)MISC[16]); };

    REP(0) if (IN(0)) {
        conv_range(gw, I_IN, NGW);
        for (int m = gw; m < T; m += NGW) {
            const GAS f32x4* xr = (const GAS f32x4*)(x_in + (size_t)m * D) + lane; f32x4 v[4]; float s = 0.f;
#pragma unroll
            for (int j = 0; j < 4; ++j) { v[j] = xr[64 * j]; s += (v[j].x * v[j].x + v[j].y * v[j].y) + (v[j].z * v[j].z + v[j].w * v[j].w); }
            s = wave_sum(s); if (lane == 0) ss0[m] = s;
            GAS unsigned long long* o8 = (GAS unsigned long long*)(XB + (size_t)m * D) + lane;
#pragma unroll
            for (int j = 0; j < 4; ++j) o8[64 * j] = (unsigned long long)pk2(v[j].x, v[j].y) | ((unsigned long long)pk2(v[j].z, v[j].w) << 32);
        }
        for (int i = vcu * NTHR + tid; i < T * 8; i += G * NTHR) {
            const int tok = i >> 3, f = i & 7;
            const double inv = exp2(-(double)f * (18.931568569324174 / 8.0));
            double ang = (double)positions[tok] * inv; ang -= 6.283185307179586 * rint(ang * 0.15915494309189535);
            float sn, cs; sincosf((float)ang, &sn, &cs);
            rope[(size_t)tok * 16 + f] = cs; rope[(size_t)tok * 16 + 8 + f] = sn;
        }
    }
    SEAM(0);

    REP(1) if (IN(1)) {
        pg8::Gemm g{XB, Win_t, T, NPROJ, D}; pg8::StaticOrder S; S.init(T, NPROJ, G, bx);
        pg8::EpiProj E{ACT0, T, ss0, 1, ev_q_norm, ev_k_norm, rope, 0, 1.f};
        pg8::gemm_phase<pg8::EpiProj, pg8::StaticOrder, true, true>(lds, g, S, E);
    }
    SEAM(1);

    REP(2) if (IN(2)) {
        const float gqm = wave_max(fabsf(ev_q_norm[lane])), gkm = wave_max(fabsf(ev_k_norm[lane]));
        const float mref = 8.f * gqm * gkm * pg8::LOG2E;
        constexpr int NJOBS = (NITEMS - I_IN + 63) / 64;
        const bool conv_first = ((bx >> 3) & 3) == 3;
#define P2_CONV_LOOP() for (;;) { const int j = pull(CW_QCONV); if (j >= NJOBS) break; \
            const int first = I_IN + j * 64 + wave * 8; conv_range(first, (first + 8 < NITEMS) ? first + 8 : NITEMS, 1); }
        if (conv_first) P2_CONV_LOOP()
#pragma unroll 1
        for (int kq = 0; kq < 8; ++kq) { const int xq = (bx + kq) & 7;
            for (;;) { const int idx = pull(CW_QATT + 64 * xq); if (idx >= 128) break;
                if (idx < 64) { if (args.flags & 1) continue;
                    const int bhm = 2 * xq + (idx & 1), qb = 31 - (idx >> 1);
                    const int b = bhm >> 3, hm = bhm & 7, h = hm >> 1;
                    const bf16* base = ACT0 + (size_t)b * SEQ * 64;
                    att::attn_unit<0, 128, false, 1>((LAS char*)lds, base + (size_t)(24 + hm) * T * 64, base + (size_t)(32 + hm) * T * 64, base + (size_t)(40 + 2 * h) * T * 64, OD + (size_t)b * SEQ * D + hm * 128, D, qb * 256, mref, nullptr, 1.f, args.flags);
                } else { if (args.flags & 2) continue;
                    const int bh = 2 * xq + (idx & 1), qb = 31 - ((idx - 64) >> 1);
                    const int b = bh >> 3, h = bh & 7;
                    const bf16* base = ACT0 + (size_t)b * SEQ * 64;
                    att::attn_unit<2, 64>((LAS char*)lds, base + (size_t)h * T * 64, base + (size_t)(8 + h) * T * 64, base + (size_t)(16 + h) * T * 64, AO + (size_t)b * SEQ * D + h * 64, D, qb * 256, 0.f, nullptr);
                }
            }
        }
        P2_CONV_LOOP()
#undef P2_CONV_LOOP
    }
    SEAM(2);

    REP(3) if (IN(3)) {
        const float a1 = wave_sum(ev_lq1[lane] * ev_lk1[lane]), a2 = wave_sum(ev_lq2[lane] * ev_lk2[lane]);
        const float lam_init = 0.2f, lam = expf(a1) - expf(a2) + lam_init;
        const int h = lane >> 4, v0 = (lane & 15) * 8;
        float sg[8];
#pragma unroll
        for (int j = 0; j < 8; ++j) sg[j] = ev_subln[v0 + j] * (1.f - lam_init);
        for (int m = gw; m < T; m += NGW) {
            const v4u a = *(const GAS v4u*)(OD + (size_t)m * D + (2 * h) * 128 + v0), b = *(const GAS v4u*)(OD + (size_t)m * D + (2 * h + 1) * 128 + v0);
            float d[8]; float s = 0.f;
#pragma unroll
            for (int j = 0; j < 4; ++j) { const unsigned ua = a[j], ub = b[j];
                d[2 * j] = bf2f((unsigned short)(ua & 0xffffu)) - lam * bf2f((unsigned short)(ub & 0xffffu));
                d[2 * j + 1] = bf2f((unsigned short)(ua >> 16)) - lam * bf2f((unsigned short)(ub >> 16));
                s += d[2 * j] * d[2 * j] + d[2 * j + 1] * d[2 * j + 1]; }
            s += __shfl_xor(s, 1); s += __shfl_xor(s, 2); s += __shfl_xor(s, 4); s += __shfl_xor(s, 8);
            const float rs = rsqrtf(s * (1.f / 128.f) + pg8::RMS_EPS);
            v4u o; o.x = pk2(d[0] * rs * sg[0], d[1] * rs * sg[1]); o.y = pk2(d[2] * rs * sg[2], d[3] * rs * sg[3]); o.z = pk2(d[4] * rs * sg[4], d[5] * rs * sg[5]); o.w = pk2(d[6] * rs * sg[6], d[7] * rs * sg[7]);
            *(GAS v4u*)(AO + (size_t)m * D + 512 + h * 128 + v0) = o;
        }
    }
    SEAM(3);

    REP(4) if (IN(4)) {
        pg8::Gemm g{AO, Wo0_t, T, D, D}; pg8::StaticOrder S; S.init(T, D, G, bx);
        pg8::EpiResid E{x_in, XF, XB, ss1, 1.f, nullptr};
        pg8::gemm_phase<pg8::EpiResid, pg8::StaticOrder, false, true>(lds, g, S, E);
    }
    SEAM(4);

    REP(5) if (IN(5)) {
        pg8::Gemm g{XB, Wgu0_t, T, 2 * FFD, D}; pg8::StaticOrder S; S.init(T, 2 * FFD, G, bx, (args.flags >> 9) & 1);
        pg8::EpiSwiglu<false> E{ACT0, FFD, ss1, 16, nullptr, 0, 2 * FFD / 256, 1.f};
        pg8::gemm_phase<pg8::EpiSwiglu<false>, pg8::StaticOrder, true, true>(lds, g, S, E);
    }
    SEAM(5);

    if (IN(6)) {
        pg8::Gemm g{ACT0, Wd0_t, T, D, FFD}; pg8::StaticOrder S; S.init(T, D, G, bx);
        pg8::EpiResid E{XF, XF, nullptr, ss2, 1.f, XB8};
        pg8::gemm_phase<pg8::EpiResid, pg8::StaticOrder, false, true>(lds, g, S, E);
    }
    SEAM(6);

    REP(7) if (IN(7)) {
        pg8::Gemm g{(const bf16*)XB8, (const bf16*)Wqkv8, T, NPROJ, D / 2}; pg8::StaticOrder S; S.init(T, NPROJ, G, bx);
        pg8::EpiProj E{ACT0, T, ss2, 16, od_q_norm, od_k_norm, nullptr, 1, 1.f / W8_SCALE};
        pg8::gemm_phase<pg8::EpiProj, pg8::StaticOrder, true, true, true>(lds, g, S, E);
    }
    SEAM(7);

    REP(8) if (IN(8)) {
        const float gqm = wave_max(fabsf(od_q_norm[lane])), gkm = wave_max(fabsf(od_k_norm[lane]));
        for (int L = vcu; L < 1024; L += G) {
            const int bh = (L & 255) >> 3, qb = 4 * (L & 7) + (L >> 8);
            const int b = bh >> 4, h = bh & 15;
            const float* tab = od_rel_bias + h * 257;
            float tm = fabsf(tab[lane]); tm = fmaxf(tm, fabsf(tab[64 + lane])); tm = fmaxf(tm, fabsf(tab[128 + lane])); tm = fmaxf(tm, fabsf(tab[192 + lane])); tm = fmaxf(tm, fabsf(tab[256]));
            tm = wave_max(tm);
            const float mref = (8.f * gqm * gkm + tm) * pg8::LOG2E;
            const bf16* base = ACT0 + (size_t)b * SEQ * 64;
            att::attn_unit<1, 64, true, 1>((LAS char*)lds, base + (size_t)h * T * 64, base + (size_t)(16 + h) * T * 64, base + (size_t)(32 + h) * T * 64, AO8 + (size_t)b * SEQ * D + h * 64, D, qb * 256, mref, tab, AO8_SCALE);
        }
    }
    SEAM(8);

    REP(9) if (IN(9)) {
        pg8::Gemm g{(const bf16*)AO8, (const bf16*)Wo18, T, D, D / 2}; pg8::StaticOrder S; S.init(T, D, G, bx);
        pg8::EpiResid E{XF, out, nullptr, nullptr, 1.f / (W8_SCALE * AO8_SCALE), nullptr};
        pg8::gemm_phase<pg8::EpiResid, pg8::StaticOrder, false, true, true>(lds, g, S, E);
    }
    SEAM(9);

    REP(10) if (IN(10)) {
        LAS float* wrT = (LAS float*)lds;
        LAS unsigned* sel = (LAS unsigned*)(lds + 32768);
        for (int i = tid; i < 1024; i += NTHR) { const float gn = od_ffn_norm[i]; const f32x4 w0 = *(const GAS f32x4*)(od_router + (size_t)i * 8), w1 = *(const GAS f32x4*)(od_router + (size_t)i * 8 + 4);
            wrT[i] = w0.x * gn; wrT[1024 + i] = w0.y * gn; wrT[2048 + i] = w0.z * gn; wrT[3072 + i] = w0.w * gn; wrT[4096 + i] = w1.x * gn; wrT[5120 + i] = w1.y * gn; wrT[6144 + i] = w1.z * gn; wrT[7168 + i] = w1.w * gn; }
        __syncthreads();
        for (int blk = vcu; blk < T / 64; blk += G) {
#pragma unroll 1
            for (int q4 = 0; q4 < 2; ++q4) {
                const int tok0 = blk * 64 + wave * 8 + q4 * 4;
                f32x4 xv[4][4]; float s[4]; float lg[4][8];
#pragma unroll
                for (int t4 = 0; t4 < 4; ++t4) { const GAS f32x4* xr = (const GAS f32x4*)(out + (size_t)(tok0 + t4) * D) + lane;
#pragma unroll
                    for (int j = 0; j < 4; ++j) xv[t4][j] = xr[64 * j]; }
#pragma unroll
                for (int t4 = 0; t4 < 4; ++t4) { s[t4] = 0.f;
#pragma unroll
                    for (int e2 = 0; e2 < 8; ++e2) lg[t4][e2] = 0.f;
#pragma unroll
                    for (int j = 0; j < 4; ++j) { const f32x4 v = xv[t4][j]; s[t4] += (v.x * v.x + v.y * v.y) + (v.z * v.z + v.w * v.w); } }
#pragma unroll
                for (int j = 0; j < 4; ++j)
#pragma unroll
                    for (int e2 = 0; e2 < 8; ++e2) { const f32x4 w = *(const LAS f32x4*)(wrT + e2 * 1024 + 256 * j + 4 * lane);
#pragma unroll
                        for (int t4 = 0; t4 < 4; ++t4) { const f32x4 v = xv[t4][j]; lg[t4][e2] += (v.x * w.x + v.y * w.y) + (v.z * w.z + v.w * w.w); } }
#pragma unroll
                for (int t4 = 0; t4 < 4; ++t4) { s[t4] = wave_sum(s[t4]);
#pragma unroll
                    for (int e2 = 0; e2 < 8; ++e2) lg[t4][e2] = wave_sum(lg[t4][e2]); }
                if (lane == 0) {
#pragma unroll
                    for (int t4 = 0; t4 < 4; ++t4) { const int tok = tok0 + t4;
                        const float r = rsqrtf(s[t4] * (1.f / 1024.f) + pg8::RMS_EPS); ss3[tok] = s[t4];
                        int e0 = 0; float v0 = lg[t4][0];
#pragma unroll
                        for (int e2 = 1; e2 < 8; ++e2) if (lg[t4][e2] > v0) { v0 = lg[t4][e2]; e0 = e2; }
                        int e1 = -1; float v1 = 0.f;
#pragma unroll
                        for (int e2 = 0; e2 < 8; ++e2) if (e2 != e0 && (e1 < 0 || lg[t4][e2] > v1)) { v1 = lg[t4][e2]; e1 = e2; }
                        const float ex = expf((v1 - v0) * r), g0 = 1.f / (1.f + ex), g1 = ex / (1.f + ex);
                        sel[wave * 8 + q4 * 4 + t4] = (unsigned)e0 | ((unsigned)e1 << 8); tokgate[2 * tok] = g0; tokgate[2 * tok + 1] = g1; }
                }
            }
            __syncthreads();
            if (wave == 0) { const unsigned sv = sel[lane]; const int e0 = sv & 0xff, e1 = sv >> 8; unsigned rank0 = 0, rank1 = 0;
                const unsigned long long lt = (1ull << lane) - 1ull;
#pragma unroll
                for (int e = 0; e < 8; ++e) { const unsigned long long m0 = __ballot(e0 == e), m1 = __ballot(e1 == e);
                    if (e0 == e) rank0 = __popcll(m0 & lt); if (e1 == e) rank1 = __popcll(m1 & lt);
                    if (lane == 0) { ctl[CW_HIST + blk * 16 + e] = __popcll(m0); ctl[CW_HIST + blk * 16 + 8 + e] = __popcll(m1); } }
                toksel[blk * 64 + lane] = sv | (rank0 << 16) | (rank1 << 24); }
            __syncthreads();
        }
    }
    SEAM(10);

    REP(11) if (IN(11)) {
        LAS unsigned* hs = (LAS unsigned*)lds;
        for (int i = tid; i < 4096; i += NTHR) hs[i] = ctl[CW_HIST + i];
        __syncthreads();
        if (tid < 16) hs[4096 + tid] = 0u;
        __syncthreads();
        { unsigned s = 0; const int g2 = tid & 15;
#pragma unroll
          for (int b2 = tid >> 4; b2 < 256; b2 += 32) s += hs[b2 * 16 + g2];
          atomicAdd((unsigned*)&hs[4096 + g2], s); }
        __syncthreads();
        if (tid == 0) { unsigned acc = 0; for (int g2 = 0; g2 < 16; ++g2) { hs[4128 + g2] = acc; acc += (hs[4096 + g2] + 255u) & ~255u; } hs[4128 + 16] = acc; }
        __syncthreads();
        if (bx == 0) {
            if (tid == 0) { const int nA = (int)(hs[4128 + 8] >> 8), nT = (int)(hs[4128 + 16] >> 8), nC1 = (nT - nA + 1) / 2, nC2 = nT - nA - nC1;
                ctl[CW_MOE] = nA; ctl[CW_MOE + 1] = nT;
                for (int ph = 0; ph < 2; ++ph) { const int nd = (ph == 0 ? nA : nC1) * (D / 256), nu = (ph == 0 ? nC1 : nC2) * (2 * FFE / 256);
                    int H = nd > G ? nd - G : (nd < G ? nd : 0); int mode = 1, R = 0; if (H >= G) H = 0;
                    pg8::MoeOrder::plan(nu, H, G, D / 128, FFE / 128, mode, R);
                    ctl[CW_MOE + 2 + 3 * ph] = H; ctl[CW_MOE + 3 + 3 * ph] = R; ctl[CW_MOE + 4 + 3 * ph] = mode; } }
            if (tid < 16) { const unsigned t0 = hs[4128 + tid] >> 8, t1 = hs[4128 + tid + 1] >> 8; for (unsigned t = t0; t < t1; ++t) ctl[CW_MOE + 16 + t] = tid & 7; }
        }
        for (int blk = vcu; blk < T / 64; blk += G) {
            if (tid < 16) hs[4160 + tid] = 0u;
            __syncthreads();
            { unsigned s = 0; const int g2 = tid & 15;
#pragma unroll
              for (int b2 = tid >> 4; b2 < 256; b2 += 32) s += (b2 < blk) ? hs[b2 * 16 + g2] : 0u;
              atomicAdd((unsigned*)&hs[4160 + g2], s); }
            __syncthreads();
            for (int tl = wave; tl < 64; tl += NWAVES) {
                const int tok = blk * 64 + tl; const unsigned sv = toksel[tok];
                const GAS f32x4* xr = (const GAS f32x4*)(out + (size_t)tok * D + 16 * lane); const f32x4 v0 = xr[0], v1 = xr[1], v2 = xr[2], v3 = xr[3];
                v4u pk; pk.x = pg8::pk4_fp8(v0[0], v0[1], v0[2], v0[3]); pk.y = pg8::pk4_fp8(v1[0], v1[1], v1[2], v1[3]); pk.z = pg8::pk4_fp8(v2[0], v2[1], v2[2], v2[3]); pk.w = pg8::pk4_fp8(v3[0], v3[1], v3[2], v3[3]);
#pragma unroll
                for (int sl = 0; sl < 2; ++sl) { const int e = (sv >> (8 * sl)) & 0xff, rank = (sv >> (16 + 8 * sl)) & 0xff, g2 = sl * 8 + e;
                    const unsigned srow = hs[4128 + g2] + hs[4160 + g2] + rank;
                    *(GAS v4u*)(SORTA8 + (size_t)srow * D + lane * 16) = pk;
                    if (lane == 0) { rowtok[srow] = tok; rowgate[srow] = tokgate[2 * tok + sl]; } }
            }
            __syncthreads();
        }
        for (int g2 = vcu; g2 < 16; g2 += G) {
            const unsigned r0 = hs[4128 + g2] + hs[4096 + g2], r1 = hs[4128 + g2 + 1];
            for (unsigned r = r0 + wave; r < r1; r += NWAVES) { if (lane == 0) { rowtok[r] = -1; rowgate[r] = 0.f; }
                *(GAS v4u*)(SORTA8 + (size_t)r * D + lane * 16) = (v4u){0u, 0u, 0u, 0u}; }
        }
    }
    SEAM(11);

    if (IN(12) || IN(13) || IN(14) || IN(15)) {
        const int nA = (int)__builtin_amdgcn_readfirstlane(ctl[CW_MOE]), nT = (int)__builtin_amdgcn_readfirstlane(ctl[CW_MOE + 1]);
        const int nC1 = (nT - nA + 1) / 2, nC2 = nT - nA - nC1;
        const int* texp = (const int*)(ctl + CW_MOE + 16);
        unsigned char* const ACT_C0 = ACTE8; unsigned char* const ACT_C1 = ACTE8 + (size_t)63 * MiB; unsigned char* const ACT_C2 = ACT_C1 + (size_t)36 * 256 * FFE;
        constexpr int NPN_GU = 2 * FFE / 256, NPN_D = D / 256;
#define MOE_GU(TILE0, NTILE, ACTBUF, PLAN) do { int H_ = 0, R_ = 0, mode_ = 1; \
        if ((PLAN) >= 0) { H_ = (int)__builtin_amdgcn_readfirstlane(ctl[CW_MOE + 2 + 3 * (PLAN)]); R_ = (int)__builtin_amdgcn_readfirstlane(ctl[CW_MOE + 3 + 3 * (PLAN)]); mode_ = (int)__builtin_amdgcn_readfirstlane(ctl[CW_MOE + 4 + 3 * (PLAN)]); } \
        pg8::Gemm g{(const bf16*)(SORTA8 + (size_t)(TILE0) * 256 * D), (const bf16*)WEgu8, 0, 0, D / 2}; pg8::MoeOrder S; S.init((NTILE), NPN_GU, G, bx, (TILE0), texp, H_, R_, mode_); \
        pg8::EpiSwiglu<true> E{(ACTBUF), FFE, ss3, 1, rowtok, (TILE0), NPN_GU, 1.f / W8_SCALE}; \
        pg8::gemm_phase<pg8::EpiSwiglu<true>, pg8::MoeOrder, true, true, true>(lds, g, S, E); } while (0)
#define MOE_DOWN(TILE0, NTILE, ACTBUF) do { pg8::Gemm g{(const bf16*)(ACTBUF), (const bf16*)WEd8, 0, 0, FFE / 2}; pg8::MoeOrder S; S.init((NTILE), NPN_D, G, bx, (TILE0), texp); \
        pg8::EpiMoeDown E{out, rowtok, rowgate, (TILE0), 1.f / W8_SCALE, (args.flags >> 2) & 1}; \
        pg8::gemm_phase<pg8::EpiMoeDown, pg8::MoeOrder, true, true, true>(lds, g, S, E); } while (0)
        if (IN(12)) MOE_GU(0, nA, ACT_C0, -1);
        SEAM(12);
        if (IN(13)) { MOE_DOWN(0, nA, ACT_C0); MOE_GU(nA, nC1, ACT_C1, 0); }
        SEAM(13);
        if (IN(14)) { MOE_DOWN(nA, nC1, ACT_C1); if (nC2 > 0) MOE_GU(nA + nC1, nC2, ACT_C2, 1); }
        SEAM(14);
        if (IN(15)) { if (nC2 > 0) MOE_DOWN(nA + nC1, nC2, ACT_C2); }
#undef MOE_GU
#undef MOE_DOWN
    }
#undef IN
#undef SEAM
#undef x_in
#undef positions
#undef ev_attn_norm
#undef ev_w_in
#undef ev_q_norm
#undef ev_k_norm
#undef ev_lq1
#undef ev_lk1
#undef ev_lq2
#undef ev_lk2
#undef ev_subln
#undef ev_w_out
#undef ev_ffn_norm
#undef ev_w_gate
#undef ev_w_up
#undef ev_w_down
#undef od_attn_norm
#undef od_w_qkv
#undef od_q_norm
#undef od_k_norm
#undef od_rel_bias
#undef od_w_out
#undef od_ffn_norm
#undef od_router
#undef od_we_gate
#undef od_we_up
#undef od_we_down
#undef KIN
}

constexpr int N_PHASES = 16;
extern "C" void kernel_launch(void* const* d_in, const int* in_sizes, int n_in, void* d_out, int out_size, void* d_ws, size_t ws_size, hipStream_t stream) {
    static int grid = 0;
    if (grid == 0) {
        if (n_in != 27 || out_size != T * D || ws_size < WS_END) { fprintf(stderr, "kernel_launch: unexpected problem (n_in %d, out %d, ws %zu)\n", n_in, out_size, ws_size); grid = -1; return; }
        int dev = 0, cus = 0, per_cu = 0;
        if (hipGetDevice(&dev) != hipSuccess || hipDeviceGetAttribute(&cus, hipDeviceAttributeMultiprocessorCount, dev) != hipSuccess) { grid = -1; return; }
        if (hipFuncSetAttribute((const void*)fwd_kernel, hipFuncAttributeMaxDynamicSharedMemorySize, LDS_BYTES) != hipSuccess) { fprintf(stderr, "kernel_launch: hipFuncSetAttribute failed\n"); grid = -1; return; }
        if (hipOccupancyMaxActiveBlocksPerMultiprocessor(&per_cu, (const void*)fwd_kernel, NTHR, LDS_BYTES) != hipSuccess || per_cu < 1) { fprintf(stderr, "kernel_launch: occupancy query says %d\n", per_cu); }
        (void)hipGetLastError();
        grid = cus;
    }
    if (grid < 0) return;
    (void)hipMemsetAsync(d_ws, 0, CTL_ZERO_BYTES, stream);
    KArgs a{};
    for (int i = 0; i < 27; ++i) a.in[i] = d_in[i];
    a.out = (float*)d_out; a.ws = (unsigned char*)d_ws; a.ph_lo = 0; a.ph_hi = N_PHASES;
    hipLaunchKernelGGL(fwd_kernel, dim3(grid), dim3(NTHR), LDS_BYTES, stream, a);
#if defined(PROBE_LO)
    (void)hipMemsetAsync((char*)d_ws + CW_BAR * 4, 0, XCD_BAR_WORDS * 4, stream); (void)hipMemsetAsync((char*)d_ws + CW_QATT * 4, 0, 4096, stream);
    a.ph_lo = PROBE_LO; a.ph_hi = PROBE_HI;
#if defined(PROBE_FLAGS)
    a.flags = PROBE_FLAGS;
#endif
    hipLaunchKernelGGL(fwd_kernel, dim3(grid), dim3(NTHR), LDS_BYTES, stream, a);
#endif
}
```

```cpp
#include <hip/hip_runtime.h>
#include <cstdio>
#include <cstdint>
#include <cmath>
#define PROBE_MASK 0x0
namespace pg8 {
#define PG8_LAS __attribute__((address_space(3)))
typedef unsigned short bf16_t;
typedef short bf16x8 __attribute__((ext_vector_type(8)));
typedef float f32x4 __attribute__((ext_vector_type(4)));
typedef unsigned u32x4 __attribute__((ext_vector_type(4)));
constexpr int BM = 256, BK = 64, HALF = 128, HTB = HALF * BK * 2  , STAGE_BYTES = 8 * HTB, NXCD = 8, WGM = 8;

__host__ __device__ __forceinline__ int lds_byte(int r, int c) { const int st = (r >> 4) * 2 + (c >> 5), rr = r & 15, cc = c & 31, ob = rr * 64 + cc * 2; return st * 1024 + (ob ^ (((ob >> 9) & 1) << 5)); }
__host__ __device__ __forceinline__ void stage_rc(int b, int& R, int& C) { const int st = b / 1024, sb = b % 1024, swz = sb ^ (((sb >> 9) & 1) << 5); R = (st >> 1) * 16 + swz / 64; C = (st & 1) * 32 + (swz % 64) / 2; }
__host__ __device__ __forceinline__ int perm32(int rho) { const int n = rho >> 4, i = rho & 15; return 8 * (i >> 2) + 4 * n + (i & 3); }

struct Unit { int pm, pn; };
struct Gemm { const bf16_t* A; const bf16_t* Bt; int M, N, K; };

struct StaticOrder {
    int nM, nN, nwg, G, c, hot;
    __host__ __device__ void init(int M, int N, int G_, int c_, int hot_ = 0) { nM = M / BM; nN = N / BM; nwg = nM * nN; G = G_; c = c_; hot = hot_; }
    __host__ __device__ bool next(int i, Unit& u) const {
        const long L = (long)i * G + c; if (L >= nwg) return false;
        int wgid = (int)L; { const int q = nwg / NXCD, r = nwg % NXCD, xcd = wgid % NXCD, off = wgid / NXCD; wgid = (xcd < r ? xcd * (q + 1) : r * (q + 1) + (xcd - r) * q) + off; }
        const int nig = WGM * nN, gid = wgid / nig, fm = gid * WGM, gsz = (nM - fm) < WGM ? (nM - fm) : WGM;
        u.pm = fm + ((wgid % nig) % gsz); u.pn = (wgid % nig) / gsz; if (hot) { u.pm &= 3; u.pn = 0; } return true;
    }
    __device__ __forceinline__ void a_ready(const Unit&) const {}
    __device__ __forceinline__ void done(const Unit&) const {}
};

struct MoeOrder {
    int nM, nN, nwg, G, c, tile0; const int* tile_expert;
    int H, R, mode;
    __device__ void init(int ntiles, int npn, int G_, int c_, int tile0_, const int* te, int H_ = 0, int R_ = 0, int mode_ = 1) { nM = ntiles; nN = npn; nwg = nM * nN; G = G_; c = c_; tile0 = tile0_; tile_expert = te; H = H_; R = R_; mode = mode_; }
    __device__ static __forceinline__ void plan(int nu, int H, int G, int ucost, int extra, int& mode, int& R) {
        mode = 1; R = 0; if (H <= 0 || H >= G) return;
        const int rmax = (nu + (G - H) - 1) / (G - H); int best = 0x7fffffff;
        for (int r2 = 0; r2 <= rmax; ++r2) { const int rest = nu - r2 * (G - H) > 0 ? nu - r2 * (G - H) : 0;
            { const int light = ucost * r2, heavy = extra + ucost * ((rest + H - 1) / H); const int mk = light > heavy ? light : heavy; if (mk < best) { best = mk; mode = 1; R = r2; } }
            { const int sh = (rest + G - 1) / G; const int light = ucost * (r2 + sh), heavy = extra + ucost * sh; const int mk = light > heavy ? light : heavy; if (mk < best) { best = mk; mode = 2; R = r2; } } }
    }
    __device__ bool next(int i, Unit& u) const {
        long L;
        if (H == 0) L = (long)i * G + c;
        else if (c >= H) { if (i < R) L = (long)i * (G - H) + (c - H); else if (mode == 2) L = (long)R * (G - H) + (long)(i - R) * G + c; else return false; }
        else L = (long)R * (G - H) + (long)i * (mode == 2 ? G : H) + c;
        if (L >= nwg) return false;
        int wgid = (int)L; { const int q = nwg / NXCD, r = nwg % NXCD, xcd = wgid % NXCD, off = wgid / NXCD; wgid = (xcd < r ? xcd * (q + 1) : r * (q + 1) + (xcd - r) * q) + off; }
        const int nig = WGM * nN, gid = wgid / nig, fm = gid * WGM, gsz = (nM - fm) < WGM ? (nM - fm) : WGM;
        u.pm = fm + ((wgid % nig) % gsz); const int pnl = (wgid % nig) / gsz;
        const int e = __builtin_amdgcn_readfirstlane(tile_expert[tile0 + u.pm]);
        u.pn = e * nN + pnl; return true;
    }
    __device__ __forceinline__ void a_ready(const Unit&) const {}
    __device__ __forceinline__ void done(const Unit&) const {}
};

__device__ __forceinline__ unsigned cvt_pk_bf16(float lo, float hi) { unsigned r; asm volatile("v_cvt_pk_bf16_f32 %0, %1, %2" : "=v"(r) : "v"(lo), "v"(hi)); return r; }
__device__ __forceinline__ u32x4 pack8(const f32x4& a, const f32x4& b) { u32x4 w; w.x = cvt_pk_bf16(a[0], a[1]); w.y = cvt_pk_bf16(a[2], a[3]); w.z = cvt_pk_bf16(b[0], b[1]); w.w = cvt_pk_bf16(b[2], b[3]); return w; }
__device__ __forceinline__ unsigned pk4_fp8(float a, float b, float c, float d) { int w = __builtin_amdgcn_cvt_pk_fp8_f32(a, b, 0, false); w = __builtin_amdgcn_cvt_pk_fp8_f32(c, d, w, true); return (unsigned)w; }
constexpr float RMS_EPS = 1e-6f;
constexpr float LOG2E = 1.4426950408889634f;
constexpr float C2 = 0.125f * LOG2E;
__device__ __forceinline__ float row_ss(const float* ss, int nparts, int row) {
    if (nparts == 1) return ss[row];
    const f32x4* p = (const f32x4*)(ss + (size_t)row * 16); f32x4 a = p[0], b = p[1], c = p[2], d = p[3]; a = (a + b) + (c + d); return (a[0] + a[1]) + (a[2] + a[3]);
}

struct EpiProj {
    static constexpr bool PERM = true, AFTER_DRAIN = false;
    bf16_t* O; int ldc; const float* ss; int nparts; const float* gq; const float* gk; const float* rope; int layer; float pre;
    __device__ __forceinline__ void operator()(const f32x4 (&acc)[2][2][4][2], const Unit& u, int wr, int wc, int fr, int fq) const {
        const int pn = u.pn; int kind = 0; float scale = 1.f; bool rope_on = false;
        if (layer == 0) { const int t = pn >> 1; if (t == 0) scale = C2; else if (t == 3) { kind = 1; scale = C2; rope_on = true; } else if (t == 4) { kind = 2; rope_on = true; } }
        else { const int t = pn >> 2; if (t == 0) { kind = 1; scale = C2; } else if (t == 1) kind = 2; }
        const float* gv = (kind == 1) ? gq : gk;
        f32x4 g[2][2];
#pragma unroll
        for (int bj = 0; bj < 2; ++bj)
#pragma unroll
            for (int n = 0; n < 2; ++n) g[bj][n] = kind ? *(const f32x4*)(gv + 32 * bj + 8 * fq + 4 * n) : (f32x4){1.f, 1.f, 1.f, 1.f};
        const int row0 = u.pm * BM + wr * 64 + fr, col0 = pn * BM + wc * 64 + 8 * fq;
#pragma unroll
        for (int ai = 0; ai < 2; ++ai)
#pragma unroll
            for (int m = 0; m < 4; ++m) {
                const int row = row0 + ai * HALF + m * 16;
                const float r = rsqrtf(row_ss(ss, nparts, row) * (1.f / 1024.f) + RMS_EPS) * pre;
                f32x4 v[2][2]; float s = 0.f;
#pragma unroll
                for (int bj = 0; bj < 2; ++bj)
#pragma unroll
                    for (int n = 0; n < 2; ++n) { v[bj][n] = acc[ai][bj][m][n] * r; const f32x4 x = v[bj][n]; s += (x[0] * x[0] + x[1] * x[1]) + (x[2] * x[2] + x[3] * x[3]); }
                if (kind) {
                    s += __shfl_xor(s, 16); s += __shfl_xor(s, 32);
                    const float rs = rsqrtf(s * (1.f / 64.f) + RMS_EPS);
#pragma unroll
                    for (int bj = 0; bj < 2; ++bj)
#pragma unroll
                        for (int n = 0; n < 2; ++n) v[bj][n] = v[bj][n] * rs * g[bj][n];
                    if (rope_on) {
                        f32x4 p[2];
#pragma unroll
                        for (int n = 0; n < 2; ++n)
#pragma unroll
                            for (int j = 0; j < 4; ++j) p[n][j] = __shfl_xor(v[0][n][j], 16);
                        const f32x4 c0 = *(const f32x4*)(rope + (size_t)row * 16), c1 = *(const f32x4*)(rope + (size_t)row * 16 + 4);
                        const f32x4 s0 = *(const f32x4*)(rope + (size_t)row * 16 + 8), s1 = *(const f32x4*)(rope + (size_t)row * 16 + 12);
                        if (fq == 0) { v[0][0] = v[0][0] * c0 - p[0] * s0; v[0][1] = v[0][1] * c1 - p[1] * s1; }
                        else if (fq == 1) { v[0][0] = v[0][0] * c0 + p[0] * s0; v[0][1] = v[0][1] * c1 + p[1] * s1; }
                    }
                }
                bf16_t* rowp = O + ((size_t)(pn * 4 + wc) * ldc + row) * 64 + 8 * fq;
#pragma unroll
                for (int bj = 0; bj < 2; ++bj) *(u32x4*)(rowp + 32 * bj) = pack8(v[bj][0] * scale, v[bj][1] * scale);
            }
    }
};

struct EpiResid {
    static constexpr bool PERM = true, AFTER_DRAIN = false;
    const float* base; float* out; bf16_t* xb; float* ss; float pre; unsigned char* x8;
    __device__ __forceinline__ void operator()(const f32x4 (&acc)[2][2][4][2], const Unit& u, int wr, int wc, int fr, int fq) const {
        const int row0 = u.pm * BM + wr * 64 + fr, col0 = u.pn * BM + wc * 32 + 8 * fq;
#pragma unroll
        for (int ai = 0; ai < 2; ++ai)
#pragma unroll
            for (int m = 0; m < 4; ++m) {
                const int row = row0 + ai * HALF + m * 16; float s = 0.f;
#pragma unroll
                for (int bj = 0; bj < 2; ++bj) {
                    const size_t off = (size_t)row * 1024 + col0 + bj * HALF;
                    const f32x4 v0 = acc[ai][bj][m][0] * pre + *(const f32x4*)(base + off), v1 = acc[ai][bj][m][1] * pre + *(const f32x4*)(base + off + 4);
                    *(f32x4*)(out + off) = v0; *(f32x4*)(out + off + 4) = v1;
                    if (xb) *(u32x4*)(xb + off) = pack8(v0, v1);
                    if (x8) { typedef unsigned u32x2 __attribute__((ext_vector_type(2))); u32x2 w8; w8.x = pk4_fp8(v0[0], v0[1], v0[2], v0[3]); w8.y = pk4_fp8(v1[0], v1[1], v1[2], v1[3]); *(u32x2*)(x8 + off) = w8; }
                    s += (v0[0] * v0[0] + v0[1] * v0[1]) + (v0[2] * v0[2] + v0[3] * v0[3]) + (v1[0] * v1[0] + v1[1] * v1[1]) + (v1[2] * v1[2] + v1[3] * v1[3]);
                }
                if (ss) { s += __shfl_xor(s, 16); s += __shfl_xor(s, 32); if (fq == 0) ss[(size_t)row * 16 + u.pn * 4 + wc] = s; }
            }
    }
};

template <bool OUT8> struct EpiSwiglu {
    static constexpr bool PERM = true, AFTER_DRAIN = false;
    void* O; int ldc; const float* ss; int nparts; const int* rowtok; int tile0; int npn; float pre;
    __device__ __forceinline__ void operator()(const f32x4 (&acc)[2][2][4][2], const Unit& u, int wr, int wc, int fr, int fq) const {
        const int pnl = u.pn % npn; const int row0 = u.pm * BM + wr * 64 + fr, col0 = pnl * HALF + wc * 32 + 8 * fq;
#pragma unroll
        for (int ai = 0; ai < 2; ++ai)
#pragma unroll
            for (int m = 0; m < 4; ++m) {
                const int row = row0 + ai * HALF + m * 16;
                int tok = row; if (rowtok) tok = rowtok[tile0 * BM + row];
                const float r = (tok >= 0) ? rsqrtf(row_ss(ss, nparts, tok >= 0 ? tok : 0) * (1.f / 1024.f) + RMS_EPS) * pre : 0.f;
                f32x4 a[2]; const float rl = -r * LOG2E, r2 = r * r;
#pragma unroll
                for (int n = 0; n < 2; ++n) { const f32x4 gq = acc[ai][0][m][n], t = gq * rl; f32x4 d;
#pragma unroll
                    for (int j = 0; j < 4; ++j) d[j] = __builtin_amdgcn_rcpf(1.f + __builtin_amdgcn_exp2f(t[j]));
                    a[n] = ((gq * acc[ai][1][m][n]) * r2) * d; }
                if constexpr (OUT8) { typedef unsigned u32x2 __attribute__((ext_vector_type(2))); u32x2 w; w.x = pk4_fp8(a[0][0], a[0][1], a[0][2], a[0][3]); w.y = pk4_fp8(a[1][0], a[1][1], a[1][2], a[1][3]); *(u32x2*)((unsigned char*)O + (size_t)row * ldc + col0) = w; }
                else *(u32x4*)((bf16_t*)O + (size_t)row * ldc + col0) = pack8(a[0], a[1]);
            }
    }
};

struct EpiMoeDown {
    static constexpr bool PERM = true, AFTER_DRAIN = false;
    float* out; const int* rowtok; const float* rowgate; int tile0; float pre; int nostore;
    __device__ __forceinline__ void operator()(const f32x4 (&acc)[2][2][4][2], const Unit& u, int wr, int wc, int fr, int fq) const {
        const int pnl = u.pn & 3; const int row0 = (tile0 + u.pm) * BM + wr * 64 + fr, col0 = pnl * BM + wc * 32 + 8 * fq;
#pragma unroll
        for (int ai = 0; ai < 2; ++ai)
#pragma unroll
            for (int m = 0; m < 4; ++m) {
                const int srow = row0 + ai * HALF + m * 16; const int tok = nostore ? -1 : rowtok[srow];
                if (tok >= 0) { const float gt = rowgate[srow] * pre;
#pragma unroll
                    for (int bj = 0; bj < 2; ++bj)
#pragma unroll
                        for (int n = 0; n < 2; ++n) { f32x4* p = (f32x4*)(out + (size_t)tok * 1024 + col0 + bj * HALF + 4 * n); *p = *p + acc[ai][bj][m][n] * gt; } }
            }
    }
};

typedef int i32x4 __attribute__((ext_vector_type(4)));
typedef int i32x8 __attribute__((ext_vector_type(8)));
template <class Epi, class Sched, bool ALIGN_EPI = false, bool SP2 = false, bool F8 = false>
__device__ __forceinline__ void gemm_phase(PG8_LAS unsigned char* lds, const Gemm g, const Sched& S, const Epi& E) {
    const int tid = threadIdx.x, wid = __builtin_amdgcn_readfirstlane(tid >> 6), lane = tid & 63, wr = wid >> 2, wc = wid & 3, fr = lane & 15, fq = lane >> 4;
    const int K = g.K, nt = K / BK;
    unsigned voffA[2], voffB[2];
#pragma unroll
    for (int i = 0; i < 2; ++i) { int R, C; stage_rc(tid * 16 + i * 8192, R, C); const int Rb = Epi::PERM ? ((R & ~31) + perm32(R & 31)) : R;
        voffA[i] = (unsigned)(R * K + C) * 2u; voffB[i] = (unsigned)(Rb * K + C) * 2u; }
    const size_t kstep = (size_t)(BK * 2);
    const size_t hstep = (size_t)HALF * K * 2;
    const size_t tstep = 2 * hstep;
    const unsigned ldsw = (unsigned)wid * 1024u;
    const int aoff = lds_byte(wr * 64 + fr, fq * 8), boff = lds_byte(wc * 32 + fr, fq * 8);
#define PG8_SA(b, h) (((b) * 2 + (h)) * HTB)
#define PG8_SB(b, h) ((4 + (b) * 2 + (h)) * HTB)
#define PG8_STAGE(bufoff, gbase, voff) do { _Pragma("unroll") for (int _i = 0; _i < 2; ++_i) \
        __builtin_amdgcn_global_load_lds((const unsigned*)((const char*)(gbase) + (voff)[_i]), (PG8_LAS unsigned*)(lds + (bufoff) + ldsw + _i * 8192), 16, 0, 0); } while (0)
#define PG8_LDA(dst, b, h) do { if constexpr (F8) { _Pragma("unroll") for (int m = 0; m < 4; ++m) dst##8[m] = PG8_CAT(*(const PG8_LAS bf16x8*)(lds + PG8_SA(b, h) + aoff + m * 2048), *(const PG8_LAS bf16x8*)(lds + PG8_SA(b, h) + aoff + m * 2048 + 1024)); } \
        else { _Pragma("unroll") for (int m = 0; m < 4; ++m) _Pragma("unroll") for (int k = 0; k < 2; ++k) dst[m][k] = *(const PG8_LAS bf16x8*)(lds + PG8_SA(b, h) + aoff + m * 2048 + k * 1024); } } while (0)
#define PG8_LDB(dst, b, h) do { if constexpr (F8) { _Pragma("unroll") for (int n = 0; n < 2; ++n) dst##8[n] = PG8_CAT(*(const PG8_LAS bf16x8*)(lds + PG8_SB(b, h) + boff + n * 2048), *(const PG8_LAS bf16x8*)(lds + PG8_SB(b, h) + boff + n * 2048 + 1024)); } \
        else { _Pragma("unroll") for (int n = 0; n < 2; ++n) _Pragma("unroll") for (int k = 0; k < 2; ++k) dst[n][k] = *(const PG8_LAS bf16x8*)(lds + PG8_SB(b, h) + boff + n * 2048 + k * 1024); } } while (0)
#define PG8_CAT(x, y) __builtin_shufflevector(__builtin_bit_cast(i32x4, (x)), __builtin_bit_cast(i32x4, (y)), 0, 1, 2, 3, 4, 5, 6, 7)
#define PG8_MMA(ai, bj, At, Bt) do { __builtin_amdgcn_s_setprio(1); _Pragma("unroll") for (int m = 0; m < 4; ++m) _Pragma("unroll") for (int n = 0; n < 2; ++n) { \
        if constexpr (F8) { asm volatile("v_mfma_f32_16x16x128_f8f6f4 %0, %1, %2, %0" : "+v"(acc[ai][bj][m][n]) : "v"(Bt##8[n]), "v"(At##8[m])); } \
        else { _Pragma("unroll") for (int k = 0; k < 2; ++k) acc[ai][bj][m][n] = __builtin_amdgcn_mfma_f32_16x16x32_bf16(Bt[n][k], At[m][k], acc[ai][bj][m][n], 0, 0, 0); } } __builtin_amdgcn_s_setprio(0); } while (0)
#define PG8_WAIT_V(n) asm volatile("s_waitcnt vmcnt(" #n ")" ::: "memory")
#define PG8_WAIT_L(n) asm volatile("s_waitcnt lgkmcnt(" #n ")" ::: "memory")
#define PG8_BAR __builtin_amdgcn_s_barrier()
#define PG8_SCHED __builtin_amdgcn_sched_barrier(0)
    Unit cur, nxt; int ui = 0;
    if (!S.next(0, cur)) return;
    f32x4 acc[2][2][4][2];
#pragma unroll
    for (int a = 0; a < 2; ++a)
#pragma unroll
        for (int b = 0; b < 2; ++b)
#pragma unroll
            for (int m = 0; m < 4; ++m)
#pragma unroll
                for (int n = 0; n < 2; ++n) acc[a][b][m][n] = (f32x4){0.f, 0.f, 0.f, 0.f};
    bf16x8 At[4][2], B0[2][2], B1[2][2];
    i32x8 At8[4], B08[2], B18[2];
    const char* cA = (const char*)g.A + (size_t)cur.pm * tstep; const char* cB = (const char*)g.Bt + (size_t)cur.pn * tstep;
    S.a_ready(cur);
    if constexpr (SP2) {
        PG8_STAGE(PG8_SB(0, 0), cB, voffB); PG8_STAGE(PG8_SB(0, 1), cB + hstep, voffB); PG8_STAGE(PG8_SA(0, 0), cA, voffA); PG8_STAGE(PG8_SA(0, 1), cA + hstep, voffA);
        if (wr == 1) PG8_BAR;
        PG8_WAIT_V(2); PG8_BAR;
        PG8_STAGE(PG8_SB(1, 0), cB + kstep, voffB); PG8_STAGE(PG8_SA(1, 0), cA + kstep, voffA); PG8_STAGE(PG8_SB(1, 1), cB + hstep + kstep, voffB);
        PG8_WAIT_V(6); PG8_BAR;
    } else {
        PG8_STAGE(PG8_SB(0, 0), cB, voffB); PG8_STAGE(PG8_SA(0, 0), cA, voffA); PG8_STAGE(PG8_SB(0, 1), cB + hstep, voffB); PG8_STAGE(PG8_SA(0, 1), cA + hstep, voffA);
        if (wr == 1) PG8_BAR;
        PG8_WAIT_V(4); PG8_BAR;
        PG8_STAGE(PG8_SB(1, 0), cB + kstep, voffB); PG8_STAGE(PG8_SA(1, 0), cA + kstep, voffA); PG8_STAGE(PG8_SB(1, 1), cB + hstep + kstep, voffB);
        PG8_WAIT_V(6); PG8_BAR;
    }
    for (;;) {
        const bool has_next = S.next(ui + 1, nxt);
        const char* nA = has_next ? (const char*)g.A + (size_t)nxt.pm * tstep : cA; const char* nB = has_next ? (const char*)g.Bt + (size_t)nxt.pn * tstep : cB;
#pragma nounroll
        for (int t = 0; t < nt; t += 2) {
            const bool last = (t == nt - 2);
            const char* a1 = cA + (size_t)(t + 1) * kstep;
            const char* a2 = last ? nA : cA + (size_t)(t + 2) * kstep; const char* b2 = last ? nB : cB + (size_t)(t + 2) * kstep;
            const char* a3 = a2 + kstep; const char* b3 = b2 + kstep;
            if (last && has_next) S.a_ready(nxt);
            if constexpr (SP2) {
            PG8_LDB(B0, 0, 0); PG8_LDB(B1, 0, 1); PG8_SCHED; PG8_LDA(At, 0, 0); PG8_STAGE(PG8_SA(1, 1), a1 + hstep, voffA);
            PG8_WAIT_V(8); PG8_WAIT_L(0); PG8_BAR; PG8_MMA(0, 0, At, B0); PG8_MMA(0, 1, At, B1); PG8_BAR; PG8_SCHED;
            PG8_LDA(At, 0, 1); PG8_STAGE(PG8_SB(0, 0), b2, voffB); PG8_STAGE(PG8_SB(0, 1), b2 + hstep, voffB); PG8_STAGE(PG8_SA(0, 0), a2, voffA);
            PG8_WAIT_V(8); PG8_WAIT_L(0); PG8_BAR; PG8_MMA(1, 0, At, B0); PG8_MMA(1, 1, At, B1); PG8_BAR; PG8_SCHED;
            PG8_LDB(B0, 1, 0); PG8_LDB(B1, 1, 1); PG8_SCHED; PG8_LDA(At, 1, 0); PG8_STAGE(PG8_SA(0, 1), a2 + hstep, voffA);
            PG8_WAIT_V(8); PG8_WAIT_L(0); PG8_BAR; PG8_MMA(0, 0, At, B0); PG8_MMA(0, 1, At, B1); PG8_BAR; PG8_SCHED;
            PG8_LDA(At, 1, 1); PG8_STAGE(PG8_SB(1, 0), b3, voffB); PG8_STAGE(PG8_SB(1, 1), b3 + hstep, voffB); PG8_STAGE(PG8_SA(1, 0), a3, voffA);
            PG8_WAIT_V(8); PG8_WAIT_L(0); PG8_BAR; PG8_MMA(1, 0, At, B0); PG8_MMA(1, 1, At, B1); PG8_BAR; PG8_SCHED;
            } else {
            PG8_LDB(B0, 0, 0); PG8_SCHED; PG8_LDA(At, 0, 0); PG8_STAGE(PG8_SA(1, 1), a1 + hstep, voffA);
            PG8_WAIT_L(8); PG8_BAR; PG8_WAIT_L(0); PG8_MMA(0, 0, At, B0); PG8_BAR; PG8_SCHED;
            PG8_LDB(B1, 0, 1); PG8_STAGE(PG8_SB(0, 0), b2, voffB);
            PG8_BAR; PG8_WAIT_L(0); PG8_MMA(0, 1, At, B1); PG8_BAR;
            PG8_LDA(At, 0, 1); PG8_STAGE(PG8_SA(0, 0), a2, voffA);
            PG8_BAR; PG8_WAIT_L(0); PG8_MMA(1, 0, At, B0); PG8_BAR; PG8_SCHED;
            PG8_STAGE(PG8_SB(0, 1), b2 + hstep, voffB);
            PG8_WAIT_V(6); PG8_BAR; PG8_MMA(1, 1, At, B1); PG8_BAR;
            PG8_LDB(B0, 1, 0); PG8_SCHED; PG8_LDA(At, 1, 0); PG8_STAGE(PG8_SA(0, 1), a2 + hstep, voffA);
            PG8_WAIT_L(8); PG8_BAR; PG8_WAIT_L(0); PG8_MMA(0, 0, At, B0); PG8_BAR; PG8_SCHED;
            PG8_LDB(B1, 1, 1); PG8_STAGE(PG8_SB(1, 0), b3, voffB);
            PG8_BAR; PG8_WAIT_L(0); PG8_MMA(0, 1, At, B1); PG8_BAR;
            PG8_LDA(At, 1, 1); PG8_STAGE(PG8_SA(1, 0), a3, voffA);
            PG8_BAR; PG8_WAIT_L(0); PG8_MMA(1, 0, At, B0); PG8_BAR; PG8_SCHED;
            PG8_STAGE(PG8_SB(1, 1), b3 + hstep, voffB);
            PG8_WAIT_V(6); PG8_BAR; PG8_MMA(1, 1, At, B1); PG8_BAR;
            }
        }
        if constexpr (F8) asm volatile("s_nop 15\n\ts_nop 15\n\ts_nop 15" ::: "memory");
        if constexpr (ALIGN_EPI) { if (wr == 0) PG8_BAR; }
        if constexpr (!Epi::AFTER_DRAIN) { E(acc, cur, wr, wc, fr, fq); S.done(cur); }
        if (!has_next) break;
#pragma unroll
        for (int a = 0; a < 2; ++a)
#pragma unroll
            for (int b = 0; b < 2; ++b)
#pragma unroll
                for (int m = 0; m < 4; ++m)
#pragma unroll
                    for (int n = 0; n < 2; ++n) acc[a][b][m][n] = (f32x4){0.f, 0.f, 0.f, 0.f};
        cur = nxt; cA = nA; cB = nB; ++ui;
        if constexpr (ALIGN_EPI) { if (wr == 1) PG8_BAR; }
    }
    PG8_WAIT_V(0);
    if constexpr (!ALIGN_EPI) { if (wr == 0) PG8_BAR; }
    PG8_BAR;
    if constexpr (Epi::AFTER_DRAIN) { E.fused(acc, cur, wr, wc, fr, fq, lds, wid, lane); S.done(cur); }
#undef PG8_SA
#undef PG8_SB
#undef PG8_STAGE
#undef PG8_LDA
#undef PG8_LDB
#undef PG8_MMA
#undef PG8_CAT
#undef PG8_WAIT_V
#undef PG8_WAIT_L
#undef PG8_BAR
#undef PG8_SCHED
}
}

namespace att {
using pg8::bf16_t; using pg8::bf16x8; using pg8::u32x4;
typedef float f32x16 __attribute__((ext_vector_type(16)));
typedef short s16x4 __attribute__((ext_vector_type(4)));
typedef float f32x2_t __attribute__((ext_vector_type(2))); typedef __bf16 bf16x2_t __attribute__((ext_vector_type(2)));
#define ALAS __attribute__((address_space(3)))
typedef ALAS const char* lds_cptr;
constexpr int SEQ = 8192, PITCH = 64, VNEXT = 2 * SEQ * 64;
constexpr int KVSLOT = 24576;
constexpr int L_WS = 114688, L_TAB = L_WS + 2048, L_FLAG = L_TAB + 1056, L_END = L_FLAG + 128, L_OST = 0;
constexpr float SB_THR = 152.f;
__device__ __forceinline__ int crow(int r, int hi) { return (r & 3) + 8 * (r >> 2) + 4 * hi; }
__device__ __forceinline__ void glds16(const void* gsrc, unsigned lds_dst) { unsigned keep;
    asm volatile("s_mov_b32 %0, m0\n\ts_mov_b32 m0, %2\n\ts_nop 0\n\tglobal_load_lds_dwordx4 %1, off\n\ts_mov_b32 m0, %0" : "=&s"(keep) : "v"(gsrc), "s"(lds_dst) : "memory"); }
__device__ __forceinline__ unsigned cvtpk(float lo, float hi) { f32x2_t v = {lo, hi}; bf16x2_t b = __builtin_convertvector(v, bf16x2_t); return __builtin_bit_cast(unsigned, b); }
__device__ __forceinline__ unsigned short f2bf(float f) { unsigned u = __builtin_bit_cast(unsigned, f); return (unsigned short)((u + 0x7fffu + ((u >> 16) & 1u)) >> 16); }
#define MFMA32(a, b, c) __builtin_amdgcn_mfma_f32_32x32x16_bf16((a), (b), (c), 0, 0, 0)

__device__ __forceinline__ void qkt(f32x16& p0, f32x16& p1, lds_cptr kb, const bf16x8* qr, const f32x16& cin) {
#pragma unroll
    for (int d0 = 0; d0 < 4; ++d0) {
        const bf16x8 b0 = *(const ALAS bf16x8*)(kb + d0 * 2048);
        const bf16x8 b1 = *(const ALAS bf16x8*)(kb + d0 * 2048 + 512);
        if (d0 == 0) { p0 = MFMA32(b0, qr[0], cin); p1 = MFMA32(b1, qr[0], cin); }
        else { p0 = MFMA32(b0, qr[d0], p0); p1 = MFMA32(b1, qr[d0], p1); }
    }
}

__device__ __forceinline__ void qkt_sw(f32x16& p0, f32x16& p1, lds_cptr ks, const int (&kofs)[4], const bf16x8* qr, const f32x16& cin) {
    bf16x8 kf[8];
#pragma unroll
    for (int d0 = 0; d0 < 4; ++d0) { kf[2 * d0] = *(const ALAS bf16x8*)(ks + kofs[d0]); kf[2 * d0 + 1] = *(const ALAS bf16x8*)(ks + kofs[d0] + 4096); }
    p0 = MFMA32(kf[0], qr[0], cin); p1 = MFMA32(kf[1], qr[0], cin);
#pragma unroll
    for (int d0 = 1; d0 < 4; ++d0) { p0 = MFMA32(kf[2 * d0], qr[d0], p0); p1 = MFMA32(kf[2 * d0 + 1], qr[d0], p1); }
}
template <int ND> __device__ __forceinline__ void pv(f32x16* o, int vb, bf16x8 pa0, bf16x8 pa1, bf16x8 pa2, bf16x8 pa3) {
#pragma unroll
    for (int d0 = 0; d0 < ND; ++d0) { s16x4 lo[4], hi[4];
#pragma unroll
        for (int ks = 0; ks < 4; ++ks) {
            asm volatile("ds_read_b64_tr_b16 %0,%1 offset:%c2" : "=&v"(lo[ks]) : "v"(vb), "i"(d0 * 4096 + ks * 1024) : "memory");
            asm volatile("ds_read_b64_tr_b16 %0,%1 offset:%c2" : "=&v"(hi[ks]) : "v"(vb), "i"(d0 * 4096 + ks * 1024 + 512) : "memory"); }
        asm volatile("s_waitcnt lgkmcnt(0)" ::: "memory"); __builtin_amdgcn_sched_barrier(0);
#define ATT_PK(k) (bf16x8){lo[k][0], lo[k][1], lo[k][2], lo[k][3], hi[k][0], hi[k][1], hi[k][2], hi[k][3]}
        o[d0] = MFMA32(pa0, ATT_PK(0), o[d0]);
        o[d0] = MFMA32(pa1, ATT_PK(1), o[d0]);
        o[d0] = MFMA32(pa2, ATT_PK(2), o[d0]);
        o[d0] = MFMA32(pa3, ATT_PK(3), o[d0]);
#undef ATT_PK
    }
}

template <int MODE, int VD, bool OUT8 = false, int TPB = 1>
__device__ __forceinline__ void attn_unit(ALAS char* shm, const bf16_t* Qb, const bf16_t* Kb, const bf16_t* Vb, void* Ob, int opitch, int q0, float mref2, const float* tab, float oscale = 1.f, int dbg = 0) {
    constexpr int ND = VD / 32, SLOT = 8192 + VD * 128;
    static_assert(2 * TPB * SLOT <= L_WS, "ring vs LDS map");
    const int tid = threadIdx.x, lane = tid & 63, r32 = lane & 31, hi = lane >> 5; const int wid = __builtin_amdgcn_readfirstlane(tid >> 6);
    const unsigned lds0 = (unsigned)(uintptr_t)shm;
    ALAS float* wsf = (ALAS float*)(shm + L_WS) + wid * 64;
    ALAS float* tabL = (ALAS float*)(shm + L_TAB);
    ALAS unsigned* flg = (ALAS unsigned*)(shm + L_FLAG);
    if (MODE == 1) { for (int i = tid; i < 257; i += 512) tabL[i] = tab[i] * pg8::LOG2E; }
    const bf16_t* Qw = Qb + (size_t)(q0 + wid * 32) * PITCH;
    bf16x8 qr[4];
#pragma unroll
    for (int d0 = 0; d0 < 4; ++d0) qr[d0] = *(const bf16x8*)(Qw + (size_t)r32 * PITCH + d0 * 16 + hi * 8);
    int t_first, n_t, t_step;
    if (MODE == 0) { t_first = 0; n_t = q0 / 64 + 4; t_step = 1; }
    else if (MODE == 1) { const int c0 = q0 / 64; t_first = c0 - 8 > 0 ? c0 - 8 : 0; n_t = c0 + 4 - t_first; t_step = 1; }
    else { t_first = q0 / 64 + 3; n_t = q0 / 64 + 4; t_step = -1; }
    const int krow = 8 * wid + (lane >> 3);
    const bf16_t* ksrc = Kb + (size_t)krow * PITCH + (((lane & 7) ^ ((krow >> 1) & 7)) * 8);
    int kofs[4];
#pragma unroll
    for (int d0 = 0; d0 < 4; ++d0) kofs[d0] = (r32 >> 3) * 1024 + ((r32 & 7) * 8 + ((2 * d0 + hi) ^ ((r32 >> 1) & 7))) * 16;
    const bf16_t* vsrc = Vb + (size_t)(16 * (wid & 3) + (lane >> 2)) * PITCH + (wid >> 2) * 32 + (lane & 3) * 8;
#define ATT_DMA(t, slot) do { if (dbg & 64) break; const size_t to_ = (size_t)(t) * 64 * PITCH; const unsigned sb_ = lds0 + (unsigned)(slot) * SLOT; \
        glds16(ksrc + to_, (unsigned)__builtin_amdgcn_readfirstlane(sb_ + wid * 1024)); \
        glds16(vsrc + to_, (unsigned)__builtin_amdgcn_readfirstlane(sb_ + 8192 + wid * 1024)); \
        if (VD == 128) glds16(vsrc + to_ + VNEXT, (unsigned)__builtin_amdgcn_readfirstlane(sb_ + 8192 + (wid + 8) * 1024)); } while (0)
    f32x16 o[ND];
#pragma unroll
    for (int d = 0; d < ND; ++d) o[d] = f32x16{};
    f32x16 cin;
#pragma unroll
    for (int r = 0; r < 16; ++r) cin[r] = (MODE == 2) ? 0.f : -mref2;
    float l_reg = 0.f, A = 0.f; bool wdone = false;
    const int wrow0 = q0 + wid * 32, qrow = wrow0 + r32;
    const int vb0 = (int)lds0 + 8192 + ((lane >> 4) & 1) * 32 + (lane & 3) * 8 + (4 * hi + ((lane & 15) >> 2)) * 64;
    asm volatile("s_waitcnt vmcnt(0)" ::: "memory"); asm volatile("" : "+v"(qr[0]), "+v"(qr[1]), "+v"(qr[2]), "+v"(qr[3]));
#pragma unroll
    for (int u = 0; u < TPB; ++u) ATT_DMA(t_first + u * t_step, u);
    for (int i = 0; i < n_t; ++i) {
        const int t = t_first + i * t_step, slot = i % (2 * TPB);
        if (i % TPB == 0) {
        asm volatile("s_waitcnt vmcnt(0) lgkmcnt(0)\n\ts_barrier" ::: "memory");
        if (MODE == 2 && i > 0) { const int par = ((i - 1) & 3) * 8; unsigned all = 1u;
#pragma unroll
            for (int w = 0; w < 8; ++w) all &= flg[par + w];
            if (__builtin_amdgcn_readfirstlane(all)) break; }
        if (i + TPB < n_t) {
#pragma unroll
            for (int u = 0; u < TPB; ++u) ATT_DMA(t + (TPB + u) * t_step, (i + TPB + u) % (2 * TPB)); }
        }
        bool active;
        if (MODE == 0) active = (64 * t <= wrow0);
        else if (MODE == 1) { const int cw = wrow0 / 64; active = (t >= cw - 8) && (t <= cw); }
        else active = !wdone && (64 * t < wrow0 + 31);
        if (active && !(dbg & 32)) {
            f32x16 p0, p1; qkt_sw(p0, p1, (lds_cptr)shm + slot * SLOT, kofs, qr, cin);
            if (MODE == 0) {
#pragma unroll
                for (int r = 0; r < 16; ++r) { p0[r] = __builtin_amdgcn_exp2f(p0[r]); p1[r] = __builtin_amdgcn_exp2f(p1[r]); }
            } else if (MODE == 1) {
                const int cw = wrow0 / 64;
                if (t <= cw - 3) { const float cb = tabL[256];
#pragma unroll
                    for (int r = 0; r < 16; ++r) { p0[r] = __builtin_amdgcn_exp2f(p0[r] + cb); p1[r] = __builtin_amdgcn_exp2f(p1[r] + cb); }
                } else { const int dq = qrow - 64 * t - 4 * hi;
#pragma unroll
                    for (int r = 0; r < 16; ++r) { int d0 = dq - ((r & 3) + 8 * (r >> 2)), d1 = d0 - 32;
                        d0 = d0 < -128 ? -128 : (d0 > 128 ? 128 : d0); d1 = d1 < -128 ? -128 : (d1 > 128 ? 128 : d1);
                        p0[r] = __builtin_amdgcn_exp2f(p0[r] + tabL[d0 + 128]); p1[r] = __builtin_amdgcn_exp2f(p1[r] + tabL[d1 + 128]); }
                }
            } else {
                const bool needmask = (64 * t + 63 >= wrow0);
                const int kq = qrow - 64 * t - 4 * hi;
                float g[8];
#pragma unroll
                for (int k = 0; k < 8; ++k) g[k] = 0.f;
                f32x16 s0, s1;
#pragma unroll
                for (int r = 0; r < 16; ++r) { const int kv = (r & 3) + 8 * (r >> 2);
                    { const float y = p0[r], a = __builtin_fabsf(y); float sp = __builtin_fmaxf(y, 0.f) + __builtin_amdgcn_logf(1.f + __builtin_amdgcn_exp2f(-a)); if (needmask && !(kv < kq)) sp = 0.f; s0[r] = sp; g[r >> 2] += sp; }
                    { const float y = p1[r], a = __builtin_fabsf(y); float sp = __builtin_fmaxf(y, 0.f) + __builtin_amdgcn_logf(1.f + __builtin_amdgcn_exp2f(-a)); if (needmask && !(kv + 32 < kq)) sp = 0.f; s1[r] = sp; g[4 + (r >> 2)] += sp; } }
                float pg[8];
#pragma unroll
                for (int k = 0; k < 8; ++k) pg[k] = __shfl_xor(g[k], 32);
                float base[8]; float own = 0.f, par = 0.f;
#pragma unroll
                for (int k = 7; k >= 0; --k) { const float par_incl = par + pg[k]; base[k] = A + own + (hi == 0 ? par_incl : par); own += g[k]; par = par_incl; }
                A += own + par;
#pragma unroll
                for (int k = 0; k < 4; ++k) {
                    { float c = base[k]; c += s0[4 * k + 3]; const float w3 = __builtin_amdgcn_exp2f(p0[4 * k + 3] - c); c += s0[4 * k + 2]; const float w2 = __builtin_amdgcn_exp2f(p0[4 * k + 2] - c);
                      c += s0[4 * k + 1]; const float w1 = __builtin_amdgcn_exp2f(p0[4 * k + 1] - c); c += s0[4 * k]; const float w0 = __builtin_amdgcn_exp2f(p0[4 * k] - c);
                      p0[4 * k] = w0; p0[4 * k + 1] = w1; p0[4 * k + 2] = w2; p0[4 * k + 3] = w3; }
                    { float c = base[4 + k]; c += s1[4 * k + 3]; const float w3 = __builtin_amdgcn_exp2f(p1[4 * k + 3] - c); c += s1[4 * k + 2]; const float w2 = __builtin_amdgcn_exp2f(p1[4 * k + 2] - c);
                      c += s1[4 * k + 1]; const float w1 = __builtin_amdgcn_exp2f(p1[4 * k + 1] - c); c += s1[4 * k]; const float w0 = __builtin_amdgcn_exp2f(p1[4 * k] - c);
                      p1[4 * k] = w0; p1[4 * k + 1] = w1; p1[4 * k + 2] = w2; p1[4 * k + 3] = w3; }
                }
                if (needmask) {
#pragma unroll
                    for (int r = 0; r < 16; ++r) { const int kv = (r & 3) + 8 * (r >> 2); if (!(kv < kq)) p0[r] = 0.f; if (!(kv + 32 < kq)) p1[r] = 0.f; }
                }
                wdone = __all(A >= SB_THR);
            }
            if (MODE != 2) { float s = 0.f;
#pragma unroll
                for (int r = 0; r < 16; ++r) s += p0[r] + p1[r];
                l_reg += s; }
            u32x4 pw0, pw1, pw2, pw3;
            pw0 = (u32x4){cvtpk(p0[0], p0[1]), cvtpk(p0[2], p0[3]), cvtpk(p0[4], p0[5]), cvtpk(p0[6], p0[7])};
            pw1 = (u32x4){cvtpk(p0[8], p0[9]), cvtpk(p0[10], p0[11]), cvtpk(p0[12], p0[13]), cvtpk(p0[14], p0[15])};
            pw2 = (u32x4){cvtpk(p1[0], p1[1]), cvtpk(p1[2], p1[3]), cvtpk(p1[4], p1[5]), cvtpk(p1[6], p1[7])};
            pw3 = (u32x4){cvtpk(p1[8], p1[9]), cvtpk(p1[10], p1[11]), cvtpk(p1[12], p1[13]), cvtpk(p1[14], p1[15])};
            pv<ND>(o, vb0 + slot * SLOT, __builtin_bit_cast(bf16x8, pw0), __builtin_bit_cast(bf16x8, pw1), __builtin_bit_cast(bf16x8, pw2), __builtin_bit_cast(bf16x8, pw3));
        }
        if (MODE == 2) { if (lane == 0) flg[(i & 3) * 8 + wid] = wdone ? 1u : 0u; }
    }
#undef ATT_DMA
    asm volatile("s_waitcnt vmcnt(0) lgkmcnt(0)\n\ts_barrier" ::: "memory");
    float rl[16];
    if (MODE != 2) {
        l_reg += __shfl_xor(l_reg, 32);
        if (hi == 0) wsf[32 + r32] = l_reg;
        asm volatile("s_waitcnt lgkmcnt(0)" ::: "memory");
#pragma unroll
        for (int r = 0; r < 16; ++r) rl[r] = __builtin_amdgcn_rcpf(wsf[32 + crow(r, hi)]) * oscale;
    } else {
#pragma unroll
        for (int r = 0; r < 16; ++r) rl[r] = oscale;
    }
    if constexpr (OUT8) {
        static_assert(!OUT8 || VD == 64, "fp8 output: 64-wide heads");
        unsigned char* Ow = (unsigned char*)Ob + (size_t)(q0 + wid * 32) * opitch;
        ALAS unsigned char* stg = (ALAS unsigned char*)(shm + L_OST) + wid * 2048;
#pragma unroll
        for (int r = 0; r < 16; ++r) { const int orow = crow(r, hi);
#pragma unroll
            for (int d0 = 0; d0 < 2; ++d0) { const float v = o[d0][r] * rl[r]; stg[orow * 64 + d0 * 32 + r32] = (unsigned char)(__builtin_amdgcn_cvt_pk_fp8_f32(v, v, 0, false) & 0xff); } }
        asm volatile("s_waitcnt lgkmcnt(0)" ::: "memory");
#pragma unroll
        for (int i = 0; i < 2; ++i) { const int row = i * 16 + (lane >> 2), ch = lane & 3; const u32x4 v = *(const ALAS u32x4*)(stg + row * 64 + ch * 16); *(u32x4*)(Ow + (size_t)row * opitch + ch * 16) = v; }
        asm volatile("s_waitcnt lgkmcnt(0)" ::: "memory");
    } else {
    bf16_t* Ow = (bf16_t*)Ob + (size_t)(q0 + wid * 32) * opitch;
    ALAS bf16_t* stg = (ALAS bf16_t*)(shm + L_OST) + wid * 2048;
#pragma unroll
    for (int half = 0; half < ND / 2; ++half) {
#pragma unroll
        for (int r = 0; r < 16; ++r) { const int orow = crow(r, hi);
#pragma unroll
            for (int d0 = 0; d0 < 2; ++d0) stg[orow * 64 + d0 * 32 + r32] = f2bf(o[half * 2 + d0][r] * rl[r]); }
        asm volatile("s_waitcnt lgkmcnt(0)" ::: "memory");
#pragma unroll
        for (int i = 0; i < 4; ++i) { const int row = i * 8 + (lane >> 3), ch = lane & 7; const u32x4 v = *(const ALAS u32x4*)(stg + row * 64 + ch * 8); *(u32x4*)(Ow + (size_t)row * opitch + half * 64 + ch * 8) = v; }
        asm volatile("s_waitcnt lgkmcnt(0)" ::: "memory");
    }
    }
    asm volatile("s_waitcnt vmcnt(0) lgkmcnt(0)\n\ts_barrier" ::: "memory");
}


__device__ __forceinline__ void qkt8(f32x16& p0, f32x16& p1, lds_cptr kb, const bf16x8* qr, const f32x16& cin) {
    bf16x8 kf[8];
#pragma unroll
    for (int d0 = 0; d0 < 4; ++d0) { kf[2 * d0] = *(const ALAS bf16x8*)(kb + d0 * 2048); kf[2 * d0 + 1] = *(const ALAS bf16x8*)(kb + d0 * 2048 + 512); }
    __builtin_amdgcn_sched_barrier(0);
    p0 = MFMA32(kf[0], qr[0], cin); p1 = MFMA32(kf[1], qr[0], cin);
#pragma unroll
    for (int d0 = 1; d0 < 4; ++d0) { p0 = MFMA32(kf[2 * d0], qr[d0], p0); p1 = MFMA32(kf[2 * d0 + 1], qr[d0], p1); }
}
template <int ND, int KS0> __device__ __forceinline__ void v_reads(s16x4 (&lo)[ND][2], s16x4 (&hi)[ND][2], int vb) {
#pragma unroll
    for (int ks = 0; ks < 2; ++ks)
#pragma unroll
        for (int d0 = 0; d0 < ND; ++d0) {
            asm volatile("ds_read_b64_tr_b16 %0,%1 offset:%c2" : "=&v"(lo[d0][ks]) : "v"(vb), "i"(d0 * 4096 + (KS0 + ks) * 1024) : "memory");
            asm volatile("ds_read_b64_tr_b16 %0,%1 offset:%c2" : "=&v"(hi[d0][ks]) : "v"(vb), "i"(d0 * 4096 + (KS0 + ks) * 1024 + 512) : "memory"); }
}
template <int ND> __device__ __forceinline__ void pv_half(f32x16* o, const s16x4 (&lo)[ND][2], const s16x4 (&hi)[ND][2], bf16x8 pa, bf16x8 pb) {
#define ATT_PK2(d, k) (bf16x8){lo[d][k][0], lo[d][k][1], lo[d][k][2], lo[d][k][3], hi[d][k][0], hi[d][k][1], hi[d][k][2], hi[d][k][3]}
#pragma unroll
    for (int d0 = 0; d0 < ND; ++d0) o[d0] = MFMA32(pa, ATT_PK2(d0, 0), o[d0]);
#pragma unroll
    for (int d0 = 0; d0 < ND; ++d0) o[d0] = MFMA32(pb, ATT_PK2(d0, 1), o[d0]);
#undef ATT_PK2
}
template <int MODE> __device__ __forceinline__ void p_half(f32x16& p, float& l_reg, u32x4& wa, u32x4& wb, bool const_bias, int dq, const ALAS float* tabL) {
    if (MODE == 0) {
#pragma unroll
        for (int r = 0; r < 16; ++r) p[r] = __builtin_amdgcn_exp2f(p[r]);
    } else if (const_bias) { const float cb = tabL[256];
#pragma unroll
        for (int r = 0; r < 16; ++r) p[r] = __builtin_amdgcn_exp2f(p[r] + cb);
    } else {
#pragma unroll
        for (int r = 0; r < 16; ++r) { int d = dq - ((r & 3) + 8 * (r >> 2)); d = d < -128 ? -128 : (d > 128 ? 128 : d); p[r] = __builtin_amdgcn_exp2f(p[r] + tabL[d + 128]); }
    }
    float s = 0.f;
#pragma unroll
    for (int r = 0; r < 16; ++r) s += p[r];
    l_reg += s;
    wa = (u32x4){cvtpk(p[0], p[1]), cvtpk(p[2], p[3]), cvtpk(p[4], p[5]), cvtpk(p[6], p[7])};
    wb = (u32x4){cvtpk(p[8], p[9]), cvtpk(p[10], p[11]), cvtpk(p[12], p[13]), cvtpk(p[14], p[15])};
}
__device__ __forceinline__ void vm_wait_n(int n) {
    if (n <= 0) asm volatile("s_waitcnt vmcnt(0)" ::: "memory"); else if (n == 1) asm volatile("s_waitcnt vmcnt(1)" ::: "memory"); else if (n == 2) asm volatile("s_waitcnt vmcnt(2)" ::: "memory");
    else if (n == 3) asm volatile("s_waitcnt vmcnt(3)" ::: "memory"); else if (n == 4) asm volatile("s_waitcnt vmcnt(4)" ::: "memory"); else if (n == 5) asm volatile("s_waitcnt vmcnt(5)" ::: "memory");
    else if (n == 6) asm volatile("s_waitcnt vmcnt(6)" ::: "memory"); else if (n == 7) asm volatile("s_waitcnt vmcnt(7)" ::: "memory"); else if (n == 8) asm volatile("s_waitcnt vmcnt(8)" ::: "memory");
    else if (n == 9) asm volatile("s_waitcnt vmcnt(9)" ::: "memory"); else if (n == 10) asm volatile("s_waitcnt vmcnt(10)" ::: "memory"); else asm volatile("s_waitcnt vmcnt(11)" ::: "memory");
}
template <int MODE, int VD, bool OUT8 = false, int PD = 3>
__device__ __forceinline__ void attn_unit_pp(ALAS char* shm, const bf16_t* Qb, const bf16_t* Kb, const bf16_t* Vb, void* Ob, int opitch, int q0, float mref2, const float* tab, float oscale = 1.f, int dbg = 0) {
    static_assert(MODE == 0 || MODE == 1, "ping-pong loop: softmax modes only");
    constexpr int ND = VD / 32, NV = VD / 64, NS = PD + 1, PER = 1 + NV, SLOT = 8192 + VD * 128;
    static_assert(NS * SLOT <= L_WS, "ring vs LDS map");
    const int tid = threadIdx.x, lane = tid & 63, r32 = lane & 31, hi = lane >> 5; const int wid = __builtin_amdgcn_readfirstlane(tid >> 6); const int grp = wid >> 2;
    const unsigned lds0 = (unsigned)(uintptr_t)shm;
    ALAS float* wsf = (ALAS float*)(shm + L_WS) + wid * 64;
    ALAS float* tabL = (ALAS float*)(shm + L_TAB);
    if (MODE == 1) { for (int i = tid; i < 257; i += 512) tabL[i] = tab[i] * pg8::LOG2E; }
    const bf16_t* Qw = Qb + (size_t)(q0 + wid * 32) * PITCH;
    bf16x8 qr[4];
#pragma unroll
    for (int d0 = 0; d0 < 4; ++d0) qr[d0] = *(const bf16x8*)(Qw + (size_t)r32 * PITCH + d0 * 16 + hi * 8);
    int t_first, n_t;
    if (MODE == 0) { t_first = 0; n_t = q0 / 64 + 4; }
    else { const int c0 = q0 / 64; t_first = c0 - 8 > 0 ? c0 - 8 : 0; n_t = c0 + 4 - t_first; }
    const bf16_t* ksrc = Kb + (size_t)lane * PITCH + wid * 8 + (size_t)t_first * 64 * PITCH;
    const bf16_t* vsrc = Vb + (size_t)(16 * (wid & 3) + (lane >> 2)) * PITCH + (wid >> 2) * 32 + (lane & 3) * 8 + (size_t)t_first * 64 * PITCH;
    const bf16_t* ksrc_c = Kb + (size_t)t_first * 64 * PITCH + wid * 512 + lane * 8;
    int issued = 0;
#define PP_DMA_K(i) do { if ((i) < n_t && !(dbg & 64)) { glds16(((dbg & 128) ? ksrc_c : ksrc) + (size_t)(i) * 64 * PITCH, (unsigned)__builtin_amdgcn_readfirstlane(lds0 + (unsigned)((i) % NS) * SLOT + wid * 1024)); issued += 1; } } while (0)
#define PP_DMA_V(i) do { if ((i) < n_t && !(dbg & 64)) { const unsigned sb_ = lds0 + (unsigned)((i) % NS) * SLOT + 8192; glds16(vsrc + (size_t)(i) * 64 * PITCH, (unsigned)__builtin_amdgcn_readfirstlane(sb_ + wid * 1024)); \
        if (VD == 128) glds16(vsrc + (size_t)(i) * 64 * PITCH + VNEXT, (unsigned)__builtin_amdgcn_readfirstlane(sb_ + (wid + 8) * 1024)); issued += NV; } } while (0)
#define PP_NEED_K(j) do { if (!(dbg & 256)) vm_wait_n(issued - ((j) * PER + 1)); } while (0)
#define PP_NEED_V(j) do { if (!(dbg & 256)) vm_wait_n(issued - ((j) + 1) * PER); } while (0)
#define PP_BAR() asm volatile("s_waitcnt lgkmcnt(0)\n\ts_barrier" ::: "memory")
    f32x16 o[ND];
#pragma unroll
    for (int d = 0; d < ND; ++d) o[d] = f32x16{};
    f32x16 cin;
#pragma unroll
    for (int r = 0; r < 16; ++r) cin[r] = -mref2;
    float l_reg = 0.f;
    const int wrow0 = q0 + wid * 32, qrow = wrow0 + r32, cw = wrow0 / 64;
    const int vb0 = (int)lds0 + 8192 + ((lane >> 4) & 1) * 32 + (lane & 3) * 8 + (4 * hi + ((lane & 15) >> 2)) * 64;
    asm volatile("s_waitcnt vmcnt(0)" ::: "memory"); asm volatile("" : "+v"(qr[0]), "+v"(qr[1]), "+v"(qr[2]), "+v"(qr[3]));
#pragma unroll
    for (int j = 0; j < PD; ++j) { PP_DMA_K(j); PP_DMA_V(j); }
    if (grp) PP_DMA_K(PD);
    PP_NEED_V(0);
    PP_BAR();
    if (grp) PP_BAR();
    u32x4 pw0, pw1, pw2, pw3; f32x16 p1;
    for (int i = 0; i < n_t; ++i) {
        const int t = t_first + i, slot = i % NS;
        bool active;
        if (MODE == 0) active = (t <= cw); else active = (t >= cw - 8) && (t <= cw);
        if (grp == 0) PP_DMA_K(i + PD); else PP_DMA_V(i + PD);
        if (active && !(dbg & 32)) {
            const lds_cptr kb = (lds_cptr)shm + slot * SLOT + hi * 1024 + r32 * 16;
            f32x16 p0; qkt8(p0, p1, kb, qr, cin);
            p_half<MODE>(p0, l_reg, pw0, pw1, (t <= cw - 3) || (dbg & 8), qrow - 64 * t - 4 * hi, tabL);
        }
        if (grp == 0) PP_NEED_V(i); else PP_NEED_K(i + 1);
        PP_BAR();
        if (grp == 0) PP_DMA_V(i + PD); else PP_DMA_K(i + 1 + PD);
        if (active && !(dbg & 16)) {
            const int vb = vb0 + slot * SLOT;
            s16x4 lo0[ND][2], hi0[ND][2], lo1[ND][2], hi1[ND][2];
            v_reads<ND, 0>(lo0, hi0, vb);
            asm volatile("s_waitcnt lgkmcnt(0)" ::: "memory");
            v_reads<ND, 2>(lo1, hi1, vb);
            __builtin_amdgcn_sched_barrier(0);
            pv_half<ND>(o, lo0, hi0, __builtin_bit_cast(bf16x8, pw0), __builtin_bit_cast(bf16x8, pw1));
            __builtin_amdgcn_sched_barrier(0);
            p_half<MODE>(p1, l_reg, pw2, pw3, (t <= cw - 3) || (dbg & 8), qrow - 64 * t - 4 * hi - 32, tabL);
            asm volatile("s_waitcnt lgkmcnt(0)" ::: "memory");
            __builtin_amdgcn_sched_barrier(0);
            pv_half<ND>(o, lo1, hi1, __builtin_bit_cast(bf16x8, pw2), __builtin_bit_cast(bf16x8, pw3));
        }
        if (grp == 0) PP_NEED_K(i + 1); else PP_NEED_V(i + 1);
        PP_BAR();
    }
    if (grp == 0) PP_BAR();
#undef PP_DMA_K
#undef PP_DMA_V
#undef PP_NEED_K
#undef PP_NEED_V
    float rl[16];
    l_reg += __shfl_xor(l_reg, 32);
    if (hi == 0) wsf[32 + r32] = l_reg;
    asm volatile("s_waitcnt lgkmcnt(0)" ::: "memory");
#pragma unroll
    for (int r = 0; r < 16; ++r) rl[r] = __builtin_amdgcn_rcpf(wsf[32 + crow(r, hi)]) * oscale;
    if constexpr (OUT8) {
        static_assert(!OUT8 || VD == 64, "fp8 output: 64-wide heads");
        unsigned char* Ow = (unsigned char*)Ob + (size_t)(q0 + wid * 32) * opitch;
        ALAS unsigned char* stg = (ALAS unsigned char*)(shm + L_OST) + wid * 2048;
#pragma unroll
        for (int r = 0; r < 16; ++r) { const int orow = crow(r, hi);
#pragma unroll
            for (int d0 = 0; d0 < 2; ++d0) { const float v = o[d0][r] * rl[r]; stg[orow * 64 + d0 * 32 + r32] = (unsigned char)(__builtin_amdgcn_cvt_pk_fp8_f32(v, v, 0, false) & 0xff); } }
        asm volatile("s_waitcnt lgkmcnt(0)" ::: "memory");
#pragma unroll
        for (int i = 0; i < 2; ++i) { const int row = i * 16 + (lane >> 2), ch = lane & 3; const u32x4 v = *(const ALAS u32x4*)(stg + row * 64 + ch * 16); *(u32x4*)(Ow + (size_t)row * opitch + ch * 16) = v; }
        asm volatile("s_waitcnt lgkmcnt(0)" ::: "memory");
    } else {
    bf16_t* Ow = (bf16_t*)Ob + (size_t)(q0 + wid * 32) * opitch;
    ALAS bf16_t* stg = (ALAS bf16_t*)(shm + L_OST) + wid * 2048;
#pragma unroll
    for (int half = 0; half < ND / 2; ++half) {
#pragma unroll
        for (int r = 0; r < 16; ++r) { const int orow = crow(r, hi);
#pragma unroll
            for (int d0 = 0; d0 < 2; ++d0) stg[orow * 64 + d0 * 32 + r32] = f2bf(o[half * 2 + d0][r] * rl[r]); }
        asm volatile("s_waitcnt lgkmcnt(0)" ::: "memory");
#pragma unroll
        for (int i = 0; i < 4; ++i) { const int row = i * 8 + (lane >> 3), ch = lane & 7; const u32x4 v = *(const ALAS u32x4*)(stg + row * 64 + ch * 8); *(u32x4*)(Ow + (size_t)row * opitch + half * 64 + ch * 8) = v; }
        asm volatile("s_waitcnt lgkmcnt(0)" ::: "memory");
    }
    }
    PP_BAR();
#undef PP_BAR
}
}

constexpr int NWAVES = 8, NTHR = NWAVES * 64;
constexpr int BATCH = 2, SEQ = 8192, T = BATCH * SEQ, D = 1024;
constexpr int NPROJ = 3072, FFD = 2816, FFE = 3584, NEXP = 8;
constexpr size_t MiB = 1u << 20;
constexpr size_t CTL_ZERO_BYTES = 1 * MiB;
constexpr int CW_TMO = 0, CW_BAR = 4096;
constexpr int CW_HIST = 16384;
constexpr int CW_QATT = 32768, CW_QCONV = 32768 + 64 * 8;
constexpr int CW_MOE = 24576;
constexpr size_t WS_SS0 = 1 * MiB, WS_SS3 = WS_SS0 + 65536, WS_ROPE = WS_SS3 + 65536  , WS_TOKSEL = WS_ROPE + MiB  ,
                 WS_TOKGATE = WS_TOKSEL + 65536  , WS_ROWTOK = WS_TOKGATE + 131072  , WS_ROWGATE = WS_ROWTOK + 147456  ;
static_assert(WS_ROWGATE + 147456 <= 4 * MiB, "small arrays");
constexpr size_t WS_XB = 4 * MiB;
constexpr size_t WS_AO = 36 * MiB;
constexpr size_t WS_ACT0 = 68 * MiB;
constexpr size_t WS_XF = 164 * MiB;
constexpr size_t WS_WIN = 228 * MiB, WS_WO0 = 234 * MiB, WS_WGU0 = 236 * MiB, WS_WD0 = 247 * MiB, WS_WQKV = 253 * MiB, WS_WO1 = 259 * MiB;
constexpr size_t WS_WEGU = 264 * MiB;
constexpr size_t WS_WED = 376 * MiB;
constexpr size_t WS_SS1 = 432 * MiB, WS_SS2 = 433 * MiB;
constexpr size_t WS_END = 434 * MiB;
constexpr size_t WS_SORTA = 36 * MiB;
constexpr size_t WS_ACTE = 108 * MiB;
static_assert(WS_SORTA + (size_t)36864 * 2048 <= WS_ACTE && WS_ACTE + (size_t)18432 * 7168 <= WS_WO0 && WS_WD0 + (size_t)1024 * 2816 * 2 <= WS_WQKV && WS_WO1 + 2 * MiB <= WS_WEGU, "ws map");
constexpr int RING_BYTES = 131072, MISC_OFF = RING_BYTES + 320, LDS_BYTES = 147456;
static_assert(att::L_END <= RING_BYTES, "attention LDS");

#define GAS __attribute__((address_space(1)))
#define LAS __attribute__((address_space(3)))
typedef unsigned short bf16;
typedef unsigned v4u __attribute__((ext_vector_type(4)));
typedef float f32x4 __attribute__((ext_vector_type(4)));
typedef GAS unsigned gu32;
#define RLX_AGENT __ATOMIC_RELAXED, __HIP_MEMORY_SCOPE_AGENT
#define LDS_WAIT() asm volatile("s_waitcnt lgkmcnt(0)" ::: "memory")
#define VM_WAIT() asm volatile("s_waitcnt vmcnt(0)" ::: "memory")
__device__ __forceinline__ unsigned f2bf(float f) { unsigned u = __builtin_bit_cast(unsigned, f); return (u + 0x7fffu + ((u >> 16) & 1u)) >> 16; }
__device__ __forceinline__ unsigned pk2(float lo, float hi) { return f2bf(lo) | (f2bf(hi) << 16); }
__device__ __forceinline__ float bf2f(unsigned short h) { return __builtin_bit_cast(float, (unsigned)h << 16); }
#define XB_TMO      128
#define XB_XCNT(j)  (256  + 64 * (j))
#define XB_XSUB(j)  (1280 + 64 * (j))
#define XB_XGEN(j)  (2304 + 64 * (j))
#define XB_TOP      3328
#define XB_TOPGEN   3392
#define XCD_BAR_WORDS 3456
#define XB_SPIN_CAP (1u << 18)

__device__ __forceinline__ unsigned xb_ld(unsigned* p)              { return __hip_atomic_load(p, __ATOMIC_RELAXED, __HIP_MEMORY_SCOPE_AGENT); }
__device__ __forceinline__ unsigned xb_add(unsigned* p, unsigned v) { return __hip_atomic_fetch_add(p, v, __ATOMIC_RELAXED, __HIP_MEMORY_SCOPE_AGENT); }
__device__ __forceinline__ unsigned xb_xcc_id() { return (unsigned)__builtin_amdgcn_s_getreg((3 << 11) | 20) & 0xFu; }
#define XB_SPIN(cond, bar) do { unsigned _sp = 0; while (cond) { __builtin_amdgcn_s_sleep(1); \
    if ((++_sp & 255u) == 0u) { if (xb_ld(&(bar)[XB_TMO])) break; if (_sp > XB_SPIN_CAP) { atomicAdd(&(bar)[XB_TMO], 1u); break; } } } } while (0)

struct XcdBarrier {
    unsigned* bar; unsigned x;
    volatile LAS unsigned* st;
};

__device__ __forceinline__ XcdBarrier xcd_barrier_post(unsigned* bar, volatile LAS unsigned* st) {
    XcdBarrier b; b.bar = bar; b.x = xb_xcc_id(); b.st = st;
    if (threadIdx.x == 0) (void)xb_add(&bar[XB_XCNT(b.x)], 1u);
    return b;
}
__device__ __forceinline__ void xcd_barrier_complete(unsigned* bar, unsigned x, unsigned& nloc, unsigned& nx) {
    const unsigned G = gridDim.x * gridDim.y * gridDim.z;
    unsigned sum, cnt, mine, sp = 0u;
    for (;;) {
        sum = 0u; cnt = 0u; mine = 0u;
#pragma unroll
        for (unsigned j = 0; j < 16; ++j) { const unsigned c = xb_ld(&bar[XB_XCNT(j)]); sum += c; cnt += (c > 0u) ? 1u : 0u; mine = (j == x) ? c : mine; }
        if (sum == G) break;
        __builtin_amdgcn_s_sleep(1);
        if ((++sp & 255u) == 0u) { if (xb_ld(&bar[XB_TMO])) break; if (sp > XB_SPIN_CAP) { atomicAdd(&bar[XB_TMO], 1u); break; } }
    }
    nloc = mine > 0u ? mine : 1u; nx = cnt > 0u ? cnt : 1u;
}

__device__ __forceinline__ void xcd_barrier(const XcdBarrier& b) {
    asm volatile("s_waitcnt vmcnt(0)" ::: "memory");
    __syncthreads();
    if (threadIdx.x == 0) {
        unsigned* bar = b.bar;
        __builtin_amdgcn_s_waitcnt(0);
        unsigned nloc = b.st[0], nx = b.st[1];
        if (nloc == 0u) { xcd_barrier_complete(bar, b.x, nloc, nx); b.st[0] = nloc; b.st[1] = nx; }
        const unsigned old = xb_add(&bar[XB_XSUB(b.x)], 1u);
        const unsigned gen = old / nloc;
        if (old + 1u == (gen + 1u) * nloc) {
            __builtin_amdgcn_fence(__ATOMIC_RELEASE, "agent");
            asm volatile("s_waitcnt vmcnt(0)" ::: "memory");
            const unsigned og = xb_add(&bar[XB_TOP], 1u);
            const unsigned tg = og / nx;
            if (og + 1u == (tg + 1u) * nx) xb_add(&bar[XB_TOPGEN], 1u);
            else XB_SPIN(xb_ld(&bar[XB_TOPGEN]) == tg, bar);
            __builtin_amdgcn_fence(__ATOMIC_ACQUIRE, "agent");
            xb_add(&bar[XB_XGEN(b.x)], 1u);
            asm volatile("s_waitcnt vmcnt(0)" ::: "memory");
        } else {
            XB_SPIN(xb_ld(&bar[XB_XGEN(b.x)]) == gen, bar);
            __builtin_amdgcn_fence(__ATOMIC_ACQUIRE, "agent");
            asm volatile("s_waitcnt vmcnt(0)" ::: "memory");
        }
    }
    __syncthreads();
}

__device__ __forceinline__ float wave_sum(float v) {
#pragma unroll
    for (int o = 1; o < 64; o <<= 1) v += __shfl_xor(v, o);
    return v;
}
__device__ __forceinline__ float wave_max(float v) {
#pragma unroll
    for (int o = 1; o < 64; o <<= 1) v = fmaxf(v, __shfl_xor(v, o));
    return v;
}
__device__ __forceinline__ int dest_block(int blk, int map) {
    if (map == 1) { const int s = blk & 7; return (blk & ~7) + 4 * (s & 1) + (s >> 1); }
    if (map == 2) return (blk >> 2) * 8 + (blk & 3);
    if (map == 3) return (blk >> 2) * 8 + 4 + (blk & 3);
    return blk;
}
__device__ __forceinline__ void tr_tile(const float* W, int K, int N, bf16* WT, int map, const float* gain, LAS unsigned* scr, int item, int lane) {
    const int nblk = N / 64, kb = item / nblk, nb = item % nblk, k0 = 64 * kb, n0 = 64 * nb;
    const int c = lane & 15, ip = lane >> 4;
#pragma unroll
    for (int it = 0; it < 8; ++it) { const int kp = it * 4 + ip, k = k0 + 2 * kp;
        f32x4 a = *(const GAS f32x4*)(W + (size_t)k * N + n0 + 4 * c), b = *(const GAS f32x4*)(W + (size_t)(k + 1) * N + n0 + 4 * c);
        if (gain) { a = a * gain[k]; b = b * gain[k + 1]; }
#pragma unroll
        for (int j = 0; j < 4; ++j) scr[(4 * c + j) * 33 + kp] = pk2(a[j], b[j]); }
    LDS_WAIT(); asm volatile("" ::: "memory");
#pragma unroll
    for (int it = 0; it < 8; ++it) { const int n = it * 8 + (lane >> 3), q = lane & 7;
        v4u o; o.x = scr[n * 33 + 4 * q]; o.y = scr[n * 33 + 4 * q + 1]; o.z = scr[n * 33 + 4 * q + 2]; o.w = scr[n * 33 + 4 * q + 3];
        const int drow = dest_block((n0 + n) >> 5, map) * 32 + (n & 31);
        *(GAS v4u*)(WT + (size_t)drow * K + k0 + 8 * q) = o; }
    LDS_WAIT(); asm volatile("" ::: "memory");
}

__device__ __forceinline__ void tr_tile8(const float* W, int K, int N, unsigned char* WT, int map, const float* gain, float wscale, LAS unsigned* scr, int item, int lane) {
    const int nblk = N / 64, kb = item / nblk, nb = item % nblk, k0 = 64 * kb, n0 = 64 * nb;
    const int c = lane & 15, ip = lane >> 4;
#pragma unroll
    for (int it = 0; it < 4; ++it) { const int k4 = it * 4 + ip, k = k0 + 4 * k4; f32x4 a[4];
#pragma unroll
        for (int i = 0; i < 4; ++i) a[i] = *(const GAS f32x4*)(W + (size_t)(k + i) * N + n0 + 4 * c) * ((gain ? gain[k + i] : 1.f) * wscale);
#pragma unroll
        for (int j = 0; j < 4; ++j) scr[(4 * c + j) * 17 + k4] = pg8::pk4_fp8(a[0][j], a[1][j], a[2][j], a[3][j]); }
    LDS_WAIT(); asm volatile("" ::: "memory");
#pragma unroll
    for (int it = 0; it < 4; ++it) { const int n = it * 16 + (lane >> 2), q = lane & 3;
        v4u o; o.x = scr[n * 17 + 4 * q]; o.y = scr[n * 17 + 4 * q + 1]; o.z = scr[n * 17 + 4 * q + 2]; o.w = scr[n * 17 + 4 * q + 3];
        const int drow = dest_block((n0 + n) >> 5, map) * 32 + (n & 31);
        *(GAS v4u*)(WT + (size_t)drow * K + k0 + 16 * q) = o; }
    LDS_WAIT(); asm volatile("" ::: "memory");
}

struct TrItem { const float* W; unsigned char* WT; const float* gain; int K, N, map, fp8, k0, n0; float scale; };
__device__ __forceinline__ void tr_load(const TrItem& d, f32x4 (&a)[16], float (&g)[16], int lane) {
    const int c = lane & 15, ip = lane >> 4;
#pragma unroll
    for (int it = 0; it < 4; ++it)
#pragma unroll
        for (int i = 0; i < 4; ++i) { const int k = d.k0 + 4 * (it * 4 + ip) + i;
            a[it * 4 + i] = __builtin_nontemporal_load((const GAS f32x4*)(d.W + (size_t)k * d.N + d.n0 + 4 * c)); g[it * 4 + i] = d.gain ? d.gain[k] : 1.f; }
}
__device__ __forceinline__ void tr_emit(const TrItem& d, const f32x4 (&a)[16], const float (&g)[16], LAS unsigned* scr, int lane) {
    const int c = lane & 15, ip = lane >> 4;
    if (d.fp8) {
#pragma unroll
        for (int it = 0; it < 4; ++it) { const int k4 = it * 4 + ip;
#pragma unroll
            for (int j = 0; j < 4; ++j) scr[(4 * c + j) * 17 + k4] = pg8::pk4_fp8(a[it * 4][j] * (g[it * 4] * d.scale), a[it * 4 + 1][j] * (g[it * 4 + 1] * d.scale), a[it * 4 + 2][j] * (g[it * 4 + 2] * d.scale), a[it * 4 + 3][j] * (g[it * 4 + 3] * d.scale)); }
        LDS_WAIT(); asm volatile("" ::: "memory");
#pragma unroll
        for (int it = 0; it < 4; ++it) { const int n = it * 16 + (lane >> 2), q = lane & 3;
            v4u o; o.x = scr[n * 17 + 4 * q]; o.y = scr[n * 17 + 4 * q + 1]; o.z = scr[n * 17 + 4 * q + 2]; o.w = scr[n * 17 + 4 * q + 3];
            const int drow = dest_block((d.n0 + n) >> 5, d.map) * 32 + (n & 31);
            __builtin_nontemporal_store(o, (GAS v4u*)(d.WT + (size_t)drow * d.K + d.k0 + 16 * q)); }
    } else {
#pragma unroll
        for (int it = 0; it < 4; ++it) { const int k4 = it * 4 + ip;
#pragma unroll
            for (int j = 0; j < 4; ++j) { scr[(4 * c + j) * 33 + 2 * k4] = pk2(a[it * 4][j] * g[it * 4], a[it * 4 + 1][j] * g[it * 4 + 1]); scr[(4 * c + j) * 33 + 2 * k4 + 1] = pk2(a[it * 4 + 2][j] * g[it * 4 + 2], a[it * 4 + 3][j] * g[it * 4 + 3]); } }
        LDS_WAIT(); asm volatile("" ::: "memory");
#pragma unroll
        for (int it = 0; it < 8; ++it) { const int n = it * 8 + (lane >> 3), q = lane & 7;
            v4u o; o.x = scr[n * 33 + 4 * q]; o.y = scr[n * 33 + 4 * q + 1]; o.z = scr[n * 33 + 4 * q + 2]; o.w = scr[n * 33 + 4 * q + 3];
            const int drow = dest_block((d.n0 + n) >> 5, d.map) * 32 + (n & 31);
            __builtin_nontemporal_store(o, (GAS v4u*)(d.WT + ((size_t)drow * d.K + d.k0 + 8 * q) * 2)); }
    }
    LDS_WAIT(); asm volatile("" ::: "memory");
}
constexpr float AO8_SCALE = 16.f;
constexpr float W8_SCALE = 64.f;

#ifndef PROBE_MASK
#define PROBE_MASK 0
#endif
struct KArgs { const void* in[27]; float* out; unsigned char* ws; int ph_lo, ph_hi, flags, pad; };

struct KArgs;
__device__ __forceinline__ const void* karg_in(const KArgs& a, int k) { asm volatile("" : "+s"(k)); return a.in[k]; }
__global__ void __launch_bounds__(NTHR, 2) fwd_kernel(KArgs args) {
    extern __shared__ __attribute__((aligned(16))) unsigned char lds_raw[];
    LAS unsigned char* lds = (LAS unsigned char*)lds_raw;
    volatile LAS unsigned* MISC = (volatile LAS unsigned*)(lds + MISC_OFF);
    const int tid = threadIdx.x, lane = tid & 63, wave = __builtin_amdgcn_readfirstlane(tid >> 6);
    const int G = gridDim.x; const int bx = blockIdx.x; const int vcu = (G % 8 == 0) ? (bx % 8) * (G / 8) + bx / 8 : bx;
    unsigned char* ws = args.ws;
    unsigned* ctl = (unsigned*)ws;
    for (int u = tid; u < (LDS_BYTES - RING_BYTES) / 4; u += NTHR) ((LAS unsigned*)(lds + RING_BYTES))[u] = 0u;
    __syncthreads();
    XcdBarrier bar = xcd_barrier_post(ctl + CW_BAR, MISC + 8);
    const int lo = args.ph_lo, hi_ph = args.ph_hi;
#define IN(k) (lo <= (k) && (k) < hi_ph)
#define REP(k)
#define SEAM(k) do { if (IN(k) && IN((k) + 1)) xcd_barrier(bar); } while (0)
#define KIN(T, k) ((const T*)karg_in(args, (k)))
#define x_in KIN(float, 0)
#define positions KIN(int, 1)
#define ev_attn_norm KIN(float, 2)
#define ev_w_in KIN(float, 3)
#define ev_q_norm KIN(float, 4)
#define ev_k_norm KIN(float, 5)
#define ev_lq1 KIN(float, 6)
#define ev_lk1 KIN(float, 7)
#define ev_lq2 KIN(float, 8)
#define ev_lk2 KIN(float, 9)
#define ev_subln KIN(float, 10)
#define ev_w_out KIN(float, 11)
#define ev_ffn_norm KIN(float, 12)
#define ev_w_gate KIN(float, 13)
#define ev_w_up KIN(float, 14)
#define ev_w_down KIN(float, 15)
#define od_attn_norm KIN(float, 16)
#define od_w_qkv KIN(float, 17)
#define od_q_norm KIN(float, 18)
#define od_k_norm KIN(float, 19)
#define od_rel_bias KIN(float, 20)
#define od_w_out KIN(float, 21)
#define od_ffn_norm KIN(float, 22)
#define od_router KIN(float, 23)
#define od_we_gate KIN(float, 24)
#define od_we_up KIN(float, 25)
#define od_we_down KIN(float, 26)
    float* out = args.out;
    float* ss0 = (float*)(ws + WS_SS0); float* ss1 = (float*)(ws + WS_SS1); float* ss2 = (float*)(ws + WS_SS2); float* ss3 = (float*)(ws + WS_SS3);
    float* rope = (float*)(ws + WS_ROPE); unsigned* toksel = (unsigned*)(ws + WS_TOKSEL); float* tokgate = (float*)(ws + WS_TOKGATE);
    int* rowtok = (int*)(ws + WS_ROWTOK); float* rowgate = (float*)(ws + WS_ROWGATE);
    bf16* XB = (bf16*)(ws + WS_XB); bf16* AO = (bf16*)(ws + WS_AO); bf16* ACT0 = (bf16*)(ws + WS_ACT0); float* XF = (float*)(ws + WS_XF); bf16* OD = (bf16*)(ws + WS_XF);
    bf16* Win_t = (bf16*)(ws + WS_WIN); bf16* Wo0_t = (bf16*)(ws + WS_WO0); bf16* Wgu0_t = (bf16*)(ws + WS_WGU0); bf16* Wd0_t = (bf16*)(ws + WS_WD0);
    unsigned char* Wqkv8 = ws + WS_WQKV; unsigned char* Wo18 = ws + WS_WO1; unsigned char* XB8 = ws + WS_XB; unsigned char* AO8 = ws + WS_AO; unsigned char* WEgu8 = ws + WS_WEGU; unsigned char* WEd8 = ws + WS_WED;
    unsigned char* SORTA8 = ws + WS_SORTA; unsigned char* ACTE8 = ws + WS_ACTE;
    const int gw = vcu * NWAVES + wave, NGW = G * NWAVES;

    constexpr int I_IN = 16 * 48, I_O = 16 * 16, I_G = 16 * 44, I_D = 44 * 16, I_EG = 16 * 56, I_ED = 56 * 16;
    constexpr int NSMALL = I_IN + I_O + 2 * I_G + I_D + I_IN + I_O, NITEMS = NSMALL + 24 * I_EG;
        auto decode = [&](int it) -> TrItem {
        TrItem d; int r = it; d.scale = 1.f; d.fp8 = 0; d.gain = nullptr; d.map = 0;
        auto fin = [&](int nbl) { d.k0 = 64 * (r / nbl); d.n0 = 64 * (r % nbl); };
        if (r < I_IN) { d.W = ev_w_in; d.K = D; d.N = NPROJ; d.WT = (unsigned char*)Win_t; d.map = 1; d.gain = ev_attn_norm; fin(NPROJ / 64); return d; } r -= I_IN;
        if (r < I_O) { d.W = ev_w_out; d.K = D; d.N = D; d.WT = (unsigned char*)Wo0_t; fin(D / 64); return d; } r -= I_O;
        if (r < I_G) { d.W = ev_w_gate; d.K = D; d.N = FFD; d.WT = (unsigned char*)Wgu0_t; d.map = 2; d.gain = ev_ffn_norm; fin(FFD / 64); return d; } r -= I_G;
        if (r < I_G) { d.W = ev_w_up; d.K = D; d.N = FFD; d.WT = (unsigned char*)Wgu0_t; d.map = 3; d.gain = ev_ffn_norm; fin(FFD / 64); return d; } r -= I_G;
        if (r < I_D) { d.W = ev_w_down; d.K = FFD; d.N = D; d.WT = (unsigned char*)Wd0_t; fin(D / 64); return d; } r -= I_D;
        d.fp8 = 1; d.scale = W8_SCALE;
        if (r < I_IN) { d.W = od_w_qkv; d.K = D; d.N = NPROJ; d.WT = Wqkv8; d.map = 1; d.gain = od_attn_norm; fin(NPROJ / 64); return d; } r -= I_IN;
        if (r < I_O) { d.W = od_w_out; d.K = D; d.N = D; d.WT = Wo18; fin(D / 64); return d; } r -= I_O;
        const int which = r / (8 * I_EG), rr = r % (8 * I_EG), e2 = rr / I_EG; r = rr % I_EG;
        if (which == 0) { d.W = od_we_gate + (size_t)e2 * D * FFE; d.K = D; d.N = FFE; d.WT = WEgu8 + (size_t)e2 * 2 * FFE * D; d.map = 2; d.gain = od_ffn_norm; fin(FFE / 64); }
        else if (which == 1) { d.W = od_we_up + (size_t)e2 * D * FFE; d.K = D; d.N = FFE; d.WT = WEgu8 + (size_t)e2 * 2 * FFE * D; d.map = 3; d.gain = od_ffn_norm; fin(FFE / 64); }
        else { d.W = od_we_down + (size_t)e2 * FFE * D; d.K = FFE; d.N = D; d.WT = WEd8 + (size_t)e2 * D * FFE; fin(D / 64); }
        return d; };
    auto conv_range = [&](int first, int end, int stride) {
        LAS unsigned* scr = (LAS unsigned*)(lds + wave * 8704);
        f32x4 bufA[16], bufB[16]; float gA[16], gB[16]; TrItem dA, dB; int it = first;
        if (it < end) { dA = decode(it); tr_load(dA, bufA, gA, lane); }
        while (it < end) {
            const int it2 = it + stride, it3 = it2 + stride;
            if (it2 < end) { dB = decode(it2); tr_load(dB, bufB, gB, lane); }
            tr_emit(dA, bufA, gA, scr, lane);
            if (it3 < end) { dA = decode(it3); tr_load(dA, bufA, gA, lane); }
            if (it2 < end) tr_emit(dB, bufB, gB, scr, lane);
            it = it3; } };
    auto pull = [&](int qword) -> int {
        __syncthreads(); if (tid == 0) MISC[16] = __hip_atomic_fetch_add(ctl + qword, 1u, __ATOMIC_RELAXED, __HIP_MEMORY_SCOPE_AGENT); __syncthreads();
        return __builtin_amdgcn_readfirstlane((int)MISC[16]); };

    REP(0) if (IN(0)) {
        conv_range(gw, I_IN, NGW);
        for (int m0 = gw; m0 < T; m0 += 2 * NGW) {
            f32x4 v[2][4];
#pragma unroll
            for (int u = 0; u < 2; ++u) { const int m = m0 + u * NGW; if (m < T) { const GAS f32x4* xr = (const GAS f32x4*)(x_in + (size_t)m * D) + lane;
#pragma unroll
                for (int j = 0; j < 4; ++j) v[u][j] = __builtin_nontemporal_load(xr + 64 * j); } }
#pragma unroll
            for (int u = 0; u < 2; ++u) { const int m = m0 + u * NGW; if (m >= T) break; float s = 0.f;
#pragma unroll
                for (int j = 0; j < 4; ++j) s += (v[u][j].x * v[u][j].x + v[u][j].y * v[u][j].y) + (v[u][j].z * v[u][j].z + v[u][j].w * v[u][j].w);
                s = wave_sum(s); if (lane == 0) ss0[m] = s;
                GAS unsigned long long* o8 = (GAS unsigned long long*)(XB + (size_t)m * D) + lane;
#pragma unroll
                for (int j = 0; j < 4; ++j) o8[64 * j] = (unsigned long long)pk2(v[u][j].x, v[u][j].y) | ((unsigned long long)pk2(v[u][j].z, v[u][j].w) << 32); }
        }
        for (int i = vcu * NTHR + tid; i < T * 8; i += G * NTHR) {
            const int tok = i >> 3, f = i & 7;
            const double inv = exp2(-(double)f * (18.931568569324174 / 8.0));
            double ang = (double)positions[tok] * inv; ang -= 6.283185307179586 * rint(ang * 0.15915494309189535);
            float sn, cs; sincosf((float)ang, &sn, &cs);
            rope[(size_t)tok * 16 + f] = cs; rope[(size_t)tok * 16 + 8 + f] = sn;
        }
    }
    SEAM(0);

    REP(1) if (IN(1)) {
        pg8::Gemm g{XB, Win_t, T, NPROJ, D}; pg8::StaticOrder S; S.init(T, NPROJ, G, bx);
        pg8::EpiProj E{ACT0, T, ss0, 1, ev_q_norm, ev_k_norm, rope, 0, 1.f};
        pg8::gemm_phase<pg8::EpiProj, pg8::StaticOrder, true, true>(lds, g, S, E);
    }
    SEAM(1);

    REP(2) if (IN(2)) {
        const float gqm = wave_max(fabsf(ev_q_norm[lane])), gkm = wave_max(fabsf(ev_k_norm[lane]));
        const float mref = 8.f * gqm * gkm * pg8::LOG2E;
        constexpr int NJOBS = (NITEMS - I_IN + 63) / 64;
        const bool conv_first = ((bx >> 3) & 3) == 3;
#define P2_CONV_LOOP() for (;;) { const int j = pull(CW_QCONV); if (j >= NJOBS) break; \
            const int first = I_IN + j * 64 + wave * 8; conv_range(first, (first + 8 < NITEMS) ? first + 8 : NITEMS, 1); }
        if (conv_first) P2_CONV_LOOP()
#pragma unroll 1
        for (int kq = 0; kq < 8; ++kq) { const int xq = (bx + kq) & 7;
            for (;;) { const int idx = pull(CW_QATT + 64 * xq); if (idx >= 128) break;
                if (idx < 64) { if (args.flags & 1) continue;
                    const int bhm = 2 * xq + (idx & 1), qb = 31 - (idx >> 1);
                    const int b = bhm >> 3, hm = bhm & 7, h = hm >> 1;
                    const bf16* base = ACT0 + (size_t)b * SEQ * 64;
                    att::attn_unit<0, 128, false, 1>((LAS char*)lds, base + (size_t)(24 + hm) * T * 64, base + (size_t)(32 + hm) * T * 64, base + (size_t)(40 + 2 * h) * T * 64, OD + (size_t)b * SEQ * D + hm * 128, D, qb * 256, mref, nullptr, 1.f, args.flags);
                } else { if (args.flags & 2) continue;
                    const int bh = 2 * xq + (idx & 1), qb = 31 - ((idx - 64) >> 1);
                    const int b = bh >> 3, h = bh & 7;
                    const bf16* base = ACT0 + (size_t)b * SEQ * 64;
                    att::attn_unit<2, 64>((LAS char*)lds, base + (size_t)h * T * 64, base + (size_t)(8 + h) * T * 64, base + (size_t)(16 + h) * T * 64, AO + (size_t)b * SEQ * D + h * 64, D, qb * 256, 0.f, nullptr);
                }
            }
        }
        P2_CONV_LOOP()
#undef P2_CONV_LOOP
    }
    SEAM(2);

    REP(3) if (IN(3)) {
        const float a1 = wave_sum(ev_lq1[lane] * ev_lk1[lane]), a2 = wave_sum(ev_lq2[lane] * ev_lk2[lane]);
        const float lam_init = 0.2f, lam = expf(a1) - expf(a2) + lam_init;
        const int h = lane >> 4, v0 = (lane & 15) * 8;
        float sg[8];
#pragma unroll
        for (int j = 0; j < 8; ++j) sg[j] = ev_subln[v0 + j] * (1.f - lam_init);
        for (int m0 = gw; m0 < T; m0 += 4 * NGW) {
            v4u a4[4], b4[4];
#pragma unroll
            for (int u = 0; u < 4; ++u) { const int m = m0 + u * NGW; if (m < T) { a4[u] = *(const GAS v4u*)(OD + (size_t)m * D + (2 * h) * 128 + v0); b4[u] = *(const GAS v4u*)(OD + (size_t)m * D + (2 * h + 1) * 128 + v0); } }
#pragma unroll
            for (int u = 0; u < 4; ++u) { const int m = m0 + u * NGW; if (m >= T) break;
                const v4u a = a4[u], b = b4[u]; float d[8]; float s = 0.f;
#pragma unroll
                for (int j = 0; j < 4; ++j) { const unsigned ua = a[j], ub = b[j];
                    d[2 * j] = bf2f((unsigned short)(ua & 0xffffu)) - lam * bf2f((unsigned short)(ub & 0xffffu));
                    d[2 * j + 1] = bf2f((unsigned short)(ua >> 16)) - lam * bf2f((unsigned short)(ub >> 16));
                    s += d[2 * j] * d[2 * j] + d[2 * j + 1] * d[2 * j + 1]; }
                s += __shfl_xor(s, 1); s += __shfl_xor(s, 2); s += __shfl_xor(s, 4); s += __shfl_xor(s, 8);
                const float rs = rsqrtf(s * (1.f / 128.f) + pg8::RMS_EPS);
                v4u o; o.x = pk2(d[0] * rs * sg[0], d[1] * rs * sg[1]); o.y = pk2(d[2] * rs * sg[2], d[3] * rs * sg[3]); o.z = pk2(d[4] * rs * sg[4], d[5] * rs * sg[5]); o.w = pk2(d[6] * rs * sg[6], d[7] * rs * sg[7]);
                *(GAS v4u*)(AO + (size_t)m * D + 512 + h * 128 + v0) = o; }
        }
    }
    SEAM(3);

    REP(4) if (IN(4)) {
        pg8::Gemm g{AO, Wo0_t, T, D, D}; pg8::StaticOrder S; S.init(T, D, G, bx);
        pg8::EpiResid E{x_in, XF, XB, ss1, 1.f, nullptr};
        pg8::gemm_phase<pg8::EpiResid, pg8::StaticOrder, false, true>(lds, g, S, E);
    }
    SEAM(4);

    REP(5) if (IN(5)) {
        pg8::Gemm g{XB, Wgu0_t, T, 2 * FFD, D}; pg8::StaticOrder S; S.init(T, 2 * FFD, G, bx, (args.flags >> 9) & 1);
        pg8::EpiSwiglu<false> E{ACT0, FFD, ss1, 16, nullptr, 0, 2 * FFD / 256, 1.f};
        pg8::gemm_phase<pg8::EpiSwiglu<false>, pg8::StaticOrder, true, true>(lds, g, S, E);
    }
    SEAM(5);

    if (IN(6)) {
        pg8::Gemm g{ACT0, Wd0_t, T, D, FFD}; pg8::StaticOrder S; S.init(T, D, G, bx);
        pg8::EpiResid E{XF, XF, nullptr, ss2, 1.f, XB8};
        pg8::gemm_phase<pg8::EpiResid, pg8::StaticOrder, false, true>(lds, g, S, E);
    }
    SEAM(6);

    REP(7) if (IN(7)) {
        pg8::Gemm g{(const bf16*)XB8, (const bf16*)Wqkv8, T, NPROJ, D / 2}; pg8::StaticOrder S; S.init(T, NPROJ, G, bx);
        pg8::EpiProj E{ACT0, T, ss2, 16, od_q_norm, od_k_norm, nullptr, 1, 1.f / W8_SCALE};
        pg8::gemm_phase<pg8::EpiProj, pg8::StaticOrder, true, true, true>(lds, g, S, E);
    }
    SEAM(7);

    REP(8) if (IN(8)) {
        const float gqm = wave_max(fabsf(od_q_norm[lane])), gkm = wave_max(fabsf(od_k_norm[lane]));
        for (int L = vcu; L < 1024; L += G) {
            const int bh = (L & 255) >> 3, qb = 4 * (L & 7) + (L >> 8);
            const int b = bh >> 4, h = bh & 15;
            const float* tab = od_rel_bias + h * 257;
            float tm = fabsf(tab[lane]); tm = fmaxf(tm, fabsf(tab[64 + lane])); tm = fmaxf(tm, fabsf(tab[128 + lane])); tm = fmaxf(tm, fabsf(tab[192 + lane])); tm = fmaxf(tm, fabsf(tab[256]));
            tm = wave_max(tm);
            const float mref = (8.f * gqm * gkm + tm) * pg8::LOG2E;
            const bf16* base = ACT0 + (size_t)b * SEQ * 64;
            att::attn_unit<1, 64, true, 1>((LAS char*)lds, base + (size_t)h * T * 64, base + (size_t)(16 + h) * T * 64, base + (size_t)(32 + h) * T * 64, AO8 + (size_t)b * SEQ * D + h * 64, D, qb * 256, mref, tab, AO8_SCALE);
        }
    }
    SEAM(8);

    REP(9) if (IN(9)) {
        pg8::Gemm g{(const bf16*)AO8, (const bf16*)Wo18, T, D, D / 2}; pg8::StaticOrder S; S.init(T, D, G, bx);
        pg8::EpiResid E{XF, out, nullptr, nullptr, 1.f / (W8_SCALE * AO8_SCALE), nullptr};
        pg8::gemm_phase<pg8::EpiResid, pg8::StaticOrder, false, true, true>(lds, g, S, E);
    }
    SEAM(9);

    REP(10) if (IN(10)) {
        LAS float* wrT = (LAS float*)lds;
        LAS unsigned* sel = (LAS unsigned*)(lds + 32768);
        for (int i = tid; i < 1024; i += NTHR) { const float gn = od_ffn_norm[i]; const f32x4 w0 = *(const GAS f32x4*)(od_router + (size_t)i * 8), w1 = *(const GAS f32x4*)(od_router + (size_t)i * 8 + 4);
            wrT[i] = w0.x * gn; wrT[1024 + i] = w0.y * gn; wrT[2048 + i] = w0.z * gn; wrT[3072 + i] = w0.w * gn; wrT[4096 + i] = w1.x * gn; wrT[5120 + i] = w1.y * gn; wrT[6144 + i] = w1.z * gn; wrT[7168 + i] = w1.w * gn; }
        __syncthreads();
        for (int blk = vcu; blk < T / 64; blk += G) {
#pragma unroll 1
            for (int q4 = 0; q4 < 2; ++q4) {
                const int tk = lane >> 4, sub = lane & 15; const int tok = blk * 64 + wave * 8 + q4 * 4 + tk;
                const GAS f32x4* xr = (const GAS f32x4*)(out + (size_t)tok * D) + sub; float s = 0.f; float lg[8];
#pragma unroll
                for (int e2 = 0; e2 < 8; ++e2) lg[e2] = 0.f;
#pragma unroll
                for (int jh = 0; jh < 2; ++jh) { f32x4 xv[8];
#pragma unroll
                    for (int j = 0; j < 8; ++j) xv[j] = xr[16 * (8 * jh + j)];
#pragma unroll
                    for (int j = 0; j < 8; ++j) { const f32x4 v = xv[j]; s += (v.x * v.x + v.y * v.y) + (v.z * v.z + v.w * v.w);
#pragma unroll
                        for (int e2 = 0; e2 < 8; ++e2) { const f32x4 w = *(const LAS f32x4*)(wrT + e2 * 1024 + 64 * (8 * jh + j) + 4 * sub); lg[e2] += (v.x * w.x + v.y * w.y) + (v.z * w.z + v.w * w.w); } } }
#pragma unroll
                for (int o = 1; o < 16; o <<= 1) { s += __shfl_xor(s, o);
#pragma unroll
                    for (int e2 = 0; e2 < 8; ++e2) lg[e2] += __shfl_xor(lg[e2], o); }
                if (sub == 0) {
                    const float r = rsqrtf(s * (1.f / 1024.f) + pg8::RMS_EPS); ss3[tok] = s;
                    int e0 = 0; float v0 = lg[0];
#pragma unroll
                    for (int e2 = 1; e2 < 8; ++e2) if (lg[e2] > v0) { v0 = lg[e2]; e0 = e2; }
                    int e1 = -1; float v1 = 0.f;
#pragma unroll
                    for (int e2 = 0; e2 < 8; ++e2) if (e2 != e0 && (e1 < 0 || lg[e2] > v1)) { v1 = lg[e2]; e1 = e2; }
                    const float ex = expf((v1 - v0) * r), g0 = 1.f / (1.f + ex), g1 = ex / (1.f + ex);
                    sel[wave * 8 + q4 * 4 + tk] = (unsigned)e0 | ((unsigned)e1 << 8); tokgate[2 * tok] = g0; tokgate[2 * tok + 1] = g1;
                }
            }
            __syncthreads();
            if (wave == 0) { const unsigned sv = sel[lane]; const int e0 = sv & 0xff, e1 = sv >> 8; unsigned rank0 = 0, rank1 = 0;
                const unsigned long long lt = (1ull << lane) - 1ull;
#pragma unroll
                for (int e = 0; e < 8; ++e) { const unsigned long long m0 = __ballot(e0 == e), m1 = __ballot(e1 == e);
                    if (e0 == e) rank0 = __popcll(m0 & lt); if (e1 == e) rank1 = __popcll(m1 & lt);
                    if (lane == 0) { ctl[CW_HIST + blk * 16 + e] = __popcll(m0); ctl[CW_HIST + blk * 16 + 8 + e] = __popcll(m1); } }
                toksel[blk * 64 + lane] = sv | (rank0 << 16) | (rank1 << 24); }
            __syncthreads();
        }
    }
    SEAM(10);

    REP(11) if (IN(11)) {
        LAS unsigned* hs = (LAS unsigned*)lds;
        for (int i = tid; i < 4096; i += NTHR) hs[i] = ctl[CW_HIST + i];
        __syncthreads();
        if (tid < 16) hs[4096 + tid] = 0u;
        __syncthreads();
        { unsigned s = 0; const int g2 = tid & 15;
#pragma unroll
          for (int b2 = tid >> 4; b2 < 256; b2 += 32) s += hs[b2 * 16 + g2];
          atomicAdd((unsigned*)&hs[4096 + g2], s); }
        __syncthreads();
        if (tid == 0) { unsigned acc = 0; for (int g2 = 0; g2 < 16; ++g2) { hs[4128 + g2] = acc; acc += (hs[4096 + g2] + 255u) & ~255u; } hs[4128 + 16] = acc; }
        __syncthreads();
        if (bx == 0) {
            if (tid == 0) { const int nA = (int)(hs[4128 + 8] >> 8), nT = (int)(hs[4128 + 16] >> 8), nC1 = (nT - nA + 1) / 2, nC2 = nT - nA - nC1;
                ctl[CW_MOE] = nA; ctl[CW_MOE + 1] = nT;
                for (int ph = 0; ph < 2; ++ph) { const int nd = (ph == 0 ? nA : nC1) * (D / 256), nu = (ph == 0 ? nC1 : nC2) * (2 * FFE / 256);
                    int H = nd > G ? nd - G : (nd < G ? nd : 0); int mode = 1, R = 0; if (H >= G) H = 0;
                    pg8::MoeOrder::plan(nu, H, G, D / 128, FFE / 128, mode, R);
                    ctl[CW_MOE + 2 + 3 * ph] = H; ctl[CW_MOE + 3 + 3 * ph] = R; ctl[CW_MOE + 4 + 3 * ph] = mode; } }
            if (tid < 16) { const unsigned t0 = hs[4128 + tid] >> 8, t1 = hs[4128 + tid + 1] >> 8; for (unsigned t = t0; t < t1; ++t) ctl[CW_MOE + 16 + t] = tid & 7; }
        }
        for (int blk = vcu; blk < T / 64; blk += G) {
            if (tid < 16) hs[4160 + tid] = 0u;
            __syncthreads();
            { unsigned s = 0; const int g2 = tid & 15;
#pragma unroll
              for (int b2 = tid >> 4; b2 < 256; b2 += 32) s += (b2 < blk) ? hs[b2 * 16 + g2] : 0u;
              atomicAdd((unsigned*)&hs[4160 + g2], s); }
            __syncthreads();
            for (int tl = wave; tl < 64; tl += NWAVES) {
                const int tok = blk * 64 + tl; const unsigned sv = toksel[tok];
                const GAS f32x4* xr = (const GAS f32x4*)(out + (size_t)tok * D + 16 * lane); const f32x4 v0 = xr[0], v1 = xr[1], v2 = xr[2], v3 = xr[3];
                v4u pk; pk.x = pg8::pk4_fp8(v0[0], v0[1], v0[2], v0[3]); pk.y = pg8::pk4_fp8(v1[0], v1[1], v1[2], v1[3]); pk.z = pg8::pk4_fp8(v2[0], v2[1], v2[2], v2[3]); pk.w = pg8::pk4_fp8(v3[0], v3[1], v3[2], v3[3]);
#pragma unroll
                for (int sl = 0; sl < 2; ++sl) { const int e = (sv >> (8 * sl)) & 0xff, rank = (sv >> (16 + 8 * sl)) & 0xff, g2 = sl * 8 + e;
                    const unsigned srow = hs[4128 + g2] + hs[4160 + g2] + rank;
                    *(GAS v4u*)(SORTA8 + (size_t)srow * D + lane * 16) = pk;
                    if (lane == 0) { rowtok[srow] = tok; rowgate[srow] = tokgate[2 * tok + sl]; } }
            }
            __syncthreads();
        }
        for (int g2 = vcu; g2 < 16; g2 += G) {
            const unsigned r0 = hs[4128 + g2] + hs[4096 + g2], r1 = hs[4128 + g2 + 1];
            for (unsigned r = r0 + wave; r < r1; r += NWAVES) { if (lane == 0) { rowtok[r] = -1; rowgate[r] = 0.f; }
                *(GAS v4u*)(SORTA8 + (size_t)r * D + lane * 16) = (v4u){0u, 0u, 0u, 0u}; }
        }
    }
    SEAM(11);

    if (IN(12) || IN(13) || IN(14) || IN(15)) {
        const int nA = (int)__builtin_amdgcn_readfirstlane(ctl[CW_MOE]), nT = (int)__builtin_amdgcn_readfirstlane(ctl[CW_MOE + 1]);
        const int nC1 = (nT - nA + 1) / 2, nC2 = nT - nA - nC1;
        const int* texp = (const int*)(ctl + CW_MOE + 16);
        unsigned char* const ACT_C0 = ACTE8; unsigned char* const ACT_C1 = ACTE8 + (size_t)63 * MiB; unsigned char* const ACT_C2 = ACT_C1 + (size_t)36 * 256 * FFE;
        constexpr int NPN_GU = 2 * FFE / 256, NPN_D = D / 256;
#define MOE_GU(TILE0, NTILE, ACTBUF, PLAN) do { int H_ = 0, R_ = 0, mode_ = 1; \
        if ((PLAN) >= 0) { H_ = (int)__builtin_amdgcn_readfirstlane(ctl[CW_MOE + 2 + 3 * (PLAN)]); R_ = (int)__builtin_amdgcn_readfirstlane(ctl[CW_MOE + 3 + 3 * (PLAN)]); mode_ = (int)__builtin_amdgcn_readfirstlane(ctl[CW_MOE + 4 + 3 * (PLAN)]); } \
        pg8::Gemm g{(const bf16*)(SORTA8 + (size_t)(TILE0) * 256 * D), (const bf16*)WEgu8, 0, 0, D / 2}; pg8::MoeOrder S; S.init((NTILE), NPN_GU, G, bx, (TILE0), texp, H_, R_, mode_); \
        pg8::EpiSwiglu<true> E{(ACTBUF), FFE, ss3, 1, rowtok, (TILE0), NPN_GU, 1.f / W8_SCALE}; \
        pg8::gemm_phase<pg8::EpiSwiglu<true>, pg8::MoeOrder, true, true, true>(lds, g, S, E); } while (0)
#define MOE_DOWN(TILE0, NTILE, ACTBUF) do { pg8::Gemm g{(const bf16*)(ACTBUF), (const bf16*)WEd8, 0, 0, FFE / 2}; pg8::MoeOrder S; S.init((NTILE), NPN_D, G, bx, (TILE0), texp); \
        pg8::EpiMoeDown E{out, rowtok, rowgate, (TILE0), 1.f / W8_SCALE, (args.flags >> 2) & 1}; \
        pg8::gemm_phase<pg8::EpiMoeDown, pg8::MoeOrder, true, true, true>(lds, g, S, E); } while (0)
        if (IN(12)) MOE_GU(0, nA, ACT_C0, -1);
        SEAM(12);
        if (IN(13)) { MOE_DOWN(0, nA, ACT_C0); MOE_GU(nA, nC1, ACT_C1, 0); }
        SEAM(13);
        if (IN(14)) { MOE_DOWN(nA, nC1, ACT_C1); if (nC2 > 0) MOE_GU(nA + nC1, nC2, ACT_C2, 1); }
        SEAM(14);
        if (IN(15)) { if (nC2 > 0) MOE_DOWN(nA + nC1, nC2, ACT_C2); }
#undef MOE_GU
#undef MOE_DOWN
    }
#undef IN
#undef SEAM
#undef x_in
#undef positions
#undef ev_attn_norm
#undef ev_w_in
#undef ev_q_norm
#undef ev_k_norm
#undef ev_lq1
#undef ev_lk1
#undef ev_lq2
#undef ev_lk2
#undef ev_subln
#undef ev_w_out
#undef ev_ffn_norm
#undef ev_w_gate
#undef ev_w_up
#undef ev_w_down
#undef od_attn_norm
#undef od_w_qkv
#undef od_q_norm
#undef od_k_norm
#undef od_rel_bias
#undef od_w_out
#undef od_ffn_norm
#undef od_router
#undef od_we_gate
#undef od_we_up
#undef od_we_down
#undef KIN
}

constexpr int N_PHASES = 16;
extern "C" void kernel_launch(void* const* d_in, const int* in_sizes, int n_in, void* d_out, int out_size, void* d_ws, size_t ws_size, hipStream_t stream) {
    static int grid = 0;
    if (grid == 0) {
        if (n_in != 27 || out_size != T * D || ws_size < WS_END) { fprintf(stderr, "kernel_launch: unexpected problem (n_in %d, out %d, ws %zu)\n", n_in, out_size, ws_size); grid = -1; return; }
        int dev = 0, cus = 0, per_cu = 0;
        if (hipGetDevice(&dev) != hipSuccess || hipDeviceGetAttribute(&cus, hipDeviceAttributeMultiprocessorCount, dev) != hipSuccess) { grid = -1; return; }
        if (hipFuncSetAttribute((const void*)fwd_kernel, hipFuncAttributeMaxDynamicSharedMemorySize, LDS_BYTES) != hipSuccess) { fprintf(stderr, "kernel_launch: hipFuncSetAttribute failed\n"); grid = -1; return; }
        if (hipOccupancyMaxActiveBlocksPerMultiprocessor(&per_cu, (const void*)fwd_kernel, NTHR, LDS_BYTES) != hipSuccess || per_cu < 1) { fprintf(stderr, "kernel_launch: occupancy query says %d\n", per_cu); }
        (void)hipGetLastError();
        grid = cus;
    }
    if (grid < 0) return;
    (void)hipMemsetAsync(d_ws, 0, CTL_ZERO_BYTES, stream);
    KArgs a{};
    for (int i = 0; i < 27; ++i) a.in[i] = d_in[i];
    a.out = (float*)d_out; a.ws = (unsigned char*)d_ws; a.ph_lo = 0; a.ph_hi = N_PHASES;
    hipLaunchKernelGGL(fwd_kernel, dim3(grid), dim3(NTHR), LDS_BYTES, stream, a);
#if defined(PROBE_LO)
    (void)hipMemsetAsync((char*)d_ws + CW_BAR * 4, 0, XCD_BAR_WORDS * 4, stream); (void)hipMemsetAsync((char*)d_ws + CW_QATT * 4, 0, 4096, stream);
    a.ph_lo = PROBE_LO; a.ph_hi = PROBE_HI;
#if defined(PROBE_FLAGS)
    a.flags = PROBE_FLAGS;
#endif
    hipLaunchKernelGGL(fwd_kernel, dim3(grid), dim3(NTHR), LDS_BYTES, stream, a);
#endif
}
```

```cpp
#include <hip/hip_runtime.h>
#include <cstdio>
#include <cstdint>
#include <cmath>
#define PROBE_MASK 0x0
namespace pg8 {
#define PG8_LAS __attribute__((address_space(3)))
typedef unsigned short bf16_t;
typedef short bf16x8 __attribute__((ext_vector_type(8)));
typedef float f32x4 __attribute__((ext_vector_type(4)));
typedef unsigned u32x4 __attribute__((ext_vector_type(4)));
constexpr int BM = 256, BK = 64, HALF = 128, HTB = HALF * BK * 2  , STAGE_BYTES = 8 * HTB, NXCD = 8, WGM = 4;

__host__ __device__ __forceinline__ int lds_byte(int r, int c) { const int st = (r >> 4) * 2 + (c >> 5), rr = r & 15, cc = c & 31, ob = rr * 64 + cc * 2; return st * 1024 + (ob ^ (((ob >> 9) & 1) << 5)); }
__host__ __device__ __forceinline__ void stage_rc(int b, int& R, int& C) { const int st = b / 1024, sb = b % 1024, swz = sb ^ (((sb >> 9) & 1) << 5); R = (st >> 1) * 16 + swz / 64; C = (st & 1) * 32 + (swz % 64) / 2; }
__host__ __device__ __forceinline__ int perm32(int rho) { const int n = rho >> 4, i = rho & 15; return 8 * (i >> 2) + 4 * n + (i & 3); }

struct Unit { int pm, pn; };
struct Gemm { const bf16_t* A; const bf16_t* Bt; int M, N, K; };

struct StaticOrder {
    int nM, nN, nwg, G, c, hot;
    __host__ __device__ void init(int M, int N, int G_, int c_, int hot_ = 0) { nM = M / BM; nN = N / BM; nwg = nM * nN; G = G_; c = c_; hot = hot_; }
    __host__ __device__ bool next(int i, Unit& u) const {
        const long L = (long)i * G + c; if (L >= nwg) return false;
        int wgid = (int)L; { const int q = nwg / NXCD, r = nwg % NXCD, xcd = wgid % NXCD, off = wgid / NXCD; wgid = (xcd < r ? xcd * (q + 1) : r * (q + 1) + (xcd - r) * q) + off; }
        const int nig = WGM * nN, gid = wgid / nig, fm = gid * WGM, gsz = (nM - fm) < WGM ? (nM - fm) : WGM;
        u.pm = fm + ((wgid % nig) % gsz); u.pn = (wgid % nig) / gsz; if (hot) { u.pm &= 3; u.pn = 0; } return true;
    }
    __device__ __forceinline__ void a_ready(const Unit&) const {}
    __device__ __forceinline__ void done(const Unit&) const {}
};

struct MoeOrder {
    int nM, nN, nwg, G, c, tile0; const int* tile_expert;
    int H, R, mode;
    __device__ void init(int ntiles, int npn, int G_, int c_, int tile0_, const int* te, int H_ = 0, int R_ = 0, int mode_ = 1) { nM = ntiles; nN = npn; nwg = nM * nN; G = G_; c = c_; tile0 = tile0_; tile_expert = te; H = H_; R = R_; mode = mode_; }
    __device__ static __forceinline__ void plan(int nu, int H, int G, int ucost, int extra, int& mode, int& R) {
        mode = 1; R = 0; if (H <= 0 || H >= G) return;
        const int rmax = (nu + (G - H) - 1) / (G - H); int best = 0x7fffffff;
        for (int r2 = 0; r2 <= rmax; ++r2) { const int rest = nu - r2 * (G - H) > 0 ? nu - r2 * (G - H) : 0;
            { const int light = ucost * r2, heavy = extra + ucost * ((rest + H - 1) / H); const int mk = light > heavy ? light : heavy; if (mk < best) { best = mk; mode = 1; R = r2; } }
            { const int sh = (rest + G - 1) / G; const int light = ucost * (r2 + sh), heavy = extra + ucost * sh; const int mk = light > heavy ? light : heavy; if (mk < best) { best = mk; mode = 2; R = r2; } } }
    }
    __device__ bool next(int i, Unit& u) const {
        long L;
        if (H == 0) L = (long)i * G + c;
        else if (c >= H) { if (i < R) L = (long)i * (G - H) + (c - H); else if (mode == 2) L = (long)R * (G - H) + (long)(i - R) * G + c; else return false; }
        else L = (long)R * (G - H) + (long)i * (mode == 2 ? G : H) + c;
        if (L >= nwg) return false;
        int wgid = (int)L; { const int q = nwg / NXCD, r = nwg % NXCD, xcd = wgid % NXCD, off = wgid / NXCD; wgid = (xcd < r ? xcd * (q + 1) : r * (q + 1) + (xcd - r) * q) + off; }
        const int nig = WGM * nN, gid = wgid / nig, fm = gid * WGM, gsz = (nM - fm) < WGM ? (nM - fm) : WGM;
        u.pm = fm + ((wgid % nig) % gsz); const int pnl = (wgid % nig) / gsz;
        const int e = __builtin_amdgcn_readfirstlane(tile_expert[tile0 + u.pm]);
        u.pn = e * nN + pnl; return true;
    }
    __device__ __forceinline__ void a_ready(const Unit&) const {}
    __device__ __forceinline__ void done(const Unit&) const {}
};

__device__ __forceinline__ unsigned cvt_pk_bf16(float lo, float hi) { unsigned r; asm volatile("v_cvt_pk_bf16_f32 %0, %1, %2" : "=v"(r) : "v"(lo), "v"(hi)); return r; }
__device__ __forceinline__ u32x4 pack8(const f32x4& a, const f32x4& b) { u32x4 w; w.x = cvt_pk_bf16(a[0], a[1]); w.y = cvt_pk_bf16(a[2], a[3]); w.z = cvt_pk_bf16(b[0], b[1]); w.w = cvt_pk_bf16(b[2], b[3]); return w; }
__device__ __forceinline__ unsigned pk4_fp8(float a, float b, float c, float d) { int w = __builtin_amdgcn_cvt_pk_fp8_f32(a, b, 0, false); w = __builtin_amdgcn_cvt_pk_fp8_f32(c, d, w, true); return (unsigned)w; }
constexpr float RMS_EPS = 1e-6f;
constexpr float LOG2E = 1.4426950408889634f;
constexpr float C2 = 0.125f * LOG2E;
__device__ __forceinline__ float row_ss(const float* ss, int nparts, int row) {
    if (nparts == 1) return ss[row];
    const f32x4* p = (const f32x4*)(ss + (size_t)row * 16); f32x4 a = p[0], b = p[1], c = p[2], d = p[3]; a = (a + b) + (c + d); return (a[0] + a[1]) + (a[2] + a[3]);
}

struct EpiProj {
    static constexpr bool PERM = true, AFTER_DRAIN = false;
    bf16_t* O; int ldc; const float* ss; int nparts; const float* gq; const float* gk; const float* rope; int layer; float pre;
    __device__ __forceinline__ void operator()(const f32x4 (&acc)[2][2][4][2], const Unit& u, int wr, int wc, int fr, int fq) const {
        const int pn = u.pn; int kind = 0; float scale = 1.f; bool rope_on = false;
        if (layer == 0) { const int t = pn >> 1; if (t == 0) scale = C2; else if (t == 3) { kind = 1; scale = C2; rope_on = true; } else if (t == 4) { kind = 2; rope_on = true; } }
        else { const int t = pn >> 2; if (t == 0) { kind = 1; scale = C2; } else if (t == 1) kind = 2; }
        const float* gv = (kind == 1) ? gq : gk;
        f32x4 g[2][2];
#pragma unroll
        for (int bj = 0; bj < 2; ++bj)
#pragma unroll
            for (int n = 0; n < 2; ++n) g[bj][n] = kind ? *(const f32x4*)(gv + 32 * bj + 8 * fq + 4 * n) : (f32x4){1.f, 1.f, 1.f, 1.f};
        const int row0 = u.pm * BM + wr * 64 + fr, col0 = pn * BM + wc * 64 + 8 * fq;
#pragma unroll
        for (int ai = 0; ai < 2; ++ai)
#pragma unroll
            for (int m = 0; m < 4; ++m) {
                const int row = row0 + ai * HALF + m * 16;
                const float r = rsqrtf(row_ss(ss, nparts, row) * (1.f / 1024.f) + RMS_EPS) * pre;
                f32x4 v[2][2]; float s = 0.f;
#pragma unroll
                for (int bj = 0; bj < 2; ++bj)
#pragma unroll
                    for (int n = 0; n < 2; ++n) { v[bj][n] = acc[ai][bj][m][n] * r; const f32x4 x = v[bj][n]; s += (x[0] * x[0] + x[1] * x[1]) + (x[2] * x[2] + x[3] * x[3]); }
                if (kind) {
                    s += __shfl_xor(s, 16); s += __shfl_xor(s, 32);
                    const float rs = rsqrtf(s * (1.f / 64.f) + RMS_EPS);
#pragma unroll
                    for (int bj = 0; bj < 2; ++bj)
#pragma unroll
                        for (int n = 0; n < 2; ++n) v[bj][n] = v[bj][n] * rs * g[bj][n];
                    if (rope_on) {
                        f32x4 p[2];
#pragma unroll
                        for (int n = 0; n < 2; ++n)
#pragma unroll
                            for (int j = 0; j < 4; ++j) p[n][j] = __shfl_xor(v[0][n][j], 16);
                        const f32x4 c0 = *(const f32x4*)(rope + (size_t)row * 16), c1 = *(const f32x4*)(rope + (size_t)row * 16 + 4);
                        const f32x4 s0 = *(const f32x4*)(rope + (size_t)row * 16 + 8), s1 = *(const f32x4*)(rope + (size_t)row * 16 + 12);
                        if (fq == 0) { v[0][0] = v[0][0] * c0 - p[0] * s0; v[0][1] = v[0][1] * c1 - p[1] * s1; }
                        else if (fq == 1) { v[0][0] = v[0][0] * c0 + p[0] * s0; v[0][1] = v[0][1] * c1 + p[1] * s1; }
                    }
                }
                bf16_t* rowp = O + ((size_t)(pn * 4 + wc) * ldc + row) * 64 + 8 * fq;
#pragma unroll
                for (int bj = 0; bj < 2; ++bj) *(u32x4*)(rowp + 32 * bj) = pack8(v[bj][0] * scale, v[bj][1] * scale);
            }
    }
};

struct EpiResid {
    static constexpr bool PERM = true, AFTER_DRAIN = false;
    const float* base; float* out; bf16_t* xb; float* ss; float pre; unsigned char* x8;
    __device__ __forceinline__ void operator()(const f32x4 (&acc)[2][2][4][2], const Unit& u, int wr, int wc, int fr, int fq) const {
        const int row0 = u.pm * BM + wr * 64 + fr, col0 = u.pn * BM + wc * 32 + 8 * fq;
#pragma unroll
        for (int ai = 0; ai < 2; ++ai)
#pragma unroll
            for (int m = 0; m < 4; ++m) {
                const int row = row0 + ai * HALF + m * 16; float s = 0.f;
#pragma unroll
                for (int bj = 0; bj < 2; ++bj) {
                    const size_t off = (size_t)row * 1024 + col0 + bj * HALF;
                    const f32x4 v0 = acc[ai][bj][m][0] * pre + *(const f32x4*)(base + off), v1 = acc[ai][bj][m][1] * pre + *(const f32x4*)(base + off + 4);
                    *(f32x4*)(out + off) = v0; *(f32x4*)(out + off + 4) = v1;
                    if (xb) *(u32x4*)(xb + off) = pack8(v0, v1);
                    if (x8) { typedef unsigned u32x2 __attribute__((ext_vector_type(2))); u32x2 w8; w8.x = pk4_fp8(v0[0], v0[1], v0[2], v0[3]); w8.y = pk4_fp8(v1[0], v1[1], v1[2], v1[3]); *(u32x2*)(x8 + off) = w8; }
                    s += (v0[0] * v0[0] + v0[1] * v0[1]) + (v0[2] * v0[2] + v0[3] * v0[3]) + (v1[0] * v1[0] + v1[1] * v1[1]) + (v1[2] * v1[2] + v1[3] * v1[3]);
                }
                if (ss) { s += __shfl_xor(s, 16); s += __shfl_xor(s, 32); if (fq == 0) ss[(size_t)row * 16 + u.pn * 4 + wc] = s; }
            }
    }
};

template <bool OUT8> struct EpiSwiglu {
    static constexpr bool PERM = true, AFTER_DRAIN = false;
    void* O; int ldc; const float* ss; int nparts; const int* rowtok; int tile0; int npn; float pre;
    __device__ __forceinline__ void operator()(const f32x4 (&acc)[2][2][4][2], const Unit& u, int wr, int wc, int fr, int fq) const {
        const int pnl = u.pn % npn; const int row0 = u.pm * BM + wr * 64 + fr, col0 = pnl * HALF + wc * 32 + 8 * fq;
#pragma unroll
        for (int ai = 0; ai < 2; ++ai)
#pragma unroll
            for (int m = 0; m < 4; ++m) {
                const int row = row0 + ai * HALF + m * 16;
                int tok = row; if (rowtok) tok = rowtok[tile0 * BM + row];
                const float r = (tok >= 0) ? rsqrtf(row_ss(ss, nparts, tok >= 0 ? tok : 0) * (1.f / 1024.f) + RMS_EPS) * pre : 0.f;
                f32x4 a[2]; const float rl = -r * LOG2E, r2 = r * r;
#pragma unroll
                for (int n = 0; n < 2; ++n) { const f32x4 gq = acc[ai][0][m][n], t = gq * rl; f32x4 d;
#pragma unroll
                    for (int j = 0; j < 4; ++j) d[j] = __builtin_amdgcn_rcpf(1.f + __builtin_amdgcn_exp2f(t[j]));
                    a[n] = ((gq * acc[ai][1][m][n]) * r2) * d; }
                if constexpr (OUT8) { typedef unsigned u32x2 __attribute__((ext_vector_type(2))); u32x2 w; w.x = pk4_fp8(a[0][0], a[0][1], a[0][2], a[0][3]); w.y = pk4_fp8(a[1][0], a[1][1], a[1][2], a[1][3]); *(u32x2*)((unsigned char*)O + (size_t)row * ldc + col0) = w; }
                else *(u32x4*)((bf16_t*)O + (size_t)row * ldc + col0) = pack8(a[0], a[1]);
            }
    }
};

struct EpiMoeDown {
    static constexpr bool PERM = true, AFTER_DRAIN = false;
    float* out; const int* rowtok; const float* rowgate; int tile0; float pre; int nostore;
    __device__ __forceinline__ void operator()(const f32x4 (&acc)[2][2][4][2], const Unit& u, int wr, int wc, int fr, int fq) const {
        const int pnl = u.pn & 3; const int row0 = (tile0 + u.pm) * BM + wr * 64 + fr, col0 = pnl * BM + wc * 32 + 8 * fq;
#pragma unroll
        for (int ai = 0; ai < 2; ++ai)
#pragma unroll
            for (int m = 0; m < 4; ++m) {
                const int srow = row0 + ai * HALF + m * 16; const int tok = nostore ? -1 : rowtok[srow];
                if (tok >= 0) { const float gt = rowgate[srow] * pre;
#pragma unroll
                    for (int bj = 0; bj < 2; ++bj)
#pragma unroll
                        for (int n = 0; n < 2; ++n) { f32x4* p = (f32x4*)(out + (size_t)tok * 1024 + col0 + bj * HALF + 4 * n); *p = *p + acc[ai][bj][m][n] * gt; } }
            }
    }
};

typedef int i32x4 __attribute__((ext_vector_type(4)));
typedef int i32x8 __attribute__((ext_vector_type(8)));
template <class Epi, class Sched, bool ALIGN_EPI = false, bool SP2 = false, bool F8 = false>
__device__ __forceinline__ void gemm_phase(PG8_LAS unsigned char* lds, const Gemm g, const Sched& S, const Epi& E) {
    const int tid = threadIdx.x, wid = __builtin_amdgcn_readfirstlane(tid >> 6), lane = tid & 63, wr = wid >> 2, wc = wid & 3, fr = lane & 15, fq = lane >> 4;
    const int K = g.K, nt = K / BK;
    unsigned voffA[2], voffB[2];
#pragma unroll
    for (int i = 0; i < 2; ++i) { int R, C; stage_rc(tid * 16 + i * 8192, R, C); const int Rb = Epi::PERM ? ((R & ~31) + perm32(R & 31)) : R;
        voffA[i] = (unsigned)(R * K + C) * 2u; voffB[i] = (unsigned)(Rb * K + C) * 2u; }
    const size_t kstep = (size_t)(BK * 2);
    const size_t hstep = (size_t)HALF * K * 2;
    const size_t tstep = 2 * hstep;
    const unsigned ldsw = (unsigned)wid * 1024u;
    const int aoff = lds_byte(wr * 64 + fr, fq * 8), boff = lds_byte(wc * 32 + fr, fq * 8);
#define PG8_SA(b, h) (((b) * 2 + (h)) * HTB)
#define PG8_SB(b, h) ((4 + (b) * 2 + (h)) * HTB)
#define PG8_STAGE(bufoff, gbase, voff) do { _Pragma("unroll") for (int _i = 0; _i < 2; ++_i) \
        __builtin_amdgcn_global_load_lds((const unsigned*)((const char*)(gbase) + (voff)[_i]), (PG8_LAS unsigned*)(lds + (bufoff) + ldsw + _i * 8192), 16, 0, 0); } while (0)
#define PG8_LDA(dst, b, h) do { if constexpr (F8) { _Pragma("unroll") for (int m = 0; m < 4; ++m) dst##8[m] = PG8_CAT(*(const PG8_LAS bf16x8*)(lds + PG8_SA(b, h) + aoff + m * 2048), *(const PG8_LAS bf16x8*)(lds + PG8_SA(b, h) + aoff + m * 2048 + 1024)); } \
        else { _Pragma("unroll") for (int m = 0; m < 4; ++m) _Pragma("unroll") for (int k = 0; k < 2; ++k) dst[m][k] = *(const PG8_LAS bf16x8*)(lds + PG8_SA(b, h) + aoff + m * 2048 + k * 1024); } } while (0)
#define PG8_LDB(dst, b, h) do { if constexpr (F8) { _Pragma("unroll") for (int n = 0; n < 2; ++n) dst##8[n] = PG8_CAT(*(const PG8_LAS bf16x8*)(lds + PG8_SB(b, h) + boff + n * 2048), *(const PG8_LAS bf16x8*)(lds + PG8_SB(b, h) + boff + n * 2048 + 1024)); } \
        else { _Pragma("unroll") for (int n = 0; n < 2; ++n) _Pragma("unroll") for (int k = 0; k < 2; ++k) dst[n][k] = *(const PG8_LAS bf16x8*)(lds + PG8_SB(b, h) + boff + n * 2048 + k * 1024); } } while (0)
#define PG8_CAT(x, y) __builtin_shufflevector(__builtin_bit_cast(i32x4, (x)), __builtin_bit_cast(i32x4, (y)), 0, 1, 2, 3, 4, 5, 6, 7)
#define PG8_MMA(ai, bj, At, Bt) do { __builtin_amdgcn_s_setprio(1); _Pragma("unroll") for (int m = 0; m < 4; ++m) _Pragma("unroll") for (int n = 0; n < 2; ++n) { \
        if constexpr (F8) { asm volatile("v_mfma_f32_16x16x128_f8f6f4 %0, %1, %2, %0" : "+v"(acc[ai][bj][m][n]) : "v"(Bt##8[n]), "v"(At##8[m])); } \
        else { _Pragma("unroll") for (int k = 0; k < 2; ++k) acc[ai][bj][m][n] = __builtin_amdgcn_mfma_f32_16x16x32_bf16(Bt[n][k], At[m][k], acc[ai][bj][m][n], 0, 0, 0); } } __builtin_amdgcn_s_setprio(0); } while (0)
#define PG8_WAIT_V(n) asm volatile("s_waitcnt vmcnt(" #n ")" ::: "memory")
#define PG8_WAIT_L(n) asm volatile("s_waitcnt lgkmcnt(" #n ")" ::: "memory")
#define PG8_BAR __builtin_amdgcn_s_barrier()
#define PG8_SCHED __builtin_amdgcn_sched_barrier(0)
    Unit cur, nxt; int ui = 0;
    if (!S.next(0, cur)) return;
    f32x4 acc[2][2][4][2];
#pragma unroll
    for (int a = 0; a < 2; ++a)
#pragma unroll
        for (int b = 0; b < 2; ++b)
#pragma unroll
            for (int m = 0; m < 4; ++m)
#pragma unroll
                for (int n = 0; n < 2; ++n) acc[a][b][m][n] = (f32x4){0.f, 0.f, 0.f, 0.f};
    bf16x8 At[4][2], B0[2][2], B1[2][2];
    i32x8 At8[4], B08[2], B18[2];
    const char* cA = (const char*)g.A + (size_t)cur.pm * tstep; const char* cB = (const char*)g.Bt + (size_t)cur.pn * tstep;
    S.a_ready(cur);
    if constexpr (SP2) {
        PG8_STAGE(PG8_SB(0, 0), cB, voffB); PG8_STAGE(PG8_SB(0, 1), cB + hstep, voffB); PG8_STAGE(PG8_SA(0, 0), cA, voffA); PG8_STAGE(PG8_SA(0, 1), cA + hstep, voffA);
        if (wr == 1) PG8_BAR;
        PG8_WAIT_V(2); PG8_BAR;
        PG8_STAGE(PG8_SB(1, 0), cB + kstep, voffB); PG8_STAGE(PG8_SA(1, 0), cA + kstep, voffA); PG8_STAGE(PG8_SB(1, 1), cB + hstep + kstep, voffB);
        PG8_WAIT_V(6); PG8_BAR;
    } else {
        PG8_STAGE(PG8_SB(0, 0), cB, voffB); PG8_STAGE(PG8_SA(0, 0), cA, voffA); PG8_STAGE(PG8_SB(0, 1), cB + hstep, voffB); PG8_STAGE(PG8_SA(0, 1), cA + hstep, voffA);
        if (wr == 1) PG8_BAR;
        PG8_WAIT_V(4); PG8_BAR;
        PG8_STAGE(PG8_SB(1, 0), cB + kstep, voffB); PG8_STAGE(PG8_SA(1, 0), cA + kstep, voffA); PG8_STAGE(PG8_SB(1, 1), cB + hstep + kstep, voffB);
        PG8_WAIT_V(6); PG8_BAR;
    }
    for (;;) {
        const bool has_next = S.next(ui + 1, nxt);
        const char* nA = has_next ? (const char*)g.A + (size_t)nxt.pm * tstep : cA; const char* nB = has_next ? (const char*)g.Bt + (size_t)nxt.pn * tstep : cB;
#pragma nounroll
        for (int t = 0; t < nt; t += 2) {
            const bool last = (t == nt - 2);
            const char* a1 = cA + (size_t)(t + 1) * kstep;
            const char* a2 = last ? nA : cA + (size_t)(t + 2) * kstep; const char* b2 = last ? nB : cB + (size_t)(t + 2) * kstep;
            const char* a3 = a2 + kstep; const char* b3 = b2 + kstep;
            if (last && has_next) S.a_ready(nxt);
            if constexpr (SP2) {
            PG8_LDB(B0, 0, 0); PG8_LDB(B1, 0, 1); PG8_SCHED; PG8_LDA(At, 0, 0); PG8_STAGE(PG8_SA(1, 1), a1 + hstep, voffA);
            PG8_WAIT_V(8); PG8_WAIT_L(0); PG8_BAR; PG8_MMA(0, 0, At, B0); PG8_MMA(0, 1, At, B1); PG8_BAR; PG8_SCHED;
            PG8_LDA(At, 0, 1); PG8_STAGE(PG8_SB(0, 0), b2, voffB); PG8_STAGE(PG8_SB(0, 1), b2 + hstep, voffB); PG8_STAGE(PG8_SA(0, 0), a2, voffA);
            PG8_WAIT_V(8); PG8_WAIT_L(0); PG8_BAR; PG8_MMA(1, 0, At, B0); PG8_MMA(1, 1, At, B1); PG8_BAR; PG8_SCHED;
            PG8_LDB(B0, 1, 0); PG8_LDB(B1, 1, 1); PG8_SCHED; PG8_LDA(At, 1, 0); PG8_STAGE(PG8_SA(0, 1), a2 + hstep, voffA);
            PG8_WAIT_V(8); PG8_WAIT_L(0); PG8_BAR; PG8_MMA(0, 0, At, B0); PG8_MMA(0, 1, At, B1); PG8_BAR; PG8_SCHED;
            PG8_LDA(At, 1, 1); PG8_STAGE(PG8_SB(1, 0), b3, voffB); PG8_STAGE(PG8_SB(1, 1), b3 + hstep, voffB); PG8_STAGE(PG8_SA(1, 0), a3, voffA);
            PG8_WAIT_V(8); PG8_WAIT_L(0); PG8_BAR; PG8_MMA(1, 0, At, B0); PG8_MMA(1, 1, At, B1); PG8_BAR; PG8_SCHED;
            } else {
            PG8_LDB(B0, 0, 0); PG8_SCHED; PG8_LDA(At, 0, 0); PG8_STAGE(PG8_SA(1, 1), a1 + hstep, voffA);
            PG8_WAIT_L(8); PG8_BAR; PG8_WAIT_L(0); PG8_MMA(0, 0, At, B0); PG8_BAR; PG8_SCHED;
            PG8_LDB(B1, 0, 1); PG8_STAGE(PG8_SB(0, 0), b2, voffB);
            PG8_BAR; PG8_WAIT_L(0); PG8_MMA(0, 1, At, B1); PG8_BAR;
            PG8_LDA(At, 0, 1); PG8_STAGE(PG8_SA(0, 0), a2, voffA);
            PG8_BAR; PG8_WAIT_L(0); PG8_MMA(1, 0, At, B0); PG8_BAR; PG8_SCHED;
            PG8_STAGE(PG8_SB(0, 1), b2 + hstep, voffB);
            PG8_WAIT_V(6); PG8_BAR; PG8_MMA(1, 1, At, B1); PG8_BAR;
            PG8_LDB(B0, 1, 0); PG8_SCHED; PG8_LDA(At, 1, 0); PG8_STAGE(PG8_SA(0, 1), a2 + hstep, voffA);
            PG8_WAIT_L(8); PG8_BAR; PG8_WAIT_L(0); PG8_MMA(0, 0, At, B0); PG8_BAR; PG8_SCHED;
            PG8_LDB(B1, 1, 1); PG8_STAGE(PG8_SB(1, 0), b3, voffB);
            PG8_BAR; PG8_WAIT_L(0); PG8_MMA(0, 1, At, B1); PG8_BAR;
            PG8_LDA(At, 1, 1); PG8_STAGE(PG8_SA(1, 0), a3, voffA);
            PG8_BAR; PG8_WAIT_L(0); PG8_MMA(1, 0, At, B0); PG8_BAR; PG8_SCHED;
            PG8_STAGE(PG8_SB(1, 1), b3 + hstep, voffB);
            PG8_WAIT_V(6); PG8_BAR; PG8_MMA(1, 1, At, B1); PG8_BAR;
            }
        }
        if constexpr (F8) asm volatile("s_nop 15\n\ts_nop 15\n\ts_nop 15" ::: "memory");
        if constexpr (ALIGN_EPI) { if (wr == 0) PG8_BAR; }
        if constexpr (!Epi::AFTER_DRAIN) { E(acc, cur, wr, wc, fr, fq); S.done(cur); }
        if (!has_next) break;
#pragma unroll
        for (int a = 0; a < 2; ++a)
#pragma unroll
            for (int b = 0; b < 2; ++b)
#pragma unroll
                for (int m = 0; m < 4; ++m)
#pragma unroll
                    for (int n = 0; n < 2; ++n) acc[a][b][m][n] = (f32x4){0.f, 0.f, 0.f, 0.f};
        cur = nxt; cA = nA; cB = nB; ++ui;
        if constexpr (ALIGN_EPI) { if (wr == 1) PG8_BAR; }
    }
    PG8_WAIT_V(0);
    if constexpr (!ALIGN_EPI) { if (wr == 0) PG8_BAR; }
    PG8_BAR;
    if constexpr (Epi::AFTER_DRAIN) { E.fused(acc, cur, wr, wc, fr, fq, lds, wid, lane); S.done(cur); }
#undef PG8_SA
#undef PG8_SB
#undef PG8_STAGE
#undef PG8_LDA
#undef PG8_LDB
#undef PG8_MMA
#undef PG8_CAT
#undef PG8_WAIT_V
#undef PG8_WAIT_L
#undef PG8_BAR
#undef PG8_SCHED
}
}

namespace att {
using pg8::bf16_t; using pg8::bf16x8; using pg8::u32x4;
typedef float f32x16 __attribute__((ext_vector_type(16)));
typedef short s16x4 __attribute__((ext_vector_type(4)));
typedef float f32x2_t __attribute__((ext_vector_type(2))); typedef __bf16 bf16x2_t __attribute__((ext_vector_type(2)));
#define ALAS __attribute__((address_space(3)))
typedef ALAS const char* lds_cptr;
constexpr int SEQ = 8192, PITCH = 64, VNEXT = 2 * SEQ * 64;
constexpr int KVSLOT = 24576;
constexpr int L_WS = 114688, L_TAB = L_WS + 2048, L_FLAG = L_TAB + 1056, L_END = L_FLAG + 128, L_OST = 0;
constexpr float SB_THR = 152.f;
__device__ __forceinline__ int crow(int r, int hi) { return (r & 3) + 8 * (r >> 2) + 4 * hi; }
__device__ __forceinline__ void glds16(const void* gsrc, unsigned lds_dst) { unsigned keep;
    asm volatile("s_mov_b32 %0, m0\n\ts_mov_b32 m0, %2\n\ts_nop 0\n\tglobal_load_lds_dwordx4 %1, off\n\ts_mov_b32 m0, %0" : "=&s"(keep) : "v"(gsrc), "s"(lds_dst) : "memory"); }
__device__ __forceinline__ unsigned cvtpk(float lo, float hi) { f32x2_t v = {lo, hi}; bf16x2_t b = __builtin_convertvector(v, bf16x2_t); return __builtin_bit_cast(unsigned, b); }
__device__ __forceinline__ unsigned short f2bf(float f) { unsigned u = __builtin_bit_cast(unsigned, f); return (unsigned short)((u + 0x7fffu + ((u >> 16) & 1u)) >> 16); }
#define MFMA32(a, b, c) __builtin_amdgcn_mfma_f32_32x32x16_bf16((a), (b), (c), 0, 0, 0)

__device__ __forceinline__ void qkt(f32x16& p0, f32x16& p1, lds_cptr kb, const bf16x8* qr, const f32x16& cin) {
#pragma unroll
    for (int d0 = 0; d0 < 4; ++d0) {
        const bf16x8 b0 = *(const ALAS bf16x8*)(kb + d0 * 2048);
        const bf16x8 b1 = *(const ALAS bf16x8*)(kb + d0 * 2048 + 512);
        if (d0 == 0) { p0 = MFMA32(b0, qr[0], cin); p1 = MFMA32(b1, qr[0], cin); }
        else { p0 = MFMA32(b0, qr[d0], p0); p1 = MFMA32(b1, qr[d0], p1); }
    }
}

__device__ __forceinline__ void qkt_sw(f32x16& p0, f32x16& p1, lds_cptr ks, const int (&kofs)[4], const bf16x8* qr, const f32x16& cin) {
    bf16x8 kf[8];
#pragma unroll
    for (int d0 = 0; d0 < 4; ++d0) { kf[2 * d0] = *(const ALAS bf16x8*)(ks + kofs[d0]); kf[2 * d0 + 1] = *(const ALAS bf16x8*)(ks + kofs[d0] + 4096); }
    p0 = MFMA32(kf[0], qr[0], cin); p1 = MFMA32(kf[1], qr[0], cin);
#pragma unroll
    for (int d0 = 1; d0 < 4; ++d0) { p0 = MFMA32(kf[2 * d0], qr[d0], p0); p1 = MFMA32(kf[2 * d0 + 1], qr[d0], p1); }
}
template <int ND> __device__ __forceinline__ void pv(f32x16* o, int vb, bf16x8 pa0, bf16x8 pa1, bf16x8 pa2, bf16x8 pa3) {
#pragma unroll
    for (int d0 = 0; d0 < ND; ++d0) { s16x4 lo[4], hi[4];
#pragma unroll
        for (int ks = 0; ks < 4; ++ks) {
            asm volatile("ds_read_b64_tr_b16 %0,%1 offset:%c2" : "=&v"(lo[ks]) : "v"(vb), "i"(d0 * 4096 + ks * 1024) : "memory");
            asm volatile("ds_read_b64_tr_b16 %0,%1 offset:%c2" : "=&v"(hi[ks]) : "v"(vb), "i"(d0 * 4096 + ks * 1024 + 512) : "memory"); }
        asm volatile("s_waitcnt lgkmcnt(0)" ::: "memory"); __builtin_amdgcn_sched_barrier(0);
#define ATT_PK(k) (bf16x8){lo[k][0], lo[k][1], lo[k][2], lo[k][3], hi[k][0], hi[k][1], hi[k][2], hi[k][3]}
        o[d0] = MFMA32(pa0, ATT_PK(0), o[d0]);
        o[d0] = MFMA32(pa1, ATT_PK(1), o[d0]);
        o[d0] = MFMA32(pa2, ATT_PK(2), o[d0]);
        o[d0] = MFMA32(pa3, ATT_PK(3), o[d0]);
#undef ATT_PK
    }
}

template <int MODE, int VD, bool OUT8 = false, int TPB = 1>
__device__ __forceinline__ void attn_unit(ALAS char* shm, const bf16_t* Qb, const bf16_t* Kb, const bf16_t* Vb, void* Ob, int opitch, int q0, float mref2, const float* tab, float oscale = 1.f, int dbg = 0) {
    constexpr int ND = VD / 32, SLOT = 8192 + VD * 128;
    static_assert(2 * TPB * SLOT <= L_WS, "ring vs LDS map");
    const int tid = threadIdx.x, lane = tid & 63, r32 = lane & 31, hi = lane >> 5; const int wid = __builtin_amdgcn_readfirstlane(tid >> 6);
    const unsigned lds0 = (unsigned)(uintptr_t)shm;
    ALAS float* wsf = (ALAS float*)(shm + L_WS) + wid * 64;
    ALAS float* tabL = (ALAS float*)(shm + L_TAB);
    ALAS unsigned* flg = (ALAS unsigned*)(shm + L_FLAG);
    if (MODE == 1) { for (int i = tid; i < 257; i += 512) tabL[i] = tab[i] * pg8::LOG2E; }
    const bf16_t* Qw = Qb + (size_t)(q0 + wid * 32) * PITCH;
    bf16x8 qr[4];
#pragma unroll
    for (int d0 = 0; d0 < 4; ++d0) qr[d0] = *(const bf16x8*)(Qw + (size_t)r32 * PITCH + d0 * 16 + hi * 8);
    int t_first, n_t, t_step;
    if (MODE == 0) { t_first = 0; n_t = q0 / 64 + 4; t_step = 1; }
    else if (MODE == 1) { const int c0 = q0 / 64; t_first = c0 - 8 > 0 ? c0 - 8 : 0; n_t = c0 + 4 - t_first; t_step = 1; }
    else { t_first = q0 / 64 + 3; n_t = q0 / 64 + 4; t_step = -1; }
    const int krow = 8 * wid + (lane >> 3);
    const bf16_t* ksrc = Kb + (size_t)krow * PITCH + (((lane & 7) ^ ((krow >> 1) & 7)) * 8);
    int kofs[4];
#pragma unroll
    for (int d0 = 0; d0 < 4; ++d0) kofs[d0] = (r32 >> 3) * 1024 + ((r32 & 7) * 8 + ((2 * d0 + hi) ^ ((r32 >> 1) & 7))) * 16;
    const bf16_t* vsrc = Vb + (size_t)(16 * (wid & 3) + (lane >> 2)) * PITCH + (wid >> 2) * 32 + (lane & 3) * 8;
#define ATT_DMA(t, slot) do { if (dbg & 64) break; const size_t to_ = (size_t)(t) * 64 * PITCH; const unsigned sb_ = lds0 + (unsigned)(slot) * SLOT; \
        glds16(ksrc + to_, (unsigned)__builtin_amdgcn_readfirstlane(sb_ + wid * 1024)); \
        glds16(vsrc + to_, (unsigned)__builtin_amdgcn_readfirstlane(sb_ + 8192 + wid * 1024)); \
        if (VD == 128) glds16(vsrc + to_ + VNEXT, (unsigned)__builtin_amdgcn_readfirstlane(sb_ + 8192 + (wid + 8) * 1024)); } while (0)
    f32x16 o[ND];
#pragma unroll
    for (int d = 0; d < ND; ++d) o[d] = f32x16{};
    f32x16 cin;
#pragma unroll
    for (int r = 0; r < 16; ++r) cin[r] = (MODE == 2) ? 0.f : -mref2;
    float l_reg = 0.f, A = 0.f; bool wdone = false;
    const int wrow0 = q0 + wid * 32, qrow = wrow0 + r32;
    const int vb0 = (int)lds0 + 8192 + ((lane >> 4) & 1) * 32 + (lane & 3) * 8 + (4 * hi + ((lane & 15) >> 2)) * 64;
    asm volatile("s_waitcnt vmcnt(0)" ::: "memory"); asm volatile("" : "+v"(qr[0]), "+v"(qr[1]), "+v"(qr[2]), "+v"(qr[3]));
#pragma unroll
    for (int u = 0; u < TPB; ++u) ATT_DMA(t_first + u * t_step, u);
    for (int i = 0; i < n_t; ++i) {
        const int t = t_first + i * t_step, slot = i % (2 * TPB);
        if (i % TPB == 0) {
        asm volatile("s_waitcnt vmcnt(0) lgkmcnt(0)\n\ts_barrier" ::: "memory");
        if (MODE == 2 && i > 0) { const int par = ((i - 1) & 3) * 8; unsigned all = 1u;
#pragma unroll
            for (int w = 0; w < 8; ++w) all &= flg[par + w];
            if (__builtin_amdgcn_readfirstlane(all)) break; }
        if (i + TPB < n_t) {
#pragma unroll
            for (int u = 0; u < TPB; ++u) ATT_DMA(t + (TPB + u) * t_step, (i + TPB + u) % (2 * TPB)); }
        }
        bool active;
        if (MODE == 0) active = (64 * t <= wrow0);
        else if (MODE == 1) { const int cw = wrow0 / 64; active = (t >= cw - 8) && (t <= cw); }
        else active = !wdone && (64 * t < wrow0 + 31);
        if (active && !(dbg & 32)) {
            f32x16 p0, p1; qkt_sw(p0, p1, (lds_cptr)shm + slot * SLOT, kofs, qr, cin);
            if (MODE == 0) {
#pragma unroll
                for (int r = 0; r < 16; ++r) { p0[r] = __builtin_amdgcn_exp2f(p0[r]); p1[r] = __builtin_amdgcn_exp2f(p1[r]); }
            } else if (MODE == 1) {
                const int cw = wrow0 / 64;
                if (t <= cw - 3) { const float cb = tabL[256];
#pragma unroll
                    for (int r = 0; r < 16; ++r) { p0[r] = __builtin_amdgcn_exp2f(p0[r] + cb); p1[r] = __builtin_amdgcn_exp2f(p1[r] + cb); }
                } else { const int dq = qrow - 64 * t - 4 * hi;
#pragma unroll
                    for (int r = 0; r < 16; ++r) { int d0 = dq - ((r & 3) + 8 * (r >> 2)), d1 = d0 - 32;
                        d0 = d0 < -128 ? -128 : (d0 > 128 ? 128 : d0); d1 = d1 < -128 ? -128 : (d1 > 128 ? 128 : d1);
                        p0[r] = __builtin_amdgcn_exp2f(p0[r] + tabL[d0 + 128]); p1[r] = __builtin_amdgcn_exp2f(p1[r] + tabL[d1 + 128]); }
                }
            } else {
                const bool needmask = (64 * t + 63 >= wrow0);
                const int kq = qrow - 64 * t - 4 * hi;
                float g[8];
#pragma unroll
                for (int k = 0; k < 8; ++k) g[k] = 0.f;
                f32x16 s0, s1;
#pragma unroll
                for (int r = 0; r < 16; ++r) { const int kv = (r & 3) + 8 * (r >> 2);
                    { const float y = p0[r], a = __builtin_fabsf(y); float sp = __builtin_fmaxf(y, 0.f) + __builtin_amdgcn_logf(1.f + __builtin_amdgcn_exp2f(-a)); if (needmask && !(kv < kq)) sp = 0.f; s0[r] = sp; g[r >> 2] += sp; }
                    { const float y = p1[r], a = __builtin_fabsf(y); float sp = __builtin_fmaxf(y, 0.f) + __builtin_amdgcn_logf(1.f + __builtin_amdgcn_exp2f(-a)); if (needmask && !(kv + 32 < kq)) sp = 0.f; s1[r] = sp; g[4 + (r >> 2)] += sp; } }
                float pg[8];
#pragma unroll
                for (int k = 0; k < 8; ++k) pg[k] = __shfl_xor(g[k], 32);
                float base[8]; float own = 0.f, par = 0.f;
#pragma unroll
                for (int k = 7; k >= 0; --k) { const float par_incl = par + pg[k]; base[k] = A + own + (hi == 0 ? par_incl : par); own += g[k]; par = par_incl; }
                A += own + par;
#pragma unroll
                for (int k = 0; k < 4; ++k) {
                    { float c = base[k]; c += s0[4 * k + 3]; const float w3 = __builtin_amdgcn_exp2f(p0[4 * k + 3] - c); c += s0[4 * k + 2]; const float w2 = __builtin_amdgcn_exp2f(p0[4 * k + 2] - c);
                      c += s0[4 * k + 1]; const float w1 = __builtin_amdgcn_exp2f(p0[4 * k + 1] - c); c += s0[4 * k]; const float w0 = __builtin_amdgcn_exp2f(p0[4 * k] - c);
                      p0[4 * k] = w0; p0[4 * k + 1] = w1; p0[4 * k + 2] = w2; p0[4 * k + 3] = w3; }
                    { float c = base[4 + k]; c += s1[4 * k + 3]; const float w3 = __builtin_amdgcn_exp2f(p1[4 * k + 3] - c); c += s1[4 * k + 2]; const float w2 = __builtin_amdgcn_exp2f(p1[4 * k + 2] - c);
                      c += s1[4 * k + 1]; const float w1 = __builtin_amdgcn_exp2f(p1[4 * k + 1] - c); c += s1[4 * k]; const float w0 = __builtin_amdgcn_exp2f(p1[4 * k] - c);
                      p1[4 * k] = w0; p1[4 * k + 1] = w1; p1[4 * k + 2] = w2; p1[4 * k + 3] = w3; }
                }
                if (needmask) {
#pragma unroll
                    for (int r = 0; r < 16; ++r) { const int kv = (r & 3) + 8 * (r >> 2); if (!(kv < kq)) p0[r] = 0.f; if (!(kv + 32 < kq)) p1[r] = 0.f; }
                }
                wdone = __all(A >= SB_THR);
            }
            if (MODE != 2) { float s = 0.f;
#pragma unroll
                for (int r = 0; r < 16; ++r) s += p0[r] + p1[r];
                l_reg += s; }
            u32x4 pw0, pw1, pw2, pw3;
            pw0 = (u32x4){cvtpk(p0[0], p0[1]), cvtpk(p0[2], p0[3]), cvtpk(p0[4], p0[5]), cvtpk(p0[6], p0[7])};
            pw1 = (u32x4){cvtpk(p0[8], p0[9]), cvtpk(p0[10], p0[11]), cvtpk(p0[12], p0[13]), cvtpk(p0[14], p0[15])};
            pw2 = (u32x4){cvtpk(p1[0], p1[1]), cvtpk(p1[2], p1[3]), cvtpk(p1[4], p1[5]), cvtpk(p1[6], p1[7])};
            pw3 = (u32x4){cvtpk(p1[8], p1[9]), cvtpk(p1[10], p1[11]), cvtpk(p1[12], p1[13]), cvtpk(p1[14], p1[15])};
            pv<ND>(o, vb0 + slot * SLOT, __builtin_bit_cast(bf16x8, pw0), __builtin_bit_cast(bf16x8, pw1), __builtin_bit_cast(bf16x8, pw2), __builtin_bit_cast(bf16x8, pw3));
        }
        if (MODE == 2) { if (lane == 0) flg[(i & 3) * 8 + wid] = wdone ? 1u : 0u; }
    }
#undef ATT_DMA
    asm volatile("s_waitcnt vmcnt(0) lgkmcnt(0)\n\ts_barrier" ::: "memory");
    float rl[16];
    if (MODE != 2) {
        l_reg += __shfl_xor(l_reg, 32);
        if (hi == 0) wsf[32 + r32] = l_reg;
        asm volatile("s_waitcnt lgkmcnt(0)" ::: "memory");
#pragma unroll
        for (int r = 0; r < 16; ++r) rl[r] = __builtin_amdgcn_rcpf(wsf[32 + crow(r, hi)]) * oscale;
    } else {
#pragma unroll
        for (int r = 0; r < 16; ++r) rl[r] = oscale;
    }
    if constexpr (OUT8) {
        static_assert(!OUT8 || VD == 64, "fp8 output: 64-wide heads");
        unsigned char* Ow = (unsigned char*)Ob + (size_t)(q0 + wid * 32) * opitch;
        ALAS unsigned char* stg = (ALAS unsigned char*)(shm + L_OST) + wid * 2048;
#pragma unroll
        for (int r = 0; r < 16; ++r) { const int orow = crow(r, hi);
#pragma unroll
            for (int d0 = 0; d0 < 2; ++d0) { const float v = o[d0][r] * rl[r]; stg[orow * 64 + d0 * 32 + r32] = (unsigned char)(__builtin_amdgcn_cvt_pk_fp8_f32(v, v, 0, false) & 0xff); } }
        asm volatile("s_waitcnt lgkmcnt(0)" ::: "memory");
#pragma unroll
        for (int i = 0; i < 2; ++i) { const int row = i * 16 + (lane >> 2), ch = lane & 3; const u32x4 v = *(const ALAS u32x4*)(stg + row * 64 + ch * 16); *(u32x4*)(Ow + (size_t)row * opitch + ch * 16) = v; }
        asm volatile("s_waitcnt lgkmcnt(0)" ::: "memory");
    } else {
    bf16_t* Ow = (bf16_t*)Ob + (size_t)(q0 + wid * 32) * opitch;
    ALAS bf16_t* stg = (ALAS bf16_t*)(shm + L_OST) + wid * 2048;
#pragma unroll
    for (int half = 0; half < ND / 2; ++half) {
#pragma unroll
        for (int r = 0; r < 16; ++r) { const int orow = crow(r, hi);
#pragma unroll
            for (int d0 = 0; d0 < 2; ++d0) stg[orow * 64 + d0 * 32 + r32] = f2bf(o[half * 2 + d0][r] * rl[r]); }
        asm volatile("s_waitcnt lgkmcnt(0)" ::: "memory");
#pragma unroll
        for (int i = 0; i < 4; ++i) { const int row = i * 8 + (lane >> 3), ch = lane & 7; const u32x4 v = *(const ALAS u32x4*)(stg + row * 64 + ch * 8); *(u32x4*)(Ow + (size_t)row * opitch + half * 64 + ch * 8) = v; }
        asm volatile("s_waitcnt lgkmcnt(0)" ::: "memory");
    }
    }
    asm volatile("s_waitcnt vmcnt(0) lgkmcnt(0)\n\ts_barrier" ::: "memory");
}


__device__ __forceinline__ void qkt8(f32x16& p0, f32x16& p1, lds_cptr kb, const bf16x8* qr, const f32x16& cin) {
    bf16x8 kf[8];
#pragma unroll
    for (int d0 = 0; d0 < 4; ++d0) { kf[2 * d0] = *(const ALAS bf16x8*)(kb + d0 * 2048); kf[2 * d0 + 1] = *(const ALAS bf16x8*)(kb + d0 * 2048 + 512); }
    __builtin_amdgcn_sched_barrier(0);
    p0 = MFMA32(kf[0], qr[0], cin); p1 = MFMA32(kf[1], qr[0], cin);
#pragma unroll
    for (int d0 = 1; d0 < 4; ++d0) { p0 = MFMA32(kf[2 * d0], qr[d0], p0); p1 = MFMA32(kf[2 * d0 + 1], qr[d0], p1); }
}
template <int ND, int KS0> __device__ __forceinline__ void v_reads(s16x4 (&lo)[ND][2], s16x4 (&hi)[ND][2], int vb) {
#pragma unroll
    for (int ks = 0; ks < 2; ++ks)
#pragma unroll
        for (int d0 = 0; d0 < ND; ++d0) {
            asm volatile("ds_read_b64_tr_b16 %0,%1 offset:%c2" : "=&v"(lo[d0][ks]) : "v"(vb), "i"(d0 * 4096 + (KS0 + ks) * 1024) : "memory");
            asm volatile("ds_read_b64_tr_b16 %0,%1 offset:%c2" : "=&v"(hi[d0][ks]) : "v"(vb), "i"(d0 * 4096 + (KS0 + ks) * 1024 + 512) : "memory"); }
}
template <int ND> __device__ __forceinline__ void pv_half(f32x16* o, const s16x4 (&lo)[ND][2], const s16x4 (&hi)[ND][2], bf16x8 pa, bf16x8 pb) {
#define ATT_PK2(d, k) (bf16x8){lo[d][k][0], lo[d][k][1], lo[d][k][2], lo[d][k][3], hi[d][k][0], hi[d][k][1], hi[d][k][2], hi[d][k][3]}
#pragma unroll
    for (int d0 = 0; d0 < ND; ++d0) o[d0] = MFMA32(pa, ATT_PK2(d0, 0), o[d0]);
#pragma unroll
    for (int d0 = 0; d0 < ND; ++d0) o[d0] = MFMA32(pb, ATT_PK2(d0, 1), o[d0]);
#undef ATT_PK2
}
template <int MODE> __device__ __forceinline__ void p_half(f32x16& p, float& l_reg, u32x4& wa, u32x4& wb, bool const_bias, int dq, const ALAS float* tabL) {
    if (MODE == 0) {
#pragma unroll
        for (int r = 0; r < 16; ++r) p[r] = __builtin_amdgcn_exp2f(p[r]);
    } else if (const_bias) { const float cb = tabL[256];
#pragma unroll
        for (int r = 0; r < 16; ++r) p[r] = __builtin_amdgcn_exp2f(p[r] + cb);
    } else {
#pragma unroll
        for (int r = 0; r < 16; ++r) { int d = dq - ((r & 3) + 8 * (r >> 2)); d = d < -128 ? -128 : (d > 128 ? 128 : d); p[r] = __builtin_amdgcn_exp2f(p[r] + tabL[d + 128]); }
    }
    float s = 0.f;
#pragma unroll
    for (int r = 0; r < 16; ++r) s += p[r];
    l_reg += s;
    wa = (u32x4){cvtpk(p[0], p[1]), cvtpk(p[2], p[3]), cvtpk(p[4], p[5]), cvtpk(p[6], p[7])};
    wb = (u32x4){cvtpk(p[8], p[9]), cvtpk(p[10], p[11]), cvtpk(p[12], p[13]), cvtpk(p[14], p[15])};
}
__device__ __forceinline__ void vm_wait_n(int n) {
    if (n <= 0) asm volatile("s_waitcnt vmcnt(0)" ::: "memory"); else if (n == 1) asm volatile("s_waitcnt vmcnt(1)" ::: "memory"); else if (n == 2) asm volatile("s_waitcnt vmcnt(2)" ::: "memory");
    else if (n == 3) asm volatile("s_waitcnt vmcnt(3)" ::: "memory"); else if (n == 4) asm volatile("s_waitcnt vmcnt(4)" ::: "memory"); else if (n == 5) asm volatile("s_waitcnt vmcnt(5)" ::: "memory");
    else if (n == 6) asm volatile("s_waitcnt vmcnt(6)" ::: "memory"); else if (n == 7) asm volatile("s_waitcnt vmcnt(7)" ::: "memory"); else if (n == 8) asm volatile("s_waitcnt vmcnt(8)" ::: "memory");
    else if (n == 9) asm volatile("s_waitcnt vmcnt(9)" ::: "memory"); else if (n == 10) asm volatile("s_waitcnt vmcnt(10)" ::: "memory"); else asm volatile("s_waitcnt vmcnt(11)" ::: "memory");
}
template <int MODE, int VD, bool OUT8 = false, int PD = 3>
__device__ __forceinline__ void attn_unit_pp(ALAS char* shm, const bf16_t* Qb, const bf16_t* Kb, const bf16_t* Vb, void* Ob, int opitch, int q0, float mref2, const float* tab, float oscale = 1.f, int dbg = 0) {
    static_assert(MODE == 0 || MODE == 1, "ping-pong loop: softmax modes only");
    constexpr int ND = VD / 32, NV = VD / 64, NS = PD + 1, PER = 1 + NV, SLOT = 8192 + VD * 128;
    static_assert(NS * SLOT <= L_WS, "ring vs LDS map");
    const int tid = threadIdx.x, lane = tid & 63, r32 = lane & 31, hi = lane >> 5; const int wid = __builtin_amdgcn_readfirstlane(tid >> 6); const int grp = wid >> 2;
    const unsigned lds0 = (unsigned)(uintptr_t)shm;
    ALAS float* wsf = (ALAS float*)(shm + L_WS) + wid * 64;
    ALAS float* tabL = (ALAS float*)(shm + L_TAB);
    if (MODE == 1) { for (int i = tid; i < 257; i += 512) tabL[i] = tab[i] * pg8::LOG2E; }
    const bf16_t* Qw = Qb + (size_t)(q0 + wid * 32) * PITCH;
    bf16x8 qr[4];
#pragma unroll
    for (int d0 = 0; d0 < 4; ++d0) qr[d0] = *(const bf16x8*)(Qw + (size_t)r32 * PITCH + d0 * 16 + hi * 8);
    int t_first, n_t;
    if (MODE == 0) { t_first = 0; n_t = q0 / 64 + 4; }
    else { const int c0 = q0 / 64; t_first = c0 - 8 > 0 ? c0 - 8 : 0; n_t = c0 + 4 - t_first; }
    const bf16_t* ksrc = Kb + (size_t)lane * PITCH + wid * 8 + (size_t)t_first * 64 * PITCH;
    const bf16_t* vsrc = Vb + (size_t)(16 * (wid & 3) + (lane >> 2)) * PITCH + (wid >> 2) * 32 + (lane & 3) * 8 + (size_t)t_first * 64 * PITCH;
    const bf16_t* ksrc_c = Kb + (size_t)t_first * 64 * PITCH + wid * 512 + lane * 8;
    int issued = 0;
#define PP_DMA_K(i) do { if ((i) < n_t && !(dbg & 64)) { glds16(((dbg & 128) ? ksrc_c : ksrc) + (size_t)(i) * 64 * PITCH, (unsigned)__builtin_amdgcn_readfirstlane(lds0 + (unsigned)((i) % NS) * SLOT + wid * 1024)); issued += 1; } } while (0)
#define PP_DMA_V(i) do { if ((i) < n_t && !(dbg & 64)) { const unsigned sb_ = lds0 + (unsigned)((i) % NS) * SLOT + 8192; glds16(vsrc + (size_t)(i) * 64 * PITCH, (unsigned)__builtin_amdgcn_readfirstlane(sb_ + wid * 1024)); \
        if (VD == 128) glds16(vsrc + (size_t)(i) * 64 * PITCH + VNEXT, (unsigned)__builtin_amdgcn_readfirstlane(sb_ + (wid + 8) * 1024)); issued += NV; } } while (0)
#define PP_NEED_K(j) do { if (!(dbg & 256)) vm_wait_n(issued - ((j) * PER + 1)); } while (0)
#define PP_NEED_V(j) do { if (!(dbg & 256)) vm_wait_n(issued - ((j) + 1) * PER); } while (0)
#define PP_BAR() asm volatile("s_waitcnt lgkmcnt(0)\n\ts_barrier" ::: "memory")
    f32x16 o[ND];
#pragma unroll
    for (int d = 0; d < ND; ++d) o[d] = f32x16{};
    f32x16 cin;
#pragma unroll
    for (int r = 0; r < 16; ++r) cin[r] = -mref2;
    float l_reg = 0.f;
    const int wrow0 = q0 + wid * 32, qrow = wrow0 + r32, cw = wrow0 / 64;
    const int vb0 = (int)lds0 + 8192 + ((lane >> 4) & 1) * 32 + (lane & 3) * 8 + (4 * hi + ((lane & 15) >> 2)) * 64;
    asm volatile("s_waitcnt vmcnt(0)" ::: "memory"); asm volatile("" : "+v"(qr[0]), "+v"(qr[1]), "+v"(qr[2]), "+v"(qr[3]));
#pragma unroll
    for (int j = 0; j < PD; ++j) { PP_DMA_K(j); PP_DMA_V(j); }
    if (grp) PP_DMA_K(PD);
    PP_NEED_V(0);
    PP_BAR();
    if (grp) PP_BAR();
    u32x4 pw0, pw1, pw2, pw3; f32x16 p1;
    for (int i = 0; i < n_t; ++i) {
        const int t = t_first + i, slot = i % NS;
        bool active;
        if (MODE == 0) active = (t <= cw); else active = (t >= cw - 8) && (t <= cw);
        if (grp == 0) PP_DMA_K(i + PD); else PP_DMA_V(i + PD);
        if (active && !(dbg & 32)) {
            const lds_cptr kb = (lds_cptr)shm + slot * SLOT + hi * 1024 + r32 * 16;
            f32x16 p0; qkt8(p0, p1, kb, qr, cin);
            p_half<MODE>(p0, l_reg, pw0, pw1, (t <= cw - 3) || (dbg & 8), qrow - 64 * t - 4 * hi, tabL);
        }
        if (grp == 0) PP_NEED_V(i); else PP_NEED_K(i + 1);
        PP_BAR();
        if (grp == 0) PP_DMA_V(i + PD); else PP_DMA_K(i + 1 + PD);
        if (active && !(dbg & 16)) {
            const int vb = vb0 + slot * SLOT;
            s16x4 lo0[ND][2], hi0[ND][2], lo1[ND][2], hi1[ND][2];
            v_reads<ND, 0>(lo0, hi0, vb);
            asm volatile("s_waitcnt lgkmcnt(0)" ::: "memory");
            v_reads<ND, 2>(lo1, hi1, vb);
            __builtin_amdgcn_sched_barrier(0);
            pv_half<ND>(o, lo0, hi0, __builtin_bit_cast(bf16x8, pw0), __builtin_bit_cast(bf16x8, pw1));
            __builtin_amdgcn_sched_barrier(0);
            p_half<MODE>(p1, l_reg, pw2, pw3, (t <= cw - 3) || (dbg & 8), qrow - 64 * t - 4 * hi - 32, tabL);
            asm volatile("s_waitcnt lgkmcnt(0)" ::: "memory");
            __builtin_amdgcn_sched_barrier(0);
            pv_half<ND>(o, lo1, hi1, __builtin_bit_cast(bf16x8, pw2), __builtin_bit_cast(bf16x8, pw3));
        }
        if (grp == 0) PP_NEED_K(i + 1); else PP_NEED_V(i + 1);
        PP_BAR();
    }
    if (grp == 0) PP_BAR();
#undef PP_DMA_K
#undef PP_DMA_V
#undef PP_NEED_K
#undef PP_NEED_V
    float rl[16];
    l_reg += __shfl_xor(l_reg, 32);
    if (hi == 0) wsf[32 + r32] = l_reg;
    asm volatile("s_waitcnt lgkmcnt(0)" ::: "memory");
#pragma unroll
    for (int r = 0; r < 16; ++r) rl[r] = __builtin_amdgcn_rcpf(wsf[32 + crow(r, hi)]) * oscale;
    if constexpr (OUT8) {
        static_assert(!OUT8 || VD == 64, "fp8 output: 64-wide heads");
        unsigned char* Ow = (unsigned char*)Ob + (size_t)(q0 + wid * 32) * opitch;
        ALAS unsigned char* stg = (ALAS unsigned char*)(shm + L_OST) + wid * 2048;
#pragma unroll
        for (int r = 0; r < 16; ++r) { const int orow = crow(r, hi);
#pragma unroll
            for (int d0 = 0; d0 < 2; ++d0) { const float v = o[d0][r] * rl[r]; stg[orow * 64 + d0 * 32 + r32] = (unsigned char)(__builtin_amdgcn_cvt_pk_fp8_f32(v, v, 0, false) & 0xff); } }
        asm volatile("s_waitcnt lgkmcnt(0)" ::: "memory");
#pragma unroll
        for (int i = 0; i < 2; ++i) { const int row = i * 16 + (lane >> 2), ch = lane & 3; const u32x4 v = *(const ALAS u32x4*)(stg + row * 64 + ch * 16); *(u32x4*)(Ow + (size_t)row * opitch + ch * 16) = v; }
        asm volatile("s_waitcnt lgkmcnt(0)" ::: "memory");
    } else {
    bf16_t* Ow = (bf16_t*)Ob + (size_t)(q0 + wid * 32) * opitch;
    ALAS bf16_t* stg = (ALAS bf16_t*)(shm + L_OST) + wid * 2048;
#pragma unroll
    for (int half = 0; half < ND / 2; ++half) {
#pragma unroll
        for (int r = 0; r < 16; ++r) { const int orow = crow(r, hi);
#pragma unroll
            for (int d0 = 0; d0 < 2; ++d0) stg[orow * 64 + d0 * 32 + r32] = f2bf(o[half * 2 + d0][r] * rl[r]); }
        asm volatile("s_waitcnt lgkmcnt(0)" ::: "memory");
#pragma unroll
        for (int i = 0; i < 4; ++i) { const int row = i * 8 + (lane >> 3), ch = lane & 7; const u32x4 v = *(const ALAS u32x4*)(stg + row * 64 + ch * 8); *(u32x4*)(Ow + (size_t)row * opitch + half * 64 + ch * 8) = v; }
        asm volatile("s_waitcnt lgkmcnt(0)" ::: "memory");
    }
    }
    PP_BAR();
#undef PP_BAR
}
}

constexpr int NWAVES = 8, NTHR = NWAVES * 64;
constexpr int BATCH = 2, SEQ = 8192, T = BATCH * SEQ, D = 1024;
constexpr int NPROJ = 3072, FFD = 2816, FFE = 3584, NEXP = 8;
constexpr size_t MiB = 1u << 20;
constexpr size_t CTL_ZERO_BYTES = 1 * MiB;
constexpr int CW_TMO = 0, CW_BAR = 4096;
constexpr int CW_HIST = 16384;
constexpr int CW_QATT = 32768, CW_QCONV = 32768 + 64 * 8;
constexpr int CW_MOE = 24576;
constexpr size_t WS_SS0 = 1 * MiB, WS_SS3 = WS_SS0 + 65536, WS_ROPE = WS_SS3 + 65536  , WS_TOKSEL = WS_ROPE + MiB  ,
                 WS_TOKGATE = WS_TOKSEL + 65536  , WS_ROWTOK = WS_TOKGATE + 131072  , WS_ROWGATE = WS_ROWTOK + 147456  ;
static_assert(WS_ROWGATE + 147456 <= 4 * MiB, "small arrays");
constexpr size_t WS_XB = 4 * MiB;
constexpr size_t WS_AO = 36 * MiB;
constexpr size_t WS_ACT0 = 68 * MiB;
constexpr size_t WS_XF = 164 * MiB;
constexpr size_t WS_WIN = 228 * MiB, WS_WO0 = 234 * MiB, WS_WGU0 = 236 * MiB, WS_WD0 = 247 * MiB, WS_WQKV = 253 * MiB, WS_WO1 = 259 * MiB;
constexpr size_t WS_WEGU = 264 * MiB;
constexpr size_t WS_WED = 376 * MiB;
constexpr size_t WS_SS1 = 432 * MiB, WS_SS2 = 433 * MiB;
constexpr size_t WS_END = 434 * MiB;
constexpr size_t WS_SORTA = 36 * MiB;
constexpr size_t WS_ACTE = 108 * MiB;
static_assert(WS_SORTA + (size_t)36864 * 2048 <= WS_ACTE && WS_ACTE + (size_t)18432 * 7168 <= WS_WO0 && WS_WD0 + (size_t)1024 * 2816 * 2 <= WS_WQKV && WS_WO1 + 2 * MiB <= WS_WEGU, "ws map");
constexpr int RING_BYTES = 131072, MISC_OFF = RING_BYTES + 320, LDS_BYTES = 147456;
static_assert(att::L_END <= RING_BYTES, "attention LDS");

#define GAS __attribute__((address_space(1)))
#define LAS __attribute__((address_space(3)))
typedef unsigned short bf16;
typedef unsigned v4u __attribute__((ext_vector_type(4)));
typedef float f32x4 __attribute__((ext_vector_type(4)));
typedef GAS unsigned gu32;
#define RLX_AGENT __ATOMIC_RELAXED, __HIP_MEMORY_SCOPE_AGENT
#define LDS_WAIT() asm volatile("s_waitcnt lgkmcnt(0)" ::: "memory")
#define VM_WAIT() asm volatile("s_waitcnt vmcnt(0)" ::: "memory")
__device__ __forceinline__ unsigned f2bf(float f) { unsigned u = __builtin_bit_cast(unsigned, f); return (u + 0x7fffu + ((u >> 16) & 1u)) >> 16; }
__device__ __forceinline__ unsigned pk2(float lo, float hi) { return f2bf(lo) | (f2bf(hi) << 16); }
__device__ __forceinline__ float bf2f(unsigned short h) { return __builtin_bit_cast(float, (unsigned)h << 16); }
#define XB_TMO      128
#define XB_XCNT(j)  (256  + 64 * (j))
#define XB_XSUB(j)  (1280 + 64 * (j))
#define XB_XGEN(j)  (2304 + 64 * (j))
#define XB_TOP      3328
#define XB_TOPGEN   3392
#define XCD_BAR_WORDS 3456
#define XB_SPIN_CAP (1u << 18)

__device__ __forceinline__ unsigned xb_ld(unsigned* p)              { return __hip_atomic_load(p, __ATOMIC_RELAXED, __HIP_MEMORY_SCOPE_AGENT); }
__device__ __forceinline__ unsigned xb_add(unsigned* p, unsigned v) { return __hip_atomic_fetch_add(p, v, __ATOMIC_RELAXED, __HIP_MEMORY_SCOPE_AGENT); }
__device__ __forceinline__ unsigned xb_xcc_id() { return (unsigned)__builtin_amdgcn_s_getreg((3 << 11) | 20) & 0xFu; }
#define XB_SPIN(cond, bar) do { unsigned _sp = 0; while (cond) { __builtin_amdgcn_s_sleep(1); \
    if ((++_sp & 255u) == 0u) { if (xb_ld(&(bar)[XB_TMO])) break; if (_sp > XB_SPIN_CAP) { atomicAdd(&(bar)[XB_TMO], 1u); break; } } } } while (0)

struct XcdBarrier {
    unsigned* bar; unsigned x;
    volatile LAS unsigned* st;
};

__device__ __forceinline__ XcdBarrier xcd_barrier_post(unsigned* bar, volatile LAS unsigned* st) {
    XcdBarrier b; b.bar = bar; b.x = xb_xcc_id(); b.st = st;
    if (threadIdx.x == 0) (void)xb_add(&bar[XB_XCNT(b.x)], 1u);
    return b;
}
__device__ __forceinline__ void xcd_barrier_complete(unsigned* bar, unsigned x, unsigned& nloc, unsigned& nx) {
    const unsigned G = gridDim.x * gridDim.y * gridDim.z;
    unsigned sum, cnt, mine, sp = 0u;
    for (;;) {
        sum = 0u; cnt = 0u; mine = 0u;
#pragma unroll
        for (unsigned j = 0; j < 16; ++j) { const unsigned c = xb_ld(&bar[XB_XCNT(j)]); sum += c; cnt += (c > 0u) ? 1u : 0u; mine = (j == x) ? c : mine; }
        if (sum == G) break;
        __builtin_amdgcn_s_sleep(1);
        if ((++sp & 255u) == 0u) { if (xb_ld(&bar[XB_TMO])) break; if (sp > XB_SPIN_CAP) { atomicAdd(&bar[XB_TMO], 1u); break; } }
    }
    nloc = mine > 0u ? mine : 1u; nx = cnt > 0u ? cnt : 1u;
}

__device__ __forceinline__ void xcd_barrier(const XcdBarrier& b) {
    asm volatile("s_waitcnt vmcnt(0)" ::: "memory");
    __syncthreads();
    if (threadIdx.x == 0) {
        unsigned* bar = b.bar;
        __builtin_amdgcn_s_waitcnt(0);
        unsigned nloc = b.st[0], nx = b.st[1];
        if (nloc == 0u) { xcd_barrier_complete(bar, b.x, nloc, nx); b.st[0] = nloc; b.st[1] = nx; }
        const unsigned old = xb_add(&bar[XB_XSUB(b.x)], 1u);
        const unsigned gen = old / nloc;
        if (old + 1u == (gen + 1u) * nloc) {
            __builtin_amdgcn_fence(__ATOMIC_RELEASE, "agent");
            asm volatile("s_waitcnt vmcnt(0)" ::: "memory");
            const unsigned og = xb_add(&bar[XB_TOP], 1u);
            const unsigned tg = og / nx;
            if (og + 1u == (tg + 1u) * nx) xb_add(&bar[XB_TOPGEN], 1u);
            else XB_SPIN(xb_ld(&bar[XB_TOPGEN]) == tg, bar);
            __builtin_amdgcn_fence(__ATOMIC_ACQUIRE, "agent");
            xb_add(&bar[XB_XGEN(b.x)], 1u);
            asm volatile("s_waitcnt vmcnt(0)" ::: "memory");
        } else {
            XB_SPIN(xb_ld(&bar[XB_XGEN(b.x)]) == gen, bar);
            __builtin_amdgcn_fence(__ATOMIC_ACQUIRE, "agent");
            asm volatile("s_waitcnt vmcnt(0)" ::: "memory");
        }
    }
    __syncthreads();
}

__device__ __forceinline__ float wave_sum(float v) {
#pragma unroll
    for (int o = 1; o < 64; o <<= 1) v += __shfl_xor(v, o);
    return v;
}
__device__ __forceinline__ float wave_max(float v) {
#pragma unroll
    for (int o = 1; o < 64; o <<= 1) v = fmaxf(v, __shfl_xor(v, o));
    return v;
}
__device__ __forceinline__ int dest_block(int blk, int map) {
    if (map == 1) { const int s = blk & 7; return (blk & ~7) + 4 * (s & 1) + (s >> 1); }
    if (map == 2) return (blk >> 2) * 8 + (blk & 3);
    if (map == 3) return (blk >> 2) * 8 + 4 + (blk & 3);
    return blk;
}
__device__ __forceinline__ void tr_tile(const float* W, int K, int N, bf16* WT, int map, const float* gain, LAS unsigned* scr, int item, int lane) {
    const int nblk = N / 64, kb = item / nblk, nb = item % nblk, k0 = 64 * kb, n0 = 64 * nb;
    const int c = lane & 15, ip = lane >> 4;
#pragma unroll
    for (int it = 0; it < 8; ++it) { const int kp = it * 4 + ip, k = k0 + 2 * kp;
        f32x4 a = *(const GAS f32x4*)(W + (size_t)k * N + n0 + 4 * c), b = *(const GAS f32x4*)(W + (size_t)(k + 1) * N + n0 + 4 * c);
        if (gain) { a = a * gain[k]; b = b * gain[k + 1]; }
#pragma unroll
        for (int j = 0; j < 4; ++j) scr[(4 * c + j) * 33 + kp] = pk2(a[j], b[j]); }
    LDS_WAIT(); asm volatile("" ::: "memory");
#pragma unroll
    for (int it = 0; it < 8; ++it) { const int n = it * 8 + (lane >> 3), q = lane & 7;
        v4u o; o.x = scr[n * 33 + 4 * q]; o.y = scr[n * 33 + 4 * q + 1]; o.z = scr[n * 33 + 4 * q + 2]; o.w = scr[n * 33 + 4 * q + 3];
        const int drow = dest_block((n0 + n) >> 5, map) * 32 + (n & 31);
        *(GAS v4u*)(WT + (size_t)drow * K + k0 + 8 * q) = o; }
    LDS_WAIT(); asm volatile("" ::: "memory");
}

__device__ __forceinline__ void tr_tile8(const float* W, int K, int N, unsigned char* WT, int map, const float* gain, float wscale, LAS unsigned* scr, int item, int lane) {
    const int nblk = N / 64, kb = item / nblk, nb = item % nblk, k0 = 64 * kb, n0 = 64 * nb;
    const int c = lane & 15, ip = lane >> 4;
#pragma unroll
    for (int it = 0; it < 4; ++it) { const int k4 = it * 4 + ip, k = k0 + 4 * k4; f32x4 a[4];
#pragma unroll
        for (int i = 0; i < 4; ++i) a[i] = *(const GAS f32x4*)(W + (size_t)(k + i) * N + n0 + 4 * c) * ((gain ? gain[k + i] : 1.f) * wscale);
#pragma unroll
        for (int j = 0; j < 4; ++j) scr[(4 * c + j) * 17 + k4] = pg8::pk4_fp8(a[0][j], a[1][j], a[2][j], a[3][j]); }
    LDS_WAIT(); asm volatile("" ::: "memory");
#pragma unroll
    for (int it = 0; it < 4; ++it) { const int n = it * 16 + (lane >> 2), q = lane & 3;
        v4u o; o.x = scr[n * 17 + 4 * q]; o.y = scr[n * 17 + 4 * q + 1]; o.z = scr[n * 17 + 4 * q + 2]; o.w = scr[n * 17 + 4 * q + 3];
        const int drow = dest_block((n0 + n) >> 5, map) * 32 + (n & 31);
        *(GAS v4u*)(WT + (size_t)drow * K + k0 + 16 * q) = o; }
    LDS_WAIT(); asm volatile("" ::: "memory");
}

struct TrItem { const float* W; unsigned char* WT; const float* gain; int K, N, map, fp8, k0, n0; float scale; };
__device__ __forceinline__ void tr_load(const TrItem& d, f32x4 (&a)[16], float (&g)[16], int lane) {
    const int c = lane & 15, ip = lane >> 4;
#pragma unroll
    for (int it = 0; it < 4; ++it)
#pragma unroll
        for (int i = 0; i < 4; ++i) { const int k = d.k0 + 4 * (it * 4 + ip) + i;
            a[it * 4 + i] = __builtin_nontemporal_load((const GAS f32x4*)(d.W + (size_t)k * d.N + d.n0 + 4 * c)); g[it * 4 + i] = d.gain ? d.gain[k] : 1.f; }
}
__device__ __forceinline__ void tr_emit(const TrItem& d, const f32x4 (&a)[16], const float (&g)[16], LAS unsigned* scr, int lane) {
    const int c = lane & 15, ip = lane >> 4;
    if (d.fp8) {
#pragma unroll
        for (int it = 0; it < 4; ++it) { const int k4 = it * 4 + ip;
#pragma unroll
            for (int j = 0; j < 4; ++j) scr[(4 * c + j) * 17 + k4] = pg8::pk4_fp8(a[it * 4][j] * (g[it * 4] * d.scale), a[it * 4 + 1][j] * (g[it * 4 + 1] * d.scale), a[it * 4 + 2][j] * (g[it * 4 + 2] * d.scale), a[it * 4 + 3][j] * (g[it * 4 + 3] * d.scale)); }
        LDS_WAIT(); asm volatile("" ::: "memory");
#pragma unroll
        for (int it = 0; it < 4; ++it) { const int n = it * 16 + (lane >> 2), q = lane & 3;
            v4u o; o.x = scr[n * 17 + 4 * q]; o.y = scr[n * 17 + 4 * q + 1]; o.z = scr[n * 17 + 4 * q + 2]; o.w = scr[n * 17 + 4 * q + 3];
            const int drow = dest_block((d.n0 + n) >> 5, d.map) * 32 + (n & 31);
            __builtin_nontemporal_store(o, (GAS v4u*)(d.WT + (size_t)drow * d.K + d.k0 + 16 * q)); }
    } else {
#pragma unroll
        for (int it = 0; it < 4; ++it) { const int k4 = it * 4 + ip;
#pragma unroll
            for (int j = 0; j < 4; ++j) { scr[(4 * c + j) * 33 + 2 * k4] = pk2(a[it * 4][j] * g[it * 4], a[it * 4 + 1][j] * g[it * 4 + 1]); scr[(4 * c + j) * 33 + 2 * k4 + 1] = pk2(a[it * 4 + 2][j] * g[it * 4 + 2], a[it * 4 + 3][j] * g[it * 4 + 3]); } }
        LDS_WAIT(); asm volatile("" ::: "memory");
#pragma unroll
        for (int it = 0; it < 8; ++it) { const int n = it * 8 + (lane >> 3), q = lane & 7;
            v4u o; o.x = scr[n * 33 + 4 * q]; o.y = scr[n * 33 + 4 * q + 1]; o.z = scr[n * 33 + 4 * q + 2]; o.w = scr[n * 33 + 4 * q + 3];
            const int drow = dest_block((d.n0 + n) >> 5, d.map) * 32 + (n & 31);
            __builtin_nontemporal_store(o, (GAS v4u*)(d.WT + ((size_t)drow * d.K + d.k0 + 8 * q) * 2)); }
    }
    LDS_WAIT(); asm volatile("" ::: "memory");
}
constexpr float AO8_SCALE = 16.f;
constexpr float W8_SCALE = 64.f;

#ifndef PROBE_MASK
#define PROBE_MASK 0
#endif
struct KArgs { const void* in[27]; float* out; unsigned char* ws; int ph_lo, ph_hi, flags, pad; };

struct KArgs;
__device__ __forceinline__ const void* karg_in(const KArgs& a, int k) { asm volatile("" : "+s"(k)); return a.in[k]; }
__global__ void __launch_bounds__(NTHR, 2) fwd_kernel(KArgs args) {
    extern __shared__ __attribute__((aligned(16))) unsigned char lds_raw[];
    LAS unsigned char* lds = (LAS unsigned char*)lds_raw;
    volatile LAS unsigned* MISC = (volatile LAS unsigned*)(lds + MISC_OFF);
    const int tid = threadIdx.x, lane = tid & 63, wave = __builtin_amdgcn_readfirstlane(tid >> 6);
    const int G = gridDim.x; const int bx = blockIdx.x; const int vcu = (G % 8 == 0) ? (bx % 8) * (G / 8) + bx / 8 : bx;
    unsigned char* ws = args.ws;
    unsigned* ctl = (unsigned*)ws;
    for (int u = tid; u < (LDS_BYTES - RING_BYTES) / 4; u += NTHR) ((LAS unsigned*)(lds + RING_BYTES))[u] = 0u;
    __syncthreads();
    XcdBarrier bar = xcd_barrier_post(ctl + CW_BAR, MISC + 8);
    const int lo = args.ph_lo, hi_ph = args.ph_hi;
#define IN(k) (lo <= (k) && (k) < hi_ph)
#define REP(k)
#define SEAM(k) do { if (IN(k) && IN((k) + 1)) xcd_barrier(bar); } while (0)
#define KIN(T, k) ((const T*)karg_in(args, (k)))
#define x_in KIN(float, 0)
#define positions KIN(int, 1)
#define ev_attn_norm KIN(float, 2)
#define ev_w_in KIN(float, 3)
#define ev_q_norm KIN(float, 4)
#define ev_k_norm KIN(float, 5)
#define ev_lq1 KIN(float, 6)
#define ev_lk1 KIN(float, 7)
#define ev_lq2 KIN(float, 8)
#define ev_lk2 KIN(float, 9)
#define ev_subln KIN(float, 10)
#define ev_w_out KIN(float, 11)
#define ev_ffn_norm KIN(float, 12)
#define ev_w_gate KIN(float, 13)
#define ev_w_up KIN(float, 14)
#define ev_w_down KIN(float, 15)
#define od_attn_norm KIN(float, 16)
#define od_w_qkv KIN(float, 17)
#define od_q_norm KIN(float, 18)
#define od_k_norm KIN(float, 19)
#define od_rel_bias KIN(float, 20)
#define od_w_out KIN(float, 21)
#define od_ffn_norm KIN(float, 22)
#define od_router KIN(float, 23)
#define od_we_gate KIN(float, 24)
#define od_we_up KIN(float, 25)
#define od_we_down KIN(float, 26)
    float* out = args.out;
    float* ss0 = (float*)(ws + WS_SS0); float* ss1 = (float*)(ws + WS_SS1); float* ss2 = (float*)(ws + WS_SS2); float* ss3 = (float*)(ws + WS_SS3);
    float* rope = (float*)(ws + WS_ROPE); unsigned* toksel = (unsigned*)(ws + WS_TOKSEL); float* tokgate = (float*)(ws + WS_TOKGATE);
    int* rowtok = (int*)(ws + WS_ROWTOK); float* rowgate = (float*)(ws + WS_ROWGATE);
    bf16* XB = (bf16*)(ws + WS_XB); bf16* AO = (bf16*)(ws + WS_AO); bf16* ACT0 = (bf16*)(ws + WS_ACT0); float* XF = (float*)(ws + WS_XF); bf16* OD = (bf16*)(ws + WS_XF);
    bf16* Win_t = (bf16*)(ws + WS_WIN); bf16* Wo0_t = (bf16*)(ws + WS_WO0); bf16* Wgu0_t = (bf16*)(ws + WS_WGU0); bf16* Wd0_t = (bf16*)(ws + WS_WD0);
    unsigned char* Wqkv8 = ws + WS_WQKV; unsigned char* Wo18 = ws + WS_WO1; unsigned char* XB8 = ws + WS_XB; unsigned char* AO8 = ws + WS_AO; unsigned char* WEgu8 = ws + WS_WEGU; unsigned char* WEd8 = ws + WS_WED;
    unsigned char* SORTA8 = ws + WS_SORTA; unsigned char* ACTE8 = ws + WS_ACTE;
    const int gw = vcu * NWAVES + wave, NGW = G * NWAVES;

    constexpr int I_IN = 16 * 48, I_O = 16 * 16, I_G = 16 * 44, I_D = 44 * 16, I_EG = 16 * 56, I_ED = 56 * 16;
    constexpr int NSMALL = I_IN + I_O + 2 * I_G + I_D + I_IN + I_O, NITEMS = NSMALL + 24 * I_EG;
        auto decode = [&](int it) -> TrItem {
        TrItem d; int r = it; d.scale = 1.f; d.fp8 = 0; d.gain = nullptr; d.map = 0;
        auto fin = [&](int nbl) { d.k0 = 64 * (r / nbl); d.n0 = 64 * (r % nbl); };
        if (r < I_IN) { d.W = ev_w_in; d.K = D; d.N = NPROJ; d.WT = (unsigned char*)Win_t; d.map = 1; d.gain = ev_attn_norm; fin(NPROJ / 64); return d; } r -= I_IN;
        if (r < I_O) { d.W = ev_w_out; d.K = D; d.N = D; d.WT = (unsigned char*)Wo0_t; fin(D / 64); return d; } r -= I_O;
        if (r < I_G) { d.W = ev_w_gate; d.K = D; d.N = FFD; d.WT = (unsigned char*)Wgu0_t; d.map = 2; d.gain = ev_ffn_norm; fin(FFD / 64); return d; } r -= I_G;
        if (r < I_G) { d.W = ev_w_up; d.K = D; d.N = FFD; d.WT = (unsigned char*)Wgu0_t; d.map = 3; d.gain = ev_ffn_norm; fin(FFD / 64); return d; } r -= I_G;
        if (r < I_D) { d.W = ev_w_down; d.K = FFD; d.N = D; d.WT = (unsigned char*)Wd0_t; fin(D / 64); return d; } r -= I_D;
        d.fp8 = 1; d.scale = W8_SCALE;
        if (r < I_IN) { d.W = od_w_qkv; d.K = D; d.N = NPROJ; d.WT = Wqkv8; d.map = 1; d.gain = od_attn_norm; fin(NPROJ / 64); return d; } r -= I_IN;
        if (r < I_O) { d.W = od_w_out; d.K = D; d.N = D; d.WT = Wo18; fin(D / 64); return d; } r -= I_O;
        const int which = r / (8 * I_EG), rr = r % (8 * I_EG), e2 = rr / I_EG; r = rr % I_EG;
        if (which == 0) { d.W = od_we_gate + (size_t)e2 * D * FFE; d.K = D; d.N = FFE; d.WT = WEgu8 + (size_t)e2 * 2 * FFE * D; d.map = 2; d.gain = od_ffn_norm; fin(FFE / 64); }
        else if (which == 1) { d.W = od_we_up + (size_t)e2 * D * FFE; d.K = D; d.N = FFE; d.WT = WEgu8 + (size_t)e2 * 2 * FFE * D; d.map = 3; d.gain = od_ffn_norm; fin(FFE / 64); }
        else { d.W = od_we_down + (size_t)e2 * FFE * D; d.K = FFE; d.N = D; d.WT = WEd8 + (size_t)e2 * D * FFE; fin(D / 64); }
        return d; };
    auto conv_range = [&](int first, int end, int stride) {
        LAS unsigned* scr = (LAS unsigned*)(lds + wave * 8704);
        f32x4 bufA[16], bufB[16]; float gA[16], gB[16]; TrItem dA, dB; int it = first;
        if (it < end) { dA = decode(it); tr_load(dA, bufA, gA, lane); }
        while (it < end) {
            const int it2 = it + stride, it3 = it2 + stride;
            if (it2 < end) { dB = decode(it2); tr_load(dB, bufB, gB, lane); }
            tr_emit(dA, bufA, gA, scr, lane);
            if (it3 < end) { dA = decode(it3); tr_load(dA, bufA, gA, lane); }
            if (it2 < end) tr_emit(dB, bufB, gB, scr, lane);
            it = it3; } };
    auto pull = [&](int qword) -> int {
        __syncthreads(); if (tid == 0) MISC[16] = __hip_atomic_fetch_add(ctl + qword, 1u, __ATOMIC_RELAXED, __HIP_MEMORY_SCOPE_AGENT); __syncthreads();
        return __builtin_amdgcn_readfirstlane((int)MISC[16]); };

    REP(0) if (IN(0)) {
        conv_range(gw, I_IN, NGW);
        for (int m0 = gw; m0 < T; m0 += 2 * NGW) {
            f32x4 v[2][4];
#pragma unroll
            for (int u = 0; u < 2; ++u) { const int m = m0 + u * NGW; if (m < T) { const GAS f32x4* xr = (const GAS f32x4*)(x_in + (size_t)m * D) + lane;
#pragma unroll
                for (int j = 0; j < 4; ++j) v[u][j] = __builtin_nontemporal_load(xr + 64 * j); } }
#pragma unroll
            for (int u = 0; u < 2; ++u) { const int m = m0 + u * NGW; if (m >= T) break; float s = 0.f;
#pragma unroll
                for (int j = 0; j < 4; ++j) s += (v[u][j].x * v[u][j].x + v[u][j].y * v[u][j].y) + (v[u][j].z * v[u][j].z + v[u][j].w * v[u][j].w);
                s = wave_sum(s); if (lane == 0) ss0[m] = s;
                GAS unsigned long long* o8 = (GAS unsigned long long*)(XB + (size_t)m * D) + lane;
#pragma unroll
                for (int j = 0; j < 4; ++j) o8[64 * j] = (unsigned long long)pk2(v[u][j].x, v[u][j].y) | ((unsigned long long)pk2(v[u][j].z, v[u][j].w) << 32); }
        }
        for (int i = vcu * NTHR + tid; i < T * 8; i += G * NTHR) {
            const int tok = i >> 3, f = i & 7;
            const double inv = exp2(-(double)f * (18.931568569324174 / 8.0));
            double ang = (double)positions[tok] * inv; ang -= 6.283185307179586 * rint(ang * 0.15915494309189535);
            float sn, cs; sincosf((float)ang, &sn, &cs);
            rope[(size_t)tok * 16 + f] = cs; rope[(size_t)tok * 16 + 8 + f] = sn;
        }
    }
    SEAM(0);

    REP(1) if (IN(1)) {
        pg8::Gemm g{XB, Win_t, T, NPROJ, D}; pg8::StaticOrder S; S.init(T, NPROJ, G, bx);
        pg8::EpiProj E{ACT0, T, ss0, 1, ev_q_norm, ev_k_norm, rope, 0, 1.f};
        pg8::gemm_phase<pg8::EpiProj, pg8::StaticOrder, true, true>(lds, g, S, E);
    }
    SEAM(1);

    REP(2) if (IN(2)) {
        const float gqm = wave_max(fabsf(ev_q_norm[lane])), gkm = wave_max(fabsf(ev_k_norm[lane]));
        const float mref = 8.f * gqm * gkm * pg8::LOG2E;
        constexpr int NJOBS = (NITEMS - I_IN + 63) / 64;
        const bool conv_first = ((bx >> 3) & 3) == 3;
#define P2_CONV_LOOP() for (;;) { const int j = pull(CW_QCONV); if (j >= NJOBS) break; \
            const int first = I_IN + j * 64 + wave * 8; conv_range(first, (first + 8 < NITEMS) ? first + 8 : NITEMS, 1); }
        if (conv_first) P2_CONV_LOOP()
#pragma unroll 1
        for (int kq = 0; kq < 8; ++kq) { const int xq = (bx + kq) & 7;
            for (;;) { const int idx = pull(CW_QATT + 64 * xq); if (idx >= 128) break;
                if (idx < 64) { if (args.flags & 1) continue;
                    const int bhm = 2 * xq + (idx & 1), qb = 31 - (idx >> 1);
                    const int b = bhm >> 3, hm = bhm & 7, h = hm >> 1;
                    const bf16* base = ACT0 + (size_t)b * SEQ * 64;
                    att::attn_unit<0, 128, false, 1>((LAS char*)lds, base + (size_t)(24 + hm) * T * 64, base + (size_t)(32 + hm) * T * 64, base + (size_t)(40 + 2 * h) * T * 64, OD + (size_t)b * SEQ * D + hm * 128, D, qb * 256, mref, nullptr, 1.f, args.flags);
                } else { if (args.flags & 2) continue;
                    const int bh = 2 * xq + (idx & 1), qb = 31 - ((idx - 64) >> 1);
                    const int b = bh >> 3, h = bh & 7;
                    const bf16* base = ACT0 + (size_t)b * SEQ * 64;
                    att::attn_unit<2, 64>((LAS char*)lds, base + (size_t)h * T * 64, base + (size_t)(8 + h) * T * 64, base + (size_t)(16 + h) * T * 64, AO + (size_t)b * SEQ * D + h * 64, D, qb * 256, 0.f, nullptr);
                }
            }
        }
        P2_CONV_LOOP()
#undef P2_CONV_LOOP
    }
    SEAM(2);

    REP(3) if (IN(3)) {
        const float a1 = wave_sum(ev_lq1[lane] * ev_lk1[lane]), a2 = wave_sum(ev_lq2[lane] * ev_lk2[lane]);
        const float lam_init = 0.2f, lam = expf(a1) - expf(a2) + lam_init;
        const int h = lane >> 4, v0 = (lane & 15) * 8;
        float sg[8];
#pragma unroll
        for (int j = 0; j < 8; ++j) sg[j] = ev_subln[v0 + j] * (1.f - lam_init);
        for (int m0 = gw; m0 < T; m0 += 4 * NGW) {
            v4u a4[4], b4[4];
#pragma unroll
            for (int u = 0; u < 4; ++u) { const int m = m0 + u * NGW; if (m < T) { a4[u] = *(const GAS v4u*)(OD + (size_t)m * D + (2 * h) * 128 + v0); b4[u] = *(const GAS v4u*)(OD + (size_t)m * D + (2 * h + 1) * 128 + v0); } }
#pragma unroll
            for (int u = 0; u < 4; ++u) { const int m = m0 + u * NGW; if (m >= T) break;
                const v4u a = a4[u], b = b4[u]; float d[8]; float s = 0.f;
#pragma unroll
                for (int j = 0; j < 4; ++j) { const unsigned ua = a[j], ub = b[j];
                    d[2 * j] = bf2f((unsigned short)(ua & 0xffffu)) - lam * bf2f((unsigned short)(ub & 0xffffu));
                    d[2 * j + 1] = bf2f((unsigned short)(ua >> 16)) - lam * bf2f((unsigned short)(ub >> 16));
                    s += d[2 * j] * d[2 * j] + d[2 * j + 1] * d[2 * j + 1]; }
                s += __shfl_xor(s, 1); s += __shfl_xor(s, 2); s += __shfl_xor(s, 4); s += __shfl_xor(s, 8);
                const float rs = rsqrtf(s * (1.f / 128.f) + pg8::RMS_EPS);
                v4u o; o.x = pk2(d[0] * rs * sg[0], d[1] * rs * sg[1]); o.y = pk2(d[2] * rs * sg[2], d[3] * rs * sg[3]); o.z = pk2(d[4] * rs * sg[4], d[5] * rs * sg[5]); o.w = pk2(d[6] * rs * sg[6], d[7] * rs * sg[7]);
                *(GAS v4u*)(AO + (size_t)m * D + 512 + h * 128 + v0) = o; }
        }
    }
    SEAM(3);

    REP(4) if (IN(4)) {
        pg8::Gemm g{AO, Wo0_t, T, D, D}; pg8::StaticOrder S; S.init(T, D, G, bx);
        pg8::EpiResid E{x_in, XF, XB, ss1, 1.f, nullptr};
        pg8::gemm_phase<pg8::EpiResid, pg8::StaticOrder, false, true>(lds, g, S, E);
    }
    SEAM(4);

    REP(5) if (IN(5)) {
        pg8::Gemm g{XB, Wgu0_t, T, 2 * FFD, D}; pg8::StaticOrder S; S.init(T, 2 * FFD, G, bx, (args.flags >> 9) & 1);
        pg8::EpiSwiglu<false> E{ACT0, FFD, ss1, 16, nullptr, 0, 2 * FFD / 256, 1.f};
        pg8::gemm_phase<pg8::EpiSwiglu<false>, pg8::StaticOrder, true, true>(lds, g, S, E);
    }
    SEAM(5);

    if (IN(6)) {
        pg8::Gemm g{ACT0, Wd0_t, T, D, FFD}; pg8::StaticOrder S; S.init(T, D, G, bx);
        pg8::EpiResid E{XF, XF, nullptr, ss2, 1.f, XB8};
        pg8::gemm_phase<pg8::EpiResid, pg8::StaticOrder, false, true>(lds, g, S, E);
    }
    SEAM(6);

    REP(7) if (IN(7)) {
        pg8::Gemm g{(const bf16*)XB8, (const bf16*)Wqkv8, T, NPROJ, D / 2}; pg8::StaticOrder S; S.init(T, NPROJ, G, bx);
        pg8::EpiProj E{ACT0, T, ss2, 16, od_q_norm, od_k_norm, nullptr, 1, 1.f / W8_SCALE};
        pg8::gemm_phase<pg8::EpiProj, pg8::StaticOrder, true, true, true>(lds, g, S, E);
    }
    SEAM(7);

    REP(8) if (IN(8)) {
        const float gqm = wave_max(fabsf(od_q_norm[lane])), gkm = wave_max(fabsf(od_k_norm[lane]));
        for (int L = vcu; L < 1024; L += G) {
            const int bh = (L & 255) >> 3, qb = 4 * (L & 7) + (L >> 8);
            const int b = bh >> 4, h = bh & 15;
            const float* tab = od_rel_bias + h * 257;
            float tm = fabsf(tab[lane]); tm = fmaxf(tm, fabsf(tab[64 + lane])); tm = fmaxf(tm, fabsf(tab[128 + lane])); tm = fmaxf(tm, fabsf(tab[192 + lane])); tm = fmaxf(tm, fabsf(tab[256]));
            tm = wave_max(tm);
            const float mref = (8.f * gqm * gkm + tm) * pg8::LOG2E;
            const bf16* base = ACT0 + (size_t)b * SEQ * 64;
            att::attn_unit<1, 64, true, 1>((LAS char*)lds, base + (size_t)h * T * 64, base + (size_t)(16 + h) * T * 64, base + (size_t)(32 + h) * T * 64, AO8 + (size_t)b * SEQ * D + h * 64, D, qb * 256, mref, tab, AO8_SCALE);
        }
    }
    SEAM(8);

    REP(9) if (IN(9)) {
        pg8::Gemm g{(const bf16*)AO8, (const bf16*)Wo18, T, D, D / 2}; pg8::StaticOrder S; S.init(T, D, G, bx);
        pg8::EpiResid E{XF, out, nullptr, nullptr, 1.f / (W8_SCALE * AO8_SCALE), nullptr};
        pg8::gemm_phase<pg8::EpiResid, pg8::StaticOrder, false, true, true>(lds, g, S, E);
    }
    SEAM(9);

    REP(10) if (IN(10)) {
        LAS float* wrT = (LAS float*)lds;
        LAS unsigned* sel = (LAS unsigned*)(lds + 32768);
        for (int i = tid; i < 1024; i += NTHR) { const float gn = od_ffn_norm[i]; const f32x4 w0 = *(const GAS f32x4*)(od_router + (size_t)i * 8), w1 = *(const GAS f32x4*)(od_router + (size_t)i * 8 + 4);
            wrT[i] = w0.x * gn; wrT[1024 + i] = w0.y * gn; wrT[2048 + i] = w0.z * gn; wrT[3072 + i] = w0.w * gn; wrT[4096 + i] = w1.x * gn; wrT[5120 + i] = w1.y * gn; wrT[6144 + i] = w1.z * gn; wrT[7168 + i] = w1.w * gn; }
        __syncthreads();
        for (int blk = vcu; blk < T / 64; blk += G) {
#pragma unroll 1
            for (int q4 = 0; q4 < 2; ++q4) {
                const int tk = lane >> 4, sub = lane & 15; const int tok = blk * 64 + wave * 8 + q4 * 4 + tk;
                const GAS f32x4* xr = (const GAS f32x4*)(out + (size_t)tok * D) + sub; float s = 0.f; float lg[8];
#pragma unroll
                for (int e2 = 0; e2 < 8; ++e2) lg[e2] = 0.f;
#pragma unroll
                for (int jh = 0; jh < 2; ++jh) { f32x4 xv[8];
#pragma unroll
                    for (int j = 0; j < 8; ++j) xv[j] = xr[16 * (8 * jh + j)];
#pragma unroll
                    for (int j = 0; j < 8; ++j) { const f32x4 v = xv[j]; s += (v.x * v.x + v.y * v.y) + (v.z * v.z + v.w * v.w);
#pragma unroll
                        for (int e2 = 0; e2 < 8; ++e2) { const f32x4 w = *(const LAS f32x4*)(wrT + e2 * 1024 + 64 * (8 * jh + j) + 4 * sub); lg[e2] += (v.x * w.x + v.y * w.y) + (v.z * w.z + v.w * w.w); } } }
#pragma unroll
                for (int o = 1; o < 16; o <<= 1) { s += __shfl_xor(s, o);
#pragma unroll
                    for (int e2 = 0; e2 < 8; ++e2) lg[e2] += __shfl_xor(lg[e2], o); }
                if (sub == 0) {
                    const float r = rsqrtf(s * (1.f / 1024.f) + pg8::RMS_EPS); ss3[tok] = s;
                    int e0 = 0; float v0 = lg[0];
#pragma unroll
                    for (int e2 = 1; e2 < 8; ++e2) if (lg[e2] > v0) { v0 = lg[e2]; e0 = e2; }
                    int e1 = -1; float v1 = 0.f;
#pragma unroll
                    for (int e2 = 0; e2 < 8; ++e2) if (e2 != e0 && (e1 < 0 || lg[e2] > v1)) { v1 = lg[e2]; e1 = e2; }
                    const float ex = expf((v1 - v0) * r), g0 = 1.f / (1.f + ex), g1 = ex / (1.f + ex);
                    sel[wave * 8 + q4 * 4 + tk] = (unsigned)e0 | ((unsigned)e1 << 8); tokgate[2 * tok] = g0; tokgate[2 * tok + 1] = g1;
                }
            }
            __syncthreads();
            if (wave == 0) { const unsigned sv = sel[lane]; const int e0 = sv & 0xff, e1 = sv >> 8; unsigned rank0 = 0, rank1 = 0;
                const unsigned long long lt = (1ull << lane) - 1ull;
#pragma unroll
                for (int e = 0; e < 8; ++e) { const unsigned long long m0 = __ballot(e0 == e), m1 = __ballot(e1 == e);
                    if (e0 == e) rank0 = __popcll(m0 & lt); if (e1 == e) rank1 = __popcll(m1 & lt);
                    if (lane == 0) { ctl[CW_HIST + blk * 16 + e] = __popcll(m0); ctl[CW_HIST + blk * 16 + 8 + e] = __popcll(m1); } }
                toksel[blk * 64 + lane] = sv | (rank0 << 16) | (rank1 << 24); }
            __syncthreads();
        }
    }
    SEAM(10);

    REP(11) if (IN(11)) {
        LAS unsigned* hs = (LAS unsigned*)lds;
        for (int i = tid; i < 4096; i += NTHR) hs[i] = ctl[CW_HIST + i];
        __syncthreads();
        if (tid < 16) hs[4096 + tid] = 0u;
        __syncthreads();
        { unsigned s = 0; const int g2 = tid & 15;
#pragma unroll
          for (int b2 = tid >> 4; b2 < 256; b2 += 32) s += hs[b2 * 16 + g2];
          atomicAdd((unsigned*)&hs[4096 + g2], s); }
        __syncthreads();
        if (tid == 0) { unsigned acc = 0; for (int g2 = 0; g2 < 16; ++g2) { hs[4128 + g2] = acc; acc += (hs[4096 + g2] + 255u) & ~255u; } hs[4128 + 16] = acc; }
        __syncthreads();
        if (bx == 0) {
            if (tid == 0) { const int nA = (int)(hs[4128 + 8] >> 8), nT = (int)(hs[4128 + 16] >> 8), nC1 = (nT - nA + 1) / 2, nC2 = nT - nA - nC1;
                ctl[CW_MOE] = nA; ctl[CW_MOE + 1] = nT;
                for (int ph = 0; ph < 2; ++ph) { const int nd = (ph == 0 ? nA : nC1) * (D / 256), nu = (ph == 0 ? nC1 : nC2) * (2 * FFE / 256);
                    int H = nd > G ? nd - G : (nd < G ? nd : 0); int mode = 1, R = 0; if (H >= G) H = 0;
                    pg8::MoeOrder::plan(nu, H, G, D / 128, FFE / 128, mode, R);
                    ctl[CW_MOE + 2 + 3 * ph] = H; ctl[CW_MOE + 3 + 3 * ph] = R; ctl[CW_MOE + 4 + 3 * ph] = mode; } }
            if (tid < 16) { const unsigned t0 = hs[4128 + tid] >> 8, t1 = hs[4128 + tid + 1] >> 8; for (unsigned t = t0; t < t1; ++t) ctl[CW_MOE + 16 + t] = tid & 7; }
        }
        for (int blk = vcu; blk < T / 64; blk += G) {
            if (tid < 16) hs[4160 + tid] = 0u;
            __syncthreads();
            { unsigned s = 0; const int g2 = tid & 15;
#pragma unroll
              for (int b2 = tid >> 4; b2 < 256; b2 += 32) s += (b2 < blk) ? hs[b2 * 16 + g2] : 0u;
              atomicAdd((unsigned*)&hs[4160 + g2], s); }
            __syncthreads();
            for (int tl = wave; tl < 64; tl += NWAVES) {
                const int tok = blk * 64 + tl; const unsigned sv = toksel[tok];
                const GAS f32x4* xr = (const GAS f32x4*)(out + (size_t)tok * D + 16 * lane); const f32x4 v0 = xr[0], v1 = xr[1], v2 = xr[2], v3 = xr[3];
                v4u pk; pk.x = pg8::pk4_fp8(v0[0], v0[1], v0[2], v0[3]); pk.y = pg8::pk4_fp8(v1[0], v1[1], v1[2], v1[3]); pk.z = pg8::pk4_fp8(v2[0], v2[1], v2[2], v2[3]); pk.w = pg8::pk4_fp8(v3[0], v3[1], v3[2], v3[3]);
#pragma unroll
                for (int sl = 0; sl < 2; ++sl) { const int e = (sv >> (8 * sl)) & 0xff, rank = (sv >> (16 + 8 * sl)) & 0xff, g2 = sl * 8 + e;
                    const unsigned srow = hs[4128 + g2] + hs[4160 + g2] + rank;
                    *(GAS v4u*)(SORTA8 + (size_t)srow * D + lane * 16) = pk;
                    if (lane == 0) { rowtok[srow] = tok; rowgate[srow] = tokgate[2 * tok + sl]; } }
            }
            __syncthreads();
        }
        for (int g2 = vcu; g2 < 16; g2 += G) {
            const unsigned r0 = hs[4128 + g2] + hs[4096 + g2], r1 = hs[4128 + g2 + 1];
            for (unsigned r = r0 + wave; r < r1; r += NWAVES) { if (lane == 0) { rowtok[r] = -1; rowgate[r] = 0.f; }
                *(GAS v4u*)(SORTA8 + (size_t)r * D + lane * 16) = (v4u){0u, 0u, 0u, 0u}; }
        }
    }
    SEAM(11);

    if (IN(12) || IN(13) || IN(14) || IN(15)) {
        const int nA = (int)__builtin_amdgcn_readfirstlane(ctl[CW_MOE]), nT = (int)__builtin_amdgcn_readfirstlane(ctl[CW_MOE + 1]);
        const int nC1 = (nT - nA + 1) / 2, nC2 = nT - nA - nC1;
        const int* texp = (const int*)(ctl + CW_MOE + 16);
        unsigned char* const ACT_C0 = ACTE8; unsigned char* const ACT_C1 = ACTE8 + (size_t)63 * MiB; unsigned char* const ACT_C2 = ACT_C1 + (size_t)36 * 256 * FFE;
        constexpr int NPN_GU = 2 * FFE / 256, NPN_D = D / 256;
#define MOE_GU(TILE0, NTILE, ACTBUF, PLAN) do { int H_ = 0, R_ = 0, mode_ = 1; \
        if ((PLAN) >= 0) { H_ = (int)__builtin_amdgcn_readfirstlane(ctl[CW_MOE + 2 + 3 * (PLAN)]); R_ = (int)__builtin_amdgcn_readfirstlane(ctl[CW_MOE + 3 + 3 * (PLAN)]); mode_ = (int)__builtin_amdgcn_readfirstlane(ctl[CW_MOE + 4 + 3 * (PLAN)]); } \
        pg8::Gemm g{(const bf16*)(SORTA8 + (size_t)(TILE0) * 256 * D), (const bf16*)WEgu8, 0, 0, D / 2}; pg8::MoeOrder S; S.init((NTILE), NPN_GU, G, bx, (TILE0), texp, H_, R_, mode_); \
        pg8::EpiSwiglu<true> E{(ACTBUF), FFE, ss3, 1, rowtok, (TILE0), NPN_GU, 1.f / W8_SCALE}; \
        pg8::gemm_phase<pg8::EpiSwiglu<true>, pg8::MoeOrder, true, true, true>(lds, g, S, E); } while (0)
#define MOE_DOWN(TILE0, NTILE, ACTBUF) do { pg8::Gemm g{(const bf16*)(ACTBUF), (const bf16*)WEd8, 0, 0, FFE / 2}; pg8::MoeOrder S; S.init((NTILE), NPN_D, G, bx, (TILE0), texp); \
        pg8::EpiMoeDown E{out, rowtok, rowgate, (TILE0), 1.f / W8_SCALE, (args.flags >> 2) & 1}; \
        pg8::gemm_phase<pg8::EpiMoeDown, pg8::MoeOrder, true, true, true>(lds, g, S, E); } while (0)
        if (IN(12)) MOE_GU(0, nA, ACT_C0, -1);
        SEAM(12);
        if (IN(13)) { MOE_DOWN(0, nA, ACT_C0); MOE_GU(nA, nC1, ACT_C1, 0); }
        SEAM(13);
        if (IN(14)) { MOE_DOWN(nA, nC1, ACT_C1); if (nC2 > 0) MOE_GU(nA + nC1, nC2, ACT_C2, 1); }
        SEAM(14);
        if (IN(15)) { if (nC2 > 0) MOE_DOWN(nA + nC1, nC2, ACT_C2); }
#undef MOE_GU
#undef MOE_DOWN
    }
#undef IN
#undef SEAM
#undef x_in
#undef positions
#undef ev_attn_norm
#undef ev_w_in
#undef ev_q_norm
#undef ev_k_norm
#undef ev_lq1
#undef ev_lk1
#undef ev_lq2
#undef ev_lk2
#undef ev_subln
#undef ev_w_out
#undef ev_ffn_norm
#undef ev_w_gate
#undef ev_w_up
#undef ev_w_down
#undef od_attn_norm
#undef od_w_qkv
#undef od_q_norm
#undef od_k_norm
#undef od_rel_bias
#undef od_w_out
#undef od_ffn_norm
#undef od_router
#undef od_we_gate
#undef od_we_up
#undef od_we_down
#undef KIN
}

constexpr int N_PHASES = 16;
extern "C" void kernel_launch(void* const* d_in, const int* in_sizes, int n_in, void* d_out, int out_size, void* d_ws, size_t ws_size, hipStream_t stream) {
    static int grid = 0;
    if (grid == 0) {
        if (n_in != 27 || out_size != T * D || ws_size < WS_END) { fprintf(stderr, "kernel_launch: unexpected problem (n_in %d, out %d, ws %zu)\n", n_in, out_size, ws_size); grid = -1; return; }
        int dev = 0, cus = 0, per_cu = 0;
        if (hipGetDevice(&dev) != hipSuccess || hipDeviceGetAttribute(&cus, hipDeviceAttributeMultiprocessorCount, dev) != hipSuccess) { grid = -1; return; }
        if (hipFuncSetAttribute((const void*)fwd_kernel, hipFuncAttributeMaxDynamicSharedMemorySize, LDS_BYTES) != hipSuccess) { fprintf(stderr, "kernel_launch: hipFuncSetAttribute failed\n"); grid = -1; return; }
        if (hipOccupancyMaxActiveBlocksPerMultiprocessor(&per_cu, (const void*)fwd_kernel, NTHR, LDS_BYTES) != hipSuccess || per_cu < 1) { fprintf(stderr, "kernel_launch: occupancy query says %d\n", per_cu); }
        (void)hipGetLastError();
        grid = cus;
    }
    if (grid < 0) return;
    (void)hipMemsetAsync(d_ws, 0, CTL_ZERO_BYTES, stream);
    KArgs a{};
    for (int i = 0; i < 27; ++i) a.in[i] = d_in[i];
    a.out = (float*)d_out; a.ws = (unsigned char*)d_ws; a.ph_lo = 0; a.ph_hi = N_PHASES;
    hipLaunchKernelGGL(fwd_kernel, dim3(grid), dim3(NTHR), LDS_BYTES, stream, a);
#if defined(PROBE_LO)
    (void)hipMemsetAsync((char*)d_ws + CW_BAR * 4, 0, XCD_BAR_WORDS * 4, stream); (void)hipMemsetAsync((char*)d_ws + CW_QATT * 4, 0, 4096, stream);
    a.ph_lo = PROBE_LO; a.ph_hi = PROBE_HI;
#if defined(PROBE_FLAGS)
    a.flags = PROBE_FLAGS;
#endif
    hipLaunchKernelGGL(fwd_kernel, dim3(grid), dim3(NTHR), LDS_BYTES, stream, a);
#endif
}
```

```cpp
#include <hip/hip_runtime.h>
#include <cstdio>
#include <cstdint>
#include <cmath>
#define PROBE_MASK 0x0
namespace pg8 {
#define PG8_LAS __attribute__((address_space(3)))
typedef unsigned short bf16_t;
typedef short bf16x8 __attribute__((ext_vector_type(8)));
typedef float f32x4 __attribute__((ext_vector_type(4)));
typedef unsigned u32x4 __attribute__((ext_vector_type(4)));
constexpr int BM = 256, BK = 64, HALF = 128, HTB = HALF * BK * 2  , STAGE_BYTES = 8 * HTB, NXCD = 8, WGM = 4;

__host__ __device__ __forceinline__ int lds_byte(int r, int c) { const int st = (r >> 4) * 2 + (c >> 5), rr = r & 15, cc = c & 31, ob = rr * 64 + cc * 2; return st * 1024 + (ob ^ (((ob >> 9) & 1) << 5)); }
__host__ __device__ __forceinline__ void stage_rc(int b, int& R, int& C) { const int st = b / 1024, sb = b % 1024, swz = sb ^ (((sb >> 9) & 1) << 5); R = (st >> 1) * 16 + swz / 64; C = (st & 1) * 32 + (swz % 64) / 2; }
__host__ __device__ __forceinline__ int perm32(int rho) { const int n = rho >> 4, i = rho & 15; return 8 * (i >> 2) + 4 * n + (i & 3); }

struct Unit { int pm, pn; };
struct Gemm { const bf16_t* A; const bf16_t* Bt; int M, N, K; };

struct StaticOrder {
    int nM, nN, nwg, G, c, hot;
    __host__ __device__ void init(int M, int N, int G_, int c_, int hot_ = 0) { nM = M / BM; nN = N / BM; nwg = nM * nN; G = G_; c = c_; hot = hot_; }
    __host__ __device__ bool next(int i, Unit& u) const {
        const long L = (long)i * G + c; if (L >= nwg) return false;
        int wgid = (int)L; { const int q = nwg / NXCD, r = nwg % NXCD, xcd = wgid % NXCD, off = wgid / NXCD; wgid = (xcd < r ? xcd * (q + 1) : r * (q + 1) + (xcd - r) * q) + off; }
        const int nig = WGM * nN, gid = wgid / nig, fm = gid * WGM, gsz = (nM - fm) < WGM ? (nM - fm) : WGM;
        u.pm = fm + ((wgid % nig) % gsz); u.pn = (wgid % nig) / gsz; if (hot) { u.pm &= 3; u.pn = 0; } return true;
    }
    __device__ __forceinline__ void a_ready(const Unit&) const {}
    __device__ __forceinline__ void done(const Unit&) const {}
};

struct MoeOrder {
    int nM, nN, nwg, G, c, tile0; const int* tile_expert;
    int H, R, mode;
    __device__ void init(int ntiles, int npn, int G_, int c_, int tile0_, const int* te, int H_ = 0, int R_ = 0, int mode_ = 1) { nM = ntiles; nN = npn; nwg = nM * nN; G = G_; c = c_; tile0 = tile0_; tile_expert = te; H = H_; R = R_; mode = mode_; }
    __device__ static __forceinline__ void plan(int nu, int H, int G, int ucost, int extra, int& mode, int& R) {
        mode = 1; R = 0; if (H <= 0 || H >= G) return;
        const int rmax = (nu + (G - H) - 1) / (G - H); int best = 0x7fffffff;
        for (int r2 = 0; r2 <= rmax; ++r2) { const int rest = nu - r2 * (G - H) > 0 ? nu - r2 * (G - H) : 0;
            { const int light = ucost * r2, heavy = extra + ucost * ((rest + H - 1) / H); const int mk = light > heavy ? light : heavy; if (mk < best) { best = mk; mode = 1; R = r2; } }
            { const int sh = (rest + G - 1) / G; const int light = ucost * (r2 + sh), heavy = extra + ucost * sh; const int mk = light > heavy ? light : heavy; if (mk < best) { best = mk; mode = 2; R = r2; } } }
    }
    __device__ bool next(int i, Unit& u) const {
        long L;
        if (H == 0) L = (long)i * G + c;
        else if (c >= H) { if (i < R) L = (long)i * (G - H) + (c - H); else if (mode == 2) L = (long)R * (G - H) + (long)(i - R) * G + c; else return false; }
        else L = (long)R * (G - H) + (long)i * (mode == 2 ? G : H) + c;
        if (L >= nwg) return false;
        int wgid = (int)L; { const int q = nwg / NXCD, r = nwg % NXCD, xcd = wgid % NXCD, off = wgid / NXCD; wgid = (xcd < r ? xcd * (q + 1) : r * (q + 1) + (xcd - r) * q) + off; }
        const int nig = WGM * nN, gid = wgid / nig, fm = gid * WGM, gsz = (nM - fm) < WGM ? (nM - fm) : WGM;
        u.pm = fm + ((wgid % nig) % gsz); const int pnl = (wgid % nig) / gsz;
        const int e = tile_expert[tile0 + u.pm];
        u.pn = e * nN + pnl; return true;
    }
    __device__ __forceinline__ void a_ready(const Unit&) const {}
    __device__ __forceinline__ void done(const Unit&) const {}
};

constexpr int MAX_UNITS = 64;
template <class Sched> __device__ __forceinline__ void build_unit_list(const Sched& S, PG8_LAS int* list) {
    const int t = threadIdx.x;
    if (t < MAX_UNITS) { Unit u; u.pm = 0; u.pn = 0; const bool ok = S.next(t, u); list[2 * t] = ok ? u.pm : -1; list[2 * t + 1] = u.pn; }
    __syncthreads();
}
struct ListOrder {
    const PG8_LAS int* list;
    __device__ __forceinline__ bool next(int i, Unit& u) const {
        if (i >= MAX_UNITS) return false;
        const int pm = __builtin_amdgcn_readfirstlane(list[2 * i]); if (pm < 0) return false;
        u.pm = pm; u.pn = __builtin_amdgcn_readfirstlane(list[2 * i + 1]); return true; }
    __device__ __forceinline__ void a_ready(const Unit&) const {}
    __device__ __forceinline__ void done(const Unit&) const {}
};

__device__ __forceinline__ unsigned cvt_pk_bf16(float lo, float hi) { unsigned r; asm volatile("v_cvt_pk_bf16_f32 %0, %1, %2" : "=v"(r) : "v"(lo), "v"(hi)); return r; }
__device__ __forceinline__ u32x4 pack8(const f32x4& a, const f32x4& b) { u32x4 w; w.x = cvt_pk_bf16(a[0], a[1]); w.y = cvt_pk_bf16(a[2], a[3]); w.z = cvt_pk_bf16(b[0], b[1]); w.w = cvt_pk_bf16(b[2], b[3]); return w; }
__device__ __forceinline__ unsigned pk4_fp8(float a, float b, float c, float d) { int w = __builtin_amdgcn_cvt_pk_fp8_f32(a, b, 0, false); w = __builtin_amdgcn_cvt_pk_fp8_f32(c, d, w, true); return (unsigned)w; }
constexpr float RMS_EPS = 1e-6f;
constexpr float LOG2E = 1.4426950408889634f;
constexpr float C2 = 0.125f * LOG2E;
__device__ __forceinline__ float row_ss(const float* ss, int nparts, int row) {
    if (nparts == 1) return ss[row];
    const f32x4* p = (const f32x4*)(ss + (size_t)row * 16); f32x4 a = p[0], b = p[1], c = p[2], d = p[3]; a = (a + b) + (c + d); return (a[0] + a[1]) + (a[2] + a[3]);
}

struct EpiProj {
    static constexpr bool PERM = true, AFTER_DRAIN = false;
    bf16_t* O; int ldc; const float* ss; int nparts; const float* gq; const float* gk; const float* rope; int layer; float pre;
    __device__ __forceinline__ void operator()(const f32x4 (&acc)[2][2][4][2], const Unit& u, int wr, int wc, int fr, int fq) const {
        const int pn = u.pn; int kind = 0; float scale = 1.f; bool rope_on = false;
        if (layer == 0) { const int t = pn >> 1; if (t == 0) scale = C2; else if (t == 3) { kind = 1; scale = C2; rope_on = true; } else if (t == 4) { kind = 2; rope_on = true; } }
        else { const int t = pn >> 2; if (t == 0) { kind = 1; scale = C2; } else if (t == 1) kind = 2; }
        const float* gv = (kind == 1) ? gq : gk;
        f32x4 g[2][2];
#pragma unroll
        for (int bj = 0; bj < 2; ++bj)
#pragma unroll
            for (int n = 0; n < 2; ++n) g[bj][n] = kind ? *(const f32x4*)(gv + 32 * bj + 8 * fq + 4 * n) : (f32x4){1.f, 1.f, 1.f, 1.f};
        const int row0 = u.pm * BM + wr * 64 + fr, col0 = pn * BM + wc * 64 + 8 * fq;
#pragma unroll
        for (int ai = 0; ai < 2; ++ai)
#pragma unroll
            for (int m = 0; m < 4; ++m) {
                const int row = row0 + ai * HALF + m * 16;
                const float r = rsqrtf(row_ss(ss, nparts, row) * (1.f / 1024.f) + RMS_EPS) * pre;
                f32x4 v[2][2]; float s = 0.f;
#pragma unroll
                for (int bj = 0; bj < 2; ++bj)
#pragma unroll
                    for (int n = 0; n < 2; ++n) { v[bj][n] = acc[ai][bj][m][n] * r; const f32x4 x = v[bj][n]; s += (x[0] * x[0] + x[1] * x[1]) + (x[2] * x[2] + x[3] * x[3]); }
                if (kind) {
                    s += __shfl_xor(s, 16); s += __shfl_xor(s, 32);
                    const float rs = rsqrtf(s * (1.f / 64.f) + RMS_EPS);
#pragma unroll
                    for (int bj = 0; bj < 2; ++bj)
#pragma unroll
                        for (int n = 0; n < 2; ++n) v[bj][n] = v[bj][n] * rs * g[bj][n];
                    if (rope_on) {
                        f32x4 p[2];
#pragma unroll
                        for (int n = 0; n < 2; ++n)
#pragma unroll
                            for (int j = 0; j < 4; ++j) p[n][j] = __shfl_xor(v[0][n][j], 16);
                        const f32x4 c0 = *(const f32x4*)(rope + (size_t)row * 16), c1 = *(const f32x4*)(rope + (size_t)row * 16 + 4);
                        const f32x4 s0 = *(const f32x4*)(rope + (size_t)row * 16 + 8), s1 = *(const f32x4*)(rope + (size_t)row * 16 + 12);
                        if (fq == 0) { v[0][0] = v[0][0] * c0 - p[0] * s0; v[0][1] = v[0][1] * c1 - p[1] * s1; }
                        else if (fq == 1) { v[0][0] = v[0][0] * c0 + p[0] * s0; v[0][1] = v[0][1] * c1 + p[1] * s1; }
                    }
                }
                bf16_t* rowp = O + ((size_t)(pn * 4 + wc) * ldc + row) * 64 + 8 * fq;
#pragma unroll
                for (int bj = 0; bj < 2; ++bj) *(u32x4*)(rowp + 32 * bj) = pack8(v[bj][0] * scale, v[bj][1] * scale);
            }
    }
};

struct EpiResid {
    static constexpr bool PERM = true, AFTER_DRAIN = false;
    const float* base; float* out; bf16_t* xb; float* ss; float pre; unsigned char* x8;
    __device__ __forceinline__ void operator()(const f32x4 (&acc)[2][2][4][2], const Unit& u, int wr, int wc, int fr, int fq) const {
        const int row0 = u.pm * BM + wr * 64 + fr, col0 = u.pn * BM + wc * 32 + 8 * fq;
#pragma unroll
        for (int ai = 0; ai < 2; ++ai)
#pragma unroll
            for (int m = 0; m < 4; ++m) {
                const int row = row0 + ai * HALF + m * 16; float s = 0.f;
#pragma unroll
                for (int bj = 0; bj < 2; ++bj) {
                    const size_t off = (size_t)row * 1024 + col0 + bj * HALF;
                    const f32x4 v0 = acc[ai][bj][m][0] * pre + *(const f32x4*)(base + off), v1 = acc[ai][bj][m][1] * pre + *(const f32x4*)(base + off + 4);
                    *(f32x4*)(out + off) = v0; *(f32x4*)(out + off + 4) = v1;
                    if (xb) *(u32x4*)(xb + off) = pack8(v0, v1);
                    if (x8) { typedef unsigned u32x2 __attribute__((ext_vector_type(2))); u32x2 w8; w8.x = pk4_fp8(v0[0], v0[1], v0[2], v0[3]); w8.y = pk4_fp8(v1[0], v1[1], v1[2], v1[3]); *(u32x2*)(x8 + off) = w8; }
                    s += (v0[0] * v0[0] + v0[1] * v0[1]) + (v0[2] * v0[2] + v0[3] * v0[3]) + (v1[0] * v1[0] + v1[1] * v1[1]) + (v1[2] * v1[2] + v1[3] * v1[3]);
                }
                if (ss) { s += __shfl_xor(s, 16); s += __shfl_xor(s, 32); if (fq == 0) ss[(size_t)row * 16 + u.pn * 4 + wc] = s; }
            }
    }
};

template <bool OUT8> struct EpiSwiglu {
    static constexpr bool PERM = true, AFTER_DRAIN = false;
    void* O; int ldc; const float* ss; int nparts; const float* rowscale; int tile0; int npn; float pre;
    __device__ __forceinline__ void operator()(const f32x4 (&acc)[2][2][4][2], const Unit& u, int wr, int wc, int fr, int fq) const {
        const int pnl = u.pn % npn; const int row0 = u.pm * BM + wr * 64 + fr, col0 = pnl * HALF + wc * 32 + 8 * fq;
#pragma unroll
        for (int ai = 0; ai < 2; ++ai)
#pragma unroll
            for (int m = 0; m < 4; ++m) {
                const int row = row0 + ai * HALF + m * 16;
                const float r = rowscale ? rowscale[tile0 * BM + row] * pre : rsqrtf(row_ss(ss, nparts, row) * (1.f / 1024.f) + RMS_EPS) * pre;
                f32x4 a[2]; const float rl = -r * LOG2E, r2 = r * r;
#pragma unroll
                for (int n = 0; n < 2; ++n) { const f32x4 gq = acc[ai][0][m][n], t = gq * rl; f32x4 d;
#pragma unroll
                    for (int j = 0; j < 4; ++j) d[j] = __builtin_amdgcn_rcpf(1.f + __builtin_amdgcn_exp2f(t[j]));
                    a[n] = ((gq * acc[ai][1][m][n]) * r2) * d; }
                if constexpr (OUT8) { typedef unsigned u32x2 __attribute__((ext_vector_type(2))); u32x2 w; w.x = pk4_fp8(a[0][0], a[0][1], a[0][2], a[0][3]); w.y = pk4_fp8(a[1][0], a[1][1], a[1][2], a[1][3]); *(u32x2*)((unsigned char*)O + (size_t)row * ldc + col0) = w; }
                else *(u32x4*)((bf16_t*)O + (size_t)row * ldc + col0) = pack8(a[0], a[1]);
            }
    }
};

struct EpiMoeDown {
    static constexpr bool PERM = true, AFTER_DRAIN = false;
    float* out; const int* rowtok; const float* rowgate; int tile0; float pre; int nostore;
    __device__ __forceinline__ void operator()(const f32x4 (&acc)[2][2][4][2], const Unit& u, int wr, int wc, int fr, int fq) const {
        const int pnl = u.pn & 3; const int row0 = (tile0 + u.pm) * BM + wr * 64 + fr, col0 = pnl * BM + wc * 32 + 8 * fq;
#pragma unroll
        for (int ai = 0; ai < 2; ++ai)
#pragma unroll
            for (int m = 0; m < 4; ++m) {
                const int srow = row0 + ai * HALF + m * 16; const int tok = nostore ? -1 : rowtok[srow];
                if (tok >= 0) { const float gt = rowgate[srow] * pre;
#pragma unroll
                    for (int bj = 0; bj < 2; ++bj)
#pragma unroll
                        for (int n = 0; n < 2; ++n) { f32x4* p = (f32x4*)(out + (size_t)tok * 1024 + col0 + bj * HALF + 4 * n); *p = *p + acc[ai][bj][m][n] * gt; } }
            }
    }
};

typedef int i32x4 __attribute__((ext_vector_type(4)));
typedef int i32x8 __attribute__((ext_vector_type(8)));
template <class Epi, class Sched, bool ALIGN_EPI = false, bool SP2 = false, bool F8 = false>
__device__ __forceinline__ void gemm_phase(PG8_LAS unsigned char* lds, const Gemm g, const Sched& S, const Epi& E) {
    const int tid = threadIdx.x, wid = __builtin_amdgcn_readfirstlane(tid >> 6), lane = tid & 63, wr = wid >> 2, wc = wid & 3, fr = lane & 15, fq = lane >> 4;
    const int K = g.K, nt = K / BK;
    unsigned voffA[2], voffB[2];
#pragma unroll
    for (int i = 0; i < 2; ++i) { int R, C; stage_rc(tid * 16 + i * 8192, R, C); const int Rb = Epi::PERM ? ((R & ~31) + perm32(R & 31)) : R;
        voffA[i] = (unsigned)(R * K + C) * 2u; voffB[i] = (unsigned)(Rb * K + C) * 2u; }
    const size_t kstep = (size_t)(BK * 2);
    const size_t hstep = (size_t)HALF * K * 2;
    const size_t tstep = 2 * hstep;
    const unsigned ldsw = (unsigned)wid * 1024u;
    const int aoff = lds_byte(wr * 64 + fr, fq * 8), boff = lds_byte(wc * 32 + fr, fq * 8);
#define PG8_SA(b, h) (((b) * 2 + (h)) * HTB)
#define PG8_SB(b, h) ((4 + (b) * 2 + (h)) * HTB)
#define PG8_STAGE(bufoff, gbase, voff) do { _Pragma("unroll") for (int _i = 0; _i < 2; ++_i) \
        __builtin_amdgcn_global_load_lds((const unsigned*)((const char*)(gbase) + (voff)[_i]), (PG8_LAS unsigned*)(lds + (bufoff) + ldsw + _i * 8192), 16, 0, 0); } while (0)
#define PG8_LDA(dst, b, h) do { if constexpr (F8) { _Pragma("unroll") for (int m = 0; m < 4; ++m) dst##8[m] = PG8_CAT(*(const PG8_LAS bf16x8*)(lds + PG8_SA(b, h) + aoff + m * 2048), *(const PG8_LAS bf16x8*)(lds + PG8_SA(b, h) + aoff + m * 2048 + 1024)); } \
        else { _Pragma("unroll") for (int m = 0; m < 4; ++m) _Pragma("unroll") for (int k = 0; k < 2; ++k) dst[m][k] = *(const PG8_LAS bf16x8*)(lds + PG8_SA(b, h) + aoff + m * 2048 + k * 1024); } } while (0)
#define PG8_LDB(dst, b, h) do { if constexpr (F8) { _Pragma("unroll") for (int n = 0; n < 2; ++n) dst##8[n] = PG8_CAT(*(const PG8_LAS bf16x8*)(lds + PG8_SB(b, h) + boff + n * 2048), *(const PG8_LAS bf16x8*)(lds + PG8_SB(b, h) + boff + n * 2048 + 1024)); } \
        else { _Pragma("unroll") for (int n = 0; n < 2; ++n) _Pragma("unroll") for (int k = 0; k < 2; ++k) dst[n][k] = *(const PG8_LAS bf16x8*)(lds + PG8_SB(b, h) + boff + n * 2048 + k * 1024); } } while (0)
#define PG8_CAT(x, y) __builtin_shufflevector(__builtin_bit_cast(i32x4, (x)), __builtin_bit_cast(i32x4, (y)), 0, 1, 2, 3, 4, 5, 6, 7)
#define PG8_MMA(ai, bj, At, Bt) do { __builtin_amdgcn_s_setprio(1); _Pragma("unroll") for (int m = 0; m < 4; ++m) _Pragma("unroll") for (int n = 0; n < 2; ++n) { \
        if constexpr (F8) { asm volatile("v_mfma_f32_16x16x128_f8f6f4 %0, %1, %2, %0" : "+v"(acc[ai][bj][m][n]) : "v"(Bt##8[n]), "v"(At##8[m])); } \
        else { _Pragma("unroll") for (int k = 0; k < 2; ++k) acc[ai][bj][m][n] = __builtin_amdgcn_mfma_f32_16x16x32_bf16(Bt[n][k], At[m][k], acc[ai][bj][m][n], 0, 0, 0); } } __builtin_amdgcn_s_setprio(0); } while (0)
#define PG8_WAIT_V(n) asm volatile("s_waitcnt vmcnt(" #n ")" ::: "memory")
#define PG8_WAIT_L(n) asm volatile("s_waitcnt lgkmcnt(" #n ")" ::: "memory")
#define PG8_BAR __builtin_amdgcn_s_barrier()
#define PG8_SCHED __builtin_amdgcn_sched_barrier(0)
    Unit cur, nxt; int ui = 0;
    if (!S.next(0, cur)) return;
    f32x4 acc[2][2][4][2];
#pragma unroll
    for (int a = 0; a < 2; ++a)
#pragma unroll
        for (int b = 0; b < 2; ++b)
#pragma unroll
            for (int m = 0; m < 4; ++m)
#pragma unroll
                for (int n = 0; n < 2; ++n) acc[a][b][m][n] = (f32x4){0.f, 0.f, 0.f, 0.f};
    bf16x8 At[4][2], B0[2][2], B1[2][2];
    i32x8 At8[4], B08[2], B18[2];
    const char* cA = (const char*)g.A + (size_t)cur.pm * tstep; const char* cB = (const char*)g.Bt + (size_t)cur.pn * tstep;
    S.a_ready(cur);
    if constexpr (SP2) {
        PG8_STAGE(PG8_SB(0, 0), cB, voffB); PG8_STAGE(PG8_SB(0, 1), cB + hstep, voffB); PG8_STAGE(PG8_SA(0, 0), cA, voffA); PG8_STAGE(PG8_SA(0, 1), cA + hstep, voffA);
        if (wr == 1) PG8_BAR;
        PG8_WAIT_V(2); PG8_BAR;
        PG8_STAGE(PG8_SB(1, 0), cB + kstep, voffB); PG8_STAGE(PG8_SA(1, 0), cA + kstep, voffA); PG8_STAGE(PG8_SB(1, 1), cB + hstep + kstep, voffB);
        PG8_WAIT_V(6); PG8_BAR;
    } else {
        PG8_STAGE(PG8_SB(0, 0), cB, voffB); PG8_STAGE(PG8_SA(0, 0), cA, voffA); PG8_STAGE(PG8_SB(0, 1), cB + hstep, voffB); PG8_STAGE(PG8_SA(0, 1), cA + hstep, voffA);
        if (wr == 1) PG8_BAR;
        PG8_WAIT_V(4); PG8_BAR;
        PG8_STAGE(PG8_SB(1, 0), cB + kstep, voffB); PG8_STAGE(PG8_SA(1, 0), cA + kstep, voffA); PG8_STAGE(PG8_SB(1, 1), cB + hstep + kstep, voffB);
        PG8_WAIT_V(6); PG8_BAR;
    }
    for (;;) {
        const bool has_next = S.next(ui + 1, nxt);
        const char* nA = has_next ? (const char*)g.A + (size_t)nxt.pm * tstep : cA; const char* nB = has_next ? (const char*)g.Bt + (size_t)nxt.pn * tstep : cB;
#pragma nounroll
        for (int t = 0; t < nt; t += 2) {
            const bool last = (t == nt - 2);
            const char* a1 = cA + (size_t)(t + 1) * kstep;
            const char* a2 = last ? nA : cA + (size_t)(t + 2) * kstep; const char* b2 = last ? nB : cB + (size_t)(t + 2) * kstep;
            const char* a3 = a2 + kstep; const char* b3 = b2 + kstep;
            if (last && has_next) S.a_ready(nxt);
            if constexpr (SP2) {
            PG8_LDB(B0, 0, 0); PG8_LDB(B1, 0, 1); PG8_SCHED; PG8_LDA(At, 0, 0); PG8_STAGE(PG8_SA(1, 1), a1 + hstep, voffA);
            PG8_WAIT_V(8); PG8_WAIT_L(0); PG8_BAR; PG8_MMA(0, 0, At, B0); PG8_MMA(0, 1, At, B1); PG8_BAR; PG8_SCHED;
            PG8_LDA(At, 0, 1); PG8_STAGE(PG8_SB(0, 0), b2, voffB); PG8_STAGE(PG8_SB(0, 1), b2 + hstep, voffB); PG8_STAGE(PG8_SA(0, 0), a2, voffA);
            PG8_WAIT_V(8); PG8_WAIT_L(0); PG8_BAR; PG8_MMA(1, 0, At, B0); PG8_MMA(1, 1, At, B1); PG8_BAR; PG8_SCHED;
            PG8_LDB(B0, 1, 0); PG8_LDB(B1, 1, 1); PG8_SCHED; PG8_LDA(At, 1, 0); PG8_STAGE(PG8_SA(0, 1), a2 + hstep, voffA);
            PG8_WAIT_V(8); PG8_WAIT_L(0); PG8_BAR; PG8_MMA(0, 0, At, B0); PG8_MMA(0, 1, At, B1); PG8_BAR; PG8_SCHED;
            PG8_LDA(At, 1, 1); PG8_STAGE(PG8_SB(1, 0), b3, voffB); PG8_STAGE(PG8_SB(1, 1), b3 + hstep, voffB); PG8_STAGE(PG8_SA(1, 0), a3, voffA);
            PG8_WAIT_V(8); PG8_WAIT_L(0); PG8_BAR; PG8_MMA(1, 0, At, B0); PG8_MMA(1, 1, At, B1); PG8_BAR; PG8_SCHED;
            } else {
            PG8_LDB(B0, 0, 0); PG8_SCHED; PG8_LDA(At, 0, 0); PG8_STAGE(PG8_SA(1, 1), a1 + hstep, voffA);
            PG8_WAIT_L(8); PG8_BAR; PG8_WAIT_L(0); PG8_MMA(0, 0, At, B0); PG8_BAR; PG8_SCHED;
            PG8_LDB(B1, 0, 1); PG8_STAGE(PG8_SB(0, 0), b2, voffB);
            PG8_BAR; PG8_WAIT_L(0); PG8_MMA(0, 1, At, B1); PG8_BAR;
            PG8_LDA(At, 0, 1); PG8_STAGE(PG8_SA(0, 0), a2, voffA);
            PG8_BAR; PG8_WAIT_L(0); PG8_MMA(1, 0, At, B0); PG8_BAR; PG8_SCHED;
            PG8_STAGE(PG8_SB(0, 1), b2 + hstep, voffB);
            PG8_WAIT_V(6); PG8_BAR; PG8_MMA(1, 1, At, B1); PG8_BAR;
            PG8_LDB(B0, 1, 0); PG8_SCHED; PG8_LDA(At, 1, 0); PG8_STAGE(PG8_SA(0, 1), a2 + hstep, voffA);
            PG8_WAIT_L(8); PG8_BAR; PG8_WAIT_L(0); PG8_MMA(0, 0, At, B0); PG8_BAR; PG8_SCHED;
            PG8_LDB(B1, 1, 1); PG8_STAGE(PG8_SB(1, 0), b3, voffB);
            PG8_BAR; PG8_WAIT_L(0); PG8_MMA(0, 1, At, B1); PG8_BAR;
            PG8_LDA(At, 1, 1); PG8_STAGE(PG8_SA(1, 0), a3, voffA);
            PG8_BAR; PG8_WAIT_L(0); PG8_MMA(1, 0, At, B0); PG8_BAR; PG8_SCHED;
            PG8_STAGE(PG8_SB(1, 1), b3 + hstep, voffB);
            PG8_WAIT_V(6); PG8_BAR; PG8_MMA(1, 1, At, B1); PG8_BAR;
            }
        }
        if constexpr (F8) asm volatile("s_nop 15\n\ts_nop 15\n\ts_nop 15" ::: "memory");
        if constexpr (ALIGN_EPI) { if (wr == 0) PG8_BAR; }
        if constexpr (!Epi::AFTER_DRAIN) { E(acc, cur, wr, wc, fr, fq); S.done(cur); }
        if (!has_next) break;
#pragma unroll
        for (int a = 0; a < 2; ++a)
#pragma unroll
            for (int b = 0; b < 2; ++b)
#pragma unroll
                for (int m = 0; m < 4; ++m)
#pragma unroll
                    for (int n = 0; n < 2; ++n) acc[a][b][m][n] = (f32x4){0.f, 0.f, 0.f, 0.f};
        cur = nxt; cA = nA; cB = nB; ++ui;
        if constexpr (ALIGN_EPI) { if (wr == 1) PG8_BAR; }
    }
    PG8_WAIT_V(0);
    if constexpr (!ALIGN_EPI) { if (wr == 0) PG8_BAR; }
    PG8_BAR;
    if constexpr (Epi::AFTER_DRAIN) { E.fused(acc, cur, wr, wc, fr, fq, lds, wid, lane); S.done(cur); }
#undef PG8_SA
#undef PG8_SB
#undef PG8_STAGE
#undef PG8_LDA
#undef PG8_LDB
#undef PG8_MMA
#undef PG8_CAT
#undef PG8_WAIT_V
#undef PG8_WAIT_L
#undef PG8_BAR
#undef PG8_SCHED
}
}

namespace att {
using pg8::bf16_t; using pg8::bf16x8; using pg8::u32x4;
typedef float f32x16 __attribute__((ext_vector_type(16)));
typedef short s16x4 __attribute__((ext_vector_type(4)));
typedef float f32x2_t __attribute__((ext_vector_type(2))); typedef __bf16 bf16x2_t __attribute__((ext_vector_type(2)));
#define ALAS __attribute__((address_space(3)))
typedef ALAS const char* lds_cptr;
constexpr int SEQ = 8192, PITCH = 64, VNEXT = 2 * SEQ * 64;
constexpr int KVSLOT = 24576;
constexpr int L_WS = 114688, L_TAB = L_WS + 2048, L_FLAG = L_TAB + 1056, L_END = L_FLAG + 128, L_OST = 0;
constexpr float SB_THR = 152.f;
__device__ __forceinline__ int crow(int r, int hi) { return (r & 3) + 8 * (r >> 2) + 4 * hi; }
__device__ __forceinline__ void glds16(const void* gsrc, unsigned lds_dst) { unsigned keep;
    asm volatile("s_mov_b32 %0, m0\n\ts_mov_b32 m0, %2\n\ts_nop 0\n\tglobal_load_lds_dwordx4 %1, off\n\ts_mov_b32 m0, %0" : "=&s"(keep) : "v"(gsrc), "s"(lds_dst) : "memory"); }
__device__ __forceinline__ unsigned cvtpk(float lo, float hi) { f32x2_t v = {lo, hi}; bf16x2_t b = __builtin_convertvector(v, bf16x2_t); return __builtin_bit_cast(unsigned, b); }
__device__ __forceinline__ unsigned short f2bf(float f) { unsigned u = __builtin_bit_cast(unsigned, f); return (unsigned short)((u + 0x7fffu + ((u >> 16) & 1u)) >> 16); }
#define MFMA32(a, b, c) __builtin_amdgcn_mfma_f32_32x32x16_bf16((a), (b), (c), 0, 0, 0)

__device__ __forceinline__ void qkt(f32x16& p0, f32x16& p1, lds_cptr kb, const bf16x8* qr, const f32x16& cin) {
#pragma unroll
    for (int d0 = 0; d0 < 4; ++d0) {
        const bf16x8 b0 = *(const ALAS bf16x8*)(kb + d0 * 2048);
        const bf16x8 b1 = *(const ALAS bf16x8*)(kb + d0 * 2048 + 512);
        if (d0 == 0) { p0 = MFMA32(b0, qr[0], cin); p1 = MFMA32(b1, qr[0], cin); }
        else { p0 = MFMA32(b0, qr[d0], p0); p1 = MFMA32(b1, qr[d0], p1); }
    }
}

__device__ __forceinline__ void qkt_sw(f32x16& p0, f32x16& p1, lds_cptr ks, const int (&kofs)[4], const bf16x8* qr, const f32x16& cin) {
    bf16x8 kf[8];
#pragma unroll
    for (int d0 = 0; d0 < 4; ++d0) { kf[2 * d0] = *(const ALAS bf16x8*)(ks + kofs[d0]); kf[2 * d0 + 1] = *(const ALAS bf16x8*)(ks + kofs[d0] + 4096); }
    p0 = MFMA32(kf[0], qr[0], cin); p1 = MFMA32(kf[1], qr[0], cin);
#pragma unroll
    for (int d0 = 1; d0 < 4; ++d0) { p0 = MFMA32(kf[2 * d0], qr[d0], p0); p1 = MFMA32(kf[2 * d0 + 1], qr[d0], p1); }
}
template <int ND> __device__ __forceinline__ void pv(f32x16* o, int vb, bf16x8 pa0, bf16x8 pa1, bf16x8 pa2, bf16x8 pa3) {
#pragma unroll
    for (int d0 = 0; d0 < ND; ++d0) { s16x4 lo[4], hi[4];
#pragma unroll
        for (int ks = 0; ks < 4; ++ks) {
            asm volatile("ds_read_b64_tr_b16 %0,%1 offset:%c2" : "=&v"(lo[ks]) : "v"(vb), "i"(d0 * 4096 + ks * 1024) : "memory");
            asm volatile("ds_read_b64_tr_b16 %0,%1 offset:%c2" : "=&v"(hi[ks]) : "v"(vb), "i"(d0 * 4096 + ks * 1024 + 512) : "memory"); }
        asm volatile("s_waitcnt lgkmcnt(0)" ::: "memory"); __builtin_amdgcn_sched_barrier(0);
#define ATT_PK(k) (bf16x8){lo[k][0], lo[k][1], lo[k][2], lo[k][3], hi[k][0], hi[k][1], hi[k][2], hi[k][3]}
        o[d0] = MFMA32(pa0, ATT_PK(0), o[d0]);
        o[d0] = MFMA32(pa1, ATT_PK(1), o[d0]);
        o[d0] = MFMA32(pa2, ATT_PK(2), o[d0]);
        o[d0] = MFMA32(pa3, ATT_PK(3), o[d0]);
#undef ATT_PK
    }
}

template <int MODE, int VD, bool OUT8 = false, int TPB = 1>
__device__ __forceinline__ void attn_unit(ALAS char* shm, const bf16_t* Qb, const bf16_t* Kb, const bf16_t* Vb, void* Ob, int opitch, int q0, float mref2, const float* tab, float oscale = 1.f, int dbg = 0) {
    constexpr int ND = VD / 32, SLOT = 8192 + VD * 128;
    static_assert(2 * TPB * SLOT <= L_WS, "ring vs LDS map");
    const int tid = threadIdx.x, lane = tid & 63, r32 = lane & 31, hi = lane >> 5; const int wid = __builtin_amdgcn_readfirstlane(tid >> 6);
    const unsigned lds0 = (unsigned)(uintptr_t)shm;
    ALAS float* wsf = (ALAS float*)(shm + L_WS) + wid * 64;
    ALAS float* tabL = (ALAS float*)(shm + L_TAB);
    ALAS unsigned* flg = (ALAS unsigned*)(shm + L_FLAG);
    if (MODE == 1) { for (int i = tid; i < 257; i += 512) tabL[i] = tab[i] * pg8::LOG2E; }
    const bf16_t* Qw = Qb + (size_t)(q0 + wid * 32) * PITCH;
    bf16x8 qr[4];
#pragma unroll
    for (int d0 = 0; d0 < 4; ++d0) qr[d0] = *(const bf16x8*)(Qw + (size_t)r32 * PITCH + d0 * 16 + hi * 8);
    int t_first, n_t, t_step;
    if (MODE == 0) { t_first = 0; n_t = q0 / 64 + 4; t_step = 1; }
    else if (MODE == 1) { const int c0 = q0 / 64; t_first = c0 - 8 > 0 ? c0 - 8 : 0; n_t = c0 + 4 - t_first; t_step = 1; }
    else { t_first = q0 / 64 + 3; n_t = q0 / 64 + 4; t_step = -1; }
    const int krow = 8 * wid + (lane >> 3);
    const bf16_t* ksrc = Kb + (size_t)krow * PITCH + (((lane & 7) ^ ((krow >> 1) & 7)) * 8);
    int kofs[4];
#pragma unroll
    for (int d0 = 0; d0 < 4; ++d0) kofs[d0] = (r32 >> 3) * 1024 + ((r32 & 7) * 8 + ((2 * d0 + hi) ^ ((r32 >> 1) & 7))) * 16;
    const bf16_t* vsrc = Vb + (size_t)(16 * (wid & 3) + (lane >> 2)) * PITCH + (wid >> 2) * 32 + (lane & 3) * 8;
#define ATT_DMA(t, slot) do { if (dbg & 64) break; const size_t to_ = (size_t)(t) * 64 * PITCH; const unsigned sb_ = lds0 + (unsigned)(slot) * SLOT; \
        glds16(ksrc + to_, (unsigned)__builtin_amdgcn_readfirstlane(sb_ + wid * 1024)); \
        glds16(vsrc + to_, (unsigned)__builtin_amdgcn_readfirstlane(sb_ + 8192 + wid * 1024)); \
        if (VD == 128) glds16(vsrc + to_ + VNEXT, (unsigned)__builtin_amdgcn_readfirstlane(sb_ + 8192 + (wid + 8) * 1024)); } while (0)
    f32x16 o[ND];
#pragma unroll
    for (int d = 0; d < ND; ++d) o[d] = f32x16{};
    f32x16 cin;
#pragma unroll
    for (int r = 0; r < 16; ++r) cin[r] = (MODE == 2) ? 0.f : -mref2;
    float l_reg = 0.f, A = 0.f; bool wdone = false;
    const int wrow0 = q0 + wid * 32, qrow = wrow0 + r32;
    const int vb0 = (int)lds0 + 8192 + ((lane >> 4) & 1) * 32 + (lane & 3) * 8 + (4 * hi + ((lane & 15) >> 2)) * 64;
    asm volatile("s_waitcnt vmcnt(0)" ::: "memory"); asm volatile("" : "+v"(qr[0]), "+v"(qr[1]), "+v"(qr[2]), "+v"(qr[3]));
#pragma unroll
    for (int u = 0; u < TPB; ++u) ATT_DMA(t_first + u * t_step, u);
    for (int i = 0; i < n_t; ++i) {
        const int t = t_first + i * t_step, slot = i % (2 * TPB);
        if (i % TPB == 0) {
        asm volatile("s_waitcnt vmcnt(0) lgkmcnt(0)\n\ts_barrier" ::: "memory");
        if (MODE == 2 && i > 0) { const int par = ((i - 1) & 3) * 8; unsigned all = 1u;
#pragma unroll
            for (int w = 0; w < 8; ++w) all &= flg[par + w];
            if (__builtin_amdgcn_readfirstlane(all)) break; }
        if (i + TPB < n_t) {
#pragma unroll
            for (int u = 0; u < TPB; ++u) ATT_DMA(t + (TPB + u) * t_step, (i + TPB + u) % (2 * TPB)); }
        }
        bool active;
        if (MODE == 0) active = (64 * t <= wrow0);
        else if (MODE == 1) { const int cw = wrow0 / 64; active = (t >= cw - 8) && (t <= cw); }
        else active = !wdone && (64 * t < wrow0 + 31);
        if (active && !(dbg & 32)) {
            f32x16 p0, p1; qkt_sw(p0, p1, (lds_cptr)shm + slot * SLOT, kofs, qr, cin);
            if (MODE == 0) {
#pragma unroll
                for (int r = 0; r < 16; ++r) { p0[r] = __builtin_amdgcn_exp2f(p0[r]); p1[r] = __builtin_amdgcn_exp2f(p1[r]); }
            } else if (MODE == 1) {
                const int cw = wrow0 / 64;
                if (t <= cw - 3) { const float cb = tabL[256];
#pragma unroll
                    for (int r = 0; r < 16; ++r) { p0[r] = __builtin_amdgcn_exp2f(p0[r] + cb); p1[r] = __builtin_amdgcn_exp2f(p1[r] + cb); }
                } else { const int dq = qrow - 64 * t - 4 * hi;
#pragma unroll
                    for (int r = 0; r < 16; ++r) { int d0 = dq - ((r & 3) + 8 * (r >> 2)), d1 = d0 - 32;
                        d0 = d0 < -128 ? -128 : (d0 > 128 ? 128 : d0); d1 = d1 < -128 ? -128 : (d1 > 128 ? 128 : d1);
                        p0[r] = __builtin_amdgcn_exp2f(p0[r] + tabL[d0 + 128]); p1[r] = __builtin_amdgcn_exp2f(p1[r] + tabL[d1 + 128]); }
                }
            } else {
                const bool needmask = (64 * t + 63 >= wrow0);
                const int kq = qrow - 64 * t - 4 * hi;
                float g[8];
#pragma unroll
                for (int k = 0; k < 8; ++k) g[k] = 0.f;
                f32x16 s0, s1;
#pragma unroll
                for (int r = 0; r < 16; ++r) { const int kv = (r & 3) + 8 * (r >> 2);
                    { const float y = p0[r], a = __builtin_fabsf(y); float sp = __builtin_fmaxf(y, 0.f) + __builtin_amdgcn_logf(1.f + __builtin_amdgcn_exp2f(-a)); if (needmask && !(kv < kq)) sp = 0.f; s0[r] = sp; g[r >> 2] += sp; }
                    { const float y = p1[r], a = __builtin_fabsf(y); float sp = __builtin_fmaxf(y, 0.f) + __builtin_amdgcn_logf(1.f + __builtin_amdgcn_exp2f(-a)); if (needmask && !(kv + 32 < kq)) sp = 0.f; s1[r] = sp; g[4 + (r >> 2)] += sp; } }
                float pg[8];
#pragma unroll
                for (int k = 0; k < 8; ++k) pg[k] = __shfl_xor(g[k], 32);
                float base[8]; float own = 0.f, par = 0.f;
#pragma unroll
                for (int k = 7; k >= 0; --k) { const float par_incl = par + pg[k]; base[k] = A + own + (hi == 0 ? par_incl : par); own += g[k]; par = par_incl; }
                A += own + par;
#pragma unroll
                for (int k = 0; k < 4; ++k) {
                    { float c = base[k]; c += s0[4 * k + 3]; const float w3 = __builtin_amdgcn_exp2f(p0[4 * k + 3] - c); c += s0[4 * k + 2]; const float w2 = __builtin_amdgcn_exp2f(p0[4 * k + 2] - c);
                      c += s0[4 * k + 1]; const float w1 = __builtin_amdgcn_exp2f(p0[4 * k + 1] - c); c += s0[4 * k]; const float w0 = __builtin_amdgcn_exp2f(p0[4 * k] - c);
                      p0[4 * k] = w0; p0[4 * k + 1] = w1; p0[4 * k + 2] = w2; p0[4 * k + 3] = w3; }
                    { float c = base[4 + k]; c += s1[4 * k + 3]; const float w3 = __builtin_amdgcn_exp2f(p1[4 * k + 3] - c); c += s1[4 * k + 2]; const float w2 = __builtin_amdgcn_exp2f(p1[4 * k + 2] - c);
                      c += s1[4 * k + 1]; const float w1 = __builtin_amdgcn_exp2f(p1[4 * k + 1] - c); c += s1[4 * k]; const float w0 = __builtin_amdgcn_exp2f(p1[4 * k] - c);
                      p1[4 * k] = w0; p1[4 * k + 1] = w1; p1[4 * k + 2] = w2; p1[4 * k + 3] = w3; }
                }
                if (needmask) {
#pragma unroll
                    for (int r = 0; r < 16; ++r) { const int kv = (r & 3) + 8 * (r >> 2); if (!(kv < kq)) p0[r] = 0.f; if (!(kv + 32 < kq)) p1[r] = 0.f; }
                }
                wdone = __all(A >= SB_THR);
            }
            if (MODE != 2) { float s = 0.f;
#pragma unroll
                for (int r = 0; r < 16; ++r) s += p0[r] + p1[r];
                l_reg += s; }
            u32x4 pw0, pw1, pw2, pw3;
            pw0 = (u32x4){cvtpk(p0[0], p0[1]), cvtpk(p0[2], p0[3]), cvtpk(p0[4], p0[5]), cvtpk(p0[6], p0[7])};
            pw1 = (u32x4){cvtpk(p0[8], p0[9]), cvtpk(p0[10], p0[11]), cvtpk(p0[12], p0[13]), cvtpk(p0[14], p0[15])};
            pw2 = (u32x4){cvtpk(p1[0], p1[1]), cvtpk(p1[2], p1[3]), cvtpk(p1[4], p1[5]), cvtpk(p1[6], p1[7])};
            pw3 = (u32x4){cvtpk(p1[8], p1[9]), cvtpk(p1[10], p1[11]), cvtpk(p1[12], p1[13]), cvtpk(p1[14], p1[15])};
            pv<ND>(o, vb0 + slot * SLOT, __builtin_bit_cast(bf16x8, pw0), __builtin_bit_cast(bf16x8, pw1), __builtin_bit_cast(bf16x8, pw2), __builtin_bit_cast(bf16x8, pw3));
        }
        if (MODE == 2) { if (lane == 0) flg[(i & 3) * 8 + wid] = wdone ? 1u : 0u; }
    }
#undef ATT_DMA
    asm volatile("s_waitcnt vmcnt(0) lgkmcnt(0)\n\ts_barrier" ::: "memory");
    float rl[16];
    if (MODE != 2) {
        l_reg += __shfl_xor(l_reg, 32);
        if (hi == 0) wsf[32 + r32] = l_reg;
        asm volatile("s_waitcnt lgkmcnt(0)" ::: "memory");
#pragma unroll
        for (int r = 0; r < 16; ++r) rl[r] = __builtin_amdgcn_rcpf(wsf[32 + crow(r, hi)]) * oscale;
    } else {
#pragma unroll
        for (int r = 0; r < 16; ++r) rl[r] = oscale;
    }
    if constexpr (OUT8) {
        static_assert(!OUT8 || VD == 64, "fp8 output: 64-wide heads");
        unsigned char* Ow = (unsigned char*)Ob + (size_t)(q0 + wid * 32) * opitch;
        ALAS unsigned char* stg = (ALAS unsigned char*)(shm + L_OST) + wid * 2048;
#pragma unroll
        for (int r = 0; r < 16; ++r) { const int orow = crow(r, hi);
#pragma unroll
            for (int d0 = 0; d0 < 2; ++d0) { const float v = o[d0][r] * rl[r]; stg[orow * 64 + d0 * 32 + r32] = (unsigned char)(__builtin_amdgcn_cvt_pk_fp8_f32(v, v, 0, false) & 0xff); } }
        asm volatile("s_waitcnt lgkmcnt(0)" ::: "memory");
#pragma unroll
        for (int i = 0; i < 2; ++i) { const int row = i * 16 + (lane >> 2), ch = lane & 3; const u32x4 v = *(const ALAS u32x4*)(stg + row * 64 + ch * 16); *(u32x4*)(Ow + (size_t)row * opitch + ch * 16) = v; }
        asm volatile("s_waitcnt lgkmcnt(0)" ::: "memory");
    } else {
    bf16_t* Ow = (bf16_t*)Ob + (size_t)(q0 + wid * 32) * opitch;
    ALAS bf16_t* stg = (ALAS bf16_t*)(shm + L_OST) + wid * 2048;
#pragma unroll
    for (int half = 0; half < ND / 2; ++half) {
#pragma unroll
        for (int r = 0; r < 16; ++r) { const int orow = crow(r, hi);
#pragma unroll
            for (int d0 = 0; d0 < 2; ++d0) stg[orow * 64 + d0 * 32 + r32] = f2bf(o[half * 2 + d0][r] * rl[r]); }
        asm volatile("s_waitcnt lgkmcnt(0)" ::: "memory");
#pragma unroll
        for (int i = 0; i < 4; ++i) { const int row = i * 8 + (lane >> 3), ch = lane & 7; const u32x4 v = *(const ALAS u32x4*)(stg + row * 64 + ch * 8); *(u32x4*)(Ow + (size_t)row * opitch + half * 64 + ch * 8) = v; }
        asm volatile("s_waitcnt lgkmcnt(0)" ::: "memory");
    }
    }
    asm volatile("s_waitcnt vmcnt(0) lgkmcnt(0)\n\ts_barrier" ::: "memory");
}


__device__ __forceinline__ void qkt8(f32x16& p0, f32x16& p1, lds_cptr kb, const bf16x8* qr, const f32x16& cin) {
    bf16x8 kf[8];
#pragma unroll
    for (int d0 = 0; d0 < 4; ++d0) { kf[2 * d0] = *(const ALAS bf16x8*)(kb + d0 * 2048); kf[2 * d0 + 1] = *(const ALAS bf16x8*)(kb + d0 * 2048 + 512); }
    __builtin_amdgcn_sched_barrier(0);
    p0 = MFMA32(kf[0], qr[0], cin); p1 = MFMA32(kf[1], qr[0], cin);
#pragma unroll
    for (int d0 = 1; d0 < 4; ++d0) { p0 = MFMA32(kf[2 * d0], qr[d0], p0); p1 = MFMA32(kf[2 * d0 + 1], qr[d0], p1); }
}
template <int ND, int KS0> __device__ __forceinline__ void v_reads(s16x4 (&lo)[ND][2], s16x4 (&hi)[ND][2], int vb) {
#pragma unroll
    for (int ks = 0; ks < 2; ++ks)
#pragma unroll
        for (int d0 = 0; d0 < ND; ++d0) {
            asm volatile("ds_read_b64_tr_b16 %0,%1 offset:%c2" : "=&v"(lo[d0][ks]) : "v"(vb), "i"(d0 * 4096 + (KS0 + ks) * 1024) : "memory");
            asm volatile("ds_read_b64_tr_b16 %0,%1 offset:%c2" : "=&v"(hi[d0][ks]) : "v"(vb), "i"(d0 * 4096 + (KS0 + ks) * 1024 + 512) : "memory"); }
}
template <int ND> __device__ __forceinline__ void pv_half(f32x16* o, const s16x4 (&lo)[ND][2], const s16x4 (&hi)[ND][2], bf16x8 pa, bf16x8 pb) {
#define ATT_PK2(d, k) (bf16x8){lo[d][k][0], lo[d][k][1], lo[d][k][2], lo[d][k][3], hi[d][k][0], hi[d][k][1], hi[d][k][2], hi[d][k][3]}
#pragma unroll
    for (int d0 = 0; d0 < ND; ++d0) o[d0] = MFMA32(pa, ATT_PK2(d0, 0), o[d0]);
#pragma unroll
    for (int d0 = 0; d0 < ND; ++d0) o[d0] = MFMA32(pb, ATT_PK2(d0, 1), o[d0]);
#undef ATT_PK2
}
template <int MODE> __device__ __forceinline__ void p_half(f32x16& p, float& l_reg, u32x4& wa, u32x4& wb, bool const_bias, int dq, const ALAS float* tabL) {
    if (MODE == 0) {
#pragma unroll
        for (int r = 0; r < 16; ++r) p[r] = __builtin_amdgcn_exp2f(p[r]);
    } else if (const_bias) { const float cb = tabL[256];
#pragma unroll
        for (int r = 0; r < 16; ++r) p[r] = __builtin_amdgcn_exp2f(p[r] + cb);
    } else {
#pragma unroll
        for (int r = 0; r < 16; ++r) { int d = dq - ((r & 3) + 8 * (r >> 2)); d = d < -128 ? -128 : (d > 128 ? 128 : d); p[r] = __builtin_amdgcn_exp2f(p[r] + tabL[d + 128]); }
    }
    float s = 0.f;
#pragma unroll
    for (int r = 0; r < 16; ++r) s += p[r];
    l_reg += s;
    wa = (u32x4){cvtpk(p[0], p[1]), cvtpk(p[2], p[3]), cvtpk(p[4], p[5]), cvtpk(p[6], p[7])};
    wb = (u32x4){cvtpk(p[8], p[9]), cvtpk(p[10], p[11]), cvtpk(p[12], p[13]), cvtpk(p[14], p[15])};
}
__device__ __forceinline__ void vm_wait_n(int n) {
    if (n <= 0) asm volatile("s_waitcnt vmcnt(0)" ::: "memory"); else if (n == 1) asm volatile("s_waitcnt vmcnt(1)" ::: "memory"); else if (n == 2) asm volatile("s_waitcnt vmcnt(2)" ::: "memory");
    else if (n == 3) asm volatile("s_waitcnt vmcnt(3)" ::: "memory"); else if (n == 4) asm volatile("s_waitcnt vmcnt(4)" ::: "memory"); else if (n == 5) asm volatile("s_waitcnt vmcnt(5)" ::: "memory");
    else if (n == 6) asm volatile("s_waitcnt vmcnt(6)" ::: "memory"); else if (n == 7) asm volatile("s_waitcnt vmcnt(7)" ::: "memory"); else if (n == 8) asm volatile("s_waitcnt vmcnt(8)" ::: "memory");
    else if (n == 9) asm volatile("s_waitcnt vmcnt(9)" ::: "memory"); else if (n == 10) asm volatile("s_waitcnt vmcnt(10)" ::: "memory"); else asm volatile("s_waitcnt vmcnt(11)" ::: "memory");
}
template <int MODE, int VD, bool OUT8 = false, int PD = 3>
__device__ __forceinline__ void attn_unit_pp(ALAS char* shm, const bf16_t* Qb, const bf16_t* Kb, const bf16_t* Vb, void* Ob, int opitch, int q0, float mref2, const float* tab, float oscale = 1.f, int dbg = 0) {
    static_assert(MODE == 0 || MODE == 1, "ping-pong loop: softmax modes only");
    constexpr int ND = VD / 32, NV = VD / 64, NS = PD + 1, PER = 1 + NV, SLOT = 8192 + VD * 128;
    static_assert(NS * SLOT <= L_WS, "ring vs LDS map");
    const int tid = threadIdx.x, lane = tid & 63, r32 = lane & 31, hi = lane >> 5; const int wid = __builtin_amdgcn_readfirstlane(tid >> 6); const int grp = wid >> 2;
    const unsigned lds0 = (unsigned)(uintptr_t)shm;
    ALAS float* wsf = (ALAS float*)(shm + L_WS) + wid * 64;
    ALAS float* tabL = (ALAS float*)(shm + L_TAB);
    if (MODE == 1) { for (int i = tid; i < 257; i += 512) tabL[i] = tab[i] * pg8::LOG2E; }
    const bf16_t* Qw = Qb + (size_t)(q0 + wid * 32) * PITCH;
    bf16x8 qr[4];
#pragma unroll
    for (int d0 = 0; d0 < 4; ++d0) qr[d0] = *(const bf16x8*)(Qw + (size_t)r32 * PITCH + d0 * 16 + hi * 8);
    int t_first, n_t;
    if (MODE == 0) { t_first = 0; n_t = q0 / 64 + 4; }
    else { const int c0 = q0 / 64; t_first = c0 - 8 > 0 ? c0 - 8 : 0; n_t = c0 + 4 - t_first; }
    const bf16_t* ksrc = Kb + (size_t)lane * PITCH + wid * 8 + (size_t)t_first * 64 * PITCH;
    const bf16_t* vsrc = Vb + (size_t)(16 * (wid & 3) + (lane >> 2)) * PITCH + (wid >> 2) * 32 + (lane & 3) * 8 + (size_t)t_first * 64 * PITCH;
    const bf16_t* ksrc_c = Kb + (size_t)t_first * 64 * PITCH + wid * 512 + lane * 8;
    int issued = 0;
#define PP_DMA_K(i) do { if ((i) < n_t && !(dbg & 64)) { glds16(((dbg & 128) ? ksrc_c : ksrc) + (size_t)(i) * 64 * PITCH, (unsigned)__builtin_amdgcn_readfirstlane(lds0 + (unsigned)((i) % NS) * SLOT + wid * 1024)); issued += 1; } } while (0)
#define PP_DMA_V(i) do { if ((i) < n_t && !(dbg & 64)) { const unsigned sb_ = lds0 + (unsigned)((i) % NS) * SLOT + 8192; glds16(vsrc + (size_t)(i) * 64 * PITCH, (unsigned)__builtin_amdgcn_readfirstlane(sb_ + wid * 1024)); \
        if (VD == 128) glds16(vsrc + (size_t)(i) * 64 * PITCH + VNEXT, (unsigned)__builtin_amdgcn_readfirstlane(sb_ + (wid + 8) * 1024)); issued += NV; } } while (0)
#define PP_NEED_K(j) do { if (!(dbg & 256)) vm_wait_n(issued - ((j) * PER + 1)); } while (0)
#define PP_NEED_V(j) do { if (!(dbg & 256)) vm_wait_n(issued - ((j) + 1) * PER); } while (0)
#define PP_BAR() asm volatile("s_waitcnt lgkmcnt(0)\n\ts_barrier" ::: "memory")
    f32x16 o[ND];
#pragma unroll
    for (int d = 0; d < ND; ++d) o[d] = f32x16{};
    f32x16 cin;
#pragma unroll
    for (int r = 0; r < 16; ++r) cin[r] = -mref2;
    float l_reg = 0.f;
    const int wrow0 = q0 + wid * 32, qrow = wrow0 + r32, cw = wrow0 / 64;
    const int vb0 = (int)lds0 + 8192 + ((lane >> 4) & 1) * 32 + (lane & 3) * 8 + (4 * hi + ((lane & 15) >> 2)) * 64;
    asm volatile("s_waitcnt vmcnt(0)" ::: "memory"); asm volatile("" : "+v"(qr[0]), "+v"(qr[1]), "+v"(qr[2]), "+v"(qr[3]));
#pragma unroll
    for (int j = 0; j < PD; ++j) { PP_DMA_K(j); PP_DMA_V(j); }
    if (grp) PP_DMA_K(PD);
    PP_NEED_V(0);
    PP_BAR();
    if (grp) PP_BAR();
    u32x4 pw0, pw1, pw2, pw3; f32x16 p1;
    for (int i = 0; i < n_t; ++i) {
        const int t = t_first + i, slot = i % NS;
        bool active;
        if (MODE == 0) active = (t <= cw); else active = (t >= cw - 8) && (t <= cw);
        if (grp == 0) PP_DMA_K(i + PD); else PP_DMA_V(i + PD);
        if (active && !(dbg & 32)) {
            const lds_cptr kb = (lds_cptr)shm + slot * SLOT + hi * 1024 + r32 * 16;
            f32x16 p0; qkt8(p0, p1, kb, qr, cin);
            p_half<MODE>(p0, l_reg, pw0, pw1, (t <= cw - 3) || (dbg & 8), qrow - 64 * t - 4 * hi, tabL);
        }
        if (grp == 0) PP_NEED_V(i); else PP_NEED_K(i + 1);
        PP_BAR();
        if (grp == 0) PP_DMA_V(i + PD); else PP_DMA_K(i + 1 + PD);
        if (active && !(dbg & 16)) {
            const int vb = vb0 + slot * SLOT;
            s16x4 lo0[ND][2], hi0[ND][2], lo1[ND][2], hi1[ND][2];
            v_reads<ND, 0>(lo0, hi0, vb);
            asm volatile("s_waitcnt lgkmcnt(0)" ::: "memory");
            v_reads<ND, 2>(lo1, hi1, vb);
            __builtin_amdgcn_sched_barrier(0);
            pv_half<ND>(o, lo0, hi0, __builtin_bit_cast(bf16x8, pw0), __builtin_bit_cast(bf16x8, pw1));
            __builtin_amdgcn_sched_barrier(0);
            p_half<MODE>(p1, l_reg, pw2, pw3, (t <= cw - 3) || (dbg & 8), qrow - 64 * t - 4 * hi - 32, tabL);
            asm volatile("s_waitcnt lgkmcnt(0)" ::: "memory");
            __builtin_amdgcn_sched_barrier(0);
            pv_half<ND>(o, lo1, hi1, __builtin_bit_cast(bf16x8, pw2), __builtin_bit_cast(bf16x8, pw3));
        }
        if (grp == 0) PP_NEED_K(i + 1); else PP_NEED_V(i + 1);
        PP_BAR();
    }
    if (grp == 0) PP_BAR();
#undef PP_DMA_K
#undef PP_DMA_V
#undef PP_NEED_K
#undef PP_NEED_V
    float rl[16];
    l_reg += __shfl_xor(l_reg, 32);
    if (hi == 0) wsf[32 + r32] = l_reg;
    asm volatile("s_waitcnt lgkmcnt(0)" ::: "memory");
#pragma unroll
    for (int r = 0; r < 16; ++r) rl[r] = __builtin_amdgcn_rcpf(wsf[32 + crow(r, hi)]) * oscale;
    if constexpr (OUT8) {
        static_assert(!OUT8 || VD == 64, "fp8 output: 64-wide heads");
        unsigned char* Ow = (unsigned char*)Ob + (size_t)(q0 + wid * 32) * opitch;
        ALAS unsigned char* stg = (ALAS unsigned char*)(shm + L_OST) + wid * 2048;
#pragma unroll
        for (int r = 0; r < 16; ++r) { const int orow = crow(r, hi);
#pragma unroll
            for (int d0 = 0; d0 < 2; ++d0) { const float v = o[d0][r] * rl[r]; stg[orow * 64 + d0 * 32 + r32] = (unsigned char)(__builtin_amdgcn_cvt_pk_fp8_f32(v, v, 0, false) & 0xff); } }
        asm volatile("s_waitcnt lgkmcnt(0)" ::: "memory");
#pragma unroll
        for (int i = 0; i < 2; ++i) { const int row = i * 16 + (lane >> 2), ch = lane & 3; const u32x4 v = *(const ALAS u32x4*)(stg + row * 64 + ch * 16); *(u32x4*)(Ow + (size_t)row * opitch + ch * 16) = v; }
        asm volatile("s_waitcnt lgkmcnt(0)" ::: "memory");
    } else {
    bf16_t* Ow = (bf16_t*)Ob + (size_t)(q0 + wid * 32) * opitch;
    ALAS bf16_t* stg = (ALAS bf16_t*)(shm + L_OST) + wid * 2048;
#pragma unroll
    for (int half = 0; half < ND / 2; ++half) {
#pragma unroll
        for (int r = 0; r < 16; ++r) { const int orow = crow(r, hi);
#pragma unroll
            for (int d0 = 0; d0 < 2; ++d0) stg[orow * 64 + d0 * 32 + r32] = f2bf(o[half * 2 + d0][r] * rl[r]); }
        asm volatile("s_waitcnt lgkmcnt(0)" ::: "memory");
#pragma unroll
        for (int i = 0; i < 4; ++i) { const int row = i * 8 + (lane >> 3), ch = lane & 7; const u32x4 v = *(const ALAS u32x4*)(stg + row * 64 + ch * 8); *(u32x4*)(Ow + (size_t)row * opitch + half * 64 + ch * 8) = v; }
        asm volatile("s_waitcnt lgkmcnt(0)" ::: "memory");
    }
    }
    PP_BAR();
#undef PP_BAR
}
}

constexpr int NWAVES = 8, NTHR = NWAVES * 64;
constexpr int BATCH = 2, SEQ = 8192, T = BATCH * SEQ, D = 1024;
constexpr int NPROJ = 3072, FFD = 2816, FFE = 3584, NEXP = 8;
constexpr size_t MiB = 1u << 20;
constexpr size_t CTL_ZERO_BYTES = 1 * MiB;
constexpr int CW_TMO = 0, CW_BAR = 4096;
constexpr int CW_HIST = 16384;
constexpr int CW_QATT = 32768, CW_QCONV = 32768 + 64 * 8;
constexpr int CW_MOE = 24576;
constexpr size_t WS_SS0 = 1 * MiB, WS_SS3 = WS_SS0 + 65536, WS_ROPE = WS_SS3 + 65536  , WS_TOKSEL = WS_ROPE + MiB  ,
                 WS_TOKGATE = WS_TOKSEL + 65536  , WS_ROWTOK = WS_TOKGATE + 131072  , WS_ROWGATE = WS_ROWTOK + 147456  , WS_ROWSCALE = WS_ROWGATE + 147456  ;
static_assert(WS_ROWSCALE + 147456 <= 4 * MiB, "small arrays");
constexpr size_t WS_XB = 4 * MiB;
constexpr size_t WS_AO = 36 * MiB;
constexpr size_t WS_ACT0 = 68 * MiB;
constexpr size_t WS_XF = 164 * MiB;
constexpr size_t WS_WIN = 228 * MiB, WS_WO0 = 234 * MiB, WS_WGU0 = 236 * MiB, WS_WD0 = 247 * MiB, WS_WQKV = 253 * MiB, WS_WO1 = 259 * MiB;
constexpr size_t WS_WEGU = 264 * MiB;
constexpr size_t WS_WED = 376 * MiB;
constexpr size_t WS_SS1 = 432 * MiB, WS_SS2 = 433 * MiB;
constexpr size_t WS_END = 434 * MiB;
constexpr size_t WS_SORTA = 36 * MiB;
constexpr size_t WS_ACTE = 108 * MiB;
static_assert(WS_SORTA + (size_t)36864 * 2048 <= WS_ACTE && WS_ACTE + (size_t)18432 * 7168 <= WS_WO0 && WS_WD0 + (size_t)1024 * 2816 * 2 <= WS_WQKV && WS_WO1 + 2 * MiB <= WS_WEGU, "ws map");
constexpr int RING_BYTES = 131072, MISC_OFF = RING_BYTES + 320, ULIST_OFF = RING_BYTES + 1024  , LDS_BYTES = 147456;
static_assert(att::L_END <= RING_BYTES, "attention LDS");

#define GAS __attribute__((address_space(1)))
#define LAS __attribute__((address_space(3)))
typedef unsigned short bf16;
typedef unsigned v4u __attribute__((ext_vector_type(4)));
typedef float f32x4 __attribute__((ext_vector_type(4)));
typedef GAS unsigned gu32;
#define RLX_AGENT __ATOMIC_RELAXED, __HIP_MEMORY_SCOPE_AGENT
#define LDS_WAIT() asm volatile("s_waitcnt lgkmcnt(0)" ::: "memory")
#define VM_WAIT() asm volatile("s_waitcnt vmcnt(0)" ::: "memory")
__device__ __forceinline__ unsigned f2bf(float f) { unsigned u = __builtin_bit_cast(unsigned, f); return (u + 0x7fffu + ((u >> 16) & 1u)) >> 16; }
__device__ __forceinline__ unsigned pk2(float lo, float hi) { return f2bf(lo) | (f2bf(hi) << 16); }
__device__ __forceinline__ float bf2f(unsigned short h) { return __builtin_bit_cast(float, (unsigned)h << 16); }
#define XB_TMO      128
#define XB_XCNT(j)  (256  + 64 * (j))
#define XB_XSUB(j)  (1280 + 64 * (j))
#define XB_XGEN(j)  (2304 + 64 * (j))
#define XB_TOP      3328
#define XB_TOPGEN   3392
#define XCD_BAR_WORDS 3456
#define XB_SPIN_CAP (1u << 18)

__device__ __forceinline__ unsigned xb_ld(unsigned* p)              { return __hip_atomic_load(p, __ATOMIC_RELAXED, __HIP_MEMORY_SCOPE_AGENT); }
__device__ __forceinline__ unsigned xb_add(unsigned* p, unsigned v) { return __hip_atomic_fetch_add(p, v, __ATOMIC_RELAXED, __HIP_MEMORY_SCOPE_AGENT); }
__device__ __forceinline__ unsigned xb_xcc_id() { return (unsigned)__builtin_amdgcn_s_getreg((3 << 11) | 20) & 0xFu; }
#define XB_SPIN(cond, bar) do { unsigned _sp = 0; while (cond) { __builtin_amdgcn_s_sleep(1); \
    if ((++_sp & 255u) == 0u) { if (xb_ld(&(bar)[XB_TMO])) break; if (_sp > XB_SPIN_CAP) { atomicAdd(&(bar)[XB_TMO], 1u); break; } } } } while (0)

struct XcdBarrier {
    unsigned* bar; unsigned x;
    volatile LAS unsigned* st;
};

__device__ __forceinline__ XcdBarrier xcd_barrier_post(unsigned* bar, volatile LAS unsigned* st) {
    XcdBarrier b; b.bar = bar; b.x = xb_xcc_id(); b.st = st;
    if (threadIdx.x == 0) (void)xb_add(&bar[XB_XCNT(b.x)], 1u);
    return b;
}
__device__ __forceinline__ void xcd_barrier_complete(unsigned* bar, unsigned x, unsigned& nloc, unsigned& nx) {
    const unsigned G = gridDim.x * gridDim.y * gridDim.z;
    unsigned sum, cnt, mine, sp = 0u;
    for (;;) {
        sum = 0u; cnt = 0u; mine = 0u;
#pragma unroll
        for (unsigned j = 0; j < 16; ++j) { const unsigned c = xb_ld(&bar[XB_XCNT(j)]); sum += c; cnt += (c > 0u) ? 1u : 0u; mine = (j == x) ? c : mine; }
        if (sum == G) break;
        __builtin_amdgcn_s_sleep(1);
        if ((++sp & 255u) == 0u) { if (xb_ld(&bar[XB_TMO])) break; if (sp > XB_SPIN_CAP) { atomicAdd(&bar[XB_TMO], 1u); break; } }
    }
    nloc = mine > 0u ? mine : 1u; nx = cnt > 0u ? cnt : 1u;
}

__device__ __forceinline__ void xcd_barrier(const XcdBarrier& b) {
    asm volatile("s_waitcnt vmcnt(0)" ::: "memory");
    __syncthreads();
    if (threadIdx.x == 0) {
        unsigned* bar = b.bar;
        __builtin_amdgcn_s_waitcnt(0);
        unsigned nloc = b.st[0], nx = b.st[1];
        if (nloc == 0u) { xcd_barrier_complete(bar, b.x, nloc, nx); b.st[0] = nloc; b.st[1] = nx; }
        const unsigned old = xb_add(&bar[XB_XSUB(b.x)], 1u);
        const unsigned gen = old / nloc;
        if (old + 1u == (gen + 1u) * nloc) {
            __builtin_amdgcn_fence(__ATOMIC_RELEASE, "agent");
            asm volatile("s_waitcnt vmcnt(0)" ::: "memory");
            const unsigned og = xb_add(&bar[XB_TOP], 1u);
            const unsigned tg = og / nx;
            if (og + 1u == (tg + 1u) * nx) xb_add(&bar[XB_TOPGEN], 1u);
            else XB_SPIN(xb_ld(&bar[XB_TOPGEN]) == tg, bar);
            __builtin_amdgcn_fence(__ATOMIC_ACQUIRE, "agent");
            xb_add(&bar[XB_XGEN(b.x)], 1u);
            asm volatile("s_waitcnt vmcnt(0)" ::: "memory");
        } else {
            XB_SPIN(xb_ld(&bar[XB_XGEN(b.x)]) == gen, bar);
            __builtin_amdgcn_fence(__ATOMIC_ACQUIRE, "agent");
            asm volatile("s_waitcnt vmcnt(0)" ::: "memory");
        }
    }
    __syncthreads();
}

__device__ __forceinline__ float wave_sum(float v) {
#pragma unroll
    for (int o = 1; o < 64; o <<= 1) v += __shfl_xor(v, o);
    return v;
}
__device__ __forceinline__ float wave_max(float v) {
#pragma unroll
    for (int o = 1; o < 64; o <<= 1) v = fmaxf(v, __shfl_xor(v, o));
    return v;
}
__device__ __forceinline__ int dest_block(int blk, int map) {
    if (map == 1) { const int s = blk & 7; return (blk & ~7) + 4 * (s & 1) + (s >> 1); }
    if (map == 2) return (blk >> 2) * 8 + (blk & 3);
    if (map == 3) return (blk >> 2) * 8 + 4 + (blk & 3);
    return blk;
}
__device__ __forceinline__ void tr_tile(const float* W, int K, int N, bf16* WT, int map, const float* gain, LAS unsigned* scr, int item, int lane) {
    const int nblk = N / 64, kb = item / nblk, nb = item % nblk, k0 = 64 * kb, n0 = 64 * nb;
    const int c = lane & 15, ip = lane >> 4;
#pragma unroll
    for (int it = 0; it < 8; ++it) { const int kp = it * 4 + ip, k = k0 + 2 * kp;
        f32x4 a = *(const GAS f32x4*)(W + (size_t)k * N + n0 + 4 * c), b = *(const GAS f32x4*)(W + (size_t)(k + 1) * N + n0 + 4 * c);
        if (gain) { a = a * gain[k]; b = b * gain[k + 1]; }
#pragma unroll
        for (int j = 0; j < 4; ++j) scr[(4 * c + j) * 33 + kp] = pk2(a[j], b[j]); }
    LDS_WAIT(); asm volatile("" ::: "memory");
#pragma unroll
    for (int it = 0; it < 8; ++it) { const int n = it * 8 + (lane >> 3), q = lane & 7;
        v4u o; o.x = scr[n * 33 + 4 * q]; o.y = scr[n * 33 + 4 * q + 1]; o.z = scr[n * 33 + 4 * q + 2]; o.w = scr[n * 33 + 4 * q + 3];
        const int drow = dest_block((n0 + n) >> 5, map) * 32 + (n & 31);
        *(GAS v4u*)(WT + (size_t)drow * K + k0 + 8 * q) = o; }
    LDS_WAIT(); asm volatile("" ::: "memory");
}

__device__ __forceinline__ void tr_tile8(const float* W, int K, int N, unsigned char* WT, int map, const float* gain, float wscale, LAS unsigned* scr, int item, int lane) {
    const int nblk = N / 64, kb = item / nblk, nb = item % nblk, k0 = 64 * kb, n0 = 64 * nb;
    const int c = lane & 15, ip = lane >> 4;
#pragma unroll
    for (int it = 0; it < 4; ++it) { const int k4 = it * 4 + ip, k = k0 + 4 * k4; f32x4 a[4];
#pragma unroll
        for (int i = 0; i < 4; ++i) a[i] = *(const GAS f32x4*)(W + (size_t)(k + i) * N + n0 + 4 * c) * ((gain ? gain[k + i] : 1.f) * wscale);
#pragma unroll
        for (int j = 0; j < 4; ++j) scr[(4 * c + j) * 17 + k4] = pg8::pk4_fp8(a[0][j], a[1][j], a[2][j], a[3][j]); }
    LDS_WAIT(); asm volatile("" ::: "memory");
#pragma unroll
    for (int it = 0; it < 4; ++it) { const int n = it * 16 + (lane >> 2), q = lane & 3;
        v4u o; o.x = scr[n * 17 + 4 * q]; o.y = scr[n * 17 + 4 * q + 1]; o.z = scr[n * 17 + 4 * q + 2]; o.w = scr[n * 17 + 4 * q + 3];
        const int drow = dest_block((n0 + n) >> 5, map) * 32 + (n & 31);
        *(GAS v4u*)(WT + (size_t)drow * K + k0 + 16 * q) = o; }
    LDS_WAIT(); asm volatile("" ::: "memory");
}

struct TrItem { const float* W; unsigned char* WT; const float* gain; int K, N, map, fp8, k0, n0; float scale; };
__device__ __forceinline__ void tr_load(const TrItem& d, f32x4 (&a)[16], float (&g)[16], int lane) {
    const int c = lane & 15, ip = lane >> 4;
#pragma unroll
    for (int it = 0; it < 4; ++it)
#pragma unroll
        for (int i = 0; i < 4; ++i) { const int k = d.k0 + 4 * (it * 4 + ip) + i;
            a[it * 4 + i] = __builtin_nontemporal_load((const GAS f32x4*)(d.W + (size_t)k * d.N + d.n0 + 4 * c)); g[it * 4 + i] = d.gain ? d.gain[k] : 1.f; }
}
__device__ __forceinline__ void tr_emit(const TrItem& d, const f32x4 (&a)[16], const float (&g)[16], LAS unsigned* scr, int lane) {
    const int c = lane & 15, ip = lane >> 4;
    if (d.fp8) {
#pragma unroll
        for (int it = 0; it < 4; ++it) { const int k4 = it * 4 + ip;
#pragma unroll
            for (int j = 0; j < 4; ++j) scr[(4 * c + j) * 17 + k4] = pg8::pk4_fp8(a[it * 4][j] * (g[it * 4] * d.scale), a[it * 4 + 1][j] * (g[it * 4 + 1] * d.scale), a[it * 4 + 2][j] * (g[it * 4 + 2] * d.scale), a[it * 4 + 3][j] * (g[it * 4 + 3] * d.scale)); }
        LDS_WAIT(); asm volatile("" ::: "memory");
#pragma unroll
        for (int it = 0; it < 4; ++it) { const int n = it * 16 + (lane >> 2), q = lane & 3;
            v4u o; o.x = scr[n * 17 + 4 * q]; o.y = scr[n * 17 + 4 * q + 1]; o.z = scr[n * 17 + 4 * q + 2]; o.w = scr[n * 17 + 4 * q + 3];
            const int drow = dest_block((d.n0 + n) >> 5, d.map) * 32 + (n & 31);
            __builtin_nontemporal_store(o, (GAS v4u*)(d.WT + (size_t)drow * d.K + d.k0 + 16 * q)); }
    } else {
#pragma unroll
        for (int it = 0; it < 4; ++it) { const int k4 = it * 4 + ip;
#pragma unroll
            for (int j = 0; j < 4; ++j) { scr[(4 * c + j) * 33 + 2 * k4] = pk2(a[it * 4][j] * g[it * 4], a[it * 4 + 1][j] * g[it * 4 + 1]); scr[(4 * c + j) * 33 + 2 * k4 + 1] = pk2(a[it * 4 + 2][j] * g[it * 4 + 2], a[it * 4 + 3][j] * g[it * 4 + 3]); } }
        LDS_WAIT(); asm volatile("" ::: "memory");
#pragma unroll
        for (int it = 0; it < 8; ++it) { const int n = it * 8 + (lane >> 3), q = lane & 7;
            v4u o; o.x = scr[n * 33 + 4 * q]; o.y = scr[n * 33 + 4 * q + 1]; o.z = scr[n * 33 + 4 * q + 2]; o.w = scr[n * 33 + 4 * q + 3];
            const int drow = dest_block((d.n0 + n) >> 5, d.map) * 32 + (n & 31);
            __builtin_nontemporal_store(o, (GAS v4u*)(d.WT + ((size_t)drow * d.K + d.k0 + 8 * q) * 2)); }
    }
    LDS_WAIT(); asm volatile("" ::: "memory");
}
constexpr float AO8_SCALE = 16.f;
constexpr float W8_SCALE = 64.f;

#ifndef PROBE_MASK
#define PROBE_MASK 0
#endif
struct KArgs { const void* in[27]; float* out; unsigned char* ws; int ph_lo, ph_hi, flags, pad; };

struct KArgs;
__device__ __forceinline__ const void* karg_in(const KArgs& a, int k) { asm volatile("" : "+s"(k)); return a.in[k]; }
__global__ void __launch_bounds__(NTHR, 2) fwd_kernel(KArgs args) {
    extern __shared__ __attribute__((aligned(16))) unsigned char lds_raw[];
    LAS unsigned char* lds = (LAS unsigned char*)lds_raw;
    volatile LAS unsigned* MISC = (volatile LAS unsigned*)(lds + MISC_OFF);
    const int tid = threadIdx.x, lane = tid & 63, wave = __builtin_amdgcn_readfirstlane(tid >> 6);
    const int G = gridDim.x; const int bx = blockIdx.x; const int vcu = (G % 8 == 0) ? (bx % 8) * (G / 8) + bx / 8 : bx;
    unsigned char* ws = args.ws;
    unsigned* ctl = (unsigned*)ws;
    for (int u = tid; u < (LDS_BYTES - RING_BYTES) / 4; u += NTHR) ((LAS unsigned*)(lds + RING_BYTES))[u] = 0u;
    __syncthreads();
    XcdBarrier bar = xcd_barrier_post(ctl + CW_BAR, MISC + 8);
    const int lo = args.ph_lo, hi_ph = args.ph_hi;
#define IN(k) (lo <= (k) && (k) < hi_ph)
#define REP(k)
#define SEAM(k) do { if (IN(k) && IN((k) + 1)) xcd_barrier(bar); } while (0)
#define KIN(T, k) ((const T*)karg_in(args, (k)))
#define x_in KIN(float, 0)
#define positions KIN(int, 1)
#define ev_attn_norm KIN(float, 2)
#define ev_w_in KIN(float, 3)
#define ev_q_norm KIN(float, 4)
#define ev_k_norm KIN(float, 5)
#define ev_lq1 KIN(float, 6)
#define ev_lk1 KIN(float, 7)
#define ev_lq2 KIN(float, 8)
#define ev_lk2 KIN(float, 9)
#define ev_subln KIN(float, 10)
#define ev_w_out KIN(float, 11)
#define ev_ffn_norm KIN(float, 12)
#define ev_w_gate KIN(float, 13)
#define ev_w_up KIN(float, 14)
#define ev_w_down KIN(float, 15)
#define od_attn_norm KIN(float, 16)
#define od_w_qkv KIN(float, 17)
#define od_q_norm KIN(float, 18)
#define od_k_norm KIN(float, 19)
#define od_rel_bias KIN(float, 20)
#define od_w_out KIN(float, 21)
#define od_ffn_norm KIN(float, 22)
#define od_router KIN(float, 23)
#define od_we_gate KIN(float, 24)
#define od_we_up KIN(float, 25)
#define od_we_down KIN(float, 26)
    float* out = args.out;
    float* ss0 = (float*)(ws + WS_SS0); float* ss1 = (float*)(ws + WS_SS1); float* ss2 = (float*)(ws + WS_SS2); float* ss3 = (float*)(ws + WS_SS3);
    float* rope = (float*)(ws + WS_ROPE); unsigned* toksel = (unsigned*)(ws + WS_TOKSEL); float* tokgate = (float*)(ws + WS_TOKGATE);
    int* rowtok = (int*)(ws + WS_ROWTOK); float* rowgate = (float*)(ws + WS_ROWGATE); float* rowscale = (float*)(ws + WS_ROWSCALE);
    bf16* XB = (bf16*)(ws + WS_XB); bf16* AO = (bf16*)(ws + WS_AO); bf16* ACT0 = (bf16*)(ws + WS_ACT0); float* XF = (float*)(ws + WS_XF); bf16* OD = (bf16*)(ws + WS_XF);
    bf16* Win_t = (bf16*)(ws + WS_WIN); bf16* Wo0_t = (bf16*)(ws + WS_WO0); bf16* Wgu0_t = (bf16*)(ws + WS_WGU0); bf16* Wd0_t = (bf16*)(ws + WS_WD0);
    unsigned char* Wqkv8 = ws + WS_WQKV; unsigned char* Wo18 = ws + WS_WO1; unsigned char* XB8 = ws + WS_XB; unsigned char* AO8 = ws + WS_AO; unsigned char* WEgu8 = ws + WS_WEGU; unsigned char* WEd8 = ws + WS_WED;
    unsigned char* SORTA8 = ws + WS_SORTA; unsigned char* ACTE8 = ws + WS_ACTE;
    const int gw = vcu * NWAVES + wave, NGW = G * NWAVES;

    constexpr int I_IN = 16 * 48, I_O = 16 * 16, I_G = 16 * 44, I_D = 44 * 16, I_EG = 16 * 56, I_ED = 56 * 16;
    constexpr int NSMALL = I_IN + I_O + 2 * I_G + I_D + I_IN + I_O, NITEMS = NSMALL + 24 * I_EG;
        auto decode = [&](int it) -> TrItem {
        TrItem d; int r = it; d.scale = 1.f; d.fp8 = 0; d.gain = nullptr; d.map = 0;
        auto fin = [&](int nbl) { d.k0 = 64 * (r / nbl); d.n0 = 64 * (r % nbl); };
        if (r < I_IN) { d.W = ev_w_in; d.K = D; d.N = NPROJ; d.WT = (unsigned char*)Win_t; d.map = 1; d.gain = ev_attn_norm; fin(NPROJ / 64); return d; } r -= I_IN;
        if (r < I_O) { d.W = ev_w_out; d.K = D; d.N = D; d.WT = (unsigned char*)Wo0_t; fin(D / 64); return d; } r -= I_O;
        if (r < I_G) { d.W = ev_w_gate; d.K = D; d.N = FFD; d.WT = (unsigned char*)Wgu0_t; d.map = 2; d.gain = ev_ffn_norm; fin(FFD / 64); return d; } r -= I_G;
        if (r < I_G) { d.W = ev_w_up; d.K = D; d.N = FFD; d.WT = (unsigned char*)Wgu0_t; d.map = 3; d.gain = ev_ffn_norm; fin(FFD / 64); return d; } r -= I_G;
        if (r < I_D) { d.W = ev_w_down; d.K = FFD; d.N = D; d.WT = (unsigned char*)Wd0_t; fin(D / 64); return d; } r -= I_D;
        d.fp8 = 1; d.scale = W8_SCALE;
        if (r < I_IN) { d.W = od_w_qkv; d.K = D; d.N = NPROJ; d.WT = Wqkv8; d.map = 1; d.gain = od_attn_norm; fin(NPROJ / 64); return d; } r -= I_IN;
        if (r < I_O) { d.W = od_w_out; d.K = D; d.N = D; d.WT = Wo18; fin(D / 64); return d; } r -= I_O;
        const int which = r / (8 * I_EG), rr = r % (8 * I_EG), e2 = rr / I_EG; r = rr % I_EG;
        if (which == 0) { d.W = od_we_gate + (size_t)e2 * D * FFE; d.K = D; d.N = FFE; d.WT = WEgu8 + (size_t)e2 * 2 * FFE * D; d.map = 2; d.gain = od_ffn_norm; fin(FFE / 64); }
        else if (which == 1) { d.W = od_we_up + (size_t)e2 * D * FFE; d.K = D; d.N = FFE; d.WT = WEgu8 + (size_t)e2 * 2 * FFE * D; d.map = 3; d.gain = od_ffn_norm; fin(FFE / 64); }
        else { d.W = od_we_down + (size_t)e2 * FFE * D; d.K = FFE; d.N = D; d.WT = WEd8 + (size_t)e2 * D * FFE; fin(D / 64); }
        return d; };
    auto conv_range = [&](int first, int end, int stride) {
        LAS unsigned* scr = (LAS unsigned*)(lds + wave * 8704);
        f32x4 bufA[16], bufB[16]; float gA[16], gB[16]; TrItem dA, dB; int it = first;
        if (it < end) { dA = decode(it); tr_load(dA, bufA, gA, lane); }
        while (it < end) {
            const int it2 = it + stride, it3 = it2 + stride;
            if (it2 < end) { dB = decode(it2); tr_load(dB, bufB, gB, lane); }
            tr_emit(dA, bufA, gA, scr, lane);
            if (it3 < end) { dA = decode(it3); tr_load(dA, bufA, gA, lane); }
            if (it2 < end) tr_emit(dB, bufB, gB, scr, lane);
            it = it3; } };
    auto pull = [&](int qword) -> int {
        __syncthreads(); if (tid == 0) MISC[16] = __hip_atomic_fetch_add(ctl + qword, 1u, __ATOMIC_RELAXED, __HIP_MEMORY_SCOPE_AGENT); __syncthreads();
        return __builtin_amdgcn_readfirstlane((int)MISC[16]); };

    REP(0) if (IN(0)) {
        conv_range(gw, I_IN, NGW);
        for (int m0 = gw; m0 < T; m0 += 2 * NGW) {
            f32x4 v[2][4];
#pragma unroll
            for (int u = 0; u < 2; ++u) { const int m = m0 + u * NGW; if (m < T) { const GAS f32x4* xr = (const GAS f32x4*)(x_in + (size_t)m * D) + lane;
#pragma unroll
                for (int j = 0; j < 4; ++j) v[u][j] = __builtin_nontemporal_load(xr + 64 * j); } }
#pragma unroll
            for (int u = 0; u < 2; ++u) { const int m = m0 + u * NGW; if (m >= T) break; float s = 0.f;
#pragma unroll
                for (int j = 0; j < 4; ++j) s += (v[u][j].x * v[u][j].x + v[u][j].y * v[u][j].y) + (v[u][j].z * v[u][j].z + v[u][j].w * v[u][j].w);
                s = wave_sum(s); if (lane == 0) ss0[m] = s;
                GAS unsigned long long* o8 = (GAS unsigned long long*)(XB + (size_t)m * D) + lane;
#pragma unroll
                for (int j = 0; j < 4; ++j) o8[64 * j] = (unsigned long long)pk2(v[u][j].x, v[u][j].y) | ((unsigned long long)pk2(v[u][j].z, v[u][j].w) << 32); }
        }
        for (int i = vcu * NTHR + tid; i < T * 8; i += G * NTHR) {
            const int tok = i >> 3, f = i & 7;
            const double inv = (f == 0) ? 1.0 : (f == 1) ? 0.19392274474868576 : (f == 2) ? 0.03760603093086393 : (f == 3) ? 0.007292664737217109 : (f == 4) ? 0.001414213562373095 : (f == 5) ? 0.0002742481756762073 : (f == 6) ? 5.318295896944988e-05 : 1.031338537721246e-05;
            double ang = (double)positions[tok] * inv; ang -= 6.283185307179586 * rint(ang * 0.15915494309189535);
            float sn, cs; sincosf((float)ang, &sn, &cs);
            rope[(size_t)tok * 16 + f] = cs; rope[(size_t)tok * 16 + 8 + f] = sn;
        }
    }
    SEAM(0);

    LAS int* ulist = (LAS int*)(lds + ULIST_OFF);
#define RUN_GEMM(EPI, ALIGN, F8, g, S, E) do { pg8::build_unit_list((S), ulist); const pg8::ListOrder LO_{ulist}; pg8::gemm_phase<EPI, pg8::ListOrder, ALIGN, true, F8>(lds, (g), LO_, (E)); } while (0)
    REP(1) if (IN(1)) {
        pg8::Gemm g{XB, Win_t, T, NPROJ, D}; pg8::StaticOrder S; S.init(T, NPROJ, G, bx);
        pg8::EpiProj E{ACT0, T, ss0, 1, ev_q_norm, ev_k_norm, rope, 0, 1.f};
        RUN_GEMM(pg8::EpiProj, true, false, g, S, E);
    }
    SEAM(1);

    REP(2) if (IN(2)) {
        const float gqm = wave_max(fabsf(ev_q_norm[lane])), gkm = wave_max(fabsf(ev_k_norm[lane]));
        const float mref = 8.f * gqm * gkm * pg8::LOG2E;
        constexpr int NJOBS = (NITEMS - I_IN + 63) / 64;
        const bool conv_first = ((bx >> 3) & 3) == 3;
#define P2_CONV_LOOP() for (;;) { const int j = pull(CW_QCONV); if (j >= NJOBS) break; \
            const int first = I_IN + j * 64 + wave * 8; conv_range(first, (first + 8 < NITEMS) ? first + 8 : NITEMS, 1); }
        if (conv_first) P2_CONV_LOOP()
#pragma unroll 1
        for (int kq = 0; kq < 8; ++kq) { const int xq = (bx + kq) & 7;
            for (;;) { const int idx = pull(CW_QATT + 64 * xq); if (idx >= 128) break;
                if (idx < 64) { if (args.flags & 1) continue;
                    const int bhm = 2 * xq + (idx & 1), qb = 31 - (idx >> 1);
                    const int b = bhm >> 3, hm = bhm & 7, h = hm >> 1;
                    const bf16* base = ACT0 + (size_t)b * SEQ * 64;
                    att::attn_unit<0, 128, false, 1>((LAS char*)lds, base + (size_t)(24 + hm) * T * 64, base + (size_t)(32 + hm) * T * 64, base + (size_t)(40 + 2 * h) * T * 64, OD + (size_t)b * SEQ * D + hm * 128, D, qb * 256, mref, nullptr, 1.f, args.flags);
                } else { if (args.flags & 2) continue;
                    const int bh = 2 * xq + (idx & 1), qb = 31 - ((idx - 64) >> 1);
                    const int b = bh >> 3, h = bh & 7;
                    const bf16* base = ACT0 + (size_t)b * SEQ * 64;
                    att::attn_unit<2, 64>((LAS char*)lds, base + (size_t)h * T * 64, base + (size_t)(8 + h) * T * 64, base + (size_t)(16 + h) * T * 64, AO + (size_t)b * SEQ * D + h * 64, D, qb * 256, 0.f, nullptr);
                }
            }
        }
        P2_CONV_LOOP()
#undef P2_CONV_LOOP
    }
    SEAM(2);

    REP(3) if (IN(3)) {
        const float a1 = wave_sum(ev_lq1[lane] * ev_lk1[lane]), a2 = wave_sum(ev_lq2[lane] * ev_lk2[lane]);
        const float lam_init = 0.2f, lam = expf(a1) - expf(a2) + lam_init;
        const int h = lane >> 4, v0 = (lane & 15) * 8;
        float sg[8];
#pragma unroll
        for (int j = 0; j < 8; ++j) sg[j] = ev_subln[v0 + j] * (1.f - lam_init);
        for (int m0 = gw; m0 < T; m0 += 4 * NGW) {
            v4u a4[4], b4[4];
#pragma unroll
            for (int u = 0; u < 4; ++u) { const int m = m0 + u * NGW; if (m < T) { a4[u] = *(const GAS v4u*)(OD + (size_t)m * D + (2 * h) * 128 + v0); b4[u] = *(const GAS v4u*)(OD + (size_t)m * D + (2 * h + 1) * 128 + v0); } }
#pragma unroll
            for (int u = 0; u < 4; ++u) { const int m = m0 + u * NGW; if (m >= T) break;
                const v4u a = a4[u], b = b4[u]; float d[8]; float s = 0.f;
#pragma unroll
                for (int j = 0; j < 4; ++j) { const unsigned ua = a[j], ub = b[j];
                    d[2 * j] = bf2f((unsigned short)(ua & 0xffffu)) - lam * bf2f((unsigned short)(ub & 0xffffu));
                    d[2 * j + 1] = bf2f((unsigned short)(ua >> 16)) - lam * bf2f((unsigned short)(ub >> 16));
                    s += d[2 * j] * d[2 * j] + d[2 * j + 1] * d[2 * j + 1]; }
                s += __shfl_xor(s, 1); s += __shfl_xor(s, 2); s += __shfl_xor(s, 4); s += __shfl_xor(s, 8);
                const float rs = rsqrtf(s * (1.f / 128.f) + pg8::RMS_EPS);
                v4u o; o.x = pk2(d[0] * rs * sg[0], d[1] * rs * sg[1]); o.y = pk2(d[2] * rs * sg[2], d[3] * rs * sg[3]); o.z = pk2(d[4] * rs * sg[4], d[5] * rs * sg[5]); o.w = pk2(d[6] * rs * sg[6], d[7] * rs * sg[7]);
                *(GAS v4u*)(AO + (size_t)m * D + 512 + h * 128 + v0) = o; }
        }
    }
    SEAM(3);

    REP(4) if (IN(4)) {
        pg8::Gemm g{AO, Wo0_t, T, D, D}; pg8::StaticOrder S; S.init(T, D, G, bx);
        pg8::EpiResid E{x_in, XF, XB, ss1, 1.f, nullptr};
        RUN_GEMM(pg8::EpiResid, false, false, g, S, E);
    }
    SEAM(4);

    REP(5) if (IN(5)) {
        pg8::Gemm g{XB, Wgu0_t, T, 2 * FFD, D}; pg8::StaticOrder S; S.init(T, 2 * FFD, G, bx, (args.flags >> 9) & 1);
        pg8::EpiSwiglu<false> E{ACT0, FFD, ss1, 16, nullptr, 0, 2 * FFD / 256, 1.f};
        RUN_GEMM(pg8::EpiSwiglu<false>, true, false, g, S, E);
    }
    SEAM(5);

    if (IN(6)) {
        pg8::Gemm g{ACT0, Wd0_t, T, D, FFD}; pg8::StaticOrder S; S.init(T, D, G, bx);
        pg8::EpiResid E{XF, XF, nullptr, ss2, 1.f, XB8};
        RUN_GEMM(pg8::EpiResid, false, false, g, S, E);
    }
    SEAM(6);

    REP(7) if (IN(7)) {
        pg8::Gemm g{(const bf16*)XB8, (const bf16*)Wqkv8, T, NPROJ, D / 2}; pg8::StaticOrder S; S.init(T, NPROJ, G, bx);
        pg8::EpiProj E{ACT0, T, ss2, 16, od_q_norm, od_k_norm, nullptr, 1, 1.f / W8_SCALE};
        RUN_GEMM(pg8::EpiProj, true, true, g, S, E);
    }
    SEAM(7);

    REP(8) if (IN(8)) {
        const float gqm = wave_max(fabsf(od_q_norm[lane])), gkm = wave_max(fabsf(od_k_norm[lane]));
        for (int L = vcu; L < 1024; L += G) {
            const int bh = (L & 255) >> 3, qb = 4 * (L & 7) + (L >> 8);
            const int b = bh >> 4, h = bh & 15;
            const float* tab = od_rel_bias + h * 257;
            float tm = fabsf(tab[lane]); tm = fmaxf(tm, fabsf(tab[64 + lane])); tm = fmaxf(tm, fabsf(tab[128 + lane])); tm = fmaxf(tm, fabsf(tab[192 + lane])); tm = fmaxf(tm, fabsf(tab[256]));
            tm = wave_max(tm);
            const float mref = (8.f * gqm * gkm + tm) * pg8::LOG2E;
            const bf16* base = ACT0 + (size_t)b * SEQ * 64;
            att::attn_unit<1, 64, true, 1>((LAS char*)lds, base + (size_t)h * T * 64, base + (size_t)(16 + h) * T * 64, base + (size_t)(32 + h) * T * 64, AO8 + (size_t)b * SEQ * D + h * 64, D, qb * 256, mref, tab, AO8_SCALE);
        }
    }
    SEAM(8);

    REP(9) if (IN(9)) {
        pg8::Gemm g{(const bf16*)AO8, (const bf16*)Wo18, T, D, D / 2}; pg8::StaticOrder S; S.init(T, D, G, bx);
        pg8::EpiResid E{XF, out, nullptr, nullptr, 1.f / (W8_SCALE * AO8_SCALE), XB8};
        RUN_GEMM(pg8::EpiResid, false, true, g, S, E);
    }
    SEAM(9);

    REP(10) if (IN(10)) {
        LAS float* wrT = (LAS float*)lds;
        LAS unsigned* sel = (LAS unsigned*)(lds + 32768);
        for (int i = tid; i < 1024; i += NTHR) { const float gn = od_ffn_norm[i]; const f32x4 w0 = *(const GAS f32x4*)(od_router + (size_t)i * 8), w1 = *(const GAS f32x4*)(od_router + (size_t)i * 8 + 4);
            wrT[i] = w0.x * gn; wrT[1024 + i] = w0.y * gn; wrT[2048 + i] = w0.z * gn; wrT[3072 + i] = w0.w * gn; wrT[4096 + i] = w1.x * gn; wrT[5120 + i] = w1.y * gn; wrT[6144 + i] = w1.z * gn; wrT[7168 + i] = w1.w * gn; }
        __syncthreads();
        for (int blk = vcu; blk < T / 64; blk += G) {
#pragma unroll 1
            for (int q4 = 0; q4 < 2; ++q4) {
                const int tk = lane >> 4, sub = lane & 15; const int tok = blk * 64 + wave * 8 + q4 * 4 + tk;
                const GAS f32x4* xr = (const GAS f32x4*)(out + (size_t)tok * D) + sub; float s = 0.f; float lg[8];
#pragma unroll
                for (int e2 = 0; e2 < 8; ++e2) lg[e2] = 0.f;
#pragma unroll
                for (int jh = 0; jh < 2; ++jh) { f32x4 xv[8];
#pragma unroll
                    for (int j = 0; j < 8; ++j) xv[j] = xr[16 * (8 * jh + j)];
#pragma unroll
                    for (int j = 0; j < 8; ++j) { const f32x4 v = xv[j]; s += (v.x * v.x + v.y * v.y) + (v.z * v.z + v.w * v.w);
#pragma unroll
                        for (int e2 = 0; e2 < 8; ++e2) { const f32x4 w = *(const LAS f32x4*)(wrT + e2 * 1024 + 64 * (8 * jh + j) + 4 * sub); lg[e2] += (v.x * w.x + v.y * w.y) + (v.z * w.z + v.w * w.w); } } }
#pragma unroll
                for (int o = 1; o < 16; o <<= 1) { s += __shfl_xor(s, o);
#pragma unroll
                    for (int e2 = 0; e2 < 8; ++e2) lg[e2] += __shfl_xor(lg[e2], o); }
                if (sub == 0) {
                    const float r = rsqrtf(s * (1.f / 1024.f) + pg8::RMS_EPS); ss3[tok] = s;
                    int e0 = 0; float v0 = lg[0];
#pragma unroll
                    for (int e2 = 1; e2 < 8; ++e2) if (lg[e2] > v0) { v0 = lg[e2]; e0 = e2; }
                    int e1 = -1; float v1 = 0.f;
#pragma unroll
                    for (int e2 = 0; e2 < 8; ++e2) if (e2 != e0 && (e1 < 0 || lg[e2] > v1)) { v1 = lg[e2]; e1 = e2; }
                    const float ex = expf((v1 - v0) * r), g0 = 1.f / (1.f + ex), g1 = ex / (1.f + ex);
                    sel[wave * 8 + q4 * 4 + tk] = (unsigned)e0 | ((unsigned)e1 << 8); tokgate[2 * tok] = g0; tokgate[2 * tok + 1] = g1;
                }
            }
            __syncthreads();
            if (wave == 0) { const unsigned sv = sel[lane]; const int e0 = sv & 0xff, e1 = sv >> 8; unsigned rank0 = 0, rank1 = 0;
                const unsigned long long lt = (1ull << lane) - 1ull;
#pragma unroll
                for (int e = 0; e < 8; ++e) { const unsigned long long m0 = __ballot(e0 == e), m1 = __ballot(e1 == e);
                    if (e0 == e) rank0 = __popcll(m0 & lt); if (e1 == e) rank1 = __popcll(m1 & lt);
                    if (lane == 0) { ctl[CW_HIST + blk * 16 + e] = __popcll(m0); ctl[CW_HIST + blk * 16 + 8 + e] = __popcll(m1); } }
                toksel[blk * 64 + lane] = sv | (rank0 << 16) | (rank1 << 24); }
            __syncthreads();
        }
    }
    SEAM(10);

    REP(11) if (IN(11)) {
        LAS unsigned* hs = (LAS unsigned*)lds;
        for (int i = tid; i < 4096; i += NTHR) hs[i] = ctl[CW_HIST + i];
        __syncthreads();
        if (tid < 16) hs[4096 + tid] = 0u;
        __syncthreads();
        { unsigned s = 0; const int g2 = tid & 15;
#pragma unroll
          for (int b2 = tid >> 4; b2 < 256; b2 += 32) s += hs[b2 * 16 + g2];
          atomicAdd((unsigned*)&hs[4096 + g2], s); }
        __syncthreads();
        if (tid == 0) { unsigned acc = 0; for (int g2 = 0; g2 < 16; ++g2) { hs[4128 + g2] = acc; acc += (hs[4096 + g2] + 255u) & ~255u; } hs[4128 + 16] = acc; }
        __syncthreads();
        if (bx == 0) {
            if (tid == 0) { const int nA = (int)(hs[4128 + 8] >> 8), nT = (int)(hs[4128 + 16] >> 8), nC1 = (nT - nA + 1) / 2, nC2 = nT - nA - nC1;
                ctl[CW_MOE] = nA; ctl[CW_MOE + 1] = nT;
                for (int ph = 0; ph < 2; ++ph) { const int nd = (ph == 0 ? nA : nC1) * (D / 256), nu = (ph == 0 ? nC1 : nC2) * (2 * FFE / 256);
                    int H = nd > G ? nd - G : (nd < G ? nd : 0); int mode = 1, R = 0; if (H >= G) H = 0;
                    pg8::MoeOrder::plan(nu, H, G, D / 128, FFE / 128, mode, R);
                    ctl[CW_MOE + 2 + 3 * ph] = H; ctl[CW_MOE + 3 + 3 * ph] = R; ctl[CW_MOE + 4 + 3 * ph] = mode; } }
            if (tid < 16) { const unsigned t0 = hs[4128 + tid] >> 8, t1 = hs[4128 + tid + 1] >> 8; for (unsigned t = t0; t < t1; ++t) ctl[CW_MOE + 16 + t] = tid & 7; }
        }
        for (int blk = vcu; blk < T / 64; blk += G) {
            if (tid < 16) hs[4160 + tid] = 0u;
            __syncthreads();
            { unsigned s = 0; const int g2 = tid & 15;
#pragma unroll
              for (int b2 = tid >> 4; b2 < 256; b2 += 32) s += (b2 < blk) ? hs[b2 * 16 + g2] : 0u;
              atomicAdd((unsigned*)&hs[4160 + g2], s); }
            __syncthreads();
            for (int tl = wave; tl < 64; tl += NWAVES) {
                const int tok = blk * 64 + tl; const unsigned sv = toksel[tok];
                const v4u pk = *(const GAS v4u*)(XB8 + (size_t)tok * D + 16 * lane);
#pragma unroll
                for (int sl = 0; sl < 2; ++sl) { const int e = (sv >> (8 * sl)) & 0xff, rank = (sv >> (16 + 8 * sl)) & 0xff, g2 = sl * 8 + e;
                    const unsigned srow = hs[4128 + g2] + hs[4160 + g2] + rank;
                    *(GAS v4u*)(SORTA8 + (size_t)srow * D + lane * 16) = pk;
                    if (lane == 0) { rowtok[srow] = tok; rowgate[srow] = tokgate[2 * tok + sl]; rowscale[srow] = rsqrtf(ss3[tok] * (1.f / 1024.f) + pg8::RMS_EPS); } }
            }
            __syncthreads();
        }
        for (int g2 = vcu; g2 < 16; g2 += G) {
            const unsigned r0 = hs[4128 + g2] + hs[4096 + g2], r1 = hs[4128 + g2 + 1];
            for (unsigned r = r0 + wave; r < r1; r += NWAVES) { if (lane == 0) { rowtok[r] = -1; rowgate[r] = 0.f; rowscale[r] = 0.f; }
                *(GAS v4u*)(SORTA8 + (size_t)r * D + lane * 16) = (v4u){0u, 0u, 0u, 0u}; }
        }
    }
    SEAM(11);

    if (IN(12) || IN(13) || IN(14) || IN(15)) {
        const int nA = (int)__builtin_amdgcn_readfirstlane(ctl[CW_MOE]), nT = (int)__builtin_amdgcn_readfirstlane(ctl[CW_MOE + 1]);
        const int nC1 = (nT - nA + 1) / 2, nC2 = nT - nA - nC1;
        const int* texp = (const int*)(ctl + CW_MOE + 16);
        unsigned char* const ACT_C0 = ACTE8; unsigned char* const ACT_C1 = ACTE8 + (size_t)63 * MiB; unsigned char* const ACT_C2 = ACT_C1 + (size_t)36 * 256 * FFE;
        constexpr int NPN_GU = 2 * FFE / 256, NPN_D = D / 256;
#define MOE_GU(TILE0, NTILE, ACTBUF, PLAN) do { int H_ = 0, R_ = 0, mode_ = 1; \
        if ((PLAN) >= 0) { H_ = (int)__builtin_amdgcn_readfirstlane(ctl[CW_MOE + 2 + 3 * (PLAN)]); R_ = (int)__builtin_amdgcn_readfirstlane(ctl[CW_MOE + 3 + 3 * (PLAN)]); mode_ = (int)__builtin_amdgcn_readfirstlane(ctl[CW_MOE + 4 + 3 * (PLAN)]); } \
        pg8::Gemm g{(const bf16*)(SORTA8 + (size_t)(TILE0) * 256 * D), (const bf16*)WEgu8, 0, 0, D / 2}; pg8::MoeOrder S; S.init((NTILE), NPN_GU, G, bx, (TILE0), texp, H_, R_, mode_); \
        pg8::EpiSwiglu<true> E{(ACTBUF), FFE, nullptr, 1, rowscale, (TILE0), NPN_GU, 1.f / W8_SCALE}; \
        RUN_GEMM(pg8::EpiSwiglu<true>, true, true, g, S, E); } while (0)
#define MOE_DOWN(TILE0, NTILE, ACTBUF) do { pg8::Gemm g{(const bf16*)(ACTBUF), (const bf16*)WEd8, 0, 0, FFE / 2}; pg8::MoeOrder S; S.init((NTILE), NPN_D, G, bx, (TILE0), texp); \
        pg8::EpiMoeDown E{out, rowtok, rowgate, (TILE0), 1.f / W8_SCALE, (args.flags >> 2) & 1}; \
        RUN_GEMM(pg8::EpiMoeDown, true, true, g, S, E); } while (0)
        if (IN(12)) MOE_GU(0, nA, ACT_C0, -1);
        SEAM(12);
        if (IN(13)) { MOE_DOWN(0, nA, ACT_C0); MOE_GU(nA, nC1, ACT_C1, 0); }
        SEAM(13);
        if (IN(14)) { MOE_DOWN(nA, nC1, ACT_C1); if (nC2 > 0) MOE_GU(nA + nC1, nC2, ACT_C2, 1); }
        SEAM(14);
        if (IN(15)) { if (nC2 > 0) MOE_DOWN(nA + nC1, nC2, ACT_C2); }
#undef MOE_GU
#undef MOE_DOWN
    }
#undef IN
#undef SEAM
#undef RUN_GEMM
#undef x_in
#undef positions
#undef ev_attn_norm
#undef ev_w_in
#undef ev_q_norm
#undef ev_k_norm
#undef ev_lq1
#undef ev_lk1
#undef ev_lq2
#undef ev_lk2
#undef ev_subln
#undef ev_w_out
#undef ev_ffn_norm
#undef ev_w_gate
#undef ev_w_up
#undef ev_w_down
#undef od_attn_norm
#undef od_w_qkv
#undef od_q_norm
#undef od_k_norm
#undef od_rel_bias
#undef od_w_out
#undef od_ffn_norm
#undef od_router
#undef od_we_gate
#undef od_we_up
#undef od_we_down
#undef KIN
}

constexpr int N_PHASES = 16;
extern "C" void kernel_launch(void* const* d_in, const int* in_sizes, int n_in, void* d_out, int out_size, void* d_ws, size_t ws_size, hipStream_t stream) {
    static int grid = 0;
    if (grid == 0) {
        if (n_in != 27 || out_size != T * D || ws_size < WS_END) { fprintf(stderr, "kernel_launch: unexpected problem (n_in %d, out %d, ws %zu)\n", n_in, out_size, ws_size); grid = -1; return; }
        int dev = 0, cus = 0, per_cu = 0;
        if (hipGetDevice(&dev) != hipSuccess || hipDeviceGetAttribute(&cus, hipDeviceAttributeMultiprocessorCount, dev) != hipSuccess) { grid = -1; return; }
        if (hipFuncSetAttribute((const void*)fwd_kernel, hipFuncAttributeMaxDynamicSharedMemorySize, LDS_BYTES) != hipSuccess) { fprintf(stderr, "kernel_launch: hipFuncSetAttribute failed\n"); grid = -1; return; }
        if (hipOccupancyMaxActiveBlocksPerMultiprocessor(&per_cu, (const void*)fwd_kernel, NTHR, LDS_BYTES) != hipSuccess || per_cu < 1) { fprintf(stderr, "kernel_launch: occupancy query says %d\n", per_cu); }
        (void)hipGetLastError();
        grid = cus;
    }
    if (grid < 0) return;
    (void)hipMemsetAsync(d_ws, 0, CTL_ZERO_BYTES, stream);
    KArgs a{};
    for (int i = 0; i < 27; ++i) a.in[i] = d_in[i];
    a.out = (float*)d_out; a.ws = (unsigned char*)d_ws; a.ph_lo = 0; a.ph_hi = N_PHASES;
    hipLaunchKernelGGL(fwd_kernel, dim3(grid), dim3(NTHR), LDS_BYTES, stream, a);
#if defined(PROBE_LO)
    (void)hipMemsetAsync((char*)d_ws + CW_BAR * 4, 0, XCD_BAR_WORDS * 4, stream); (void)hipMemsetAsync((char*)d_ws + CW_QATT * 4, 0, 4096, stream);
    a.ph_lo = PROBE_LO; a.ph_hi = PROBE_HI;
#if defined(PROBE_FLAGS)
    a.flags = PROBE_FLAGS;
#endif
    hipLaunchKernelGGL(fwd_kernel, dim3(grid), dim3(NTHR), LDS_BYTES, stream, a);
#endif
}
```

```cpp
#include <hip/hip_runtime.h>
#include <cstdio>
#include <cstdint>
#include <cmath>
#define PROBE_MASK 0x0
namespace pg8 {
#define PG8_LAS __attribute__((address_space(3)))
typedef unsigned short bf16_t;
typedef short bf16x8 __attribute__((ext_vector_type(8)));
typedef float f32x4 __attribute__((ext_vector_type(4)));
typedef unsigned u32x4 __attribute__((ext_vector_type(4)));
constexpr int BM = 256, BK = 64, HALF = 128, HTB = HALF * BK * 2  , STAGE_BYTES = 8 * HTB, NXCD = 8, WGM = 4;

__host__ __device__ __forceinline__ int lds_byte(int r, int c) { const int st = (r >> 4) * 2 + (c >> 5), rr = r & 15, cc = c & 31, ob = rr * 64 + cc * 2; return st * 1024 + (ob ^ (((ob >> 9) & 1) << 5)); }
__host__ __device__ __forceinline__ void stage_rc(int b, int& R, int& C) { const int st = b / 1024, sb = b % 1024, swz = sb ^ (((sb >> 9) & 1) << 5); R = (st >> 1) * 16 + swz / 64; C = (st & 1) * 32 + (swz % 64) / 2; }
__host__ __device__ __forceinline__ int perm32(int rho) { const int n = rho >> 4, i = rho & 15; return 8 * (i >> 2) + 4 * n + (i & 3); }

struct Unit { int pm, pn, aux; };
struct Gemm { const bf16_t* A; const bf16_t* Bt; int M, N, K; };

struct StaticOrder {
    int nM, nN, nwg, G, c, hot;
    __host__ __device__ void init(int M, int N, int G_, int c_, int hot_ = 0) { nM = M / BM; nN = N / BM; nwg = nM * nN; G = G_; c = c_; hot = hot_; }
    __host__ __device__ bool next(int i, Unit& u) const {
        const long L = (long)i * G + c; if (L >= nwg) return false;
        int wgid = (int)L; { const int q = nwg / NXCD, r = nwg % NXCD, xcd = wgid % NXCD, off = wgid / NXCD; wgid = (xcd < r ? xcd * (q + 1) : r * (q + 1) + (xcd - r) * q) + off; }
        const int nig = WGM * nN, gid = wgid / nig, fm = gid * WGM, gsz = (nM - fm) < WGM ? (nM - fm) : WGM;
        u.pm = fm + ((wgid % nig) % gsz); u.pn = (wgid % nig) / gsz; if (hot) { u.pm &= 3; u.pn = 0; } return true;
    }
    __device__ __forceinline__ void a_ready(const Unit&) const {}
    __device__ __forceinline__ void done(const Unit&) const {}
};

struct MoeOrder {
    int nM, nN, nwg, G, c, tile0; const int* tile_expert;
    int H, R, mode;
    __device__ void init(int ntiles, int npn, int G_, int c_, int tile0_, const int* te, int H_ = 0, int R_ = 0, int mode_ = 1) { nM = ntiles; nN = npn; nwg = nM * nN; G = G_; c = c_; tile0 = tile0_; tile_expert = te; H = H_; R = R_; mode = mode_; }
    __device__ static __forceinline__ void plan(int nu, int H, int G, int ucost, int extra, int& mode, int& R) {
        mode = 1; R = 0; if (H <= 0 || H >= G) return;
        const int rmax = (nu + (G - H) - 1) / (G - H); int best = 0x7fffffff;
        for (int r2 = 0; r2 <= rmax; ++r2) { const int rest = nu - r2 * (G - H) > 0 ? nu - r2 * (G - H) : 0;
            { const int light = ucost * r2, heavy = extra + ucost * ((rest + H - 1) / H); const int mk = light > heavy ? light : heavy; if (mk < best) { best = mk; mode = 1; R = r2; } }
            { const int sh = (rest + G - 1) / G; const int light = ucost * (r2 + sh), heavy = extra + ucost * sh; const int mk = light > heavy ? light : heavy; if (mk < best) { best = mk; mode = 2; R = r2; } } }
    }
    __device__ bool next(int i, Unit& u) const {
        long L;
        if (H == 0) L = (long)i * G + c;
        else if (c >= H) { if (i < R) L = (long)i * (G - H) + (c - H); else if (mode == 2) L = (long)R * (G - H) + (long)(i - R) * G + c; else return false; }
        else L = (long)R * (G - H) + (long)i * (mode == 2 ? G : H) + c;
        if (L >= nwg) return false;
        int wgid = (int)L; { const int q = nwg / NXCD, r = nwg % NXCD, xcd = wgid % NXCD, off = wgid / NXCD; wgid = (xcd < r ? xcd * (q + 1) : r * (q + 1) + (xcd - r) * q) + off; }
        const int nig = WGM * nN, gid = wgid / nig, fm = gid * WGM, gsz = (nM - fm) < WGM ? (nM - fm) : WGM;
        u.pm = fm + ((wgid % nig) % gsz); const int pnl = (wgid % nig) / gsz;
        const int e = tile_expert[tile0 + u.pm];
        u.pn = e * nN + pnl; return true;
    }
    __device__ __forceinline__ void a_ready(const Unit&) const {}
    __device__ __forceinline__ void done(const Unit&) const {}
};

constexpr int MAX_UNITS = 64, RT_UNITS = 16;
template <class Sched, class RowFn> __device__ __forceinline__ void build_unit_list(const Sched& S, PG8_LAS int* list, PG8_LAS float* rtab, const RowFn& rowfn) {
    const int t = threadIdx.x;
    if (t < MAX_UNITS) { Unit u; u.pm = 0; u.pn = 0; u.aux = t; const bool ok = S.next(t, u); list[2 * t] = ok ? u.pm : -1; list[2 * t + 1] = u.pn; }
    __syncthreads();
    if (rtab) {
#pragma unroll 1
        for (int i = t >> 8; i < RT_UNITS; i += 2) { Unit u; u.pm = list[2 * i]; u.pn = list[2 * i + 1]; u.aux = i; if (u.pm < 0) break; rtab[i * 256 + (t & 255)] = rowfn(u, t & 255); }
        __syncthreads();
    }
}
struct ListOrder {
    const PG8_LAS int* list;
    __device__ __forceinline__ bool next(int i, Unit& u) const {
        if (i >= MAX_UNITS) return false;
        const int pm = __builtin_amdgcn_readfirstlane(list[2 * i]); if (pm < 0) return false;
        u.pm = pm; u.pn = __builtin_amdgcn_readfirstlane(list[2 * i + 1]); u.aux = i; return true; }
    __device__ __forceinline__ void a_ready(const Unit&) const {}
    __device__ __forceinline__ void done(const Unit&) const {}
};

__device__ __forceinline__ unsigned cvt_pk_bf16(float lo, float hi) { unsigned r; asm volatile("v_cvt_pk_bf16_f32 %0, %1, %2" : "=v"(r) : "v"(lo), "v"(hi)); return r; }
__device__ __forceinline__ u32x4 pack8(const f32x4& a, const f32x4& b) { u32x4 w; w.x = cvt_pk_bf16(a[0], a[1]); w.y = cvt_pk_bf16(a[2], a[3]); w.z = cvt_pk_bf16(b[0], b[1]); w.w = cvt_pk_bf16(b[2], b[3]); return w; }
__device__ __forceinline__ unsigned pk4_fp8(float a, float b, float c, float d) { int w = __builtin_amdgcn_cvt_pk_fp8_f32(a, b, 0, false); w = __builtin_amdgcn_cvt_pk_fp8_f32(c, d, w, true); return (unsigned)w; }
constexpr float RMS_EPS = 1e-6f;
constexpr float LOG2E = 1.4426950408889634f;
constexpr float C2 = 0.125f * LOG2E;
__device__ __forceinline__ float row_ss(const float* ss, int nparts, int row) {
    if (nparts == 1) return ss[row];
    const f32x4* p = (const f32x4*)(ss + (size_t)row * 16); f32x4 a = p[0], b = p[1], c = p[2], d = p[3]; a = (a + b) + (c + d); return (a[0] + a[1]) + (a[2] + a[3]);
}

struct EpiProj {
    static constexpr bool PERM = true, AFTER_DRAIN = false;
    bf16_t* O; int ldc; const float* ss; int nparts; const float* gq; const float* gk; const float* rope; int layer; float pre; const PG8_LAS float* rtab;
    __device__ __forceinline__ void operator()(const f32x4 (&acc)[2][2][4][2], const Unit& u, int wr, int wc, int fr, int fq) const {
        const int pn = u.pn; int kind = 0; float scale = 1.f; bool rope_on = false;
        if (layer == 0) { const int t = pn >> 1; if (t == 0) scale = C2; else if (t == 3) { kind = 1; scale = C2; rope_on = true; } else if (t == 4) { kind = 2; rope_on = true; } }
        else { const int t = pn >> 2; if (t == 0) { kind = 1; scale = C2; } else if (t == 1) kind = 2; }
        const float* gv = (kind == 1) ? gq : gk;
        f32x4 g[2][2];
#pragma unroll
        for (int bj = 0; bj < 2; ++bj)
#pragma unroll
            for (int n = 0; n < 2; ++n) g[bj][n] = kind ? *(const f32x4*)(gv + 32 * bj + 8 * fq + 4 * n) : (f32x4){1.f, 1.f, 1.f, 1.f};
        const int row0 = u.pm * BM + wr * 64 + fr, col0 = pn * BM + wc * 64 + 8 * fq;
#pragma unroll
        for (int ai = 0; ai < 2; ++ai)
#pragma unroll
            for (int m = 0; m < 4; ++m) {
                const int row = row0 + ai * HALF + m * 16;
                const float r = (u.aux < RT_UNITS) ? rtab[u.aux * 256 + wr * 64 + fr + ai * HALF + m * 16] * pre : rsqrtf(row_ss(ss, nparts, row) * (1.f / 1024.f) + RMS_EPS) * pre;
                f32x4 v[2][2]; float s = 0.f;
#pragma unroll
                for (int bj = 0; bj < 2; ++bj)
#pragma unroll
                    for (int n = 0; n < 2; ++n) { v[bj][n] = acc[ai][bj][m][n] * r; const f32x4 x = v[bj][n]; s += (x[0] * x[0] + x[1] * x[1]) + (x[2] * x[2] + x[3] * x[3]); }
                if (kind) {
                    s += __shfl_xor(s, 16); s += __shfl_xor(s, 32);
                    const float rs = rsqrtf(s * (1.f / 64.f) + RMS_EPS);
#pragma unroll
                    for (int bj = 0; bj < 2; ++bj)
#pragma unroll
                        for (int n = 0; n < 2; ++n) v[bj][n] = v[bj][n] * rs * g[bj][n];
                    if (rope_on) {
                        f32x4 p[2];
#pragma unroll
                        for (int n = 0; n < 2; ++n)
#pragma unroll
                            for (int j = 0; j < 4; ++j) p[n][j] = __shfl_xor(v[0][n][j], 16);
                        const f32x4 c0 = *(const f32x4*)(rope + (size_t)row * 16), c1 = *(const f32x4*)(rope + (size_t)row * 16 + 4);
                        const f32x4 s0 = *(const f32x4*)(rope + (size_t)row * 16 + 8), s1 = *(const f32x4*)(rope + (size_t)row * 16 + 12);
                        if (fq == 0) { v[0][0] = v[0][0] * c0 - p[0] * s0; v[0][1] = v[0][1] * c1 - p[1] * s1; }
                        else if (fq == 1) { v[0][0] = v[0][0] * c0 + p[0] * s0; v[0][1] = v[0][1] * c1 + p[1] * s1; }
                    }
                }
                bf16_t* rowp = O + ((size_t)(pn * 4 + wc) * ldc + row) * 64 + 8 * fq;
#pragma unroll
                for (int bj = 0; bj < 2; ++bj) *(u32x4*)(rowp + 32 * bj) = pack8(v[bj][0] * scale, v[bj][1] * scale);
            }
    }
};

struct EpiResid {
    static constexpr bool PERM = true, AFTER_DRAIN = false;
    const float* base; float* out; bf16_t* xb; float* ss; float pre; unsigned char* x8;
    __device__ __forceinline__ void operator()(const f32x4 (&acc)[2][2][4][2], const Unit& u, int wr, int wc, int fr, int fq) const {
        const int row0 = u.pm * BM + wr * 64 + fr, col0 = u.pn * BM + wc * 32 + 8 * fq;
#pragma unroll
        for (int rp = 0; rp < 4; ++rp) {
            const int ai = rp >> 1; f32x4 bv[2][2][2];
#pragma unroll
            for (int mm = 0; mm < 2; ++mm)
#pragma unroll
                for (int bj = 0; bj < 2; ++bj) { const size_t off = (size_t)(row0 + ai * HALF + ((rp & 1) * 2 + mm) * 16) * 1024 + col0 + bj * HALF; bv[mm][bj][0] = *(const f32x4*)(base + off); bv[mm][bj][1] = *(const f32x4*)(base + off + 4); }
#pragma unroll
            for (int mm = 0; mm < 2; ++mm) { const int m = (rp & 1) * 2 + mm;
                const int row = row0 + ai * HALF + m * 16; float s = 0.f;
#pragma unroll
                for (int bj = 0; bj < 2; ++bj) {
                    const size_t off = (size_t)row * 1024 + col0 + bj * HALF;
                    const f32x4 v0 = acc[ai][bj][m][0] * pre + bv[mm][bj][0], v1 = acc[ai][bj][m][1] * pre + bv[mm][bj][1];
                    *(f32x4*)(out + off) = v0; *(f32x4*)(out + off + 4) = v1;
                    if (xb) *(u32x4*)(xb + off) = pack8(v0, v1);
                    if (x8) { typedef unsigned u32x2 __attribute__((ext_vector_type(2))); u32x2 w8; w8.x = pk4_fp8(v0[0], v0[1], v0[2], v0[3]); w8.y = pk4_fp8(v1[0], v1[1], v1[2], v1[3]); *(u32x2*)(x8 + off) = w8; }
                    s += (v0[0] * v0[0] + v0[1] * v0[1]) + (v0[2] * v0[2] + v0[3] * v0[3]) + (v1[0] * v1[0] + v1[1] * v1[1]) + (v1[2] * v1[2] + v1[3] * v1[3]);
                }
                if (ss) { s += __shfl_xor(s, 16); s += __shfl_xor(s, 32); if (fq == 0) ss[(size_t)row * 16 + u.pn * 4 + wc] = s; }
            }
        }
    }
};

template <bool OUT8> struct EpiSwiglu {
    static constexpr bool PERM = true, AFTER_DRAIN = false;
    void* O; int ldc; const float* ss; int nparts; const float* rowscale; int tile0; int npn; float pre; const PG8_LAS float* rtab;
    __device__ __forceinline__ void operator()(const f32x4 (&acc)[2][2][4][2], const Unit& u, int wr, int wc, int fr, int fq) const {
        const int pnl = u.pn % npn; const int row0 = u.pm * BM + wr * 64 + fr, col0 = pnl * HALF + wc * 32 + 8 * fq;
#pragma unroll
        for (int ai = 0; ai < 2; ++ai)
#pragma unroll
            for (int m = 0; m < 4; ++m) {
                const int row = row0 + ai * HALF + m * 16;
                const float r = (u.aux < RT_UNITS) ? rtab[u.aux * 256 + wr * 64 + fr + ai * HALF + m * 16] * pre : (rowscale ? rowscale[tile0 * BM + row] * pre : rsqrtf(row_ss(ss, nparts, row) * (1.f / 1024.f) + RMS_EPS) * pre);
                f32x4 a[2]; const float rl = -r * LOG2E, r2 = r * r;
#pragma unroll
                for (int n = 0; n < 2; ++n) { const f32x4 gq = acc[ai][0][m][n], t = gq * rl; f32x4 d;
#pragma unroll
                    for (int j = 0; j < 4; ++j) d[j] = __builtin_amdgcn_rcpf(1.f + __builtin_amdgcn_exp2f(t[j]));
                    a[n] = ((gq * acc[ai][1][m][n]) * r2) * d; }
                if constexpr (OUT8) { typedef unsigned u32x2 __attribute__((ext_vector_type(2))); u32x2 w; w.x = pk4_fp8(a[0][0], a[0][1], a[0][2], a[0][3]); w.y = pk4_fp8(a[1][0], a[1][1], a[1][2], a[1][3]); *(u32x2*)((unsigned char*)O + (size_t)row * ldc + col0) = w; }
                else *(u32x4*)((bf16_t*)O + (size_t)row * ldc + col0) = pack8(a[0], a[1]);
            }
    }
};

struct EpiMoeDown {
    static constexpr bool PERM = true, AFTER_DRAIN = false;
    float* out; const int* rowtok; const float* rowgate; int tile0; float pre; int nostore;
    __device__ __forceinline__ void operator()(const f32x4 (&acc)[2][2][4][2], const Unit& u, int wr, int wc, int fr, int fq) const {
        const int pnl = u.pn & 3; const int row0 = (tile0 + u.pm) * BM + wr * 64 + fr, col0 = pnl * BM + wc * 32 + 8 * fq;
        int tk[2][4]; float gt[2][4];
#pragma unroll
        for (int ai = 0; ai < 2; ++ai)
#pragma unroll
            for (int m = 0; m < 4; ++m) { const int srow = row0 + ai * HALF + m * 16; tk[ai][m] = nostore ? -1 : rowtok[srow]; gt[ai][m] = rowgate[srow] * pre; }
#pragma unroll
        for (int rp = 0; rp < 4; ++rp) { const int ai = rp >> 1; f32x4 ov[2][2][2];
#pragma unroll
            for (int mm = 0; mm < 2; ++mm) { const int m = (rp & 1) * 2 + mm; const int tc = tk[ai][m] > 0 ? tk[ai][m] : 0;
#pragma unroll
                for (int bj = 0; bj < 2; ++bj)
#pragma unroll
                    for (int n = 0; n < 2; ++n) ov[mm][bj][n] = *(const f32x4*)(out + (size_t)tc * 1024 + col0 + bj * HALF + 4 * n); }
#pragma unroll
            for (int mm = 0; mm < 2; ++mm) { const int m = (rp & 1) * 2 + mm;
                if (tk[ai][m] >= 0) {
#pragma unroll
                    for (int bj = 0; bj < 2; ++bj)
#pragma unroll
                        for (int n = 0; n < 2; ++n) *(f32x4*)(out + (size_t)tk[ai][m] * 1024 + col0 + bj * HALF + 4 * n) = ov[mm][bj][n] + acc[ai][bj][m][n] * gt[ai][m]; } }
        }
    }
};

typedef int i32x4 __attribute__((ext_vector_type(4)));
typedef int i32x8 __attribute__((ext_vector_type(8)));
template <class Epi, class Sched, bool ALIGN_EPI = false, bool SP2 = false, bool F8 = false>
__device__ __forceinline__ void gemm_phase(PG8_LAS unsigned char* lds, const Gemm g, const Sched& S, const Epi& E) {
    const int tid = threadIdx.x, wid = __builtin_amdgcn_readfirstlane(tid >> 6), lane = tid & 63, wr = wid >> 2, wc = wid & 3, fr = lane & 15, fq = lane >> 4;
    const int K = g.K, nt = K / BK;
    unsigned voffA[2], voffB[2];
#pragma unroll
    for (int i = 0; i < 2; ++i) { int R, C; stage_rc(tid * 16 + i * 8192, R, C); const int Rb = Epi::PERM ? ((R & ~31) + perm32(R & 31)) : R;
        voffA[i] = (unsigned)(R * K + C) * 2u; voffB[i] = (unsigned)(Rb * K + C) * 2u; }
    const size_t kstep = (size_t)(BK * 2);
    const size_t hstep = (size_t)HALF * K * 2;
    const size_t tstep = 2 * hstep;
    const unsigned ldsw = (unsigned)wid * 1024u;
    const int aoff = lds_byte(wr * 64 + fr, fq * 8), boff = lds_byte(wc * 32 + fr, fq * 8);
#define PG8_SA(b, h) (((b) * 2 + (h)) * HTB)
#define PG8_SB(b, h) ((4 + (b) * 2 + (h)) * HTB)
#define PG8_STAGE(bufoff, gbase, voff) do { _Pragma("unroll") for (int _i = 0; _i < 2; ++_i) \
        __builtin_amdgcn_global_load_lds((const unsigned*)((const char*)(gbase) + (voff)[_i]), (PG8_LAS unsigned*)(lds + (bufoff) + ldsw + _i * 8192), 16, 0, 0); } while (0)
#define PG8_LDA(dst, b, h) do { if constexpr (F8) { _Pragma("unroll") for (int m = 0; m < 4; ++m) dst##8[m] = PG8_CAT(*(const PG8_LAS bf16x8*)(lds + PG8_SA(b, h) + aoff + m * 2048), *(const PG8_LAS bf16x8*)(lds + PG8_SA(b, h) + aoff + m * 2048 + 1024)); } \
        else { _Pragma("unroll") for (int m = 0; m < 4; ++m) _Pragma("unroll") for (int k = 0; k < 2; ++k) dst[m][k] = *(const PG8_LAS bf16x8*)(lds + PG8_SA(b, h) + aoff + m * 2048 + k * 1024); } } while (0)
#define PG8_LDB(dst, b, h) do { if constexpr (F8) { _Pragma("unroll") for (int n = 0; n < 2; ++n) dst##8[n] = PG8_CAT(*(const PG8_LAS bf16x8*)(lds + PG8_SB(b, h) + boff + n * 2048), *(const PG8_LAS bf16x8*)(lds + PG8_SB(b, h) + boff + n * 2048 + 1024)); } \
        else { _Pragma("unroll") for (int n = 0; n < 2; ++n) _Pragma("unroll") for (int k = 0; k < 2; ++k) dst[n][k] = *(const PG8_LAS bf16x8*)(lds + PG8_SB(b, h) + boff + n * 2048 + k * 1024); } } while (0)
#define PG8_CAT(x, y) __builtin_shufflevector(__builtin_bit_cast(i32x4, (x)), __builtin_bit_cast(i32x4, (y)), 0, 1, 2, 3, 4, 5, 6, 7)
#define PG8_MMA(ai, bj, At, Bt) do { __builtin_amdgcn_s_setprio(1); _Pragma("unroll") for (int m = 0; m < 4; ++m) _Pragma("unroll") for (int n = 0; n < 2; ++n) { \
        if constexpr (F8) { asm volatile("v_mfma_f32_16x16x128_f8f6f4 %0, %1, %2, %0" : "+v"(acc[ai][bj][m][n]) : "v"(Bt##8[n]), "v"(At##8[m])); } \
        else { _Pragma("unroll") for (int k = 0; k < 2; ++k) acc[ai][bj][m][n] = __builtin_amdgcn_mfma_f32_16x16x32_bf16(Bt[n][k], At[m][k], acc[ai][bj][m][n], 0, 0, 0); } } __builtin_amdgcn_s_setprio(0); } while (0)
#define PG8_WAIT_V(n) asm volatile("s_waitcnt vmcnt(" #n ")" ::: "memory")
#define PG8_WAIT_L(n) asm volatile("s_waitcnt lgkmcnt(" #n ")" ::: "memory")
#define PG8_BAR __builtin_amdgcn_s_barrier()
#define PG8_SCHED __builtin_amdgcn_sched_barrier(0)
    Unit cur, nxt; int ui = 0;
    if (!S.next(0, cur)) return;
    f32x4 acc[2][2][4][2];
#pragma unroll
    for (int a = 0; a < 2; ++a)
#pragma unroll
        for (int b = 0; b < 2; ++b)
#pragma unroll
            for (int m = 0; m < 4; ++m)
#pragma unroll
                for (int n = 0; n < 2; ++n) acc[a][b][m][n] = (f32x4){0.f, 0.f, 0.f, 0.f};
    bf16x8 At[4][2], B0[2][2], B1[2][2];
    i32x8 At8[4], B08[2], B18[2];
    const char* cA = (const char*)g.A + (size_t)cur.pm * tstep; const char* cB = (const char*)g.Bt + (size_t)cur.pn * tstep;
    S.a_ready(cur);
    if constexpr (SP2) {
        PG8_STAGE(PG8_SB(0, 0), cB, voffB); PG8_STAGE(PG8_SB(0, 1), cB + hstep, voffB); PG8_STAGE(PG8_SA(0, 0), cA, voffA); PG8_STAGE(PG8_SA(0, 1), cA + hstep, voffA);
        if (wr == 1) PG8_BAR;
        PG8_WAIT_V(2); PG8_BAR;
        PG8_STAGE(PG8_SB(1, 0), cB + kstep, voffB); PG8_STAGE(PG8_SA(1, 0), cA + kstep, voffA); PG8_STAGE(PG8_SB(1, 1), cB + hstep + kstep, voffB);
        PG8_WAIT_V(6); PG8_BAR;
    } else {
        PG8_STAGE(PG8_SB(0, 0), cB, voffB); PG8_STAGE(PG8_SA(0, 0), cA, voffA); PG8_STAGE(PG8_SB(0, 1), cB + hstep, voffB); PG8_STAGE(PG8_SA(0, 1), cA + hstep, voffA);
        if (wr == 1) PG8_BAR;
        PG8_WAIT_V(4); PG8_BAR;
        PG8_STAGE(PG8_SB(1, 0), cB + kstep, voffB); PG8_STAGE(PG8_SA(1, 0), cA + kstep, voffA); PG8_STAGE(PG8_SB(1, 1), cB + hstep + kstep, voffB);
        PG8_WAIT_V(6); PG8_BAR;
    }
    for (;;) {
        const bool has_next = S.next(ui + 1, nxt);
        const char* nA = has_next ? (const char*)g.A + (size_t)nxt.pm * tstep : cA; const char* nB = has_next ? (const char*)g.Bt + (size_t)nxt.pn * tstep : cB;
#pragma nounroll
        for (int t = 0; t < nt; t += 2) {
            const bool last = (t == nt - 2);
            const char* a1 = cA + (size_t)(t + 1) * kstep;
            const char* a2 = last ? nA : cA + (size_t)(t + 2) * kstep; const char* b2 = last ? nB : cB + (size_t)(t + 2) * kstep;
            const char* a3 = a2 + kstep; const char* b3 = b2 + kstep;
            if (last && has_next) S.a_ready(nxt);
            if constexpr (SP2) {
            PG8_LDB(B0, 0, 0); PG8_LDB(B1, 0, 1); PG8_SCHED; PG8_LDA(At, 0, 0); PG8_STAGE(PG8_SA(1, 1), a1 + hstep, voffA);
            PG8_WAIT_V(8); PG8_WAIT_L(0); PG8_BAR; PG8_MMA(0, 0, At, B0); PG8_MMA(0, 1, At, B1); PG8_BAR; PG8_SCHED;
            PG8_LDA(At, 0, 1); PG8_STAGE(PG8_SB(0, 0), b2, voffB); PG8_STAGE(PG8_SB(0, 1), b2 + hstep, voffB); PG8_STAGE(PG8_SA(0, 0), a2, voffA);
            PG8_WAIT_V(8); PG8_WAIT_L(0); PG8_BAR; PG8_MMA(1, 0, At, B0); PG8_MMA(1, 1, At, B1); PG8_BAR; PG8_SCHED;
            PG8_LDB(B0, 1, 0); PG8_LDB(B1, 1, 1); PG8_SCHED; PG8_LDA(At, 1, 0); PG8_STAGE(PG8_SA(0, 1), a2 + hstep, voffA);
            PG8_WAIT_V(8); PG8_WAIT_L(0); PG8_BAR; PG8_MMA(0, 0, At, B0); PG8_MMA(0, 1, At, B1); PG8_BAR; PG8_SCHED;
            PG8_LDA(At, 1, 1); PG8_STAGE(PG8_SB(1, 0), b3, voffB); PG8_STAGE(PG8_SB(1, 1), b3 + hstep, voffB); PG8_STAGE(PG8_SA(1, 0), a3, voffA);
            PG8_WAIT_V(8); PG8_WAIT_L(0); PG8_BAR; PG8_MMA(1, 0, At, B0); PG8_MMA(1, 1, At, B1); PG8_BAR; PG8_SCHED;
            } else {
            PG8_LDB(B0, 0, 0); PG8_SCHED; PG8_LDA(At, 0, 0); PG8_STAGE(PG8_SA(1, 1), a1 + hstep, voffA);
            PG8_WAIT_L(8); PG8_BAR; PG8_WAIT_L(0); PG8_MMA(0, 0, At, B0); PG8_BAR; PG8_SCHED;
            PG8_LDB(B1, 0, 1); PG8_STAGE(PG8_SB(0, 0), b2, voffB);
            PG8_BAR; PG8_WAIT_L(0); PG8_MMA(0, 1, At, B1); PG8_BAR;
            PG8_LDA(At, 0, 1); PG8_STAGE(PG8_SA(0, 0), a2, voffA);
            PG8_BAR; PG8_WAIT_L(0); PG8_MMA(1, 0, At, B0); PG8_BAR; PG8_SCHED;
            PG8_STAGE(PG8_SB(0, 1), b2 + hstep, voffB);
            PG8_WAIT_V(6); PG8_BAR; PG8_MMA(1, 1, At, B1); PG8_BAR;
            PG8_LDB(B0, 1, 0); PG8_SCHED; PG8_LDA(At, 1, 0); PG8_STAGE(PG8_SA(0, 1), a2 + hstep, voffA);
            PG8_WAIT_L(8); PG8_BAR; PG8_WAIT_L(0); PG8_MMA(0, 0, At, B0); PG8_BAR; PG8_SCHED;
            PG8_LDB(B1, 1, 1); PG8_STAGE(PG8_SB(1, 0), b3, voffB);
            PG8_BAR; PG8_WAIT_L(0); PG8_MMA(0, 1, At, B1); PG8_BAR;
            PG8_LDA(At, 1, 1); PG8_STAGE(PG8_SA(1, 0), a3, voffA);
            PG8_BAR; PG8_WAIT_L(0); PG8_MMA(1, 0, At, B0); PG8_BAR; PG8_SCHED;
            PG8_STAGE(PG8_SB(1, 1), b3 + hstep, voffB);
            PG8_WAIT_V(6); PG8_BAR; PG8_MMA(1, 1, At, B1); PG8_BAR;
            }
        }
        if constexpr (F8) asm volatile("s_nop 15\n\ts_nop 15\n\ts_nop 15" ::: "memory");
        if constexpr (ALIGN_EPI) { if (wr == 0) PG8_BAR; }
        if constexpr (!Epi::AFTER_DRAIN) { E(acc, cur, wr, wc, fr, fq); S.done(cur); }
        if (!has_next) break;
#pragma unroll
        for (int a = 0; a < 2; ++a)
#pragma unroll
            for (int b = 0; b < 2; ++b)
#pragma unroll
                for (int m = 0; m < 4; ++m)
#pragma unroll
                    for (int n = 0; n < 2; ++n) acc[a][b][m][n] = (f32x4){0.f, 0.f, 0.f, 0.f};
        cur = nxt; cA = nA; cB = nB; ++ui;
        if constexpr (ALIGN_EPI) { if (wr == 1) PG8_BAR; }
    }
    PG8_WAIT_V(0);
    if constexpr (!ALIGN_EPI) { if (wr == 0) PG8_BAR; }
    PG8_BAR;
    if constexpr (Epi::AFTER_DRAIN) { E.fused(acc, cur, wr, wc, fr, fq, lds, wid, lane); S.done(cur); }
#undef PG8_SA
#undef PG8_SB
#undef PG8_STAGE
#undef PG8_LDA
#undef PG8_LDB
#undef PG8_MMA
#undef PG8_CAT
#undef PG8_WAIT_V
#undef PG8_WAIT_L
#undef PG8_BAR
#undef PG8_SCHED
}
}

namespace att {
using pg8::bf16_t; using pg8::bf16x8; using pg8::u32x4;
typedef float f32x16 __attribute__((ext_vector_type(16)));
typedef short s16x4 __attribute__((ext_vector_type(4)));
typedef float f32x2_t __attribute__((ext_vector_type(2))); typedef __bf16 bf16x2_t __attribute__((ext_vector_type(2)));
#define ALAS __attribute__((address_space(3)))
typedef ALAS const char* lds_cptr;
constexpr int SEQ = 8192, PITCH = 64, VNEXT = 2 * SEQ * 64;
constexpr int KVSLOT = 24576;
constexpr int L_WS = 114688, L_TAB = L_WS + 2048, L_FLAG = L_TAB + 1056, L_END = L_FLAG + 128, L_OST = 0;
constexpr float SB_THR = 152.f;
__device__ __forceinline__ int crow(int r, int hi) { return (r & 3) + 8 * (r >> 2) + 4 * hi; }
__device__ __forceinline__ void glds16(const void* gsrc, unsigned lds_dst) { unsigned keep;
    asm volatile("s_mov_b32 %0, m0\n\ts_mov_b32 m0, %2\n\ts_nop 0\n\tglobal_load_lds_dwordx4 %1, off\n\ts_mov_b32 m0, %0" : "=&s"(keep) : "v"(gsrc), "s"(lds_dst) : "memory"); }
__device__ __forceinline__ unsigned cvtpk(float lo, float hi) { f32x2_t v = {lo, hi}; bf16x2_t b = __builtin_convertvector(v, bf16x2_t); return __builtin_bit_cast(unsigned, b); }
__device__ __forceinline__ unsigned short f2bf(float f) { unsigned u = __builtin_bit_cast(unsigned, f); return (unsigned short)((u + 0x7fffu + ((u >> 16) & 1u)) >> 16); }
#define MFMA32(a, b, c) __builtin_amdgcn_mfma_f32_32x32x16_bf16((a), (b), (c), 0, 0, 0)

__device__ __forceinline__ void qkt(f32x16& p0, f32x16& p1, lds_cptr kb, const bf16x8* qr, const f32x16& cin) {
#pragma unroll
    for (int d0 = 0; d0 < 4; ++d0) {
        const bf16x8 b0 = *(const ALAS bf16x8*)(kb + d0 * 2048);
        const bf16x8 b1 = *(const ALAS bf16x8*)(kb + d0 * 2048 + 512);
        if (d0 == 0) { p0 = MFMA32(b0, qr[0], cin); p1 = MFMA32(b1, qr[0], cin); }
        else { p0 = MFMA32(b0, qr[d0], p0); p1 = MFMA32(b1, qr[d0], p1); }
    }
}

__device__ __forceinline__ void qkt_sw(f32x16& p0, f32x16& p1, lds_cptr ks, const int (&kofs)[4], const bf16x8* qr, const f32x16& cin) {
    bf16x8 kf[8];
#pragma unroll
    for (int d0 = 0; d0 < 4; ++d0) { kf[2 * d0] = *(const ALAS bf16x8*)(ks + kofs[d0]); kf[2 * d0 + 1] = *(const ALAS bf16x8*)(ks + kofs[d0] + 4096); }
    p0 = MFMA32(kf[0], qr[0], cin); p1 = MFMA32(kf[1], qr[0], cin);
#pragma unroll
    for (int d0 = 1; d0 < 4; ++d0) { p0 = MFMA32(kf[2 * d0], qr[d0], p0); p1 = MFMA32(kf[2 * d0 + 1], qr[d0], p1); }
}
template <int ND> __device__ __forceinline__ void pv(f32x16* o, int vb, bf16x8 pa0, bf16x8 pa1, bf16x8 pa2, bf16x8 pa3) {
#pragma unroll
    for (int d0 = 0; d0 < ND; ++d0) { s16x4 lo[4], hi[4];
#pragma unroll
        for (int ks = 0; ks < 4; ++ks) {
            asm volatile("ds_read_b64_tr_b16 %0,%1 offset:%c2" : "=&v"(lo[ks]) : "v"(vb), "i"(d0 * 4096 + ks * 1024) : "memory");
            asm volatile("ds_read_b64_tr_b16 %0,%1 offset:%c2" : "=&v"(hi[ks]) : "v"(vb), "i"(d0 * 4096 + ks * 1024 + 512) : "memory"); }
        asm volatile("s_waitcnt lgkmcnt(0)" ::: "memory"); __builtin_amdgcn_sched_barrier(0);
#define ATT_PK(k) (bf16x8){lo[k][0], lo[k][1], lo[k][2], lo[k][3], hi[k][0], hi[k][1], hi[k][2], hi[k][3]}
        o[d0] = MFMA32(pa0, ATT_PK(0), o[d0]);
        o[d0] = MFMA32(pa1, ATT_PK(1), o[d0]);
        o[d0] = MFMA32(pa2, ATT_PK(2), o[d0]);
        o[d0] = MFMA32(pa3, ATT_PK(3), o[d0]);
#undef ATT_PK
    }
}

template <int MODE, int VD, bool OUT8 = false, int TPB = 1>
__device__ __forceinline__ void attn_unit(ALAS char* shm, const bf16_t* Qb, const bf16_t* Kb, const bf16_t* Vb, void* Ob, int opitch, int q0, float mref2, const float* tab, float oscale = 1.f, int dbg = 0) {
    constexpr int ND = VD / 32, SLOT = 8192 + VD * 128;
    static_assert(2 * TPB * SLOT <= L_WS, "ring vs LDS map");
    const int tid = threadIdx.x, lane = tid & 63, r32 = lane & 31, hi = lane >> 5; const int wid = __builtin_amdgcn_readfirstlane(tid >> 6);
    const unsigned lds0 = (unsigned)(uintptr_t)shm;
    ALAS float* wsf = (ALAS float*)(shm + L_WS) + wid * 64;
    ALAS float* tabL = (ALAS float*)(shm + L_TAB);
    ALAS unsigned* flg = (ALAS unsigned*)(shm + L_FLAG);
    if (MODE == 1) { for (int i = tid; i < 257; i += 512) tabL[i] = tab[i] * pg8::LOG2E; }
    const bf16_t* Qw = Qb + (size_t)(q0 + wid * 32) * PITCH;
    bf16x8 qr[4];
#pragma unroll
    for (int d0 = 0; d0 < 4; ++d0) qr[d0] = *(const bf16x8*)(Qw + (size_t)r32 * PITCH + d0 * 16 + hi * 8);
    int t_first, n_t, t_step;
    if (MODE == 0) { t_first = 0; n_t = q0 / 64 + 4; t_step = 1; }
    else if (MODE == 1) { const int c0 = q0 / 64; t_first = c0 - 8 > 0 ? c0 - 8 : 0; n_t = c0 + 4 - t_first; t_step = 1; }
    else { t_first = q0 / 64 + 3; n_t = q0 / 64 + 4; t_step = -1; }
    const int krow = 8 * wid + (lane >> 3);
    const bf16_t* ksrc = Kb + (size_t)krow * PITCH + (((lane & 7) ^ ((krow >> 1) & 7)) * 8);
    int kofs[4];
#pragma unroll
    for (int d0 = 0; d0 < 4; ++d0) kofs[d0] = (r32 >> 3) * 1024 + ((r32 & 7) * 8 + ((2 * d0 + hi) ^ ((r32 >> 1) & 7))) * 16;
    const bf16_t* vsrc = Vb + (size_t)(16 * (wid & 3) + (lane >> 2)) * PITCH + (wid >> 2) * 32 + (lane & 3) * 8;
#define ATT_DMA(t, slot) do { if (dbg & 64) break; const size_t to_ = (size_t)(t) * 64 * PITCH; const unsigned sb_ = lds0 + (unsigned)(slot) * SLOT; \
        glds16(ksrc + to_, (unsigned)__builtin_amdgcn_readfirstlane(sb_ + wid * 1024)); \
        glds16(vsrc + to_, (unsigned)__builtin_amdgcn_readfirstlane(sb_ + 8192 + wid * 1024)); \
        if (VD == 128) glds16(vsrc + to_ + VNEXT, (unsigned)__builtin_amdgcn_readfirstlane(sb_ + 8192 + (wid + 8) * 1024)); } while (0)
    f32x16 o[ND];
#pragma unroll
    for (int d = 0; d < ND; ++d) o[d] = f32x16{};
    f32x16 cin;
#pragma unroll
    for (int r = 0; r < 16; ++r) cin[r] = (MODE == 2) ? 0.f : -mref2;
    float l_reg = 0.f, A = 0.f; bool wdone = false;
    const int wrow0 = q0 + wid * 32, qrow = wrow0 + r32;
    const int vb0 = (int)lds0 + 8192 + ((lane >> 4) & 1) * 32 + (lane & 3) * 8 + (4 * hi + ((lane & 15) >> 2)) * 64;
    asm volatile("s_waitcnt vmcnt(0)" ::: "memory"); asm volatile("" : "+v"(qr[0]), "+v"(qr[1]), "+v"(qr[2]), "+v"(qr[3]));
#pragma unroll
    for (int u = 0; u < TPB; ++u) ATT_DMA(t_first + u * t_step, u);
    for (int i = 0; i < n_t; ++i) {
        const int t = t_first + i * t_step, slot = i % (2 * TPB);
        if (i % TPB == 0) {
        asm volatile("s_waitcnt vmcnt(0) lgkmcnt(0)\n\ts_barrier" ::: "memory");
        if (MODE == 2 && i > 0) { const int par = ((i - 1) & 3) * 8; unsigned all = 1u;
#pragma unroll
            for (int w = 0; w < 8; ++w) all &= flg[par + w];
            if (__builtin_amdgcn_readfirstlane(all)) break; }
        if (i + TPB < n_t) {
#pragma unroll
            for (int u = 0; u < TPB; ++u) ATT_DMA(t + (TPB + u) * t_step, (i + TPB + u) % (2 * TPB)); }
        }
        bool active;
        if (MODE == 0) active = (64 * t <= wrow0);
        else if (MODE == 1) { const int cw = wrow0 / 64; active = (t >= cw - 8) && (t <= cw); }
        else active = !wdone && (64 * t < wrow0 + 31);
        if (active && !(dbg & 32)) {
            f32x16 p0, p1; qkt_sw(p0, p1, (lds_cptr)shm + slot * SLOT, kofs, qr, cin);
            if (MODE == 0) {
#pragma unroll
                for (int r = 0; r < 16; ++r) { p0[r] = __builtin_amdgcn_exp2f(p0[r]); p1[r] = __builtin_amdgcn_exp2f(p1[r]); }
            } else if (MODE == 1) {
                const int cw = wrow0 / 64;
                if (t <= cw - 3) { const float cb = tabL[256];
#pragma unroll
                    for (int r = 0; r < 16; ++r) { p0[r] = __builtin_amdgcn_exp2f(p0[r] + cb); p1[r] = __builtin_amdgcn_exp2f(p1[r] + cb); }
                } else { const int dq = qrow - 64 * t - 4 * hi;
#pragma unroll
                    for (int r = 0; r < 16; ++r) { int d0 = dq - ((r & 3) + 8 * (r >> 2)), d1 = d0 - 32;
                        d0 = d0 < -128 ? -128 : (d0 > 128 ? 128 : d0); d1 = d1 < -128 ? -128 : (d1 > 128 ? 128 : d1);
                        p0[r] = __builtin_amdgcn_exp2f(p0[r] + tabL[d0 + 128]); p1[r] = __builtin_amdgcn_exp2f(p1[r] + tabL[d1 + 128]); }
                }
            } else {
                const bool needmask = (64 * t + 63 >= wrow0);
                const int kq = qrow - 64 * t - 4 * hi;
                float g[8];
#pragma unroll
                for (int k = 0; k < 8; ++k) g[k] = 0.f;
                f32x16 s0, s1;
#pragma unroll
                for (int r = 0; r < 16; ++r) { const int kv = (r & 3) + 8 * (r >> 2);
                    { const float y = p0[r], a = __builtin_fabsf(y); float sp = __builtin_fmaxf(y, 0.f) + __builtin_amdgcn_logf(1.f + __builtin_amdgcn_exp2f(-a)); if (needmask && !(kv < kq)) sp = 0.f; s0[r] = sp; g[r >> 2] += sp; }
                    { const float y = p1[r], a = __builtin_fabsf(y); float sp = __builtin_fmaxf(y, 0.f) + __builtin_amdgcn_logf(1.f + __builtin_amdgcn_exp2f(-a)); if (needmask && !(kv + 32 < kq)) sp = 0.f; s1[r] = sp; g[4 + (r >> 2)] += sp; } }
                float pg[8];
#pragma unroll
                for (int k = 0; k < 8; ++k) pg[k] = __shfl_xor(g[k], 32);
                float base[8]; float own = 0.f, par = 0.f;
#pragma unroll
                for (int k = 7; k >= 0; --k) { const float par_incl = par + pg[k]; base[k] = A + own + (hi == 0 ? par_incl : par); own += g[k]; par = par_incl; }
                A += own + par;
#pragma unroll
                for (int k = 0; k < 4; ++k) {
                    { float c = base[k]; c += s0[4 * k + 3]; const float w3 = __builtin_amdgcn_exp2f(p0[4 * k + 3] - c); c += s0[4 * k + 2]; const float w2 = __builtin_amdgcn_exp2f(p0[4 * k + 2] - c);
                      c += s0[4 * k + 1]; const float w1 = __builtin_amdgcn_exp2f(p0[4 * k + 1] - c); c += s0[4 * k]; const float w0 = __builtin_amdgcn_exp2f(p0[4 * k] - c);
                      p0[4 * k] = w0; p0[4 * k + 1] = w1; p0[4 * k + 2] = w2; p0[4 * k + 3] = w3; }
                    { float c = base[4 + k]; c += s1[4 * k + 3]; const float w3 = __builtin_amdgcn_exp2f(p1[4 * k + 3] - c); c += s1[4 * k + 2]; const float w2 = __builtin_amdgcn_exp2f(p1[4 * k + 2] - c);
                      c += s1[4 * k + 1]; const float w1 = __builtin_amdgcn_exp2f(p1[4 * k + 1] - c); c += s1[4 * k]; const float w0 = __builtin_amdgcn_exp2f(p1[4 * k] - c);
                      p1[4 * k] = w0; p1[4 * k + 1] = w1; p1[4 * k + 2] = w2; p1[4 * k + 3] = w3; }
                }
                if (needmask) {
#pragma unroll
                    for (int r = 0; r < 16; ++r) { const int kv = (r & 3) + 8 * (r >> 2); if (!(kv < kq)) p0[r] = 0.f; if (!(kv + 32 < kq)) p1[r] = 0.f; }
                }
                wdone = __all(A >= SB_THR);
            }
            if (MODE != 2) { float s = 0.f;
#pragma unroll
                for (int r = 0; r < 16; ++r) s += p0[r] + p1[r];
                l_reg += s; }
            u32x4 pw0, pw1, pw2, pw3;
            pw0 = (u32x4){cvtpk(p0[0], p0[1]), cvtpk(p0[2], p0[3]), cvtpk(p0[4], p0[5]), cvtpk(p0[6], p0[7])};
            pw1 = (u32x4){cvtpk(p0[8], p0[9]), cvtpk(p0[10], p0[11]), cvtpk(p0[12], p0[13]), cvtpk(p0[14], p0[15])};
            pw2 = (u32x4){cvtpk(p1[0], p1[1]), cvtpk(p1[2], p1[3]), cvtpk(p1[4], p1[5]), cvtpk(p1[6], p1[7])};
            pw3 = (u32x4){cvtpk(p1[8], p1[9]), cvtpk(p1[10], p1[11]), cvtpk(p1[12], p1[13]), cvtpk(p1[14], p1[15])};
            pv<ND>(o, vb0 + slot * SLOT, __builtin_bit_cast(bf16x8, pw0), __builtin_bit_cast(bf16x8, pw1), __builtin_bit_cast(bf16x8, pw2), __builtin_bit_cast(bf16x8, pw3));
        }
        if (MODE == 2) { if (lane == 0) flg[(i & 3) * 8 + wid] = wdone ? 1u : 0u; }
    }
#undef ATT_DMA
    asm volatile("s_waitcnt vmcnt(0) lgkmcnt(0)\n\ts_barrier" ::: "memory");
    float rl[16];
    if (MODE != 2) {
        l_reg += __shfl_xor(l_reg, 32);
        if (hi == 0) wsf[32 + r32] = l_reg;
        asm volatile("s_waitcnt lgkmcnt(0)" ::: "memory");
#pragma unroll
        for (int r = 0; r < 16; ++r) rl[r] = __builtin_amdgcn_rcpf(wsf[32 + crow(r, hi)]) * oscale;
    } else {
#pragma unroll
        for (int r = 0; r < 16; ++r) rl[r] = oscale;
    }
    if constexpr (OUT8) {
        static_assert(!OUT8 || VD == 64, "fp8 output: 64-wide heads");
        unsigned char* Ow = (unsigned char*)Ob + (size_t)(q0 + wid * 32) * opitch;
        ALAS unsigned char* stg = (ALAS unsigned char*)(shm + L_OST) + wid * 2048;
#pragma unroll
        for (int r = 0; r < 16; ++r) { const int orow = crow(r, hi);
#pragma unroll
            for (int d0 = 0; d0 < 2; ++d0) { const float v = o[d0][r] * rl[r]; stg[orow * 64 + d0 * 32 + r32] = (unsigned char)(__builtin_amdgcn_cvt_pk_fp8_f32(v, v, 0, false) & 0xff); } }
        asm volatile("s_waitcnt lgkmcnt(0)" ::: "memory");
#pragma unroll
        for (int i = 0; i < 2; ++i) { const int row = i * 16 + (lane >> 2), ch = lane & 3; const u32x4 v = *(const ALAS u32x4*)(stg + row * 64 + ch * 16); *(u32x4*)(Ow + (size_t)row * opitch + ch * 16) = v; }
        asm volatile("s_waitcnt lgkmcnt(0)" ::: "memory");
    } else {
    bf16_t* Ow = (bf16_t*)Ob + (size_t)(q0 + wid * 32) * opitch;
    ALAS bf16_t* stg = (ALAS bf16_t*)(shm + L_OST) + wid * 2048;
#pragma unroll
    for (int half = 0; half < ND / 2; ++half) {
#pragma unroll
        for (int r = 0; r < 16; ++r) { const int orow = crow(r, hi);
#pragma unroll
            for (int d0 = 0; d0 < 2; ++d0) stg[orow * 64 + d0 * 32 + r32] = f2bf(o[half * 2 + d0][r] * rl[r]); }
        asm volatile("s_waitcnt lgkmcnt(0)" ::: "memory");
#pragma unroll
        for (int i = 0; i < 4; ++i) { const int row = i * 8 + (lane >> 3), ch = lane & 7; const u32x4 v = *(const ALAS u32x4*)(stg + row * 64 + ch * 8); *(u32x4*)(Ow + (size_t)row * opitch + half * 64 + ch * 8) = v; }
        asm volatile("s_waitcnt lgkmcnt(0)" ::: "memory");
    }
    }
    asm volatile("s_waitcnt vmcnt(0) lgkmcnt(0)\n\ts_barrier" ::: "memory");
}


__device__ __forceinline__ void qkt8(f32x16& p0, f32x16& p1, lds_cptr kb, const bf16x8* qr, const f32x16& cin) {
    bf16x8 kf[8];
#pragma unroll
    for (int d0 = 0; d0 < 4; ++d0) { kf[2 * d0] = *(const ALAS bf16x8*)(kb + d0 * 2048); kf[2 * d0 + 1] = *(const ALAS bf16x8*)(kb + d0 * 2048 + 512); }
    __builtin_amdgcn_sched_barrier(0);
    p0 = MFMA32(kf[0], qr[0], cin); p1 = MFMA32(kf[1], qr[0], cin);
#pragma unroll
    for (int d0 = 1; d0 < 4; ++d0) { p0 = MFMA32(kf[2 * d0], qr[d0], p0); p1 = MFMA32(kf[2 * d0 + 1], qr[d0], p1); }
}
template <int ND, int KS0> __device__ __forceinline__ void v_reads(s16x4 (&lo)[ND][2], s16x4 (&hi)[ND][2], int vb) {
#pragma unroll
    for (int ks = 0; ks < 2; ++ks)
#pragma unroll
        for (int d0 = 0; d0 < ND; ++d0) {
            asm volatile("ds_read_b64_tr_b16 %0,%1 offset:%c2" : "=&v"(lo[d0][ks]) : "v"(vb), "i"(d0 * 4096 + (KS0 + ks) * 1024) : "memory");
            asm volatile("ds_read_b64_tr_b16 %0,%1 offset:%c2" : "=&v"(hi[d0][ks]) : "v"(vb), "i"(d0 * 4096 + (KS0 + ks) * 1024 + 512) : "memory"); }
}
template <int ND> __device__ __forceinline__ void pv_half(f32x16* o, const s16x4 (&lo)[ND][2], const s16x4 (&hi)[ND][2], bf16x8 pa, bf16x8 pb) {
#define ATT_PK2(d, k) (bf16x8){lo[d][k][0], lo[d][k][1], lo[d][k][2], lo[d][k][3], hi[d][k][0], hi[d][k][1], hi[d][k][2], hi[d][k][3]}
#pragma unroll
    for (int d0 = 0; d0 < ND; ++d0) o[d0] = MFMA32(pa, ATT_PK2(d0, 0), o[d0]);
#pragma unroll
    for (int d0 = 0; d0 < ND; ++d0) o[d0] = MFMA32(pb, ATT_PK2(d0, 1), o[d0]);
#undef ATT_PK2
}
template <int MODE> __device__ __forceinline__ void p_half(f32x16& p, float& l_reg, u32x4& wa, u32x4& wb, bool const_bias, int dq, const ALAS float* tabL) {
    if (MODE == 0) {
#pragma unroll
        for (int r = 0; r < 16; ++r) p[r] = __builtin_amdgcn_exp2f(p[r]);
    } else if (const_bias) { const float cb = tabL[256];
#pragma unroll
        for (int r = 0; r < 16; ++r) p[r] = __builtin_amdgcn_exp2f(p[r] + cb);
    } else {
#pragma unroll
        for (int r = 0; r < 16; ++r) { int d = dq - ((r & 3) + 8 * (r >> 2)); d = d < -128 ? -128 : (d > 128 ? 128 : d); p[r] = __builtin_amdgcn_exp2f(p[r] + tabL[d + 128]); }
    }
    float s = 0.f;
#pragma unroll
    for (int r = 0; r < 16; ++r) s += p[r];
    l_reg += s;
    wa = (u32x4){cvtpk(p[0], p[1]), cvtpk(p[2], p[3]), cvtpk(p[4], p[5]), cvtpk(p[6], p[7])};
    wb = (u32x4){cvtpk(p[8], p[9]), cvtpk(p[10], p[11]), cvtpk(p[12], p[13]), cvtpk(p[14], p[15])};
}
__device__ __forceinline__ void vm_wait_n(int n) {
    if (n <= 0) asm volatile("s_waitcnt vmcnt(0)" ::: "memory"); else if (n == 1) asm volatile("s_waitcnt vmcnt(1)" ::: "memory"); else if (n == 2) asm volatile("s_waitcnt vmcnt(2)" ::: "memory");
    else if (n == 3) asm volatile("s_waitcnt vmcnt(3)" ::: "memory"); else if (n == 4) asm volatile("s_waitcnt vmcnt(4)" ::: "memory"); else if (n == 5) asm volatile("s_waitcnt vmcnt(5)" ::: "memory");
    else if (n == 6) asm volatile("s_waitcnt vmcnt(6)" ::: "memory"); else if (n == 7) asm volatile("s_waitcnt vmcnt(7)" ::: "memory"); else if (n == 8) asm volatile("s_waitcnt vmcnt(8)" ::: "memory");
    else if (n == 9) asm volatile("s_waitcnt vmcnt(9)" ::: "memory"); else if (n == 10) asm volatile("s_waitcnt vmcnt(10)" ::: "memory"); else asm volatile("s_waitcnt vmcnt(11)" ::: "memory");
}
template <int MODE, int VD, bool OUT8 = false, int PD = 3>
__device__ __forceinline__ void attn_unit_pp(ALAS char* shm, const bf16_t* Qb, const bf16_t* Kb, const bf16_t* Vb, void* Ob, int opitch, int q0, float mref2, const float* tab, float oscale = 1.f, int dbg = 0) {
    static_assert(MODE == 0 || MODE == 1, "ping-pong loop: softmax modes only");
    constexpr int ND = VD / 32, NV = VD / 64, NS = PD + 1, PER = 1 + NV, SLOT = 8192 + VD * 128;
    static_assert(NS * SLOT <= L_WS, "ring vs LDS map");
    const int tid = threadIdx.x, lane = tid & 63, r32 = lane & 31, hi = lane >> 5; const int wid = __builtin_amdgcn_readfirstlane(tid >> 6); const int grp = wid >> 2;
    const unsigned lds0 = (unsigned)(uintptr_t)shm;
    ALAS float* wsf = (ALAS float*)(shm + L_WS) + wid * 64;
    ALAS float* tabL = (ALAS float*)(shm + L_TAB);
    if (MODE == 1) { for (int i = tid; i < 257; i += 512) tabL[i] = tab[i] * pg8::LOG2E; }
    const bf16_t* Qw = Qb + (size_t)(q0 + wid * 32) * PITCH;
    bf16x8 qr[4];
#pragma unroll
    for (int d0 = 0; d0 < 4; ++d0) qr[d0] = *(const bf16x8*)(Qw + (size_t)r32 * PITCH + d0 * 16 + hi * 8);
    int t_first, n_t;
    if (MODE == 0) { t_first = 0; n_t = q0 / 64 + 4; }
    else { const int c0 = q0 / 64; t_first = c0 - 8 > 0 ? c0 - 8 : 0; n_t = c0 + 4 - t_first; }
    const bf16_t* ksrc = Kb + (size_t)lane * PITCH + wid * 8 + (size_t)t_first * 64 * PITCH;
    const bf16_t* vsrc = Vb + (size_t)(16 * (wid & 3) + (lane >> 2)) * PITCH + (wid >> 2) * 32 + (lane & 3) * 8 + (size_t)t_first * 64 * PITCH;
    const bf16_t* ksrc_c = Kb + (size_t)t_first * 64 * PITCH + wid * 512 + lane * 8;
    int issued = 0;
#define PP_DMA_K(i) do { if ((i) < n_t && !(dbg & 64)) { glds16(((dbg & 128) ? ksrc_c : ksrc) + (size_t)(i) * 64 * PITCH, (unsigned)__builtin_amdgcn_readfirstlane(lds0 + (unsigned)((i) % NS) * SLOT + wid * 1024)); issued += 1; } } while (0)
#define PP_DMA_V(i) do { if ((i) < n_t && !(dbg & 64)) { const unsigned sb_ = lds0 + (unsigned)((i) % NS) * SLOT + 8192; glds16(vsrc + (size_t)(i) * 64 * PITCH, (unsigned)__builtin_amdgcn_readfirstlane(sb_ + wid * 1024)); \
        if (VD == 128) glds16(vsrc + (size_t)(i) * 64 * PITCH + VNEXT, (unsigned)__builtin_amdgcn_readfirstlane(sb_ + (wid + 8) * 1024)); issued += NV; } } while (0)
#define PP_NEED_K(j) do { if (!(dbg & 256)) vm_wait_n(issued - ((j) * PER + 1)); } while (0)
#define PP_NEED_V(j) do { if (!(dbg & 256)) vm_wait_n(issued - ((j) + 1) * PER); } while (0)
#define PP_BAR() asm volatile("s_waitcnt lgkmcnt(0)\n\ts_barrier" ::: "memory")
    f32x16 o[ND];
#pragma unroll
    for (int d = 0; d < ND; ++d) o[d] = f32x16{};
    f32x16 cin;
#pragma unroll
    for (int r = 0; r < 16; ++r) cin[r] = -mref2;
    float l_reg = 0.f;
    const int wrow0 = q0 + wid * 32, qrow = wrow0 + r32, cw = wrow0 / 64;
    const int vb0 = (int)lds0 + 8192 + ((lane >> 4) & 1) * 32 + (lane & 3) * 8 + (4 * hi + ((lane & 15) >> 2)) * 64;
    asm volatile("s_waitcnt vmcnt(0)" ::: "memory"); asm volatile("" : "+v"(qr[0]), "+v"(qr[1]), "+v"(qr[2]), "+v"(qr[3]));
#pragma unroll
    for (int j = 0; j < PD; ++j) { PP_DMA_K(j); PP_DMA_V(j); }
    if (grp) PP_DMA_K(PD);
    PP_NEED_V(0);
    PP_BAR();
    if (grp) PP_BAR();
    u32x4 pw0, pw1, pw2, pw3; f32x16 p1;
    for (int i = 0; i < n_t; ++i) {
        const int t = t_first + i, slot = i % NS;
        bool active;
        if (MODE == 0) active = (t <= cw); else active = (t >= cw - 8) && (t <= cw);
        if (grp == 0) PP_DMA_K(i + PD); else PP_DMA_V(i + PD);
        if (active && !(dbg & 32)) {
            const lds_cptr kb = (lds_cptr)shm + slot * SLOT + hi * 1024 + r32 * 16;
            f32x16 p0; qkt8(p0, p1, kb, qr, cin);
            p_half<MODE>(p0, l_reg, pw0, pw1, (t <= cw - 3) || (dbg & 8), qrow - 64 * t - 4 * hi, tabL);
        }
        if (grp == 0) PP_NEED_V(i); else PP_NEED_K(i + 1);
        PP_BAR();
        if (grp == 0) PP_DMA_V(i + PD); else PP_DMA_K(i + 1 + PD);
        if (active && !(dbg & 16)) {
            const int vb = vb0 + slot * SLOT;
            s16x4 lo0[ND][2], hi0[ND][2], lo1[ND][2], hi1[ND][2];
            v_reads<ND, 0>(lo0, hi0, vb);
            asm volatile("s_waitcnt lgkmcnt(0)" ::: "memory");
            v_reads<ND, 2>(lo1, hi1, vb);
            __builtin_amdgcn_sched_barrier(0);
            pv_half<ND>(o, lo0, hi0, __builtin_bit_cast(bf16x8, pw0), __builtin_bit_cast(bf16x8, pw1));
            __builtin_amdgcn_sched_barrier(0);
            p_half<MODE>(p1, l_reg, pw2, pw3, (t <= cw - 3) || (dbg & 8), qrow - 64 * t - 4 * hi - 32, tabL);
            asm volatile("s_waitcnt lgkmcnt(0)" ::: "memory");
            __builtin_amdgcn_sched_barrier(0);
            pv_half<ND>(o, lo1, hi1, __builtin_bit_cast(bf16x8, pw2), __builtin_bit_cast(bf16x8, pw3));
        }
        if (grp == 0) PP_NEED_K(i + 1); else PP_NEED_V(i + 1);
        PP_BAR();
    }
    if (grp == 0) PP_BAR();
#undef PP_DMA_K
#undef PP_DMA_V
#undef PP_NEED_K
#undef PP_NEED_V
    float rl[16];
    l_reg += __shfl_xor(l_reg, 32);
    if (hi == 0) wsf[32 + r32] = l_reg;
    asm volatile("s_waitcnt lgkmcnt(0)" ::: "memory");
#pragma unroll
    for (int r = 0; r < 16; ++r) rl[r] = __builtin_amdgcn_rcpf(wsf[32 + crow(r, hi)]) * oscale;
    if constexpr (OUT8) {
        static_assert(!OUT8 || VD == 64, "fp8 output: 64-wide heads");
        unsigned char* Ow = (unsigned char*)Ob + (size_t)(q0 + wid * 32) * opitch;
        ALAS unsigned char* stg = (ALAS unsigned char*)(shm + L_OST) + wid * 2048;
#pragma unroll
        for (int r = 0; r < 16; ++r) { const int orow = crow(r, hi);
#pragma unroll
            for (int d0 = 0; d0 < 2; ++d0) { const float v = o[d0][r] * rl[r]; stg[orow * 64 + d0 * 32 + r32] = (unsigned char)(__builtin_amdgcn_cvt_pk_fp8_f32(v, v, 0, false) & 0xff); } }
        asm volatile("s_waitcnt lgkmcnt(0)" ::: "memory");
#pragma unroll
        for (int i = 0; i < 2; ++i) { const int row = i * 16 + (lane >> 2), ch = lane & 3; const u32x4 v = *(const ALAS u32x4*)(stg + row * 64 + ch * 16); *(u32x4*)(Ow + (size_t)row * opitch + ch * 16) = v; }
        asm volatile("s_waitcnt lgkmcnt(0)" ::: "memory");
    } else {
    bf16_t* Ow = (bf16_t*)Ob + (size_t)(q0 + wid * 32) * opitch;
    ALAS bf16_t* stg = (ALAS bf16_t*)(shm + L_OST) + wid * 2048;
#pragma unroll
    for (int half = 0; half < ND / 2; ++half) {
#pragma unroll
        for (int r = 0; r < 16; ++r) { const int orow = crow(r, hi);
#pragma unroll
            for (int d0 = 0; d0 < 2; ++d0) stg[orow * 64 + d0 * 32 + r32] = f2bf(o[half * 2 + d0][r] * rl[r]); }
        asm volatile("s_waitcnt lgkmcnt(0)" ::: "memory");
#pragma unroll
        for (int i = 0; i < 4; ++i) { const int row = i * 8 + (lane >> 3), ch = lane & 7; const u32x4 v = *(const ALAS u32x4*)(stg + row * 64 + ch * 8); *(u32x4*)(Ow + (size_t)row * opitch + half * 64 + ch * 8) = v; }
        asm volatile("s_waitcnt lgkmcnt(0)" ::: "memory");
    }
    }
    PP_BAR();
#undef PP_BAR
}
}

constexpr int NWAVES = 8, NTHR = NWAVES * 64;
constexpr int BATCH = 2, SEQ = 8192, T = BATCH * SEQ, D = 1024;
constexpr int NPROJ = 3072, FFD = 2816, FFE = 3584, NEXP = 8;
constexpr size_t MiB = 1u << 20;
constexpr size_t CTL_ZERO_BYTES = 1 * MiB;
constexpr int CW_TMO = 0, CW_BAR = 4096;
constexpr int CW_HIST = 16384;
constexpr int CW_QATT = 32768, CW_QCONV = 32768 + 64 * 8;
constexpr int CW_MOE = 24576;
constexpr size_t WS_SS0 = 1 * MiB, WS_SS3 = WS_SS0 + 65536, WS_ROPE = WS_SS3 + 65536  , WS_TOKSEL = WS_ROPE + MiB  ,
                 WS_TOKGATE = WS_TOKSEL + 65536  , WS_ROWTOK = WS_TOKGATE + 131072  , WS_ROWGATE = WS_ROWTOK + 147456  , WS_ROWSCALE = WS_ROWGATE + 147456  ;
static_assert(WS_ROWSCALE + 147456 <= 4 * MiB, "small arrays");
constexpr size_t WS_XB = 4 * MiB;
constexpr size_t WS_AO = 36 * MiB;
constexpr size_t WS_ACT0 = 68 * MiB;
constexpr size_t WS_XF = 164 * MiB;
constexpr size_t WS_WIN = 228 * MiB, WS_WO0 = 234 * MiB, WS_WGU0 = 236 * MiB, WS_WD0 = 247 * MiB, WS_WQKV = 253 * MiB, WS_WO1 = 259 * MiB;
constexpr size_t WS_WEGU = 264 * MiB;
constexpr size_t WS_WED = 376 * MiB;
constexpr size_t WS_SS1 = 432 * MiB, WS_SS2 = 433 * MiB;
constexpr size_t WS_END = 434 * MiB;
constexpr size_t WS_SORTA = 36 * MiB;
constexpr size_t WS_ACTE = 108 * MiB;
static_assert(WS_SORTA + (size_t)36864 * 2048 <= WS_ACTE && WS_ACTE + (size_t)18432 * 7168 <= WS_WO0 && WS_WD0 + (size_t)1024 * 2816 * 2 <= WS_WQKV && WS_WO1 + 2 * MiB <= WS_WEGU, "ws map");
constexpr int RING_BYTES = 131072, MISC_OFF = RING_BYTES + 320, ULIST_OFF = RING_BYTES + 1024  , RTAB_OFF = RING_BYTES + 2048  , LDS_BYTES = 155648;
static_assert(RTAB_OFF + 16 * 1024 <= LDS_BYTES, "LDS control area");
static_assert(att::L_END <= RING_BYTES, "attention LDS");

#define GAS __attribute__((address_space(1)))
#define LAS __attribute__((address_space(3)))
typedef unsigned short bf16;
typedef unsigned v4u __attribute__((ext_vector_type(4)));
typedef float f32x4 __attribute__((ext_vector_type(4)));
typedef GAS unsigned gu32;
#define RLX_AGENT __ATOMIC_RELAXED, __HIP_MEMORY_SCOPE_AGENT
#define LDS_WAIT() asm volatile("s_waitcnt lgkmcnt(0)" ::: "memory")
#define VM_WAIT() asm volatile("s_waitcnt vmcnt(0)" ::: "memory")
__device__ __forceinline__ unsigned f2bf(float f) { unsigned u = __builtin_bit_cast(unsigned, f); return (u + 0x7fffu + ((u >> 16) & 1u)) >> 16; }
__device__ __forceinline__ unsigned pk2(float lo, float hi) { return f2bf(lo) | (f2bf(hi) << 16); }
__device__ __forceinline__ float bf2f(unsigned short h) { return __builtin_bit_cast(float, (unsigned)h << 16); }
#define XB_TMO      128
#define XB_XCNT(j)  (256  + 64 * (j))
#define XB_XSUB(j)  (1280 + 64 * (j))
#define XB_XGEN(j)  (2304 + 64 * (j))
#define XB_TOP      3328
#define XB_TOPGEN   3392
#define XCD_BAR_WORDS 3456
#define XB_SPIN_CAP (1u << 18)

__device__ __forceinline__ unsigned xb_ld(unsigned* p)              { return __hip_atomic_load(p, __ATOMIC_RELAXED, __HIP_MEMORY_SCOPE_AGENT); }
__device__ __forceinline__ unsigned xb_add(unsigned* p, unsigned v) { return __hip_atomic_fetch_add(p, v, __ATOMIC_RELAXED, __HIP_MEMORY_SCOPE_AGENT); }
__device__ __forceinline__ unsigned xb_xcc_id() { return (unsigned)__builtin_amdgcn_s_getreg((3 << 11) | 20) & 0xFu; }
#define XB_SPIN(cond, bar) do { unsigned _sp = 0; while (cond) { __builtin_amdgcn_s_sleep(1); \
    if ((++_sp & 255u) == 0u) { if (xb_ld(&(bar)[XB_TMO])) break; if (_sp > XB_SPIN_CAP) { atomicAdd(&(bar)[XB_TMO], 1u); break; } } } } while (0)

struct XcdBarrier {
    unsigned* bar; unsigned x;
    volatile LAS unsigned* st;
};

__device__ __forceinline__ XcdBarrier xcd_barrier_post(unsigned* bar, volatile LAS unsigned* st) {
    XcdBarrier b; b.bar = bar; b.x = xb_xcc_id(); b.st = st;
    if (threadIdx.x == 0) (void)xb_add(&bar[XB_XCNT(b.x)], 1u);
    return b;
}
__device__ __forceinline__ void xcd_barrier_complete(unsigned* bar, unsigned x, unsigned& nloc, unsigned& nx) {
    const unsigned G = gridDim.x * gridDim.y * gridDim.z;
    unsigned sum, cnt, mine, sp = 0u;
    for (;;) {
        sum = 0u; cnt = 0u; mine = 0u;
#pragma unroll
        for (unsigned j = 0; j < 16; ++j) { const unsigned c = xb_ld(&bar[XB_XCNT(j)]); sum += c; cnt += (c > 0u) ? 1u : 0u; mine = (j == x) ? c : mine; }
        if (sum == G) break;
        __builtin_amdgcn_s_sleep(1);
        if ((++sp & 255u) == 0u) { if (xb_ld(&bar[XB_TMO])) break; if (sp > XB_SPIN_CAP) { atomicAdd(&bar[XB_TMO], 1u); break; } }
    }
    nloc = mine > 0u ? mine : 1u; nx = cnt > 0u ? cnt : 1u;
}

__device__ __forceinline__ void xcd_barrier(const XcdBarrier& b) {
    asm volatile("s_waitcnt vmcnt(0)" ::: "memory");
    __syncthreads();
    if (threadIdx.x == 0) {
        unsigned* bar = b.bar;
        __builtin_amdgcn_s_waitcnt(0);
        unsigned nloc = b.st[0], nx = b.st[1];
        if (nloc == 0u) { xcd_barrier_complete(bar, b.x, nloc, nx); b.st[0] = nloc; b.st[1] = nx; }
        const unsigned old = xb_add(&bar[XB_XSUB(b.x)], 1u);
        const unsigned gen = old / nloc;
        if (old + 1u == (gen + 1u) * nloc) {
            __builtin_amdgcn_fence(__ATOMIC_RELEASE, "agent");
            asm volatile("s_waitcnt vmcnt(0)" ::: "memory");
            const unsigned og = xb_add(&bar[XB_TOP], 1u);
            const unsigned tg = og / nx;
            if (og + 1u == (tg + 1u) * nx) xb_add(&bar[XB_TOPGEN], 1u);
            else XB_SPIN(xb_ld(&bar[XB_TOPGEN]) == tg, bar);
            __builtin_amdgcn_fence(__ATOMIC_ACQUIRE, "agent");
            xb_add(&bar[XB_XGEN(b.x)], 1u);
            asm volatile("s_waitcnt vmcnt(0)" ::: "memory");
        } else {
            XB_SPIN(xb_ld(&bar[XB_XGEN(b.x)]) == gen, bar);
            __builtin_amdgcn_fence(__ATOMIC_ACQUIRE, "agent");
            asm volatile("s_waitcnt vmcnt(0)" ::: "memory");
        }
    }
    __syncthreads();
}

__device__ __forceinline__ float wave_sum(float v) {
#pragma unroll
    for (int o = 1; o < 64; o <<= 1) v += __shfl_xor(v, o);
    return v;
}
__device__ __forceinline__ float wave_max(float v) {
#pragma unroll
    for (int o = 1; o < 64; o <<= 1) v = fmaxf(v, __shfl_xor(v, o));
    return v;
}
__device__ __forceinline__ int dest_block(int blk, int map) {
    if (map == 1) { const int s = blk & 7; return (blk & ~7) + 4 * (s & 1) + (s >> 1); }
    if (map == 2) return (blk >> 2) * 8 + (blk & 3);
    if (map == 3) return (blk >> 2) * 8 + 4 + (blk & 3);
    return blk;
}
__device__ __forceinline__ void tr_tile(const float* W, int K, int N, bf16* WT, int map, const float* gain, LAS unsigned* scr, int item, int lane) {
    const int nblk = N / 64, kb = item / nblk, nb = item % nblk, k0 = 64 * kb, n0 = 64 * nb;
    const int c = lane & 15, ip = lane >> 4;
#pragma unroll
    for (int it = 0; it < 8; ++it) { const int kp = it * 4 + ip, k = k0 + 2 * kp;
        f32x4 a = *(const GAS f32x4*)(W + (size_t)k * N + n0 + 4 * c), b = *(const GAS f32x4*)(W + (size_t)(k + 1) * N + n0 + 4 * c);
        if (gain) { a = a * gain[k]; b = b * gain[k + 1]; }
#pragma unroll
        for (int j = 0; j < 4; ++j) scr[(4 * c + j) * 33 + kp] = pk2(a[j], b[j]); }
    LDS_WAIT(); asm volatile("" ::: "memory");
#pragma unroll
    for (int it = 0; it < 8; ++it) { const int n = it * 8 + (lane >> 3), q = lane & 7;
        v4u o; o.x = scr[n * 33 + 4 * q]; o.y = scr[n * 33 + 4 * q + 1]; o.z = scr[n * 33 + 4 * q + 2]; o.w = scr[n * 33 + 4 * q + 3];
        const int drow = dest_block((n0 + n) >> 5, map) * 32 + (n & 31);
        *(GAS v4u*)(WT + (size_t)drow * K + k0 + 8 * q) = o; }
    LDS_WAIT(); asm volatile("" ::: "memory");
}

__device__ __forceinline__ void tr_tile8(const float* W, int K, int N, unsigned char* WT, int map, const float* gain, float wscale, LAS unsigned* scr, int item, int lane) {
    const int nblk = N / 64, kb = item / nblk, nb = item % nblk, k0 = 64 * kb, n0 = 64 * nb;
    const int c = lane & 15, ip = lane >> 4;
#pragma unroll
    for (int it = 0; it < 4; ++it) { const int k4 = it * 4 + ip, k = k0 + 4 * k4; f32x4 a[4];
#pragma unroll
        for (int i = 0; i < 4; ++i) a[i] = *(const GAS f32x4*)(W + (size_t)(k + i) * N + n0 + 4 * c) * ((gain ? gain[k + i] : 1.f) * wscale);
#pragma unroll
        for (int j = 0; j < 4; ++j) scr[(4 * c + j) * 17 + k4] = pg8::pk4_fp8(a[0][j], a[1][j], a[2][j], a[3][j]); }
    LDS_WAIT(); asm volatile("" ::: "memory");
#pragma unroll
    for (int it = 0; it < 4; ++it) { const int n = it * 16 + (lane >> 2), q = lane & 3;
        v4u o; o.x = scr[n * 17 + 4 * q]; o.y = scr[n * 17 + 4 * q + 1]; o.z = scr[n * 17 + 4 * q + 2]; o.w = scr[n * 17 + 4 * q + 3];
        const int drow = dest_block((n0 + n) >> 5, map) * 32 + (n & 31);
        *(GAS v4u*)(WT + (size_t)drow * K + k0 + 16 * q) = o; }
    LDS_WAIT(); asm volatile("" ::: "memory");
}

struct TrItem { const float* W; unsigned char* WT; const float* gain; int K, N, map, fp8, k0, n0; float scale; };
__device__ __forceinline__ void tr_load(const TrItem& d, f32x4 (&a)[16], float (&g)[16], int lane) {
    const int c = lane & 15, ip = lane >> 4;
#pragma unroll
    for (int it = 0; it < 4; ++it)
#pragma unroll
        for (int i = 0; i < 4; ++i) { const int k = d.k0 + 4 * (it * 4 + ip) + i;
            a[it * 4 + i] = __builtin_nontemporal_load((const GAS f32x4*)(d.W + (size_t)k * d.N + d.n0 + 4 * c)); g[it * 4 + i] = d.gain ? d.gain[k] : 1.f; }
}
__device__ __forceinline__ void tr_emit(const TrItem& d, const f32x4 (&a)[16], const float (&g)[16], LAS unsigned* scr, int lane) {
    const int c = lane & 15, ip = lane >> 4;
    if (d.fp8) {
#pragma unroll
        for (int it = 0; it < 4; ++it) { const int k4 = it * 4 + ip;
#pragma unroll
            for (int j = 0; j < 4; ++j) scr[(4 * c + j) * 17 + k4] = pg8::pk4_fp8(a[it * 4][j] * (g[it * 4] * d.scale), a[it * 4 + 1][j] * (g[it * 4 + 1] * d.scale), a[it * 4 + 2][j] * (g[it * 4 + 2] * d.scale), a[it * 4 + 3][j] * (g[it * 4 + 3] * d.scale)); }
        LDS_WAIT(); asm volatile("" ::: "memory");
#pragma unroll
        for (int it = 0; it < 4; ++it) { const int n = it * 16 + (lane >> 2), q = lane & 3;
            v4u o; o.x = scr[n * 17 + 4 * q]; o.y = scr[n * 17 + 4 * q + 1]; o.z = scr[n * 17 + 4 * q + 2]; o.w = scr[n * 17 + 4 * q + 3];
            const int drow = dest_block((d.n0 + n) >> 5, d.map) * 32 + (n & 31);
            __builtin_nontemporal_store(o, (GAS v4u*)(d.WT + (size_t)drow * d.K + d.k0 + 16 * q)); }
    } else {
#pragma unroll
        for (int it = 0; it < 4; ++it) { const int k4 = it * 4 + ip;
#pragma unroll
            for (int j = 0; j < 4; ++j) { scr[(4 * c + j) * 33 + 2 * k4] = pk2(a[it * 4][j] * g[it * 4], a[it * 4 + 1][j] * g[it * 4 + 1]); scr[(4 * c + j) * 33 + 2 * k4 + 1] = pk2(a[it * 4 + 2][j] * g[it * 4 + 2], a[it * 4 + 3][j] * g[it * 4 + 3]); } }
        LDS_WAIT(); asm volatile("" ::: "memory");
#pragma unroll
        for (int it = 0; it < 8; ++it) { const int n = it * 8 + (lane >> 3), q = lane & 7;
            v4u o; o.x = scr[n * 33 + 4 * q]; o.y = scr[n * 33 + 4 * q + 1]; o.z = scr[n * 33 + 4 * q + 2]; o.w = scr[n * 33 + 4 * q + 3];
            const int drow = dest_block((d.n0 + n) >> 5, d.map) * 32 + (n & 31);
            __builtin_nontemporal_store(o, (GAS v4u*)(d.WT + ((size_t)drow * d.K + d.k0 + 8 * q) * 2)); }
    }
    LDS_WAIT(); asm volatile("" ::: "memory");
}
constexpr float AO8_SCALE = 16.f;
constexpr float W8_SCALE = 64.f;

#ifndef PROBE_MASK
#define PROBE_MASK 0
#endif
struct KArgs { const void* in[27]; float* out; unsigned char* ws; int ph_lo, ph_hi, flags, pad; };

struct KArgs;
__device__ __forceinline__ const void* karg_in(const KArgs& a, int k) { asm volatile("" : "+s"(k)); return a.in[k]; }
__global__ void __launch_bounds__(NTHR, 2) fwd_kernel(KArgs args) {
    extern __shared__ __attribute__((aligned(16))) unsigned char lds_raw[];
    LAS unsigned char* lds = (LAS unsigned char*)lds_raw;
    volatile LAS unsigned* MISC = (volatile LAS unsigned*)(lds + MISC_OFF);
    const int tid = threadIdx.x, lane = tid & 63, wave = __builtin_amdgcn_readfirstlane(tid >> 6);
    const int G = gridDim.x; const int bx = blockIdx.x; const int vcu = (G % 8 == 0) ? (bx % 8) * (G / 8) + bx / 8 : bx;
    unsigned char* ws = args.ws;
    unsigned* ctl = (unsigned*)ws;
    for (int u = tid; u < (LDS_BYTES - RING_BYTES) / 4; u += NTHR) ((LAS unsigned*)(lds + RING_BYTES))[u] = 0u;
    __syncthreads();
    XcdBarrier bar = xcd_barrier_post(ctl + CW_BAR, MISC + 8);
    const int lo = args.ph_lo, hi_ph = args.ph_hi;
#define IN(k) (lo <= (k) && (k) < hi_ph)
#define REP(k)
#define SEAM(k) do { if (IN(k) && IN((k) + 1)) xcd_barrier(bar); } while (0)
#define KIN(T, k) ((const T*)karg_in(args, (k)))
#define x_in KIN(float, 0)
#define positions KIN(int, 1)
#define ev_attn_norm KIN(float, 2)
#define ev_w_in KIN(float, 3)
#define ev_q_norm KIN(float, 4)
#define ev_k_norm KIN(float, 5)
#define ev_lq1 KIN(float, 6)
#define ev_lk1 KIN(float, 7)
#define ev_lq2 KIN(float, 8)
#define ev_lk2 KIN(float, 9)
#define ev_subln KIN(float, 10)
#define ev_w_out KIN(float, 11)
#define ev_ffn_norm KIN(float, 12)
#define ev_w_gate KIN(float, 13)
#define ev_w_up KIN(float, 14)
#define ev_w_down KIN(float, 15)
#define od_attn_norm KIN(float, 16)
#define od_w_qkv KIN(float, 17)
#define od_q_norm KIN(float, 18)
#define od_k_norm KIN(float, 19)
#define od_rel_bias KIN(float, 20)
#define od_w_out KIN(float, 21)
#define od_ffn_norm KIN(float, 22)
#define od_router KIN(float, 23)
#define od_we_gate KIN(float, 24)
#define od_we_up KIN(float, 25)
#define od_we_down KIN(float, 26)
    float* out = args.out;
    float* ss0 = (float*)(ws + WS_SS0); float* ss1 = (float*)(ws + WS_SS1); float* ss2 = (float*)(ws + WS_SS2); float* ss3 = (float*)(ws + WS_SS3);
    float* rope = (float*)(ws + WS_ROPE); unsigned* toksel = (unsigned*)(ws + WS_TOKSEL); float* tokgate = (float*)(ws + WS_TOKGATE);
    int* rowtok = (int*)(ws + WS_ROWTOK); float* rowgate = (float*)(ws + WS_ROWGATE); float* rowscale = (float*)(ws + WS_ROWSCALE);
    bf16* XB = (bf16*)(ws + WS_XB); bf16* AO = (bf16*)(ws + WS_AO); bf16* ACT0 = (bf16*)(ws + WS_ACT0); float* XF = (float*)(ws + WS_XF); bf16* OD = (bf16*)(ws + WS_XF);
    bf16* Win_t = (bf16*)(ws + WS_WIN); bf16* Wo0_t = (bf16*)(ws + WS_WO0); bf16* Wgu0_t = (bf16*)(ws + WS_WGU0); bf16* Wd0_t = (bf16*)(ws + WS_WD0);
    unsigned char* Wqkv8 = ws + WS_WQKV; unsigned char* Wo18 = ws + WS_WO1; unsigned char* XB8 = ws + WS_XB; unsigned char* AO8 = ws + WS_AO; unsigned char* WEgu8 = ws + WS_WEGU; unsigned char* WEd8 = ws + WS_WED;
    unsigned char* SORTA8 = ws + WS_SORTA; unsigned char* ACTE8 = ws + WS_ACTE;
    const int gw = vcu * NWAVES + wave, NGW = G * NWAVES;

    constexpr int I_IN = 16 * 48, I_O = 16 * 16, I_G = 16 * 44, I_D = 44 * 16, I_EG = 16 * 56, I_ED = 56 * 16;
    constexpr int NSMALL = I_IN + I_O + 2 * I_G + I_D + I_IN + I_O, NITEMS = NSMALL + 24 * I_EG;
        auto decode = [&](int it) -> TrItem {
        TrItem d; int r = it; d.scale = 1.f; d.fp8 = 0; d.gain = nullptr; d.map = 0;
        auto fin = [&](int nbl) { d.k0 = 64 * (r / nbl); d.n0 = 64 * (r % nbl); };
        if (r < I_IN) { d.W = ev_w_in; d.K = D; d.N = NPROJ; d.WT = (unsigned char*)Win_t; d.map = 1; d.gain = ev_attn_norm; fin(NPROJ / 64); return d; } r -= I_IN;
        if (r < I_O) { d.W = ev_w_out; d.K = D; d.N = D; d.WT = (unsigned char*)Wo0_t; fin(D / 64); return d; } r -= I_O;
        if (r < I_G) { d.W = ev_w_gate; d.K = D; d.N = FFD; d.WT = (unsigned char*)Wgu0_t; d.map = 2; d.gain = ev_ffn_norm; fin(FFD / 64); return d; } r -= I_G;
        if (r < I_G) { d.W = ev_w_up; d.K = D; d.N = FFD; d.WT = (unsigned char*)Wgu0_t; d.map = 3; d.gain = ev_ffn_norm; fin(FFD / 64); return d; } r -= I_G;
        if (r < I_D) { d.W = ev_w_down; d.K = FFD; d.N = D; d.WT = (unsigned char*)Wd0_t; fin(D / 64); return d; } r -= I_D;
        d.fp8 = 1; d.scale = W8_SCALE;
        if (r < I_IN) { d.W = od_w_qkv; d.K = D; d.N = NPROJ; d.WT = Wqkv8; d.map = 1; d.gain = od_attn_norm; fin(NPROJ / 64); return d; } r -= I_IN;
        if (r < I_O) { d.W = od_w_out; d.K = D; d.N = D; d.WT = Wo18; fin(D / 64); return d; } r -= I_O;
        const int which = r / (8 * I_EG), rr = r % (8 * I_EG), e2 = rr / I_EG; r = rr % I_EG;
        if (which == 0) { d.W = od_we_gate + (size_t)e2 * D * FFE; d.K = D; d.N = FFE; d.WT = WEgu8 + (size_t)e2 * 2 * FFE * D; d.map = 2; d.gain = od_ffn_norm; fin(FFE / 64); }
        else if (which == 1) { d.W = od_we_up + (size_t)e2 * D * FFE; d.K = D; d.N = FFE; d.WT = WEgu8 + (size_t)e2 * 2 * FFE * D; d.map = 3; d.gain = od_ffn_norm; fin(FFE / 64); }
        else { d.W = od_we_down + (size_t)e2 * FFE * D; d.K = FFE; d.N = D; d.WT = WEd8 + (size_t)e2 * D * FFE; fin(D / 64); }
        return d; };
    auto conv_range = [&](int first, int end, int stride) {
        LAS unsigned* scr = (LAS unsigned*)(lds + wave * 8704);
        f32x4 bufA[16], bufB[16]; float gA[16], gB[16]; TrItem dA, dB; int it = first;
        if (it < end) { dA = decode(it); tr_load(dA, bufA, gA, lane); }
        while (it < end) {
            const int it2 = it + stride, it3 = it2 + stride;
            if (it2 < end) { dB = decode(it2); tr_load(dB, bufB, gB, lane); }
            tr_emit(dA, bufA, gA, scr, lane);
            if (it3 < end) { dA = decode(it3); tr_load(dA, bufA, gA, lane); }
            if (it2 < end) tr_emit(dB, bufB, gB, scr, lane);
            it = it3; } };
    auto pull = [&](int qword) -> int {
        __syncthreads(); if (tid == 0) MISC[16] = __hip_atomic_fetch_add(ctl + qword, 1u, __ATOMIC_RELAXED, __HIP_MEMORY_SCOPE_AGENT); __syncthreads();
        return __builtin_amdgcn_readfirstlane((int)MISC[16]); };

    REP(0) if (IN(0)) {
        conv_range(gw, I_IN, NGW);
        for (int m0 = gw; m0 < T; m0 += 2 * NGW) {
            f32x4 v[2][4];
#pragma unroll
            for (int u = 0; u < 2; ++u) { const int m = m0 + u * NGW; if (m < T) { const GAS f32x4* xr = (const GAS f32x4*)(x_in + (size_t)m * D) + lane;
#pragma unroll
                for (int j = 0; j < 4; ++j) v[u][j] = __builtin_nontemporal_load(xr + 64 * j); } }
#pragma unroll
            for (int u = 0; u < 2; ++u) { const int m = m0 + u * NGW; if (m >= T) break; float s = 0.f;
#pragma unroll
                for (int j = 0; j < 4; ++j) s += (v[u][j].x * v[u][j].x + v[u][j].y * v[u][j].y) + (v[u][j].z * v[u][j].z + v[u][j].w * v[u][j].w);
                s = wave_sum(s); if (lane == 0) ss0[m] = s;
                GAS unsigned long long* o8 = (GAS unsigned long long*)(XB + (size_t)m * D) + lane;
#pragma unroll
                for (int j = 0; j < 4; ++j) o8[64 * j] = (unsigned long long)pk2(v[u][j].x, v[u][j].y) | ((unsigned long long)pk2(v[u][j].z, v[u][j].w) << 32); }
        }
        for (int i = vcu * NTHR + tid; i < T * 8; i += G * NTHR) {
            const int tok = i >> 3, f = i & 7;
            const double inv = (f == 0) ? 1.0 : (f == 1) ? 0.19392274474868576 : (f == 2) ? 0.03760603093086393 : (f == 3) ? 0.007292664737217109 : (f == 4) ? 0.001414213562373095 : (f == 5) ? 0.0002742481756762073 : (f == 6) ? 5.318295896944988e-05 : 1.031338537721246e-05;
            double ang = (double)positions[tok] * inv; ang -= 6.283185307179586 * rint(ang * 0.15915494309189535);
            float sn, cs; sincosf((float)ang, &sn, &cs);
            rope[(size_t)tok * 16 + f] = cs; rope[(size_t)tok * 16 + 8 + f] = sn;
        }
    }
    SEAM(0);

    LAS int* ulist = (LAS int*)(lds + ULIST_OFF);
    LAS float* rtab = (LAS float*)(lds + RTAB_OFF);
    const auto no_rows = [](const pg8::Unit&, int) { return 0.f; };
#define RUN_GEMM(EPI, ALIGN, F8, g, S, E, RT, ROWFN) do { pg8::build_unit_list((S), ulist, (RT), (ROWFN)); const pg8::ListOrder LO_{ulist}; pg8::gemm_phase<EPI, pg8::ListOrder, ALIGN, true, F8>(lds, (g), LO_, (E)); } while (0)
    REP(1) if (IN(1)) {
        pg8::Gemm g{XB, Win_t, T, NPROJ, D}; pg8::StaticOrder S; S.init(T, NPROJ, G, bx);
        pg8::EpiProj E{ACT0, T, ss0, 1, ev_q_norm, ev_k_norm, rope, 0, 1.f, rtab};
        const float* ssp = ss0; const auto rowfn = [ssp](const pg8::Unit& u, int lr) { return rsqrtf(ssp[u.pm * 256 + lr] * (1.f / 1024.f) + pg8::RMS_EPS); };
        RUN_GEMM(pg8::EpiProj, true, false, g, S, E, rtab, rowfn);
    }
    SEAM(1);

    REP(2) if (IN(2)) {
        const float gqm = wave_max(fabsf(ev_q_norm[lane])), gkm = wave_max(fabsf(ev_k_norm[lane]));
        const float mref = 8.f * gqm * gkm * pg8::LOG2E;
        constexpr int NJOBS = (NITEMS - I_IN + 63) / 64;
        const bool conv_first = ((bx >> 3) & 3) == 3;
#define P2_CONV_LOOP() for (;;) { const int j = pull(CW_QCONV); if (j >= NJOBS) break; \
            const int first = I_IN + j * 64 + wave * 8; conv_range(first, (first + 8 < NITEMS) ? first + 8 : NITEMS, 1); }
        if (conv_first) P2_CONV_LOOP()
#pragma unroll 1
        for (int kq = 0; kq < 8; ++kq) { const int xq = (bx + kq) & 7;
            for (;;) { const int idx = pull(CW_QATT + 64 * xq); if (idx >= 128) break;
                if (idx < 64) { if (args.flags & 1) continue;
                    const int bhm = 2 * xq + (idx & 1), qb = 31 - (idx >> 1);
                    const int b = bhm >> 3, hm = bhm & 7, h = hm >> 1;
                    const bf16* base = ACT0 + (size_t)b * SEQ * 64;
                    att::attn_unit<0, 128, false, 1>((LAS char*)lds, base + (size_t)(24 + hm) * T * 64, base + (size_t)(32 + hm) * T * 64, base + (size_t)(40 + 2 * h) * T * 64, OD + (size_t)b * SEQ * D + hm * 128, D, qb * 256, mref, nullptr, 1.f, args.flags);
                } else { if (args.flags & 2) continue;
                    const int bh = 2 * xq + (idx & 1), qb = 31 - ((idx - 64) >> 1);
                    const int b = bh >> 3, h = bh & 7;
                    const bf16* base = ACT0 + (size_t)b * SEQ * 64;
                    att::attn_unit<2, 64>((LAS char*)lds, base + (size_t)h * T * 64, base + (size_t)(8 + h) * T * 64, base + (size_t)(16 + h) * T * 64, AO + (size_t)b * SEQ * D + h * 64, D, qb * 256, 0.f, nullptr);
                }
            }
        }
        P2_CONV_LOOP()
#undef P2_CONV_LOOP
    }
    SEAM(2);

    REP(3) if (IN(3)) {
        const float a1 = wave_sum(ev_lq1[lane] * ev_lk1[lane]), a2 = wave_sum(ev_lq2[lane] * ev_lk2[lane]);
        const float lam_init = 0.2f, lam = expf(a1) - expf(a2) + lam_init;
        const int h = lane >> 4, v0 = (lane & 15) * 8;
        float sg[8];
#pragma unroll
        for (int j = 0; j < 8; ++j) sg[j] = ev_subln[v0 + j] * (1.f - lam_init);
        for (int m0 = gw; m0 < T; m0 += 4 * NGW) {
            v4u a4[4], b4[4];
#pragma unroll
            for (int u = 0; u < 4; ++u) { const int m = m0 + u * NGW; if (m < T) { a4[u] = *(const GAS v4u*)(OD + (size_t)m * D + (2 * h) * 128 + v0); b4[u] = *(const GAS v4u*)(OD + (size_t)m * D + (2 * h + 1) * 128 + v0); } }
#pragma unroll
            for (int u = 0; u < 4; ++u) { const int m = m0 + u * NGW; if (m >= T) break;
                const v4u a = a4[u], b = b4[u]; float d[8]; float s = 0.f;
#pragma unroll
                for (int j = 0; j < 4; ++j) { const unsigned ua = a[j], ub = b[j];
                    d[2 * j] = bf2f((unsigned short)(ua & 0xffffu)) - lam * bf2f((unsigned short)(ub & 0xffffu));
                    d[2 * j + 1] = bf2f((unsigned short)(ua >> 16)) - lam * bf2f((unsigned short)(ub >> 16));
                    s += d[2 * j] * d[2 * j] + d[2 * j + 1] * d[2 * j + 1]; }
                s += __shfl_xor(s, 1); s += __shfl_xor(s, 2); s += __shfl_xor(s, 4); s += __shfl_xor(s, 8);
                const float rs = rsqrtf(s * (1.f / 128.f) + pg8::RMS_EPS);
                v4u o; o.x = pk2(d[0] * rs * sg[0], d[1] * rs * sg[1]); o.y = pk2(d[2] * rs * sg[2], d[3] * rs * sg[3]); o.z = pk2(d[4] * rs * sg[4], d[5] * rs * sg[5]); o.w = pk2(d[6] * rs * sg[6], d[7] * rs * sg[7]);
                *(GAS v4u*)(AO + (size_t)m * D + 512 + h * 128 + v0) = o; }
        }
    }
    SEAM(3);

    REP(4) if (IN(4)) {
        pg8::Gemm g{AO, Wo0_t, T, D, D}; pg8::StaticOrder S; S.init(T, D, G, bx);
        pg8::EpiResid E{x_in, XF, XB, ss1, 1.f, nullptr};
        RUN_GEMM(pg8::EpiResid, false, false, g, S, E, (LAS float*)nullptr, no_rows);
    }
    SEAM(4);

    REP(5) if (IN(5)) {
        pg8::Gemm g{XB, Wgu0_t, T, 2 * FFD, D}; pg8::StaticOrder S; S.init(T, 2 * FFD, G, bx, (args.flags >> 9) & 1);
        pg8::EpiSwiglu<false> E{ACT0, FFD, ss1, 16, nullptr, 0, 2 * FFD / 256, 1.f, rtab};
        const float* ssp = ss1; const auto rowfn = [ssp](const pg8::Unit& u, int lr) { return rsqrtf(pg8::row_ss(ssp, 16, u.pm * 256 + lr) * (1.f / 1024.f) + pg8::RMS_EPS); };
        RUN_GEMM(pg8::EpiSwiglu<false>, true, false, g, S, E, rtab, rowfn);
    }
    SEAM(5);

    if (IN(6)) {
        pg8::Gemm g{ACT0, Wd0_t, T, D, FFD}; pg8::StaticOrder S; S.init(T, D, G, bx);
        pg8::EpiResid E{XF, XF, nullptr, ss2, 1.f, XB8};
        RUN_GEMM(pg8::EpiResid, false, false, g, S, E, (LAS float*)nullptr, no_rows);
    }
    SEAM(6);

    REP(7) if (IN(7)) {
        pg8::Gemm g{(const bf16*)XB8, (const bf16*)Wqkv8, T, NPROJ, D / 2}; pg8::StaticOrder S; S.init(T, NPROJ, G, bx);
        pg8::EpiProj E{ACT0, T, ss2, 16, od_q_norm, od_k_norm, nullptr, 1, 1.f / W8_SCALE, rtab};
        const float* ssp = ss2; const auto rowfn = [ssp](const pg8::Unit& u, int lr) { return rsqrtf(pg8::row_ss(ssp, 16, u.pm * 256 + lr) * (1.f / 1024.f) + pg8::RMS_EPS); };
        RUN_GEMM(pg8::EpiProj, true, true, g, S, E, rtab, rowfn);
    }
    SEAM(7);

    REP(8) if (IN(8)) {
        const float gqm = wave_max(fabsf(od_q_norm[lane])), gkm = wave_max(fabsf(od_k_norm[lane]));
        for (int L = vcu; L < 1024; L += G) {
            const int bh = (L & 255) >> 3, qb = 4 * (L & 7) + (L >> 8);
            const int b = bh >> 4, h = bh & 15;
            const float* tab = od_rel_bias + h * 257;
            float tm = fabsf(tab[lane]); tm = fmaxf(tm, fabsf(tab[64 + lane])); tm = fmaxf(tm, fabsf(tab[128 + lane])); tm = fmaxf(tm, fabsf(tab[192 + lane])); tm = fmaxf(tm, fabsf(tab[256]));
            tm = wave_max(tm);
            const float mref = (8.f * gqm * gkm + tm) * pg8::LOG2E;
            const bf16* base = ACT0 + (size_t)b * SEQ * 64;
            att::attn_unit<1, 64, true, 1>((LAS char*)lds, base + (size_t)h * T * 64, base + (size_t)(16 + h) * T * 64, base + (size_t)(32 + h) * T * 64, AO8 + (size_t)b * SEQ * D + h * 64, D, qb * 256, mref, tab, AO8_SCALE);
        }
    }
    SEAM(8);

    REP(9) if (IN(9)) {
        pg8::Gemm g{(const bf16*)AO8, (const bf16*)Wo18, T, D, D / 2}; pg8::StaticOrder S; S.init(T, D, G, bx);
        pg8::EpiResid E{XF, out, nullptr, nullptr, 1.f / (W8_SCALE * AO8_SCALE), XB8};
        RUN_GEMM(pg8::EpiResid, false, true, g, S, E, (LAS float*)nullptr, no_rows);
    }
    SEAM(9);

    REP(10) if (IN(10)) {
        LAS float* wrT = (LAS float*)lds;
        LAS unsigned* sel = (LAS unsigned*)(lds + 32768);
        for (int i = tid; i < 1024; i += NTHR) { const float gn = od_ffn_norm[i]; const f32x4 w0 = *(const GAS f32x4*)(od_router + (size_t)i * 8), w1 = *(const GAS f32x4*)(od_router + (size_t)i * 8 + 4);
            wrT[i] = w0.x * gn; wrT[1024 + i] = w0.y * gn; wrT[2048 + i] = w0.z * gn; wrT[3072 + i] = w0.w * gn; wrT[4096 + i] = w1.x * gn; wrT[5120 + i] = w1.y * gn; wrT[6144 + i] = w1.z * gn; wrT[7168 + i] = w1.w * gn; }
        __syncthreads();
        for (int blk = vcu; blk < T / 64; blk += G) {
#pragma unroll 1
            for (int q4 = 0; q4 < 2; ++q4) {
                const int tk = lane >> 4, sub = lane & 15; const int tok = blk * 64 + wave * 8 + q4 * 4 + tk;
                const GAS f32x4* xr = (const GAS f32x4*)(out + (size_t)tok * D) + sub; float s = 0.f; float lg[8];
#pragma unroll
                for (int e2 = 0; e2 < 8; ++e2) lg[e2] = 0.f;
#pragma unroll
                for (int jh = 0; jh < 2; ++jh) { f32x4 xv[8];
#pragma unroll
                    for (int j = 0; j < 8; ++j) xv[j] = xr[16 * (8 * jh + j)];
#pragma unroll
                    for (int j = 0; j < 8; ++j) { const f32x4 v = xv[j]; s += (v.x * v.x + v.y * v.y) + (v.z * v.z + v.w * v.w);
#pragma unroll
                        for (int e2 = 0; e2 < 8; ++e2) { const f32x4 w = *(const LAS f32x4*)(wrT + e2 * 1024 + 64 * (8 * jh + j) + 4 * sub); lg[e2] += (v.x * w.x + v.y * w.y) + (v.z * w.z + v.w * w.w); } } }
#pragma unroll
                for (int o = 1; o < 16; o <<= 1) { s += __shfl_xor(s, o);
#pragma unroll
                    for (int e2 = 0; e2 < 8; ++e2) lg[e2] += __shfl_xor(lg[e2], o); }
                if (sub == 0) {
                    const float r = rsqrtf(s * (1.f / 1024.f) + pg8::RMS_EPS); ss3[tok] = s;
                    int e0 = 0; float v0 = lg[0];
#pragma unroll
                    for (int e2 = 1; e2 < 8; ++e2) if (lg[e2] > v0) { v0 = lg[e2]; e0 = e2; }
                    int e1 = -1; float v1 = 0.f;
#pragma unroll
                    for (int e2 = 0; e2 < 8; ++e2) if (e2 != e0 && (e1 < 0 || lg[e2] > v1)) { v1 = lg[e2]; e1 = e2; }
                    const float ex = expf((v1 - v0) * r), g0 = 1.f / (1.f + ex), g1 = ex / (1.f + ex);
                    sel[wave * 8 + q4 * 4 + tk] = (unsigned)e0 | ((unsigned)e1 << 8); tokgate[2 * tok] = g0; tokgate[2 * tok + 1] = g1;
                }
            }
            __syncthreads();
            if (wave == 0) { const unsigned sv = sel[lane]; const int e0 = sv & 0xff, e1 = sv >> 8; unsigned rank0 = 0, rank1 = 0;
                const unsigned long long lt = (1ull << lane) - 1ull;
#pragma unroll
                for (int e = 0; e < 8; ++e) { const unsigned long long m0 = __ballot(e0 == e), m1 = __ballot(e1 == e);
                    if (e0 == e) rank0 = __popcll(m0 & lt); if (e1 == e) rank1 = __popcll(m1 & lt);
                    if (lane == 0) { ctl[CW_HIST + blk * 16 + e] = __popcll(m0); ctl[CW_HIST + blk * 16 + 8 + e] = __popcll(m1); } }
                toksel[blk * 64 + lane] = sv | (rank0 << 16) | (rank1 << 24); }
            __syncthreads();
        }
    }
    SEAM(10);

    REP(11) if (IN(11)) {
        LAS unsigned* hs = (LAS unsigned*)lds;
        for (int i = tid; i < 4096; i += NTHR) hs[i] = ctl[CW_HIST + i];
        __syncthreads();
        if (tid < 16) hs[4096 + tid] = 0u;
        __syncthreads();
        { unsigned s = 0; const int g2 = tid & 15;
#pragma unroll
          for (int b2 = tid >> 4; b2 < 256; b2 += 32) s += hs[b2 * 16 + g2];
          atomicAdd((unsigned*)&hs[4096 + g2], s); }
        __syncthreads();
        if (tid == 0) { unsigned acc = 0; for (int g2 = 0; g2 < 16; ++g2) { hs[4128 + g2] = acc; acc += (hs[4096 + g2] + 255u) & ~255u; } hs[4128 + 16] = acc; }
        __syncthreads();
        if (bx == 0) {
            if (tid == 0) { const int nA = (int)(hs[4128 + 8] >> 8), nT = (int)(hs[4128 + 16] >> 8), nC1 = (nT - nA + 1) / 2, nC2 = nT - nA - nC1;
                ctl[CW_MOE] = nA; ctl[CW_MOE + 1] = nT;
                for (int ph = 0; ph < 2; ++ph) { const int nd = (ph == 0 ? nA : nC1) * (D / 256), nu = (ph == 0 ? nC1 : nC2) * (2 * FFE / 256);
                    int H = nd > G ? nd - G : (nd < G ? nd : 0); int mode = 1, R = 0; if (H >= G) H = 0;
                    pg8::MoeOrder::plan(nu, H, G, D / 128, FFE / 128, mode, R);
                    ctl[CW_MOE + 2 + 3 * ph] = H; ctl[CW_MOE + 3 + 3 * ph] = R; ctl[CW_MOE + 4 + 3 * ph] = mode; } }
            if (tid < 16) { const unsigned t0 = hs[4128 + tid] >> 8, t1 = hs[4128 + tid + 1] >> 8; for (unsigned t = t0; t < t1; ++t) ctl[CW_MOE + 16 + t] = tid & 7; }
        }
        for (int blk = vcu; blk < T / 64; blk += G) {
            if (tid < 16) hs[4160 + tid] = 0u;
            __syncthreads();
            { unsigned s = 0; const int g2 = tid & 15;
#pragma unroll
              for (int b2 = tid >> 4; b2 < 256; b2 += 32) s += (b2 < blk) ? hs[b2 * 16 + g2] : 0u;
              atomicAdd((unsigned*)&hs[4160 + g2], s); }
            __syncthreads();
            for (int tl = wave; tl < 64; tl += NWAVES) {
                const int tok = blk * 64 + tl; const unsigned sv = toksel[tok];
                const v4u pk = *(const GAS v4u*)(XB8 + (size_t)tok * D + 16 * lane);
#pragma unroll
                for (int sl = 0; sl < 2; ++sl) { const int e = (sv >> (8 * sl)) & 0xff, rank = (sv >> (16 + 8 * sl)) & 0xff, g2 = sl * 8 + e;
                    const unsigned srow = hs[4128 + g2] + hs[4160 + g2] + rank;
                    *(GAS v4u*)(SORTA8 + (size_t)srow * D + lane * 16) = pk;
                    if (lane == 0) { rowtok[srow] = tok; rowgate[srow] = tokgate[2 * tok + sl]; rowscale[srow] = rsqrtf(ss3[tok] * (1.f / 1024.f) + pg8::RMS_EPS); } }
            }
            __syncthreads();
        }
        for (int g2 = vcu; g2 < 16; g2 += G) {
            const unsigned r0 = hs[4128 + g2] + hs[4096 + g2], r1 = hs[4128 + g2 + 1];
            for (unsigned r = r0 + wave; r < r1; r += NWAVES) { if (lane == 0) { rowtok[r] = -1; rowgate[r] = 0.f; rowscale[r] = 0.f; }
                *(GAS v4u*)(SORTA8 + (size_t)r * D + lane * 16) = (v4u){0u, 0u, 0u, 0u}; }
        }
    }
    SEAM(11);

    if (IN(12) || IN(13) || IN(14) || IN(15)) {
        const int nA = (int)__builtin_amdgcn_readfirstlane(ctl[CW_MOE]), nT = (int)__builtin_amdgcn_readfirstlane(ctl[CW_MOE + 1]);
        const int nC1 = (nT - nA + 1) / 2, nC2 = nT - nA - nC1;
        const int* texp = (const int*)(ctl + CW_MOE + 16);
        unsigned char* const ACT_C0 = ACTE8; unsigned char* const ACT_C1 = ACTE8 + (size_t)63 * MiB; unsigned char* const ACT_C2 = ACT_C1 + (size_t)36 * 256 * FFE;
        constexpr int NPN_GU = 2 * FFE / 256, NPN_D = D / 256;
#define MOE_GU(TILE0, NTILE, ACTBUF, PLAN) do { int H_ = 0, R_ = 0, mode_ = 1; \
        if ((PLAN) >= 0) { H_ = (int)__builtin_amdgcn_readfirstlane(ctl[CW_MOE + 2 + 3 * (PLAN)]); R_ = (int)__builtin_amdgcn_readfirstlane(ctl[CW_MOE + 3 + 3 * (PLAN)]); mode_ = (int)__builtin_amdgcn_readfirstlane(ctl[CW_MOE + 4 + 3 * (PLAN)]); } \
        pg8::Gemm g{(const bf16*)(SORTA8 + (size_t)(TILE0) * 256 * D), (const bf16*)WEgu8, 0, 0, D / 2}; pg8::MoeOrder S; S.init((NTILE), NPN_GU, G, bx, (TILE0), texp, H_, R_, mode_); \
        pg8::EpiSwiglu<true> E{(ACTBUF), FFE, nullptr, 1, rowscale, (TILE0), NPN_GU, 1.f / W8_SCALE, rtab}; \
        const float* rsp_ = rowscale + (size_t)(TILE0) * 256; const auto rowfn_ = [rsp_](const pg8::Unit& u, int lr) { return rsp_[u.pm * 256 + lr]; }; \
        RUN_GEMM(pg8::EpiSwiglu<true>, true, true, g, S, E, rtab, rowfn_); } while (0)
#define MOE_DOWN(TILE0, NTILE, ACTBUF) do { pg8::Gemm g{(const bf16*)(ACTBUF), (const bf16*)WEd8, 0, 0, FFE / 2}; pg8::MoeOrder S; S.init((NTILE), NPN_D, G, bx, (TILE0), texp); \
        pg8::EpiMoeDown E{out, rowtok, rowgate, (TILE0), 1.f / W8_SCALE, (args.flags >> 2) & 1}; \
        RUN_GEMM(pg8::EpiMoeDown, true, true, g, S, E, (LAS float*)nullptr, no_rows); } while (0)
        if (IN(12)) MOE_GU(0, nA, ACT_C0, -1);
        SEAM(12);
        if (IN(13)) { MOE_DOWN(0, nA, ACT_C0); MOE_GU(nA, nC1, ACT_C1, 0); }
        SEAM(13);
        if (IN(14)) { MOE_DOWN(nA, nC1, ACT_C1); if (nC2 > 0) MOE_GU(nA + nC1, nC2, ACT_C2, 1); }
        SEAM(14);
        if (IN(15)) { if (nC2 > 0) MOE_DOWN(nA + nC1, nC2, ACT_C2); }
#undef MOE_GU
#undef MOE_DOWN
    }
#undef IN
#undef SEAM
#undef RUN_GEMM
#undef x_in
#undef positions
#undef ev_attn_norm
#undef ev_w_in
#undef ev_q_norm
#undef ev_k_norm
#undef ev_lq1
#undef ev_lk1
#undef ev_lq2
#undef ev_lk2
#undef ev_subln
#undef ev_w_out
#undef ev_ffn_norm
#undef ev_w_gate
#undef ev_w_up
#undef ev_w_down
#undef od_attn_norm
#undef od_w_qkv
#undef od_q_norm
#undef od_k_norm
#undef od_rel_bias
#undef od_w_out
#undef od_ffn_norm
#undef od_router
#undef od_we_gate
#undef od_we_up
#undef od_we_down
#undef KIN
}

constexpr int N_PHASES = 16;
extern "C" void kernel_launch(void* const* d_in, const int* in_sizes, int n_in, void* d_out, int out_size, void* d_ws, size_t ws_size, hipStream_t stream) {
    static int grid = 0;
    if (grid == 0) {
        if (n_in != 27 || out_size != T * D || ws_size < WS_END) { fprintf(stderr, "kernel_launch: unexpected problem (n_in %d, out %d, ws %zu)\n", n_in, out_size, ws_size); grid = -1; return; }
        int dev = 0, cus = 0, per_cu = 0;
        if (hipGetDevice(&dev) != hipSuccess || hipDeviceGetAttribute(&cus, hipDeviceAttributeMultiprocessorCount, dev) != hipSuccess) { grid = -1; return; }
        if (hipFuncSetAttribute((const void*)fwd_kernel, hipFuncAttributeMaxDynamicSharedMemorySize, LDS_BYTES) != hipSuccess) { fprintf(stderr, "kernel_launch: hipFuncSetAttribute failed\n"); grid = -1; return; }
        if (hipOccupancyMaxActiveBlocksPerMultiprocessor(&per_cu, (const void*)fwd_kernel, NTHR, LDS_BYTES) != hipSuccess || per_cu < 1) { fprintf(stderr, "kernel_launch: occupancy query says %d\n", per_cu); }
        (void)hipGetLastError();
        grid = cus;
    }
    if (grid < 0) return;
    (void)hipMemsetAsync(d_ws, 0, CTL_ZERO_BYTES, stream);
    KArgs a{};
    for (int i = 0; i < 27; ++i) a.in[i] = d_in[i];
    a.out = (float*)d_out; a.ws = (unsigned char*)d_ws; a.ph_lo = 0; a.ph_hi = N_PHASES;
    hipLaunchKernelGGL(fwd_kernel, dim3(grid), dim3(NTHR), LDS_BYTES, stream, a);
#if defined(PROBE_LO)
    (void)hipMemsetAsync((char*)d_ws + CW_BAR * 4, 0, XCD_BAR_WORDS * 4, stream); (void)hipMemsetAsync((char*)d_ws + CW_QATT * 4, 0, 4096, stream);
    a.ph_lo = PROBE_LO; a.ph_hi = PROBE_HI;
#if defined(PROBE_FLAGS)
    a.flags = PROBE_FLAGS;
#endif
    hipLaunchKernelGGL(fwd_kernel, dim3(grid), dim3(NTHR), LDS_BYTES, stream, a);
#endif
}
```

```cpp
#include <hip/hip_runtime.h>
#include <cstdio>
#include <cstdint>
#include <cmath>
#define PROBE_MASK 0x0
namespace pg8 {
#define PG8_LAS __attribute__((address_space(3)))
typedef unsigned short bf16_t;
typedef short bf16x8 __attribute__((ext_vector_type(8)));
typedef float f32x4 __attribute__((ext_vector_type(4)));
typedef unsigned u32x4 __attribute__((ext_vector_type(4)));
constexpr int BM = 256, BK = 64, HALF = 128, HTB = HALF * BK * 2  , STAGE_BYTES = 8 * HTB, NXCD = 8, WGM = 4;

__host__ __device__ __forceinline__ int lds_byte(int r, int c) { const int st = (r >> 4) * 2 + (c >> 5), rr = r & 15, cc = c & 31, ob = rr * 64 + cc * 2; return st * 1024 + (ob ^ (((ob >> 9) & 1) << 5)); }
__host__ __device__ __forceinline__ void stage_rc(int b, int& R, int& C) { const int st = b / 1024, sb = b % 1024, swz = sb ^ (((sb >> 9) & 1) << 5); R = (st >> 1) * 16 + swz / 64; C = (st & 1) * 32 + (swz % 64) / 2; }
__host__ __device__ __forceinline__ int perm32(int rho) { const int n = rho >> 4, i = rho & 15; return 8 * (i >> 2) + 4 * n + (i & 3); }

struct Unit { int pm, pn, aux; };
struct Gemm { const bf16_t* A; const bf16_t* Bt; int M, N, K; };

struct StaticOrder {
    int nM, nN, nwg, G, c, hot;
    __host__ __device__ void init(int M, int N, int G_, int c_, int hot_ = 0) { nM = M / BM; nN = N / BM; nwg = nM * nN; G = G_; c = c_; hot = hot_; }
    __host__ __device__ bool next(int i, Unit& u) const {
        const long L = (long)i * G + c; if (L >= nwg) return false;
        int wgid = (int)L; { const int q = nwg / NXCD, r = nwg % NXCD, xcd = wgid % NXCD, off = wgid / NXCD; wgid = (xcd < r ? xcd * (q + 1) : r * (q + 1) + (xcd - r) * q) + off; }
        const int nig = WGM * nN, gid = wgid / nig, fm = gid * WGM, gsz = (nM - fm) < WGM ? (nM - fm) : WGM;
        u.pm = fm + ((wgid % nig) % gsz); u.pn = (wgid % nig) / gsz; if (hot) { u.pm &= 3; u.pn = 0; } return true;
    }
    __device__ __forceinline__ void a_ready(const Unit&) const {}
    __device__ __forceinline__ void done(const Unit&) const {}
};

struct MoeOrder {
    int nM, nN, nwg, G, c, tile0; const int* tile_expert;
    int H, R, mode;
    __device__ void init(int ntiles, int npn, int G_, int c_, int tile0_, const int* te, int H_ = 0, int R_ = 0, int mode_ = 1) { nM = ntiles; nN = npn; nwg = nM * nN; G = G_; c = c_; tile0 = tile0_; tile_expert = te; H = H_; R = R_; mode = mode_; }
    __device__ static __forceinline__ void plan(int nu, int H, int G, int ucost, int extra, int& mode, int& R) {
        mode = 1; R = 0; if (H <= 0 || H >= G) return;
        const int rmax = (nu + (G - H) - 1) / (G - H); int best = 0x7fffffff;
        for (int r2 = 0; r2 <= rmax; ++r2) { const int rest = nu - r2 * (G - H) > 0 ? nu - r2 * (G - H) : 0;
            { const int light = ucost * r2, heavy = extra + ucost * ((rest + H - 1) / H); const int mk = light > heavy ? light : heavy; if (mk < best) { best = mk; mode = 1; R = r2; } }
            { const int sh = (rest + G - 1) / G; const int light = ucost * (r2 + sh), heavy = extra + ucost * sh; const int mk = light > heavy ? light : heavy; if (mk < best) { best = mk; mode = 2; R = r2; } } }
    }
    __device__ bool next(int i, Unit& u) const {
        long L;
        if (H == 0) L = (long)i * G + c;
        else if (c >= H) { if (i < R) L = (long)i * (G - H) + (c - H); else if (mode == 2) L = (long)R * (G - H) + (long)(i - R) * G + c; else return false; }
        else L = (long)R * (G - H) + (long)i * (mode == 2 ? G : H) + c;
        if (L >= nwg) return false;
        int wgid = (int)L; { const int q = nwg / NXCD, r = nwg % NXCD, xcd = wgid % NXCD, off = wgid / NXCD; wgid = (xcd < r ? xcd * (q + 1) : r * (q + 1) + (xcd - r) * q) + off; }
        const int nig = WGM * nN, gid = wgid / nig, fm = gid * WGM, gsz = (nM - fm) < WGM ? (nM - fm) : WGM;
        u.pm = fm + ((wgid % nig) % gsz); const int pnl = (wgid % nig) / gsz;
        const int e = tile_expert[tile0 + u.pm];
        u.pn = e * nN + pnl; return true;
    }
    __device__ __forceinline__ void a_ready(const Unit&) const {}
    __device__ __forceinline__ void done(const Unit&) const {}
};

constexpr int MAX_UNITS = 64, RT_UNITS = 16;
template <class Sched, class RowFn> __device__ __forceinline__ void build_unit_list(const Sched& S, PG8_LAS int* list, PG8_LAS float* rtab, const RowFn& rowfn) {
    const int t = threadIdx.x;
    if (t < MAX_UNITS) { Unit u; u.pm = 0; u.pn = 0; u.aux = t; const bool ok = S.next(t, u); list[2 * t] = ok ? u.pm : -1; list[2 * t + 1] = u.pn; }
    __syncthreads();
    if (rtab) {
#pragma unroll 1
        for (int i = t >> 8; i < RT_UNITS; i += 2) { Unit u; u.pm = list[2 * i]; u.pn = list[2 * i + 1]; u.aux = i; if (u.pm < 0) break; rtab[i * 256 + (t & 255)] = rowfn(u, t & 255); }
        __syncthreads();
    }
}
struct ListOrder {
    const PG8_LAS int* list;
    __device__ __forceinline__ bool next(int i, Unit& u) const {
        if (i >= MAX_UNITS) return false;
        const int pm = __builtin_amdgcn_readfirstlane(list[2 * i]); if (pm < 0) return false;
        u.pm = pm; u.pn = __builtin_amdgcn_readfirstlane(list[2 * i + 1]); u.aux = i; return true; }
    __device__ __forceinline__ void a_ready(const Unit&) const {}
    __device__ __forceinline__ void done(const Unit&) const {}
};

__device__ __forceinline__ unsigned cvt_pk_bf16(float lo, float hi) { unsigned r; asm volatile("v_cvt_pk_bf16_f32 %0, %1, %2" : "=v"(r) : "v"(lo), "v"(hi)); return r; }
__device__ __forceinline__ u32x4 pack8(const f32x4& a, const f32x4& b) { u32x4 w; w.x = cvt_pk_bf16(a[0], a[1]); w.y = cvt_pk_bf16(a[2], a[3]); w.z = cvt_pk_bf16(b[0], b[1]); w.w = cvt_pk_bf16(b[2], b[3]); return w; }
__device__ __forceinline__ unsigned pk4_fp8(float a, float b, float c, float d) { int w = __builtin_amdgcn_cvt_pk_fp8_f32(a, b, 0, false); w = __builtin_amdgcn_cvt_pk_fp8_f32(c, d, w, true); return (unsigned)w; }
constexpr float RMS_EPS = 1e-6f;
constexpr float LOG2E = 1.4426950408889634f;
constexpr float C2 = 0.125f * LOG2E;
__device__ __forceinline__ float row_ss(const float* ss, int nparts, int row) {
    if (nparts == 1) return ss[row];
    const f32x4* p = (const f32x4*)(ss + (size_t)row * 16); f32x4 a = p[0], b = p[1], c = p[2], d = p[3]; a = (a + b) + (c + d); return (a[0] + a[1]) + (a[2] + a[3]);
}

struct EpiProj {
    static constexpr bool PERM = true, AFTER_DRAIN = false;
    bf16_t* O; int ldc; const float* ss; int nparts; const float* gq; const float* gk; const float* rope; int layer; float pre; const PG8_LAS float* rtab;
    __device__ __forceinline__ void operator()(const f32x4 (&acc)[2][2][4][2], const Unit& u, int wr, int wc, int fr, int fq) const {
        const int pn = u.pn; int kind = 0; float scale = 1.f; bool rope_on = false;
        if (layer == 0) { const int t = pn >> 1; if (t == 0) scale = C2; else if (t == 3) { kind = 1; scale = C2; rope_on = true; } else if (t == 4) { kind = 2; rope_on = true; } }
        else { const int t = pn >> 2; if (t == 0) { kind = 1; scale = C2; } else if (t == 1) kind = 2; }
        const float* gv = (kind == 1) ? gq : gk;
        f32x4 g[2][2];
#pragma unroll
        for (int bj = 0; bj < 2; ++bj)
#pragma unroll
            for (int n = 0; n < 2; ++n) g[bj][n] = kind ? *(const f32x4*)(gv + 32 * bj + 8 * fq + 4 * n) : (f32x4){1.f, 1.f, 1.f, 1.f};
        const int row0 = u.pm * BM + wr * 64 + fr, col0 = pn * BM + wc * 64 + 8 * fq;
#pragma unroll
        for (int ai = 0; ai < 2; ++ai)
#pragma unroll
            for (int m = 0; m < 4; ++m) {
                const int row = row0 + ai * HALF + m * 16;
                const float r = (u.aux < RT_UNITS) ? rtab[u.aux * 256 + wr * 64 + fr + ai * HALF + m * 16] * pre : rsqrtf(row_ss(ss, nparts, row) * (1.f / 1024.f) + RMS_EPS) * pre;
                f32x4 v[2][2]; float s = 0.f;
#pragma unroll
                for (int bj = 0; bj < 2; ++bj)
#pragma unroll
                    for (int n = 0; n < 2; ++n) { v[bj][n] = acc[ai][bj][m][n] * r; const f32x4 x = v[bj][n]; s += (x[0] * x[0] + x[1] * x[1]) + (x[2] * x[2] + x[3] * x[3]); }
                if (kind) {
                    s += __shfl_xor(s, 16); s += __shfl_xor(s, 32);
                    const float rs = rsqrtf(s * (1.f / 64.f) + RMS_EPS);
#pragma unroll
                    for (int bj = 0; bj < 2; ++bj)
#pragma unroll
                        for (int n = 0; n < 2; ++n) v[bj][n] = v[bj][n] * rs * g[bj][n];
                    if (rope_on) {
                        f32x4 p[2];
#pragma unroll
                        for (int n = 0; n < 2; ++n)
#pragma unroll
                            for (int j = 0; j < 4; ++j) p[n][j] = __shfl_xor(v[0][n][j], 16);
                        const f32x4 c0 = *(const f32x4*)(rope + (size_t)row * 16), c1 = *(const f32x4*)(rope + (size_t)row * 16 + 4);
                        const f32x4 s0 = *(const f32x4*)(rope + (size_t)row * 16 + 8), s1 = *(const f32x4*)(rope + (size_t)row * 16 + 12);
                        if (fq == 0) { v[0][0] = v[0][0] * c0 - p[0] * s0; v[0][1] = v[0][1] * c1 - p[1] * s1; }
                        else if (fq == 1) { v[0][0] = v[0][0] * c0 + p[0] * s0; v[0][1] = v[0][1] * c1 + p[1] * s1; }
                    }
                }
                bf16_t* rowp = O + ((size_t)(pn * 4 + wc) * ldc + row) * 64 + 8 * fq;
#pragma unroll
                for (int bj = 0; bj < 2; ++bj) *(u32x4*)(rowp + 32 * bj) = pack8(v[bj][0] * scale, v[bj][1] * scale);
            }
    }
};

struct EpiResid {
    static constexpr bool PERM = true, AFTER_DRAIN = false;
    const float* base; float* out; bf16_t* xb; float* ss; float pre; unsigned char* x8;
    __device__ __forceinline__ void operator()(const f32x4 (&acc)[2][2][4][2], const Unit& u, int wr, int wc, int fr, int fq) const {
        const int row0 = u.pm * BM + wr * 64 + fr, col0 = u.pn * BM + wc * 32 + 8 * fq;
#pragma unroll
        for (int rp = 0; rp < 4; ++rp) {
            const int ai = rp >> 1; f32x4 bv[2][2][2];
#pragma unroll
            for (int mm = 0; mm < 2; ++mm)
#pragma unroll
                for (int bj = 0; bj < 2; ++bj) { const size_t off = (size_t)(row0 + ai * HALF + ((rp & 1) * 2 + mm) * 16) * 1024 + col0 + bj * HALF; bv[mm][bj][0] = *(const f32x4*)(base + off); bv[mm][bj][1] = *(const f32x4*)(base + off + 4); }
#pragma unroll
            for (int mm = 0; mm < 2; ++mm) { const int m = (rp & 1) * 2 + mm;
                const int row = row0 + ai * HALF + m * 16; float s = 0.f;
#pragma unroll
                for (int bj = 0; bj < 2; ++bj) {
                    const size_t off = (size_t)row * 1024 + col0 + bj * HALF;
                    const f32x4 v0 = acc[ai][bj][m][0] * pre + bv[mm][bj][0], v1 = acc[ai][bj][m][1] * pre + bv[mm][bj][1];
                    *(f32x4*)(out + off) = v0; *(f32x4*)(out + off + 4) = v1;
                    if (xb) *(u32x4*)(xb + off) = pack8(v0, v1);
                    if (x8) { typedef unsigned u32x2 __attribute__((ext_vector_type(2))); u32x2 w8; w8.x = pk4_fp8(v0[0], v0[1], v0[2], v0[3]); w8.y = pk4_fp8(v1[0], v1[1], v1[2], v1[3]); *(u32x2*)(x8 + off) = w8; }
                    s += (v0[0] * v0[0] + v0[1] * v0[1]) + (v0[2] * v0[2] + v0[3] * v0[3]) + (v1[0] * v1[0] + v1[1] * v1[1]) + (v1[2] * v1[2] + v1[3] * v1[3]);
                }
                if (ss) { s += __shfl_xor(s, 16); s += __shfl_xor(s, 32); if (fq == 0) ss[(size_t)row * 16 + u.pn * 4 + wc] = s; }
            }
        }
    }
};

template <bool OUT8> struct EpiSwiglu {
    static constexpr bool PERM = true, AFTER_DRAIN = false;
    void* O; int ldc; const float* ss; int nparts; const float* rowscale; int tile0; int npn; float pre; const PG8_LAS float* rtab;
    __device__ __forceinline__ void operator()(const f32x4 (&acc)[2][2][4][2], const Unit& u, int wr, int wc, int fr, int fq) const {
        const int pnl = u.pn % npn; const int row0 = u.pm * BM + wr * 64 + fr, col0 = pnl * HALF + wc * 32 + 8 * fq;
#pragma unroll
        for (int ai = 0; ai < 2; ++ai)
#pragma unroll
            for (int m = 0; m < 4; ++m) {
                const int row = row0 + ai * HALF + m * 16;
                const float r = (u.aux < RT_UNITS) ? rtab[u.aux * 256 + wr * 64 + fr + ai * HALF + m * 16] * pre : (rowscale ? rowscale[tile0 * BM + row] * pre : rsqrtf(row_ss(ss, nparts, row) * (1.f / 1024.f) + RMS_EPS) * pre);
                f32x4 a[2]; const float rl = -r * LOG2E, ir2 = __builtin_amdgcn_rcpf(r * r);
#pragma unroll
                for (int n = 0; n < 2; ++n) { const f32x4 gq = acc[ai][0][m][n], t = gq * rl; f32x4 d;
#pragma unroll
                    for (int j = 0; j < 4; ++j) d[j] = __builtin_amdgcn_rcpf(__builtin_fmaf(__builtin_amdgcn_exp2f(t[j]), ir2, ir2));
                    a[n] = (gq * acc[ai][1][m][n]) * d; }
                if constexpr (OUT8) { typedef unsigned u32x2 __attribute__((ext_vector_type(2))); u32x2 w; w.x = pk4_fp8(a[0][0], a[0][1], a[0][2], a[0][3]); w.y = pk4_fp8(a[1][0], a[1][1], a[1][2], a[1][3]); *(u32x2*)((unsigned char*)O + (size_t)row * ldc + col0) = w; }
                else *(u32x4*)((bf16_t*)O + (size_t)row * ldc + col0) = pack8(a[0], a[1]);
            }
    }
};

struct EpiMoeDown {
    static constexpr bool PERM = true, AFTER_DRAIN = false;
    float* out; const int* rowtok; const float* rowgate; int tile0; float pre; int nostore;
    __device__ __forceinline__ void operator()(const f32x4 (&acc)[2][2][4][2], const Unit& u, int wr, int wc, int fr, int fq) const {
        const int pnl = u.pn & 3; const int row0 = (tile0 + u.pm) * BM + wr * 64 + fr, col0 = pnl * BM + wc * 32 + 8 * fq;
        int tk[2][4]; float gt[2][4];
#pragma unroll
        for (int ai = 0; ai < 2; ++ai)
#pragma unroll
            for (int m = 0; m < 4; ++m) { const int srow = row0 + ai * HALF + m * 16; tk[ai][m] = nostore ? -1 : rowtok[srow]; gt[ai][m] = rowgate[srow] * pre; }
#pragma unroll
        for (int rp = 0; rp < 4; ++rp) { const int ai = rp >> 1; f32x4 ov[2][2][2];
#pragma unroll
            for (int mm = 0; mm < 2; ++mm) { const int m = (rp & 1) * 2 + mm; const int tc = tk[ai][m] > 0 ? tk[ai][m] : 0;
#pragma unroll
                for (int bj = 0; bj < 2; ++bj)
#pragma unroll
                    for (int n = 0; n < 2; ++n) ov[mm][bj][n] = *(const f32x4*)(out + (size_t)tc * 1024 + col0 + bj * HALF + 4 * n); }
#pragma unroll
            for (int mm = 0; mm < 2; ++mm) { const int m = (rp & 1) * 2 + mm;
                if (tk[ai][m] >= 0) {
#pragma unroll
                    for (int bj = 0; bj < 2; ++bj)
#pragma unroll
                        for (int n = 0; n < 2; ++n) *(f32x4*)(out + (size_t)tk[ai][m] * 1024 + col0 + bj * HALF + 4 * n) = ov[mm][bj][n] + acc[ai][bj][m][n] * gt[ai][m]; } }
        }
    }
};

typedef int i32x4 __attribute__((ext_vector_type(4)));
typedef int i32x8 __attribute__((ext_vector_type(8)));
template <class Epi, class Sched, bool ALIGN_EPI = false, bool SP2 = false, bool F8 = false>
__device__ __forceinline__ void gemm_phase(PG8_LAS unsigned char* lds, const Gemm g, const Sched& S, const Epi& E) {
    const int tid = threadIdx.x, wid = __builtin_amdgcn_readfirstlane(tid >> 6), lane = tid & 63, wr = wid >> 2, wc = wid & 3, fr = lane & 15, fq = lane >> 4;
    const int K = g.K, nt = K / BK;
    unsigned voffA[2], voffB[2];
#pragma unroll
    for (int i = 0; i < 2; ++i) { int R, C; stage_rc(tid * 16 + i * 8192, R, C); const int Rb = Epi::PERM ? ((R & ~31) + perm32(R & 31)) : R;
        voffA[i] = (unsigned)(R * K + C) * 2u; voffB[i] = (unsigned)(Rb * K + C) * 2u; }
    const size_t kstep = (size_t)(BK * 2);
    const size_t hstep = (size_t)HALF * K * 2;
    const size_t tstep = 2 * hstep;
    const unsigned ldsw = (unsigned)wid * 1024u;
    const int aoff = lds_byte(wr * 64 + fr, fq * 8), boff = lds_byte(wc * 32 + fr, fq * 8);
#define PG8_SA(b, h) (((b) * 2 + (h)) * HTB)
#define PG8_SB(b, h) ((4 + (b) * 2 + (h)) * HTB)
#define PG8_STAGE(bufoff, gbase, voff) do { _Pragma("unroll") for (int _i = 0; _i < 2; ++_i) \
        __builtin_amdgcn_global_load_lds((const unsigned*)((const char*)(gbase) + (voff)[_i]), (PG8_LAS unsigned*)(lds + (bufoff) + ldsw + _i * 8192), 16, 0, 0); } while (0)
#define PG8_LDA(dst, b, h) do { if constexpr (F8) { _Pragma("unroll") for (int m = 0; m < 4; ++m) dst##8[m] = PG8_CAT(*(const PG8_LAS bf16x8*)(lds + PG8_SA(b, h) + aoff + m * 2048), *(const PG8_LAS bf16x8*)(lds + PG8_SA(b, h) + aoff + m * 2048 + 1024)); } \
        else { _Pragma("unroll") for (int m = 0; m < 4; ++m) _Pragma("unroll") for (int k = 0; k < 2; ++k) dst[m][k] = *(const PG8_LAS bf16x8*)(lds + PG8_SA(b, h) + aoff + m * 2048 + k * 1024); } } while (0)
#define PG8_LDB(dst, b, h) do { if constexpr (F8) { _Pragma("unroll") for (int n = 0; n < 2; ++n) dst##8[n] = PG8_CAT(*(const PG8_LAS bf16x8*)(lds + PG8_SB(b, h) + boff + n * 2048), *(const PG8_LAS bf16x8*)(lds + PG8_SB(b, h) + boff + n * 2048 + 1024)); } \
        else { _Pragma("unroll") for (int n = 0; n < 2; ++n) _Pragma("unroll") for (int k = 0; k < 2; ++k) dst[n][k] = *(const PG8_LAS bf16x8*)(lds + PG8_SB(b, h) + boff + n * 2048 + k * 1024); } } while (0)
#define PG8_CAT(x, y) __builtin_shufflevector(__builtin_bit_cast(i32x4, (x)), __builtin_bit_cast(i32x4, (y)), 0, 1, 2, 3, 4, 5, 6, 7)
#define PG8_MMA(ai, bj, At, Bt) do { __builtin_amdgcn_s_setprio(1); _Pragma("unroll") for (int m = 0; m < 4; ++m) _Pragma("unroll") for (int n = 0; n < 2; ++n) { \
        if constexpr (F8) { asm volatile("v_mfma_f32_16x16x128_f8f6f4 %0, %1, %2, %0" : "+v"(acc[ai][bj][m][n]) : "v"(Bt##8[n]), "v"(At##8[m])); } \
        else { _Pragma("unroll") for (int k = 0; k < 2; ++k) acc[ai][bj][m][n] = __builtin_amdgcn_mfma_f32_16x16x32_bf16(Bt[n][k], At[m][k], acc[ai][bj][m][n], 0, 0, 0); } } __builtin_amdgcn_s_setprio(0); } while (0)
#define PG8_WAIT_V(n) asm volatile("s_waitcnt vmcnt(" #n ")" ::: "memory")
#define PG8_WAIT_L(n) asm volatile("s_waitcnt lgkmcnt(" #n ")" ::: "memory")
#define PG8_BAR __builtin_amdgcn_s_barrier()
#define PG8_SCHED __builtin_amdgcn_sched_barrier(0)
    Unit cur, nxt; int ui = 0;
    if (!S.next(0, cur)) return;
    f32x4 acc[2][2][4][2];
#pragma unroll
    for (int a = 0; a < 2; ++a)
#pragma unroll
        for (int b = 0; b < 2; ++b)
#pragma unroll
            for (int m = 0; m < 4; ++m)
#pragma unroll
                for (int n = 0; n < 2; ++n) acc[a][b][m][n] = (f32x4){0.f, 0.f, 0.f, 0.f};
    bf16x8 At[4][2], B0[2][2], B1[2][2];
    i32x8 At8[4], B08[2], B18[2];
    const char* cA = (const char*)g.A + (size_t)cur.pm * tstep; const char* cB = (const char*)g.Bt + (size_t)cur.pn * tstep;
    S.a_ready(cur);
    if constexpr (SP2) {
        PG8_STAGE(PG8_SB(0, 0), cB, voffB); PG8_STAGE(PG8_SB(0, 1), cB + hstep, voffB); PG8_STAGE(PG8_SA(0, 0), cA, voffA); PG8_STAGE(PG8_SA(0, 1), cA + hstep, voffA);
        if (wr == 1) PG8_BAR;
        PG8_WAIT_V(2); PG8_BAR;
        PG8_STAGE(PG8_SB(1, 0), cB + kstep, voffB); PG8_STAGE(PG8_SA(1, 0), cA + kstep, voffA); PG8_STAGE(PG8_SB(1, 1), cB + hstep + kstep, voffB);
        PG8_WAIT_V(6); PG8_BAR;
    } else {
        PG8_STAGE(PG8_SB(0, 0), cB, voffB); PG8_STAGE(PG8_SA(0, 0), cA, voffA); PG8_STAGE(PG8_SB(0, 1), cB + hstep, voffB); PG8_STAGE(PG8_SA(0, 1), cA + hstep, voffA);
        if (wr == 1) PG8_BAR;
        PG8_WAIT_V(4); PG8_BAR;
        PG8_STAGE(PG8_SB(1, 0), cB + kstep, voffB); PG8_STAGE(PG8_SA(1, 0), cA + kstep, voffA); PG8_STAGE(PG8_SB(1, 1), cB + hstep + kstep, voffB);
        PG8_WAIT_V(6); PG8_BAR;
    }
    for (;;) {
        const bool has_next = S.next(ui + 1, nxt);
        const char* nA = has_next ? (const char*)g.A + (size_t)nxt.pm * tstep : cA; const char* nB = has_next ? (const char*)g.Bt + (size_t)nxt.pn * tstep : cB;
#pragma nounroll
        for (int t = 0; t < nt; t += 2) {
            const bool last = (t == nt - 2);
            const char* a1 = cA + (size_t)(t + 1) * kstep;
            const char* a2 = last ? nA : cA + (size_t)(t + 2) * kstep; const char* b2 = last ? nB : cB + (size_t)(t + 2) * kstep;
            const char* a3 = a2 + kstep; const char* b3 = b2 + kstep;
            if (last && has_next) S.a_ready(nxt);
            if constexpr (SP2) {
            PG8_LDB(B0, 0, 0); PG8_LDB(B1, 0, 1); PG8_SCHED; PG8_LDA(At, 0, 0); PG8_STAGE(PG8_SA(1, 1), a1 + hstep, voffA);
            PG8_WAIT_V(8); PG8_WAIT_L(0); PG8_BAR; PG8_MMA(0, 0, At, B0); PG8_MMA(0, 1, At, B1); PG8_BAR; PG8_SCHED;
            PG8_LDA(At, 0, 1); PG8_STAGE(PG8_SB(0, 0), b2, voffB); PG8_STAGE(PG8_SB(0, 1), b2 + hstep, voffB); PG8_STAGE(PG8_SA(0, 0), a2, voffA);
            PG8_WAIT_V(8); PG8_WAIT_L(0); PG8_BAR; PG8_MMA(1, 0, At, B0); PG8_MMA(1, 1, At, B1); PG8_BAR; PG8_SCHED;
            PG8_LDB(B0, 1, 0); PG8_LDB(B1, 1, 1); PG8_SCHED; PG8_LDA(At, 1, 0); PG8_STAGE(PG8_SA(0, 1), a2 + hstep, voffA);
            PG8_WAIT_V(8); PG8_WAIT_L(0); PG8_BAR; PG8_MMA(0, 0, At, B0); PG8_MMA(0, 1, At, B1); PG8_BAR; PG8_SCHED;
            PG8_LDA(At, 1, 1); PG8_STAGE(PG8_SB(1, 0), b3, voffB); PG8_STAGE(PG8_SB(1, 1), b3 + hstep, voffB); PG8_STAGE(PG8_SA(1, 0), a3, voffA);
            PG8_WAIT_V(8); PG8_WAIT_L(0); PG8_BAR; PG8_MMA(1, 0, At, B0); PG8_MMA(1, 1, At, B1); PG8_BAR; PG8_SCHED;
            } else {
            PG8_LDB(B0, 0, 0); PG8_SCHED; PG8_LDA(At, 0, 0); PG8_STAGE(PG8_SA(1, 1), a1 + hstep, voffA);
            PG8_WAIT_L(8); PG8_BAR; PG8_WAIT_L(0); PG8_MMA(0, 0, At, B0); PG8_BAR; PG8_SCHED;
            PG8_LDB(B1, 0, 1); PG8_STAGE(PG8_SB(0, 0), b2, voffB);
            PG8_BAR; PG8_WAIT_L(0); PG8_MMA(0, 1, At, B1); PG8_BAR;
            PG8_LDA(At, 0, 1); PG8_STAGE(PG8_SA(0, 0), a2, voffA);
            PG8_BAR; PG8_WAIT_L(0); PG8_MMA(1, 0, At, B0); PG8_BAR; PG8_SCHED;
            PG8_STAGE(PG8_SB(0, 1), b2 + hstep, voffB);
            PG8_WAIT_V(6); PG8_BAR; PG8_MMA(1, 1, At, B1); PG8_BAR;
            PG8_LDB(B0, 1, 0); PG8_SCHED; PG8_LDA(At, 1, 0); PG8_STAGE(PG8_SA(0, 1), a2 + hstep, voffA);
            PG8_WAIT_L(8); PG8_BAR; PG8_WAIT_L(0); PG8_MMA(0, 0, At, B0); PG8_BAR; PG8_SCHED;
            PG8_LDB(B1, 1, 1); PG8_STAGE(PG8_SB(1, 0), b3, voffB);
            PG8_BAR; PG8_WAIT_L(0); PG8_MMA(0, 1, At, B1); PG8_BAR;
            PG8_LDA(At, 1, 1); PG8_STAGE(PG8_SA(1, 0), a3, voffA);
            PG8_BAR; PG8_WAIT_L(0); PG8_MMA(1, 0, At, B0); PG8_BAR; PG8_SCHED;
            PG8_STAGE(PG8_SB(1, 1), b3 + hstep, voffB);
            PG8_WAIT_V(6); PG8_BAR; PG8_MMA(1, 1, At, B1); PG8_BAR;
            }
        }
        if constexpr (F8) asm volatile("s_nop 15\n\ts_nop 15\n\ts_nop 15" ::: "memory");
        if constexpr (ALIGN_EPI) { if (wr == 0) PG8_BAR; }
        if constexpr (!Epi::AFTER_DRAIN) { E(acc, cur, wr, wc, fr, fq); S.done(cur); }
        if (!has_next) break;
#pragma unroll
        for (int a = 0; a < 2; ++a)
#pragma unroll
            for (int b = 0; b < 2; ++b)
#pragma unroll
                for (int m = 0; m < 4; ++m)
#pragma unroll
                    for (int n = 0; n < 2; ++n) acc[a][b][m][n] = (f32x4){0.f, 0.f, 0.f, 0.f};
        cur = nxt; cA = nA; cB = nB; ++ui;
        if constexpr (ALIGN_EPI) { if (wr == 1) PG8_BAR; }
    }
    PG8_WAIT_V(0);
    if constexpr (!ALIGN_EPI) { if (wr == 0) PG8_BAR; }
    PG8_BAR;
    if constexpr (Epi::AFTER_DRAIN) { E.fused(acc, cur, wr, wc, fr, fq, lds, wid, lane); S.done(cur); }
#undef PG8_SA
#undef PG8_SB
#undef PG8_STAGE
#undef PG8_LDA
#undef PG8_LDB
#undef PG8_MMA
#undef PG8_CAT
#undef PG8_WAIT_V
#undef PG8_WAIT_L
#undef PG8_BAR
#undef PG8_SCHED
}
}

namespace att {
using pg8::bf16_t; using pg8::bf16x8; using pg8::u32x4;
typedef float f32x16 __attribute__((ext_vector_type(16)));
typedef short s16x4 __attribute__((ext_vector_type(4)));
typedef float f32x2_t __attribute__((ext_vector_type(2))); typedef __bf16 bf16x2_t __attribute__((ext_vector_type(2)));
#define ALAS __attribute__((address_space(3)))
typedef ALAS const char* lds_cptr;
constexpr int SEQ = 8192, PITCH = 64, VNEXT = 2 * SEQ * 64;
constexpr int KVSLOT = 24576;
constexpr int L_WS = 114688, L_TAB = L_WS + 2048, L_FLAG = L_TAB + 1056, L_END = L_FLAG + 128, L_OST = 0;
constexpr float SB_THR = 152.f;
__device__ __forceinline__ int crow(int r, int hi) { return (r & 3) + 8 * (r >> 2) + 4 * hi; }
__device__ __forceinline__ void glds16(const void* gsrc, unsigned lds_dst) { unsigned keep;
    asm volatile("s_mov_b32 %0, m0\n\ts_mov_b32 m0, %2\n\ts_nop 0\n\tglobal_load_lds_dwordx4 %1, off\n\ts_mov_b32 m0, %0" : "=&s"(keep) : "v"(gsrc), "s"(lds_dst) : "memory"); }
__device__ __forceinline__ unsigned cvtpk(float lo, float hi) { f32x2_t v = {lo, hi}; bf16x2_t b = __builtin_convertvector(v, bf16x2_t); return __builtin_bit_cast(unsigned, b); }
__device__ __forceinline__ unsigned short f2bf(float f) { unsigned u = __builtin_bit_cast(unsigned, f); return (unsigned short)((u + 0x7fffu + ((u >> 16) & 1u)) >> 16); }
#define MFMA32(a, b, c) __builtin_amdgcn_mfma_f32_32x32x16_bf16((a), (b), (c), 0, 0, 0)

__device__ __forceinline__ void qkt(f32x16& p0, f32x16& p1, lds_cptr kb, const bf16x8* qr, const f32x16& cin) {
#pragma unroll
    for (int d0 = 0; d0 < 4; ++d0) {
        const bf16x8 b0 = *(const ALAS bf16x8*)(kb + d0 * 2048);
        const bf16x8 b1 = *(const ALAS bf16x8*)(kb + d0 * 2048 + 512);
        if (d0 == 0) { p0 = MFMA32(b0, qr[0], cin); p1 = MFMA32(b1, qr[0], cin); }
        else { p0 = MFMA32(b0, qr[d0], p0); p1 = MFMA32(b1, qr[d0], p1); }
    }
}

__device__ __forceinline__ void qkt_sw(f32x16& p0, f32x16& p1, lds_cptr ks, const int (&kofs)[4], const bf16x8* qr, const f32x16& cin) {
    bf16x8 kf[8];
#pragma unroll
    for (int d0 = 0; d0 < 4; ++d0) { kf[2 * d0] = *(const ALAS bf16x8*)(ks + kofs[d0]); kf[2 * d0 + 1] = *(const ALAS bf16x8*)(ks + kofs[d0] + 4096); }
    p0 = MFMA32(kf[0], qr[0], cin); p1 = MFMA32(kf[1], qr[0], cin);
#pragma unroll
    for (int d0 = 1; d0 < 4; ++d0) { p0 = MFMA32(kf[2 * d0], qr[d0], p0); p1 = MFMA32(kf[2 * d0 + 1], qr[d0], p1); }
}
template <int ND> __device__ __forceinline__ void pv(f32x16* o, int vb, bf16x8 pa0, bf16x8 pa1, bf16x8 pa2, bf16x8 pa3) {
#pragma unroll
    for (int d0 = 0; d0 < ND; ++d0) { s16x4 lo[4], hi[4];
#pragma unroll
        for (int ks = 0; ks < 4; ++ks) {
            asm volatile("ds_read_b64_tr_b16 %0,%1 offset:%c2" : "=&v"(lo[ks]) : "v"(vb), "i"(d0 * 4096 + ks * 1024) : "memory");
            asm volatile("ds_read_b64_tr_b16 %0,%1 offset:%c2" : "=&v"(hi[ks]) : "v"(vb), "i"(d0 * 4096 + ks * 1024 + 512) : "memory"); }
        asm volatile("s_waitcnt lgkmcnt(0)" ::: "memory"); __builtin_amdgcn_sched_barrier(0);
#define ATT_PK(k) (bf16x8){lo[k][0], lo[k][1], lo[k][2], lo[k][3], hi[k][0], hi[k][1], hi[k][2], hi[k][3]}
        o[d0] = MFMA32(pa0, ATT_PK(0), o[d0]);
        o[d0] = MFMA32(pa1, ATT_PK(1), o[d0]);
        o[d0] = MFMA32(pa2, ATT_PK(2), o[d0]);
        o[d0] = MFMA32(pa3, ATT_PK(3), o[d0]);
#undef ATT_PK
    }
}

template <int MODE, int VD, bool OUT8 = false, int TPB = 1>
__device__ __forceinline__ void attn_unit(ALAS char* shm, const bf16_t* Qb, const bf16_t* Kb, const bf16_t* Vb, void* Ob, int opitch, int q0, float mref2, const float* tab, float oscale = 1.f, int dbg = 0) {
    constexpr int ND = VD / 32, SLOT = 8192 + VD * 128;
    static_assert(2 * TPB * SLOT <= L_WS, "ring vs LDS map");
    const int tid = threadIdx.x, lane = tid & 63, r32 = lane & 31, hi = lane >> 5; const int wid = __builtin_amdgcn_readfirstlane(tid >> 6);
    const unsigned lds0 = (unsigned)(uintptr_t)shm;
    ALAS float* wsf = (ALAS float*)(shm + L_WS) + wid * 64;
    ALAS float* tabL = (ALAS float*)(shm + L_TAB);
    ALAS unsigned* flg = (ALAS unsigned*)(shm + L_FLAG);
    if (MODE == 1) { for (int i = tid; i < 257; i += 512) tabL[i] = tab[i] * pg8::LOG2E; }
    const bf16_t* Qw = Qb + (size_t)(q0 + wid * 32) * PITCH;
    bf16x8 qr[4];
#pragma unroll
    for (int d0 = 0; d0 < 4; ++d0) qr[d0] = *(const bf16x8*)(Qw + (size_t)r32 * PITCH + d0 * 16 + hi * 8);
    int t_first, n_t, t_step;
    if (MODE == 0) { t_first = 0; n_t = q0 / 64 + 4; t_step = 1; }
    else if (MODE == 1) { const int c0 = q0 / 64; t_first = c0 - 8 > 0 ? c0 - 8 : 0; n_t = c0 + 4 - t_first; t_step = 1; }
    else { t_first = q0 / 64 + 3; n_t = q0 / 64 + 4; t_step = -1; }
    const int krow = 8 * wid + (lane >> 3);
    const bf16_t* ksrc = Kb + (size_t)krow * PITCH + (((lane & 7) ^ ((krow >> 1) & 7)) * 8);
    int kofs[4];
#pragma unroll
    for (int d0 = 0; d0 < 4; ++d0) kofs[d0] = (r32 >> 3) * 1024 + ((r32 & 7) * 8 + ((2 * d0 + hi) ^ ((r32 >> 1) & 7))) * 16;
    const bf16_t* vsrc = Vb + (size_t)(16 * (wid & 3) + (lane >> 2)) * PITCH + (wid >> 2) * 32 + (lane & 3) * 8;
#define ATT_DMA(t, slot) do { if (dbg & 64) break; const size_t to_ = (size_t)(t) * 64 * PITCH; const unsigned sb_ = lds0 + (unsigned)(slot) * SLOT; \
        glds16(ksrc + to_, (unsigned)__builtin_amdgcn_readfirstlane(sb_ + wid * 1024)); \
        glds16(vsrc + to_, (unsigned)__builtin_amdgcn_readfirstlane(sb_ + 8192 + wid * 1024)); \
        if (VD == 128) glds16(vsrc + to_ + VNEXT, (unsigned)__builtin_amdgcn_readfirstlane(sb_ + 8192 + (wid + 8) * 1024)); } while (0)
    f32x16 o[ND];
#pragma unroll
    for (int d = 0; d < ND; ++d) o[d] = f32x16{};
    f32x16 cin;
#pragma unroll
    for (int r = 0; r < 16; ++r) cin[r] = (MODE == 2) ? 0.f : -mref2;
    float l_reg = 0.f, A = 0.f; bool wdone = false;
    const int wrow0 = q0 + wid * 32, qrow = wrow0 + r32;
    const int vb0 = (int)lds0 + 8192 + ((lane >> 4) & 1) * 32 + (lane & 3) * 8 + (4 * hi + ((lane & 15) >> 2)) * 64;
#pragma unroll
    for (int u = 0; u < TPB; ++u) ATT_DMA(t_first + u * t_step, u);
    asm volatile("s_waitcnt vmcnt(0)" ::: "memory"); asm volatile("" : "+v"(qr[0]), "+v"(qr[1]), "+v"(qr[2]), "+v"(qr[3]));
    for (int i = 0; i < n_t; ++i) {
        const int t = t_first + i * t_step, slot = i % (2 * TPB);
        if (i % TPB == 0) {
        asm volatile("s_waitcnt vmcnt(0) lgkmcnt(0)\n\ts_barrier" ::: "memory");
        if (MODE == 2 && i > 0) { const int par = ((i - 1) & 3) * 8; unsigned all = 1u;
#pragma unroll
            for (int w = 0; w < 8; ++w) all &= flg[par + w];
            if (__builtin_amdgcn_readfirstlane(all)) break; }
        if (i + TPB < n_t) {
#pragma unroll
            for (int u = 0; u < TPB; ++u) ATT_DMA(t + (TPB + u) * t_step, (i + TPB + u) % (2 * TPB)); }
        }
        bool active;
        if (MODE == 0) active = (64 * t <= wrow0);
        else if (MODE == 1) { const int cw = wrow0 / 64; active = (t >= cw - 8) && (t <= cw); }
        else active = !wdone && (64 * t < wrow0 + 31);
        if (active && !(dbg & 32)) {
            f32x16 p0, p1; qkt_sw(p0, p1, (lds_cptr)shm + slot * SLOT, kofs, qr, cin);
            if (MODE == 0) {
#pragma unroll
                for (int r = 0; r < 16; ++r) { p0[r] = __builtin_amdgcn_exp2f(p0[r]); p1[r] = __builtin_amdgcn_exp2f(p1[r]); }
            } else if (MODE == 1) {
                const int cw = wrow0 / 64;
                if (t <= cw - 3) { const float cb = tabL[256];
#pragma unroll
                    for (int r = 0; r < 16; ++r) { p0[r] = __builtin_amdgcn_exp2f(p0[r] + cb); p1[r] = __builtin_amdgcn_exp2f(p1[r] + cb); }
                } else { const int dq = qrow - 64 * t - 4 * hi;
#pragma unroll
                    for (int r = 0; r < 16; ++r) { int d0 = dq - ((r & 3) + 8 * (r >> 2)), d1 = d0 - 32;
                        d0 = d0 < -128 ? -128 : (d0 > 128 ? 128 : d0); d1 = d1 < -128 ? -128 : (d1 > 128 ? 128 : d1);
                        p0[r] = __builtin_amdgcn_exp2f(p0[r] + tabL[d0 + 128]); p1[r] = __builtin_amdgcn_exp2f(p1[r] + tabL[d1 + 128]); }
                }
            } else {
                const bool needmask = (64 * t + 63 >= wrow0);
                const int kq = qrow - 64 * t - 4 * hi;
                float g[8];
#pragma unroll
                for (int k = 0; k < 8; ++k) g[k] = 0.f;
                f32x16 s0, s1;
#pragma unroll
                for (int r = 0; r < 16; ++r) { const int kv = (r & 3) + 8 * (r >> 2);
                    { const float y = p0[r], a = __builtin_fabsf(y); float sp = __builtin_fmaxf(y, 0.f) + __builtin_amdgcn_logf(1.f + __builtin_amdgcn_exp2f(-a)); if (needmask && !(kv < kq)) sp = 0.f; s0[r] = sp; g[r >> 2] += sp; }
                    { const float y = p1[r], a = __builtin_fabsf(y); float sp = __builtin_fmaxf(y, 0.f) + __builtin_amdgcn_logf(1.f + __builtin_amdgcn_exp2f(-a)); if (needmask && !(kv + 32 < kq)) sp = 0.f; s1[r] = sp; g[4 + (r >> 2)] += sp; } }
                float pg[8];
#pragma unroll
                for (int k = 0; k < 8; ++k) pg[k] = __shfl_xor(g[k], 32);
                float base[8]; float own = 0.f, par = 0.f;
#pragma unroll
                for (int k = 7; k >= 0; --k) { const float par_incl = par + pg[k]; base[k] = A + own + (hi == 0 ? par_incl : par); own += g[k]; par = par_incl; }
                A += own + par;
#pragma unroll
                for (int k = 0; k < 4; ++k) {
                    { float c = base[k]; c += s0[4 * k + 3]; const float w3 = __builtin_amdgcn_exp2f(p0[4 * k + 3] - c); c += s0[4 * k + 2]; const float w2 = __builtin_amdgcn_exp2f(p0[4 * k + 2] - c);
                      c += s0[4 * k + 1]; const float w1 = __builtin_amdgcn_exp2f(p0[4 * k + 1] - c); c += s0[4 * k]; const float w0 = __builtin_amdgcn_exp2f(p0[4 * k] - c);
                      p0[4 * k] = w0; p0[4 * k + 1] = w1; p0[4 * k + 2] = w2; p0[4 * k + 3] = w3; }
                    { float c = base[4 + k]; c += s1[4 * k + 3]; const float w3 = __builtin_amdgcn_exp2f(p1[4 * k + 3] - c); c += s1[4 * k + 2]; const float w2 = __builtin_amdgcn_exp2f(p1[4 * k + 2] - c);
                      c += s1[4 * k + 1]; const float w1 = __builtin_amdgcn_exp2f(p1[4 * k + 1] - c); c += s1[4 * k]; const float w0 = __builtin_amdgcn_exp2f(p1[4 * k] - c);
                      p1[4 * k] = w0; p1[4 * k + 1] = w1; p1[4 * k + 2] = w2; p1[4 * k + 3] = w3; }
                }
                if (needmask) {
#pragma unroll
                    for (int r = 0; r < 16; ++r) { const int kv = (r & 3) + 8 * (r >> 2); if (!(kv < kq)) p0[r] = 0.f; if (!(kv + 32 < kq)) p1[r] = 0.f; }
                }
                wdone = __all(A >= SB_THR);
            }
            if (MODE != 2) { float s = 0.f;
#pragma unroll
                for (int r = 0; r < 16; ++r) s += p0[r] + p1[r];
                l_reg += s; }
            u32x4 pw0, pw1, pw2, pw3;
            pw0 = (u32x4){cvtpk(p0[0], p0[1]), cvtpk(p0[2], p0[3]), cvtpk(p0[4], p0[5]), cvtpk(p0[6], p0[7])};
            pw1 = (u32x4){cvtpk(p0[8], p0[9]), cvtpk(p0[10], p0[11]), cvtpk(p0[12], p0[13]), cvtpk(p0[14], p0[15])};
            pw2 = (u32x4){cvtpk(p1[0], p1[1]), cvtpk(p1[2], p1[3]), cvtpk(p1[4], p1[5]), cvtpk(p1[6], p1[7])};
            pw3 = (u32x4){cvtpk(p1[8], p1[9]), cvtpk(p1[10], p1[11]), cvtpk(p1[12], p1[13]), cvtpk(p1[14], p1[15])};
            pv<ND>(o, vb0 + slot * SLOT, __builtin_bit_cast(bf16x8, pw0), __builtin_bit_cast(bf16x8, pw1), __builtin_bit_cast(bf16x8, pw2), __builtin_bit_cast(bf16x8, pw3));
        }
        if (MODE == 2) { if (lane == 0) flg[(i & 3) * 8 + wid] = wdone ? 1u : 0u; }
    }
#undef ATT_DMA
    asm volatile("s_waitcnt vmcnt(0) lgkmcnt(0)\n\ts_barrier" ::: "memory");
    float rl[16];
    if (MODE != 2) {
        l_reg += __shfl_xor(l_reg, 32);
        if (hi == 0) wsf[32 + r32] = l_reg;
        asm volatile("s_waitcnt lgkmcnt(0)" ::: "memory");
#pragma unroll
        for (int r = 0; r < 16; ++r) rl[r] = __builtin_amdgcn_rcpf(wsf[32 + crow(r, hi)]) * oscale;
    } else {
#pragma unroll
        for (int r = 0; r < 16; ++r) rl[r] = oscale;
    }
    if constexpr (OUT8) {
        static_assert(!OUT8 || VD == 64, "fp8 output: 64-wide heads");
        unsigned char* Ow = (unsigned char*)Ob + (size_t)(q0 + wid * 32) * opitch;
        ALAS unsigned char* stg = (ALAS unsigned char*)(shm + L_OST) + wid * 2048;
#pragma unroll
        for (int r = 0; r < 16; ++r) { const int orow = crow(r, hi);
#pragma unroll
            for (int d0 = 0; d0 < 2; ++d0) { const float v = o[d0][r] * rl[r]; stg[orow * 64 + d0 * 32 + r32] = (unsigned char)(__builtin_amdgcn_cvt_pk_fp8_f32(v, v, 0, false) & 0xff); } }
        asm volatile("s_waitcnt lgkmcnt(0)" ::: "memory");
#pragma unroll
        for (int i = 0; i < 2; ++i) { const int row = i * 16 + (lane >> 2), ch = lane & 3; const u32x4 v = *(const ALAS u32x4*)(stg + row * 64 + ch * 16); *(u32x4*)(Ow + (size_t)row * opitch + ch * 16) = v; }
        asm volatile("s_waitcnt lgkmcnt(0)" ::: "memory");
    } else {
    bf16_t* Ow = (bf16_t*)Ob + (size_t)(q0 + wid * 32) * opitch;
    ALAS bf16_t* stg = (ALAS bf16_t*)(shm + L_OST) + wid * 2048;
#pragma unroll
    for (int half = 0; half < ND / 2; ++half) {
#pragma unroll
        for (int r = 0; r < 16; ++r) { const int orow = crow(r, hi);
#pragma unroll
            for (int d0 = 0; d0 < 2; ++d0) stg[orow * 64 + d0 * 32 + r32] = f2bf(o[half * 2 + d0][r] * rl[r]); }
        asm volatile("s_waitcnt lgkmcnt(0)" ::: "memory");
#pragma unroll
        for (int i = 0; i < 4; ++i) { const int row = i * 8 + (lane >> 3), ch = lane & 7; const u32x4 v = *(const ALAS u32x4*)(stg + row * 64 + ch * 8); *(u32x4*)(Ow + (size_t)row * opitch + half * 64 + ch * 8) = v; }
        asm volatile("s_waitcnt lgkmcnt(0)" ::: "memory");
    }
    }
    asm volatile("s_waitcnt lgkmcnt(0)\n\ts_barrier" ::: "memory");
}


template <int MODE, int VD, bool OUT8 = false>
__device__ __forceinline__ void attn_unit_lag(ALAS char* shm, const bf16_t* Qb, const bf16_t* Kb, const bf16_t* Vb, void* Ob, int opitch, int q0, float mref2, const float* tab, float oscale = 1.f) {
    static_assert(MODE == 0 || MODE == 1, "stage-lagged loop: softmax modes only");
    constexpr int ND = VD / 32, VBY = VD * 128, VOFF = 16384;
    static_assert(VOFF + 3 * VBY <= L_WS, "ring vs LDS map");
    const int tid = threadIdx.x, lane = tid & 63, r32 = lane & 31, hi = lane >> 5; const int wid = __builtin_amdgcn_readfirstlane(tid >> 6); const bool lag = wid >= 4;
    const unsigned lds0 = (unsigned)(uintptr_t)shm;
    ALAS float* wsf = (ALAS float*)(shm + L_WS) + wid * 64;
    ALAS float* tabL = (ALAS float*)(shm + L_TAB);
    if (MODE == 1) { for (int i = tid; i < 257; i += 512) tabL[i] = tab[i] * pg8::LOG2E; }
    const bf16_t* Qw = Qb + (size_t)(q0 + wid * 32) * PITCH;
    bf16x8 qr[4];
#pragma unroll
    for (int d0 = 0; d0 < 4; ++d0) qr[d0] = *(const bf16x8*)(Qw + (size_t)r32 * PITCH + d0 * 16 + hi * 8);
    int t_first, n_t;
    if (MODE == 0) { t_first = 0; n_t = q0 / 64 + 4; }
    else { const int c0 = q0 / 64; t_first = c0 - 8 > 0 ? c0 - 8 : 0; n_t = c0 + 4 - t_first; }
    const int krow = 8 * wid + (lane >> 3);
    const bf16_t* ksrc = Kb + (size_t)krow * PITCH + (((lane & 7) ^ ((krow >> 1) & 7)) * 8) + (size_t)t_first * 64 * PITCH;
    int kofs[4];
#pragma unroll
    for (int d0 = 0; d0 < 4; ++d0) kofs[d0] = (r32 >> 3) * 1024 + ((r32 & 7) * 8 + ((2 * d0 + hi) ^ ((r32 >> 1) & 7))) * 16;
    const bf16_t* vsrc = Vb + (size_t)(16 * (wid & 3) + (lane >> 2)) * PITCH + (wid >> 2) * 32 + (lane & 3) * 8 + (size_t)t_first * 64 * PITCH;
#define LAG_DMA(i, v3) do { const size_t to_ = (size_t)(i) * 64 * PITCH; const unsigned vb_ = lds0 + VOFF + (unsigned)(v3) * VBY; \
        glds16(ksrc + to_, (unsigned)__builtin_amdgcn_readfirstlane(lds0 + (unsigned)((i) & 1) * 8192 + wid * 1024)); \
        glds16(vsrc + to_, (unsigned)__builtin_amdgcn_readfirstlane(vb_ + wid * 1024)); \
        if (VD == 128) glds16(vsrc + to_ + VNEXT, (unsigned)__builtin_amdgcn_readfirstlane(vb_ + (wid + 8) * 1024)); } while (0)
    f32x16 o[ND];
#pragma unroll
    for (int d = 0; d < ND; ++d) o[d] = f32x16{};
    f32x16 cin;
#pragma unroll
    for (int r = 0; r < 16; ++r) cin[r] = -mref2;
    float l_reg = 0.f;
    const int wrow0 = q0 + wid * 32, qrow = wrow0 + r32, cw = wrow0 / 64;
    const int vbl = (int)lds0 + VOFF + ((lane >> 4) & 1) * 32 + (lane & 3) * 8 + (4 * hi + ((lane & 15) >> 2)) * 64;
    LAG_DMA(0, 0);
    asm volatile("s_waitcnt vmcnt(0)" ::: "memory"); asm volatile("" : "+v"(qr[0]), "+v"(qr[1]), "+v"(qr[2]), "+v"(qr[3]));
    u32x4 pw0 = {0u, 0u, 0u, 0u}, pw1 = pw0, pw2 = pw0, pw3 = pw0; bool prev_act = false; int v3 = 0, v3p = 0;
    for (int i = 0; i < n_t; ++i) {
        const int t = t_first + i;
        asm volatile("s_waitcnt vmcnt(0) lgkmcnt(0)\n\ts_barrier" ::: "memory");
        const int v3n = (v3 == 2) ? 0 : v3 + 1;
        if (i + 1 < n_t) LAG_DMA(i + 1, v3n);
        if (lag && prev_act) pv<ND>(o, vbl + v3p * VBY, __builtin_bit_cast(bf16x8, pw0), __builtin_bit_cast(bf16x8, pw1), __builtin_bit_cast(bf16x8, pw2), __builtin_bit_cast(bf16x8, pw3));
        bool active;
        if (MODE == 0) active = (t <= cw); else active = (t >= cw - 8) && (t <= cw);
        if (active) {
            f32x16 p0, p1; qkt_sw(p0, p1, (lds_cptr)shm + (i & 1) * 8192, kofs, qr, cin);
            if (MODE == 0) {
#pragma unroll
                for (int r = 0; r < 16; ++r) { p0[r] = __builtin_amdgcn_exp2f(p0[r]); p1[r] = __builtin_amdgcn_exp2f(p1[r]); }
            } else {
                if (t <= cw - 3) { const float cb = tabL[256];
#pragma unroll
                    for (int r = 0; r < 16; ++r) { p0[r] = __builtin_amdgcn_exp2f(p0[r] + cb); p1[r] = __builtin_amdgcn_exp2f(p1[r] + cb); }
                } else { const int dq = qrow - 64 * t - 4 * hi;
#pragma unroll
                    for (int r = 0; r < 16; ++r) { int d0 = dq - ((r & 3) + 8 * (r >> 2)), d1 = d0 - 32;
                        d0 = d0 < -128 ? -128 : (d0 > 128 ? 128 : d0); d1 = d1 < -128 ? -128 : (d1 > 128 ? 128 : d1);
                        p0[r] = __builtin_amdgcn_exp2f(p0[r] + tabL[d0 + 128]); p1[r] = __builtin_amdgcn_exp2f(p1[r] + tabL[d1 + 128]); }
                }
            }
            float s = 0.f;
#pragma unroll
            for (int r = 0; r < 16; ++r) s += p0[r] + p1[r];
            l_reg += s;
            pw0 = (u32x4){cvtpk(p0[0], p0[1]), cvtpk(p0[2], p0[3]), cvtpk(p0[4], p0[5]), cvtpk(p0[6], p0[7])};
            pw1 = (u32x4){cvtpk(p0[8], p0[9]), cvtpk(p0[10], p0[11]), cvtpk(p0[12], p0[13]), cvtpk(p0[14], p0[15])};
            pw2 = (u32x4){cvtpk(p1[0], p1[1]), cvtpk(p1[2], p1[3]), cvtpk(p1[4], p1[5]), cvtpk(p1[6], p1[7])};
            pw3 = (u32x4){cvtpk(p1[8], p1[9]), cvtpk(p1[10], p1[11]), cvtpk(p1[12], p1[13]), cvtpk(p1[14], p1[15])};
            if (!lag) pv<ND>(o, vbl + v3 * VBY, __builtin_bit_cast(bf16x8, pw0), __builtin_bit_cast(bf16x8, pw1), __builtin_bit_cast(bf16x8, pw2), __builtin_bit_cast(bf16x8, pw3));
        }
        prev_act = active; v3p = v3; v3 = v3n;
    }
    if (lag && prev_act) pv<ND>(o, vbl + v3p * VBY, __builtin_bit_cast(bf16x8, pw0), __builtin_bit_cast(bf16x8, pw1), __builtin_bit_cast(bf16x8, pw2), __builtin_bit_cast(bf16x8, pw3));
#undef LAG_DMA
    asm volatile("s_waitcnt vmcnt(0) lgkmcnt(0)\n\ts_barrier" ::: "memory");
    float rl[16];
    l_reg += __shfl_xor(l_reg, 32);
    if (hi == 0) wsf[32 + r32] = l_reg;
    asm volatile("s_waitcnt lgkmcnt(0)" ::: "memory");
#pragma unroll
    for (int r = 0; r < 16; ++r) rl[r] = __builtin_amdgcn_rcpf(wsf[32 + crow(r, hi)]) * oscale;
    if constexpr (OUT8) {
        static_assert(!OUT8 || VD == 64, "fp8 output: 64-wide heads");
        unsigned char* Ow = (unsigned char*)Ob + (size_t)(q0 + wid * 32) * opitch;
        ALAS unsigned char* stg = (ALAS unsigned char*)(shm + L_OST) + wid * 2048;
#pragma unroll
        for (int r = 0; r < 16; ++r) { const int orow = crow(r, hi);
#pragma unroll
            for (int d0 = 0; d0 < 2; ++d0) { const float v = o[d0][r] * rl[r]; stg[orow * 64 + d0 * 32 + r32] = (unsigned char)(__builtin_amdgcn_cvt_pk_fp8_f32(v, v, 0, false) & 0xff); } }
        asm volatile("s_waitcnt lgkmcnt(0)" ::: "memory");
#pragma unroll
        for (int i = 0; i < 2; ++i) { const int row = i * 16 + (lane >> 2), ch = lane & 3; const u32x4 v = *(const ALAS u32x4*)(stg + row * 64 + ch * 16); *(u32x4*)(Ow + (size_t)row * opitch + ch * 16) = v; }
        asm volatile("s_waitcnt lgkmcnt(0)" ::: "memory");
    } else {
        bf16_t* Ow = (bf16_t*)Ob + (size_t)(q0 + wid * 32) * opitch;
        ALAS bf16_t* stg = (ALAS bf16_t*)(shm + L_OST) + wid * 2048;
#pragma unroll
        for (int half = 0; half < ND / 2; ++half) {
#pragma unroll
            for (int r = 0; r < 16; ++r) { const int orow = crow(r, hi);
#pragma unroll
                for (int d0 = 0; d0 < 2; ++d0) stg[orow * 64 + d0 * 32 + r32] = f2bf(o[half * 2 + d0][r] * rl[r]); }
            asm volatile("s_waitcnt lgkmcnt(0)" ::: "memory");
#pragma unroll
            for (int i = 0; i < 4; ++i) { const int row = i * 8 + (lane >> 3), ch = lane & 7; const u32x4 v = *(const ALAS u32x4*)(stg + row * 64 + ch * 8); *(u32x4*)(Ow + (size_t)row * opitch + half * 64 + ch * 8) = v; }
            asm volatile("s_waitcnt lgkmcnt(0)" ::: "memory");
        }
    }
    asm volatile("s_waitcnt lgkmcnt(0)\n\ts_barrier" ::: "memory");
}
__device__ __forceinline__ void qkt8(f32x16& p0, f32x16& p1, lds_cptr kb, const bf16x8* qr, const f32x16& cin) {
    bf16x8 kf[8];
#pragma unroll
    for (int d0 = 0; d0 < 4; ++d0) { kf[2 * d0] = *(const ALAS bf16x8*)(kb + d0 * 2048); kf[2 * d0 + 1] = *(const ALAS bf16x8*)(kb + d0 * 2048 + 512); }
    __builtin_amdgcn_sched_barrier(0);
    p0 = MFMA32(kf[0], qr[0], cin); p1 = MFMA32(kf[1], qr[0], cin);
#pragma unroll
    for (int d0 = 1; d0 < 4; ++d0) { p0 = MFMA32(kf[2 * d0], qr[d0], p0); p1 = MFMA32(kf[2 * d0 + 1], qr[d0], p1); }
}
template <int ND, int KS0> __device__ __forceinline__ void v_reads(s16x4 (&lo)[ND][2], s16x4 (&hi)[ND][2], int vb) {
#pragma unroll
    for (int ks = 0; ks < 2; ++ks)
#pragma unroll
        for (int d0 = 0; d0 < ND; ++d0) {
            asm volatile("ds_read_b64_tr_b16 %0,%1 offset:%c2" : "=&v"(lo[d0][ks]) : "v"(vb), "i"(d0 * 4096 + (KS0 + ks) * 1024) : "memory");
            asm volatile("ds_read_b64_tr_b16 %0,%1 offset:%c2" : "=&v"(hi[d0][ks]) : "v"(vb), "i"(d0 * 4096 + (KS0 + ks) * 1024 + 512) : "memory"); }
}
template <int ND> __device__ __forceinline__ void pv_half(f32x16* o, const s16x4 (&lo)[ND][2], const s16x4 (&hi)[ND][2], bf16x8 pa, bf16x8 pb) {
#define ATT_PK2(d, k) (bf16x8){lo[d][k][0], lo[d][k][1], lo[d][k][2], lo[d][k][3], hi[d][k][0], hi[d][k][1], hi[d][k][2], hi[d][k][3]}
#pragma unroll
    for (int d0 = 0; d0 < ND; ++d0) o[d0] = MFMA32(pa, ATT_PK2(d0, 0), o[d0]);
#pragma unroll
    for (int d0 = 0; d0 < ND; ++d0) o[d0] = MFMA32(pb, ATT_PK2(d0, 1), o[d0]);
#undef ATT_PK2
}
template <int MODE> __device__ __forceinline__ void p_half(f32x16& p, float& l_reg, u32x4& wa, u32x4& wb, bool const_bias, int dq, const ALAS float* tabL) {
    if (MODE == 0) {
#pragma unroll
        for (int r = 0; r < 16; ++r) p[r] = __builtin_amdgcn_exp2f(p[r]);
    } else if (const_bias) { const float cb = tabL[256];
#pragma unroll
        for (int r = 0; r < 16; ++r) p[r] = __builtin_amdgcn_exp2f(p[r] + cb);
    } else {
#pragma unroll
        for (int r = 0; r < 16; ++r) { int d = dq - ((r & 3) + 8 * (r >> 2)); d = d < -128 ? -128 : (d > 128 ? 128 : d); p[r] = __builtin_amdgcn_exp2f(p[r] + tabL[d + 128]); }
    }
    float s = 0.f;
#pragma unroll
    for (int r = 0; r < 16; ++r) s += p[r];
    l_reg += s;
    wa = (u32x4){cvtpk(p[0], p[1]), cvtpk(p[2], p[3]), cvtpk(p[4], p[5]), cvtpk(p[6], p[7])};
    wb = (u32x4){cvtpk(p[8], p[9]), cvtpk(p[10], p[11]), cvtpk(p[12], p[13]), cvtpk(p[14], p[15])};
}
__device__ __forceinline__ void vm_wait_n(int n) {
    if (n <= 0) asm volatile("s_waitcnt vmcnt(0)" ::: "memory"); else if (n == 1) asm volatile("s_waitcnt vmcnt(1)" ::: "memory"); else if (n == 2) asm volatile("s_waitcnt vmcnt(2)" ::: "memory");
    else if (n == 3) asm volatile("s_waitcnt vmcnt(3)" ::: "memory"); else if (n == 4) asm volatile("s_waitcnt vmcnt(4)" ::: "memory"); else if (n == 5) asm volatile("s_waitcnt vmcnt(5)" ::: "memory");
    else if (n == 6) asm volatile("s_waitcnt vmcnt(6)" ::: "memory"); else if (n == 7) asm volatile("s_waitcnt vmcnt(7)" ::: "memory"); else if (n == 8) asm volatile("s_waitcnt vmcnt(8)" ::: "memory");
    else if (n == 9) asm volatile("s_waitcnt vmcnt(9)" ::: "memory"); else if (n == 10) asm volatile("s_waitcnt vmcnt(10)" ::: "memory"); else asm volatile("s_waitcnt vmcnt(11)" ::: "memory");
}
template <int MODE, int VD, bool OUT8 = false, int PD = 3>
__device__ __forceinline__ void attn_unit_pp(ALAS char* shm, const bf16_t* Qb, const bf16_t* Kb, const bf16_t* Vb, void* Ob, int opitch, int q0, float mref2, const float* tab, float oscale = 1.f, int dbg = 0) {
    static_assert(MODE == 0 || MODE == 1, "ping-pong loop: softmax modes only");
    constexpr int ND = VD / 32, NV = VD / 64, NS = PD + 1, PER = 1 + NV, SLOT = 8192 + VD * 128;
    static_assert(NS * SLOT <= L_WS, "ring vs LDS map");
    const int tid = threadIdx.x, lane = tid & 63, r32 = lane & 31, hi = lane >> 5; const int wid = __builtin_amdgcn_readfirstlane(tid >> 6); const int grp = wid >> 2;
    const unsigned lds0 = (unsigned)(uintptr_t)shm;
    ALAS float* wsf = (ALAS float*)(shm + L_WS) + wid * 64;
    ALAS float* tabL = (ALAS float*)(shm + L_TAB);
    if (MODE == 1) { for (int i = tid; i < 257; i += 512) tabL[i] = tab[i] * pg8::LOG2E; }
    const bf16_t* Qw = Qb + (size_t)(q0 + wid * 32) * PITCH;
    bf16x8 qr[4];
#pragma unroll
    for (int d0 = 0; d0 < 4; ++d0) qr[d0] = *(const bf16x8*)(Qw + (size_t)r32 * PITCH + d0 * 16 + hi * 8);
    int t_first, n_t;
    if (MODE == 0) { t_first = 0; n_t = q0 / 64 + 4; }
    else { const int c0 = q0 / 64; t_first = c0 - 8 > 0 ? c0 - 8 : 0; n_t = c0 + 4 - t_first; }
    const bf16_t* ksrc = Kb + (size_t)lane * PITCH + wid * 8 + (size_t)t_first * 64 * PITCH;
    const bf16_t* vsrc = Vb + (size_t)(16 * (wid & 3) + (lane >> 2)) * PITCH + (wid >> 2) * 32 + (lane & 3) * 8 + (size_t)t_first * 64 * PITCH;
    const bf16_t* ksrc_c = Kb + (size_t)t_first * 64 * PITCH + wid * 512 + lane * 8;
    int issued = 0;
#define PP_DMA_K(i) do { if ((i) < n_t && !(dbg & 64)) { glds16(((dbg & 128) ? ksrc_c : ksrc) + (size_t)(i) * 64 * PITCH, (unsigned)__builtin_amdgcn_readfirstlane(lds0 + (unsigned)((i) % NS) * SLOT + wid * 1024)); issued += 1; } } while (0)
#define PP_DMA_V(i) do { if ((i) < n_t && !(dbg & 64)) { const unsigned sb_ = lds0 + (unsigned)((i) % NS) * SLOT + 8192; glds16(vsrc + (size_t)(i) * 64 * PITCH, (unsigned)__builtin_amdgcn_readfirstlane(sb_ + wid * 1024)); \
        if (VD == 128) glds16(vsrc + (size_t)(i) * 64 * PITCH + VNEXT, (unsigned)__builtin_amdgcn_readfirstlane(sb_ + (wid + 8) * 1024)); issued += NV; } } while (0)
#define PP_NEED_K(j) do { if (!(dbg & 256)) vm_wait_n(issued - ((j) * PER + 1)); } while (0)
#define PP_NEED_V(j) do { if (!(dbg & 256)) vm_wait_n(issued - ((j) + 1) * PER); } while (0)
#define PP_BAR() asm volatile("s_waitcnt lgkmcnt(0)\n\ts_barrier" ::: "memory")
    f32x16 o[ND];
#pragma unroll
    for (int d = 0; d < ND; ++d) o[d] = f32x16{};
    f32x16 cin;
#pragma unroll
    for (int r = 0; r < 16; ++r) cin[r] = -mref2;
    float l_reg = 0.f;
    const int wrow0 = q0 + wid * 32, qrow = wrow0 + r32, cw = wrow0 / 64;
    const int vb0 = (int)lds0 + 8192 + ((lane >> 4) & 1) * 32 + (lane & 3) * 8 + (4 * hi + ((lane & 15) >> 2)) * 64;
    asm volatile("s_waitcnt vmcnt(0)" ::: "memory"); asm volatile("" : "+v"(qr[0]), "+v"(qr[1]), "+v"(qr[2]), "+v"(qr[3]));
#pragma unroll
    for (int j = 0; j < PD; ++j) { PP_DMA_K(j); PP_DMA_V(j); }
    if (grp) PP_DMA_K(PD);
    PP_NEED_V(0);
    PP_BAR();
    if (grp) PP_BAR();
    u32x4 pw0, pw1, pw2, pw3; f32x16 p1;
    for (int i = 0; i < n_t; ++i) {
        const int t = t_first + i, slot = i % NS;
        bool active;
        if (MODE == 0) active = (t <= cw); else active = (t >= cw - 8) && (t <= cw);
        if (grp == 0) PP_DMA_K(i + PD); else PP_DMA_V(i + PD);
        if (active && !(dbg & 32)) {
            const lds_cptr kb = (lds_cptr)shm + slot * SLOT + hi * 1024 + r32 * 16;
            f32x16 p0; qkt8(p0, p1, kb, qr, cin);
            p_half<MODE>(p0, l_reg, pw0, pw1, (t <= cw - 3) || (dbg & 8), qrow - 64 * t - 4 * hi, tabL);
        }
        if (grp == 0) PP_NEED_V(i); else PP_NEED_K(i + 1);
        PP_BAR();
        if (grp == 0) PP_DMA_V(i + PD); else PP_DMA_K(i + 1 + PD);
        if (active && !(dbg & 16)) {
            const int vb = vb0 + slot * SLOT;
            s16x4 lo0[ND][2], hi0[ND][2], lo1[ND][2], hi1[ND][2];
            v_reads<ND, 0>(lo0, hi0, vb);
            asm volatile("s_waitcnt lgkmcnt(0)" ::: "memory");
            v_reads<ND, 2>(lo1, hi1, vb);
            __builtin_amdgcn_sched_barrier(0);
            pv_half<ND>(o, lo0, hi0, __builtin_bit_cast(bf16x8, pw0), __builtin_bit_cast(bf16x8, pw1));
            __builtin_amdgcn_sched_barrier(0);
            p_half<MODE>(p1, l_reg, pw2, pw3, (t <= cw - 3) || (dbg & 8), qrow - 64 * t - 4 * hi - 32, tabL);
            asm volatile("s_waitcnt lgkmcnt(0)" ::: "memory");
            __builtin_amdgcn_sched_barrier(0);
            pv_half<ND>(o, lo1, hi1, __builtin_bit_cast(bf16x8, pw2), __builtin_bit_cast(bf16x8, pw3));
        }
        if (grp == 0) PP_NEED_K(i + 1); else PP_NEED_V(i + 1);
        PP_BAR();
    }
    if (grp == 0) PP_BAR();
#undef PP_DMA_K
#undef PP_DMA_V
#undef PP_NEED_K
#undef PP_NEED_V
    float rl[16];
    l_reg += __shfl_xor(l_reg, 32);
    if (hi == 0) wsf[32 + r32] = l_reg;
    asm volatile("s_waitcnt lgkmcnt(0)" ::: "memory");
#pragma unroll
    for (int r = 0; r < 16; ++r) rl[r] = __builtin_amdgcn_rcpf(wsf[32 + crow(r, hi)]) * oscale;
    if constexpr (OUT8) {
        static_assert(!OUT8 || VD == 64, "fp8 output: 64-wide heads");
        unsigned char* Ow = (unsigned char*)Ob + (size_t)(q0 + wid * 32) * opitch;
        ALAS unsigned char* stg = (ALAS unsigned char*)(shm + L_OST) + wid * 2048;
#pragma unroll
        for (int r = 0; r < 16; ++r) { const int orow = crow(r, hi);
#pragma unroll
            for (int d0 = 0; d0 < 2; ++d0) { const float v = o[d0][r] * rl[r]; stg[orow * 64 + d0 * 32 + r32] = (unsigned char)(__builtin_amdgcn_cvt_pk_fp8_f32(v, v, 0, false) & 0xff); } }
        asm volatile("s_waitcnt lgkmcnt(0)" ::: "memory");
#pragma unroll
        for (int i = 0; i < 2; ++i) { const int row = i * 16 + (lane >> 2), ch = lane & 3; const u32x4 v = *(const ALAS u32x4*)(stg + row * 64 + ch * 16); *(u32x4*)(Ow + (size_t)row * opitch + ch * 16) = v; }
        asm volatile("s_waitcnt lgkmcnt(0)" ::: "memory");
    } else {
    bf16_t* Ow = (bf16_t*)Ob + (size_t)(q0 + wid * 32) * opitch;
    ALAS bf16_t* stg = (ALAS bf16_t*)(shm + L_OST) + wid * 2048;
#pragma unroll
    for (int half = 0; half < ND / 2; ++half) {
#pragma unroll
        for (int r = 0; r < 16; ++r) { const int orow = crow(r, hi);
#pragma unroll
            for (int d0 = 0; d0 < 2; ++d0) stg[orow * 64 + d0 * 32 + r32] = f2bf(o[half * 2 + d0][r] * rl[r]); }
        asm volatile("s_waitcnt lgkmcnt(0)" ::: "memory");
#pragma unroll
        for (int i = 0; i < 4; ++i) { const int row = i * 8 + (lane >> 3), ch = lane & 7; const u32x4 v = *(const ALAS u32x4*)(stg + row * 64 + ch * 8); *(u32x4*)(Ow + (size_t)row * opitch + half * 64 + ch * 8) = v; }
        asm volatile("s_waitcnt lgkmcnt(0)" ::: "memory");
    }
    }
    PP_BAR();
#undef PP_BAR
}
}

constexpr int NWAVES = 8, NTHR = NWAVES * 64;
constexpr int BATCH = 2, SEQ = 8192, T = BATCH * SEQ, D = 1024;
constexpr int NPROJ = 3072, FFD = 2816, FFE = 3584, NEXP = 8;
constexpr size_t MiB = 1u << 20;
constexpr size_t CTL_ZERO_BYTES = 1 * MiB;
constexpr int CW_TMO = 0, CW_BAR = 4096;
constexpr int CW_HIST = 16384;
constexpr int CW_QATT = 32768, CW_QCONV = 32768 + 64 * 8;
constexpr int CW_MOE = 24576;
constexpr size_t WS_SS0 = 1 * MiB, WS_SS3 = WS_SS0 + 65536, WS_ROPE = WS_SS3 + 65536  , WS_TOKSEL = WS_ROPE + MiB  ,
                 WS_TOKGATE = WS_TOKSEL + 65536  , WS_ROWTOK = WS_TOKGATE + 131072  , WS_ROWGATE = WS_ROWTOK + 147456  , WS_ROWSCALE = WS_ROWGATE + 147456  ;
static_assert(WS_ROWSCALE + 147456 <= 4 * MiB, "small arrays");
constexpr size_t WS_XB = 4 * MiB;
constexpr size_t WS_AO = 36 * MiB;
constexpr size_t WS_ACT0 = 68 * MiB;
constexpr size_t WS_XF = 164 * MiB;
constexpr size_t WS_WIN = 228 * MiB, WS_WO0 = 234 * MiB, WS_WGU0 = 236 * MiB, WS_WD0 = 247 * MiB, WS_WQKV = 253 * MiB, WS_WO1 = 259 * MiB;
constexpr size_t WS_WEGU = 264 * MiB;
constexpr size_t WS_WED = 376 * MiB;
constexpr size_t WS_SS1 = 432 * MiB, WS_SS2 = 433 * MiB;
constexpr size_t WS_END = 434 * MiB;
constexpr size_t WS_SORTA = 36 * MiB;
constexpr size_t WS_ACTE = 108 * MiB;
static_assert(WS_SORTA + (size_t)36864 * 2048 <= WS_ACTE && WS_ACTE + (size_t)18432 * 7168 <= WS_WO0 && WS_WD0 + (size_t)1024 * 2816 * 2 <= WS_WQKV && WS_WO1 + 2 * MiB <= WS_WEGU, "ws map");
constexpr int RING_BYTES = 131072, MISC_OFF = RING_BYTES + 320, ULIST_OFF = RING_BYTES + 1024  , RTAB_OFF = RING_BYTES + 2048  , LDS_BYTES = 155648;
static_assert(RTAB_OFF + 16 * 1024 <= LDS_BYTES, "LDS control area");
static_assert(att::L_END <= RING_BYTES, "attention LDS");

#define GAS __attribute__((address_space(1)))
#define LAS __attribute__((address_space(3)))
typedef unsigned short bf16;
typedef unsigned v4u __attribute__((ext_vector_type(4)));
typedef float f32x4 __attribute__((ext_vector_type(4)));
typedef GAS unsigned gu32;
#define RLX_AGENT __ATOMIC_RELAXED, __HIP_MEMORY_SCOPE_AGENT
#define LDS_WAIT() asm volatile("s_waitcnt lgkmcnt(0)" ::: "memory")
#define VM_WAIT() asm volatile("s_waitcnt vmcnt(0)" ::: "memory")
__device__ __forceinline__ unsigned f2bf(float f) { unsigned u = __builtin_bit_cast(unsigned, f); return (u + 0x7fffu + ((u >> 16) & 1u)) >> 16; }
__device__ __forceinline__ unsigned pk2(float lo, float hi) { return f2bf(lo) | (f2bf(hi) << 16); }
__device__ __forceinline__ float bf2f(unsigned short h) { return __builtin_bit_cast(float, (unsigned)h << 16); }
#define XB_TMO      128
#define XB_XCNT(j)  (256  + 64 * (j))
#define XB_XSUB(j)  (1280 + 64 * (j))
#define XB_XGEN(j)  (2304 + 64 * (j))
#define XB_TOP      3328
#define XB_TOPGEN   3392
#define XCD_BAR_WORDS 3456
#define XB_SPIN_CAP (1u << 18)

__device__ __forceinline__ unsigned xb_ld(unsigned* p)              { return __hip_atomic_load(p, __ATOMIC_RELAXED, __HIP_MEMORY_SCOPE_AGENT); }
__device__ __forceinline__ unsigned xb_add(unsigned* p, unsigned v) { return __hip_atomic_fetch_add(p, v, __ATOMIC_RELAXED, __HIP_MEMORY_SCOPE_AGENT); }
__device__ __forceinline__ unsigned xb_xcc_id() { return (unsigned)__builtin_amdgcn_s_getreg((3 << 11) | 20) & 0xFu; }
#define XB_SPIN(cond, bar) do { unsigned _sp = 0; while (cond) { __builtin_amdgcn_s_sleep(1); \
    if ((++_sp & 255u) == 0u) { if (xb_ld(&(bar)[XB_TMO])) break; if (_sp > XB_SPIN_CAP) { atomicAdd(&(bar)[XB_TMO], 1u); break; } } } } while (0)

struct XcdBarrier {
    unsigned* bar; unsigned x;
    volatile LAS unsigned* st;
};

__device__ __forceinline__ XcdBarrier xcd_barrier_post(unsigned* bar, volatile LAS unsigned* st) {
    XcdBarrier b; b.bar = bar; b.x = xb_xcc_id(); b.st = st;
    if (threadIdx.x == 0) (void)xb_add(&bar[XB_XCNT(b.x)], 1u);
    return b;
}
__device__ __forceinline__ void xcd_barrier_complete(unsigned* bar, unsigned x, unsigned& nloc, unsigned& nx) {
    const unsigned G = gridDim.x * gridDim.y * gridDim.z;
    unsigned sum, cnt, mine, sp = 0u;
    for (;;) {
        sum = 0u; cnt = 0u; mine = 0u;
#pragma unroll
        for (unsigned j = 0; j < 16; ++j) { const unsigned c = xb_ld(&bar[XB_XCNT(j)]); sum += c; cnt += (c > 0u) ? 1u : 0u; mine = (j == x) ? c : mine; }
        if (sum == G) break;
        __builtin_amdgcn_s_sleep(1);
        if ((++sp & 255u) == 0u) { if (xb_ld(&bar[XB_TMO])) break; if (sp > XB_SPIN_CAP) { atomicAdd(&bar[XB_TMO], 1u); break; } }
    }
    nloc = mine > 0u ? mine : 1u; nx = cnt > 0u ? cnt : 1u;
}

__device__ __forceinline__ void xcd_barrier(const XcdBarrier& b) {
    asm volatile("s_waitcnt vmcnt(0)" ::: "memory");
    __syncthreads();
    if (threadIdx.x == 0) {
        unsigned* bar = b.bar;
        __builtin_amdgcn_s_waitcnt(0);
        unsigned nloc = b.st[0], nx = b.st[1];
        if (nloc == 0u) { xcd_barrier_complete(bar, b.x, nloc, nx); b.st[0] = nloc; b.st[1] = nx; }
        const unsigned old = xb_add(&bar[XB_XSUB(b.x)], 1u);
        const unsigned gen = old / nloc;
        if (old + 1u == (gen + 1u) * nloc) {
            __builtin_amdgcn_fence(__ATOMIC_RELEASE, "agent");
            asm volatile("s_waitcnt vmcnt(0)" ::: "memory");
            const unsigned og = xb_add(&bar[XB_TOP], 1u);
            const unsigned tg = og / nx;
            if (og + 1u == (tg + 1u) * nx) xb_add(&bar[XB_TOPGEN], 1u);
            else XB_SPIN(xb_ld(&bar[XB_TOPGEN]) == tg, bar);
            __builtin_amdgcn_fence(__ATOMIC_ACQUIRE, "agent");
            xb_add(&bar[XB_XGEN(b.x)], 1u);
            asm volatile("s_waitcnt vmcnt(0)" ::: "memory");
        } else {
            XB_SPIN(xb_ld(&bar[XB_XGEN(b.x)]) == gen, bar);
            __builtin_amdgcn_fence(__ATOMIC_ACQUIRE, "agent");
            asm volatile("s_waitcnt vmcnt(0)" ::: "memory");
        }
    }
    __syncthreads();
}

__device__ __forceinline__ float wave_sum(float v) {
#pragma unroll
    for (int o = 1; o < 64; o <<= 1) v += __shfl_xor(v, o);
    return v;
}
__device__ __forceinline__ float wave_max(float v) {
#pragma unroll
    for (int o = 1; o < 64; o <<= 1) v = fmaxf(v, __shfl_xor(v, o));
    return v;
}
__device__ __forceinline__ int dest_block(int blk, int map) {
    if (map == 1) { const int s = blk & 7; return (blk & ~7) + 4 * (s & 1) + (s >> 1); }
    if (map == 2) return (blk >> 2) * 8 + (blk & 3);
    if (map == 3) return (blk >> 2) * 8 + 4 + (blk & 3);
    return blk;
}
__device__ __forceinline__ void tr_tile(const float* W, int K, int N, bf16* WT, int map, const float* gain, LAS unsigned* scr, int item, int lane) {
    const int nblk = N / 64, kb = item / nblk, nb = item % nblk, k0 = 64 * kb, n0 = 64 * nb;
    const int c = lane & 15, ip = lane >> 4;
#pragma unroll
    for (int it = 0; it < 8; ++it) { const int kp = it * 4 + ip, k = k0 + 2 * kp;
        f32x4 a = *(const GAS f32x4*)(W + (size_t)k * N + n0 + 4 * c), b = *(const GAS f32x4*)(W + (size_t)(k + 1) * N + n0 + 4 * c);
        if (gain) { a = a * gain[k]; b = b * gain[k + 1]; }
#pragma unroll
        for (int j = 0; j < 4; ++j) scr[(4 * c + j) * 33 + kp] = pk2(a[j], b[j]); }
    LDS_WAIT(); asm volatile("" ::: "memory");
#pragma unroll
    for (int it = 0; it < 8; ++it) { const int n = it * 8 + (lane >> 3), q = lane & 7;
        v4u o; o.x = scr[n * 33 + 4 * q]; o.y = scr[n * 33 + 4 * q + 1]; o.z = scr[n * 33 + 4 * q + 2]; o.w = scr[n * 33 + 4 * q + 3];
        const int drow = dest_block((n0 + n) >> 5, map) * 32 + (n & 31);
        *(GAS v4u*)(WT + (size_t)drow * K + k0 + 8 * q) = o; }
    LDS_WAIT(); asm volatile("" ::: "memory");
}

__device__ __forceinline__ void tr_tile8(const float* W, int K, int N, unsigned char* WT, int map, const float* gain, float wscale, LAS unsigned* scr, int item, int lane) {
    const int nblk = N / 64, kb = item / nblk, nb = item % nblk, k0 = 64 * kb, n0 = 64 * nb;
    const int c = lane & 15, ip = lane >> 4;
#pragma unroll
    for (int it = 0; it < 4; ++it) { const int k4 = it * 4 + ip, k = k0 + 4 * k4; f32x4 a[4];
#pragma unroll
        for (int i = 0; i < 4; ++i) a[i] = *(const GAS f32x4*)(W + (size_t)(k + i) * N + n0 + 4 * c) * ((gain ? gain[k + i] : 1.f) * wscale);
#pragma unroll
        for (int j = 0; j < 4; ++j) scr[(4 * c + j) * 17 + k4] = pg8::pk4_fp8(a[0][j], a[1][j], a[2][j], a[3][j]); }
    LDS_WAIT(); asm volatile("" ::: "memory");
#pragma unroll
    for (int it = 0; it < 4; ++it) { const int n = it * 16 + (lane >> 2), q = lane & 3;
        v4u o; o.x = scr[n * 17 + 4 * q]; o.y = scr[n * 17 + 4 * q + 1]; o.z = scr[n * 17 + 4 * q + 2]; o.w = scr[n * 17 + 4 * q + 3];
        const int drow = dest_block((n0 + n) >> 5, map) * 32 + (n & 31);
        *(GAS v4u*)(WT + (size_t)drow * K + k0 + 16 * q) = o; }
    LDS_WAIT(); asm volatile("" ::: "memory");
}

struct TrItem { const float* W; unsigned char* WT; const float* gain; int K, N, map, fp8, k0, n0; float scale; };
__device__ __forceinline__ void tr_load(const TrItem& d, f32x4 (&a)[16], float (&g)[16], int lane) {
    const int c = lane & 15, ip = lane >> 4;
#pragma unroll
    for (int it = 0; it < 4; ++it)
#pragma unroll
        for (int i = 0; i < 4; ++i) { const int k = d.k0 + 4 * (it * 4 + ip) + i;
            a[it * 4 + i] = __builtin_nontemporal_load((const GAS f32x4*)(d.W + (size_t)k * d.N + d.n0 + 4 * c)); g[it * 4 + i] = d.gain ? d.gain[k] : 1.f; }
}
__device__ __forceinline__ void tr_emit(const TrItem& d, const f32x4 (&a)[16], const float (&g)[16], LAS unsigned* scr, int lane) {
    const int c = lane & 15, ip = lane >> 4;
    if (d.fp8) {
#pragma unroll
        for (int it = 0; it < 4; ++it) { const int k4 = it * 4 + ip;
#pragma unroll
            for (int j = 0; j < 4; ++j) scr[(4 * c + j) * 17 + k4] = pg8::pk4_fp8(a[it * 4][j] * (g[it * 4] * d.scale), a[it * 4 + 1][j] * (g[it * 4 + 1] * d.scale), a[it * 4 + 2][j] * (g[it * 4 + 2] * d.scale), a[it * 4 + 3][j] * (g[it * 4 + 3] * d.scale)); }
        LDS_WAIT(); asm volatile("" ::: "memory");
#pragma unroll
        for (int it = 0; it < 4; ++it) { const int n = it * 16 + (lane >> 2), q = lane & 3;
            v4u o; o.x = scr[n * 17 + 4 * q]; o.y = scr[n * 17 + 4 * q + 1]; o.z = scr[n * 17 + 4 * q + 2]; o.w = scr[n * 17 + 4 * q + 3];
            const int drow = dest_block((d.n0 + n) >> 5, d.map) * 32 + (n & 31);
            __builtin_nontemporal_store(o, (GAS v4u*)(d.WT + (size_t)drow * d.K + d.k0 + 16 * q)); }
    } else {
#pragma unroll
        for (int it = 0; it < 4; ++it) { const int k4 = it * 4 + ip;
#pragma unroll
            for (int j = 0; j < 4; ++j) { scr[(4 * c + j) * 33 + 2 * k4] = pk2(a[it * 4][j] * g[it * 4], a[it * 4 + 1][j] * g[it * 4 + 1]); scr[(4 * c + j) * 33 + 2 * k4 + 1] = pk2(a[it * 4 + 2][j] * g[it * 4 + 2], a[it * 4 + 3][j] * g[it * 4 + 3]); } }
        LDS_WAIT(); asm volatile("" ::: "memory");
#pragma unroll
        for (int it = 0; it < 8; ++it) { const int n = it * 8 + (lane >> 3), q = lane & 7;
            v4u o; o.x = scr[n * 33 + 4 * q]; o.y = scr[n * 33 + 4 * q + 1]; o.z = scr[n * 33 + 4 * q + 2]; o.w = scr[n * 33 + 4 * q + 3];
            const int drow = dest_block((d.n0 + n) >> 5, d.map) * 32 + (n & 31);
            __builtin_nontemporal_store(o, (GAS v4u*)(d.WT + ((size_t)drow * d.K + d.k0 + 8 * q) * 2)); }
    }
    LDS_WAIT(); asm volatile("" ::: "memory");
}
constexpr float AO8_SCALE = 16.f;
constexpr float W8_SCALE = 64.f;

#ifndef PROBE_MASK
#define PROBE_MASK 0
#endif
struct KArgs { const void* in[27]; float* out; unsigned char* ws; int ph_lo, ph_hi, flags, pad; };

struct KArgs;
__device__ __forceinline__ const void* karg_in(const KArgs& a, int k) { asm volatile("" : "+s"(k)); return a.in[k]; }
__global__ void __launch_bounds__(NTHR, 2) fwd_kernel(KArgs args) {
    extern __shared__ __attribute__((aligned(16))) unsigned char lds_raw[];
    LAS unsigned char* lds = (LAS unsigned char*)lds_raw;
    volatile LAS unsigned* MISC = (volatile LAS unsigned*)(lds + MISC_OFF);
    const int tid = threadIdx.x, lane = tid & 63, wave = __builtin_amdgcn_readfirstlane(tid >> 6);
    const int G = gridDim.x; const int bx = blockIdx.x; const int vcu = (G % 8 == 0) ? (bx % 8) * (G / 8) + bx / 8 : bx;
    unsigned char* ws = args.ws;
    unsigned* ctl = (unsigned*)ws;
    for (int u = tid; u < (LDS_BYTES - RING_BYTES) / 4; u += NTHR) ((LAS unsigned*)(lds + RING_BYTES))[u] = 0u;
    __syncthreads();
    XcdBarrier bar = xcd_barrier_post(ctl + CW_BAR, MISC + 8);
    const int lo = args.ph_lo, hi_ph = args.ph_hi;
#define IN(k) (lo <= (k) && (k) < hi_ph)
#define REP(k)
#define SEAM(k) do { if (IN(k) && IN((k) + 1)) xcd_barrier(bar); } while (0)
#define KIN(T, k) ((const T*)karg_in(args, (k)))
#define x_in KIN(float, 0)
#define positions KIN(int, 1)
#define ev_attn_norm KIN(float, 2)
#define ev_w_in KIN(float, 3)
#define ev_q_norm KIN(float, 4)
#define ev_k_norm KIN(float, 5)
#define ev_lq1 KIN(float, 6)
#define ev_lk1 KIN(float, 7)
#define ev_lq2 KIN(float, 8)
#define ev_lk2 KIN(float, 9)
#define ev_subln KIN(float, 10)
#define ev_w_out KIN(float, 11)
#define ev_ffn_norm KIN(float, 12)
#define ev_w_gate KIN(float, 13)
#define ev_w_up KIN(float, 14)
#define ev_w_down KIN(float, 15)
#define od_attn_norm KIN(float, 16)
#define od_w_qkv KIN(float, 17)
#define od_q_norm KIN(float, 18)
#define od_k_norm KIN(float, 19)
#define od_rel_bias KIN(float, 20)
#define od_w_out KIN(float, 21)
#define od_ffn_norm KIN(float, 22)
#define od_router KIN(float, 23)
#define od_we_gate KIN(float, 24)
#define od_we_up KIN(float, 25)
#define od_we_down KIN(float, 26)
    float* out = args.out;
    float* ss0 = (float*)(ws + WS_SS0); float* ss1 = (float*)(ws + WS_SS1); float* ss2 = (float*)(ws + WS_SS2); float* ss3 = (float*)(ws + WS_SS3);
    float* rope = (float*)(ws + WS_ROPE); unsigned* toksel = (unsigned*)(ws + WS_TOKSEL); float* tokgate = (float*)(ws + WS_TOKGATE);
    int* rowtok = (int*)(ws + WS_ROWTOK); float* rowgate = (float*)(ws + WS_ROWGATE); float* rowscale = (float*)(ws + WS_ROWSCALE);
    bf16* XB = (bf16*)(ws + WS_XB); bf16* AO = (bf16*)(ws + WS_AO); bf16* ACT0 = (bf16*)(ws + WS_ACT0); float* XF = (float*)(ws + WS_XF); bf16* OD = (bf16*)(ws + WS_XF);
    bf16* Win_t = (bf16*)(ws + WS_WIN); bf16* Wo0_t = (bf16*)(ws + WS_WO0); bf16* Wgu0_t = (bf16*)(ws + WS_WGU0); bf16* Wd0_t = (bf16*)(ws + WS_WD0);
    unsigned char* Wqkv8 = ws + WS_WQKV; unsigned char* Wo18 = ws + WS_WO1; unsigned char* XB8 = ws + WS_XB; unsigned char* AO8 = ws + WS_AO; unsigned char* WEgu8 = ws + WS_WEGU; unsigned char* WEd8 = ws + WS_WED;
    unsigned char* SORTA8 = ws + WS_SORTA; unsigned char* ACTE8 = ws + WS_ACTE;
    const int gw = vcu * NWAVES + wave, NGW = G * NWAVES;

    constexpr int I_IN = 16 * 48, I_O = 16 * 16, I_G = 16 * 44, I_D = 44 * 16, I_EG = 16 * 56, I_ED = 56 * 16;
    constexpr int NSMALL = I_IN + I_O + 2 * I_G + I_D + I_IN + I_O, NITEMS = NSMALL + 24 * I_EG;
        auto decode = [&](int it) -> TrItem {
        TrItem d; int r = it; d.scale = 1.f; d.fp8 = 0; d.gain = nullptr; d.map = 0;
        auto fin = [&](int nbl) { d.k0 = 64 * (r / nbl); d.n0 = 64 * (r % nbl); };
        if (r < I_IN) { d.W = ev_w_in; d.K = D; d.N = NPROJ; d.WT = (unsigned char*)Win_t; d.map = 1; d.gain = ev_attn_norm; fin(NPROJ / 64); return d; } r -= I_IN;
        if (r < I_O) { d.W = ev_w_out; d.K = D; d.N = D; d.WT = (unsigned char*)Wo0_t; fin(D / 64); return d; } r -= I_O;
        if (r < I_G) { d.W = ev_w_gate; d.K = D; d.N = FFD; d.WT = (unsigned char*)Wgu0_t; d.map = 2; d.gain = ev_ffn_norm; fin(FFD / 64); return d; } r -= I_G;
        if (r < I_G) { d.W = ev_w_up; d.K = D; d.N = FFD; d.WT = (unsigned char*)Wgu0_t; d.map = 3; d.gain = ev_ffn_norm; fin(FFD / 64); return d; } r -= I_G;
        if (r < I_D) { d.W = ev_w_down; d.K = FFD; d.N = D; d.WT = (unsigned char*)Wd0_t; fin(D / 64); return d; } r -= I_D;
        d.fp8 = 1; d.scale = W8_SCALE;
        if (r < I_IN) { d.W = od_w_qkv; d.K = D; d.N = NPROJ; d.WT = Wqkv8; d.map = 1; d.gain = od_attn_norm; fin(NPROJ / 64); return d; } r -= I_IN;
        if (r < I_O) { d.W = od_w_out; d.K = D; d.N = D; d.WT = Wo18; fin(D / 64); return d; } r -= I_O;
        const int which = r / (8 * I_EG), rr = r % (8 * I_EG), e2 = rr / I_EG; r = rr % I_EG;
        if (which == 0) { d.W = od_we_gate + (size_t)e2 * D * FFE; d.K = D; d.N = FFE; d.WT = WEgu8 + (size_t)e2 * 2 * FFE * D; d.map = 2; d.gain = od_ffn_norm; fin(FFE / 64); }
        else if (which == 1) { d.W = od_we_up + (size_t)e2 * D * FFE; d.K = D; d.N = FFE; d.WT = WEgu8 + (size_t)e2 * 2 * FFE * D; d.map = 3; d.gain = od_ffn_norm; fin(FFE / 64); }
        else { d.W = od_we_down + (size_t)e2 * FFE * D; d.K = FFE; d.N = D; d.WT = WEd8 + (size_t)e2 * D * FFE; fin(D / 64); }
        return d; };
    auto conv_range = [&](int first, int end, int stride) {
        LAS unsigned* scr = (LAS unsigned*)(lds + wave * 8704);
        f32x4 bufA[16], bufB[16]; float gA[16], gB[16]; TrItem dA, dB; int it = first;
        if (it < end) { dA = decode(it); tr_load(dA, bufA, gA, lane); }
        while (it < end) {
            const int it2 = it + stride, it3 = it2 + stride;
            if (it2 < end) { dB = decode(it2); tr_load(dB, bufB, gB, lane); }
            tr_emit(dA, bufA, gA, scr, lane);
            if (it3 < end) { dA = decode(it3); tr_load(dA, bufA, gA, lane); }
            if (it2 < end) tr_emit(dB, bufB, gB, scr, lane);
            it = it3; } };
    auto pull = [&](int qword) -> int {
        __syncthreads(); if (tid == 0) MISC[16] = __hip_atomic_fetch_add(ctl + qword, 1u, __ATOMIC_RELAXED, __HIP_MEMORY_SCOPE_AGENT); __syncthreads();
        return __builtin_amdgcn_readfirstlane((int)MISC[16]); };

    REP(0) if (IN(0)) {
        conv_range(gw, I_IN, NGW);
        for (int m0 = gw; m0 < T; m0 += 2 * NGW) {
            f32x4 v[2][4];
#pragma unroll
            for (int u = 0; u < 2; ++u) { const int m = m0 + u * NGW; if (m < T) { const GAS f32x4* xr = (const GAS f32x4*)(x_in + (size_t)m * D) + lane;
#pragma unroll
                for (int j = 0; j < 4; ++j) v[u][j] = __builtin_nontemporal_load(xr + 64 * j); } }
#pragma unroll
            for (int u = 0; u < 2; ++u) { const int m = m0 + u * NGW; if (m >= T) break; float s = 0.f;
#pragma unroll
                for (int j = 0; j < 4; ++j) s += (v[u][j].x * v[u][j].x + v[u][j].y * v[u][j].y) + (v[u][j].z * v[u][j].z + v[u][j].w * v[u][j].w);
                s = wave_sum(s); if (lane == 0) ss0[m] = s;
                GAS unsigned long long* o8 = (GAS unsigned long long*)(XB + (size_t)m * D) + lane;
#pragma unroll
                for (int j = 0; j < 4; ++j) o8[64 * j] = (unsigned long long)pk2(v[u][j].x, v[u][j].y) | ((unsigned long long)pk2(v[u][j].z, v[u][j].w) << 32); }
        }
        for (int i = vcu * NTHR + tid; i < T * 8; i += G * NTHR) {
            const int tok = i >> 3, f = i & 7;
            const double inv = (f == 0) ? 1.0 : (f == 1) ? 0.19392274474868576 : (f == 2) ? 0.03760603093086393 : (f == 3) ? 0.007292664737217109 : (f == 4) ? 0.001414213562373095 : (f == 5) ? 0.0002742481756762073 : (f == 6) ? 5.318295896944988e-05 : 1.031338537721246e-05;
            double ang = (double)positions[tok] * inv; ang -= 6.283185307179586 * rint(ang * 0.15915494309189535);
            float sn, cs; sincosf((float)ang, &sn, &cs);
            rope[(size_t)tok * 16 + f] = cs; rope[(size_t)tok * 16 + 8 + f] = sn;
        }
    }
    SEAM(0);

    LAS int* ulist = (LAS int*)(lds + ULIST_OFF);
    LAS float* rtab = (LAS float*)(lds + RTAB_OFF);
    const auto no_rows = [](const pg8::Unit&, int) { return 0.f; };
#define RUN_GEMM(EPI, ALIGN, F8, g, S, E, RT, ROWFN) do { pg8::build_unit_list((S), ulist, (RT), (ROWFN)); const pg8::ListOrder LO_{ulist}; pg8::gemm_phase<EPI, pg8::ListOrder, ALIGN, true, F8>(lds, (g), LO_, (E)); } while (0)
    REP(1) if (IN(1)) {
        pg8::Gemm g{XB, Win_t, T, NPROJ, D}; pg8::StaticOrder S; S.init(T, NPROJ, G, bx);
        pg8::EpiProj E{ACT0, T, ss0, 1, ev_q_norm, ev_k_norm, rope, 0, 1.f, rtab};
        const float* ssp = ss0; const auto rowfn = [ssp](const pg8::Unit& u, int lr) { return rsqrtf(ssp[u.pm * 256 + lr] * (1.f / 1024.f) + pg8::RMS_EPS); };
        RUN_GEMM(pg8::EpiProj, true, false, g, S, E, rtab, rowfn);
    }
    SEAM(1);

    REP(2) if (IN(2)) {
        const float gqm = wave_max(fabsf(ev_q_norm[lane])), gkm = wave_max(fabsf(ev_k_norm[lane]));
        const float mref = 8.f * gqm * gkm * pg8::LOG2E;
        constexpr int NJOBS = (NITEMS - I_IN + 63) / 64;
        const bool conv_first = ((bx >> 3) & 3) == 3;
#define P2_CONV_LOOP() for (;;) { const int j = pull(CW_QCONV); if (j >= NJOBS) break; \
            const int first = I_IN + j * 64 + wave * 8; conv_range(first, (first + 8 < NITEMS) ? first + 8 : NITEMS, 1); }
        if (conv_first) P2_CONV_LOOP()
#pragma unroll 1
        for (int kq = 0; kq < 8; ++kq) { const int xq = (bx + kq) & 7;
            for (;;) { const int idx = pull(CW_QATT + 64 * xq); if (idx >= 128) break;
                if (idx < 64) { if (args.flags & 1) continue;
                    const int bhm = 2 * xq + (idx & 1), qb = 31 - (idx >> 1);
                    const int b = bhm >> 3, hm = bhm & 7, h = hm >> 1;
                    const bf16* base = ACT0 + (size_t)b * SEQ * 64;
                    att::attn_unit_lag<0, 128>((LAS char*)lds, base + (size_t)(24 + hm) * T * 64, base + (size_t)(32 + hm) * T * 64, base + (size_t)(40 + 2 * h) * T * 64, OD + (size_t)b * SEQ * D + hm * 128, D, qb * 256, mref, nullptr);
                } else { if (args.flags & 2) continue;
                    const int bh = 2 * xq + (idx & 1), qb = 31 - ((idx - 64) >> 1);
                    const int b = bh >> 3, h = bh & 7;
                    const bf16* base = ACT0 + (size_t)b * SEQ * 64;
                    att::attn_unit<2, 64>((LAS char*)lds, base + (size_t)h * T * 64, base + (size_t)(8 + h) * T * 64, base + (size_t)(16 + h) * T * 64, AO + (size_t)b * SEQ * D + h * 64, D, qb * 256, 0.f, nullptr);
                }
            }
        }
        P2_CONV_LOOP()
#undef P2_CONV_LOOP
    }
    SEAM(2);

    REP(3) if (IN(3)) {
        const float a1 = wave_sum(ev_lq1[lane] * ev_lk1[lane]), a2 = wave_sum(ev_lq2[lane] * ev_lk2[lane]);
        const float lam_init = 0.2f, lam = expf(a1) - expf(a2) + lam_init;
        const int h = lane >> 4, v0 = (lane & 15) * 8;
        float sg[8];
#pragma unroll
        for (int j = 0; j < 8; ++j) sg[j] = ev_subln[v0 + j] * (1.f - lam_init);
        for (int m0 = gw; m0 < T; m0 += 4 * NGW) {
            v4u a4[4], b4[4];
#pragma unroll
            for (int u = 0; u < 4; ++u) { const int m = m0 + u * NGW; if (m < T) { a4[u] = *(const GAS v4u*)(OD + (size_t)m * D + (2 * h) * 128 + v0); b4[u] = *(const GAS v4u*)(OD + (size_t)m * D + (2 * h + 1) * 128 + v0); } }
#pragma unroll
            for (int u = 0; u < 4; ++u) { const int m = m0 + u * NGW; if (m >= T) break;
                const v4u a = a4[u], b = b4[u]; float d[8]; float s = 0.f;
#pragma unroll
                for (int j = 0; j < 4; ++j) { const unsigned ua = a[j], ub = b[j];
                    d[2 * j] = bf2f((unsigned short)(ua & 0xffffu)) - lam * bf2f((unsigned short)(ub & 0xffffu));
                    d[2 * j + 1] = bf2f((unsigned short)(ua >> 16)) - lam * bf2f((unsigned short)(ub >> 16));
                    s += d[2 * j] * d[2 * j] + d[2 * j + 1] * d[2 * j + 1]; }
                s += __shfl_xor(s, 1); s += __shfl_xor(s, 2); s += __shfl_xor(s, 4); s += __shfl_xor(s, 8);
                const float rs = rsqrtf(s * (1.f / 128.f) + pg8::RMS_EPS);
                v4u o; o.x = pk2(d[0] * rs * sg[0], d[1] * rs * sg[1]); o.y = pk2(d[2] * rs * sg[2], d[3] * rs * sg[3]); o.z = pk2(d[4] * rs * sg[4], d[5] * rs * sg[5]); o.w = pk2(d[6] * rs * sg[6], d[7] * rs * sg[7]);
                *(GAS v4u*)(AO + (size_t)m * D + 512 + h * 128 + v0) = o; }
        }
    }
    SEAM(3);

    REP(4) if (IN(4)) {
        pg8::Gemm g{AO, Wo0_t, T, D, D}; pg8::StaticOrder S; S.init(T, D, G, bx);
        pg8::EpiResid E{x_in, XF, XB, ss1, 1.f, nullptr};
        RUN_GEMM(pg8::EpiResid, false, false, g, S, E, (LAS float*)nullptr, no_rows);
    }
    SEAM(4);

    REP(5) if (IN(5)) {
        pg8::Gemm g{XB, Wgu0_t, T, 2 * FFD, D}; pg8::StaticOrder S; S.init(T, 2 * FFD, G, bx, (args.flags >> 9) & 1);
        pg8::EpiSwiglu<false> E{ACT0, FFD, ss1, 16, nullptr, 0, 2 * FFD / 256, 1.f, rtab};
        const float* ssp = ss1; const auto rowfn = [ssp](const pg8::Unit& u, int lr) { return rsqrtf(pg8::row_ss(ssp, 16, u.pm * 256 + lr) * (1.f / 1024.f) + pg8::RMS_EPS); };
        RUN_GEMM(pg8::EpiSwiglu<false>, true, false, g, S, E, rtab, rowfn);
    }
    SEAM(5);

    if (IN(6)) {
        pg8::Gemm g{ACT0, Wd0_t, T, D, FFD}; pg8::StaticOrder S; S.init(T, D, G, bx);
        pg8::EpiResid E{XF, XF, nullptr, ss2, 1.f, XB8};
        RUN_GEMM(pg8::EpiResid, false, false, g, S, E, (LAS float*)nullptr, no_rows);
    }
    SEAM(6);

    REP(7) if (IN(7)) {
        pg8::Gemm g{(const bf16*)XB8, (const bf16*)Wqkv8, T, NPROJ, D / 2}; pg8::StaticOrder S; S.init(T, NPROJ, G, bx);
        pg8::EpiProj E{ACT0, T, ss2, 16, od_q_norm, od_k_norm, nullptr, 1, 1.f / W8_SCALE, rtab};
        const float* ssp = ss2; const auto rowfn = [ssp](const pg8::Unit& u, int lr) { return rsqrtf(pg8::row_ss(ssp, 16, u.pm * 256 + lr) * (1.f / 1024.f) + pg8::RMS_EPS); };
        RUN_GEMM(pg8::EpiProj, true, true, g, S, E, rtab, rowfn);
    }
    SEAM(7);

    REP(8) if (IN(8)) {
        const float gqm = wave_max(fabsf(od_q_norm[lane])), gkm = wave_max(fabsf(od_k_norm[lane]));
        for (int L = vcu; L < 1024; L += G) {
            const int bh = (L & 255) >> 3, qb = 4 * (L & 7) + (L >> 8);
            const int b = bh >> 4, h = bh & 15;
            const float* tab = od_rel_bias + h * 257;
            float tm = fabsf(tab[lane]); tm = fmaxf(tm, fabsf(tab[64 + lane])); tm = fmaxf(tm, fabsf(tab[128 + lane])); tm = fmaxf(tm, fabsf(tab[192 + lane])); tm = fmaxf(tm, fabsf(tab[256]));
            tm = wave_max(tm);
            const float mref = (8.f * gqm * gkm + tm) * pg8::LOG2E;
            const bf16* base = ACT0 + (size_t)b * SEQ * 64;
            att::attn_unit_lag<1, 64, true>((LAS char*)lds, base + (size_t)h * T * 64, base + (size_t)(16 + h) * T * 64, base + (size_t)(32 + h) * T * 64, AO8 + (size_t)b * SEQ * D + h * 64, D, qb * 256, mref, tab, AO8_SCALE);
        }
    }
    SEAM(8);

    REP(9) if (IN(9)) {
        pg8::Gemm g{(const bf16*)AO8, (const bf16*)Wo18, T, D, D / 2}; pg8::StaticOrder S; S.init(T, D, G, bx);
        pg8::EpiResid E{XF, out, nullptr, nullptr, 1.f / (W8_SCALE * AO8_SCALE), XB8};
        RUN_GEMM(pg8::EpiResid, false, true, g, S, E, (LAS float*)nullptr, no_rows);
    }
    SEAM(9);

    REP(10) if (IN(10)) {
        LAS float* wrT = (LAS float*)lds;
        LAS unsigned* sel = (LAS unsigned*)(lds + 32768);
        for (int i = tid; i < 1024; i += NTHR) { const float gn = od_ffn_norm[i]; const f32x4 w0 = *(const GAS f32x4*)(od_router + (size_t)i * 8), w1 = *(const GAS f32x4*)(od_router + (size_t)i * 8 + 4);
            wrT[i] = w0.x * gn; wrT[1024 + i] = w0.y * gn; wrT[2048 + i] = w0.z * gn; wrT[3072 + i] = w0.w * gn; wrT[4096 + i] = w1.x * gn; wrT[5120 + i] = w1.y * gn; wrT[6144 + i] = w1.z * gn; wrT[7168 + i] = w1.w * gn; }
        __syncthreads();
        for (int blk = vcu; blk < T / 64; blk += G) {
#pragma unroll 1
            for (int q4 = 0; q4 < 2; ++q4) {
                const int tk = lane >> 4, sub = lane & 15; const int tok = blk * 64 + wave * 8 + q4 * 4 + tk;
                const GAS f32x4* xr = (const GAS f32x4*)(out + (size_t)tok * D) + sub; float s = 0.f; float lg[8];
#pragma unroll
                for (int e2 = 0; e2 < 8; ++e2) lg[e2] = 0.f;
#pragma unroll
                for (int jh = 0; jh < 2; ++jh) { f32x4 xv[8];
#pragma unroll
                    for (int j = 0; j < 8; ++j) xv[j] = xr[16 * (8 * jh + j)];
#pragma unroll
                    for (int j = 0; j < 8; ++j) { const f32x4 v = xv[j]; s += (v.x * v.x + v.y * v.y) + (v.z * v.z + v.w * v.w);
#pragma unroll
                        for (int e2 = 0; e2 < 8; ++e2) { const f32x4 w = *(const LAS f32x4*)(wrT + e2 * 1024 + 64 * (8 * jh + j) + 4 * sub); lg[e2] += (v.x * w.x + v.y * w.y) + (v.z * w.z + v.w * w.w); } } }
#pragma unroll
                for (int o = 1; o < 16; o <<= 1) { s += __shfl_xor(s, o);
#pragma unroll
                    for (int e2 = 0; e2 < 8; ++e2) lg[e2] += __shfl_xor(lg[e2], o); }
                if (sub == 0) {
                    const float r = rsqrtf(s * (1.f / 1024.f) + pg8::RMS_EPS); ss3[tok] = s;
                    int e0 = 0; float v0 = lg[0];
#pragma unroll
                    for (int e2 = 1; e2 < 8; ++e2) if (lg[e2] > v0) { v0 = lg[e2]; e0 = e2; }
                    int e1 = -1; float v1 = 0.f;
#pragma unroll
                    for (int e2 = 0; e2 < 8; ++e2) if (e2 != e0 && (e1 < 0 || lg[e2] > v1)) { v1 = lg[e2]; e1 = e2; }
                    const float ex = expf((v1 - v0) * r), g0 = 1.f / (1.f + ex), g1 = ex / (1.f + ex);
                    sel[wave * 8 + q4 * 4 + tk] = (unsigned)e0 | ((unsigned)e1 << 8); tokgate[2 * tok] = g0; tokgate[2 * tok + 1] = g1;
                }
            }
            __syncthreads();
            if (wave == 0) { const unsigned sv = sel[lane]; const int e0 = sv & 0xff, e1 = sv >> 8; unsigned rank0 = 0, rank1 = 0;
                const unsigned long long lt = (1ull << lane) - 1ull;
#pragma unroll
                for (int e = 0; e < 8; ++e) { const unsigned long long m0 = __ballot(e0 == e), m1 = __ballot(e1 == e);
                    if (e0 == e) rank0 = __popcll(m0 & lt); if (e1 == e) rank1 = __popcll(m1 & lt);
                    if (lane == 0) { ctl[CW_HIST + blk * 16 + e] = __popcll(m0); ctl[CW_HIST + blk * 16 + 8 + e] = __popcll(m1); } }
                toksel[blk * 64 + lane] = sv | (rank0 << 16) | (rank1 << 24); }
            __syncthreads();
        }
    }
    SEAM(10);

    REP(11) if (IN(11)) {
        LAS unsigned* hs = (LAS unsigned*)lds;
        for (int i = tid; i < 4096; i += NTHR) hs[i] = ctl[CW_HIST + i];
        __syncthreads();
        if (tid < 16) hs[4096 + tid] = 0u;
        __syncthreads();
        { unsigned s = 0; const int g2 = tid & 15;
#pragma unroll
          for (int b2 = tid >> 4; b2 < 256; b2 += 32) s += hs[b2 * 16 + g2];
          atomicAdd((unsigned*)&hs[4096 + g2], s); }
        __syncthreads();
        if (tid == 0) { unsigned acc = 0; for (int g2 = 0; g2 < 16; ++g2) { hs[4128 + g2] = acc; acc += (hs[4096 + g2] + 255u) & ~255u; } hs[4128 + 16] = acc; }
        __syncthreads();
        if (bx == 0) {
            if (tid == 0) { const int nA = (int)(hs[4128 + 8] >> 8), nT = (int)(hs[4128 + 16] >> 8), nC1 = (nT - nA + 1) / 2, nC2 = nT - nA - nC1;
                ctl[CW_MOE] = nA; ctl[CW_MOE + 1] = nT;
                for (int ph = 0; ph < 2; ++ph) { const int nd = (ph == 0 ? nA : nC1) * (D / 256), nu = (ph == 0 ? nC1 : nC2) * (2 * FFE / 256);
                    int H = nd > G ? nd - G : (nd < G ? nd : 0); int mode = 1, R = 0; if (H >= G) H = 0;
                    pg8::MoeOrder::plan(nu, H, G, D / 128, FFE / 128, mode, R);
                    ctl[CW_MOE + 2 + 3 * ph] = H; ctl[CW_MOE + 3 + 3 * ph] = R; ctl[CW_MOE + 4 + 3 * ph] = mode; } }
            if (tid < 16) { const unsigned t0 = hs[4128 + tid] >> 8, t1 = hs[4128 + tid + 1] >> 8; for (unsigned t = t0; t < t1; ++t) ctl[CW_MOE + 16 + t] = tid & 7; }
        }
        for (int blk = vcu; blk < T / 64; blk += G) {
            if (tid < 16) hs[4160 + tid] = 0u;
            __syncthreads();
            { unsigned s = 0; const int g2 = tid & 15;
#pragma unroll
              for (int b2 = tid >> 4; b2 < 256; b2 += 32) s += (b2 < blk) ? hs[b2 * 16 + g2] : 0u;
              atomicAdd((unsigned*)&hs[4160 + g2], s); }
            __syncthreads();
            for (int tl = wave; tl < 64; tl += NWAVES) {
                const int tok = blk * 64 + tl; const unsigned sv = toksel[tok];
                const v4u pk = *(const GAS v4u*)(XB8 + (size_t)tok * D + 16 * lane);
#pragma unroll
                for (int sl = 0; sl < 2; ++sl) { const int e = (sv >> (8 * sl)) & 0xff, rank = (sv >> (16 + 8 * sl)) & 0xff, g2 = sl * 8 + e;
                    const unsigned srow = hs[4128 + g2] + hs[4160 + g2] + rank;
                    *(GAS v4u*)(SORTA8 + (size_t)srow * D + lane * 16) = pk;
                    if (lane == 0) { rowtok[srow] = tok; rowgate[srow] = tokgate[2 * tok + sl]; rowscale[srow] = rsqrtf(ss3[tok] * (1.f / 1024.f) + pg8::RMS_EPS); } }
            }
            __syncthreads();
        }
        for (int g2 = vcu; g2 < 16; g2 += G) {
            const unsigned r0 = hs[4128 + g2] + hs[4096 + g2], r1 = hs[4128 + g2 + 1];
            for (unsigned r = r0 + wave; r < r1; r += NWAVES) { if (lane == 0) { rowtok[r] = -1; rowgate[r] = 0.f; rowscale[r] = 0.f; }
                *(GAS v4u*)(SORTA8 + (size_t)r * D + lane * 16) = (v4u){0u, 0u, 0u, 0u}; }
        }
    }
    SEAM(11);

    if (IN(12) || IN(13) || IN(14) || IN(15)) {
        const int nA = (int)__builtin_amdgcn_readfirstlane(ctl[CW_MOE]), nT = (int)__builtin_amdgcn_readfirstlane(ctl[CW_MOE + 1]);
        const int nC1 = (nT - nA + 1) / 2, nC2 = nT - nA - nC1;
        const int* texp = (const int*)(ctl + CW_MOE + 16);
        unsigned char* const ACT_C0 = ACTE8; unsigned char* const ACT_C1 = ACTE8 + (size_t)63 * MiB; unsigned char* const ACT_C2 = ACT_C1 + (size_t)36 * 256 * FFE;
        constexpr int NPN_GU = 2 * FFE / 256, NPN_D = D / 256;
#define MOE_GU(TILE0, NTILE, ACTBUF, PLAN) do { int H_ = 0, R_ = 0, mode_ = 1; \
        if ((PLAN) >= 0) { H_ = (int)__builtin_amdgcn_readfirstlane(ctl[CW_MOE + 2 + 3 * (PLAN)]); R_ = (int)__builtin_amdgcn_readfirstlane(ctl[CW_MOE + 3 + 3 * (PLAN)]); mode_ = (int)__builtin_amdgcn_readfirstlane(ctl[CW_MOE + 4 + 3 * (PLAN)]); } \
        pg8::Gemm g{(const bf16*)(SORTA8 + (size_t)(TILE0) * 256 * D), (const bf16*)WEgu8, 0, 0, D / 2}; pg8::MoeOrder S; S.init((NTILE), NPN_GU, G, bx, (TILE0), texp, H_, R_, mode_); \
        pg8::EpiSwiglu<true> E{(ACTBUF), FFE, nullptr, 1, rowscale, (TILE0), NPN_GU, 1.f / W8_SCALE, rtab}; \
        const float* rsp_ = rowscale + (size_t)(TILE0) * 256; const auto rowfn_ = [rsp_](const pg8::Unit& u, int lr) { return rsp_[u.pm * 256 + lr]; }; \
        RUN_GEMM(pg8::EpiSwiglu<true>, true, true, g, S, E, rtab, rowfn_); } while (0)
#define MOE_DOWN(TILE0, NTILE, ACTBUF) do { pg8::Gemm g{(const bf16*)(ACTBUF), (const bf16*)WEd8, 0, 0, FFE / 2}; pg8::MoeOrder S; S.init((NTILE), NPN_D, G, bx, (TILE0), texp); \
        pg8::EpiMoeDown E{out, rowtok, rowgate, (TILE0), 1.f / W8_SCALE, (args.flags >> 2) & 1}; \
        RUN_GEMM(pg8::EpiMoeDown, true, true, g, S, E, (LAS float*)nullptr, no_rows); } while (0)
        if (IN(12)) MOE_GU(0, nA, ACT_C0, -1);
        SEAM(12);
        if (IN(13)) { MOE_DOWN(0, nA, ACT_C0); MOE_GU(nA, nC1, ACT_C1, 0); }
        SEAM(13);
        if (IN(14)) { MOE_DOWN(nA, nC1, ACT_C1); if (nC2 > 0) MOE_GU(nA + nC1, nC2, ACT_C2, 1); }
        SEAM(14);
        if (IN(15)) { if (nC2 > 0) MOE_DOWN(nA + nC1, nC2, ACT_C2); }
#undef MOE_GU
#undef MOE_DOWN
    }
#undef IN
#undef SEAM
#undef RUN_GEMM
#undef x_in
#undef positions
#undef ev_attn_norm
#undef ev_w_in
#undef ev_q_norm
#undef ev_k_norm
#undef ev_lq1
#undef ev_lk1
#undef ev_lq2
#undef ev_lk2
#undef ev_subln
#undef ev_w_out
#undef ev_ffn_norm
#undef ev_w_gate
#undef ev_w_up
#undef ev_w_down
#undef od_attn_norm
#undef od_w_qkv
#undef od_q_norm
#undef od_k_norm
#undef od_rel_bias
#undef od_w_out
#undef od_ffn_norm
#undef od_router
#undef od_we_gate
#undef od_we_up
#undef od_we_down
#undef KIN
}

constexpr int N_PHASES = 16;
extern "C" void kernel_launch(void* const* d_in, const int* in_sizes, int n_in, void* d_out, int out_size, void* d_ws, size_t ws_size, hipStream_t stream) {
    static int grid = 0;
    if (grid == 0) {
        if (n_in != 27 || out_size != T * D || ws_size < WS_END) { fprintf(stderr, "kernel_launch: unexpected problem (n_in %d, out %d, ws %zu)\n", n_in, out_size, ws_size); grid = -1; return; }
        int dev = 0, cus = 0, per_cu = 0;
        if (hipGetDevice(&dev) != hipSuccess || hipDeviceGetAttribute(&cus, hipDeviceAttributeMultiprocessorCount, dev) != hipSuccess) { grid = -1; return; }
        if (hipFuncSetAttribute((const void*)fwd_kernel, hipFuncAttributeMaxDynamicSharedMemorySize, LDS_BYTES) != hipSuccess) { fprintf(stderr, "kernel_launch: hipFuncSetAttribute failed\n"); grid = -1; return; }
        if (hipOccupancyMaxActiveBlocksPerMultiprocessor(&per_cu, (const void*)fwd_kernel, NTHR, LDS_BYTES) != hipSuccess || per_cu < 1) { fprintf(stderr, "kernel_launch: occupancy query says %d\n", per_cu); }
        (void)hipGetLastError();
        grid = cus;
    }
    if (grid < 0) return;
    (void)hipMemsetAsync(d_ws, 0, CTL_ZERO_BYTES, stream);
    KArgs a{};
    for (int i = 0; i < 27; ++i) a.in[i] = d_in[i];
    a.out = (float*)d_out; a.ws = (unsigned char*)d_ws; a.ph_lo = 0; a.ph_hi = N_PHASES;
    hipLaunchKernelGGL(fwd_kernel, dim3(grid), dim3(NTHR), LDS_BYTES, stream, a);
#if defined(PROBE_LO)
    (void)hipMemsetAsync((char*)d_ws + CW_BAR * 4, 0, XCD_BAR_WORDS * 4, stream); (void)hipMemsetAsync((char*)d_ws + CW_QATT * 4, 0, 4096, stream);
    a.ph_lo = PROBE_LO; a.ph_hi = PROBE_HI;
#if defined(PROBE_FLAGS)
    a.flags = PROBE_FLAGS;
#endif
    hipLaunchKernelGGL(fwd_kernel, dim3(grid), dim3(NTHR), LDS_BYTES, stream, a);
#endif
}
```

```cpp
#include <hip/hip_runtime.h>
#include <cstdio>
#include <cstdint>
#include <cmath>
#define PROBE_MASK 0x0
namespace pg8 {
#define PG8_LAS __attribute__((address_space(3)))
typedef unsigned short bf16_t;
typedef short bf16x8 __attribute__((ext_vector_type(8)));
typedef float f32x4 __attribute__((ext_vector_type(4)));
typedef unsigned u32x4 __attribute__((ext_vector_type(4)));
constexpr int BM = 256, BK = 64, HALF = 128, HTB = HALF * BK * 2  , STAGE_BYTES = 8 * HTB, NXCD = 8, WGM = 4;

__host__ __device__ __forceinline__ int lds_byte(int r, int c) { const int st = (r >> 4) * 2 + (c >> 5), rr = r & 15, cc = c & 31, ob = rr * 64 + cc * 2; return st * 1024 + (ob ^ (((ob >> 9) & 1) << 5)); }
__host__ __device__ __forceinline__ void stage_rc(int b, int& R, int& C) { const int st = b / 1024, sb = b % 1024, swz = sb ^ (((sb >> 9) & 1) << 5); R = (st >> 1) * 16 + swz / 64; C = (st & 1) * 32 + (swz % 64) / 2; }
__host__ __device__ __forceinline__ int perm32(int rho) { const int n = rho >> 4, i = rho & 15; return 8 * (i >> 2) + 4 * n + (i & 3); }

struct Unit { int pm, pn, aux; };
struct Gemm { const bf16_t* A; const bf16_t* Bt; int M, N, K; };

struct StaticOrder {
    int nM, nN, nwg, G, c, hot;
    __host__ __device__ void init(int M, int N, int G_, int c_, int hot_ = 0) { nM = M / BM; nN = N / BM; nwg = nM * nN; G = G_; c = c_; hot = hot_; }
    __host__ __device__ bool next(int i, Unit& u) const {
        const long L = (long)i * G + c; if (L >= nwg) return false;
        int wgid = (int)L; { const int q = nwg / NXCD, r = nwg % NXCD, xcd = wgid % NXCD, off = wgid / NXCD; wgid = (xcd < r ? xcd * (q + 1) : r * (q + 1) + (xcd - r) * q) + off; }
        const int nig = WGM * nN, gid = wgid / nig, fm = gid * WGM, gsz = (nM - fm) < WGM ? (nM - fm) : WGM;
        u.pm = fm + ((wgid % nig) % gsz); u.pn = (wgid % nig) / gsz; if (hot) { u.pm &= 3; u.pn = 0; } return true;
    }
    __device__ __forceinline__ void a_ready(const Unit&) const {}
    __device__ __forceinline__ void done(const Unit&) const {}
};

struct MoeOrder {
    int nM, nN, nwg, G, c, tile0; const int* tile_expert;
    int H, R, mode;
    __device__ void init(int ntiles, int npn, int G_, int c_, int tile0_, const int* te, int H_ = 0, int R_ = 0, int mode_ = 1) { nM = ntiles; nN = npn; nwg = nM * nN; G = G_; c = c_; tile0 = tile0_; tile_expert = te; H = H_; R = R_; mode = mode_; }
    __device__ static __forceinline__ void plan(int nu, int H, int G, int ucost, int extra, int& mode, int& R) {
        mode = 1; R = 0; if (H <= 0 || H >= G) return;
        const int rmax = (nu + (G - H) - 1) / (G - H); int best = 0x7fffffff;
        for (int r2 = 0; r2 <= rmax; ++r2) { const int rest = nu - r2 * (G - H) > 0 ? nu - r2 * (G - H) : 0;
            { const int light = ucost * r2, heavy = extra + ucost * ((rest + H - 1) / H); const int mk = light > heavy ? light : heavy; if (mk < best) { best = mk; mode = 1; R = r2; } }
            { const int sh = (rest + G - 1) / G; const int light = ucost * (r2 + sh), heavy = extra + ucost * sh; const int mk = light > heavy ? light : heavy; if (mk < best) { best = mk; mode = 2; R = r2; } } }
    }
    __device__ bool next(int i, Unit& u) const {
        long L;
        if (H == 0) L = (long)i * G + c;
        else if (c >= H) { if (i < R) L = (long)i * (G - H) + (c - H); else if (mode == 2) L = (long)R * (G - H) + (long)(i - R) * G + c; else return false; }
        else L = (long)R * (G - H) + (long)i * (mode == 2 ? G : H) + c;
        if (L >= nwg) return false;
        int wgid = (int)L; { const int q = nwg / NXCD, r = nwg % NXCD, xcd = wgid % NXCD, off = wgid / NXCD; wgid = (xcd < r ? xcd * (q + 1) : r * (q + 1) + (xcd - r) * q) + off; }
        const int nig = WGM * nN, gid = wgid / nig, fm = gid * WGM, gsz = (nM - fm) < WGM ? (nM - fm) : WGM;
        u.pm = fm + ((wgid % nig) % gsz); const int pnl = (wgid % nig) / gsz;
        const int e = tile_expert[tile0 + u.pm];
        u.pn = e * nN + pnl; return true;
    }
    __device__ __forceinline__ void a_ready(const Unit&) const {}
    __device__ __forceinline__ void done(const Unit&) const {}
};

constexpr int MAX_UNITS = 64, RT_UNITS = 16;
template <class Sched, class RowFn> __device__ __forceinline__ void build_unit_list(const Sched& S, PG8_LAS int* list, PG8_LAS float* rtab, const RowFn& rowfn) {
    const int t = threadIdx.x;
    if (t < MAX_UNITS) { Unit u; u.pm = 0; u.pn = 0; u.aux = t; const bool ok = S.next(t, u); list[2 * t] = ok ? u.pm : -1; list[2 * t + 1] = u.pn; }
    __syncthreads();
    if (rtab) {
#pragma unroll 1
        for (int i = t >> 8; i < RT_UNITS; i += 2) { Unit u; u.pm = list[2 * i]; u.pn = list[2 * i + 1]; u.aux = i; if (u.pm < 0) break; rtab[i * 256 + (t & 255)] = rowfn(u, t & 255); }
        __syncthreads();
    }
}
struct ListOrder {
    const PG8_LAS int* list;
    __device__ __forceinline__ bool next(int i, Unit& u) const {
        if (i >= MAX_UNITS) return false;
        const int pm = __builtin_amdgcn_readfirstlane(list[2 * i]); if (pm < 0) return false;
        u.pm = pm; u.pn = __builtin_amdgcn_readfirstlane(list[2 * i + 1]); u.aux = i; return true; }
    __device__ __forceinline__ void a_ready(const Unit&) const {}
    __device__ __forceinline__ void done(const Unit&) const {}
};

__device__ __forceinline__ unsigned cvt_pk_bf16(float lo, float hi) { unsigned r; asm volatile("v_cvt_pk_bf16_f32 %0, %1, %2" : "=v"(r) : "v"(lo), "v"(hi)); return r; }
__device__ __forceinline__ u32x4 pack8(const f32x4& a, const f32x4& b) { u32x4 w; w.x = cvt_pk_bf16(a[0], a[1]); w.y = cvt_pk_bf16(a[2], a[3]); w.z = cvt_pk_bf16(b[0], b[1]); w.w = cvt_pk_bf16(b[2], b[3]); return w; }
__device__ __forceinline__ unsigned pk4_fp8(float a, float b, float c, float d) { int w = __builtin_amdgcn_cvt_pk_fp8_f32(a, b, 0, false); w = __builtin_amdgcn_cvt_pk_fp8_f32(c, d, w, true); return (unsigned)w; }
constexpr float RMS_EPS = 1e-6f;
constexpr float LOG2E = 1.4426950408889634f;
constexpr float C2 = 0.125f * LOG2E;
__device__ __forceinline__ float row_ss(const float* ss, int nparts, int row) {
    if (nparts == 1) return ss[row];
    const f32x4* p = (const f32x4*)(ss + (size_t)row * 16); f32x4 a = p[0], b = p[1], c = p[2], d = p[3]; a = (a + b) + (c + d); return (a[0] + a[1]) + (a[2] + a[3]);
}

struct EpiProj {
    static constexpr bool PERM = true, AFTER_DRAIN = false;
    bf16_t* O; int ldc; const float* ss; int nparts; const float* gq; const float* gk; const float* rope; int layer; float pre; const PG8_LAS float* rtab; unsigned char* vt8;
    __device__ __forceinline__ void operator()(const f32x4 (&acc)[2][2][4][2], const Unit& u, int wr, int wc, int fr, int fq) const {
        const int pn = u.pn; int kind = 0; float scale = 1.f; bool rope_on = false;
        if (layer == 0) { const int t = pn >> 1; if (t == 0) scale = C2; else if (t == 3) { kind = 1; scale = C2; rope_on = true; } else if (t == 4) { kind = 2; rope_on = true; } }
        else { const int t = pn >> 2; if (t == 0) { kind = 1; scale = C2; } else if (t == 1) kind = 2; }
        const float* gv = (kind == 1) ? gq : gk;
        f32x4 g[2][2];
#pragma unroll
        for (int bj = 0; bj < 2; ++bj)
#pragma unroll
            for (int n = 0; n < 2; ++n) g[bj][n] = kind ? *(const f32x4*)(gv + 32 * bj + 8 * fq + 4 * n) : (f32x4){1.f, 1.f, 1.f, 1.f};
        const int row0 = u.pm * BM + wr * 64 + fr, col0 = pn * BM + wc * 64 + 8 * fq;
#pragma unroll
        for (int ai = 0; ai < 2; ++ai)
#pragma unroll
            for (int m = 0; m < 4; ++m) {
                const int row = row0 + ai * HALF + m * 16;
                const float r = (u.aux < RT_UNITS) ? rtab[u.aux * 256 + wr * 64 + fr + ai * HALF + m * 16] * pre : rsqrtf(row_ss(ss, nparts, row) * (1.f / 1024.f) + RMS_EPS) * pre;
                f32x4 v[2][2]; float s = 0.f;
#pragma unroll
                for (int bj = 0; bj < 2; ++bj)
#pragma unroll
                    for (int n = 0; n < 2; ++n) { v[bj][n] = acc[ai][bj][m][n] * r; const f32x4 x = v[bj][n]; s += (x[0] * x[0] + x[1] * x[1]) + (x[2] * x[2] + x[3] * x[3]); }
                if (kind) {
                    s += __shfl_xor(s, 16); s += __shfl_xor(s, 32);
                    const float rs = rsqrtf(s * (1.f / 64.f) + RMS_EPS);
#pragma unroll
                    for (int bj = 0; bj < 2; ++bj)
#pragma unroll
                        for (int n = 0; n < 2; ++n) v[bj][n] = v[bj][n] * rs * g[bj][n];
                    if (rope_on) {
                        f32x4 p[2];
#pragma unroll
                        for (int n = 0; n < 2; ++n)
#pragma unroll
                            for (int j = 0; j < 4; ++j) p[n][j] = __shfl_xor(v[0][n][j], 16);
                        const f32x4 c0 = *(const f32x4*)(rope + (size_t)row * 16), c1 = *(const f32x4*)(rope + (size_t)row * 16 + 4);
                        const f32x4 s0 = *(const f32x4*)(rope + (size_t)row * 16 + 8), s1 = *(const f32x4*)(rope + (size_t)row * 16 + 12);
                        if (fq == 0) { v[0][0] = v[0][0] * c0 - p[0] * s0; v[0][1] = v[0][1] * c1 - p[1] * s1; }
                        else if (fq == 1) { v[0][0] = v[0][0] * c0 + p[0] * s0; v[0][1] = v[0][1] * c1 + p[1] * s1; }
                    }
                }
                if (vt8 && layer == 0 && (pn >> 1) == 5) {
                    const int kv = row & 63, ptok = (row & ~63) + 32 * ((kv >> 2) & 1) + (kv & 3) + 4 * ((kv >> 3) & 3) + 16 * (kv >> 5);
                    unsigned char* vp = vt8 + (size_t)((pn * 4 + wc - 40) * 64 + 8 * fq) * ldc + ptok;
#pragma unroll
                    for (int bj = 0; bj < 2; ++bj)
#pragma unroll
                        for (int n = 0; n < 2; ++n)
#pragma unroll
                            for (int j = 0; j < 4; ++j) { const float x = v[bj][n][j]; vp[(size_t)(32 * bj + 4 * n + j) * ldc] = (unsigned char)(__builtin_amdgcn_cvt_pk_fp8_f32(x, x, 0, false) & 0xff); }
                    continue;
                }
                bf16_t* rowp = O + ((size_t)(pn * 4 + wc) * ldc + row) * 64 + 8 * fq;
#pragma unroll
                for (int bj = 0; bj < 2; ++bj) *(u32x4*)(rowp + 32 * bj) = pack8(v[bj][0] * scale, v[bj][1] * scale);
            }
    }
};

struct EpiResid {
    static constexpr bool PERM = true, AFTER_DRAIN = false;
    const float* base; float* out; bf16_t* xb; float* ss; float pre; unsigned char* x8;
    __device__ __forceinline__ void operator()(const f32x4 (&acc)[2][2][4][2], const Unit& u, int wr, int wc, int fr, int fq) const {
        const int row0 = u.pm * BM + wr * 64 + fr, col0 = u.pn * BM + wc * 32 + 8 * fq;
#pragma unroll
        for (int rp = 0; rp < 4; ++rp) {
            const int ai = rp >> 1; f32x4 bv[2][2][2];
#pragma unroll
            for (int mm = 0; mm < 2; ++mm)
#pragma unroll
                for (int bj = 0; bj < 2; ++bj) { const size_t off = (size_t)(row0 + ai * HALF + ((rp & 1) * 2 + mm) * 16) * 1024 + col0 + bj * HALF; bv[mm][bj][0] = *(const f32x4*)(base + off); bv[mm][bj][1] = *(const f32x4*)(base + off + 4); }
#pragma unroll
            for (int mm = 0; mm < 2; ++mm) { const int m = (rp & 1) * 2 + mm;
                const int row = row0 + ai * HALF + m * 16; float s = 0.f;
#pragma unroll
                for (int bj = 0; bj < 2; ++bj) {
                    const size_t off = (size_t)row * 1024 + col0 + bj * HALF;
                    const f32x4 v0 = acc[ai][bj][m][0] * pre + bv[mm][bj][0], v1 = acc[ai][bj][m][1] * pre + bv[mm][bj][1];
                    *(f32x4*)(out + off) = v0; *(f32x4*)(out + off + 4) = v1;
                    if (xb) *(u32x4*)(xb + off) = pack8(v0, v1);
                    if (x8) { typedef unsigned u32x2 __attribute__((ext_vector_type(2))); u32x2 w8; w8.x = pk4_fp8(v0[0], v0[1], v0[2], v0[3]); w8.y = pk4_fp8(v1[0], v1[1], v1[2], v1[3]); *(u32x2*)(x8 + off) = w8; }
                    s += (v0[0] * v0[0] + v0[1] * v0[1]) + (v0[2] * v0[2] + v0[3] * v0[3]) + (v1[0] * v1[0] + v1[1] * v1[1]) + (v1[2] * v1[2] + v1[3] * v1[3]);
                }
                if (ss) { s += __shfl_xor(s, 16); s += __shfl_xor(s, 32); if (fq == 0) ss[(size_t)row * 16 + u.pn * 4 + wc] = s; }
            }
        }
    }
};

template <bool OUT8> struct EpiSwiglu {
    static constexpr bool PERM = true, AFTER_DRAIN = false;
    void* O; int ldc; const float* ss; int nparts; const float* rowscale; int tile0; int npn; float pre; const PG8_LAS float* rtab;
    __device__ __forceinline__ void operator()(const f32x4 (&acc)[2][2][4][2], const Unit& u, int wr, int wc, int fr, int fq) const {
        const int pnl = u.pn % npn; const int row0 = u.pm * BM + wr * 64 + fr, col0 = pnl * HALF + wc * 32 + 8 * fq;
#pragma unroll
        for (int ai = 0; ai < 2; ++ai)
#pragma unroll
            for (int m = 0; m < 4; ++m) {
                const int row = row0 + ai * HALF + m * 16;
                const float r = (u.aux < RT_UNITS) ? rtab[u.aux * 256 + wr * 64 + fr + ai * HALF + m * 16] * pre : (rowscale ? rowscale[tile0 * BM + row] * pre : rsqrtf(row_ss(ss, nparts, row) * (1.f / 1024.f) + RMS_EPS) * pre);
                f32x4 a[2]; const float rl = -r * LOG2E, ir2 = __builtin_amdgcn_rcpf(r * r);
#pragma unroll
                for (int n = 0; n < 2; ++n) { const f32x4 gq = acc[ai][0][m][n], t = gq * rl; f32x4 d;
#pragma unroll
                    for (int j = 0; j < 4; ++j) d[j] = __builtin_amdgcn_rcpf(__builtin_fmaf(__builtin_amdgcn_exp2f(t[j]), ir2, ir2));
                    a[n] = (gq * acc[ai][1][m][n]) * d; }
                if constexpr (OUT8) { typedef unsigned u32x2 __attribute__((ext_vector_type(2))); u32x2 w; w.x = pk4_fp8(a[0][0], a[0][1], a[0][2], a[0][3]); w.y = pk4_fp8(a[1][0], a[1][1], a[1][2], a[1][3]); *(u32x2*)((unsigned char*)O + (size_t)row * ldc + col0) = w; }
                else *(u32x4*)((bf16_t*)O + (size_t)row * ldc + col0) = pack8(a[0], a[1]);
            }
    }
};

struct EpiMoeDown {
    static constexpr bool PERM = true, AFTER_DRAIN = false;
    float* out; const int* rowtok; const float* rowgate; int tile0; float pre; int nostore;
    __device__ __forceinline__ void operator()(const f32x4 (&acc)[2][2][4][2], const Unit& u, int wr, int wc, int fr, int fq) const {
        const int pnl = u.pn & 3; const int row0 = (tile0 + u.pm) * BM + wr * 64 + fr, col0 = pnl * BM + wc * 32 + 8 * fq;
        int tk[2][4]; float gt[2][4];
#pragma unroll
        for (int ai = 0; ai < 2; ++ai)
#pragma unroll
            for (int m = 0; m < 4; ++m) { const int srow = row0 + ai * HALF + m * 16; tk[ai][m] = nostore ? -1 : rowtok[srow]; gt[ai][m] = rowgate[srow] * pre; }
#pragma unroll
        for (int rp = 0; rp < 4; ++rp) { const int ai = rp >> 1; f32x4 ov[2][2][2];
#pragma unroll
            for (int mm = 0; mm < 2; ++mm) { const int m = (rp & 1) * 2 + mm; const int tc = tk[ai][m] > 0 ? tk[ai][m] : 0;
#pragma unroll
                for (int bj = 0; bj < 2; ++bj)
#pragma unroll
                    for (int n = 0; n < 2; ++n) ov[mm][bj][n] = *(const f32x4*)(out + (size_t)tc * 1024 + col0 + bj * HALF + 4 * n); }
#pragma unroll
            for (int mm = 0; mm < 2; ++mm) { const int m = (rp & 1) * 2 + mm;
                if (tk[ai][m] >= 0) {
#pragma unroll
                    for (int bj = 0; bj < 2; ++bj)
#pragma unroll
                        for (int n = 0; n < 2; ++n) *(f32x4*)(out + (size_t)tk[ai][m] * 1024 + col0 + bj * HALF + 4 * n) = ov[mm][bj][n] + acc[ai][bj][m][n] * gt[ai][m]; } }
        }
    }
};

typedef int i32x4 __attribute__((ext_vector_type(4)));
typedef int i32x8 __attribute__((ext_vector_type(8)));
template <class Epi, class Sched, bool ALIGN_EPI = false, bool SP2 = false, bool F8 = false>
__device__ __forceinline__ void gemm_phase(PG8_LAS unsigned char* lds, const Gemm g, const Sched& S, const Epi& E) {
    const int tid = threadIdx.x, wid = __builtin_amdgcn_readfirstlane(tid >> 6), lane = tid & 63, wr = wid >> 2, wc = wid & 3, fr = lane & 15, fq = lane >> 4;
    const int K = g.K, nt = K / BK;
    unsigned voffA[2], voffB[2];
#pragma unroll
    for (int i = 0; i < 2; ++i) { int R, C; stage_rc(tid * 16 + i * 8192, R, C); const int Rb = Epi::PERM ? ((R & ~31) + perm32(R & 31)) : R;
        voffA[i] = (unsigned)(R * K + C) * 2u; voffB[i] = (unsigned)(Rb * K + C) * 2u; }
    const size_t kstep = (size_t)(BK * 2);
    const size_t hstep = (size_t)HALF * K * 2;
    const size_t tstep = 2 * hstep;
    const unsigned ldsw = (unsigned)wid * 1024u;
    const int aoff = lds_byte(wr * 64 + fr, fq * 8), boff = lds_byte(wc * 32 + fr, fq * 8);
#define PG8_SA(b, h) (((b) * 2 + (h)) * HTB)
#define PG8_SB(b, h) ((4 + (b) * 2 + (h)) * HTB)
#define PG8_STAGE(bufoff, gbase, voff) do { _Pragma("unroll") for (int _i = 0; _i < 2; ++_i) \
        __builtin_amdgcn_global_load_lds((const unsigned*)((const char*)(gbase) + (voff)[_i]), (PG8_LAS unsigned*)(lds + (bufoff) + ldsw + _i * 8192), 16, 0, 0); } while (0)
#define PG8_LDA(dst, b, h) do { if constexpr (F8) { _Pragma("unroll") for (int m = 0; m < 4; ++m) dst##8[m] = PG8_CAT(*(const PG8_LAS bf16x8*)(lds + PG8_SA(b, h) + aoff + m * 2048), *(const PG8_LAS bf16x8*)(lds + PG8_SA(b, h) + aoff + m * 2048 + 1024)); } \
        else { _Pragma("unroll") for (int m = 0; m < 4; ++m) _Pragma("unroll") for (int k = 0; k < 2; ++k) dst[m][k] = *(const PG8_LAS bf16x8*)(lds + PG8_SA(b, h) + aoff + m * 2048 + k * 1024); } } while (0)
#define PG8_LDB(dst, b, h) do { if constexpr (F8) { _Pragma("unroll") for (int n = 0; n < 2; ++n) dst##8[n] = PG8_CAT(*(const PG8_LAS bf16x8*)(lds + PG8_SB(b, h) + boff + n * 2048), *(const PG8_LAS bf16x8*)(lds + PG8_SB(b, h) + boff + n * 2048 + 1024)); } \
        else { _Pragma("unroll") for (int n = 0; n < 2; ++n) _Pragma("unroll") for (int k = 0; k < 2; ++k) dst[n][k] = *(const PG8_LAS bf16x8*)(lds + PG8_SB(b, h) + boff + n * 2048 + k * 1024); } } while (0)
#define PG8_CAT(x, y) __builtin_shufflevector(__builtin_bit_cast(i32x4, (x)), __builtin_bit_cast(i32x4, (y)), 0, 1, 2, 3, 4, 5, 6, 7)
#define PG8_MMA(ai, bj, At, Bt) do { __builtin_amdgcn_s_setprio(1); _Pragma("unroll") for (int m = 0; m < 4; ++m) _Pragma("unroll") for (int n = 0; n < 2; ++n) { \
        if constexpr (F8) { asm volatile("v_mfma_f32_16x16x128_f8f6f4 %0, %1, %2, %0" : "+v"(acc[ai][bj][m][n]) : "v"(Bt##8[n]), "v"(At##8[m])); } \
        else { _Pragma("unroll") for (int k = 0; k < 2; ++k) acc[ai][bj][m][n] = __builtin_amdgcn_mfma_f32_16x16x32_bf16(Bt[n][k], At[m][k], acc[ai][bj][m][n], 0, 0, 0); } } __builtin_amdgcn_s_setprio(0); } while (0)
#define PG8_WAIT_V(n) asm volatile("s_waitcnt vmcnt(" #n ")" ::: "memory")
#define PG8_WAIT_L(n) asm volatile("s_waitcnt lgkmcnt(" #n ")" ::: "memory")
#define PG8_BAR __builtin_amdgcn_s_barrier()
#define PG8_SCHED __builtin_amdgcn_sched_barrier(0)
    Unit cur, nxt; int ui = 0;
    if (!S.next(0, cur)) return;
    f32x4 acc[2][2][4][2];
#pragma unroll
    for (int a = 0; a < 2; ++a)
#pragma unroll
        for (int b = 0; b < 2; ++b)
#pragma unroll
            for (int m = 0; m < 4; ++m)
#pragma unroll
                for (int n = 0; n < 2; ++n) acc[a][b][m][n] = (f32x4){0.f, 0.f, 0.f, 0.f};
    bf16x8 At[4][2], B0[2][2], B1[2][2];
    i32x8 At8[4], B08[2], B18[2];
    const char* cA = (const char*)g.A + (size_t)cur.pm * tstep; const char* cB = (const char*)g.Bt + (size_t)cur.pn * tstep;
    S.a_ready(cur);
    if constexpr (SP2) {
        PG8_STAGE(PG8_SB(0, 0), cB, voffB); PG8_STAGE(PG8_SB(0, 1), cB + hstep, voffB); PG8_STAGE(PG8_SA(0, 0), cA, voffA); PG8_STAGE(PG8_SA(0, 1), cA + hstep, voffA);
        if (wr == 1) PG8_BAR;
        PG8_WAIT_V(2); PG8_BAR;
        PG8_STAGE(PG8_SB(1, 0), cB + kstep, voffB); PG8_STAGE(PG8_SA(1, 0), cA + kstep, voffA); PG8_STAGE(PG8_SB(1, 1), cB + hstep + kstep, voffB);
        PG8_WAIT_V(6); PG8_BAR;
    } else {
        PG8_STAGE(PG8_SB(0, 0), cB, voffB); PG8_STAGE(PG8_SA(0, 0), cA, voffA); PG8_STAGE(PG8_SB(0, 1), cB + hstep, voffB); PG8_STAGE(PG8_SA(0, 1), cA + hstep, voffA);
        if (wr == 1) PG8_BAR;
        PG8_WAIT_V(4); PG8_BAR;
        PG8_STAGE(PG8_SB(1, 0), cB + kstep, voffB); PG8_STAGE(PG8_SA(1, 0), cA + kstep, voffA); PG8_STAGE(PG8_SB(1, 1), cB + hstep + kstep, voffB);
        PG8_WAIT_V(6); PG8_BAR;
    }
    for (;;) {
        const bool has_next = S.next(ui + 1, nxt);
        const char* nA = has_next ? (const char*)g.A + (size_t)nxt.pm * tstep : cA; const char* nB = has_next ? (const char*)g.Bt + (size_t)nxt.pn * tstep : cB;
#pragma nounroll
        for (int t = 0; t < nt; t += 2) {
            const bool last = (t == nt - 2);
            const char* a1 = cA + (size_t)(t + 1) * kstep;
            const char* a2 = last ? nA : cA + (size_t)(t + 2) * kstep; const char* b2 = last ? nB : cB + (size_t)(t + 2) * kstep;
            const char* a3 = a2 + kstep; const char* b3 = b2 + kstep;
            if (last && has_next) S.a_ready(nxt);
            if constexpr (SP2) {
            PG8_LDB(B0, 0, 0); PG8_LDB(B1, 0, 1); PG8_SCHED; PG8_LDA(At, 0, 0); PG8_STAGE(PG8_SA(1, 1), a1 + hstep, voffA);
            PG8_WAIT_V(8); PG8_WAIT_L(0); PG8_BAR; PG8_MMA(0, 0, At, B0); PG8_MMA(0, 1, At, B1); PG8_BAR; PG8_SCHED;
            PG8_LDA(At, 0, 1); PG8_STAGE(PG8_SB(0, 0), b2, voffB); PG8_STAGE(PG8_SB(0, 1), b2 + hstep, voffB); PG8_STAGE(PG8_SA(0, 0), a2, voffA);
            PG8_WAIT_V(8); PG8_WAIT_L(0); PG8_BAR; PG8_MMA(1, 0, At, B0); PG8_MMA(1, 1, At, B1); PG8_BAR; PG8_SCHED;
            PG8_LDB(B0, 1, 0); PG8_LDB(B1, 1, 1); PG8_SCHED; PG8_LDA(At, 1, 0); PG8_STAGE(PG8_SA(0, 1), a2 + hstep, voffA);
            PG8_WAIT_V(8); PG8_WAIT_L(0); PG8_BAR; PG8_MMA(0, 0, At, B0); PG8_MMA(0, 1, At, B1); PG8_BAR; PG8_SCHED;
            PG8_LDA(At, 1, 1); PG8_STAGE(PG8_SB(1, 0), b3, voffB); PG8_STAGE(PG8_SB(1, 1), b3 + hstep, voffB); PG8_STAGE(PG8_SA(1, 0), a3, voffA);
            PG8_WAIT_V(8); PG8_WAIT_L(0); PG8_BAR; PG8_MMA(1, 0, At, B0); PG8_MMA(1, 1, At, B1); PG8_BAR; PG8_SCHED;
            } else {
            PG8_LDB(B0, 0, 0); PG8_SCHED; PG8_LDA(At, 0, 0); PG8_STAGE(PG8_SA(1, 1), a1 + hstep, voffA);
            PG8_WAIT_L(8); PG8_BAR; PG8_WAIT_L(0); PG8_MMA(0, 0, At, B0); PG8_BAR; PG8_SCHED;
            PG8_LDB(B1, 0, 1); PG8_STAGE(PG8_SB(0, 0), b2, voffB);
            PG8_BAR; PG8_WAIT_L(0); PG8_MMA(0, 1, At, B1); PG8_BAR;
            PG8_LDA(At, 0, 1); PG8_STAGE(PG8_SA(0, 0), a2, voffA);
            PG8_BAR; PG8_WAIT_L(0); PG8_MMA(1, 0, At, B0); PG8_BAR; PG8_SCHED;
            PG8_STAGE(PG8_SB(0, 1), b2 + hstep, voffB);
            PG8_WAIT_V(6); PG8_BAR; PG8_MMA(1, 1, At, B1); PG8_BAR;
            PG8_LDB(B0, 1, 0); PG8_SCHED; PG8_LDA(At, 1, 0); PG8_STAGE(PG8_SA(0, 1), a2 + hstep, voffA);
            PG8_WAIT_L(8); PG8_BAR; PG8_WAIT_L(0); PG8_MMA(0, 0, At, B0); PG8_BAR; PG8_SCHED;
            PG8_LDB(B1, 1, 1); PG8_STAGE(PG8_SB(1, 0), b3, voffB);
            PG8_BAR; PG8_WAIT_L(0); PG8_MMA(0, 1, At, B1); PG8_BAR;
            PG8_LDA(At, 1, 1); PG8_STAGE(PG8_SA(1, 0), a3, voffA);
            PG8_BAR; PG8_WAIT_L(0); PG8_MMA(1, 0, At, B0); PG8_BAR; PG8_SCHED;
            PG8_STAGE(PG8_SB(1, 1), b3 + hstep, voffB);
            PG8_WAIT_V(6); PG8_BAR; PG8_MMA(1, 1, At, B1); PG8_BAR;
            }
        }
        if constexpr (F8) asm volatile("s_nop 15\n\ts_nop 15\n\ts_nop 15" ::: "memory");
        if constexpr (ALIGN_EPI) { if (wr == 0) PG8_BAR; }
        if constexpr (!Epi::AFTER_DRAIN) { E(acc, cur, wr, wc, fr, fq); S.done(cur); }
        if (!has_next) break;
#pragma unroll
        for (int a = 0; a < 2; ++a)
#pragma unroll
            for (int b = 0; b < 2; ++b)
#pragma unroll
                for (int m = 0; m < 4; ++m)
#pragma unroll
                    for (int n = 0; n < 2; ++n) acc[a][b][m][n] = (f32x4){0.f, 0.f, 0.f, 0.f};
        cur = nxt; cA = nA; cB = nB; ++ui;
        if constexpr (ALIGN_EPI) { if (wr == 1) PG8_BAR; }
    }
    PG8_WAIT_V(0);
    if constexpr (!ALIGN_EPI) { if (wr == 0) PG8_BAR; }
    PG8_BAR;
    if constexpr (Epi::AFTER_DRAIN) { E.fused(acc, cur, wr, wc, fr, fq, lds, wid, lane); S.done(cur); }
#undef PG8_SA
#undef PG8_SB
#undef PG8_STAGE
#undef PG8_LDA
#undef PG8_LDB
#undef PG8_MMA
#undef PG8_CAT
#undef PG8_WAIT_V
#undef PG8_WAIT_L
#undef PG8_BAR
#undef PG8_SCHED
}
}

namespace att {
using pg8::bf16_t; using pg8::bf16x8; using pg8::u32x4;
typedef float f32x16 __attribute__((ext_vector_type(16)));
typedef short s16x4 __attribute__((ext_vector_type(4)));
typedef float f32x2_t __attribute__((ext_vector_type(2))); typedef __bf16 bf16x2_t __attribute__((ext_vector_type(2)));
#define ALAS __attribute__((address_space(3)))
typedef ALAS const char* lds_cptr;
constexpr int SEQ = 8192, PITCH = 64, VNEXT = 2 * SEQ * 64;
constexpr int KVSLOT = 24576;
constexpr int L_WS = 114688, L_TAB = L_WS + 2048, L_FLAG = L_TAB + 1056, L_END = L_FLAG + 128, L_OST = 0;
constexpr float SB_THR = 152.f;
__device__ __forceinline__ int crow(int r, int hi) { return (r & 3) + 8 * (r >> 2) + 4 * hi; }
__device__ __forceinline__ void glds16(const void* gsrc, unsigned lds_dst) { unsigned keep;
    asm volatile("s_mov_b32 %0, m0\n\ts_mov_b32 m0, %2\n\ts_nop 0\n\tglobal_load_lds_dwordx4 %1, off\n\ts_mov_b32 m0, %0" : "=&s"(keep) : "v"(gsrc), "s"(lds_dst) : "memory"); }
__device__ __forceinline__ unsigned cvtpk(float lo, float hi) { f32x2_t v = {lo, hi}; bf16x2_t b = __builtin_convertvector(v, bf16x2_t); return __builtin_bit_cast(unsigned, b); }
__device__ __forceinline__ unsigned short f2bf(float f) { unsigned u = __builtin_bit_cast(unsigned, f); return (unsigned short)((u + 0x7fffu + ((u >> 16) & 1u)) >> 16); }
#define MFMA32(a, b, c) __builtin_amdgcn_mfma_f32_32x32x16_bf16((a), (b), (c), 0, 0, 0)

__device__ __forceinline__ void qkt(f32x16& p0, f32x16& p1, lds_cptr kb, const bf16x8* qr, const f32x16& cin) {
#pragma unroll
    for (int d0 = 0; d0 < 4; ++d0) {
        const bf16x8 b0 = *(const ALAS bf16x8*)(kb + d0 * 2048);
        const bf16x8 b1 = *(const ALAS bf16x8*)(kb + d0 * 2048 + 512);
        if (d0 == 0) { p0 = MFMA32(b0, qr[0], cin); p1 = MFMA32(b1, qr[0], cin); }
        else { p0 = MFMA32(b0, qr[d0], p0); p1 = MFMA32(b1, qr[d0], p1); }
    }
}

__device__ __forceinline__ void qkt_sw(f32x16& p0, f32x16& p1, lds_cptr ks, const int (&kofs)[4], const bf16x8* qr, const f32x16& cin) {
    bf16x8 kf[8];
#pragma unroll
    for (int d0 = 0; d0 < 4; ++d0) { kf[2 * d0] = *(const ALAS bf16x8*)(ks + kofs[d0]); kf[2 * d0 + 1] = *(const ALAS bf16x8*)(ks + kofs[d0] + 4096); }
    p0 = MFMA32(kf[0], qr[0], cin); p1 = MFMA32(kf[1], qr[0], cin);
#pragma unroll
    for (int d0 = 1; d0 < 4; ++d0) { p0 = MFMA32(kf[2 * d0], qr[d0], p0); p1 = MFMA32(kf[2 * d0 + 1], qr[d0], p1); }
}
template <int ND> __device__ __forceinline__ void pv(f32x16* o, int vb, bf16x8 pa0, bf16x8 pa1, bf16x8 pa2, bf16x8 pa3) {
#pragma unroll
    for (int d0 = 0; d0 < ND; ++d0) { s16x4 lo[4], hi[4];
#pragma unroll
        for (int ks = 0; ks < 4; ++ks) {
            asm volatile("ds_read_b64_tr_b16 %0,%1 offset:%c2" : "=&v"(lo[ks]) : "v"(vb), "i"(d0 * 4096 + ks * 1024) : "memory");
            asm volatile("ds_read_b64_tr_b16 %0,%1 offset:%c2" : "=&v"(hi[ks]) : "v"(vb), "i"(d0 * 4096 + ks * 1024 + 512) : "memory"); }
        asm volatile("s_waitcnt lgkmcnt(0)" ::: "memory"); __builtin_amdgcn_sched_barrier(0);
#define ATT_PK(k) (bf16x8){lo[k][0], lo[k][1], lo[k][2], lo[k][3], hi[k][0], hi[k][1], hi[k][2], hi[k][3]}
        o[d0] = MFMA32(pa0, ATT_PK(0), o[d0]);
        o[d0] = MFMA32(pa1, ATT_PK(1), o[d0]);
        o[d0] = MFMA32(pa2, ATT_PK(2), o[d0]);
        o[d0] = MFMA32(pa3, ATT_PK(3), o[d0]);
#undef ATT_PK
    }
}

template <int MODE, int VD, bool OUT8 = false, int TPB = 1>
__device__ __forceinline__ void attn_unit(ALAS char* shm, const bf16_t* Qb, const bf16_t* Kb, const bf16_t* Vb, void* Ob, int opitch, int q0, float mref2, const float* tab, float oscale = 1.f, int dbg = 0) {
    constexpr int ND = VD / 32, SLOT = 8192 + VD * 128;
    static_assert(2 * TPB * SLOT <= L_WS, "ring vs LDS map");
    const int tid = threadIdx.x, lane = tid & 63, r32 = lane & 31, hi = lane >> 5; const int wid = __builtin_amdgcn_readfirstlane(tid >> 6);
    const unsigned lds0 = (unsigned)(uintptr_t)shm;
    ALAS float* wsf = (ALAS float*)(shm + L_WS) + wid * 64;
    ALAS float* tabL = (ALAS float*)(shm + L_TAB);
    ALAS unsigned* flg = (ALAS unsigned*)(shm + L_FLAG);
    if (MODE == 1) { for (int i = tid; i < 257; i += 512) tabL[i] = tab[i] * pg8::LOG2E; }
    const bf16_t* Qw = Qb + (size_t)(q0 + wid * 32) * PITCH;
    bf16x8 qr[4];
#pragma unroll
    for (int d0 = 0; d0 < 4; ++d0) qr[d0] = *(const bf16x8*)(Qw + (size_t)r32 * PITCH + d0 * 16 + hi * 8);
    int t_first, n_t, t_step;
    if (MODE == 0) { t_first = 0; n_t = q0 / 64 + 4; t_step = 1; }
    else if (MODE == 1) { const int c0 = q0 / 64; t_first = c0 - 8 > 0 ? c0 - 8 : 0; n_t = c0 + 4 - t_first; t_step = 1; }
    else { t_first = q0 / 64 + 3; n_t = q0 / 64 + 4; t_step = -1; }
    const int krow = 8 * wid + (lane >> 3);
    const bf16_t* ksrc = Kb + (size_t)krow * PITCH + (((lane & 7) ^ ((krow >> 1) & 7)) * 8);
    int kofs[4];
#pragma unroll
    for (int d0 = 0; d0 < 4; ++d0) kofs[d0] = (r32 >> 3) * 1024 + ((r32 & 7) * 8 + ((2 * d0 + hi) ^ ((r32 >> 1) & 7))) * 16;
    const bf16_t* vsrc = Vb + (size_t)(16 * (wid & 3) + (lane >> 2)) * PITCH + (wid >> 2) * 32 + (lane & 3) * 8;
#define ATT_DMA(t, slot) do { if (dbg & 64) break; const size_t to_ = (size_t)(t) * 64 * PITCH; const unsigned sb_ = lds0 + (unsigned)(slot) * SLOT; \
        glds16(ksrc + to_, (unsigned)__builtin_amdgcn_readfirstlane(sb_ + wid * 1024)); \
        glds16(vsrc + to_, (unsigned)__builtin_amdgcn_readfirstlane(sb_ + 8192 + wid * 1024)); \
        if (VD == 128) glds16(vsrc + to_ + VNEXT, (unsigned)__builtin_amdgcn_readfirstlane(sb_ + 8192 + (wid + 8) * 1024)); } while (0)
    f32x16 o[ND];
#pragma unroll
    for (int d = 0; d < ND; ++d) o[d] = f32x16{};
    f32x16 cin;
#pragma unroll
    for (int r = 0; r < 16; ++r) cin[r] = (MODE == 2) ? 0.f : -mref2;
    float l_reg = 0.f, A = 0.f; bool wdone = false;
    const int wrow0 = q0 + wid * 32, qrow = wrow0 + r32;
    const int vb0 = (int)lds0 + 8192 + ((lane >> 4) & 1) * 32 + (lane & 3) * 8 + (4 * hi + ((lane & 15) >> 2)) * 64;
#pragma unroll
    for (int u = 0; u < TPB; ++u) ATT_DMA(t_first + u * t_step, u);
    asm volatile("s_waitcnt vmcnt(0)" ::: "memory"); asm volatile("" : "+v"(qr[0]), "+v"(qr[1]), "+v"(qr[2]), "+v"(qr[3]));
    for (int i = 0; i < n_t; ++i) {
        const int t = t_first + i * t_step, slot = i % (2 * TPB);
        if (i % TPB == 0) {
        asm volatile("s_waitcnt vmcnt(0) lgkmcnt(0)\n\ts_barrier" ::: "memory");
        if (MODE == 2 && i > 0) { const int par = ((i - 1) & 3) * 8; unsigned all = 1u;
#pragma unroll
            for (int w = 0; w < 8; ++w) all &= flg[par + w];
            if (__builtin_amdgcn_readfirstlane(all)) break; }
        if (i + TPB < n_t) {
#pragma unroll
            for (int u = 0; u < TPB; ++u) ATT_DMA(t + (TPB + u) * t_step, (i + TPB + u) % (2 * TPB)); }
        }
        bool active;
        if (MODE == 0) active = (64 * t <= wrow0);
        else if (MODE == 1) { const int cw = wrow0 / 64; active = (t >= cw - 8) && (t <= cw); }
        else active = !wdone && (64 * t < wrow0 + 31);
        if (active && !(dbg & 32)) {
            f32x16 p0, p1; qkt_sw(p0, p1, (lds_cptr)shm + slot * SLOT, kofs, qr, cin);
            if (MODE == 0) {
#pragma unroll
                for (int r = 0; r < 16; ++r) { p0[r] = __builtin_amdgcn_exp2f(p0[r]); p1[r] = __builtin_amdgcn_exp2f(p1[r]); }
            } else if (MODE == 1) {
                const int cw = wrow0 / 64;
                if (t <= cw - 3) { const float cb = tabL[256];
#pragma unroll
                    for (int r = 0; r < 16; ++r) { p0[r] = __builtin_amdgcn_exp2f(p0[r] + cb); p1[r] = __builtin_amdgcn_exp2f(p1[r] + cb); }
                } else { const int dq = qrow - 64 * t - 4 * hi;
#pragma unroll
                    for (int r = 0; r < 16; ++r) { int d0 = dq - ((r & 3) + 8 * (r >> 2)), d1 = d0 - 32;
                        d0 = d0 < -128 ? -128 : (d0 > 128 ? 128 : d0); d1 = d1 < -128 ? -128 : (d1 > 128 ? 128 : d1);
                        p0[r] = __builtin_amdgcn_exp2f(p0[r] + tabL[d0 + 128]); p1[r] = __builtin_amdgcn_exp2f(p1[r] + tabL[d1 + 128]); }
                }
            } else {
                const bool needmask = (64 * t + 63 >= wrow0);
                const int kq = qrow - 64 * t - 4 * hi;
                float g[8];
#pragma unroll
                for (int k = 0; k < 8; ++k) g[k] = 0.f;
                f32x16 s0, s1;
#pragma unroll
                for (int r = 0; r < 16; ++r) { const int kv = (r & 3) + 8 * (r >> 2);
                    { const float y = p0[r], a = __builtin_fabsf(y); float sp = __builtin_fmaxf(y, 0.f) + __builtin_amdgcn_logf(1.f + __builtin_amdgcn_exp2f(-a)); if (needmask && !(kv < kq)) sp = 0.f; s0[r] = sp; g[r >> 2] += sp; }
                    { const float y = p1[r], a = __builtin_fabsf(y); float sp = __builtin_fmaxf(y, 0.f) + __builtin_amdgcn_logf(1.f + __builtin_amdgcn_exp2f(-a)); if (needmask && !(kv + 32 < kq)) sp = 0.f; s1[r] = sp; g[4 + (r >> 2)] += sp; } }
                float pg[8];
#pragma unroll
                for (int k = 0; k < 8; ++k) pg[k] = __shfl_xor(g[k], 32);
                float base[8]; float own = 0.f, par = 0.f;
#pragma unroll
                for (int k = 7; k >= 0; --k) { const float par_incl = par + pg[k]; base[k] = A + own + (hi == 0 ? par_incl : par); own += g[k]; par = par_incl; }
                A += own + par;
#pragma unroll
                for (int k = 0; k < 4; ++k) {
                    { float c = base[k]; c += s0[4 * k + 3]; const float w3 = __builtin_amdgcn_exp2f(p0[4 * k + 3] - c); c += s0[4 * k + 2]; const float w2 = __builtin_amdgcn_exp2f(p0[4 * k + 2] - c);
                      c += s0[4 * k + 1]; const float w1 = __builtin_amdgcn_exp2f(p0[4 * k + 1] - c); c += s0[4 * k]; const float w0 = __builtin_amdgcn_exp2f(p0[4 * k] - c);
                      p0[4 * k] = w0; p0[4 * k + 1] = w1; p0[4 * k + 2] = w2; p0[4 * k + 3] = w3; }
                    { float c = base[4 + k]; c += s1[4 * k + 3]; const float w3 = __builtin_amdgcn_exp2f(p1[4 * k + 3] - c); c += s1[4 * k + 2]; const float w2 = __builtin_amdgcn_exp2f(p1[4 * k + 2] - c);
                      c += s1[4 * k + 1]; const float w1 = __builtin_amdgcn_exp2f(p1[4 * k + 1] - c); c += s1[4 * k]; const float w0 = __builtin_amdgcn_exp2f(p1[4 * k] - c);
                      p1[4 * k] = w0; p1[4 * k + 1] = w1; p1[4 * k + 2] = w2; p1[4 * k + 3] = w3; }
                }
                if (needmask) {
#pragma unroll
                    for (int r = 0; r < 16; ++r) { const int kv = (r & 3) + 8 * (r >> 2); if (!(kv < kq)) p0[r] = 0.f; if (!(kv + 32 < kq)) p1[r] = 0.f; }
                }
                wdone = __all(A >= SB_THR);
            }
            if (MODE != 2) { float s = 0.f;
#pragma unroll
                for (int r = 0; r < 16; ++r) s += p0[r] + p1[r];
                l_reg += s; }
            u32x4 pw0, pw1, pw2, pw3;
            pw0 = (u32x4){cvtpk(p0[0], p0[1]), cvtpk(p0[2], p0[3]), cvtpk(p0[4], p0[5]), cvtpk(p0[6], p0[7])};
            pw1 = (u32x4){cvtpk(p0[8], p0[9]), cvtpk(p0[10], p0[11]), cvtpk(p0[12], p0[13]), cvtpk(p0[14], p0[15])};
            pw2 = (u32x4){cvtpk(p1[0], p1[1]), cvtpk(p1[2], p1[3]), cvtpk(p1[4], p1[5]), cvtpk(p1[6], p1[7])};
            pw3 = (u32x4){cvtpk(p1[8], p1[9]), cvtpk(p1[10], p1[11]), cvtpk(p1[12], p1[13]), cvtpk(p1[14], p1[15])};
            pv<ND>(o, vb0 + slot * SLOT, __builtin_bit_cast(bf16x8, pw0), __builtin_bit_cast(bf16x8, pw1), __builtin_bit_cast(bf16x8, pw2), __builtin_bit_cast(bf16x8, pw3));
        }
        if (MODE == 2) { if (lane == 0) flg[(i & 3) * 8 + wid] = wdone ? 1u : 0u; }
    }
#undef ATT_DMA
    asm volatile("s_waitcnt vmcnt(0) lgkmcnt(0)\n\ts_barrier" ::: "memory");
    float rl[16];
    if (MODE != 2) {
        l_reg += __shfl_xor(l_reg, 32);
        if (hi == 0) wsf[32 + r32] = l_reg;
        asm volatile("s_waitcnt lgkmcnt(0)" ::: "memory");
#pragma unroll
        for (int r = 0; r < 16; ++r) rl[r] = __builtin_amdgcn_rcpf(wsf[32 + crow(r, hi)]) * oscale;
    } else {
#pragma unroll
        for (int r = 0; r < 16; ++r) rl[r] = oscale;
    }
    if constexpr (OUT8) {
        static_assert(!OUT8 || VD == 64, "fp8 output: 64-wide heads");
        unsigned char* Ow = (unsigned char*)Ob + (size_t)(q0 + wid * 32) * opitch;
        ALAS unsigned char* stg = (ALAS unsigned char*)(shm + L_OST) + wid * 2048;
#pragma unroll
        for (int r = 0; r < 16; ++r) { const int orow = crow(r, hi);
#pragma unroll
            for (int d0 = 0; d0 < 2; ++d0) { const float v = o[d0][r] * rl[r]; stg[orow * 64 + d0 * 32 + r32] = (unsigned char)(__builtin_amdgcn_cvt_pk_fp8_f32(v, v, 0, false) & 0xff); } }
        asm volatile("s_waitcnt lgkmcnt(0)" ::: "memory");
#pragma unroll
        for (int i = 0; i < 2; ++i) { const int row = i * 16 + (lane >> 2), ch = lane & 3; const u32x4 v = *(const ALAS u32x4*)(stg + row * 64 + ch * 16); *(u32x4*)(Ow + (size_t)row * opitch + ch * 16) = v; }
        asm volatile("s_waitcnt lgkmcnt(0)" ::: "memory");
    } else {
    bf16_t* Ow = (bf16_t*)Ob + (size_t)(q0 + wid * 32) * opitch;
    ALAS bf16_t* stg = (ALAS bf16_t*)(shm + L_OST) + wid * 2048;
#pragma unroll
    for (int half = 0; half < ND / 2; ++half) {
#pragma unroll
        for (int r = 0; r < 16; ++r) { const int orow = crow(r, hi);
#pragma unroll
            for (int d0 = 0; d0 < 2; ++d0) stg[orow * 64 + d0 * 32 + r32] = f2bf(o[half * 2 + d0][r] * rl[r]); }
        asm volatile("s_waitcnt lgkmcnt(0)" ::: "memory");
#pragma unroll
        for (int i = 0; i < 4; ++i) { const int row = i * 8 + (lane >> 3), ch = lane & 7; const u32x4 v = *(const ALAS u32x4*)(stg + row * 64 + ch * 8); *(u32x4*)(Ow + (size_t)row * opitch + half * 64 + ch * 8) = v; }
        asm volatile("s_waitcnt lgkmcnt(0)" ::: "memory");
    }
    }
    asm volatile("s_waitcnt lgkmcnt(0)\n\ts_barrier" ::: "memory");
}


template <int MODE, int VD, bool OUT8 = false, bool PV8 = false>
__device__ __forceinline__ void attn_unit_lag(ALAS char* shm, const bf16_t* Qb, const bf16_t* Kb, const bf16_t* Vb, void* Ob, int opitch, int q0, float mref2, const float* tab, float oscale = 1.f, const unsigned char* Vt = nullptr) {
    static_assert(MODE == 0 || MODE == 1, "stage-lagged loop: softmax modes only");
    static_assert(!PV8 || (MODE == 0 && VD == 128), "fp8 P.V: the differential units");
    constexpr int ND = VD / 32, VBY = PV8 ? VD * 64 : VD * 128, VOFF = 16384, TT = 2 * SEQ;
    static_assert(VOFF + 3 * VBY <= L_WS, "ring vs LDS map");
    const int tid = threadIdx.x, lane = tid & 63, r32 = lane & 31, hi = lane >> 5; const int wid = __builtin_amdgcn_readfirstlane(tid >> 6); const bool lag = wid >= 4;
    const unsigned lds0 = (unsigned)(uintptr_t)shm;
    ALAS float* wsf = (ALAS float*)(shm + L_WS) + wid * 64;
    ALAS float* tabL = (ALAS float*)(shm + L_TAB);
    if (MODE == 1) { for (int i = tid; i < 257; i += 512) tabL[i] = tab[i] * pg8::LOG2E; }
    const bf16_t* Qw = Qb + (size_t)(q0 + wid * 32) * PITCH;
    bf16x8 qr[4];
#pragma unroll
    for (int d0 = 0; d0 < 4; ++d0) qr[d0] = *(const bf16x8*)(Qw + (size_t)r32 * PITCH + d0 * 16 + hi * 8);
    int t_first, n_t;
    if (MODE == 0) { t_first = 0; n_t = q0 / 64 + 4; }
    else { const int c0 = q0 / 64; t_first = c0 - 8 > 0 ? c0 - 8 : 0; n_t = c0 + 4 - t_first; }
    const int krow = 8 * wid + (lane >> 3);
    const bf16_t* ksrc = Kb + (size_t)krow * PITCH + (((lane & 7) ^ ((krow >> 1) & 7)) * 8) + (size_t)t_first * 64 * PITCH;
    int kofs[4];
#pragma unroll
    for (int d0 = 0; d0 < 4; ++d0) kofs[d0] = (r32 >> 3) * 1024 + ((r32 & 7) * 8 + ((2 * d0 + hi) ^ ((r32 >> 1) & 7))) * 16;
    const bf16_t* vsrc = Vb + (size_t)(16 * (wid & 3) + (lane >> 2)) * PITCH + (wid >> 2) * 32 + (lane & 3) * 8 + (size_t)t_first * 64 * PITCH;
    const unsigned char* vtsrc = PV8 ? Vt + (size_t)(16 * wid + (lane >> 2)) * TT + (size_t)t_first * 64 + (((lane & 3) ^ ((lane >> 4) & 3)) * 16) : nullptr;
#define LAG_DMA(i, v3) do { const size_t to_ = (size_t)(i) * 64 * PITCH; const unsigned vb_ = lds0 + VOFF + (unsigned)(v3) * VBY; \
        glds16(ksrc + to_, (unsigned)__builtin_amdgcn_readfirstlane(lds0 + (unsigned)((i) & 1) * 8192 + wid * 1024)); \
        if (PV8) glds16(vtsrc + (size_t)(i) * 64, (unsigned)__builtin_amdgcn_readfirstlane(vb_ + wid * 1024)); \
        else { glds16(vsrc + to_, (unsigned)__builtin_amdgcn_readfirstlane(vb_ + wid * 1024)); \
               if (VD == 128) glds16(vsrc + to_ + VNEXT, (unsigned)__builtin_amdgcn_readfirstlane(vb_ + (wid + 8) * 1024)); } } while (0)
    f32x16 o[ND];
#pragma unroll
    for (int d = 0; d < ND; ++d) o[d] = f32x16{};
    f32x16 cin;
#pragma unroll
    for (int r = 0; r < 16; ++r) cin[r] = PV8 ? 12.f - mref2 : -mref2;
    float l_reg = 0.f;
    const int wrow0 = q0 + wid * 32, qrow = wrow0 + r32, cw = wrow0 / 64;
    const int vt0 = (int)lds0 + VOFF + (r32 >> 4) * 1024 + ((r32 & 15) * 4 + ((2 * hi) ^ (((r32 & 15) >> 2) & 3))) * 16, vt1 = (int)lds0 + VOFF + (r32 >> 4) * 1024 + ((r32 & 15) * 4 + ((2 * hi + 1) ^ (((r32 & 15) >> 2) & 3))) * 16;
    const int vbl = (int)lds0 + VOFF + ((lane >> 4) & 1) * 32 + (lane & 3) * 8 + (4 * hi + ((lane & 15) >> 2)) * 64;
#define LAG_PV(V3) do { if (PV8) { typedef int i32x4_t __attribute__((ext_vector_type(4))); typedef int i32x8_t __attribute__((ext_vector_type(8))); \
            const i32x8_t pa_ = __builtin_shufflevector(__builtin_bit_cast(i32x4_t, pw0), __builtin_bit_cast(i32x4_t, pw1), 0, 1, 2, 3, 4, 5, 6, 7); i32x8_t vf_[ND]; \
            _Pragma("unroll") for (int db_ = 0; db_ < ND; ++db_) { const i32x4_t a_ = *(const ALAS i32x4_t*)(ALAS char*)(uintptr_t)(unsigned)(vt0 + (V3) * VBY + db_ * 2048), b_ = *(const ALAS i32x4_t*)(ALAS char*)(uintptr_t)(unsigned)(vt1 + (V3) * VBY + db_ * 2048); \
                vf_[db_] = __builtin_shufflevector(a_, b_, 0, 1, 2, 3, 4, 5, 6, 7); } \
            _Pragma("unroll") for (int db_ = 0; db_ < ND; ++db_) asm volatile("s_nop 4\n\tv_mfma_f32_32x32x64_f8f6f4 %0, %1, %2, %0" : "+v"(o[db_]) : "v"(pa_), "v"(vf_[db_])); } \
        else pv<ND>(o, vbl + (V3) * VBY, __builtin_bit_cast(bf16x8, pw0), __builtin_bit_cast(bf16x8, pw1), __builtin_bit_cast(bf16x8, pw2), __builtin_bit_cast(bf16x8, pw3)); } while (0)
    LAG_DMA(0, 0);
    asm volatile("s_waitcnt vmcnt(0)" ::: "memory"); asm volatile("" : "+v"(qr[0]), "+v"(qr[1]), "+v"(qr[2]), "+v"(qr[3]));
    u32x4 pw0 = {0u, 0u, 0u, 0u}, pw1 = pw0, pw2 = pw0, pw3 = pw0; bool prev_act = false; int v3 = 0, v3p = 0;
    for (int i = 0; i < n_t; ++i) {
        const int t = t_first + i;
        asm volatile("s_waitcnt vmcnt(0) lgkmcnt(0)\n\ts_barrier" ::: "memory");
        const int v3n = (v3 == 2) ? 0 : v3 + 1;
        if (i + 1 < n_t) LAG_DMA(i + 1, v3n);
        if (lag && prev_act) LAG_PV(v3p);
        bool active;
        if (MODE == 0) active = (t <= cw); else active = (t >= cw - 8) && (t <= cw);
        if (active) {
            f32x16 p0, p1; qkt_sw(p0, p1, (lds_cptr)shm + (i & 1) * 8192, kofs, qr, cin);
            if (MODE == 0) {
#pragma unroll
                for (int r = 0; r < 16; ++r) { p0[r] = __builtin_amdgcn_exp2f(p0[r]); p1[r] = __builtin_amdgcn_exp2f(p1[r]); }
                if (PV8) {
#pragma unroll
                    for (int r = 0; r < 16; ++r) { p0[r] = __builtin_fminf(p0[r], 448.f); p1[r] = __builtin_fminf(p1[r], 448.f); } }
            } else {
                if (t <= cw - 3) { const float cb = tabL[256];
#pragma unroll
                    for (int r = 0; r < 16; ++r) { p0[r] = __builtin_amdgcn_exp2f(p0[r] + cb); p1[r] = __builtin_amdgcn_exp2f(p1[r] + cb); }
                } else { const int dq = qrow - 64 * t - 4 * hi;
#pragma unroll
                    for (int r = 0; r < 16; ++r) { int d0 = dq - ((r & 3) + 8 * (r >> 2)), d1 = d0 - 32;
                        d0 = d0 < -128 ? -128 : (d0 > 128 ? 128 : d0); d1 = d1 < -128 ? -128 : (d1 > 128 ? 128 : d1);
                        p0[r] = __builtin_amdgcn_exp2f(p0[r] + tabL[d0 + 128]); p1[r] = __builtin_amdgcn_exp2f(p1[r] + tabL[d1 + 128]); }
                }
            }
            float s = 0.f;
#pragma unroll
            for (int r = 0; r < 16; ++r) s += p0[r] + p1[r];
            l_reg += s;
            if (PV8) {
                pw0 = (u32x4){pg8::pk4_fp8(p0[0], p0[1], p0[2], p0[3]), pg8::pk4_fp8(p0[4], p0[5], p0[6], p0[7]), pg8::pk4_fp8(p0[8], p0[9], p0[10], p0[11]), pg8::pk4_fp8(p0[12], p0[13], p0[14], p0[15])};
                pw1 = (u32x4){pg8::pk4_fp8(p1[0], p1[1], p1[2], p1[3]), pg8::pk4_fp8(p1[4], p1[5], p1[6], p1[7]), pg8::pk4_fp8(p1[8], p1[9], p1[10], p1[11]), pg8::pk4_fp8(p1[12], p1[13], p1[14], p1[15])};
            } else {
            pw0 = (u32x4){cvtpk(p0[0], p0[1]), cvtpk(p0[2], p0[3]), cvtpk(p0[4], p0[5]), cvtpk(p0[6], p0[7])};
            pw1 = (u32x4){cvtpk(p0[8], p0[9]), cvtpk(p0[10], p0[11]), cvtpk(p0[12], p0[13]), cvtpk(p0[14], p0[15])};
            pw2 = (u32x4){cvtpk(p1[0], p1[1]), cvtpk(p1[2], p1[3]), cvtpk(p1[4], p1[5]), cvtpk(p1[6], p1[7])};
            pw3 = (u32x4){cvtpk(p1[8], p1[9]), cvtpk(p1[10], p1[11]), cvtpk(p1[12], p1[13]), cvtpk(p1[14], p1[15])};
            }
            if (!lag) LAG_PV(v3);
        }
        prev_act = active; v3p = v3; v3 = v3n;
    }
    if (lag && prev_act) LAG_PV(v3p);
#undef LAG_DMA
#undef LAG_PV
    if (PV8) asm volatile("s_nop 15\n\ts_nop 15" ::: "memory");
    asm volatile("s_waitcnt vmcnt(0) lgkmcnt(0)\n\ts_barrier" ::: "memory");
    float rl[16];
    l_reg += __shfl_xor(l_reg, 32);
    if (hi == 0) wsf[32 + r32] = l_reg;
    asm volatile("s_waitcnt lgkmcnt(0)" ::: "memory");
#pragma unroll
    for (int r = 0; r < 16; ++r) rl[r] = __builtin_amdgcn_rcpf(wsf[32 + crow(r, hi)]) * oscale;
    if constexpr (OUT8) {
        static_assert(!OUT8 || VD == 64, "fp8 output: 64-wide heads");
        unsigned char* Ow = (unsigned char*)Ob + (size_t)(q0 + wid * 32) * opitch;
        ALAS unsigned char* stg = (ALAS unsigned char*)(shm + L_OST) + wid * 2048;
#pragma unroll
        for (int r = 0; r < 16; ++r) { const int orow = crow(r, hi);
#pragma unroll
            for (int d0 = 0; d0 < 2; ++d0) { const float v = o[d0][r] * rl[r]; stg[orow * 64 + d0 * 32 + r32] = (unsigned char)(__builtin_amdgcn_cvt_pk_fp8_f32(v, v, 0, false) & 0xff); } }
        asm volatile("s_waitcnt lgkmcnt(0)" ::: "memory");
#pragma unroll
        for (int i = 0; i < 2; ++i) { const int row = i * 16 + (lane >> 2), ch = lane & 3; const u32x4 v = *(const ALAS u32x4*)(stg + row * 64 + ch * 16); *(u32x4*)(Ow + (size_t)row * opitch + ch * 16) = v; }
        asm volatile("s_waitcnt lgkmcnt(0)" ::: "memory");
    } else {
        bf16_t* Ow = (bf16_t*)Ob + (size_t)(q0 + wid * 32) * opitch;
        ALAS bf16_t* stg = (ALAS bf16_t*)(shm + L_OST) + wid * 2048;
#pragma unroll
        for (int half = 0; half < ND / 2; ++half) {
#pragma unroll
            for (int r = 0; r < 16; ++r) { const int orow = crow(r, hi);
#pragma unroll
                for (int d0 = 0; d0 < 2; ++d0) stg[orow * 64 + d0 * 32 + r32] = f2bf(o[half * 2 + d0][r] * rl[r]); }
            asm volatile("s_waitcnt lgkmcnt(0)" ::: "memory");
#pragma unroll
            for (int i = 0; i < 4; ++i) { const int row = i * 8 + (lane >> 3), ch = lane & 7; const u32x4 v = *(const ALAS u32x4*)(stg + row * 64 + ch * 8); *(u32x4*)(Ow + (size_t)row * opitch + half * 64 + ch * 8) = v; }
            asm volatile("s_waitcnt lgkmcnt(0)" ::: "memory");
        }
    }
    asm volatile("s_waitcnt lgkmcnt(0)\n\ts_barrier" ::: "memory");
}
__device__ __forceinline__ void qkt8(f32x16& p0, f32x16& p1, lds_cptr kb, const bf16x8* qr, const f32x16& cin) {
    bf16x8 kf[8];
#pragma unroll
    for (int d0 = 0; d0 < 4; ++d0) { kf[2 * d0] = *(const ALAS bf16x8*)(kb + d0 * 2048); kf[2 * d0 + 1] = *(const ALAS bf16x8*)(kb + d0 * 2048 + 512); }
    __builtin_amdgcn_sched_barrier(0);
    p0 = MFMA32(kf[0], qr[0], cin); p1 = MFMA32(kf[1], qr[0], cin);
#pragma unroll
    for (int d0 = 1; d0 < 4; ++d0) { p0 = MFMA32(kf[2 * d0], qr[d0], p0); p1 = MFMA32(kf[2 * d0 + 1], qr[d0], p1); }
}
template <int ND, int KS0> __device__ __forceinline__ void v_reads(s16x4 (&lo)[ND][2], s16x4 (&hi)[ND][2], int vb) {
#pragma unroll
    for (int ks = 0; ks < 2; ++ks)
#pragma unroll
        for (int d0 = 0; d0 < ND; ++d0) {
            asm volatile("ds_read_b64_tr_b16 %0,%1 offset:%c2" : "=&v"(lo[d0][ks]) : "v"(vb), "i"(d0 * 4096 + (KS0 + ks) * 1024) : "memory");
            asm volatile("ds_read_b64_tr_b16 %0,%1 offset:%c2" : "=&v"(hi[d0][ks]) : "v"(vb), "i"(d0 * 4096 + (KS0 + ks) * 1024 + 512) : "memory"); }
}
template <int ND> __device__ __forceinline__ void pv_half(f32x16* o, const s16x4 (&lo)[ND][2], const s16x4 (&hi)[ND][2], bf16x8 pa, bf16x8 pb) {
#define ATT_PK2(d, k) (bf16x8){lo[d][k][0], lo[d][k][1], lo[d][k][2], lo[d][k][3], hi[d][k][0], hi[d][k][1], hi[d][k][2], hi[d][k][3]}
#pragma unroll
    for (int d0 = 0; d0 < ND; ++d0) o[d0] = MFMA32(pa, ATT_PK2(d0, 0), o[d0]);
#pragma unroll
    for (int d0 = 0; d0 < ND; ++d0) o[d0] = MFMA32(pb, ATT_PK2(d0, 1), o[d0]);
#undef ATT_PK2
}
template <int MODE> __device__ __forceinline__ void p_half(f32x16& p, float& l_reg, u32x4& wa, u32x4& wb, bool const_bias, int dq, const ALAS float* tabL) {
    if (MODE == 0) {
#pragma unroll
        for (int r = 0; r < 16; ++r) p[r] = __builtin_amdgcn_exp2f(p[r]);
    } else if (const_bias) { const float cb = tabL[256];
#pragma unroll
        for (int r = 0; r < 16; ++r) p[r] = __builtin_amdgcn_exp2f(p[r] + cb);
    } else {
#pragma unroll
        for (int r = 0; r < 16; ++r) { int d = dq - ((r & 3) + 8 * (r >> 2)); d = d < -128 ? -128 : (d > 128 ? 128 : d); p[r] = __builtin_amdgcn_exp2f(p[r] + tabL[d + 128]); }
    }
    float s = 0.f;
#pragma unroll
    for (int r = 0; r < 16; ++r) s += p[r];
    l_reg += s;
    wa = (u32x4){cvtpk(p[0], p[1]), cvtpk(p[2], p[3]), cvtpk(p[4], p[5]), cvtpk(p[6], p[7])};
    wb = (u32x4){cvtpk(p[8], p[9]), cvtpk(p[10], p[11]), cvtpk(p[12], p[13]), cvtpk(p[14], p[15])};
}
__device__ __forceinline__ void vm_wait_n(int n) {
    if (n <= 0) asm volatile("s_waitcnt vmcnt(0)" ::: "memory"); else if (n == 1) asm volatile("s_waitcnt vmcnt(1)" ::: "memory"); else if (n == 2) asm volatile("s_waitcnt vmcnt(2)" ::: "memory");
    else if (n == 3) asm volatile("s_waitcnt vmcnt(3)" ::: "memory"); else if (n == 4) asm volatile("s_waitcnt vmcnt(4)" ::: "memory"); else if (n == 5) asm volatile("s_waitcnt vmcnt(5)" ::: "memory");
    else if (n == 6) asm volatile("s_waitcnt vmcnt(6)" ::: "memory"); else if (n == 7) asm volatile("s_waitcnt vmcnt(7)" ::: "memory"); else if (n == 8) asm volatile("s_waitcnt vmcnt(8)" ::: "memory");
    else if (n == 9) asm volatile("s_waitcnt vmcnt(9)" ::: "memory"); else if (n == 10) asm volatile("s_waitcnt vmcnt(10)" ::: "memory"); else asm volatile("s_waitcnt vmcnt(11)" ::: "memory");
}
template <int MODE, int VD, bool OUT8 = false, int PD = 3>
__device__ __forceinline__ void attn_unit_pp(ALAS char* shm, const bf16_t* Qb, const bf16_t* Kb, const bf16_t* Vb, void* Ob, int opitch, int q0, float mref2, const float* tab, float oscale = 1.f, int dbg = 0) {
    static_assert(MODE == 0 || MODE == 1, "ping-pong loop: softmax modes only");
    constexpr int ND = VD / 32, NV = VD / 64, NS = PD + 1, PER = 1 + NV, SLOT = 8192 + VD * 128;
    static_assert(NS * SLOT <= L_WS, "ring vs LDS map");
    const int tid = threadIdx.x, lane = tid & 63, r32 = lane & 31, hi = lane >> 5; const int wid = __builtin_amdgcn_readfirstlane(tid >> 6); const int grp = wid >> 2;
    const unsigned lds0 = (unsigned)(uintptr_t)shm;
    ALAS float* wsf = (ALAS float*)(shm + L_WS) + wid * 64;
    ALAS float* tabL = (ALAS float*)(shm + L_TAB);
    if (MODE == 1) { for (int i = tid; i < 257; i += 512) tabL[i] = tab[i] * pg8::LOG2E; }
    const bf16_t* Qw = Qb + (size_t)(q0 + wid * 32) * PITCH;
    bf16x8 qr[4];
#pragma unroll
    for (int d0 = 0; d0 < 4; ++d0) qr[d0] = *(const bf16x8*)(Qw + (size_t)r32 * PITCH + d0 * 16 + hi * 8);
    int t_first, n_t;
    if (MODE == 0) { t_first = 0; n_t = q0 / 64 + 4; }
    else { const int c0 = q0 / 64; t_first = c0 - 8 > 0 ? c0 - 8 : 0; n_t = c0 + 4 - t_first; }
    const bf16_t* ksrc = Kb + (size_t)lane * PITCH + wid * 8 + (size_t)t_first * 64 * PITCH;
    const bf16_t* vsrc = Vb + (size_t)(16 * (wid & 3) + (lane >> 2)) * PITCH + (wid >> 2) * 32 + (lane & 3) * 8 + (size_t)t_first * 64 * PITCH;
    const bf16_t* ksrc_c = Kb + (size_t)t_first * 64 * PITCH + wid * 512 + lane * 8;
    int issued = 0;
#define PP_DMA_K(i) do { if ((i) < n_t && !(dbg & 64)) { glds16(((dbg & 128) ? ksrc_c : ksrc) + (size_t)(i) * 64 * PITCH, (unsigned)__builtin_amdgcn_readfirstlane(lds0 + (unsigned)((i) % NS) * SLOT + wid * 1024)); issued += 1; } } while (0)
#define PP_DMA_V(i) do { if ((i) < n_t && !(dbg & 64)) { const unsigned sb_ = lds0 + (unsigned)((i) % NS) * SLOT + 8192; glds16(vsrc + (size_t)(i) * 64 * PITCH, (unsigned)__builtin_amdgcn_readfirstlane(sb_ + wid * 1024)); \
        if (VD == 128) glds16(vsrc + (size_t)(i) * 64 * PITCH + VNEXT, (unsigned)__builtin_amdgcn_readfirstlane(sb_ + (wid + 8) * 1024)); issued += NV; } } while (0)
#define PP_NEED_K(j) do { if (!(dbg & 256)) vm_wait_n(issued - ((j) * PER + 1)); } while (0)
#define PP_NEED_V(j) do { if (!(dbg & 256)) vm_wait_n(issued - ((j) + 1) * PER); } while (0)
#define PP_BAR() asm volatile("s_waitcnt lgkmcnt(0)\n\ts_barrier" ::: "memory")
    f32x16 o[ND];
#pragma unroll
    for (int d = 0; d < ND; ++d) o[d] = f32x16{};
    f32x16 cin;
#pragma unroll
    for (int r = 0; r < 16; ++r) cin[r] = -mref2;
    float l_reg = 0.f;
    const int wrow0 = q0 + wid * 32, qrow = wrow0 + r32, cw = wrow0 / 64;
    const int vb0 = (int)lds0 + 8192 + ((lane >> 4) & 1) * 32 + (lane & 3) * 8 + (4 * hi + ((lane & 15) >> 2)) * 64;
    asm volatile("s_waitcnt vmcnt(0)" ::: "memory"); asm volatile("" : "+v"(qr[0]), "+v"(qr[1]), "+v"(qr[2]), "+v"(qr[3]));
#pragma unroll
    for (int j = 0; j < PD; ++j) { PP_DMA_K(j); PP_DMA_V(j); }
    if (grp) PP_DMA_K(PD);
    PP_NEED_V(0);
    PP_BAR();
    if (grp) PP_BAR();
    u32x4 pw0, pw1, pw2, pw3; f32x16 p1;
    for (int i = 0; i < n_t; ++i) {
        const int t = t_first + i, slot = i % NS;
        bool active;
        if (MODE == 0) active = (t <= cw); else active = (t >= cw - 8) && (t <= cw);
        if (grp == 0) PP_DMA_K(i + PD); else PP_DMA_V(i + PD);
        if (active && !(dbg & 32)) {
            const lds_cptr kb = (lds_cptr)shm + slot * SLOT + hi * 1024 + r32 * 16;
            f32x16 p0; qkt8(p0, p1, kb, qr, cin);
            p_half<MODE>(p0, l_reg, pw0, pw1, (t <= cw - 3) || (dbg & 8), qrow - 64 * t - 4 * hi, tabL);
        }
        if (grp == 0) PP_NEED_V(i); else PP_NEED_K(i + 1);
        PP_BAR();
        if (grp == 0) PP_DMA_V(i + PD); else PP_DMA_K(i + 1 + PD);
        if (active && !(dbg & 16)) {
            const int vb = vb0 + slot * SLOT;
            s16x4 lo0[ND][2], hi0[ND][2], lo1[ND][2], hi1[ND][2];
            v_reads<ND, 0>(lo0, hi0, vb);
            asm volatile("s_waitcnt lgkmcnt(0)" ::: "memory");
            v_reads<ND, 2>(lo1, hi1, vb);
            __builtin_amdgcn_sched_barrier(0);
            pv_half<ND>(o, lo0, hi0, __builtin_bit_cast(bf16x8, pw0), __builtin_bit_cast(bf16x8, pw1));
            __builtin_amdgcn_sched_barrier(0);
            p_half<MODE>(p1, l_reg, pw2, pw3, (t <= cw - 3) || (dbg & 8), qrow - 64 * t - 4 * hi - 32, tabL);
            asm volatile("s_waitcnt lgkmcnt(0)" ::: "memory");
            __builtin_amdgcn_sched_barrier(0);
            pv_half<ND>(o, lo1, hi1, __builtin_bit_cast(bf16x8, pw2), __builtin_bit_cast(bf16x8, pw3));
        }
        if (grp == 0) PP_NEED_K(i + 1); else PP_NEED_V(i + 1);
        PP_BAR();
    }
    if (grp == 0) PP_BAR();
#undef PP_DMA_K
#undef PP_DMA_V
#undef PP_NEED_K
#undef PP_NEED_V
    float rl[16];
    l_reg += __shfl_xor(l_reg, 32);
    if (hi == 0) wsf[32 + r32] = l_reg;
    asm volatile("s_waitcnt lgkmcnt(0)" ::: "memory");
#pragma unroll
    for (int r = 0; r < 16; ++r) rl[r] = __builtin_amdgcn_rcpf(wsf[32 + crow(r, hi)]) * oscale;
    if constexpr (OUT8) {
        static_assert(!OUT8 || VD == 64, "fp8 output: 64-wide heads");
        unsigned char* Ow = (unsigned char*)Ob + (size_t)(q0 + wid * 32) * opitch;
        ALAS unsigned char* stg = (ALAS unsigned char*)(shm + L_OST) + wid * 2048;
#pragma unroll
        for (int r = 0; r < 16; ++r) { const int orow = crow(r, hi);
#pragma unroll
            for (int d0 = 0; d0 < 2; ++d0) { const float v = o[d0][r] * rl[r]; stg[orow * 64 + d0 * 32 + r32] = (unsigned char)(__builtin_amdgcn_cvt_pk_fp8_f32(v, v, 0, false) & 0xff); } }
        asm volatile("s_waitcnt lgkmcnt(0)" ::: "memory");
#pragma unroll
        for (int i = 0; i < 2; ++i) { const int row = i * 16 + (lane >> 2), ch = lane & 3; const u32x4 v = *(const ALAS u32x4*)(stg + row * 64 + ch * 16); *(u32x4*)(Ow + (size_t)row * opitch + ch * 16) = v; }
        asm volatile("s_waitcnt lgkmcnt(0)" ::: "memory");
    } else {
    bf16_t* Ow = (bf16_t*)Ob + (size_t)(q0 + wid * 32) * opitch;
    ALAS bf16_t* stg = (ALAS bf16_t*)(shm + L_OST) + wid * 2048;
#pragma unroll
    for (int half = 0; half < ND / 2; ++half) {
#pragma unroll
        for (int r = 0; r < 16; ++r) { const int orow = crow(r, hi);
#pragma unroll
            for (int d0 = 0; d0 < 2; ++d0) stg[orow * 64 + d0 * 32 + r32] = f2bf(o[half * 2 + d0][r] * rl[r]); }
        asm volatile("s_waitcnt lgkmcnt(0)" ::: "memory");
#pragma unroll
        for (int i = 0; i < 4; ++i) { const int row = i * 8 + (lane >> 3), ch = lane & 7; const u32x4 v = *(const ALAS u32x4*)(stg + row * 64 + ch * 8); *(u32x4*)(Ow + (size_t)row * opitch + half * 64 + ch * 8) = v; }
        asm volatile("s_waitcnt lgkmcnt(0)" ::: "memory");
    }
    }
    PP_BAR();
#undef PP_BAR
}
}

constexpr int NWAVES = 8, NTHR = NWAVES * 64;
constexpr int BATCH = 2, SEQ = 8192, T = BATCH * SEQ, D = 1024;
constexpr int NPROJ = 3072, FFD = 2816, FFE = 3584, NEXP = 8;
constexpr size_t MiB = 1u << 20;
constexpr size_t CTL_ZERO_BYTES = 1 * MiB;
constexpr int CW_TMO = 0, CW_BAR = 4096;
constexpr int CW_HIST = 16384;
constexpr int CW_QATT = 32768, CW_QCONV = 32768 + 64 * 8;
constexpr int CW_MOE = 24576;
constexpr size_t WS_SS0 = 1 * MiB, WS_SS3 = WS_SS0 + 65536, WS_ROPE = WS_SS3 + 65536  , WS_TOKSEL = WS_ROPE + MiB  ,
                 WS_TOKGATE = WS_TOKSEL + 65536  , WS_ROWTOK = WS_TOKGATE + 131072  , WS_ROWGATE = WS_ROWTOK + 147456  , WS_ROWSCALE = WS_ROWGATE + 147456  ;
static_assert(WS_ROWSCALE + 147456 <= 4 * MiB, "small arrays");
constexpr size_t WS_XB = 4 * MiB;
constexpr size_t WS_AO = 36 * MiB;
constexpr size_t WS_ACT0 = 68 * MiB;
constexpr size_t WS_XF = 164 * MiB;
constexpr size_t WS_WIN = 228 * MiB, WS_WO0 = 234 * MiB, WS_WGU0 = 236 * MiB, WS_WD0 = 247 * MiB, WS_WQKV = 253 * MiB, WS_WO1 = 259 * MiB;
constexpr size_t WS_WEGU = 264 * MiB;
constexpr size_t WS_WED = 376 * MiB;
constexpr size_t WS_SS1 = 432 * MiB, WS_SS2 = 433 * MiB;
constexpr size_t WS_VT8 = 434 * MiB;
constexpr size_t WS_END = 442 * MiB;
constexpr size_t WS_SORTA = 36 * MiB;
constexpr size_t WS_ACTE = 108 * MiB;
static_assert(WS_SORTA + (size_t)36864 * 2048 <= WS_ACTE && WS_ACTE + (size_t)18432 * 7168 <= WS_WO0 && WS_WD0 + (size_t)1024 * 2816 * 2 <= WS_WQKV && WS_WO1 + 2 * MiB <= WS_WEGU, "ws map");
constexpr int RING_BYTES = 131072, MISC_OFF = RING_BYTES + 320, ULIST_OFF = RING_BYTES + 1024  , RTAB_OFF = RING_BYTES + 2048  , LDS_BYTES = 155648;
static_assert(RTAB_OFF + 16 * 1024 <= LDS_BYTES, "LDS control area");
static_assert(att::L_END <= RING_BYTES, "attention LDS");

#define GAS __attribute__((address_space(1)))
#define LAS __attribute__((address_space(3)))
typedef unsigned short bf16;
typedef unsigned v4u __attribute__((ext_vector_type(4)));
typedef float f32x4 __attribute__((ext_vector_type(4)));
typedef GAS unsigned gu32;
#define RLX_AGENT __ATOMIC_RELAXED, __HIP_MEMORY_SCOPE_AGENT
#define LDS_WAIT() asm volatile("s_waitcnt lgkmcnt(0)" ::: "memory")
#define VM_WAIT() asm volatile("s_waitcnt vmcnt(0)" ::: "memory")
__device__ __forceinline__ unsigned f2bf(float f) { unsigned u = __builtin_bit_cast(unsigned, f); return (u + 0x7fffu + ((u >> 16) & 1u)) >> 16; }
__device__ __forceinline__ unsigned pk2(float lo, float hi) { return f2bf(lo) | (f2bf(hi) << 16); }
__device__ __forceinline__ float bf2f(unsigned short h) { return __builtin_bit_cast(float, (unsigned)h << 16); }
#define XB_TMO      128
#define XB_XCNT(j)  (256  + 64 * (j))
#define XB_XSUB(j)  (1280 + 64 * (j))
#define XB_XGEN(j)  (2304 + 64 * (j))
#define XB_TOP      3328
#define XB_TOPGEN   3392
#define XCD_BAR_WORDS 3456
#define XB_SPIN_CAP (1u << 18)

__device__ __forceinline__ unsigned xb_ld(unsigned* p)              { return __hip_atomic_load(p, __ATOMIC_RELAXED, __HIP_MEMORY_SCOPE_AGENT); }
__device__ __forceinline__ unsigned xb_add(unsigned* p, unsigned v) { return __hip_atomic_fetch_add(p, v, __ATOMIC_RELAXED, __HIP_MEMORY_SCOPE_AGENT); }
__device__ __forceinline__ unsigned xb_xcc_id() { return (unsigned)__builtin_amdgcn_s_getreg((3 << 11) | 20) & 0xFu; }
#define XB_SPIN(cond, bar) do { unsigned _sp = 0; while (cond) { __builtin_amdgcn_s_sleep(1); \
    if ((++_sp & 255u) == 0u) { if (xb_ld(&(bar)[XB_TMO])) break; if (_sp > XB_SPIN_CAP) { atomicAdd(&(bar)[XB_TMO], 1u); break; } } } } while (0)

struct XcdBarrier {
    unsigned* bar; unsigned x;
    volatile LAS unsigned* st;
};

__device__ __forceinline__ XcdBarrier xcd_barrier_post(unsigned* bar, volatile LAS unsigned* st) {
    XcdBarrier b; b.bar = bar; b.x = xb_xcc_id(); b.st = st;
    if (threadIdx.x == 0) (void)xb_add(&bar[XB_XCNT(b.x)], 1u);
    return b;
}
__device__ __forceinline__ void xcd_barrier_complete(unsigned* bar, unsigned x, unsigned& nloc, unsigned& nx) {
    const unsigned G = gridDim.x * gridDim.y * gridDim.z;
    unsigned sum, cnt, mine, sp = 0u;
    for (;;) {
        sum = 0u; cnt = 0u; mine = 0u;
#pragma unroll
        for (unsigned j = 0; j < 16; ++j) { const unsigned c = xb_ld(&bar[XB_XCNT(j)]); sum += c; cnt += (c > 0u) ? 1u : 0u; mine = (j == x) ? c : mine; }
        if (sum == G) break;
        __builtin_amdgcn_s_sleep(1);
        if ((++sp & 255u) == 0u) { if (xb_ld(&bar[XB_TMO])) break; if (sp > XB_SPIN_CAP) { atomicAdd(&bar[XB_TMO], 1u); break; } }
    }
    nloc = mine > 0u ? mine : 1u; nx = cnt > 0u ? cnt : 1u;
}

__device__ __forceinline__ void xcd_barrier(const XcdBarrier& b) {
    asm volatile("s_waitcnt vmcnt(0)" ::: "memory");
    __syncthreads();
    if (threadIdx.x == 0) {
        unsigned* bar = b.bar;
        __builtin_amdgcn_s_waitcnt(0);
        unsigned nloc = b.st[0], nx = b.st[1];
        if (nloc == 0u) { xcd_barrier_complete(bar, b.x, nloc, nx); b.st[0] = nloc; b.st[1] = nx; }
        const unsigned old = xb_add(&bar[XB_XSUB(b.x)], 1u);
        const unsigned gen = old / nloc;
        if (old + 1u == (gen + 1u) * nloc) {
            __builtin_amdgcn_fence(__ATOMIC_RELEASE, "agent");
            asm volatile("s_waitcnt vmcnt(0)" ::: "memory");
            const unsigned og = xb_add(&bar[XB_TOP], 1u);
            const unsigned tg = og / nx;
            if (og + 1u == (tg + 1u) * nx) xb_add(&bar[XB_TOPGEN], 1u);
            else XB_SPIN(xb_ld(&bar[XB_TOPGEN]) == tg, bar);
            __builtin_amdgcn_fence(__ATOMIC_ACQUIRE, "agent");
            xb_add(&bar[XB_XGEN(b.x)], 1u);
            asm volatile("s_waitcnt vmcnt(0)" ::: "memory");
        } else {
            XB_SPIN(xb_ld(&bar[XB_XGEN(b.x)]) == gen, bar);
            __builtin_amdgcn_fence(__ATOMIC_ACQUIRE, "agent");
            asm volatile("s_waitcnt vmcnt(0)" ::: "memory");
        }
    }
    __syncthreads();
}

__device__ __forceinline__ float wave_sum(float v) {
#pragma unroll
    for (int o = 1; o < 64; o <<= 1) v += __shfl_xor(v, o);
    return v;
}
__device__ __forceinline__ float wave_max(float v) {
#pragma unroll
    for (int o = 1; o < 64; o <<= 1) v = fmaxf(v, __shfl_xor(v, o));
    return v;
}
__device__ __forceinline__ int dest_block(int blk, int map) {
    if (map == 1) { const int s = blk & 7; return (blk & ~7) + 4 * (s & 1) + (s >> 1); }
    if (map == 2) return (blk >> 2) * 8 + (blk & 3);
    if (map == 3) return (blk >> 2) * 8 + 4 + (blk & 3);
    return blk;
}
__device__ __forceinline__ void tr_tile(const float* W, int K, int N, bf16* WT, int map, const float* gain, LAS unsigned* scr, int item, int lane) {
    const int nblk = N / 64, kb = item / nblk, nb = item % nblk, k0 = 64 * kb, n0 = 64 * nb;
    const int c = lane & 15, ip = lane >> 4;
#pragma unroll
    for (int it = 0; it < 8; ++it) { const int kp = it * 4 + ip, k = k0 + 2 * kp;
        f32x4 a = *(const GAS f32x4*)(W + (size_t)k * N + n0 + 4 * c), b = *(const GAS f32x4*)(W + (size_t)(k + 1) * N + n0 + 4 * c);
        if (gain) { a = a * gain[k]; b = b * gain[k + 1]; }
#pragma unroll
        for (int j = 0; j < 4; ++j) scr[(4 * c + j) * 33 + kp] = pk2(a[j], b[j]); }
    LDS_WAIT(); asm volatile("" ::: "memory");
#pragma unroll
    for (int it = 0; it < 8; ++it) { const int n = it * 8 + (lane >> 3), q = lane & 7;
        v4u o; o.x = scr[n * 33 + 4 * q]; o.y = scr[n * 33 + 4 * q + 1]; o.z = scr[n * 33 + 4 * q + 2]; o.w = scr[n * 33 + 4 * q + 3];
        const int drow = dest_block((n0 + n) >> 5, map) * 32 + (n & 31);
        *(GAS v4u*)(WT + (size_t)drow * K + k0 + 8 * q) = o; }
    LDS_WAIT(); asm volatile("" ::: "memory");
}

__device__ __forceinline__ void tr_tile8(const float* W, int K, int N, unsigned char* WT, int map, const float* gain, float wscale, LAS unsigned* scr, int item, int lane) {
    const int nblk = N / 64, kb = item / nblk, nb = item % nblk, k0 = 64 * kb, n0 = 64 * nb;
    const int c = lane & 15, ip = lane >> 4;
#pragma unroll
    for (int it = 0; it < 4; ++it) { const int k4 = it * 4 + ip, k = k0 + 4 * k4; f32x4 a[4];
#pragma unroll
        for (int i = 0; i < 4; ++i) a[i] = *(const GAS f32x4*)(W + (size_t)(k + i) * N + n0 + 4 * c) * ((gain ? gain[k + i] : 1.f) * wscale);
#pragma unroll
        for (int j = 0; j < 4; ++j) scr[(4 * c + j) * 17 + k4] = pg8::pk4_fp8(a[0][j], a[1][j], a[2][j], a[3][j]); }
    LDS_WAIT(); asm volatile("" ::: "memory");
#pragma unroll
    for (int it = 0; it < 4; ++it) { const int n = it * 16 + (lane >> 2), q = lane & 3;
        v4u o; o.x = scr[n * 17 + 4 * q]; o.y = scr[n * 17 + 4 * q + 1]; o.z = scr[n * 17 + 4 * q + 2]; o.w = scr[n * 17 + 4 * q + 3];
        const int drow = dest_block((n0 + n) >> 5, map) * 32 + (n & 31);
        *(GAS v4u*)(WT + (size_t)drow * K + k0 + 16 * q) = o; }
    LDS_WAIT(); asm volatile("" ::: "memory");
}

struct TrItem { const float* W; unsigned char* WT; const float* gain; int K, N, map, fp8, k0, n0; float scale; };
__device__ __forceinline__ void tr_load(const TrItem& d, f32x4 (&a)[16], float (&g)[16], int lane) {
    const int c = lane & 15, ip = lane >> 4;
#pragma unroll
    for (int it = 0; it < 4; ++it)
#pragma unroll
        for (int i = 0; i < 4; ++i) { const int k = d.k0 + 4 * (it * 4 + ip) + i;
            a[it * 4 + i] = __builtin_nontemporal_load((const GAS f32x4*)(d.W + (size_t)k * d.N + d.n0 + 4 * c)); g[it * 4 + i] = d.gain ? d.gain[k] : 1.f; }
}
__device__ __forceinline__ void tr_emit(const TrItem& d, const f32x4 (&a)[16], const float (&g)[16], LAS unsigned* scr, int lane) {
    const int c = lane & 15, ip = lane >> 4;
    if (d.fp8) {
#pragma unroll
        for (int it = 0; it < 4; ++it) { const int k4 = it * 4 + ip;
#pragma unroll
            for (int j = 0; j < 4; ++j) scr[(4 * c + j) * 17 + k4] = pg8::pk4_fp8(a[it * 4][j] * (g[it * 4] * d.scale), a[it * 4 + 1][j] * (g[it * 4 + 1] * d.scale), a[it * 4 + 2][j] * (g[it * 4 + 2] * d.scale), a[it * 4 + 3][j] * (g[it * 4 + 3] * d.scale)); }
        LDS_WAIT(); asm volatile("" ::: "memory");
#pragma unroll
        for (int it = 0; it < 4; ++it) { const int n = it * 16 + (lane >> 2), q = lane & 3;
            v4u o; o.x = scr[n * 17 + 4 * q]; o.y = scr[n * 17 + 4 * q + 1]; o.z = scr[n * 17 + 4 * q + 2]; o.w = scr[n * 17 + 4 * q + 3];
            const int drow = dest_block((d.n0 + n) >> 5, d.map) * 32 + (n & 31);
            __builtin_nontemporal_store(o, (GAS v4u*)(d.WT + (size_t)drow * d.K + d.k0 + 16 * q)); }
    } else {
#pragma unroll
        for (int it = 0; it < 4; ++it) { const int k4 = it * 4 + ip;
#pragma unroll
            for (int j = 0; j < 4; ++j) { scr[(4 * c + j) * 33 + 2 * k4] = pk2(a[it * 4][j] * g[it * 4], a[it * 4 + 1][j] * g[it * 4 + 1]); scr[(4 * c + j) * 33 + 2 * k4 + 1] = pk2(a[it * 4 + 2][j] * g[it * 4 + 2], a[it * 4 + 3][j] * g[it * 4 + 3]); } }
        LDS_WAIT(); asm volatile("" ::: "memory");
#pragma unroll
        for (int it = 0; it < 8; ++it) { const int n = it * 8 + (lane >> 3), q = lane & 7;
            v4u o; o.x = scr[n * 33 + 4 * q]; o.y = scr[n * 33 + 4 * q + 1]; o.z = scr[n * 33 + 4 * q + 2]; o.w = scr[n * 33 + 4 * q + 3];
            const int drow = dest_block((d.n0 + n) >> 5, d.map) * 32 + (n & 31);
            __builtin_nontemporal_store(o, (GAS v4u*)(d.WT + ((size_t)drow * d.K + d.k0 + 8 * q) * 2)); }
    }
    LDS_WAIT(); asm volatile("" ::: "memory");
}
constexpr float AO8_SCALE = 16.f;
constexpr float W8_SCALE = 64.f;

#ifndef PROBE_MASK
#define PROBE_MASK 0
#endif
struct KArgs { const void* in[27]; float* out; unsigned char* ws; int ph_lo, ph_hi, flags, pad; };

struct KArgs;
__device__ __forceinline__ const void* karg_in(const KArgs& a, int k) { asm volatile("" : "+s"(k)); return a.in[k]; }
__global__ void __launch_bounds__(NTHR, 2) fwd_kernel(KArgs args) {
    extern __shared__ __attribute__((aligned(16))) unsigned char lds_raw[];
    LAS unsigned char* lds = (LAS unsigned char*)lds_raw;
    volatile LAS unsigned* MISC = (volatile LAS unsigned*)(lds + MISC_OFF);
    const int tid = threadIdx.x, lane = tid & 63, wave = __builtin_amdgcn_readfirstlane(tid >> 6);
    const int G = gridDim.x; const int bx = blockIdx.x; const int vcu = (G % 8 == 0) ? (bx % 8) * (G / 8) + bx / 8 : bx;
    unsigned char* ws = args.ws;
    unsigned* ctl = (unsigned*)ws;
    for (int u = tid; u < (LDS_BYTES - RING_BYTES) / 4; u += NTHR) ((LAS unsigned*)(lds + RING_BYTES))[u] = 0u;
    __syncthreads();
    XcdBarrier bar = xcd_barrier_post(ctl + CW_BAR, MISC + 8);
    const int lo = args.ph_lo, hi_ph = args.ph_hi;
#define IN(k) (lo <= (k) && (k) < hi_ph)
#define REP(k)
#define SEAM(k) do { if (IN(k) && IN((k) + 1)) xcd_barrier(bar); } while (0)
#define KIN(T, k) ((const T*)karg_in(args, (k)))
#define x_in KIN(float, 0)
#define positions KIN(int, 1)
#define ev_attn_norm KIN(float, 2)
#define ev_w_in KIN(float, 3)
#define ev_q_norm KIN(float, 4)
#define ev_k_norm KIN(float, 5)
#define ev_lq1 KIN(float, 6)
#define ev_lk1 KIN(float, 7)
#define ev_lq2 KIN(float, 8)
#define ev_lk2 KIN(float, 9)
#define ev_subln KIN(float, 10)
#define ev_w_out KIN(float, 11)
#define ev_ffn_norm KIN(float, 12)
#define ev_w_gate KIN(float, 13)
#define ev_w_up KIN(float, 14)
#define ev_w_down KIN(float, 15)
#define od_attn_norm KIN(float, 16)
#define od_w_qkv KIN(float, 17)
#define od_q_norm KIN(float, 18)
#define od_k_norm KIN(float, 19)
#define od_rel_bias KIN(float, 20)
#define od_w_out KIN(float, 21)
#define od_ffn_norm KIN(float, 22)
#define od_router KIN(float, 23)
#define od_we_gate KIN(float, 24)
#define od_we_up KIN(float, 25)
#define od_we_down KIN(float, 26)
    float* out = args.out;
    float* ss0 = (float*)(ws + WS_SS0); float* ss1 = (float*)(ws + WS_SS1); float* ss2 = (float*)(ws + WS_SS2); float* ss3 = (float*)(ws + WS_SS3);
    float* rope = (float*)(ws + WS_ROPE); unsigned* toksel = (unsigned*)(ws + WS_TOKSEL); float* tokgate = (float*)(ws + WS_TOKGATE);
    int* rowtok = (int*)(ws + WS_ROWTOK); float* rowgate = (float*)(ws + WS_ROWGATE); float* rowscale = (float*)(ws + WS_ROWSCALE);
    bf16* XB = (bf16*)(ws + WS_XB); bf16* AO = (bf16*)(ws + WS_AO); bf16* ACT0 = (bf16*)(ws + WS_ACT0); float* XF = (float*)(ws + WS_XF); bf16* OD = (bf16*)(ws + WS_XF);
    bf16* Win_t = (bf16*)(ws + WS_WIN); bf16* Wo0_t = (bf16*)(ws + WS_WO0); bf16* Wgu0_t = (bf16*)(ws + WS_WGU0); bf16* Wd0_t = (bf16*)(ws + WS_WD0);
    unsigned char* Wqkv8 = ws + WS_WQKV; unsigned char* Wo18 = ws + WS_WO1; unsigned char* XB8 = ws + WS_XB; unsigned char* AO8 = ws + WS_AO; unsigned char* WEgu8 = ws + WS_WEGU; unsigned char* WEd8 = ws + WS_WED;
    unsigned char* SORTA8 = ws + WS_SORTA; unsigned char* ACTE8 = ws + WS_ACTE;
    const int gw = vcu * NWAVES + wave, NGW = G * NWAVES;

    constexpr int I_IN = 16 * 48, I_O = 16 * 16, I_G = 16 * 44, I_D = 44 * 16, I_EG = 16 * 56, I_ED = 56 * 16;
    constexpr int NSMALL = I_IN + I_O + 2 * I_G + I_D + I_IN + I_O, NITEMS = NSMALL + 24 * I_EG;
        auto decode = [&](int it) -> TrItem {
        TrItem d; int r = it; d.scale = 1.f; d.fp8 = 0; d.gain = nullptr; d.map = 0;
        auto fin = [&](int nbl) { d.k0 = 64 * (r / nbl); d.n0 = 64 * (r % nbl); };
        if (r < I_IN) { d.W = ev_w_in; d.K = D; d.N = NPROJ; d.WT = (unsigned char*)Win_t; d.map = 1; d.gain = ev_attn_norm; fin(NPROJ / 64); return d; } r -= I_IN;
        if (r < I_O) { d.W = ev_w_out; d.K = D; d.N = D; d.WT = (unsigned char*)Wo0_t; fin(D / 64); return d; } r -= I_O;
        if (r < I_G) { d.W = ev_w_gate; d.K = D; d.N = FFD; d.WT = (unsigned char*)Wgu0_t; d.map = 2; d.gain = ev_ffn_norm; fin(FFD / 64); return d; } r -= I_G;
        if (r < I_G) { d.W = ev_w_up; d.K = D; d.N = FFD; d.WT = (unsigned char*)Wgu0_t; d.map = 3; d.gain = ev_ffn_norm; fin(FFD / 64); return d; } r -= I_G;
        if (r < I_D) { d.W = ev_w_down; d.K = FFD; d.N = D; d.WT = (unsigned char*)Wd0_t; fin(D / 64); return d; } r -= I_D;
        d.fp8 = 1; d.scale = W8_SCALE;
        if (r < I_IN) { d.W = od_w_qkv; d.K = D; d.N = NPROJ; d.WT = Wqkv8; d.map = 1; d.gain = od_attn_norm; fin(NPROJ / 64); return d; } r -= I_IN;
        if (r < I_O) { d.W = od_w_out; d.K = D; d.N = D; d.WT = Wo18; fin(D / 64); return d; } r -= I_O;
        const int which = r / (8 * I_EG), rr = r % (8 * I_EG), e2 = rr / I_EG; r = rr % I_EG;
        if (which == 0) { d.W = od_we_gate + (size_t)e2 * D * FFE; d.K = D; d.N = FFE; d.WT = WEgu8 + (size_t)e2 * 2 * FFE * D; d.map = 2; d.gain = od_ffn_norm; fin(FFE / 64); }
        else if (which == 1) { d.W = od_we_up + (size_t)e2 * D * FFE; d.K = D; d.N = FFE; d.WT = WEgu8 + (size_t)e2 * 2 * FFE * D; d.map = 3; d.gain = od_ffn_norm; fin(FFE / 64); }
        else { d.W = od_we_down + (size_t)e2 * FFE * D; d.K = FFE; d.N = D; d.WT = WEd8 + (size_t)e2 * D * FFE; fin(D / 64); }
        return d; };
    auto conv_range = [&](int first, int end, int stride) {
        LAS unsigned* scr = (LAS unsigned*)(lds + wave * 8704);
        f32x4 bufA[16], bufB[16]; float gA[16], gB[16]; TrItem dA, dB; int it = first;
        if (it < end) { dA = decode(it); tr_load(dA, bufA, gA, lane); }
        while (it < end) {
            const int it2 = it + stride, it3 = it2 + stride;
            if (it2 < end) { dB = decode(it2); tr_load(dB, bufB, gB, lane); }
            tr_emit(dA, bufA, gA, scr, lane);
            if (it3 < end) { dA = decode(it3); tr_load(dA, bufA, gA, lane); }
            if (it2 < end) tr_emit(dB, bufB, gB, scr, lane);
            it = it3; } };
    auto pull = [&](int qword) -> int {
        __syncthreads(); if (tid == 0) MISC[16] = __hip_atomic_fetch_add(ctl + qword, 1u, __ATOMIC_RELAXED, __HIP_MEMORY_SCOPE_AGENT); __syncthreads();
        return __builtin_amdgcn_readfirstlane((int)MISC[16]); };

    REP(0) if (IN(0)) {
        conv_range(gw, I_IN, NGW);
        for (int m0 = gw; m0 < T; m0 += 2 * NGW) {
            f32x4 v[2][4];
#pragma unroll
            for (int u = 0; u < 2; ++u) { const int m = m0 + u * NGW; if (m < T) { const GAS f32x4* xr = (const GAS f32x4*)(x_in + (size_t)m * D) + lane;
#pragma unroll
                for (int j = 0; j < 4; ++j) v[u][j] = __builtin_nontemporal_load(xr + 64 * j); } }
#pragma unroll
            for (int u = 0; u < 2; ++u) { const int m = m0 + u * NGW; if (m >= T) break; float s = 0.f;
#pragma unroll
                for (int j = 0; j < 4; ++j) s += (v[u][j].x * v[u][j].x + v[u][j].y * v[u][j].y) + (v[u][j].z * v[u][j].z + v[u][j].w * v[u][j].w);
                s = wave_sum(s); if (lane == 0) ss0[m] = s;
                GAS unsigned long long* o8 = (GAS unsigned long long*)(XB + (size_t)m * D) + lane;
#pragma unroll
                for (int j = 0; j < 4; ++j) o8[64 * j] = (unsigned long long)pk2(v[u][j].x, v[u][j].y) | ((unsigned long long)pk2(v[u][j].z, v[u][j].w) << 32); }
        }
        for (int i = vcu * NTHR + tid; i < T * 8; i += G * NTHR) {
            const int tok = i >> 3, f = i & 7;
            const double inv = (f == 0) ? 1.0 : (f == 1) ? 0.19392274474868576 : (f == 2) ? 0.03760603093086393 : (f == 3) ? 0.007292664737217109 : (f == 4) ? 0.001414213562373095 : (f == 5) ? 0.0002742481756762073 : (f == 6) ? 5.318295896944988e-05 : 1.031338537721246e-05;
            double ang = (double)positions[tok] * inv; ang -= 6.283185307179586 * rint(ang * 0.15915494309189535);
            float sn, cs; sincosf((float)ang, &sn, &cs);
            rope[(size_t)tok * 16 + f] = cs; rope[(size_t)tok * 16 + 8 + f] = sn;
        }
    }
    SEAM(0);

    LAS int* ulist = (LAS int*)(lds + ULIST_OFF);
    LAS float* rtab = (LAS float*)(lds + RTAB_OFF);
    const auto no_rows = [](const pg8::Unit&, int) { return 0.f; };
#define RUN_GEMM(EPI, ALIGN, F8, g, S, E, RT, ROWFN) do { pg8::build_unit_list((S), ulist, (RT), (ROWFN)); const pg8::ListOrder LO_{ulist}; pg8::gemm_phase<EPI, pg8::ListOrder, ALIGN, true, F8>(lds, (g), LO_, (E)); } while (0)
    REP(1) if (IN(1)) {
        pg8::Gemm g{XB, Win_t, T, NPROJ, D}; pg8::StaticOrder S; S.init(T, NPROJ, G, bx);
        pg8::EpiProj E{ACT0, T, ss0, 1, ev_q_norm, ev_k_norm, rope, 0, 1.f, rtab, ws + WS_VT8};
        const float* ssp = ss0; const auto rowfn = [ssp](const pg8::Unit& u, int lr) { return rsqrtf(ssp[u.pm * 256 + lr] * (1.f / 1024.f) + pg8::RMS_EPS); };
        RUN_GEMM(pg8::EpiProj, true, false, g, S, E, rtab, rowfn);
    }
    SEAM(1);

    REP(2) if (IN(2)) {
        const float gqm = wave_max(fabsf(ev_q_norm[lane])), gkm = wave_max(fabsf(ev_k_norm[lane]));
        const float mref = 8.f * gqm * gkm * pg8::LOG2E;
        constexpr int NJOBS = (NITEMS - I_IN + 63) / 64;
        const bool conv_first = ((bx >> 3) & 3) == 3;
#define P2_CONV_LOOP() for (;;) { const int j = pull(CW_QCONV); if (j >= NJOBS) break; \
            const int first = I_IN + j * 64 + wave * 8; conv_range(first, (first + 8 < NITEMS) ? first + 8 : NITEMS, 1); }
        if (conv_first) P2_CONV_LOOP()
#pragma unroll 1
        for (int kq = 0; kq < 8; ++kq) { const int xq = (bx + kq) & 7;
            for (;;) { const int idx = pull(CW_QATT + 64 * xq); if (idx >= 128) break;
                if (idx < 64) { if (args.flags & 1) continue;
                    const int bhm = 2 * xq + (idx & 1), qb = 31 - (idx >> 1);
                    const int b = bhm >> 3, hm = bhm & 7, h = hm >> 1;
                    const bf16* base = ACT0 + (size_t)b * SEQ * 64;
                    att::attn_unit_lag<0, 128, false, true>((LAS char*)lds, base + (size_t)(24 + hm) * T * 64, base + (size_t)(32 + hm) * T * 64, nullptr, OD + (size_t)b * SEQ * D + hm * 128, D, qb * 256, mref, nullptr, 1.f, ws + WS_VT8 + (size_t)(h * 128) * T + (size_t)b * SEQ);
                } else { if (args.flags & 2) continue;
                    const int bh = 2 * xq + (idx & 1), qb = 31 - ((idx - 64) >> 1);
                    const int b = bh >> 3, h = bh & 7;
                    const bf16* base = ACT0 + (size_t)b * SEQ * 64;
                    att::attn_unit<2, 64>((LAS char*)lds, base + (size_t)h * T * 64, base + (size_t)(8 + h) * T * 64, base + (size_t)(16 + h) * T * 64, AO + (size_t)b * SEQ * D + h * 64, D, qb * 256, 0.f, nullptr);
                }
            }
        }
        P2_CONV_LOOP()
#undef P2_CONV_LOOP
    }
    SEAM(2);

    REP(3) if (IN(3)) {
        const float a1 = wave_sum(ev_lq1[lane] * ev_lk1[lane]), a2 = wave_sum(ev_lq2[lane] * ev_lk2[lane]);
        const float lam_init = 0.2f, lam = expf(a1) - expf(a2) + lam_init;
        const int h = lane >> 4, v0 = (lane & 15) * 8;
        float sg[8];
#pragma unroll
        for (int j = 0; j < 8; ++j) sg[j] = ev_subln[v0 + j] * (1.f - lam_init);
        for (int m0 = gw; m0 < T; m0 += 4 * NGW) {
            v4u a4[4], b4[4];
#pragma unroll
            for (int u = 0; u < 4; ++u) { const int m = m0 + u * NGW; if (m < T) { a4[u] = *(const GAS v4u*)(OD + (size_t)m * D + (2 * h) * 128 + v0); b4[u] = *(const GAS v4u*)(OD + (size_t)m * D + (2 * h + 1) * 128 + v0); } }
#pragma unroll
            for (int u = 0; u < 4; ++u) { const int m = m0 + u * NGW; if (m >= T) break;
                const v4u a = a4[u], b = b4[u]; float d[8]; float s = 0.f;
#pragma unroll
                for (int j = 0; j < 4; ++j) { const unsigned ua = a[j], ub = b[j];
                    d[2 * j] = bf2f((unsigned short)(ua & 0xffffu)) - lam * bf2f((unsigned short)(ub & 0xffffu));
                    d[2 * j + 1] = bf2f((unsigned short)(ua >> 16)) - lam * bf2f((unsigned short)(ub >> 16));
                    s += d[2 * j] * d[2 * j] + d[2 * j + 1] * d[2 * j + 1]; }
                s += __shfl_xor(s, 1); s += __shfl_xor(s, 2); s += __shfl_xor(s, 4); s += __shfl_xor(s, 8);
                const float rs = rsqrtf(s * (1.f / 128.f) + pg8::RMS_EPS);
                v4u o; o.x = pk2(d[0] * rs * sg[0], d[1] * rs * sg[1]); o.y = pk2(d[2] * rs * sg[2], d[3] * rs * sg[3]); o.z = pk2(d[4] * rs * sg[4], d[5] * rs * sg[5]); o.w = pk2(d[6] * rs * sg[6], d[7] * rs * sg[7]);
                *(GAS v4u*)(AO + (size_t)m * D + 512 + h * 128 + v0) = o; }
        }
    }
    SEAM(3);

    REP(4) if (IN(4)) {
        pg8::Gemm g{AO, Wo0_t, T, D, D}; pg8::StaticOrder S; S.init(T, D, G, bx);
        pg8::EpiResid E{x_in, XF, XB, ss1, 1.f, nullptr};
        RUN_GEMM(pg8::EpiResid, false, false, g, S, E, (LAS float*)nullptr, no_rows);
    }
    SEAM(4);

    REP(5) if (IN(5)) {
        pg8::Gemm g{XB, Wgu0_t, T, 2 * FFD, D}; pg8::StaticOrder S; S.init(T, 2 * FFD, G, bx, (args.flags >> 9) & 1);
        pg8::EpiSwiglu<false> E{ACT0, FFD, ss1, 16, nullptr, 0, 2 * FFD / 256, 1.f, rtab};
        const float* ssp = ss1; const auto rowfn = [ssp](const pg8::Unit& u, int lr) { return rsqrtf(pg8::row_ss(ssp, 16, u.pm * 256 + lr) * (1.f / 1024.f) + pg8::RMS_EPS); };
        RUN_GEMM(pg8::EpiSwiglu<false>, true, false, g, S, E, rtab, rowfn);
    }
    SEAM(5);

    if (IN(6)) {
        pg8::Gemm g{ACT0, Wd0_t, T, D, FFD}; pg8::StaticOrder S; S.init(T, D, G, bx);
        pg8::EpiResid E{XF, XF, nullptr, ss2, 1.f, XB8};
        RUN_GEMM(pg8::EpiResid, false, false, g, S, E, (LAS float*)nullptr, no_rows);
    }
    SEAM(6);

    REP(7) if (IN(7)) {
        pg8::Gemm g{(const bf16*)XB8, (const bf16*)Wqkv8, T, NPROJ, D / 2}; pg8::StaticOrder S; S.init(T, NPROJ, G, bx);
        pg8::EpiProj E{ACT0, T, ss2, 16, od_q_norm, od_k_norm, nullptr, 1, 1.f / W8_SCALE, rtab, nullptr};
        const float* ssp = ss2; const auto rowfn = [ssp](const pg8::Unit& u, int lr) { return rsqrtf(pg8::row_ss(ssp, 16, u.pm * 256 + lr) * (1.f / 1024.f) + pg8::RMS_EPS); };
        RUN_GEMM(pg8::EpiProj, true, true, g, S, E, rtab, rowfn);
    }
    SEAM(7);

    REP(8) if (IN(8)) {
        const float gqm = wave_max(fabsf(od_q_norm[lane])), gkm = wave_max(fabsf(od_k_norm[lane]));
        for (int L = vcu; L < 1024; L += G) {
            const int bh = (L & 255) >> 3, qb = 4 * (L & 7) + (L >> 8);
            const int b = bh >> 4, h = bh & 15;
            const float* tab = od_rel_bias + h * 257;
            float tm = fabsf(tab[lane]); tm = fmaxf(tm, fabsf(tab[64 + lane])); tm = fmaxf(tm, fabsf(tab[128 + lane])); tm = fmaxf(tm, fabsf(tab[192 + lane])); tm = fmaxf(tm, fabsf(tab[256]));
            tm = wave_max(tm);
            const float mref = (8.f * gqm * gkm + tm) * pg8::LOG2E;
            const bf16* base = ACT0 + (size_t)b * SEQ * 64;
            att::attn_unit_lag<1, 64, true>((LAS char*)lds, base + (size_t)h * T * 64, base + (size_t)(16 + h) * T * 64, base + (size_t)(32 + h) * T * 64, AO8 + (size_t)b * SEQ * D + h * 64, D, qb * 256, mref, tab, AO8_SCALE);
        }
    }
    SEAM(8);

    REP(9) if (IN(9)) {
        pg8::Gemm g{(const bf16*)AO8, (const bf16*)Wo18, T, D, D / 2}; pg8::StaticOrder S; S.init(T, D, G, bx);
        pg8::EpiResid E{XF, out, nullptr, nullptr, 1.f / (W8_SCALE * AO8_SCALE), XB8};
        RUN_GEMM(pg8::EpiResid, false, true, g, S, E, (LAS float*)nullptr, no_rows);
    }
    SEAM(9);

    REP(10) if (IN(10)) {
        LAS float* wrT = (LAS float*)lds;
        LAS unsigned* sel = (LAS unsigned*)(lds + 32768);
        for (int i = tid; i < 1024; i += NTHR) { const float gn = od_ffn_norm[i]; const f32x4 w0 = *(const GAS f32x4*)(od_router + (size_t)i * 8), w1 = *(const GAS f32x4*)(od_router + (size_t)i * 8 + 4);
            wrT[i] = w0.x * gn; wrT[1024 + i] = w0.y * gn; wrT[2048 + i] = w0.z * gn; wrT[3072 + i] = w0.w * gn; wrT[4096 + i] = w1.x * gn; wrT[5120 + i] = w1.y * gn; wrT[6144 + i] = w1.z * gn; wrT[7168 + i] = w1.w * gn; }
        __syncthreads();
        for (int blk = vcu; blk < T / 64; blk += G) {
#pragma unroll 1
            for (int q4 = 0; q4 < 2; ++q4) {
                const int tk = lane >> 4, sub = lane & 15; const int tok = blk * 64 + wave * 8 + q4 * 4 + tk;
                const GAS f32x4* xr = (const GAS f32x4*)(out + (size_t)tok * D) + sub; float s = 0.f; float lg[8];
#pragma unroll
                for (int e2 = 0; e2 < 8; ++e2) lg[e2] = 0.f;
#pragma unroll
                for (int jh = 0; jh < 2; ++jh) { f32x4 xv[8];
#pragma unroll
                    for (int j = 0; j < 8; ++j) xv[j] = xr[16 * (8 * jh + j)];
#pragma unroll
                    for (int j = 0; j < 8; ++j) { const f32x4 v = xv[j]; s += (v.x * v.x + v.y * v.y) + (v.z * v.z + v.w * v.w);
#pragma unroll
                        for (int e2 = 0; e2 < 8; ++e2) { const f32x4 w = *(const LAS f32x4*)(wrT + e2 * 1024 + 64 * (8 * jh + j) + 4 * sub); lg[e2] += (v.x * w.x + v.y * w.y) + (v.z * w.z + v.w * w.w); } } }
#pragma unroll
                for (int o = 1; o < 16; o <<= 1) { s += __shfl_xor(s, o);
#pragma unroll
                    for (int e2 = 0; e2 < 8; ++e2) lg[e2] += __shfl_xor(lg[e2], o); }
                if (sub == 0) {
                    const float r = rsqrtf(s * (1.f / 1024.f) + pg8::RMS_EPS); ss3[tok] = s;
                    int e0 = 0; float v0 = lg[0];
#pragma unroll
                    for (int e2 = 1; e2 < 8; ++e2) if (lg[e2] > v0) { v0 = lg[e2]; e0 = e2; }
                    int e1 = -1; float v1 = 0.f;
#pragma unroll
                    for (int e2 = 0; e2 < 8; ++e2) if (e2 != e0 && (e1 < 0 || lg[e2] > v1)) { v1 = lg[e2]; e1 = e2; }
                    const float ex = expf((v1 - v0) * r), g0 = 1.f / (1.f + ex), g1 = ex / (1.f + ex);
                    sel[wave * 8 + q4 * 4 + tk] = (unsigned)e0 | ((unsigned)e1 << 8); tokgate[2 * tok] = g0; tokgate[2 * tok + 1] = g1;
                }
            }
            __syncthreads();
            if (wave == 0) { const unsigned sv = sel[lane]; const int e0 = sv & 0xff, e1 = sv >> 8; unsigned rank0 = 0, rank1 = 0;
                const unsigned long long lt = (1ull << lane) - 1ull;
#pragma unroll
                for (int e = 0; e < 8; ++e) { const unsigned long long m0 = __ballot(e0 == e), m1 = __ballot(e1 == e);
                    if (e0 == e) rank0 = __popcll(m0 & lt); if (e1 == e) rank1 = __popcll(m1 & lt);
                    if (lane == 0) { ctl[CW_HIST + blk * 16 + e] = __popcll(m0); ctl[CW_HIST + blk * 16 + 8 + e] = __popcll(m1); } }
                toksel[blk * 64 + lane] = sv | (rank0 << 16) | (rank1 << 24); }
            __syncthreads();
        }
    }
    SEAM(10);

    REP(11) if (IN(11)) {
        LAS unsigned* hs = (LAS unsigned*)lds;
        for (int i = tid; i < 4096; i += NTHR) hs[i] = ctl[CW_HIST + i];
        __syncthreads();
        if (tid < 16) hs[4096 + tid] = 0u;
        __syncthreads();
        { unsigned s = 0; const int g2 = tid & 15;
#pragma unroll
          for (int b2 = tid >> 4; b2 < 256; b2 += 32) s += hs[b2 * 16 + g2];
          atomicAdd((unsigned*)&hs[4096 + g2], s); }
        __syncthreads();
        if (tid == 0) { unsigned acc = 0; for (int g2 = 0; g2 < 16; ++g2) { hs[4128 + g2] = acc; acc += (hs[4096 + g2] + 255u) & ~255u; } hs[4128 + 16] = acc; }
        __syncthreads();
        if (bx == 0) {
            if (tid == 0) { const int nA = (int)(hs[4128 + 8] >> 8), nT = (int)(hs[4128 + 16] >> 8), nC1 = (nT - nA + 1) / 2, nC2 = nT - nA - nC1;
                ctl[CW_MOE] = nA; ctl[CW_MOE + 1] = nT;
                for (int ph = 0; ph < 2; ++ph) { const int nd = (ph == 0 ? nA : nC1) * (D / 256), nu = (ph == 0 ? nC1 : nC2) * (2 * FFE / 256);
                    int H = nd > G ? nd - G : (nd < G ? nd : 0); int mode = 1, R = 0; if (H >= G) H = 0;
                    pg8::MoeOrder::plan(nu, H, G, D / 128, FFE / 128, mode, R);
                    ctl[CW_MOE + 2 + 3 * ph] = H; ctl[CW_MOE + 3 + 3 * ph] = R; ctl[CW_MOE + 4 + 3 * ph] = mode; } }
            if (tid < 16) { const unsigned t0 = hs[4128 + tid] >> 8, t1 = hs[4128 + tid + 1] >> 8; for (unsigned t = t0; t < t1; ++t) ctl[CW_MOE + 16 + t] = tid & 7; }
        }
        for (int blk = vcu; blk < T / 64; blk += G) {
            if (tid < 16) hs[4160 + tid] = 0u;
            __syncthreads();
            { unsigned s = 0; const int g2 = tid & 15;
#pragma unroll
              for (int b2 = tid >> 4; b2 < 256; b2 += 32) s += (b2 < blk) ? hs[b2 * 16 + g2] : 0u;
              atomicAdd((unsigned*)&hs[4160 + g2], s); }
            __syncthreads();
            for (int tl = wave; tl < 64; tl += NWAVES) {
                const int tok = blk * 64 + tl; const unsigned sv = toksel[tok];
                const v4u pk = *(const GAS v4u*)(XB8 + (size_t)tok * D + 16 * lane);
#pragma unroll
                for (int sl = 0; sl < 2; ++sl) { const int e = (sv >> (8 * sl)) & 0xff, rank = (sv >> (16 + 8 * sl)) & 0xff, g2 = sl * 8 + e;
                    const unsigned srow = hs[4128 + g2] + hs[4160 + g2] + rank;
                    *(GAS v4u*)(SORTA8 + (size_t)srow * D + lane * 16) = pk;
                    if (lane == 0) { rowtok[srow] = tok; rowgate[srow] = tokgate[2 * tok + sl]; rowscale[srow] = rsqrtf(ss3[tok] * (1.f / 1024.f) + pg8::RMS_EPS); } }
            }
            __syncthreads();
        }
        for (int g2 = vcu; g2 < 16; g2 += G) {
            const unsigned r0 = hs[4128 + g2] + hs[4096 + g2], r1 = hs[4128 + g2 + 1];
            for (unsigned r = r0 + wave; r < r1; r += NWAVES) { if (lane == 0) { rowtok[r] = -1; rowgate[r] = 0.f; rowscale[r] = 0.f; }
                *(GAS v4u*)(SORTA8 + (size_t)r * D + lane * 16) = (v4u){0u, 0u, 0u, 0u}; }
        }
    }
    SEAM(11);

    if (IN(12) || IN(13) || IN(14) || IN(15)) {
        const int nA = (int)__builtin_amdgcn_readfirstlane(ctl[CW_MOE]), nT = (int)__builtin_amdgcn_readfirstlane(ctl[CW_MOE + 1]);
        const int nC1 = (nT - nA + 1) / 2, nC2 = nT - nA - nC1;
        const int* texp = (const int*)(ctl + CW_MOE + 16);
        unsigned char* const ACT_C0 = ACTE8; unsigned char* const ACT_C1 = ACTE8 + (size_t)63 * MiB; unsigned char* const ACT_C2 = ACT_C1 + (size_t)36 * 256 * FFE;
        constexpr int NPN_GU = 2 * FFE / 256, NPN_D = D / 256;
#define MOE_GU(TILE0, NTILE, ACTBUF, PLAN) do { int H_ = 0, R_ = 0, mode_ = 1; \
        if ((PLAN) >= 0) { H_ = (int)__builtin_amdgcn_readfirstlane(ctl[CW_MOE + 2 + 3 * (PLAN)]); R_ = (int)__builtin_amdgcn_readfirstlane(ctl[CW_MOE + 3 + 3 * (PLAN)]); mode_ = (int)__builtin_amdgcn_readfirstlane(ctl[CW_MOE + 4 + 3 * (PLAN)]); } \
        pg8::Gemm g{(const bf16*)(SORTA8 + (size_t)(TILE0) * 256 * D), (const bf16*)WEgu8, 0, 0, D / 2}; pg8::MoeOrder S; S.init((NTILE), NPN_GU, G, bx, (TILE0), texp, H_, R_, mode_); \
        pg8::EpiSwiglu<true> E{(ACTBUF), FFE, nullptr, 1, rowscale, (TILE0), NPN_GU, 1.f / W8_SCALE, rtab}; \
        const float* rsp_ = rowscale + (size_t)(TILE0) * 256; const auto rowfn_ = [rsp_](const pg8::Unit& u, int lr) { return rsp_[u.pm * 256 + lr]; }; \
        RUN_GEMM(pg8::EpiSwiglu<true>, true, true, g, S, E, rtab, rowfn_); } while (0)
#define MOE_DOWN(TILE0, NTILE, ACTBUF) do { pg8::Gemm g{(const bf16*)(ACTBUF), (const bf16*)WEd8, 0, 0, FFE / 2}; pg8::MoeOrder S; S.init((NTILE), NPN_D, G, bx, (TILE0), texp); \
        pg8::EpiMoeDown E{out, rowtok, rowgate, (TILE0), 1.f / W8_SCALE, (args.flags >> 2) & 1}; \
        RUN_GEMM(pg8::EpiMoeDown, true, true, g, S, E, (LAS float*)nullptr, no_rows); } while (0)
        if (IN(12)) MOE_GU(0, nA, ACT_C0, -1);
        SEAM(12);
        if (IN(13)) { MOE_DOWN(0, nA, ACT_C0); MOE_GU(nA, nC1, ACT_C1, 0); }
        SEAM(13);
        if (IN(14)) { MOE_DOWN(nA, nC1, ACT_C1); if (nC2 > 0) MOE_GU(nA + nC1, nC2, ACT_C2, 1); }
        SEAM(14);
        if (IN(15)) { if (nC2 > 0) MOE_DOWN(nA + nC1, nC2, ACT_C2); }
#undef MOE_GU
#undef MOE_DOWN
    }
#undef IN
#undef SEAM
#undef RUN_GEMM
#undef x_in
#undef positions
#undef ev_attn_norm
#undef ev_w_in
#undef ev_q_norm
#undef ev_k_norm
#undef ev_lq1
#undef ev_lk1
#undef ev_lq2
#undef ev_lk2
#undef ev_subln
#undef ev_w_out
#undef ev_ffn_norm
#undef ev_w_gate
#undef ev_w_up
#undef ev_w_down
#undef od_attn_norm
#undef od_w_qkv
#undef od_q_norm
#undef od_k_norm
#undef od_rel_bias
#undef od_w_out
#undef od_ffn_norm
#undef od_router
#undef od_we_gate
#undef od_we_up
#undef od_we_down
#undef KIN
}

constexpr int N_PHASES = 16;
extern "C" void kernel_launch(void* const* d_in, const int* in_sizes, int n_in, void* d_out, int out_size, void* d_ws, size_t ws_size, hipStream_t stream) {
    static int grid = 0;
    if (grid == 0) {
        if (n_in != 27 || out_size != T * D || ws_size < WS_END) { fprintf(stderr, "kernel_launch: unexpected problem (n_in %d, out %d, ws %zu)\n", n_in, out_size, ws_size); grid = -1; return; }
        int dev = 0, cus = 0, per_cu = 0;
        if (hipGetDevice(&dev) != hipSuccess || hipDeviceGetAttribute(&cus, hipDeviceAttributeMultiprocessorCount, dev) != hipSuccess) { grid = -1; return; }
        if (hipFuncSetAttribute((const void*)fwd_kernel, hipFuncAttributeMaxDynamicSharedMemorySize, LDS_BYTES) != hipSuccess) { fprintf(stderr, "kernel_launch: hipFuncSetAttribute failed\n"); grid = -1; return; }
        if (hipOccupancyMaxActiveBlocksPerMultiprocessor(&per_cu, (const void*)fwd_kernel, NTHR, LDS_BYTES) != hipSuccess || per_cu < 1) { fprintf(stderr, "kernel_launch: occupancy query says %d\n", per_cu); }
        (void)hipGetLastError();
        grid = cus;
    }
    if (grid < 0) return;
    (void)hipMemsetAsync(d_ws, 0, CTL_ZERO_BYTES, stream);
    KArgs a{};
    for (int i = 0; i < 27; ++i) a.in[i] = d_in[i];
    a.out = (float*)d_out; a.ws = (unsigned char*)d_ws; a.ph_lo = 0; a.ph_hi = N_PHASES;
    hipLaunchKernelGGL(fwd_kernel, dim3(grid), dim3(NTHR), LDS_BYTES, stream, a);
#if defined(PROBE_LO)
    (void)hipMemsetAsync((char*)d_ws + CW_BAR * 4, 0, XCD_BAR_WORDS * 4, stream); (void)hipMemsetAsync((char*)d_ws + CW_QATT * 4, 0, 4096, stream);
    a.ph_lo = PROBE_LO; a.ph_hi = PROBE_HI;
#if defined(PROBE_FLAGS)
    a.flags = PROBE_FLAGS;
#endif
    hipLaunchKernelGGL(fwd_kernel, dim3(grid), dim3(NTHR), LDS_BYTES, stream, a);
#endif
}
```

```cpp
#include <hip/hip_runtime.h>
#include <cstdio>
#include <cstdint>
#include <cmath>
#define PROBE_MASK 0x0
namespace pg8 {
#define PG8_LAS __attribute__((address_space(3)))
typedef unsigned short bf16_t;
typedef short bf16x8 __attribute__((ext_vector_type(8)));
typedef float f32x4 __attribute__((ext_vector_type(4)));
typedef unsigned u32x4 __attribute__((ext_vector_type(4)));
constexpr int BM = 256, BK = 64, HALF = 128, HTB = HALF * BK * 2  , STAGE_BYTES = 8 * HTB, NXCD = 8, WGM = 4;

__host__ __device__ __forceinline__ int lds_byte(int r, int c) { const int st = (r >> 4) * 2 + (c >> 5), rr = r & 15, cc = c & 31, ob = rr * 64 + cc * 2; return st * 1024 + (ob ^ (((ob >> 9) & 1) << 5)); }
__host__ __device__ __forceinline__ void stage_rc(int b, int& R, int& C) { const int st = b / 1024, sb = b % 1024, swz = sb ^ (((sb >> 9) & 1) << 5); R = (st >> 1) * 16 + swz / 64; C = (st & 1) * 32 + (swz % 64) / 2; }
__host__ __device__ __forceinline__ int perm32(int rho) { const int n = rho >> 4, i = rho & 15; return 8 * (i >> 2) + 4 * n + (i & 3); }

struct Unit { int pm, pn, aux; };
struct Gemm { const bf16_t* A; const bf16_t* Bt; int M, N, K; };

struct StaticOrder {
    int nM, nN, nwg, G, c, hot;
    __host__ __device__ void init(int M, int N, int G_, int c_, int hot_ = 0) { nM = M / BM; nN = N / BM; nwg = nM * nN; G = G_; c = c_; hot = hot_; }
    __host__ __device__ bool next(int i, Unit& u) const {
        const long L = (long)i * G + c; if (L >= nwg) return false;
        int wgid = (int)L; { const int q = nwg / NXCD, r = nwg % NXCD, xcd = wgid % NXCD, off = wgid / NXCD; wgid = (xcd < r ? xcd * (q + 1) : r * (q + 1) + (xcd - r) * q) + off; }
        const int nig = WGM * nN, gid = wgid / nig, fm = gid * WGM, gsz = (nM - fm) < WGM ? (nM - fm) : WGM;
        u.pm = fm + ((wgid % nig) % gsz); u.pn = (wgid % nig) / gsz; if (hot) { u.pm &= 3; u.pn = 0; } return true;
    }
    __device__ __forceinline__ void a_ready(const Unit&) const {}
    __device__ __forceinline__ void done(const Unit&) const {}
};

struct MoeOrder {
    int nM, nN, nwg, G, c, tile0; const int* tile_expert;
    int H, R, mode;
    __device__ void init(int ntiles, int npn, int G_, int c_, int tile0_, const int* te, int H_ = 0, int R_ = 0, int mode_ = 1) { nM = ntiles; nN = npn; nwg = nM * nN; G = G_; c = c_; tile0 = tile0_; tile_expert = te; H = H_; R = R_; mode = mode_; }
    __device__ static __forceinline__ void plan(int nu, int H, int G, int ucost, int extra, int& mode, int& R) {
        mode = 1; R = 0; if (H <= 0 || H >= G) return;
        const int rmax = (nu + (G - H) - 1) / (G - H); int best = 0x7fffffff;
        for (int r2 = 0; r2 <= rmax; ++r2) { const int rest = nu - r2 * (G - H) > 0 ? nu - r2 * (G - H) : 0;
            { const int light = ucost * r2, heavy = extra + ucost * ((rest + H - 1) / H); const int mk = light > heavy ? light : heavy; if (mk < best) { best = mk; mode = 1; R = r2; } }
            { const int sh = (rest + G - 1) / G; const int light = ucost * (r2 + sh), heavy = extra + ucost * sh; const int mk = light > heavy ? light : heavy; if (mk < best) { best = mk; mode = 2; R = r2; } } }
    }
    __device__ static __forceinline__ void plan_wave(int nu, int H, int G, int ucost, int extra, int lane, int& mode, int& R) {
        mode = 1; R = 0; if (H <= 0 || H >= G) return;
        const int rmax = (nu + (G - H) - 1) / (G - H); unsigned long long best = ~0ull;
        for (int r2 = lane; r2 <= rmax; r2 += 64) { const int rest = nu - r2 * (G - H) > 0 ? nu - r2 * (G - H) : 0;
            { const int light = ucost * r2, heavy = extra + ucost * ((rest + H - 1) / H); const int mk = light > heavy ? light : heavy; const unsigned long long key = ((unsigned long long)(unsigned)mk << 32) | (unsigned)(2 * r2); best = key < best ? key : best; }
            { const int sh = (rest + G - 1) / G; const int light = ucost * (r2 + sh), heavy = extra + ucost * sh; const int mk = light > heavy ? light : heavy; const unsigned long long key = ((unsigned long long)(unsigned)mk << 32) | (unsigned)(2 * r2 + 1); best = key < best ? key : best; } }
#pragma unroll
        for (int o = 1; o < 64; o <<= 1) { const unsigned lo = __shfl_xor((unsigned)best, o), hi = __shfl_xor((unsigned)(best >> 32), o); const unsigned long long other = ((unsigned long long)hi << 32) | lo; best = other < best ? other : best; }
        mode = (int)(best & 1ull) + 1; R = (int)((best & 0xffffffffull) >> 1);
    }
    __device__ bool next(int i, Unit& u) const {
        long L;
        if (H == 0) L = (long)i * G + c;
        else if (c >= H) { if (i < R) L = (long)i * (G - H) + (c - H); else if (mode == 2) L = (long)R * (G - H) + (long)(i - R) * G + c; else return false; }
        else L = (long)R * (G - H) + (long)i * (mode == 2 ? G : H) + c;
        if (L >= nwg) return false;
        int wgid = (int)L; { const int q = nwg / NXCD, r = nwg % NXCD, xcd = wgid % NXCD, off = wgid / NXCD; wgid = (xcd < r ? xcd * (q + 1) : r * (q + 1) + (xcd - r) * q) + off; }
        const int nig = WGM * nN, gid = wgid / nig, fm = gid * WGM, gsz = (nM - fm) < WGM ? (nM - fm) : WGM;
        u.pm = fm + ((wgid % nig) % gsz); const int pnl = (wgid % nig) / gsz;
        const int e = tile_expert[tile0 + u.pm];
        u.pn = e * nN + pnl; return true;
    }
    __device__ __forceinline__ void a_ready(const Unit&) const {}
    __device__ __forceinline__ void done(const Unit&) const {}
};

constexpr int MAX_UNITS = 64, RT_UNITS = 16;
template <class Sched, class RowFn> __device__ __forceinline__ void build_unit_list(const Sched& S, PG8_LAS int* list, PG8_LAS float* rtab, const RowFn& rowfn) {
    const int t = threadIdx.x;
    if (t < MAX_UNITS) { Unit u; u.pm = 0; u.pn = 0; u.aux = t; const bool ok = S.next(t, u); list[2 * t] = ok ? u.pm : -1; list[2 * t + 1] = u.pn; }
    __syncthreads();
    if (rtab) {
        const int r = t & 255, h = t >> 8;
#pragma unroll 1
        for (int ib = 0; ib < RT_UNITS && list[2 * ib] >= 0; ib += 8) { float v[4]; bool ok[4];
#pragma unroll
            for (int k = 0; k < 4; ++k) { const int i = ib + h + 2 * k; Unit u; u.pm = list[2 * i]; u.pn = list[2 * i + 1]; u.aux = i; ok[k] = u.pm >= 0; if (!ok[k]) { u.pm = 0; u.pn = 0; } v[k] = rowfn(u, r); }
#pragma unroll
            for (int k = 0; k < 4; ++k) if (ok[k]) rtab[(ib + h + 2 * k) * 256 + r] = v[k]; }
        __syncthreads();
    }
}
struct ListOrder {
    const PG8_LAS int* list;
    __device__ __forceinline__ bool next(int i, Unit& u) const {
        if (i >= MAX_UNITS) return false;
        const int pm = __builtin_amdgcn_readfirstlane(list[2 * i]); if (pm < 0) return false;
        u.pm = pm; u.pn = __builtin_amdgcn_readfirstlane(list[2 * i + 1]); u.aux = i; return true; }
    __device__ __forceinline__ void a_ready(const Unit&) const {}
    __device__ __forceinline__ void done(const Unit&) const {}
};

__device__ __forceinline__ unsigned cvt_pk_bf16(float lo, float hi) { unsigned r; asm volatile("v_cvt_pk_bf16_f32 %0, %1, %2" : "=v"(r) : "v"(lo), "v"(hi)); return r; }
__device__ __forceinline__ u32x4 pack8(const f32x4& a, const f32x4& b) { u32x4 w; w.x = cvt_pk_bf16(a[0], a[1]); w.y = cvt_pk_bf16(a[2], a[3]); w.z = cvt_pk_bf16(b[0], b[1]); w.w = cvt_pk_bf16(b[2], b[3]); return w; }
__device__ __forceinline__ unsigned pk4_fp8(float a, float b, float c, float d) { int w = __builtin_amdgcn_cvt_pk_fp8_f32(a, b, 0, false); w = __builtin_amdgcn_cvt_pk_fp8_f32(c, d, w, true); return (unsigned)w; }
constexpr float RMS_EPS = 1e-6f;
constexpr float LOG2E = 1.4426950408889634f;
constexpr float C2 = 0.125f * LOG2E;
__device__ __forceinline__ float row_ss(const float* ss, int nparts, int row) {
    if (nparts == 1) return ss[row];
    const f32x4* p = (const f32x4*)(ss + (size_t)row * 16); f32x4 a = p[0], b = p[1], c = p[2], d = p[3]; a = (a + b) + (c + d); return (a[0] + a[1]) + (a[2] + a[3]);
}

struct EpiProj {
    static constexpr bool PERM = true, AFTER_DRAIN = false;
    bf16_t* O; int ldc; const float* ss; int nparts; const float* gq; const float* gk; const float* rope; int layer; float pre; const PG8_LAS float* rtab; unsigned char* vt8;
    __device__ __forceinline__ void operator()(const f32x4 (&acc)[2][2][4][2], const Unit& u, int wr, int wc, int fr, int fq) const {
        const int pn = u.pn; int kind = 0; float scale = 1.f; bool rope_on = false;
        if (layer == 0) { const int t = pn >> 1; if (t == 0) scale = C2; else if (t == 3) { kind = 1; scale = C2; rope_on = true; } else if (t == 4) { kind = 2; rope_on = true; } }
        else { const int t = pn >> 2; if (t == 0) { kind = 1; scale = C2; } else if (t == 1) kind = 2; }
        const float* gv = (kind == 1) ? gq : gk;
        f32x4 g[2][2];
#pragma unroll
        for (int bj = 0; bj < 2; ++bj)
#pragma unroll
            for (int n = 0; n < 2; ++n) g[bj][n] = kind ? *(const f32x4*)(gv + 32 * bj + 8 * fq + 4 * n) : (f32x4){1.f, 1.f, 1.f, 1.f};
        const int row0 = u.pm * BM + wr * 64 + fr, col0 = pn * BM + wc * 64 + 8 * fq;
#pragma unroll
        for (int ai = 0; ai < 2; ++ai)
#pragma unroll
            for (int m = 0; m < 4; ++m) {
                const int row = row0 + ai * HALF + m * 16;
                const float r = (u.aux < RT_UNITS) ? rtab[u.aux * 256 + wr * 64 + fr + ai * HALF + m * 16] * pre : rsqrtf(row_ss(ss, nparts, row) * (1.f / 1024.f) + RMS_EPS) * pre;
                f32x4 v[2][2]; float s = 0.f;
#pragma unroll
                for (int bj = 0; bj < 2; ++bj)
#pragma unroll
                    for (int n = 0; n < 2; ++n) { v[bj][n] = acc[ai][bj][m][n] * r; const f32x4 x = v[bj][n]; s += (x[0] * x[0] + x[1] * x[1]) + (x[2] * x[2] + x[3] * x[3]); }
                if (kind) {
                    s += __shfl_xor(s, 16); s += __shfl_xor(s, 32);
                    const float rs = rsqrtf(s * (1.f / 64.f) + RMS_EPS);
#pragma unroll
                    for (int bj = 0; bj < 2; ++bj)
#pragma unroll
                        for (int n = 0; n < 2; ++n) v[bj][n] = v[bj][n] * rs * g[bj][n];
                    if (rope_on) {
                        f32x4 p[2];
#pragma unroll
                        for (int n = 0; n < 2; ++n)
#pragma unroll
                            for (int j = 0; j < 4; ++j) p[n][j] = __shfl_xor(v[0][n][j], 16);
                        const f32x4 c0 = *(const f32x4*)(rope + (size_t)row * 16), c1 = *(const f32x4*)(rope + (size_t)row * 16 + 4);
                        const f32x4 s0 = *(const f32x4*)(rope + (size_t)row * 16 + 8), s1 = *(const f32x4*)(rope + (size_t)row * 16 + 12);
                        if (fq == 0) { v[0][0] = v[0][0] * c0 - p[0] * s0; v[0][1] = v[0][1] * c1 - p[1] * s1; }
                        else if (fq == 1) { v[0][0] = v[0][0] * c0 + p[0] * s0; v[0][1] = v[0][1] * c1 + p[1] * s1; }
                    }
                }
                if (vt8 && layer == 0 && (pn >> 1) == 5) {
                    const int kv = row & 63, ptok = (row & ~63) + 32 * ((kv >> 2) & 1) + (kv & 3) + 4 * ((kv >> 3) & 3) + 16 * (kv >> 5);
                    unsigned char* vp = vt8 + (size_t)((pn * 4 + wc - 40) * 64 + 8 * fq) * ldc + ptok;
#pragma unroll
                    for (int bj = 0; bj < 2; ++bj)
#pragma unroll
                        for (int n = 0; n < 2; ++n)
#pragma unroll
                            for (int j = 0; j < 4; ++j) { const float x = v[bj][n][j]; vp[(size_t)(32 * bj + 4 * n + j) * ldc] = (unsigned char)(__builtin_amdgcn_cvt_pk_fp8_f32(x, x, 0, false) & 0xff); }
                    continue;
                }
                bf16_t* rowp = O + ((size_t)(pn * 4 + wc) * ldc + row) * 64 + 8 * fq;
#pragma unroll
                for (int bj = 0; bj < 2; ++bj) *(u32x4*)(rowp + 32 * bj) = pack8(v[bj][0] * scale, v[bj][1] * scale);
            }
    }
};

struct EpiResid {
    static constexpr bool PERM = true, AFTER_DRAIN = false;
    const float* base; const bf16_t* baseb; float* out; bf16_t* xb; float* ss; float pre; unsigned char* x8;
    __device__ __forceinline__ void operator()(const f32x4 (&acc)[2][2][4][2], const Unit& u, int wr, int wc, int fr, int fq) const {
        const int row0 = u.pm * BM + wr * 64 + fr, col0 = u.pn * BM + wc * 32 + 8 * fq;
#pragma unroll
        for (int rp = 0; rp < 4; ++rp) {
            const int ai = rp >> 1; f32x4 bv[2][2][2];
            if (base) {
#pragma unroll
                for (int mm = 0; mm < 2; ++mm)
#pragma unroll
                    for (int bj = 0; bj < 2; ++bj) { const size_t off = (size_t)(row0 + ai * HALF + ((rp & 1) * 2 + mm) * 16) * 1024 + col0 + bj * HALF; bv[mm][bj][0] = *(const f32x4*)(base + off); bv[mm][bj][1] = *(const f32x4*)(base + off + 4); }
            } else { u32x4 bw[2][2];
#pragma unroll
                for (int mm = 0; mm < 2; ++mm)
#pragma unroll
                    for (int bj = 0; bj < 2; ++bj) { const size_t off = (size_t)(row0 + ai * HALF + ((rp & 1) * 2 + mm) * 16) * 1024 + col0 + bj * HALF; bw[mm][bj] = *(const u32x4*)(baseb + off); }
#pragma unroll
                for (int mm = 0; mm < 2; ++mm)
#pragma unroll
                    for (int bj = 0; bj < 2; ++bj)
#pragma unroll
                        for (int q = 0; q < 4; ++q) { const unsigned w = bw[mm][bj][q]; bv[mm][bj][q >> 1][(2 * q) & 3] = __builtin_bit_cast(float, w << 16); bv[mm][bj][q >> 1][(2 * q + 1) & 3] = __builtin_bit_cast(float, w & 0xffff0000u); }
            }
#pragma unroll
            for (int mm = 0; mm < 2; ++mm) { const int m = (rp & 1) * 2 + mm;
                const int row = row0 + ai * HALF + m * 16; float s = 0.f;
#pragma unroll
                for (int bj = 0; bj < 2; ++bj) {
                    const size_t off = (size_t)row * 1024 + col0 + bj * HALF;
                    const f32x4 v0 = acc[ai][bj][m][0] * pre + bv[mm][bj][0], v1 = acc[ai][bj][m][1] * pre + bv[mm][bj][1];
                    if (out) { *(f32x4*)(out + off) = v0; *(f32x4*)(out + off + 4) = v1; }
                    if (xb) *(u32x4*)(xb + off) = pack8(v0, v1);
                    if (x8) { typedef unsigned u32x2 __attribute__((ext_vector_type(2))); u32x2 w8; w8.x = pk4_fp8(v0[0], v0[1], v0[2], v0[3]); w8.y = pk4_fp8(v1[0], v1[1], v1[2], v1[3]); *(u32x2*)(x8 + off) = w8; }
                    s += (v0[0] * v0[0] + v0[1] * v0[1]) + (v0[2] * v0[2] + v0[3] * v0[3]) + (v1[0] * v1[0] + v1[1] * v1[1]) + (v1[2] * v1[2] + v1[3] * v1[3]);
                }
                if (ss) { s += __shfl_xor(s, 16); s += __shfl_xor(s, 32); if (fq == 0) ss[(size_t)row * 16 + u.pn * 4 + wc] = s; }
            }
        }
    }
};

template <bool OUT8> struct EpiSwiglu {
    static constexpr bool PERM = true, AFTER_DRAIN = false;
    void* O; int ldc; const float* ss; int nparts; const float* rowscale; int tile0; int npn; float pre; const PG8_LAS float* rtab;
    __device__ __forceinline__ void operator()(const f32x4 (&acc)[2][2][4][2], const Unit& u, int wr, int wc, int fr, int fq) const {
        const int pnl = u.pn % npn; const int row0 = u.pm * BM + wr * 64 + fr, col0 = pnl * HALF + wc * 32 + 8 * fq;
#pragma unroll
        for (int ai = 0; ai < 2; ++ai)
#pragma unroll
            for (int m = 0; m < 4; ++m) {
                const int row = row0 + ai * HALF + m * 16;
                const float r = (u.aux < RT_UNITS) ? rtab[u.aux * 256 + wr * 64 + fr + ai * HALF + m * 16] * pre : (rowscale ? rowscale[tile0 * BM + row] * pre : rsqrtf(row_ss(ss, nparts, row) * (1.f / 1024.f) + RMS_EPS) * pre);
                f32x4 a[2]; const float rl = -r * LOG2E, ir2 = __builtin_amdgcn_rcpf(r * r);
#pragma unroll
                for (int n = 0; n < 2; ++n) { const f32x4 gq = acc[ai][0][m][n], t = gq * rl; f32x4 d;
#pragma unroll
                    for (int j = 0; j < 4; ++j) d[j] = __builtin_amdgcn_rcpf(__builtin_fmaf(__builtin_amdgcn_exp2f(t[j]), ir2, ir2));
                    a[n] = (gq * acc[ai][1][m][n]) * d; }
                if constexpr (OUT8) { typedef unsigned u32x2 __attribute__((ext_vector_type(2))); u32x2 w; w.x = pk4_fp8(a[0][0], a[0][1], a[0][2], a[0][3]); w.y = pk4_fp8(a[1][0], a[1][1], a[1][2], a[1][3]); *(u32x2*)((unsigned char*)O + (size_t)row * ldc + col0) = w; }
                else *(u32x4*)((bf16_t*)O + (size_t)row * ldc + col0) = pack8(a[0], a[1]);
            }
    }
};

struct EpiMoeDown {
    static constexpr bool PERM = true, AFTER_DRAIN = false;
    float* out; bf16_t* xb; const int* rowtok; const float* rowgate; int tile0; float pre; int nostore; int last;
    __device__ __forceinline__ void operator()(const f32x4 (&acc)[2][2][4][2], const Unit& u, int wr, int wc, int fr, int fq) const {
        const int pnl = u.pn & 3; const int row0 = (tile0 + u.pm) * BM + wr * 64 + fr, col0 = pnl * BM + wc * 32 + 8 * fq;
        int tk[2][4]; float gt[2][4];
#pragma unroll
        for (int ai = 0; ai < 2; ++ai)
#pragma unroll
            for (int m = 0; m < 4; ++m) { const int srow = row0 + ai * HALF + m * 16; tk[ai][m] = nostore ? -1 : rowtok[srow]; gt[ai][m] = rowgate[srow] * pre; }
#pragma unroll
        for (int rp = 0; rp < 4; ++rp) { const int ai = rp >> 1; u32x4 ow[2][2];
#pragma unroll
            for (int mm = 0; mm < 2; ++mm) { const int m = (rp & 1) * 2 + mm; const int tc = tk[ai][m] > 0 ? tk[ai][m] : 0;
#pragma unroll
                for (int bj = 0; bj < 2; ++bj) ow[mm][bj] = *(const u32x4*)(xb + (size_t)tc * 1024 + col0 + bj * HALF); }
#pragma unroll
            for (int mm = 0; mm < 2; ++mm) { const int m = (rp & 1) * 2 + mm;
                if (tk[ai][m] >= 0) {
#pragma unroll
                    for (int bj = 0; bj < 2; ++bj) { f32x4 v[2];
#pragma unroll
                        for (int q = 0; q < 4; ++q) { const unsigned w = ow[mm][bj][q]; v[q >> 1][(2 * q) & 3] = __builtin_bit_cast(float, w << 16); v[q >> 1][(2 * q + 1) & 3] = __builtin_bit_cast(float, w & 0xffff0000u); }
                        v[0] = v[0] + acc[ai][bj][m][0] * gt[ai][m]; v[1] = v[1] + acc[ai][bj][m][1] * gt[ai][m];
                        const size_t off = (size_t)tk[ai][m] * 1024 + col0 + bj * HALF;
                        if (last) { __builtin_nontemporal_store(v[0], (f32x4*)(out + off)); __builtin_nontemporal_store(v[1], (f32x4*)(out + off + 4)); }
                        else *(u32x4*)(xb + off) = pack8(v[0], v[1]); } } }
        }
    }
};

typedef int i32x4 __attribute__((ext_vector_type(4)));
typedef int i32x8 __attribute__((ext_vector_type(8)));
template <class Epi, class Sched, bool ALIGN_EPI = false, bool SP2 = false, bool F8 = false>
__device__ __forceinline__ void gemm_phase(PG8_LAS unsigned char* lds, const Gemm g, const Sched& S, const Epi& E) {
    const int tid = threadIdx.x, wid = __builtin_amdgcn_readfirstlane(tid >> 6), lane = tid & 63, wr = wid >> 2, wc = wid & 3, fr = lane & 15, fq = lane >> 4;
    const int K = g.K, nt = K / BK;
    unsigned voffA[2], voffB[2];
#pragma unroll
    for (int i = 0; i < 2; ++i) { int R, C; stage_rc(tid * 16 + i * 8192, R, C); const int Rb = Epi::PERM ? ((R & ~31) + perm32(R & 31)) : R;
        voffA[i] = (unsigned)(R * K + C) * 2u; voffB[i] = (unsigned)(Rb * K + C) * 2u; }
    const size_t kstep = (size_t)(BK * 2);
    const size_t hstep = (size_t)HALF * K * 2;
    const size_t tstep = 2 * hstep;
    const unsigned ldsw = (unsigned)wid * 1024u;
    const int aoff = lds_byte(wr * 64 + fr, fq * 8), boff = lds_byte(wc * 32 + fr, fq * 8);
#define PG8_SA(b, h) (((b) * 2 + (h)) * HTB)
#define PG8_SB(b, h) ((4 + (b) * 2 + (h)) * HTB)
#define PG8_STAGE(bufoff, gbase, voff) do { _Pragma("unroll") for (int _i = 0; _i < 2; ++_i) \
        __builtin_amdgcn_global_load_lds((const unsigned*)((const char*)(gbase) + (voff)[_i]), (PG8_LAS unsigned*)(lds + (bufoff) + ldsw + _i * 8192), 16, 0, 0); } while (0)
#define PG8_LDA(dst, b, h) do { if constexpr (F8) { _Pragma("unroll") for (int m = 0; m < 4; ++m) dst##8[m] = PG8_CAT(*(const PG8_LAS bf16x8*)(lds + PG8_SA(b, h) + aoff + m * 2048), *(const PG8_LAS bf16x8*)(lds + PG8_SA(b, h) + aoff + m * 2048 + 1024)); } \
        else { _Pragma("unroll") for (int m = 0; m < 4; ++m) _Pragma("unroll") for (int k = 0; k < 2; ++k) dst[m][k] = *(const PG8_LAS bf16x8*)(lds + PG8_SA(b, h) + aoff + m * 2048 + k * 1024); } } while (0)
#define PG8_LDB(dst, b, h) do { if constexpr (F8) { _Pragma("unroll") for (int n = 0; n < 2; ++n) dst##8[n] = PG8_CAT(*(const PG8_LAS bf16x8*)(lds + PG8_SB(b, h) + boff + n * 2048), *(const PG8_LAS bf16x8*)(lds + PG8_SB(b, h) + boff + n * 2048 + 1024)); } \
        else { _Pragma("unroll") for (int n = 0; n < 2; ++n) _Pragma("unroll") for (int k = 0; k < 2; ++k) dst[n][k] = *(const PG8_LAS bf16x8*)(lds + PG8_SB(b, h) + boff + n * 2048 + k * 1024); } } while (0)
#define PG8_CAT(x, y) __builtin_shufflevector(__builtin_bit_cast(i32x4, (x)), __builtin_bit_cast(i32x4, (y)), 0, 1, 2, 3, 4, 5, 6, 7)
#define PG8_MMA(ai, bj, At, Bt) do { __builtin_amdgcn_s_setprio(1); _Pragma("unroll") for (int m = 0; m < 4; ++m) _Pragma("unroll") for (int n = 0; n < 2; ++n) { \
        if constexpr (F8) { asm volatile("v_mfma_f32_16x16x128_f8f6f4 %0, %1, %2, %0" : "+v"(acc[ai][bj][m][n]) : "v"(Bt##8[n]), "v"(At##8[m])); } \
        else { _Pragma("unroll") for (int k = 0; k < 2; ++k) acc[ai][bj][m][n] = __builtin_amdgcn_mfma_f32_16x16x32_bf16(Bt[n][k], At[m][k], acc[ai][bj][m][n], 0, 0, 0); } } __builtin_amdgcn_s_setprio(0); } while (0)
#define PG8_WAIT_V(n) asm volatile("s_waitcnt vmcnt(" #n ")" ::: "memory")
#define PG8_WAIT_L(n) asm volatile("s_waitcnt lgkmcnt(" #n ")" ::: "memory")
#define PG8_BAR __builtin_amdgcn_s_barrier()
#define PG8_SCHED __builtin_amdgcn_sched_barrier(0)
    Unit cur, nxt; int ui = 0;
    if (!S.next(0, cur)) return;
    f32x4 acc[2][2][4][2];
#pragma unroll
    for (int a = 0; a < 2; ++a)
#pragma unroll
        for (int b = 0; b < 2; ++b)
#pragma unroll
            for (int m = 0; m < 4; ++m)
#pragma unroll
                for (int n = 0; n < 2; ++n) acc[a][b][m][n] = (f32x4){0.f, 0.f, 0.f, 0.f};
    bf16x8 At[4][2], B0[2][2], B1[2][2];
    i32x8 At8[4], B08[2], B18[2];
    const char* cA = (const char*)g.A + (size_t)cur.pm * tstep; const char* cB = (const char*)g.Bt + (size_t)cur.pn * tstep;
    S.a_ready(cur);
    if constexpr (SP2) {
        PG8_STAGE(PG8_SB(0, 0), cB, voffB); PG8_STAGE(PG8_SB(0, 1), cB + hstep, voffB); PG8_STAGE(PG8_SA(0, 0), cA, voffA); PG8_STAGE(PG8_SA(0, 1), cA + hstep, voffA);
        if (wr == 1) PG8_BAR;
        PG8_WAIT_V(2); PG8_BAR;
        PG8_STAGE(PG8_SB(1, 0), cB + kstep, voffB); PG8_STAGE(PG8_SA(1, 0), cA + kstep, voffA); PG8_STAGE(PG8_SB(1, 1), cB + hstep + kstep, voffB);
        PG8_WAIT_V(6); PG8_BAR;
    } else {
        PG8_STAGE(PG8_SB(0, 0), cB, voffB); PG8_STAGE(PG8_SA(0, 0), cA, voffA); PG8_STAGE(PG8_SB(0, 1), cB + hstep, voffB); PG8_STAGE(PG8_SA(0, 1), cA + hstep, voffA);
        if (wr == 1) PG8_BAR;
        PG8_WAIT_V(4); PG8_BAR;
        PG8_STAGE(PG8_SB(1, 0), cB + kstep, voffB); PG8_STAGE(PG8_SA(1, 0), cA + kstep, voffA); PG8_STAGE(PG8_SB(1, 1), cB + hstep + kstep, voffB);
        PG8_WAIT_V(6); PG8_BAR;
    }
    for (;;) {
        const bool has_next = S.next(ui + 1, nxt);
        const char* nA = has_next ? (const char*)g.A + (size_t)nxt.pm * tstep : cA; const char* nB = has_next ? (const char*)g.Bt + (size_t)nxt.pn * tstep : cB;
#pragma nounroll
        for (int t = 0; t < nt; t += 2) {
            const bool last = (t == nt - 2);
            const char* a1 = cA + (size_t)(t + 1) * kstep;
            const char* a2 = last ? nA : cA + (size_t)(t + 2) * kstep; const char* b2 = last ? nB : cB + (size_t)(t + 2) * kstep;
            const char* a3 = a2 + kstep; const char* b3 = b2 + kstep;
            if (last && has_next) S.a_ready(nxt);
            if constexpr (SP2) {
            PG8_LDB(B0, 0, 0); PG8_LDB(B1, 0, 1); PG8_SCHED; PG8_LDA(At, 0, 0); PG8_STAGE(PG8_SA(1, 1), a1 + hstep, voffA);
            PG8_WAIT_V(8); PG8_WAIT_L(0); PG8_BAR; PG8_MMA(0, 0, At, B0); PG8_MMA(0, 1, At, B1); PG8_BAR; PG8_SCHED;
            PG8_LDA(At, 0, 1); PG8_STAGE(PG8_SB(0, 0), b2, voffB); PG8_STAGE(PG8_SB(0, 1), b2 + hstep, voffB); PG8_STAGE(PG8_SA(0, 0), a2, voffA);
            PG8_WAIT_V(8); PG8_WAIT_L(0); PG8_BAR; PG8_MMA(1, 0, At, B0); PG8_MMA(1, 1, At, B1); PG8_BAR; PG8_SCHED;
            PG8_LDB(B0, 1, 0); PG8_LDB(B1, 1, 1); PG8_SCHED; PG8_LDA(At, 1, 0); PG8_STAGE(PG8_SA(0, 1), a2 + hstep, voffA);
            PG8_WAIT_V(8); PG8_WAIT_L(0); PG8_BAR; PG8_MMA(0, 0, At, B0); PG8_MMA(0, 1, At, B1); PG8_BAR; PG8_SCHED;
            PG8_LDA(At, 1, 1); PG8_STAGE(PG8_SB(1, 0), b3, voffB); PG8_STAGE(PG8_SB(1, 1), b3 + hstep, voffB); PG8_STAGE(PG8_SA(1, 0), a3, voffA);
            PG8_WAIT_V(8); PG8_WAIT_L(0); PG8_BAR; PG8_MMA(1, 0, At, B0); PG8_MMA(1, 1, At, B1); PG8_BAR; PG8_SCHED;
            } else {
            PG8_LDB(B0, 0, 0); PG8_SCHED; PG8_LDA(At, 0, 0); PG8_STAGE(PG8_SA(1, 1), a1 + hstep, voffA);
            PG8_WAIT_L(8); PG8_BAR; PG8_WAIT_L(0); PG8_MMA(0, 0, At, B0); PG8_BAR; PG8_SCHED;
            PG8_LDB(B1, 0, 1); PG8_STAGE(PG8_SB(0, 0), b2, voffB);
            PG8_BAR; PG8_WAIT_L(0); PG8_MMA(0, 1, At, B1); PG8_BAR;
            PG8_LDA(At, 0, 1); PG8_STAGE(PG8_SA(0, 0), a2, voffA);
            PG8_BAR; PG8_WAIT_L(0); PG8_MMA(1, 0, At, B0); PG8_BAR; PG8_SCHED;
            PG8_STAGE(PG8_SB(0, 1), b2 + hstep, voffB);
            PG8_WAIT_V(6); PG8_BAR; PG8_MMA(1, 1, At, B1); PG8_BAR;
            PG8_LDB(B0, 1, 0); PG8_SCHED; PG8_LDA(At, 1, 0); PG8_STAGE(PG8_SA(0, 1), a2 + hstep, voffA);
            PG8_WAIT_L(8); PG8_BAR; PG8_WAIT_L(0); PG8_MMA(0, 0, At, B0); PG8_BAR; PG8_SCHED;
            PG8_LDB(B1, 1, 1); PG8_STAGE(PG8_SB(1, 0), b3, voffB);
            PG8_BAR; PG8_WAIT_L(0); PG8_MMA(0, 1, At, B1); PG8_BAR;
            PG8_LDA(At, 1, 1); PG8_STAGE(PG8_SA(1, 0), a3, voffA);
            PG8_BAR; PG8_WAIT_L(0); PG8_MMA(1, 0, At, B0); PG8_BAR; PG8_SCHED;
            PG8_STAGE(PG8_SB(1, 1), b3 + hstep, voffB);
            PG8_WAIT_V(6); PG8_BAR; PG8_MMA(1, 1, At, B1); PG8_BAR;
            }
        }
        if constexpr (F8) asm volatile("s_nop 15\n\ts_nop 15\n\ts_nop 15" ::: "memory");
        if constexpr (ALIGN_EPI) { if (wr == 0) PG8_BAR; }
        if constexpr (!Epi::AFTER_DRAIN) { E(acc, cur, wr, wc, fr, fq); S.done(cur); }
        if (!has_next) break;
#pragma unroll
        for (int a = 0; a < 2; ++a)
#pragma unroll
            for (int b = 0; b < 2; ++b)
#pragma unroll
                for (int m = 0; m < 4; ++m)
#pragma unroll
                    for (int n = 0; n < 2; ++n) acc[a][b][m][n] = (f32x4){0.f, 0.f, 0.f, 0.f};
        cur = nxt; cA = nA; cB = nB; ++ui;
        if constexpr (ALIGN_EPI) { if (wr == 1) PG8_BAR; }
    }
    PG8_WAIT_V(0);
    if constexpr (!ALIGN_EPI) { if (wr == 0) PG8_BAR; }
    PG8_BAR;
    if constexpr (Epi::AFTER_DRAIN) { E.fused(acc, cur, wr, wc, fr, fq, lds, wid, lane); S.done(cur); }
#undef PG8_SA
#undef PG8_SB
#undef PG8_STAGE
#undef PG8_LDA
#undef PG8_LDB
#undef PG8_MMA
#undef PG8_CAT
#undef PG8_WAIT_V
#undef PG8_WAIT_L
#undef PG8_BAR
#undef PG8_SCHED
}
}

namespace att {
using pg8::bf16_t; using pg8::bf16x8; using pg8::u32x4;
typedef float f32x16 __attribute__((ext_vector_type(16)));
typedef short s16x4 __attribute__((ext_vector_type(4)));
typedef float f32x2_t __attribute__((ext_vector_type(2))); typedef __bf16 bf16x2_t __attribute__((ext_vector_type(2)));
#define ALAS __attribute__((address_space(3)))
typedef ALAS const char* lds_cptr;
constexpr int SEQ = 8192, PITCH = 64, VNEXT = 2 * SEQ * 64;
constexpr int KVSLOT = 24576;
constexpr int L_WS = 114688, L_TAB = L_WS + 2048, L_FLAG = L_TAB + 1056, L_END = L_FLAG + 128, L_OST = 0;
constexpr float SB_EPS = 7.888609052210118e-31f;
__device__ __forceinline__ int crow(int r, int hi) { return (r & 3) + 8 * (r >> 2) + 4 * hi; }
__device__ __forceinline__ void glds16(const void* gsrc, unsigned lds_dst) { unsigned keep;
    asm volatile("s_mov_b32 %0, m0\n\ts_mov_b32 m0, %2\n\ts_nop 0\n\tglobal_load_lds_dwordx4 %1, off\n\ts_mov_b32 m0, %0" : "=&s"(keep) : "v"(gsrc), "s"(lds_dst) : "memory"); }
__device__ __forceinline__ unsigned cvtpk(float lo, float hi) { f32x2_t v = {lo, hi}; bf16x2_t b = __builtin_convertvector(v, bf16x2_t); return __builtin_bit_cast(unsigned, b); }
__device__ __forceinline__ unsigned short f2bf(float f) { unsigned u = __builtin_bit_cast(unsigned, f); return (unsigned short)((u + 0x7fffu + ((u >> 16) & 1u)) >> 16); }
#define MFMA32(a, b, c) __builtin_amdgcn_mfma_f32_32x32x16_bf16((a), (b), (c), 0, 0, 0)

__device__ __forceinline__ void qkt(f32x16& p0, f32x16& p1, lds_cptr kb, const bf16x8* qr, const f32x16& cin) {
#pragma unroll
    for (int d0 = 0; d0 < 4; ++d0) {
        const bf16x8 b0 = *(const ALAS bf16x8*)(kb + d0 * 2048);
        const bf16x8 b1 = *(const ALAS bf16x8*)(kb + d0 * 2048 + 512);
        if (d0 == 0) { p0 = MFMA32(b0, qr[0], cin); p1 = MFMA32(b1, qr[0], cin); }
        else { p0 = MFMA32(b0, qr[d0], p0); p1 = MFMA32(b1, qr[d0], p1); }
    }
}

__device__ __forceinline__ void qkt_sw(f32x16& p0, f32x16& p1, lds_cptr ks, const int (&kofs)[4], const bf16x8* qr, const f32x16& cin) {
    bf16x8 kf[8];
#pragma unroll
    for (int d0 = 0; d0 < 4; ++d0) { kf[2 * d0] = *(const ALAS bf16x8*)(ks + kofs[d0]); kf[2 * d0 + 1] = *(const ALAS bf16x8*)(ks + kofs[d0] + 4096); }
    p0 = MFMA32(kf[0], qr[0], cin); p1 = MFMA32(kf[1], qr[0], cin);
#pragma unroll
    for (int d0 = 1; d0 < 4; ++d0) { p0 = MFMA32(kf[2 * d0], qr[d0], p0); p1 = MFMA32(kf[2 * d0 + 1], qr[d0], p1); }
}
template <int ND> __device__ __forceinline__ void pv(f32x16* o, int vb, bf16x8 pa0, bf16x8 pa1, bf16x8 pa2, bf16x8 pa3) {
#pragma unroll
    for (int d0 = 0; d0 < ND; ++d0) { s16x4 lo[4], hi[4];
#pragma unroll
        for (int ks = 0; ks < 4; ++ks) {
            asm volatile("ds_read_b64_tr_b16 %0,%1 offset:%c2" : "=&v"(lo[ks]) : "v"(vb), "i"(d0 * 4096 + ks * 1024) : "memory");
            asm volatile("ds_read_b64_tr_b16 %0,%1 offset:%c2" : "=&v"(hi[ks]) : "v"(vb), "i"(d0 * 4096 + ks * 1024 + 512) : "memory"); }
        asm volatile("s_waitcnt lgkmcnt(0)" ::: "memory"); __builtin_amdgcn_sched_barrier(0);
#define ATT_PK(k) (bf16x8){lo[k][0], lo[k][1], lo[k][2], lo[k][3], hi[k][0], hi[k][1], hi[k][2], hi[k][3]}
        o[d0] = MFMA32(pa0, ATT_PK(0), o[d0]);
        o[d0] = MFMA32(pa1, ATT_PK(1), o[d0]);
        o[d0] = MFMA32(pa2, ATT_PK(2), o[d0]);
        o[d0] = MFMA32(pa3, ATT_PK(3), o[d0]);
#undef ATT_PK
    }
}

template <int MODE, int VD, bool OUT8 = false, int TPB = 1>
__device__ __forceinline__ void attn_unit(ALAS char* shm, const bf16_t* Qb, const bf16_t* Kb, const bf16_t* Vb, void* Ob, int opitch, int q0, float mref2, const float* tab, float oscale = 1.f, int dbg = 0) {
    constexpr int ND = VD / 32, SLOT = 8192 + VD * 128;
    static_assert(2 * TPB * SLOT <= L_WS, "ring vs LDS map");
    const int tid = threadIdx.x, lane = tid & 63, r32 = lane & 31, hi = lane >> 5; const int wid = __builtin_amdgcn_readfirstlane(tid >> 6);
    const unsigned lds0 = (unsigned)(uintptr_t)shm;
    ALAS float* wsf = (ALAS float*)(shm + L_WS) + wid * 64;
    ALAS float* tabL = (ALAS float*)(shm + L_TAB);
    ALAS unsigned* flg = (ALAS unsigned*)(shm + L_FLAG);
    if (MODE == 1) { for (int i = tid; i < 257; i += 512) tabL[i] = tab[i] * pg8::LOG2E; }
    const bf16_t* Qw = Qb + (size_t)(q0 + wid * 32) * PITCH;
    bf16x8 qr[4];
#pragma unroll
    for (int d0 = 0; d0 < 4; ++d0) qr[d0] = *(const bf16x8*)(Qw + (size_t)r32 * PITCH + d0 * 16 + hi * 8);
    int t_first, n_t, t_step;
    if (MODE == 0) { t_first = 0; n_t = q0 / 64 + 4; t_step = 1; }
    else if (MODE == 1) { const int c0 = q0 / 64; t_first = c0 - 8 > 0 ? c0 - 8 : 0; n_t = c0 + 4 - t_first; t_step = 1; }
    else { t_first = q0 / 64 + 3; n_t = q0 / 64 + 4; t_step = -1; }
    const int krow = 8 * wid + (lane >> 3);
    const bf16_t* ksrc = Kb + (size_t)krow * PITCH + (((lane & 7) ^ ((krow >> 1) & 7)) * 8);
    int kofs[4];
#pragma unroll
    for (int d0 = 0; d0 < 4; ++d0) kofs[d0] = (r32 >> 3) * 1024 + ((r32 & 7) * 8 + ((2 * d0 + hi) ^ ((r32 >> 1) & 7))) * 16;
    const bf16_t* vsrc = Vb + (size_t)(16 * (wid & 3) + (lane >> 2)) * PITCH + (wid >> 2) * 32 + (lane & 3) * 8;
#define ATT_DMA(t, slot) do { if (dbg & 64) break; const size_t to_ = (size_t)(t) * 64 * PITCH; const unsigned sb_ = lds0 + (unsigned)(slot) * SLOT; \
        glds16(ksrc + to_, (unsigned)__builtin_amdgcn_readfirstlane(sb_ + wid * 1024)); \
        glds16(vsrc + to_, (unsigned)__builtin_amdgcn_readfirstlane(sb_ + 8192 + wid * 1024)); \
        if (VD == 128) glds16(vsrc + to_ + VNEXT, (unsigned)__builtin_amdgcn_readfirstlane(sb_ + 8192 + (wid + 8) * 1024)); } while (0)
    f32x16 o[ND];
#pragma unroll
    for (int d = 0; d < ND; ++d) o[d] = f32x16{};
    f32x16 cin;
#pragma unroll
    for (int r = 0; r < 16; ++r) cin[r] = (MODE == 2) ? 0.f : -mref2;
    float l_reg = 0.f, A = (MODE == 2) ? 1.f : 0.f; bool wdone = false;
    const int wrow0 = q0 + wid * 32, qrow = wrow0 + r32;
    const int vb0 = (int)lds0 + 8192 + ((lane >> 4) & 1) * 32 + (lane & 3) * 8 + (4 * hi + ((lane & 15) >> 2)) * 64;
#pragma unroll
    for (int u = 0; u < TPB; ++u) ATT_DMA(t_first + u * t_step, u);
    asm volatile("s_waitcnt vmcnt(0)" ::: "memory"); asm volatile("" : "+v"(qr[0]), "+v"(qr[1]), "+v"(qr[2]), "+v"(qr[3]));
    for (int i = 0; i < n_t; ++i) {
        const int t = t_first + i * t_step, slot = i % (2 * TPB);
        if (i % TPB == 0) {
        asm volatile("s_waitcnt vmcnt(0) lgkmcnt(0)\n\ts_barrier" ::: "memory");
        if (MODE == 2 && i > 0) { const int par = ((i - 1) & 3) * 8; unsigned all = 1u;
#pragma unroll
            for (int w = 0; w < 8; ++w) all &= flg[par + w];
            if (__builtin_amdgcn_readfirstlane(all)) break; }
        if (i + TPB < n_t) {
#pragma unroll
            for (int u = 0; u < TPB; ++u) ATT_DMA(t + (TPB + u) * t_step, (i + TPB + u) % (2 * TPB)); }
        }
        bool active;
        if (MODE == 0) active = (64 * t <= wrow0);
        else if (MODE == 1) { const int cw = wrow0 / 64; active = (t >= cw - 8) && (t <= cw); }
        else active = !wdone && (64 * t < wrow0 + 31);
        if (active && !(dbg & 32)) {
            f32x16 p0, p1; qkt_sw(p0, p1, (lds_cptr)shm + slot * SLOT, kofs, qr, cin);
            if (MODE == 0) {
#pragma unroll
                for (int r = 0; r < 16; ++r) { p0[r] = __builtin_amdgcn_exp2f(p0[r]); p1[r] = __builtin_amdgcn_exp2f(p1[r]); }
            } else if (MODE == 1) {
                const int cw = wrow0 / 64;
                if (t <= cw - 3) { const float cb = tabL[256];
#pragma unroll
                    for (int r = 0; r < 16; ++r) { p0[r] = __builtin_amdgcn_exp2f(p0[r] + cb); p1[r] = __builtin_amdgcn_exp2f(p1[r] + cb); }
                } else { const int dq = qrow - 64 * t - 4 * hi;
#pragma unroll
                    for (int r = 0; r < 16; ++r) { int d0 = dq - ((r & 3) + 8 * (r >> 2)), d1 = d0 - 32;
                        d0 = d0 < -128 ? -128 : (d0 > 128 ? 128 : d0); d1 = d1 < -128 ? -128 : (d1 > 128 ? 128 : d1);
                        p0[r] = __builtin_amdgcn_exp2f(p0[r] + tabL[d0 + 128]); p1[r] = __builtin_amdgcn_exp2f(p1[r] + tabL[d1 + 128]); }
                }
            } else {
                const bool needmask = (64 * t + 63 >= wrow0);
                const int kq = qrow - 64 * t - 4 * hi;
                f32x16 s0, s1;
#pragma unroll
                for (int r = 0; r < 16; ++r) { const int kv = (r & 3) + 8 * (r >> 2);
                    { float x = __builtin_amdgcn_rcpf(1.f + __builtin_amdgcn_exp2f(p0[r])); if (needmask && !(kv < kq)) x = 1.f; s0[r] = x; }
                    { float x = __builtin_amdgcn_rcpf(1.f + __builtin_amdgcn_exp2f(p1[r])); if (needmask && !(kv + 32 < kq)) x = 1.f; s1[r] = x; } }
                float g[8];
#pragma unroll
                for (int k = 0; k < 4; ++k) { g[k] = (s0[4 * k] * s0[4 * k + 1]) * (s0[4 * k + 2] * s0[4 * k + 3]); g[4 + k] = (s1[4 * k] * s1[4 * k + 1]) * (s1[4 * k + 2] * s1[4 * k + 3]); }
                float pg[8];
#pragma unroll
                for (int k = 0; k < 8; ++k) pg[k] = __shfl_xor(g[k], 32);
                float base[8]; float own = 1.f, par = 1.f;
#pragma unroll
                for (int k = 7; k >= 0; --k) { const float par_incl = par * pg[k]; base[k] = A * own * (hi == 0 ? par_incl : par); own *= g[k]; par = par_incl; }
                A *= own * par;
#pragma unroll
                for (int k = 0; k < 4; ++k) {
                    { float c = base[k], rc;
                      rc = s0[4 * k + 3] * c; p0[4 * k + 3] = c - rc; c = rc; rc = s0[4 * k + 2] * c; p0[4 * k + 2] = c - rc; c = rc;
                      rc = s0[4 * k + 1] * c; p0[4 * k + 1] = c - rc; c = rc; rc = s0[4 * k] * c; p0[4 * k] = c - rc; }
                    { float c = base[4 + k], rc;
                      rc = s1[4 * k + 3] * c; p1[4 * k + 3] = c - rc; c = rc; rc = s1[4 * k + 2] * c; p1[4 * k + 2] = c - rc; c = rc;
                      rc = s1[4 * k + 1] * c; p1[4 * k + 1] = c - rc; c = rc; rc = s1[4 * k] * c; p1[4 * k] = c - rc; }
                }
                wdone = __all(A < SB_EPS);
            }
            if (MODE != 2) { float s = 0.f;
#pragma unroll
                for (int r = 0; r < 16; ++r) s += p0[r] + p1[r];
                l_reg += s; }
            u32x4 pw0, pw1, pw2, pw3;
            pw0 = (u32x4){cvtpk(p0[0], p0[1]), cvtpk(p0[2], p0[3]), cvtpk(p0[4], p0[5]), cvtpk(p0[6], p0[7])};
            pw1 = (u32x4){cvtpk(p0[8], p0[9]), cvtpk(p0[10], p0[11]), cvtpk(p0[12], p0[13]), cvtpk(p0[14], p0[15])};
            pw2 = (u32x4){cvtpk(p1[0], p1[1]), cvtpk(p1[2], p1[3]), cvtpk(p1[4], p1[5]), cvtpk(p1[6], p1[7])};
            pw3 = (u32x4){cvtpk(p1[8], p1[9]), cvtpk(p1[10], p1[11]), cvtpk(p1[12], p1[13]), cvtpk(p1[14], p1[15])};
            pv<ND>(o, vb0 + slot * SLOT, __builtin_bit_cast(bf16x8, pw0), __builtin_bit_cast(bf16x8, pw1), __builtin_bit_cast(bf16x8, pw2), __builtin_bit_cast(bf16x8, pw3));
        }
        if (MODE == 2) { if (lane == 0) flg[(i & 3) * 8 + wid] = wdone ? 1u : 0u; }
    }
#undef ATT_DMA
    asm volatile("s_waitcnt vmcnt(0) lgkmcnt(0)\n\ts_barrier" ::: "memory");
    float rl[16];
    if (MODE != 2) {
        l_reg += __shfl_xor(l_reg, 32);
        if (hi == 0) wsf[32 + r32] = l_reg;
        asm volatile("s_waitcnt lgkmcnt(0)" ::: "memory");
#pragma unroll
        for (int r = 0; r < 16; ++r) rl[r] = __builtin_amdgcn_rcpf(wsf[32 + crow(r, hi)]) * oscale;
    } else {
#pragma unroll
        for (int r = 0; r < 16; ++r) rl[r] = oscale;
    }
    if constexpr (OUT8) {
        static_assert(!OUT8 || VD == 64, "fp8 output: 64-wide heads");
        unsigned char* Ow = (unsigned char*)Ob + (size_t)(q0 + wid * 32) * opitch;
        ALAS unsigned char* stg = (ALAS unsigned char*)(shm + L_OST) + wid * 2048;
#pragma unroll
        for (int r = 0; r < 16; ++r) { const int orow = crow(r, hi);
#pragma unroll
            for (int d0 = 0; d0 < 2; ++d0) { const float v = o[d0][r] * rl[r]; stg[orow * 64 + d0 * 32 + r32] = (unsigned char)(__builtin_amdgcn_cvt_pk_fp8_f32(v, v, 0, false) & 0xff); } }
        asm volatile("s_waitcnt lgkmcnt(0)" ::: "memory");
#pragma unroll
        for (int i = 0; i < 2; ++i) { const int row = i * 16 + (lane >> 2), ch = lane & 3; const u32x4 v = *(const ALAS u32x4*)(stg + row * 64 + ch * 16); *(u32x4*)(Ow + (size_t)row * opitch + ch * 16) = v; }
        asm volatile("s_waitcnt lgkmcnt(0)" ::: "memory");
    } else {
    bf16_t* Ow = (bf16_t*)Ob + (size_t)(q0 + wid * 32) * opitch;
    ALAS bf16_t* stg = (ALAS bf16_t*)(shm + L_OST) + wid * 2048;
#pragma unroll
    for (int half = 0; half < ND / 2; ++half) {
#pragma unroll
        for (int r = 0; r < 16; ++r) { const int orow = crow(r, hi);
#pragma unroll
            for (int d0 = 0; d0 < 2; ++d0) stg[orow * 64 + d0 * 32 + r32] = f2bf(o[half * 2 + d0][r] * rl[r]); }
        asm volatile("s_waitcnt lgkmcnt(0)" ::: "memory");
#pragma unroll
        for (int i = 0; i < 4; ++i) { const int row = i * 8 + (lane >> 3), ch = lane & 7; const u32x4 v = *(const ALAS u32x4*)(stg + row * 64 + ch * 8); *(u32x4*)(Ow + (size_t)row * opitch + half * 64 + ch * 8) = v; }
        asm volatile("s_waitcnt lgkmcnt(0)" ::: "memory");
    }
    }
    asm volatile("s_waitcnt lgkmcnt(0)\n\ts_barrier" ::: "memory");
}


template <int NRES>
__device__ __forceinline__ void attn_unit_sb(ALAS char* shm, const bf16_t* Qb, const bf16_t* Kb, const bf16_t* Vb, void* Ob, int opitch, int q0, unsigned* qnext = nullptr, int qword_lds = 0) {
    constexpr int ND = 2, SLOT = 16384;
    static_assert(NRES >= 4 && NRES * SLOT <= L_WS, "resident window vs LDS map");
    const int tid = threadIdx.x, lane = tid & 63, r32 = lane & 31, hi = lane >> 5; const int wid = __builtin_amdgcn_readfirstlane(tid >> 6);
    const unsigned lds0 = (unsigned)(uintptr_t)shm;
    ALAS unsigned* flg = (ALAS unsigned*)(shm + L_FLAG);
    const bf16_t* Qw = Qb + (size_t)(q0 + wid * 32) * PITCH;
    bf16x8 qr[4];
#pragma unroll
    for (int d0 = 0; d0 < 4; ++d0) qr[d0] = *(const bf16x8*)(Qw + (size_t)r32 * PITCH + d0 * 16 + hi * 8);
    const int t_first = q0 / 64 + 3, n_t = q0 / 64 + 4;
    const int krow = 8 * wid + (lane >> 3);
    const bf16_t* ksrc = Kb + (size_t)krow * PITCH + (((lane & 7) ^ ((krow >> 1) & 7)) * 8);
    int kofs[4];
#pragma unroll
    for (int d0 = 0; d0 < 4; ++d0) kofs[d0] = (r32 >> 3) * 1024 + ((r32 & 7) * 8 + ((2 * d0 + hi) ^ ((r32 >> 1) & 7))) * 16;
    const bf16_t* vsrc = Vb + (size_t)(16 * (wid & 3) + (lane >> 2)) * PITCH + (wid >> 2) * 32 + (lane & 3) * 8;
#define SB_DMA(t, slot) do { const size_t to_ = (size_t)(t) * 64 * PITCH; const unsigned sb_ = lds0 + (unsigned)(slot) * SLOT; \
        glds16(ksrc + to_, (unsigned)__builtin_amdgcn_readfirstlane(sb_ + wid * 1024)); \
        glds16(vsrc + to_, (unsigned)__builtin_amdgcn_readfirstlane(sb_ + 8192 + wid * 1024)); } while (0)
    f32x16 o[ND];
#pragma unroll
    for (int d = 0; d < ND; ++d) o[d] = f32x16{};
    f32x16 cin;
#pragma unroll
    for (int r = 0; r < 16; ++r) cin[r] = 0.f;
    float A = 1.f; bool wdone = false;
    const int wrow0 = q0 + wid * 32, qrow = wrow0 + r32;
    const int vb0 = (int)lds0 + 8192 + ((lane >> 4) & 1) * 32 + (lane & 3) * 8 + (4 * hi + ((lane & 15) >> 2)) * 64;
    const int nres = n_t < NRES ? n_t : NRES;
    for (int u = 0; u < nres; ++u) SB_DMA(t_first - u, u);
    asm volatile("s_waitcnt vmcnt(0)" ::: "memory"); asm volatile("" : "+v"(qr[0]), "+v"(qr[1]), "+v"(qr[2]), "+v"(qr[3]));
    asm volatile("s_waitcnt vmcnt(0) lgkmcnt(0)\n\ts_barrier" ::: "memory");
    const auto tile = [&](const int t, const int slot) {
            f32x16 p0, p1; qkt_sw(p0, p1, (lds_cptr)shm + slot * SLOT, kofs, qr, cin);
            {
                const bool needmask = (64 * t + 63 >= wrow0);
                const int kq = qrow - 64 * t - 4 * hi;
                f32x16 s0, s1;
#pragma unroll
                for (int r = 0; r < 16; ++r) { const int kv = (r & 3) + 8 * (r >> 2);
                    { float x = __builtin_amdgcn_rcpf(1.f + __builtin_amdgcn_exp2f(p0[r])); if (needmask && !(kv < kq)) x = 1.f; s0[r] = x; }
                    { float x = __builtin_amdgcn_rcpf(1.f + __builtin_amdgcn_exp2f(p1[r])); if (needmask && !(kv + 32 < kq)) x = 1.f; s1[r] = x; } }
                float g[8];
#pragma unroll
                for (int k = 0; k < 4; ++k) { g[k] = (s0[4 * k] * s0[4 * k + 1]) * (s0[4 * k + 2] * s0[4 * k + 3]); g[4 + k] = (s1[4 * k] * s1[4 * k + 1]) * (s1[4 * k + 2] * s1[4 * k + 3]); }
                float pg[8];
#pragma unroll
                for (int k = 0; k < 8; ++k) pg[k] = __shfl_xor(g[k], 32);
                float base[8]; float own = 1.f, par = 1.f;
#pragma unroll
                for (int k = 7; k >= 0; --k) { const float par_incl = par * pg[k]; base[k] = A * own * (hi == 0 ? par_incl : par); own *= g[k]; par = par_incl; }
                A *= own * par;
#pragma unroll
                for (int k = 0; k < 4; ++k) {
                    { float c = base[k], rc;
                      rc = s0[4 * k + 3] * c; p0[4 * k + 3] = c - rc; c = rc; rc = s0[4 * k + 2] * c; p0[4 * k + 2] = c - rc; c = rc;
                      rc = s0[4 * k + 1] * c; p0[4 * k + 1] = c - rc; c = rc; rc = s0[4 * k] * c; p0[4 * k] = c - rc; }
                    { float c = base[4 + k], rc;
                      rc = s1[4 * k + 3] * c; p1[4 * k + 3] = c - rc; c = rc; rc = s1[4 * k + 2] * c; p1[4 * k + 2] = c - rc; c = rc;
                      rc = s1[4 * k + 1] * c; p1[4 * k + 1] = c - rc; c = rc; rc = s1[4 * k] * c; p1[4 * k] = c - rc; }
                }
                wdone = __all(A < SB_EPS);
            }
            u32x4 pw0, pw1, pw2, pw3;
            pw0 = (u32x4){cvtpk(p0[0], p0[1]), cvtpk(p0[2], p0[3]), cvtpk(p0[4], p0[5]), cvtpk(p0[6], p0[7])};
            pw1 = (u32x4){cvtpk(p0[8], p0[9]), cvtpk(p0[10], p0[11]), cvtpk(p0[12], p0[13]), cvtpk(p0[14], p0[15])};
            pw2 = (u32x4){cvtpk(p1[0], p1[1]), cvtpk(p1[2], p1[3]), cvtpk(p1[4], p1[5]), cvtpk(p1[6], p1[7])};
            pw3 = (u32x4){cvtpk(p1[8], p1[9]), cvtpk(p1[10], p1[11]), cvtpk(p1[12], p1[13]), cvtpk(p1[14], p1[15])};
            pv<ND>(o, vb0 + slot * SLOT, __builtin_bit_cast(bf16x8, pw0), __builtin_bit_cast(bf16x8, pw1), __builtin_bit_cast(bf16x8, pw2), __builtin_bit_cast(bf16x8, pw3)); };
#pragma unroll 1
    for (int i = 0; i < nres; ++i) { const int t = t_first - i;
        if (!wdone && (64 * t < wrow0 + 31)) tile(t, i); }
    if (lane == 0) flg[((nres - 1) & 3) * 8 + wid] = wdone ? 1u : 0u;
    asm volatile("s_waitcnt lgkmcnt(0)\n\ts_barrier" ::: "memory");
    unsigned all = 1u;
#pragma unroll
    for (int w = 0; w < 8; ++w) all &= flg[((nres - 1) & 3) * 8 + w];
    if (!__builtin_amdgcn_readfirstlane(all) && nres < n_t) {
        SB_DMA(t_first - nres, nres & 1);
#pragma unroll 1
        for (int i = nres; i < n_t; ++i) { const int t = t_first - i, slot = i & 1;
            asm volatile("s_waitcnt vmcnt(0) lgkmcnt(0)\n\ts_barrier" ::: "memory");
            if (i > nres) { const int par = ((i - 1) & 3) * 8; unsigned al2 = 1u;
#pragma unroll
                for (int w = 0; w < 8; ++w) al2 &= flg[par + w];
                if (__builtin_amdgcn_readfirstlane(al2)) break; }
            if (i + 1 < n_t) SB_DMA(t - 1, (i + 1) & 1);
            if (!wdone && (64 * t < wrow0 + 31)) tile(t, slot);
            if (lane == 0) flg[(i & 3) * 8 + wid] = wdone ? 1u : 0u;
        }
    }
#undef SB_DMA
    asm volatile("s_waitcnt vmcnt(0) lgkmcnt(0)\n\ts_barrier" ::: "memory");
    unsigned nxt_ = 0u; if (qnext != nullptr && tid == 0) nxt_ = __hip_atomic_fetch_add(qnext, 1u, __ATOMIC_RELAXED, __HIP_MEMORY_SCOPE_AGENT);
    bf16_t* Ow = (bf16_t*)Ob + (size_t)(q0 + wid * 32) * opitch;
    ALAS bf16_t* stg = (ALAS bf16_t*)(shm + L_OST) + wid * 2048;
#pragma unroll
    for (int r = 0; r < 16; ++r) { const int orow = crow(r, hi);
#pragma unroll
        for (int d0 = 0; d0 < 2; ++d0) stg[orow * 64 + d0 * 32 + r32] = f2bf(o[d0][r]); }
    asm volatile("s_waitcnt lgkmcnt(0)" ::: "memory");
#pragma unroll
    for (int i = 0; i < 4; ++i) { const int row = i * 8 + (lane >> 3), ch = lane & 7; const u32x4 v = *(const ALAS u32x4*)(stg + row * 64 + ch * 8); *(u32x4*)(Ow + (size_t)row * opitch + ch * 8) = v; }
    if (qnext != nullptr && tid == 0) *(ALAS unsigned*)(shm + qword_lds) = nxt_;
    asm volatile("s_waitcnt lgkmcnt(0)\n\ts_barrier" ::: "memory");
}

template <int MODE, int VD, bool OUT8 = false, bool PV8 = false>
__device__ __forceinline__ void attn_unit_lag(ALAS char* shm, const bf16_t* Qb, const bf16_t* Kb, const bf16_t* Vb, void* Ob, int opitch, int q0, float mref2, const float* tab, float oscale = 1.f, const unsigned char* Vt = nullptr, bool fresh_tab = true, unsigned* qnext = nullptr, int qword_lds = 0) {
    static_assert(MODE == 0 || MODE == 1, "stage-lagged loop: softmax modes only");
    static_assert(!PV8 || (MODE == 0 && VD == 128), "fp8 P.V: the differential units");
    constexpr int ND = VD / 32, VBY = PV8 ? VD * 64 : VD * 128, VOFF = 16384, TT = 2 * SEQ;
    static_assert(VOFF + 3 * VBY <= L_WS, "ring vs LDS map");
    const int tid = threadIdx.x, lane = tid & 63, r32 = lane & 31, hi = lane >> 5; const int wid = __builtin_amdgcn_readfirstlane(tid >> 6); const bool lag = wid >= 4;
    const unsigned lds0 = (unsigned)(uintptr_t)shm;
    ALAS float* wsf = (ALAS float*)(shm + L_WS) + wid * 64;
    ALAS float* tabL = (ALAS float*)(shm + L_TAB);
    if (MODE == 1 && fresh_tab) { const float cbn = tab[256]; for (int i = tid; i < 256; i += 512) { const int d = i - 64; tabL[i] = (tab[(d < 128 ? d : 128) + 128] - cbn) * pg8::LOG2E; } }
    const float cb2 = (MODE == 1) ? tab[256] * pg8::LOG2E : 0.f;
    const bf16_t* Qw = Qb + (size_t)(q0 + wid * 32) * PITCH;
    bf16x8 qr[4];
#pragma unroll
    for (int d0 = 0; d0 < 4; ++d0) qr[d0] = *(const bf16x8*)(Qw + (size_t)r32 * PITCH + d0 * 16 + hi * 8);
    int t_first, n_t;
    if (MODE == 0) { t_first = 0; n_t = q0 / 64 + 4; }
    else { const int c0 = q0 / 64; t_first = c0 - 8 > 0 ? c0 - 8 : 0; n_t = c0 + 4 - t_first; }
    const int krow = 8 * wid + (lane >> 3);
    const bf16_t* ksrc = Kb + (size_t)krow * PITCH + (((lane & 7) ^ ((krow >> 1) & 7)) * 8) + (size_t)t_first * 64 * PITCH;
    int kofs[4];
#pragma unroll
    for (int d0 = 0; d0 < 4; ++d0) kofs[d0] = (r32 >> 3) * 1024 + ((r32 & 7) * 8 + ((2 * d0 + hi) ^ ((r32 >> 1) & 7))) * 16;
    const bf16_t* vsrc = Vb + (size_t)(16 * (wid & 3) + (lane >> 2)) * PITCH + (wid >> 2) * 32 + (lane & 3) * 8 + (size_t)t_first * 64 * PITCH;
    const unsigned char* vtsrc = PV8 ? Vt + (size_t)(16 * wid + (lane >> 2)) * TT + (size_t)t_first * 64 + (((lane & 3) ^ ((lane >> 4) & 3)) * 16) : nullptr;
#define LAG_DMA(i, v3) do { const size_t to_ = (size_t)(i) * 64 * PITCH; const unsigned vb_ = lds0 + VOFF + (unsigned)(v3) * VBY; \
        glds16(ksrc + to_, (unsigned)__builtin_amdgcn_readfirstlane(lds0 + (unsigned)((i) & 1) * 8192 + wid * 1024)); \
        if (PV8) glds16(vtsrc + (size_t)(i) * 64, (unsigned)__builtin_amdgcn_readfirstlane(vb_ + wid * 1024)); \
        else { glds16(vsrc + to_, (unsigned)__builtin_amdgcn_readfirstlane(vb_ + wid * 1024)); \
               if (VD == 128) glds16(vsrc + to_ + VNEXT, (unsigned)__builtin_amdgcn_readfirstlane(vb_ + (wid + 8) * 1024)); } } while (0)
    f32x16 o[ND];
#pragma unroll
    for (int d = 0; d < ND; ++d) o[d] = f32x16{};
    f32x16 cin;
#pragma unroll
    for (int r = 0; r < 16; ++r) cin[r] = PV8 ? 12.f - mref2 : cb2 - mref2;
    float l_reg = 0.f;
    const int wrow0 = q0 + wid * 32, qrow = wrow0 + r32, cw = wrow0 / 64;
    const int vt0 = (int)lds0 + VOFF + (r32 >> 4) * 1024 + ((r32 & 15) * 4 + ((2 * hi) ^ (((r32 & 15) >> 2) & 3))) * 16, vt1 = (int)lds0 + VOFF + (r32 >> 4) * 1024 + ((r32 & 15) * 4 + ((2 * hi + 1) ^ (((r32 & 15) >> 2) & 3))) * 16;
    const int vbl = (int)lds0 + VOFF + ((lane >> 4) & 1) * 32 + (lane & 3) * 8 + (4 * hi + ((lane & 15) >> 2)) * 64;
#define LAG_PV(V3) do { if (PV8) { typedef int i32x4_t __attribute__((ext_vector_type(4))); typedef int i32x8_t __attribute__((ext_vector_type(8))); \
            const i32x8_t pa_ = __builtin_shufflevector(__builtin_bit_cast(i32x4_t, pw0), __builtin_bit_cast(i32x4_t, pw1), 0, 1, 2, 3, 4, 5, 6, 7); i32x8_t vf_[ND]; \
            _Pragma("unroll") for (int db_ = 0; db_ < ND; ++db_) { const i32x4_t a_ = *(const ALAS i32x4_t*)(ALAS char*)(uintptr_t)(unsigned)(vt0 + (V3) * VBY + db_ * 2048), b_ = *(const ALAS i32x4_t*)(ALAS char*)(uintptr_t)(unsigned)(vt1 + (V3) * VBY + db_ * 2048); \
                vf_[db_] = __builtin_shufflevector(a_, b_, 0, 1, 2, 3, 4, 5, 6, 7); } \
            _Pragma("unroll") for (int db_ = 0; db_ < ND; ++db_) asm volatile("s_nop 4\n\tv_mfma_f32_32x32x64_f8f6f4 %0, %1, %2, %0" : "+v"(o[db_]) : "v"(pa_), "v"(vf_[db_])); } \
        else pv<ND>(o, vbl + (V3) * VBY, __builtin_bit_cast(bf16x8, pw0), __builtin_bit_cast(bf16x8, pw1), __builtin_bit_cast(bf16x8, pw2), __builtin_bit_cast(bf16x8, pw3)); } while (0)
    LAG_DMA(0, 0);
    asm volatile("s_waitcnt vmcnt(0)" ::: "memory"); asm volatile("" : "+v"(qr[0]), "+v"(qr[1]), "+v"(qr[2]), "+v"(qr[3]));
    u32x4 pw0 = {0u, 0u, 0u, 0u}, pw1 = pw0, pw2 = pw0, pw3 = pw0; bool prev_act = false; int v3 = 0, v3p = 0;
    for (int i = 0; i < n_t; ++i) {
        const int t = t_first + i;
        asm volatile("s_waitcnt vmcnt(0) lgkmcnt(0)\n\ts_barrier" ::: "memory");
        const int v3n = (v3 == 2) ? 0 : v3 + 1;
        if (i + 1 < n_t) LAG_DMA(i + 1, v3n);
        if (lag && prev_act) LAG_PV(v3p);
        bool active;
        if (MODE == 0) active = (t <= cw); else active = (t >= cw - 8) && (t <= cw);
        if (active) {
            f32x16 p0, p1; qkt_sw(p0, p1, (lds_cptr)shm + (i & 1) * 8192, kofs, qr, cin);
            if (MODE == 0) {
#pragma unroll
                for (int r = 0; r < 16; ++r) { p0[r] = __builtin_amdgcn_exp2f(p0[r]); p1[r] = __builtin_amdgcn_exp2f(p1[r]); }
                if (PV8) {
#pragma unroll
                    for (int r = 0; r < 16; ++r) { p0[r] = __builtin_fminf(p0[r], 448.f); p1[r] = __builtin_fminf(p1[r], 448.f); } }
            } else {
                if (t <= cw - 3) {
#pragma unroll
                    for (int r = 0; r < 16; ++r) { p0[r] = __builtin_amdgcn_exp2f(p0[r]); p1[r] = __builtin_amdgcn_exp2f(p1[r]); }
                } else { const ALAS float* tb = tabL + (qrow - 64 * t - 4 * hi + 1);
#pragma unroll
                    for (int r = 0; r < 16; ++r) { const int kv = (r & 3) + 8 * (r >> 2);
                        p0[r] = __builtin_amdgcn_exp2f(p0[r] + tb[63 - kv]); p1[r] = __builtin_amdgcn_exp2f(p1[r] + tb[31 - kv]); }
                }
            }
            float s = 0.f;
#pragma unroll
            for (int r = 0; r < 16; ++r) s += p0[r] + p1[r];
            l_reg += s;
            if (PV8) {
                pw0 = (u32x4){pg8::pk4_fp8(p0[0], p0[1], p0[2], p0[3]), pg8::pk4_fp8(p0[4], p0[5], p0[6], p0[7]), pg8::pk4_fp8(p0[8], p0[9], p0[10], p0[11]), pg8::pk4_fp8(p0[12], p0[13], p0[14], p0[15])};
                pw1 = (u32x4){pg8::pk4_fp8(p1[0], p1[1], p1[2], p1[3]), pg8::pk4_fp8(p1[4], p1[5], p1[6], p1[7]), pg8::pk4_fp8(p1[8], p1[9], p1[10], p1[11]), pg8::pk4_fp8(p1[12], p1[13], p1[14], p1[15])};
            } else {
            pw0 = (u32x4){cvtpk(p0[0], p0[1]), cvtpk(p0[2], p0[3]), cvtpk(p0[4], p0[5]), cvtpk(p0[6], p0[7])};
            pw1 = (u32x4){cvtpk(p0[8], p0[9]), cvtpk(p0[10], p0[11]), cvtpk(p0[12], p0[13]), cvtpk(p0[14], p0[15])};
            pw2 = (u32x4){cvtpk(p1[0], p1[1]), cvtpk(p1[2], p1[3]), cvtpk(p1[4], p1[5]), cvtpk(p1[6], p1[7])};
            pw3 = (u32x4){cvtpk(p1[8], p1[9]), cvtpk(p1[10], p1[11]), cvtpk(p1[12], p1[13]), cvtpk(p1[14], p1[15])};
            }
            if (!lag) LAG_PV(v3);
        }
        prev_act = active; v3p = v3; v3 = v3n;
    }
    if (lag && prev_act) LAG_PV(v3p);
#undef LAG_DMA
#undef LAG_PV
    if (PV8) asm volatile("s_nop 15\n\ts_nop 15" ::: "memory");
    asm volatile("s_waitcnt vmcnt(0) lgkmcnt(0)\n\ts_barrier" ::: "memory");
    unsigned nxt_ = 0u; if (qnext != nullptr && tid == 0) nxt_ = __hip_atomic_fetch_add(qnext, 1u, __ATOMIC_RELAXED, __HIP_MEMORY_SCOPE_AGENT);
    float rl[16];
    l_reg += __shfl_xor(l_reg, 32);
    if (hi == 0) wsf[32 + r32] = l_reg;
    asm volatile("s_waitcnt lgkmcnt(0)" ::: "memory");
#pragma unroll
    for (int r = 0; r < 16; ++r) rl[r] = __builtin_amdgcn_rcpf(wsf[32 + crow(r, hi)]) * oscale;
    if constexpr (OUT8) {
        static_assert(!OUT8 || VD == 64, "fp8 output: 64-wide heads");
        unsigned char* Ow = (unsigned char*)Ob + (size_t)(q0 + wid * 32) * opitch;
        ALAS unsigned char* stg = (ALAS unsigned char*)(shm + L_OST) + wid * 2048;
#pragma unroll
        for (int r = 0; r < 16; ++r) { const int orow = crow(r, hi);
#pragma unroll
            for (int d0 = 0; d0 < 2; ++d0) { const float v = o[d0][r] * rl[r]; stg[orow * 64 + d0 * 32 + r32] = (unsigned char)(__builtin_amdgcn_cvt_pk_fp8_f32(v, v, 0, false) & 0xff); } }
        asm volatile("s_waitcnt lgkmcnt(0)" ::: "memory");
#pragma unroll
        for (int i = 0; i < 2; ++i) { const int row = i * 16 + (lane >> 2), ch = lane & 3; const u32x4 v = *(const ALAS u32x4*)(stg + row * 64 + ch * 16); *(u32x4*)(Ow + (size_t)row * opitch + ch * 16) = v; }
        asm volatile("s_waitcnt lgkmcnt(0)" ::: "memory");
    } else {
        bf16_t* Ow = (bf16_t*)Ob + (size_t)(q0 + wid * 32) * opitch;
        ALAS bf16_t* stg = (ALAS bf16_t*)(shm + L_OST) + wid * 2048;
#pragma unroll
        for (int half = 0; half < ND / 2; ++half) {
#pragma unroll
            for (int r = 0; r < 16; ++r) { const int orow = crow(r, hi);
#pragma unroll
                for (int d0 = 0; d0 < 2; ++d0) stg[orow * 64 + d0 * 32 + r32] = f2bf(o[half * 2 + d0][r] * rl[r]); }
            asm volatile("s_waitcnt lgkmcnt(0)" ::: "memory");
#pragma unroll
            for (int i = 0; i < 4; ++i) { const int row = i * 8 + (lane >> 3), ch = lane & 7; const u32x4 v = *(const ALAS u32x4*)(stg + row * 64 + ch * 8); *(u32x4*)(Ow + (size_t)row * opitch + half * 64 + ch * 8) = v; }
            asm volatile("s_waitcnt lgkmcnt(0)" ::: "memory");
        }
    }
    if (qnext != nullptr && tid == 0) *(ALAS unsigned*)(shm + qword_lds) = nxt_;
    asm volatile("s_waitcnt lgkmcnt(0)\n\ts_barrier" ::: "memory");
}
__device__ __forceinline__ void qkt8(f32x16& p0, f32x16& p1, lds_cptr kb, const bf16x8* qr, const f32x16& cin) {
    bf16x8 kf[8];
#pragma unroll
    for (int d0 = 0; d0 < 4; ++d0) { kf[2 * d0] = *(const ALAS bf16x8*)(kb + d0 * 2048); kf[2 * d0 + 1] = *(const ALAS bf16x8*)(kb + d0 * 2048 + 512); }
    __builtin_amdgcn_sched_barrier(0);
    p0 = MFMA32(kf[0], qr[0], cin); p1 = MFMA32(kf[1], qr[0], cin);
#pragma unroll
    for (int d0 = 1; d0 < 4; ++d0) { p0 = MFMA32(kf[2 * d0], qr[d0], p0); p1 = MFMA32(kf[2 * d0 + 1], qr[d0], p1); }
}
template <int ND, int KS0> __device__ __forceinline__ void v_reads(s16x4 (&lo)[ND][2], s16x4 (&hi)[ND][2], int vb) {
#pragma unroll
    for (int ks = 0; ks < 2; ++ks)
#pragma unroll
        for (int d0 = 0; d0 < ND; ++d0) {
            asm volatile("ds_read_b64_tr_b16 %0,%1 offset:%c2" : "=&v"(lo[d0][ks]) : "v"(vb), "i"(d0 * 4096 + (KS0 + ks) * 1024) : "memory");
            asm volatile("ds_read_b64_tr_b16 %0,%1 offset:%c2" : "=&v"(hi[d0][ks]) : "v"(vb), "i"(d0 * 4096 + (KS0 + ks) * 1024 + 512) : "memory"); }
}
template <int ND> __device__ __forceinline__ void pv_half(f32x16* o, const s16x4 (&lo)[ND][2], const s16x4 (&hi)[ND][2], bf16x8 pa, bf16x8 pb) {
#define ATT_PK2(d, k) (bf16x8){lo[d][k][0], lo[d][k][1], lo[d][k][2], lo[d][k][3], hi[d][k][0], hi[d][k][1], hi[d][k][2], hi[d][k][3]}
#pragma unroll
    for (int d0 = 0; d0 < ND; ++d0) o[d0] = MFMA32(pa, ATT_PK2(d0, 0), o[d0]);
#pragma unroll
    for (int d0 = 0; d0 < ND; ++d0) o[d0] = MFMA32(pb, ATT_PK2(d0, 1), o[d0]);
#undef ATT_PK2
}
template <int MODE> __device__ __forceinline__ void p_half(f32x16& p, float& l_reg, u32x4& wa, u32x4& wb, bool const_bias, int dq, const ALAS float* tabL) {
    if (MODE == 0) {
#pragma unroll
        for (int r = 0; r < 16; ++r) p[r] = __builtin_amdgcn_exp2f(p[r]);
    } else if (const_bias) { const float cb = tabL[256];
#pragma unroll
        for (int r = 0; r < 16; ++r) p[r] = __builtin_amdgcn_exp2f(p[r] + cb);
    } else {
#pragma unroll
        for (int r = 0; r < 16; ++r) { int d = dq - ((r & 3) + 8 * (r >> 2)); d = d < -128 ? -128 : (d > 128 ? 128 : d); p[r] = __builtin_amdgcn_exp2f(p[r] + tabL[d + 128]); }
    }
    float s = 0.f;
#pragma unroll
    for (int r = 0; r < 16; ++r) s += p[r];
    l_reg += s;
    wa = (u32x4){cvtpk(p[0], p[1]), cvtpk(p[2], p[3]), cvtpk(p[4], p[5]), cvtpk(p[6], p[7])};
    wb = (u32x4){cvtpk(p[8], p[9]), cvtpk(p[10], p[11]), cvtpk(p[12], p[13]), cvtpk(p[14], p[15])};
}
__device__ __forceinline__ void vm_wait_n(int n) {
    if (n <= 0) asm volatile("s_waitcnt vmcnt(0)" ::: "memory"); else if (n == 1) asm volatile("s_waitcnt vmcnt(1)" ::: "memory"); else if (n == 2) asm volatile("s_waitcnt vmcnt(2)" ::: "memory");
    else if (n == 3) asm volatile("s_waitcnt vmcnt(3)" ::: "memory"); else if (n == 4) asm volatile("s_waitcnt vmcnt(4)" ::: "memory"); else if (n == 5) asm volatile("s_waitcnt vmcnt(5)" ::: "memory");
    else if (n == 6) asm volatile("s_waitcnt vmcnt(6)" ::: "memory"); else if (n == 7) asm volatile("s_waitcnt vmcnt(7)" ::: "memory"); else if (n == 8) asm volatile("s_waitcnt vmcnt(8)" ::: "memory");
    else if (n == 9) asm volatile("s_waitcnt vmcnt(9)" ::: "memory"); else if (n == 10) asm volatile("s_waitcnt vmcnt(10)" ::: "memory"); else asm volatile("s_waitcnt vmcnt(11)" ::: "memory");
}
template <int MODE, int VD, bool OUT8 = false, int PD = 3>
__device__ __forceinline__ void attn_unit_pp(ALAS char* shm, const bf16_t* Qb, const bf16_t* Kb, const bf16_t* Vb, void* Ob, int opitch, int q0, float mref2, const float* tab, float oscale = 1.f, int dbg = 0) {
    static_assert(MODE == 0 || MODE == 1, "ping-pong loop: softmax modes only");
    constexpr int ND = VD / 32, NV = VD / 64, NS = PD + 1, PER = 1 + NV, SLOT = 8192 + VD * 128;
    static_assert(NS * SLOT <= L_WS, "ring vs LDS map");
    const int tid = threadIdx.x, lane = tid & 63, r32 = lane & 31, hi = lane >> 5; const int wid = __builtin_amdgcn_readfirstlane(tid >> 6); const int grp = wid >> 2;
    const unsigned lds0 = (unsigned)(uintptr_t)shm;
    ALAS float* wsf = (ALAS float*)(shm + L_WS) + wid * 64;
    ALAS float* tabL = (ALAS float*)(shm + L_TAB);
    if (MODE == 1) { for (int i = tid; i < 257; i += 512) tabL[i] = tab[i] * pg8::LOG2E; }
    const bf16_t* Qw = Qb + (size_t)(q0 + wid * 32) * PITCH;
    bf16x8 qr[4];
#pragma unroll
    for (int d0 = 0; d0 < 4; ++d0) qr[d0] = *(const bf16x8*)(Qw + (size_t)r32 * PITCH + d0 * 16 + hi * 8);
    int t_first, n_t;
    if (MODE == 0) { t_first = 0; n_t = q0 / 64 + 4; }
    else { const int c0 = q0 / 64; t_first = c0 - 8 > 0 ? c0 - 8 : 0; n_t = c0 + 4 - t_first; }
    const bf16_t* ksrc = Kb + (size_t)lane * PITCH + wid * 8 + (size_t)t_first * 64 * PITCH;
    const bf16_t* vsrc = Vb + (size_t)(16 * (wid & 3) + (lane >> 2)) * PITCH + (wid >> 2) * 32 + (lane & 3) * 8 + (size_t)t_first * 64 * PITCH;
    const bf16_t* ksrc_c = Kb + (size_t)t_first * 64 * PITCH + wid * 512 + lane * 8;
    int issued = 0;
#define PP_DMA_K(i) do { if ((i) < n_t && !(dbg & 64)) { glds16(((dbg & 128) ? ksrc_c : ksrc) + (size_t)(i) * 64 * PITCH, (unsigned)__builtin_amdgcn_readfirstlane(lds0 + (unsigned)((i) % NS) * SLOT + wid * 1024)); issued += 1; } } while (0)
#define PP_DMA_V(i) do { if ((i) < n_t && !(dbg & 64)) { const unsigned sb_ = lds0 + (unsigned)((i) % NS) * SLOT + 8192; glds16(vsrc + (size_t)(i) * 64 * PITCH, (unsigned)__builtin_amdgcn_readfirstlane(sb_ + wid * 1024)); \
        if (VD == 128) glds16(vsrc + (size_t)(i) * 64 * PITCH + VNEXT, (unsigned)__builtin_amdgcn_readfirstlane(sb_ + (wid + 8) * 1024)); issued += NV; } } while (0)
#define PP_NEED_K(j) do { if (!(dbg & 256)) vm_wait_n(issued - ((j) * PER + 1)); } while (0)
#define PP_NEED_V(j) do { if (!(dbg & 256)) vm_wait_n(issued - ((j) + 1) * PER); } while (0)
#define PP_BAR() asm volatile("s_waitcnt lgkmcnt(0)\n\ts_barrier" ::: "memory")
    f32x16 o[ND];
#pragma unroll
    for (int d = 0; d < ND; ++d) o[d] = f32x16{};
    f32x16 cin;
#pragma unroll
    for (int r = 0; r < 16; ++r) cin[r] = -mref2;
    float l_reg = 0.f;
    const int wrow0 = q0 + wid * 32, qrow = wrow0 + r32, cw = wrow0 / 64;
    const int vb0 = (int)lds0 + 8192 + ((lane >> 4) & 1) * 32 + (lane & 3) * 8 + (4 * hi + ((lane & 15) >> 2)) * 64;
    asm volatile("s_waitcnt vmcnt(0)" ::: "memory"); asm volatile("" : "+v"(qr[0]), "+v"(qr[1]), "+v"(qr[2]), "+v"(qr[3]));
#pragma unroll
    for (int j = 0; j < PD; ++j) { PP_DMA_K(j); PP_DMA_V(j); }
    if (grp) PP_DMA_K(PD);
    PP_NEED_V(0);
    PP_BAR();
    if (grp) PP_BAR();
    u32x4 pw0, pw1, pw2, pw3; f32x16 p1;
    for (int i = 0; i < n_t; ++i) {
        const int t = t_first + i, slot = i % NS;
        bool active;
        if (MODE == 0) active = (t <= cw); else active = (t >= cw - 8) && (t <= cw);
        if (grp == 0) PP_DMA_K(i + PD); else PP_DMA_V(i + PD);
        if (active && !(dbg & 32)) {
            const lds_cptr kb = (lds_cptr)shm + slot * SLOT + hi * 1024 + r32 * 16;
            f32x16 p0; qkt8(p0, p1, kb, qr, cin);
            p_half<MODE>(p0, l_reg, pw0, pw1, (t <= cw - 3) || (dbg & 8), qrow - 64 * t - 4 * hi, tabL);
        }
        if (grp == 0) PP_NEED_V(i); else PP_NEED_K(i + 1);
        PP_BAR();
        if (grp == 0) PP_DMA_V(i + PD); else PP_DMA_K(i + 1 + PD);
        if (active && !(dbg & 16)) {
            const int vb = vb0 + slot * SLOT;
            s16x4 lo0[ND][2], hi0[ND][2], lo1[ND][2], hi1[ND][2];
            v_reads<ND, 0>(lo0, hi0, vb);
            asm volatile("s_waitcnt lgkmcnt(0)" ::: "memory");
            v_reads<ND, 2>(lo1, hi1, vb);
            __builtin_amdgcn_sched_barrier(0);
            pv_half<ND>(o, lo0, hi0, __builtin_bit_cast(bf16x8, pw0), __builtin_bit_cast(bf16x8, pw1));
            __builtin_amdgcn_sched_barrier(0);
            p_half<MODE>(p1, l_reg, pw2, pw3, (t <= cw - 3) || (dbg & 8), qrow - 64 * t - 4 * hi - 32, tabL);
            asm volatile("s_waitcnt lgkmcnt(0)" ::: "memory");
            __builtin_amdgcn_sched_barrier(0);
            pv_half<ND>(o, lo1, hi1, __builtin_bit_cast(bf16x8, pw2), __builtin_bit_cast(bf16x8, pw3));
        }
        if (grp == 0) PP_NEED_K(i + 1); else PP_NEED_V(i + 1);
        PP_BAR();
    }
    if (grp == 0) PP_BAR();
#undef PP_DMA_K
#undef PP_DMA_V
#undef PP_NEED_K
#undef PP_NEED_V
    float rl[16];
    l_reg += __shfl_xor(l_reg, 32);
    if (hi == 0) wsf[32 + r32] = l_reg;
    asm volatile("s_waitcnt lgkmcnt(0)" ::: "memory");
#pragma unroll
    for (int r = 0; r < 16; ++r) rl[r] = __builtin_amdgcn_rcpf(wsf[32 + crow(r, hi)]) * oscale;
    if constexpr (OUT8) {
        static_assert(!OUT8 || VD == 64, "fp8 output: 64-wide heads");
        unsigned char* Ow = (unsigned char*)Ob + (size_t)(q0 + wid * 32) * opitch;
        ALAS unsigned char* stg = (ALAS unsigned char*)(shm + L_OST) + wid * 2048;
#pragma unroll
        for (int r = 0; r < 16; ++r) { const int orow = crow(r, hi);
#pragma unroll
            for (int d0 = 0; d0 < 2; ++d0) { const float v = o[d0][r] * rl[r]; stg[orow * 64 + d0 * 32 + r32] = (unsigned char)(__builtin_amdgcn_cvt_pk_fp8_f32(v, v, 0, false) & 0xff); } }
        asm volatile("s_waitcnt lgkmcnt(0)" ::: "memory");
#pragma unroll
        for (int i = 0; i < 2; ++i) { const int row = i * 16 + (lane >> 2), ch = lane & 3; const u32x4 v = *(const ALAS u32x4*)(stg + row * 64 + ch * 16); *(u32x4*)(Ow + (size_t)row * opitch + ch * 16) = v; }
        asm volatile("s_waitcnt lgkmcnt(0)" ::: "memory");
    } else {
    bf16_t* Ow = (bf16_t*)Ob + (size_t)(q0 + wid * 32) * opitch;
    ALAS bf16_t* stg = (ALAS bf16_t*)(shm + L_OST) + wid * 2048;
#pragma unroll
    for (int half = 0; half < ND / 2; ++half) {
#pragma unroll
        for (int r = 0; r < 16; ++r) { const int orow = crow(r, hi);
#pragma unroll
            for (int d0 = 0; d0 < 2; ++d0) stg[orow * 64 + d0 * 32 + r32] = f2bf(o[half * 2 + d0][r] * rl[r]); }
        asm volatile("s_waitcnt lgkmcnt(0)" ::: "memory");
#pragma unroll
        for (int i = 0; i < 4; ++i) { const int row = i * 8 + (lane >> 3), ch = lane & 7; const u32x4 v = *(const ALAS u32x4*)(stg + row * 64 + ch * 8); *(u32x4*)(Ow + (size_t)row * opitch + half * 64 + ch * 8) = v; }
        asm volatile("s_waitcnt lgkmcnt(0)" ::: "memory");
    }
    }
    PP_BAR();
#undef PP_BAR
}
}

constexpr int NWAVES = 8, NTHR = NWAVES * 64;
constexpr int BATCH = 2, SEQ = 8192, T = BATCH * SEQ, D = 1024;
constexpr int NPROJ = 3072, FFD = 2816, FFE = 3584, NEXP = 8;
constexpr size_t MiB = 1u << 20;
constexpr size_t CTL_ZERO_BYTES = 1 * MiB;
constexpr int CW_TMO = 0, CW_BAR = 4096;
constexpr int CW_HIST = 16384;
constexpr int CW_QATT = 32768, CW_QCONV = 32768 + 64 * 8;
constexpr int CW_MOE = 24576;
constexpr size_t WS_SS0 = 1 * MiB, WS_SS3 = WS_SS0 + 65536, WS_ROPE = WS_SS3 + 65536  , WS_TOKSEL = WS_ROPE + MiB  ,
                 WS_TOKGATE = WS_TOKSEL + 65536  , WS_ROWTOK = WS_TOKGATE + 131072  , WS_ROWGATE = WS_ROWTOK + 147456  , WS_ROWSCALE = WS_ROWGATE + 147456  ;
static_assert(WS_ROWSCALE + 147456 <= 4 * MiB, "small arrays");
constexpr size_t WS_XB = 4 * MiB;
constexpr size_t WS_AO = 36 * MiB;
constexpr size_t WS_ACT0 = 68 * MiB;
constexpr size_t WS_XF = 164 * MiB;
constexpr size_t WS_WIN = 228 * MiB, WS_WO0 = 234 * MiB, WS_WGU0 = 236 * MiB, WS_WD0 = 247 * MiB, WS_WQKV = 253 * MiB, WS_WO1 = 259 * MiB;
constexpr size_t WS_WEGU = 264 * MiB;
constexpr size_t WS_WED = 376 * MiB;
constexpr size_t WS_SS1 = 432 * MiB, WS_SS2 = 433 * MiB;
constexpr size_t WS_VT8 = 434 * MiB;
constexpr size_t WS_XB8 = 442 * MiB;
constexpr size_t WS_END = 458 * MiB;
constexpr size_t WS_SORTA = 36 * MiB;
constexpr size_t WS_ACTE = 108 * MiB;
static_assert(WS_SORTA + (size_t)36864 * 2048 <= WS_ACTE && WS_ACTE + (size_t)18432 * 7168 <= WS_WO0 && WS_WD0 + (size_t)1024 * 2816 * 2 <= WS_WQKV && WS_WO1 + 2 * MiB <= WS_WEGU, "ws map");
constexpr int RING_BYTES = 131072, MISC_OFF = RING_BYTES + 320, ULIST_OFF = RING_BYTES + 1024  , RTAB_OFF = RING_BYTES + 2048  , LDS_BYTES = 155648;
static_assert(RTAB_OFF + 16 * 1024 <= LDS_BYTES, "LDS control area");
static_assert(att::L_END <= RING_BYTES, "attention LDS");

#define GAS __attribute__((address_space(1)))
#define LAS __attribute__((address_space(3)))
typedef unsigned short bf16;
typedef unsigned v4u __attribute__((ext_vector_type(4)));
typedef float f32x4 __attribute__((ext_vector_type(4)));
typedef GAS unsigned gu32;
#define RLX_AGENT __ATOMIC_RELAXED, __HIP_MEMORY_SCOPE_AGENT
#define LDS_WAIT() asm volatile("s_waitcnt lgkmcnt(0)" ::: "memory")
#define VM_WAIT() asm volatile("s_waitcnt vmcnt(0)" ::: "memory")
__device__ __forceinline__ unsigned f2bf(float f) { unsigned u = __builtin_bit_cast(unsigned, f); return (u + 0x7fffu + ((u >> 16) & 1u)) >> 16; }
__device__ __forceinline__ unsigned pk2(float lo, float hi) { return f2bf(lo) | (f2bf(hi) << 16); }
__device__ __forceinline__ float bf2f(unsigned short h) { return __builtin_bit_cast(float, (unsigned)h << 16); }
#define XB_TMO      128
#define XB_XCNT(j)  (256  + 64 * (j))
#define XB_XSUB(j)  (1280 + 64 * (j))
#define XB_XGEN(j)  (2304 + 64 * (j))
#define XB_TOP      3328
#define XB_TOPGEN   3392
#define XCD_BAR_WORDS 3456
#define XB_SPIN_CAP (1u << 18)

__device__ __forceinline__ unsigned xb_ld(unsigned* p)              { return __hip_atomic_load(p, __ATOMIC_RELAXED, __HIP_MEMORY_SCOPE_AGENT); }
__device__ __forceinline__ unsigned xb_add(unsigned* p, unsigned v) { return __hip_atomic_fetch_add(p, v, __ATOMIC_RELAXED, __HIP_MEMORY_SCOPE_AGENT); }
__device__ __forceinline__ unsigned xb_xcc_id() { return (unsigned)__builtin_amdgcn_s_getreg((3 << 11) | 20) & 0xFu; }
#define XB_SPIN(cond, bar) do { unsigned _sp = 0; while (cond) { __builtin_amdgcn_s_sleep(1); \
    if ((++_sp & 255u) == 0u) { if (xb_ld(&(bar)[XB_TMO])) break; if (_sp > XB_SPIN_CAP) { atomicAdd(&(bar)[XB_TMO], 1u); break; } } } } while (0)

struct XcdBarrier {
    unsigned* bar; unsigned x;
    volatile LAS unsigned* st;
};

__device__ __forceinline__ XcdBarrier xcd_barrier_post(unsigned* bar, volatile LAS unsigned* st) {
    XcdBarrier b; b.bar = bar; b.x = xb_xcc_id(); b.st = st;
    if (threadIdx.x == 0) (void)xb_add(&bar[XB_XCNT(b.x)], 1u);
    return b;
}
__device__ __forceinline__ void xcd_barrier_complete(unsigned* bar, unsigned x, unsigned& nloc, unsigned& nx) {
    const unsigned G = gridDim.x * gridDim.y * gridDim.z;
    unsigned sum, cnt, mine, sp = 0u;
    for (;;) {
        sum = 0u; cnt = 0u; mine = 0u;
#pragma unroll
        for (unsigned j = 0; j < 16; ++j) { const unsigned c = xb_ld(&bar[XB_XCNT(j)]); sum += c; cnt += (c > 0u) ? 1u : 0u; mine = (j == x) ? c : mine; }
        if (sum == G) break;
        __builtin_amdgcn_s_sleep(1);
        if ((++sp & 255u) == 0u) { if (xb_ld(&bar[XB_TMO])) break; if (sp > XB_SPIN_CAP) { atomicAdd(&bar[XB_TMO], 1u); break; } }
    }
    nloc = mine > 0u ? mine : 1u; nx = cnt > 0u ? cnt : 1u;
}

__device__ __forceinline__ void xcd_barrier(const XcdBarrier& b) {
    asm volatile("s_waitcnt vmcnt(0)" ::: "memory");
    __syncthreads();
    if (threadIdx.x == 0) {
        unsigned* bar = b.bar;
        __builtin_amdgcn_s_waitcnt(0);
        unsigned nloc = b.st[0], nx = b.st[1];
        if (nloc == 0u) { xcd_barrier_complete(bar, b.x, nloc, nx); b.st[0] = nloc; b.st[1] = nx; }
        const unsigned old = xb_add(&bar[XB_XSUB(b.x)], 1u);
        const unsigned gen = old / nloc;
        if (old + 1u == (gen + 1u) * nloc) {
            __builtin_amdgcn_fence(__ATOMIC_RELEASE, "agent");
            asm volatile("s_waitcnt vmcnt(0)" ::: "memory");
            const unsigned og = xb_add(&bar[XB_TOP], 1u);
            const unsigned tg = og / nx;
            if (og + 1u == (tg + 1u) * nx) xb_add(&bar[XB_TOPGEN], 1u);
            else XB_SPIN(xb_ld(&bar[XB_TOPGEN]) == tg, bar);
            __builtin_amdgcn_fence(__ATOMIC_ACQUIRE, "agent");
            xb_add(&bar[XB_XGEN(b.x)], 1u);
            asm volatile("s_waitcnt vmcnt(0)" ::: "memory");
        } else {
            XB_SPIN(xb_ld(&bar[XB_XGEN(b.x)]) == gen, bar);
            __builtin_amdgcn_fence(__ATOMIC_ACQUIRE, "agent");
            asm volatile("s_waitcnt vmcnt(0)" ::: "memory");
        }
    }
    __syncthreads();
}

__device__ __forceinline__ float wave_sum(float v) {
#pragma unroll
    for (int o = 1; o < 64; o <<= 1) v += __shfl_xor(v, o);
    return v;
}
__device__ __forceinline__ float wave_max(float v) {
#pragma unroll
    for (int o = 1; o < 64; o <<= 1) v = fmaxf(v, __shfl_xor(v, o));
    return v;
}
__device__ __forceinline__ int dest_block(int blk, int map) {
    if (map == 1) { const int s = blk & 7; return (blk & ~7) + 4 * (s & 1) + (s >> 1); }
    if (map == 2) return (blk >> 2) * 8 + (blk & 3);
    if (map == 3) return (blk >> 2) * 8 + 4 + (blk & 3);
    return blk;
}
__device__ __forceinline__ void tr_tile(const float* W, int K, int N, bf16* WT, int map, const float* gain, LAS unsigned* scr, int item, int lane) {
    const int nblk = N / 64, kb = item / nblk, nb = item % nblk, k0 = 64 * kb, n0 = 64 * nb;
    const int c = lane & 15, ip = lane >> 4;
#pragma unroll
    for (int it = 0; it < 8; ++it) { const int kp = it * 4 + ip, k = k0 + 2 * kp;
        f32x4 a = *(const GAS f32x4*)(W + (size_t)k * N + n0 + 4 * c), b = *(const GAS f32x4*)(W + (size_t)(k + 1) * N + n0 + 4 * c);
        if (gain) { a = a * gain[k]; b = b * gain[k + 1]; }
#pragma unroll
        for (int j = 0; j < 4; ++j) scr[(4 * c + j) * 33 + kp] = pk2(a[j], b[j]); }
    LDS_WAIT(); asm volatile("" ::: "memory");
#pragma unroll
    for (int it = 0; it < 8; ++it) { const int n = it * 8 + (lane >> 3), q = lane & 7;
        v4u o; o.x = scr[n * 33 + 4 * q]; o.y = scr[n * 33 + 4 * q + 1]; o.z = scr[n * 33 + 4 * q + 2]; o.w = scr[n * 33 + 4 * q + 3];
        const int drow = dest_block((n0 + n) >> 5, map) * 32 + (n & 31);
        *(GAS v4u*)(WT + (size_t)drow * K + k0 + 8 * q) = o; }
    LDS_WAIT(); asm volatile("" ::: "memory");
}

__device__ __forceinline__ void tr_tile8(const float* W, int K, int N, unsigned char* WT, int map, const float* gain, float wscale, LAS unsigned* scr, int item, int lane) {
    const int nblk = N / 64, kb = item / nblk, nb = item % nblk, k0 = 64 * kb, n0 = 64 * nb;
    const int c = lane & 15, ip = lane >> 4;
#pragma unroll
    for (int it = 0; it < 4; ++it) { const int k4 = it * 4 + ip, k = k0 + 4 * k4; f32x4 a[4];
#pragma unroll
        for (int i = 0; i < 4; ++i) a[i] = *(const GAS f32x4*)(W + (size_t)(k + i) * N + n0 + 4 * c) * ((gain ? gain[k + i] : 1.f) * wscale);
#pragma unroll
        for (int j = 0; j < 4; ++j) scr[(4 * c + j) * 17 + k4] = pg8::pk4_fp8(a[0][j], a[1][j], a[2][j], a[3][j]); }
    LDS_WAIT(); asm volatile("" ::: "memory");
#pragma unroll
    for (int it = 0; it < 4; ++it) { const int n = it * 16 + (lane >> 2), q = lane & 3;
        v4u o; o.x = scr[n * 17 + 4 * q]; o.y = scr[n * 17 + 4 * q + 1]; o.z = scr[n * 17 + 4 * q + 2]; o.w = scr[n * 17 + 4 * q + 3];
        const int drow = dest_block((n0 + n) >> 5, map) * 32 + (n & 31);
        *(GAS v4u*)(WT + (size_t)drow * K + k0 + 16 * q) = o; }
    LDS_WAIT(); asm volatile("" ::: "memory");
}

struct TrItem { const float* W; unsigned char* WT; const float* gain; int K, N, map, fp8, k0, n0; float scale; };
__device__ __forceinline__ void tr_load(const TrItem& d, f32x4 (&a)[16], float (&g)[16], int lane) {
    const int c = lane & 15, ip = lane >> 4;
#pragma unroll
    for (int it = 0; it < 4; ++it)
#pragma unroll
        for (int i = 0; i < 4; ++i) { const int k = d.k0 + 4 * (it * 4 + ip) + i;
            a[it * 4 + i] = __builtin_nontemporal_load((const GAS f32x4*)(d.W + (size_t)k * d.N + d.n0 + 4 * c)); g[it * 4 + i] = d.gain ? d.gain[k] : 1.f; }
}
__device__ __forceinline__ void tr_emit(const TrItem& d, const f32x4 (&a)[16], const float (&g)[16], LAS unsigned* scr, int lane) {
    const int c = lane & 15, ip = lane >> 4;
    if (d.fp8) {
#pragma unroll
        for (int it = 0; it < 4; ++it) { const int k4 = it * 4 + ip;
#pragma unroll
            for (int j = 0; j < 4; ++j) scr[(4 * c + j) * 17 + k4] = pg8::pk4_fp8(a[it * 4][j] * (g[it * 4] * d.scale), a[it * 4 + 1][j] * (g[it * 4 + 1] * d.scale), a[it * 4 + 2][j] * (g[it * 4 + 2] * d.scale), a[it * 4 + 3][j] * (g[it * 4 + 3] * d.scale)); }
        LDS_WAIT(); asm volatile("" ::: "memory");
#pragma unroll
        for (int it = 0; it < 4; ++it) { const int n = it * 16 + (lane >> 2), q = lane & 3;
            v4u o; o.x = scr[n * 17 + 4 * q]; o.y = scr[n * 17 + 4 * q + 1]; o.z = scr[n * 17 + 4 * q + 2]; o.w = scr[n * 17 + 4 * q + 3];
            const int drow = dest_block((d.n0 + n) >> 5, d.map) * 32 + (n & 31);
            __builtin_nontemporal_store(o, (GAS v4u*)(d.WT + (size_t)drow * d.K + d.k0 + 16 * q)); }
    } else {
#pragma unroll
        for (int it = 0; it < 4; ++it) { const int k4 = it * 4 + ip;
#pragma unroll
            for (int j = 0; j < 4; ++j) { scr[(4 * c + j) * 33 + 2 * k4] = pk2(a[it * 4][j] * g[it * 4], a[it * 4 + 1][j] * g[it * 4 + 1]); scr[(4 * c + j) * 33 + 2 * k4 + 1] = pk2(a[it * 4 + 2][j] * g[it * 4 + 2], a[it * 4 + 3][j] * g[it * 4 + 3]); } }
        LDS_WAIT(); asm volatile("" ::: "memory");
#pragma unroll
        for (int it = 0; it < 8; ++it) { const int n = it * 8 + (lane >> 3), q = lane & 7;
            v4u o; o.x = scr[n * 33 + 4 * q]; o.y = scr[n * 33 + 4 * q + 1]; o.z = scr[n * 33 + 4 * q + 2]; o.w = scr[n * 33 + 4 * q + 3];
            const int drow = dest_block((d.n0 + n) >> 5, d.map) * 32 + (n & 31);
            __builtin_nontemporal_store(o, (GAS v4u*)(d.WT + ((size_t)drow * d.K + d.k0 + 8 * q) * 2)); }
    }
    LDS_WAIT(); asm volatile("" ::: "memory");
}
constexpr int SB_NRES = 7;
constexpr int NJOBS_P5 = 64;
constexpr float AO8_SCALE = 16.f;
constexpr float W8_SCALE = 64.f;

#ifndef PROBE_MASK
#define PROBE_MASK 0
#endif
struct KArgs { const void* in[27]; float* out; unsigned char* ws; int ph_lo, ph_hi, flags, pad; };

struct KArgs;
__device__ __forceinline__ const void* karg_in(const KArgs& a, int k) { asm volatile("" : "+s"(k)); return a.in[k]; }
__global__ void __launch_bounds__(NTHR, 2) fwd_kernel(KArgs args) {
    extern __shared__ __attribute__((aligned(16))) unsigned char lds_raw[];
    LAS unsigned char* lds = (LAS unsigned char*)lds_raw;
    volatile LAS unsigned* MISC = (volatile LAS unsigned*)(lds + MISC_OFF);
    const int tid = threadIdx.x, lane = tid & 63, wave = __builtin_amdgcn_readfirstlane(tid >> 6);
    const int G = gridDim.x; const int bx = blockIdx.x; const int vcu = (G % 8 == 0) ? (bx % 8) * (G / 8) + bx / 8 : bx;
    unsigned char* ws = args.ws;
    unsigned* ctl = (unsigned*)ws;
    for (int u = tid; u < (LDS_BYTES - RING_BYTES) / 4; u += NTHR) ((LAS unsigned*)(lds + RING_BYTES))[u] = 0u;
    __syncthreads();
    XcdBarrier bar = xcd_barrier_post(ctl + CW_BAR, MISC + 8);
    const int lo = args.ph_lo, hi_ph = args.ph_hi;
#define IN(k) (lo <= (k) && (k) < hi_ph)
#define REP(k)
#define SEAM(k) do { if (IN(k) && IN((k) + 1)) xcd_barrier(bar); } while (0)
#define KIN(T, k) ((const T*)karg_in(args, (k)))
#define x_in KIN(float, 0)
#define positions KIN(int, 1)
#define ev_attn_norm KIN(float, 2)
#define ev_w_in KIN(float, 3)
#define ev_q_norm KIN(float, 4)
#define ev_k_norm KIN(float, 5)
#define ev_lq1 KIN(float, 6)
#define ev_lk1 KIN(float, 7)
#define ev_lq2 KIN(float, 8)
#define ev_lk2 KIN(float, 9)
#define ev_subln KIN(float, 10)
#define ev_w_out KIN(float, 11)
#define ev_ffn_norm KIN(float, 12)
#define ev_w_gate KIN(float, 13)
#define ev_w_up KIN(float, 14)
#define ev_w_down KIN(float, 15)
#define od_attn_norm KIN(float, 16)
#define od_w_qkv KIN(float, 17)
#define od_q_norm KIN(float, 18)
#define od_k_norm KIN(float, 19)
#define od_rel_bias KIN(float, 20)
#define od_w_out KIN(float, 21)
#define od_ffn_norm KIN(float, 22)
#define od_router KIN(float, 23)
#define od_we_gate KIN(float, 24)
#define od_we_up KIN(float, 25)
#define od_we_down KIN(float, 26)
    float* out = args.out;
    float* ss0 = (float*)(ws + WS_SS0); float* ss1 = (float*)(ws + WS_SS1); float* ss2 = (float*)(ws + WS_SS2); float* ss3 = (float*)(ws + WS_SS3);
    float* rope = (float*)(ws + WS_ROPE); unsigned* toksel = (unsigned*)(ws + WS_TOKSEL); float* tokgate = (float*)(ws + WS_TOKGATE);
    int* rowtok = (int*)(ws + WS_ROWTOK); float* rowgate = (float*)(ws + WS_ROWGATE); float* rowscale = (float*)(ws + WS_ROWSCALE);
    bf16* XB = (bf16*)(ws + WS_XB); bf16* AO = (bf16*)(ws + WS_AO); bf16* ACT0 = (bf16*)(ws + WS_ACT0); float* XF = (float*)(ws + WS_XF); bf16* OD = (bf16*)(ws + WS_XF);
    bf16* Win_t = (bf16*)(ws + WS_WIN); bf16* Wo0_t = (bf16*)(ws + WS_WO0); bf16* Wgu0_t = (bf16*)(ws + WS_WGU0); bf16* Wd0_t = (bf16*)(ws + WS_WD0);
    unsigned char* Wqkv8 = ws + WS_WQKV; unsigned char* Wo18 = ws + WS_WO1; unsigned char* XB8 = ws + WS_XB8; unsigned char* AO8 = ws + WS_AO; unsigned char* WEgu8 = ws + WS_WEGU; unsigned char* WEd8 = ws + WS_WED;
    unsigned char* SORTA8 = ws + WS_SORTA; unsigned char* ACTE8 = ws + WS_ACTE;
    const int gw = vcu * NWAVES + wave, NGW = G * NWAVES;

    constexpr int I_IN = 16 * 48, I_O = 16 * 16, I_G = 16 * 44, I_D = 44 * 16, I_EG = 16 * 56, I_ED = 56 * 16;
    constexpr int NSMALL = I_IN + I_O + 2 * I_G + I_D + I_IN + I_O, NITEMS = NSMALL + 24 * I_EG;
        auto decode = [&](int it) -> TrItem {
        TrItem d; int r = it; d.scale = 1.f; d.fp8 = 0; d.gain = nullptr; d.map = 0;
        auto fin = [&](int nbl) { d.k0 = 64 * (r / nbl); d.n0 = 64 * (r % nbl); };
        if (r < I_IN) { d.W = ev_w_in; d.K = D; d.N = NPROJ; d.WT = (unsigned char*)Win_t; d.map = 1; d.gain = ev_attn_norm; fin(NPROJ / 64); return d; } r -= I_IN;
        if (r < I_O) { d.W = ev_w_out; d.K = D; d.N = D; d.WT = (unsigned char*)Wo0_t; fin(D / 64); return d; } r -= I_O;
        if (r < I_G) { d.W = ev_w_gate; d.K = D; d.N = FFD; d.WT = (unsigned char*)Wgu0_t; d.map = 2; d.gain = ev_ffn_norm; fin(FFD / 64); return d; } r -= I_G;
        if (r < I_G) { d.W = ev_w_up; d.K = D; d.N = FFD; d.WT = (unsigned char*)Wgu0_t; d.map = 3; d.gain = ev_ffn_norm; fin(FFD / 64); return d; } r -= I_G;
        if (r < I_D) { d.W = ev_w_down; d.K = FFD; d.N = D; d.WT = (unsigned char*)Wd0_t; fin(D / 64); return d; } r -= I_D;
        d.fp8 = 1; d.scale = W8_SCALE;
        if (r < I_IN) { d.W = od_w_qkv; d.K = D; d.N = NPROJ; d.WT = Wqkv8; d.map = 1; d.gain = od_attn_norm; fin(NPROJ / 64); return d; } r -= I_IN;
        if (r < I_O) { d.W = od_w_out; d.K = D; d.N = D; d.WT = Wo18; fin(D / 64); return d; } r -= I_O;
        const int which = r / (8 * I_EG), rr = r % (8 * I_EG), e2 = rr / I_EG; r = rr % I_EG;
        if (which == 0) { d.W = od_we_gate + (size_t)e2 * D * FFE; d.K = D; d.N = FFE; d.WT = WEgu8 + (size_t)e2 * 2 * FFE * D; d.map = 2; d.gain = od_ffn_norm; fin(FFE / 64); }
        else if (which == 1) { d.W = od_we_up + (size_t)e2 * D * FFE; d.K = D; d.N = FFE; d.WT = WEgu8 + (size_t)e2 * 2 * FFE * D; d.map = 3; d.gain = od_ffn_norm; fin(FFE / 64); }
        else { d.W = od_we_down + (size_t)e2 * FFE * D; d.K = FFE; d.N = D; d.WT = WEd8 + (size_t)e2 * D * FFE; fin(D / 64); }
        return d; };
    auto conv_range = [&](int first, int end, int stride) {
        LAS unsigned* scr = (LAS unsigned*)(lds + wave * 8704);
        f32x4 bufA[16], bufB[16]; float gA[16], gB[16]; TrItem dA, dB; int it = first;
        if (it < end) { dA = decode(it); tr_load(dA, bufA, gA, lane); }
        while (it < end) {
            const int it2 = it + stride, it3 = it2 + stride;
            if (it2 < end) { dB = decode(it2); tr_load(dB, bufB, gB, lane); }
            tr_emit(dA, bufA, gA, scr, lane);
            if (it3 < end) { dA = decode(it3); tr_load(dA, bufA, gA, lane); }
            if (it2 < end) tr_emit(dB, bufB, gB, scr, lane);
            it = it3; } };
    auto pull = [&](int qword) -> int {
        __syncthreads(); if (tid == 0) MISC[16] = __hip_atomic_fetch_add(ctl + qword, 1u, __ATOMIC_RELAXED, __HIP_MEMORY_SCOPE_AGENT); __syncthreads();
        return __builtin_amdgcn_readfirstlane((int)MISC[16]); };

    REP(0) if (IN(0)) {
        conv_range(wave * G + vcu, I_IN, NGW);
        for (int m0 = gw; m0 < T; m0 += 2 * NGW) {
            f32x4 v[2][4];
#pragma unroll
            for (int u = 0; u < 2; ++u) { const int m = m0 + u * NGW; if (m < T) { const GAS f32x4* xr = (const GAS f32x4*)(x_in + (size_t)m * D) + lane;
#pragma unroll
                for (int j = 0; j < 4; ++j) v[u][j] = __builtin_nontemporal_load(xr + 64 * j); } }
#pragma unroll
            for (int u = 0; u < 2; ++u) { const int m = m0 + u * NGW; if (m >= T) break; float s = 0.f;
#pragma unroll
                for (int j = 0; j < 4; ++j) s += (v[u][j].x * v[u][j].x + v[u][j].y * v[u][j].y) + (v[u][j].z * v[u][j].z + v[u][j].w * v[u][j].w);
                s = wave_sum(s); if (lane == 0) ss0[m] = s;
                GAS unsigned long long* o8 = (GAS unsigned long long*)(XB + (size_t)m * D) + lane;
#pragma unroll
                for (int j = 0; j < 4; ++j) o8[64 * j] = (unsigned long long)pk2(v[u][j].x, v[u][j].y) | ((unsigned long long)pk2(v[u][j].z, v[u][j].w) << 32); }
        }
        for (int i = vcu * NTHR + tid; i < T * 8; i += G * NTHR) {
            const int tok = i >> 3, f = i & 7;
            const double inv = (f == 0) ? 1.0 : (f == 1) ? 0.19392274474868576 : (f == 2) ? 0.03760603093086393 : (f == 3) ? 0.007292664737217109 : (f == 4) ? 0.001414213562373095 : (f == 5) ? 0.0002742481756762073 : (f == 6) ? 5.318295896944988e-05 : 1.031338537721246e-05;
            double ang = (double)positions[tok] * inv; ang -= 6.283185307179586 * rint(ang * 0.15915494309189535);
            float sn, cs; sincosf((float)ang, &sn, &cs);
            rope[(size_t)tok * 16 + f] = cs; rope[(size_t)tok * 16 + 8 + f] = sn;
        }
    }
    SEAM(0);

    LAS int* ulist = (LAS int*)(lds + ULIST_OFF);
    LAS float* rtab = (LAS float*)(lds + RTAB_OFF);
    const auto no_rows = [](const pg8::Unit&, int) { return 0.f; };
#define RUN_GEMM(EPI, ALIGN, F8, g, S, E, RT, ROWFN) do { pg8::build_unit_list((S), ulist, (RT), (ROWFN)); const pg8::ListOrder LO_{ulist}; pg8::gemm_phase<EPI, pg8::ListOrder, ALIGN, true, F8>(lds, (g), LO_, (E)); } while (0)
    REP(1) if (IN(1)) {
        pg8::Gemm g{XB, Win_t, T, NPROJ, D}; pg8::StaticOrder S; S.init(T, NPROJ, G, bx);
        pg8::EpiProj E{ACT0, T, ss0, 1, ev_q_norm, ev_k_norm, rope, 0, 1.f, rtab, ws + WS_VT8};
        const float* ssp = ss0; const auto rowfn = [ssp](const pg8::Unit& u, int lr) { return rsqrtf(ssp[u.pm * 256 + lr] * (1.f / 1024.f) + pg8::RMS_EPS); };
        RUN_GEMM(pg8::EpiProj, true, false, g, S, E, rtab, rowfn);
    }
    SEAM(1);

    REP(2) if (IN(2)) {
        const float gq_raw2 = fabsf(ev_q_norm[lane]), gk_raw2 = fabsf(ev_k_norm[lane]);
        float mref = 0.f; bool have_mref = false;
        const int NJOBS = (NITEMS - I_IN + 63) / 64 - (G == 256 ? NJOBS_P5 : 0);
        const bool conv_first = ((bx >> 3) & 3) == 3;
#define P2_CONV_LOOP() for (;;) { const int j = pull(CW_QCONV); if (j >= NJOBS) break; \
            const int first = I_IN + j * 64 + wave * 8; conv_range(first, (first + 8 < NITEMS) ? first + 8 : NITEMS, 1); }
        if (conv_first) P2_CONV_LOOP()
#pragma unroll 1
        for (int kq = 0; kq < 8; ++kq) { const int xq = (bx + kq) & 7;
            for (int idx = pull(CW_QATT + 64 * xq); idx < 128; ) {
                if (!have_mref) { mref = 8.f * wave_max(gq_raw2) * wave_max(gk_raw2) * pg8::LOG2E; have_mref = true; }
                if (idx < 64) { if (args.flags & 1) { idx = pull(CW_QATT + 64 * xq); continue; }
                    const int bhm = 2 * xq + (idx & 1), qb = 31 - (idx >> 1);
                    const int b = bhm >> 3, hm = bhm & 7, h = hm >> 1;
                    const bf16* base = ACT0 + (size_t)b * SEQ * 64;
                    att::attn_unit_lag<0, 128, false, true>((LAS char*)lds, base + (size_t)(24 + hm) * T * 64, base + (size_t)(32 + hm) * T * 64, nullptr, OD + (size_t)b * SEQ * D + hm * 128, D, qb * 256, mref, nullptr, 1.f, ws + WS_VT8 + (size_t)(h * 128) * T + (size_t)b * SEQ, true, ctl + CW_QATT + 64 * xq, MISC_OFF + 64);
                } else { if (args.flags & 2) { idx = pull(CW_QATT + 64 * xq); continue; }
                    const int bh = 2 * xq + (idx & 1), qb = 31 - ((idx - 64) >> 1);
                    const int b = bh >> 3, h = bh & 7;
                    const bf16* base = ACT0 + (size_t)b * SEQ * 64;
                    att::attn_unit_sb<SB_NRES>((LAS char*)lds, base + (size_t)h * T * 64, base + (size_t)(8 + h) * T * 64, base + (size_t)(16 + h) * T * 64, AO + (size_t)b * SEQ * D + h * 64, D, qb * 256, ctl + CW_QATT + 64 * xq, MISC_OFF + 64);
                }
                idx = __builtin_amdgcn_readfirstlane((int)MISC[16]);
            }
        }
        P2_CONV_LOOP()
#undef P2_CONV_LOOP
    }
    SEAM(2);

    REP(3) if (IN(3)) {
        const int h = lane >> 4, v0 = (lane & 15) * 8;
        v4u a4[8], b4[8];
        const auto p3_load = [&](int m0) {
#pragma unroll
            for (int u = 0; u < 8; ++u) { const int m = m0 + u * NGW; if (m < T) { a4[u] = *(const GAS v4u*)(OD + (size_t)m * D + (2 * h) * 128 + v0); b4[u] = *(const GAS v4u*)(OD + (size_t)m * D + (2 * h + 1) * 128 + v0); } } };
        if (gw < T) p3_load(gw);
        const float a1 = wave_sum(ev_lq1[lane] * ev_lk1[lane]), a2 = wave_sum(ev_lq2[lane] * ev_lk2[lane]);
        const float lam_init = 0.2f, lam = expf(a1) - expf(a2) + lam_init;
        float sg[8];
#pragma unroll
        for (int j = 0; j < 8; ++j) sg[j] = ev_subln[v0 + j] * (1.f - lam_init);
        for (int m0 = gw; m0 < T; m0 += 8 * NGW) {
            if (m0 != gw) p3_load(m0);
#pragma unroll
            for (int u = 0; u < 8; ++u) { const int m = m0 + u * NGW; if (m >= T) break;
                const v4u a = a4[u], b = b4[u]; float d[8]; float s = 0.f;
#pragma unroll
                for (int j = 0; j < 4; ++j) { const unsigned ua = a[j], ub = b[j];
                    d[2 * j] = bf2f((unsigned short)(ua & 0xffffu)) - lam * bf2f((unsigned short)(ub & 0xffffu));
                    d[2 * j + 1] = bf2f((unsigned short)(ua >> 16)) - lam * bf2f((unsigned short)(ub >> 16));
                    s += d[2 * j] * d[2 * j] + d[2 * j + 1] * d[2 * j + 1]; }
                s += __shfl_xor(s, 1); s += __shfl_xor(s, 2); s += __shfl_xor(s, 4); s += __shfl_xor(s, 8);
                const float rs = rsqrtf(s * (1.f / 128.f) + pg8::RMS_EPS);
                v4u o; o.x = pk2(d[0] * rs * sg[0], d[1] * rs * sg[1]); o.y = pk2(d[2] * rs * sg[2], d[3] * rs * sg[3]); o.z = pk2(d[4] * rs * sg[4], d[5] * rs * sg[5]); o.w = pk2(d[6] * rs * sg[6], d[7] * rs * sg[7]);
                *(GAS v4u*)(AO + (size_t)m * D + 512 + h * 128 + v0) = o; }
        }
    }
    SEAM(3);

    REP(4) if (IN(4)) {
        pg8::Gemm g{AO, Wo0_t, T, D, D}; pg8::StaticOrder S; S.init(T, D, G, bx);
        pg8::EpiResid E{nullptr, XB, nullptr, XB, ss1, 1.f, nullptr};
        RUN_GEMM(pg8::EpiResid, false, false, g, S, E, (LAS float*)nullptr, no_rows);
    }
    SEAM(4);

    REP(5) if (IN(5)) {
        pg8::Gemm g{XB, Wgu0_t, T, 2 * FFD, D}; pg8::StaticOrder S; S.init(T, 2 * FFD, G, bx, (args.flags >> 9) & 1);
        pg8::EpiSwiglu<false> E{ACT0, FFD, ss1, 16, nullptr, 0, 2 * FFD / 256, 1.f, rtab};
        const float* ssp = ss1; const auto rowfn = [ssp](const pg8::Unit& u, int lr) { return rsqrtf(pg8::row_ss(ssp, 16, u.pm * 256 + lr) * (1.f / 1024.f) + pg8::RMS_EPS); };
        RUN_GEMM(pg8::EpiSwiglu<false>, true, false, g, S, E, rtab, rowfn);
        if (G == 256 && bx >= 128) { __syncthreads();
            const int hj = bx - 128, first = I_IN + ((NITEMS - I_IN) / 64 - NJOBS_P5 + (hj >> 1)) * 64 + (hj & 1) * 32 + wave * 4;
            conv_range(first, first + 4, 1); }
    }
    SEAM(5);

    if (IN(6)) {
        pg8::Gemm g{ACT0, Wd0_t, T, D, FFD}; pg8::StaticOrder S; S.init(T, D, G, bx);
        pg8::EpiResid E{nullptr, XB, nullptr, XB, ss2, 1.f, XB8};
        RUN_GEMM(pg8::EpiResid, false, false, g, S, E, (LAS float*)nullptr, no_rows);
    }
    SEAM(6);

    REP(7) if (IN(7)) {
        pg8::Gemm g{(const bf16*)XB8, (const bf16*)Wqkv8, T, NPROJ, D / 2}; pg8::StaticOrder S; S.init(T, NPROJ, G, bx);
        pg8::EpiProj E{ACT0, T, ss2, 16, od_q_norm, od_k_norm, nullptr, 1, 1.f / W8_SCALE, rtab, nullptr};
        const float* ssp = ss2; const auto rowfn = [ssp](const pg8::Unit& u, int lr) { return rsqrtf(pg8::row_ss(ssp, 16, u.pm * 256 + lr) * (1.f / 1024.f) + pg8::RMS_EPS); };
        RUN_GEMM(pg8::EpiProj, true, true, g, S, E, rtab, rowfn);
    }
    SEAM(7);

    REP(8) if (IN(8)) {
        const float gq_raw = fabsf(od_q_norm[lane]), gk_raw = fabsf(od_k_norm[lane]);
        const float* tab0 = od_rel_bias + (((vcu & 255) >> 3) & 15) * 257;
        const float t0a = tab0[lane], t0b = tab0[64 + lane], t0c = tab0[128 + lane], t0d = tab0[192 + lane], t0e = tab0[256];
        const float gqm = wave_max(gq_raw), gkm = wave_max(gk_raw);
        const float tm0 = wave_max(fmaxf(fmaxf(fmaxf(fabsf(t0a), fabsf(t0b)), fmaxf(fabsf(t0c), fabsf(t0d))), fabsf(t0e)));
        int bh_prev = -1; float mref = 0.f;
        for (int L = vcu; L < 1024; L += G) {
            const int bh = (L & 255) >> 3, qb = 4 * (L & 7) + (L >> 8);
            const int b = bh >> 4, h = bh & 15;
            const float* tab = od_rel_bias + h * 257;
            const bool fresh = (bh != bh_prev); bh_prev = bh;
            if (fresh) { float tm = tm0;
                if (L != vcu) { tm = fabsf(tab[lane]); tm = fmaxf(tm, fabsf(tab[64 + lane])); tm = fmaxf(tm, fabsf(tab[128 + lane])); tm = fmaxf(tm, fabsf(tab[192 + lane])); tm = fmaxf(tm, fabsf(tab[256])); tm = wave_max(tm); }
                mref = (8.f * gqm * gkm + tm) * pg8::LOG2E; }
            const bf16* base = ACT0 + (size_t)b * SEQ * 64;
            att::attn_unit_lag<1, 64, true>((LAS char*)lds, base + (size_t)h * T * 64, base + (size_t)(16 + h) * T * 64, base + (size_t)(32 + h) * T * 64, AO8 + (size_t)b * SEQ * D + h * 64, D, qb * 256, mref, tab, AO8_SCALE, nullptr, fresh);
        }
    }
    SEAM(8);

    REP(9) if (IN(9)) {
        pg8::Gemm g{(const bf16*)AO8, (const bf16*)Wo18, T, D, D / 2}; pg8::StaticOrder S; S.init(T, D, G, bx);
        pg8::EpiResid E{nullptr, XB, nullptr, XB, nullptr, 1.f / (W8_SCALE * AO8_SCALE), nullptr};
        RUN_GEMM(pg8::EpiResid, false, true, g, S, E, (LAS float*)nullptr, no_rows);
    }
    SEAM(9);

    REP(10) if (IN(10)) {
        LAS float* wrT = (LAS float*)lds;
        LAS unsigned* sel = (LAS unsigned*)(lds + 32768);
        for (int i = tid; i < 1024; i += NTHR) { const float gn = od_ffn_norm[i]; const f32x4 w0 = *(const GAS f32x4*)(od_router + (size_t)i * 8), w1 = *(const GAS f32x4*)(od_router + (size_t)i * 8 + 4);
            wrT[i] = w0.x * gn; wrT[1024 + i] = w0.y * gn; wrT[2048 + i] = w0.z * gn; wrT[3072 + i] = w0.w * gn; wrT[4096 + i] = w1.x * gn; wrT[5120 + i] = w1.y * gn; wrT[6144 + i] = w1.z * gn; wrT[7168 + i] = w1.w * gn; }
        __syncthreads();
        for (int blk = vcu; blk < T / 64; blk += G) {
            {
                const int tk = lane >> 4, sub = lane & 15; const int tokA = blk * 64 + wave * 8 + tk, tokB = tokA + 4;
                typedef unsigned u32x2 __attribute__((ext_vector_type(2)));
                const GAS u32x2* xa = (const GAS u32x2*)(XB + (size_t)tokA * D) + sub; const GAS u32x2* xb = (const GAS u32x2*)(XB + (size_t)tokB * D) + sub;
                const auto up4 = [](u32x2 w) -> f32x4 { f32x4 r; r.x = __builtin_bit_cast(float, w.x << 16); r.y = __builtin_bit_cast(float, w.x & 0xffff0000u); r.z = __builtin_bit_cast(float, w.y << 16); r.w = __builtin_bit_cast(float, w.y & 0xffff0000u); return r; };
                float sA = 0.f, sB = 0.f; float lgA[8], lgB[8];
#pragma unroll
                for (int e2 = 0; e2 < 8; ++e2) { lgA[e2] = 0.f; lgB[e2] = 0.f; }
#pragma unroll 2
                for (int jh = 0; jh < 4; ++jh) { u32x2 va[4], vb[4];
#pragma unroll
                    for (int j = 0; j < 4; ++j) { va[j] = xa[16 * (4 * jh + j)]; vb[j] = xb[16 * (4 * jh + j)]; }
#pragma unroll
                    for (int j = 0; j < 4; ++j) { const f32x4 v = up4(va[j]), u = up4(vb[j]);
                        sA += (v.x * v.x + v.y * v.y) + (v.z * v.z + v.w * v.w); sB += (u.x * u.x + u.y * u.y) + (u.z * u.z + u.w * u.w);
#pragma unroll
                        for (int e2 = 0; e2 < 8; ++e2) { const f32x4 w = *(const LAS f32x4*)(wrT + e2 * 1024 + 64 * (4 * jh + j) + 4 * sub);
                            lgA[e2] += (v.x * w.x + v.y * w.y) + (v.z * w.z + v.w * w.w); lgB[e2] += (u.x * w.x + u.y * w.y) + (u.z * w.z + u.w * w.w); } } }
#pragma unroll
                for (int o = 1; o < 16; o <<= 1) { sA += __shfl_xor(sA, o); sB += __shfl_xor(sB, o);
#pragma unroll
                    for (int e2 = 0; e2 < 8; ++e2) { lgA[e2] += __shfl_xor(lgA[e2], o); lgB[e2] += __shfl_xor(lgB[e2], o); } }
                if (sub == 0) {
                    const auto finish = [&](int tok, float s, const float (&lg)[8], int si) {
                        const float r = rsqrtf(s * (1.f / 1024.f) + pg8::RMS_EPS); ss3[tok] = s;
                        int e0 = 0; float v0 = lg[0];
#pragma unroll
                        for (int e2 = 1; e2 < 8; ++e2) if (lg[e2] > v0) { v0 = lg[e2]; e0 = e2; }
                        int e1 = -1; float v1 = 0.f;
#pragma unroll
                        for (int e2 = 0; e2 < 8; ++e2) if (e2 != e0 && (e1 < 0 || lg[e2] > v1)) { v1 = lg[e2]; e1 = e2; }
                        const float ex = expf((v1 - v0) * r), g0 = 1.f / (1.f + ex), g1 = ex / (1.f + ex);
                        sel[si] = (unsigned)e0 | ((unsigned)e1 << 8); tokgate[2 * tok] = g0; tokgate[2 * tok + 1] = g1; };
                    finish(tokA, sA, lgA, wave * 8 + tk); finish(tokB, sB, lgB, wave * 8 + 4 + tk);
                }
            }
            __syncthreads();
            if (wave == 0) { const unsigned sv = sel[lane]; const int e0 = sv & 0xff, e1 = sv >> 8; unsigned rank0 = 0, rank1 = 0;
                const unsigned long long lt = (1ull << lane) - 1ull;
#pragma unroll
                for (int e = 0; e < 8; ++e) { const unsigned long long m0 = __ballot(e0 == e), m1 = __ballot(e1 == e);
                    if (e0 == e) rank0 = __popcll(m0 & lt); if (e1 == e) rank1 = __popcll(m1 & lt);
                    if (lane == 0) { ctl[CW_HIST + blk * 16 + e] = __popcll(m0); ctl[CW_HIST + blk * 16 + 8 + e] = __popcll(m1); } }
                toksel[blk * 64 + lane] = sv | (rank0 << 16) | (rank1 << 24); }
            __syncthreads();
        }
    }
    SEAM(10);

    REP(11) if (IN(11)) {
        LAS unsigned* hs = (LAS unsigned*)lds;
        unsigned svs[8]; v4u w0s[8], w1s[8]; float tg0[8], tg1[8], s3s[8];
        const auto p11_load = [&](int blk) {
#pragma unroll
            for (int u = 0; u < 8; ++u) { const int tok = blk * 64 + wave + 8 * u; svs[u] = toksel[tok]; tg0[u] = tokgate[2 * tok]; tg1[u] = tokgate[2 * tok + 1]; s3s[u] = ss3[tok];
                w0s[u] = *(const GAS v4u*)(XB + (size_t)tok * D + 16 * lane); w1s[u] = *(const GAS v4u*)(XB + (size_t)tok * D + 16 * lane + 8); } };
        if (vcu < T / 64) p11_load(vcu);
        for (int i = tid; i < 4096; i += NTHR) hs[i] = ctl[CW_HIST + i];
        __syncthreads();
        if (tid < 16) hs[4096 + tid] = 0u;
        __syncthreads();
        { unsigned s = 0; const int g2 = tid & 15;
#pragma unroll
          for (int b2 = tid >> 4; b2 < 256; b2 += 32) s += hs[b2 * 16 + g2];
          atomicAdd((unsigned*)&hs[4096 + g2], s); }
        __syncthreads();
        if (tid == 0) { unsigned acc = 0; for (int g2 = 0; g2 < 16; ++g2) { hs[4128 + g2] = acc; acc += (hs[4096 + g2] + 255u) & ~255u; } hs[4128 + 16] = acc; }
        __syncthreads();
        if (bx == 0) {
            if (wave == 0) { const int nA = (int)(hs[4128 + 8] >> 8), nT = (int)(hs[4128 + 16] >> 8), nC1 = (nT - nA + 1) / 2, nC2 = nT - nA - nC1;
                if (lane == 0) { ctl[CW_MOE] = nA; ctl[CW_MOE + 1] = nT; }
                for (int ph = 0; ph < 2; ++ph) { const int nd = (ph == 0 ? nA : nC1) * (D / 256), nu = (ph == 0 ? nC1 : nC2) * (2 * FFE / 256);
                    int H = nd > G ? nd - G : (nd < G ? nd : 0); int mode = 1, R = 0; if (H >= G) H = 0;
                    pg8::MoeOrder::plan_wave(nu, H, G, D / 128, FFE / 128, lane, mode, R);
                    if (lane == 0) { ctl[CW_MOE + 2 + 3 * ph] = H; ctl[CW_MOE + 3 + 3 * ph] = R; ctl[CW_MOE + 4 + 3 * ph] = mode; } } }
            if (tid < 16) { const unsigned t0 = hs[4128 + tid] >> 8, t1 = hs[4128 + tid + 1] >> 8; for (unsigned t = t0; t < t1; ++t) ctl[CW_MOE + 16 + t] = tid & 7; }
        }
        for (int blk = vcu; blk < T / 64; blk += G) {
            if (tid < 16) hs[4160 + tid] = 0u;
            __syncthreads();
            { unsigned s = 0; const int g2 = tid & 15;
#pragma unroll
              for (int b2 = tid >> 4; b2 < 256; b2 += 32) s += (b2 < blk) ? hs[b2 * 16 + g2] : 0u;
              atomicAdd((unsigned*)&hs[4160 + g2], s); }
            __syncthreads();
            { if (blk != vcu) p11_load(blk);
#pragma unroll
              for (int u = 0; u < 8; ++u) { const int tok = blk * 64 + wave + 8 * u; const unsigned sv = svs[u]; v4u pk;
#pragma unroll
                for (int q = 0; q < 2; ++q) { const unsigned a = w0s[u][2 * q], b = w0s[u][2 * q + 1], c = w1s[u][2 * q], d2 = w1s[u][2 * q + 1];
                    pk[q] = pg8::pk4_fp8(__builtin_bit_cast(float, a << 16), __builtin_bit_cast(float, a & 0xffff0000u), __builtin_bit_cast(float, b << 16), __builtin_bit_cast(float, b & 0xffff0000u));
                    pk[2 + q] = pg8::pk4_fp8(__builtin_bit_cast(float, c << 16), __builtin_bit_cast(float, c & 0xffff0000u), __builtin_bit_cast(float, d2 << 16), __builtin_bit_cast(float, d2 & 0xffff0000u)); }
#pragma unroll
                for (int sl = 0; sl < 2; ++sl) { const int e = (sv >> (8 * sl)) & 0xff, rank = (sv >> (16 + 8 * sl)) & 0xff, g2 = sl * 8 + e;
                    const unsigned srow = hs[4128 + g2] + hs[4160 + g2] + rank;
                    *(GAS v4u*)(SORTA8 + (size_t)srow * D + lane * 16) = pk;
                    if (lane == 0) { rowtok[srow] = tok; rowgate[srow] = sl ? tg1[u] : tg0[u]; rowscale[srow] = rsqrtf(s3s[u] * (1.f / 1024.f) + pg8::RMS_EPS); } } }
            }
            __syncthreads();
        }
        for (int g2 = vcu; g2 < 16; g2 += G) {
            const unsigned r0 = hs[4128 + g2] + hs[4096 + g2], r1 = hs[4128 + g2 + 1];
            for (unsigned r = r0 + wave; r < r1; r += NWAVES) { if (lane == 0) { rowtok[r] = -1; rowgate[r] = 0.f; rowscale[r] = 0.f; }
                *(GAS v4u*)(SORTA8 + (size_t)r * D + lane * 16) = (v4u){0u, 0u, 0u, 0u}; }
        }
    }
    SEAM(11);

    if (IN(12) || IN(13) || IN(14) || IN(15)) {
        const int nA = (int)__builtin_amdgcn_readfirstlane(ctl[CW_MOE]), nT = (int)__builtin_amdgcn_readfirstlane(ctl[CW_MOE + 1]);
        const int nC1 = (nT - nA + 1) / 2, nC2 = nT - nA - nC1;
        const int* texp = (const int*)(ctl + CW_MOE + 16);
        unsigned char* const ACT_C0 = ACTE8; unsigned char* const ACT_C1 = ACTE8 + (size_t)63 * MiB; unsigned char* const ACT_C2 = ACT_C1 + (size_t)36 * 256 * FFE;
        constexpr int NPN_GU = 2 * FFE / 256, NPN_D = D / 256;
#define MOE_GU(TILE0, NTILE, ACTBUF, PLAN) do { int H_ = 0, R_ = 0, mode_ = 1; \
        if ((PLAN) >= 0) { H_ = (int)__builtin_amdgcn_readfirstlane(ctl[CW_MOE + 2 + 3 * (PLAN)]); R_ = (int)__builtin_amdgcn_readfirstlane(ctl[CW_MOE + 3 + 3 * (PLAN)]); mode_ = (int)__builtin_amdgcn_readfirstlane(ctl[CW_MOE + 4 + 3 * (PLAN)]); } \
        pg8::Gemm g{(const bf16*)(SORTA8 + (size_t)(TILE0) * 256 * D), (const bf16*)WEgu8, 0, 0, D / 2}; pg8::MoeOrder S; S.init((NTILE), NPN_GU, G, bx, (TILE0), texp, H_, R_, mode_); \
        pg8::EpiSwiglu<true> E{(ACTBUF), FFE, nullptr, 1, rowscale, (TILE0), NPN_GU, 1.f / W8_SCALE, rtab}; \
        const float* rsp_ = rowscale + (size_t)(TILE0) * 256; const auto rowfn_ = [rsp_](const pg8::Unit& u, int lr) { return rsp_[u.pm * 256 + lr]; }; \
        RUN_GEMM(pg8::EpiSwiglu<true>, true, true, g, S, E, rtab, rowfn_); } while (0)
#define MOE_DOWN(TILE0, NTILE, ACTBUF, LAST) do { pg8::Gemm g{(const bf16*)(ACTBUF), (const bf16*)WEd8, 0, 0, FFE / 2}; pg8::MoeOrder S; S.init((NTILE), NPN_D, G, bx, (TILE0), texp); \
        pg8::EpiMoeDown E{out, XB, rowtok, rowgate, (TILE0), 1.f / W8_SCALE, (args.flags >> 2) & 1, (LAST)}; \
        RUN_GEMM(pg8::EpiMoeDown, true, true, g, S, E, (LAS float*)nullptr, no_rows); } while (0)
        if (IN(12)) MOE_GU(0, nA, ACT_C0, -1);
        SEAM(12);
        if (IN(13)) { MOE_DOWN(0, nA, ACT_C0, 0); MOE_GU(nA, nC1, ACT_C1, 0); }
        SEAM(13);
        if (IN(14)) { MOE_DOWN(nA, nC1, ACT_C1, 1); if (nC2 > 0) MOE_GU(nA + nC1, nC2, ACT_C2, 1); }
        SEAM(14);
        if (IN(15)) { if (nC2 > 0) MOE_DOWN(nA + nC1, nC2, ACT_C2, 1); }
#undef MOE_GU
#undef MOE_DOWN
    }
#undef IN
#undef SEAM
#undef RUN_GEMM
#undef x_in
#undef positions
#undef ev_attn_norm
#undef ev_w_in
#undef ev_q_norm
#undef ev_k_norm
#undef ev_lq1
#undef ev_lk1
#undef ev_lq2
#undef ev_lk2
#undef ev_subln
#undef ev_w_out
#undef ev_ffn_norm
#undef ev_w_gate
#undef ev_w_up
#undef ev_w_down
#undef od_attn_norm
#undef od_w_qkv
#undef od_q_norm
#undef od_k_norm
#undef od_rel_bias
#undef od_w_out
#undef od_ffn_norm
#undef od_router
#undef od_we_gate
#undef od_we_up
#undef od_we_down
#undef KIN
}

constexpr int N_PHASES = 16;
extern "C" void kernel_launch(void* const* d_in, const int* in_sizes, int n_in, void* d_out, int out_size, void* d_ws, size_t ws_size, hipStream_t stream) {
    static int grid = 0;
    if (grid == 0) {
        if (n_in != 27 || out_size != T * D || ws_size < WS_END) { fprintf(stderr, "kernel_launch: unexpected problem (n_in %d, out %d, ws %zu)\n", n_in, out_size, ws_size); grid = -1; return; }
        int dev = 0, cus = 0, per_cu = 0;
        if (hipGetDevice(&dev) != hipSuccess || hipDeviceGetAttribute(&cus, hipDeviceAttributeMultiprocessorCount, dev) != hipSuccess) { grid = -1; return; }
        if (hipFuncSetAttribute((const void*)fwd_kernel, hipFuncAttributeMaxDynamicSharedMemorySize, LDS_BYTES) != hipSuccess) { fprintf(stderr, "kernel_launch: hipFuncSetAttribute failed\n"); grid = -1; return; }
        if (hipOccupancyMaxActiveBlocksPerMultiprocessor(&per_cu, (const void*)fwd_kernel, NTHR, LDS_BYTES) != hipSuccess || per_cu < 1) { fprintf(stderr, "kernel_launch: occupancy query says %d\n", per_cu); }
        (void)hipGetLastError();
        grid = cus;
    }
    if (grid < 0) return;
    (void)hipMemsetAsync(d_ws, 0, CTL_ZERO_BYTES, stream);
    KArgs a{};
    for (int i = 0; i < 27; ++i) a.in[i] = d_in[i];
    a.out = (float*)d_out; a.ws = (unsigned char*)d_ws; a.ph_lo = 0; a.ph_hi = N_PHASES;
    hipLaunchKernelGGL(fwd_kernel, dim3(grid), dim3(NTHR), LDS_BYTES, stream, a);
#if defined(PROBE_LO)
    (void)hipMemsetAsync((char*)d_ws + CW_BAR * 4, 0, XCD_BAR_WORDS * 4, stream); (void)hipMemsetAsync((char*)d_ws + CW_QATT * 4, 0, 4096, stream);
    a.ph_lo = PROBE_LO; a.ph_hi = PROBE_HI;
#if defined(PROBE_FLAGS)
    a.flags = PROBE_FLAGS;
#endif
    hipLaunchKernelGGL(fwd_kernel, dim3(grid), dim3(NTHR), LDS_BYTES, stream, a);
#endif
}
```
